# Optimizing an MI355X kernel written in HIP

```python
import math
import numpy as np
import jax, jax.numpy as jnp
from jax import lax

D_MODEL = 1024
BATCH = 2
SEQ = 8192
DEPTH = 2

N_EVEN = (DEPTH + 1) // 2
N_ODD = DEPTH // 2

MLSTM_HEADS = 4
MLSTM_HEAD_DIM = 128
MLSTM_W = MLSTM_HEADS * MLSTM_HEAD_DIM
MLSTM_CHUNK = 128
CONV_K = 4
NSA_HEADS = 8
NSA_GROUPS = 2
NSA_HPG = NSA_HEADS // NSA_GROUPS
NSA_HEAD_DIM = 64
NSA_W = NSA_HEADS * NSA_HEAD_DIM
NSA_KV_W = NSA_GROUPS * NSA_HEAD_DIM
CMP_LEN = 32
CMP_STRIDE = 16
CMP_HIDDEN = 128
SEL_BLOCK = 64
SEL_TOPK = 16
WINDOW = 512
Q_BLOCK = 128
ROPE_THETA = 500000.0
ROPE_DIM = NSA_HEAD_DIM // 4
EVEN_MIX_W = MLSTM_W + NSA_W
MLSTM_SPLITS = (MLSTM_W,) * 5 + (MLSTM_HEADS, MLSTM_HEADS)
NSA_SPLITS = (NSA_W,) + (NSA_KV_W,) * 6 + (3 * NSA_HEADS, NSA_W)
MLSTM_COLS = sum(MLSTM_SPLITS)
NSA_COLS = sum(NSA_SPLITS)
EVEN_IN_COLS = MLSTM_COLS + NSA_COLS
HGRN_HEADS = 8
HGRN_HEAD_DIM = 128
HGRN_W = HGRN_HEADS * HGRN_HEAD_DIM
HGRN_CHUNK = 64
ODD_IN_COLS = 4 * HGRN_W
EPS = 1e-6
NEG = -1e30

kernel_name = "hybrid_mlstm_nsa_hgrn2_trunk"


def split_cols(a, sizes):
    idx = np.cumsum(sizes)[:-1].tolist()
    return jnp.split(a, idx, axis=-1)


def rms_norm(x, w):
    xf = x.astype(jnp.float32)
    return xf * lax.rsqrt(jnp.mean(xf * xf, axis=-1, keepdims=True) + EPS) * w.astype(jnp.float32)


def heads(a, n_heads):
    b, s, _ = a.shape
    return a.reshape(b, s, n_heads, -1).transpose(0, 2, 1, 3)


def partial_rope(x, pos):
    half = ROPE_DIM // 2
    inv_freq = ROPE_THETA ** (-jnp.arange(half, dtype=jnp.float32) / half)
    ang = pos.astype(jnp.float32)[:, None] * inv_freq
    cos, sin = jnp.cos(ang), jnp.sin(ang)
    x1, x2, rest = x[..., :half], x[..., half:ROPE_DIM], x[..., ROPE_DIM:]
    return jnp.concatenate([x1 * cos - x2 * sin, x1 * sin + x2 * cos, rest], axis=-1)


def masked_softmax(s, mask):
    p = jax.nn.softmax(jnp.where(mask, s, NEG), axis=-1)
    return jnp.where(mask, p, 0.0)


def causal_conv(x, w, b):
    c = x.shape[-1]
    out = lax.conv_general_dilated(
        x, w.astype(jnp.float32).reshape(CONV_K, 1, c), window_strides=(1,),
        padding=[(CONV_K - 1, 0)], dimension_numbers=('NWC', 'WIO', 'NWC'),
        feature_group_count=c)
    return out + b


def mlstm_chunkwise(q, k, v, i_pre, f_pre):
    b_, h_, s_, d = q.shape
    L = MLSTM_CHUNK
    nc = s_ // L
    logf = jax.nn.log_sigmoid(f_pre)

    def to_chunks(a):
        return jnp.moveaxis(a.reshape(b_, h_, nc, L, *a.shape[3:]), 2, 0)

    causal = jnp.tril(jnp.ones((L, L), dtype=bool))

    def step(carry, xs):
        C, n, m = carry
        qj, kj, vj, ij, fj = xs
        bcum = jnp.cumsum(fj, axis=-1)
        D = jnp.where(causal, bcum[..., :, None] - bcum[..., None, :] + ij[..., None, :], -jnp.inf)
        inter = bcum + m[..., None]
        m_row = jnp.maximum(jnp.max(D, axis=-1), inter)
        Smat = jnp.einsum('bhjd,bhsd->bhjs', qj, kj) * jnp.exp(D - m_row[..., None])
        w_inter = jnp.exp(inter - m_row)
        num = jnp.einsum('bhjs,bhse->bhje', Smat, vj) + w_inter[..., None] * jnp.einsum('bhjd,bhde->bhje', qj, C)
        den = Smat.sum(-1) + w_inter * jnp.einsum('bhjd,bhd->bhj', qj, n)
        h = num / jnp.maximum(jnp.abs(den), jnp.exp(-m_row))[..., None]
        bL = bcum[..., -1]
        dl = bL[..., None] - bcum + ij
        m_new = jnp.maximum(bL + m, jnp.max(dl, axis=-1))
        wk = jnp.exp(dl - m_new[..., None])
        decay = jnp.exp(bL + m - m_new)
        C_new = decay[..., None, None] * C + jnp.einsum('bhs,bhsd,bhse->bhde', wk, kj, vj)
        n_new = decay[..., None] * n + jnp.einsum('bhs,bhsd->bhd', wk, kj)
        return (C_new, n_new, m_new), h

    init = (jnp.zeros((b_, h_, d, d), jnp.float32), jnp.zeros((b_, h_, d), jnp.float32),
            jnp.zeros((b_, h_), jnp.float32))
    _, hs = lax.scan(step, init, (to_chunks(q), to_chunks(k), to_chunks(v), to_chunks(i_pre), to_chunks(logf)))
    return jnp.moveaxis(hs, 0, 2).reshape(b_, h_, s_, d)


def mlstm_branch(cols, f_bias, conv_w, conv_b, head_norm):
    b_, s_, _ = cols.shape
    q, k, v, o, z, ig, fg = split_cols(cols, MLSTM_SPLITS)
    qk = jax.nn.silu(causal_conv(jnp.concatenate([q, k], axis=-1), conv_w, conv_b))
    q, k = jnp.split(qk, 2, axis=-1)
    qh = heads(q, MLSTM_HEADS)
    kh = heads(k, MLSTM_HEADS) * (MLSTM_HEAD_DIM ** -0.5)
    vh = heads(v, MLSTM_HEADS)
    i_pre = ig.transpose(0, 2, 1)
    f_pre = (fg + f_bias).transpose(0, 2, 1)
    h = mlstm_chunkwise(qh, kh, vh, i_pre, f_pre).transpose(0, 2, 1, 3)
    h = rms_norm(h, head_norm.reshape(MLSTM_HEADS, MLSTM_HEAD_DIM)).reshape(b_, s_, MLSTM_W)
    return h * jax.nn.sigmoid(o) * jax.nn.silu(z)


def compress(blocks, w1, w2):
    flat = blocks.reshape(*blocks.shape[:3], CMP_LEN * NSA_HEAD_DIM)
    return jax.nn.gelu(flat @ w1) @ w2


def nsa_branch(cols, q_norm, k_norm, ck_pos, ck_w1, ck_w2, cv_pos, cv_w1, cv_w2):
    b_, s_, _ = cols.shape
    G, R, d = NSA_GROUPS, NSA_HPG, NSA_HEAD_DIM
    q, kc, vc, ks, vs, kw, vw, gt, z = split_cols(cols, NSA_SPLITS)
    pos = jnp.arange(s_)
    qh = partial_rope(rms_norm(heads(q, NSA_HEADS), q_norm), pos) * (d ** -0.5)
    qh = qh.reshape(b_, G, R, s_, d)
    ks_h = partial_rope(rms_norm(heads(ks, G), k_norm[1]), pos)
    vs_h = heads(vs, G)
    kw_h = partial_rope(rms_norm(heads(kw, G), k_norm[2]), pos)
    vw_h = heads(vw, G)

    n_cmp = (s_ - CMP_LEN) // CMP_STRIDE + 1
    cmp_idx = np.arange(n_cmp)[:, None] * CMP_STRIDE + np.arange(CMP_LEN)[None, :]
    cmp_end = jnp.asarray(cmp_idx[:, -1])
    k_cmp = compress(heads(kc, G)[:, :, cmp_idx] + ck_pos, ck_w1, ck_w2)
    k_cmp = partial_rope(rms_norm(k_cmp, k_norm[0]), cmp_end)
    v_cmp = compress(heads(vc, G)[:, :, cmp_idx] + cv_pos, cv_w1, cv_w2)

    n_sel = s_ // SEL_BLOCK
    cs = np.arange(n_cmp) * CMP_STRIDE
    ss = np.arange(n_sel) * SEL_BLOCK
    ov = np.clip(np.minimum(cs[:, None] + CMP_LEN, ss[None, :] + SEL_BLOCK)
                 - np.maximum(cs[:, None], ss[None, :]), 0, None).astype(np.float32)
    ov = jnp.asarray(ov)
    k_top = min(SEL_TOPK, n_sel)

    gates = jax.nn.sigmoid(gt.reshape(b_, s_, NSA_HEADS, 3)).transpose(0, 2, 1, 3).reshape(b_, G, R, s_, 3)
    kw_pad = jnp.pad(kw_h, ((0, 0), (0, 0), (WINDOW, 0), (0, 0)))
    vw_pad = jnp.pad(vw_h, ((0, 0), (0, 0), (WINDOW, 0), (0, 0)))
    bi = jnp.arange(b_)[:, None, None, None]
    gi = jnp.arange(G)[None, :, None, None]
    nqb = s_ // Q_BLOCK

    def to_blocks(a):
        a = a.reshape(*a.shape[:-2], nqb, Q_BLOCK, a.shape[-1])
        return jnp.moveaxis(a, -3, 0)

    def block_fn(args):
        qb, q_blk, g_blk = args
        t = qb * Q_BLOCK + jnp.arange(Q_BLOCK)
        s_c = jnp.einsum('bgrqd,bgnd->bgrqn', q_blk, k_cmp)
        p_c = masked_softmax(s_c, cmp_end[None, :] <= t[:, None])
        o_c = jnp.einsum('bgrqn,bgnd->bgrqd', p_c, v_cmp)
        imp = jnp.einsum('bgrqn,nm->bgqm', p_c, ov)
        blk = jnp.arange(n_sel)[None, :]
        cur = (t // SEL_BLOCK)[:, None]
        forced = (blk == 0) | (blk == cur) | (blk == cur - 1)
        imp = jnp.where(blk > cur, NEG, jnp.where(forced, -NEG, imp))
        _, sel = lax.top_k(imp, k_top)
        valid = sel <= cur[None, None]
        tok = (sel[..., None] * SEL_BLOCK + jnp.arange(SEL_BLOCK)).reshape(b_, G, Q_BLOCK, k_top * SEL_BLOCK)
        tok_ok = jnp.repeat(valid, SEL_BLOCK, axis=-1) & (tok <= t[:, None])
        ks_g = ks_h[bi, gi, tok]
        vs_g = vs_h[bi, gi, tok]
        s_s = jnp.einsum('bgrqd,bgqnd->bgrqn', q_blk, ks_g)
        p_s = masked_softmax(s_s, tok_ok[:, :, None])
        o_s = jnp.einsum('bgrqn,bgqnd->bgrqd', p_s, vs_g)
        kwb = lax.dynamic_slice_in_dim(kw_pad, qb * Q_BLOCK, Q_BLOCK + WINDOW, axis=2)
        vwb = lax.dynamic_slice_in_dim(vw_pad, qb * Q_BLOCK, Q_BLOCK + WINDOW, axis=2)
        sp = qb * Q_BLOCK - WINDOW + jnp.arange(Q_BLOCK + WINDOW)
        wmask = (sp[None, :] >= 0) & (sp[None, :] <= t[:, None]) & (t[:, None] - sp[None, :] < WINDOW)
        s_w = jnp.einsum('bgrqd,bgnd->bgrqn', q_blk, kwb)
        p_w = masked_softmax(s_w, wmask)
        o_w = jnp.einsum('bgrqn,bgnd->bgrqd', p_w, vwb)
        return g_blk[..., 0:1] * o_c + g_blk[..., 1:2] * o_s + g_blk[..., 2:3] * o_w

    out = lax.map(block_fn, (jnp.arange(nqb), to_blocks(qh), to_blocks(gates)))
    out = jnp.moveaxis(out, 0, 3).reshape(b_, NSA_HEADS, s_, d).transpose(0, 2, 1, 3).reshape(b_, s_, NSA_W)
    return out * jax.nn.silu(z)


def hgrn2_chunkwise(q, k, v, logf):
    b_, h_, s_, dk = q.shape
    dv = v.shape[-1]
    L = HGRN_CHUNK
    nc = s_ // L

    def to_chunks(a):
        return jnp.moveaxis(a.reshape(b_, h_, nc, L, a.shape[-1]), 2, 0)

    causal = jnp.tril(jnp.ones((L, L), dtype=bool))[..., None]

    def step(Sst, xs):
        qj, kj, vj, gj = xs
        bcum = jnp.cumsum(gj, axis=-2)
        diff = bcum[..., :, None, :] - bcum[..., None, :, :]
        dec = jnp.exp(jnp.where(causal, diff, -jnp.inf))
        A = jnp.einsum('bhjc,bhsc,bhjsc->bhjs', qj, kj, dec)
        o = jnp.einsum('bhjs,bhsv->bhjv', A, vj) + jnp.einsum('bhjc,bhcv->bhjv', qj * jnp.exp(bcum), Sst)
        bL = bcum[..., -1, :]
        S_new = jnp.exp(bL)[..., None] * Sst + jnp.einsum('bhsc,bhsv->bhcv', kj * jnp.exp(bL[..., None, :] - bcum), vj)
        return S_new, o

    init = jnp.zeros((b_, h_, dk, dv), jnp.float32)
    _, os_ = lax.scan(step, init, (to_chunks(q), to_chunks(k), to_chunks(v), to_chunks(logf)))
    return jnp.moveaxis(os_, 0, 2).reshape(b_, h_, s_, dv)


def hgrn2_layer(h, w_in, b_in, lb, head_norm, w_out):
    b_, s_, _ = h.shape
    proj = h @ w_in + b_in
    fp, iv, qp, z = jnp.split(proj, 4, axis=-1)
    logf = jnp.log(lb + (1.0 - lb) * jax.nn.sigmoid(fp))
    k = (1.0 - lb) * jax.nn.sigmoid(-fp)
    q = jax.nn.silu(qp)
    o = hgrn2_chunkwise(heads(q, HGRN_HEADS), heads(k, HGRN_HEADS), heads(iv, HGRN_HEADS), heads(logf, HGRN_HEADS))
    o = rms_norm(o.transpose(0, 2, 1, 3), head_norm.reshape(HGRN_HEADS, HGRN_HEAD_DIM)).reshape(b_, s_, HGRN_W)
    return (o * jax.nn.silu(z)) @ w_out


def even_layer(h, w_in, b_in, f_bias, conv_w, conv_b, head_norm, q_norm, k_norm,
               ck_pos, ck_w1, ck_w2, cv_pos, cv_w1, cv_w2, w_out):
    proj = h @ w_in + b_in
    m_cols, n_cols = jnp.split(proj, [MLSTM_COLS], axis=-1)
    ya = mlstm_branch(m_cols, f_bias, conv_w, conv_b, head_norm)
    yb = nsa_branch(n_cols, q_norm, k_norm, ck_pos, ck_w1, ck_w2, cv_pos, cv_w1, cv_w2)
    return jnp.concatenate([ya, yb], axis=-1) @ w_out


def setup_inputs(seed: int = 0) -> dict:
    key = jax.random.key(seed)
    ks = jax.random.split(key, 24)

    def nrm(k, shape, scale):
        return scale * jax.random.normal(k, shape, jnp.float32)

    NE, NO = N_EVEN, N_ODD
    return {
        "x": nrm(ks[0], (BATCH, SEQ, D_MODEL), 1.0),
        "norm_w": 1.0 + nrm(ks[1], (DEPTH, D_MODEL), 0.02),
        "ev_w_in": nrm(ks[2], (NE, D_MODEL, EVEN_IN_COLS), D_MODEL ** -0.5),
        "ev_b_in": nrm(ks[3], (NE, EVEN_IN_COLS), 0.02),
        "mlstm_f_bias": jnp.linspace(3.0, 6.0, MLSTM_HEADS, dtype=jnp.float32)[None, :] + nrm(ks[4], (NE, MLSTM_HEADS), 0.1),
        "mlstm_conv_w": nrm(ks[5], (NE, CONV_K, 2 * MLSTM_W), CONV_K ** -0.5),
        "mlstm_conv_b": nrm(ks[6], (NE, 2 * MLSTM_W), 0.02),
        "mlstm_head_norm": 1.0 + nrm(ks[7], (NE, MLSTM_W), 0.02),
        "nsa_q_norm": 1.0 + nrm(ks[8], (NE, NSA_HEAD_DIM), 0.02),
        "nsa_k_norm": 1.0 + nrm(ks[9], (NE, 3, NSA_HEAD_DIM), 0.02),
        "cmp_k_pos": nrm(ks[10], (NE, CMP_LEN, NSA_HEAD_DIM), 0.1),
        "cmp_k_w1": nrm(ks[11], (NE, CMP_LEN * NSA_HEAD_DIM, CMP_HIDDEN), (CMP_LEN * NSA_HEAD_DIM) ** -0.5),
        "cmp_k_w2": nrm(ks[12], (NE, CMP_HIDDEN, NSA_HEAD_DIM), CMP_HIDDEN ** -0.5),
        "cmp_v_pos": nrm(ks[13], (NE, CMP_LEN, NSA_HEAD_DIM), 0.1),
        "cmp_v_w1": nrm(ks[14], (NE, CMP_LEN * NSA_HEAD_DIM, CMP_HIDDEN), (CMP_LEN * NSA_HEAD_DIM) ** -0.5),
        "cmp_v_w2": nrm(ks[15], (NE, CMP_HIDDEN, NSA_HEAD_DIM), CMP_HIDDEN ** -0.5),
        "ev_w_out": nrm(ks[16], (NE, EVEN_MIX_W, D_MODEL), EVEN_MIX_W ** -0.5),
        "od_w_in": nrm(ks[17], (NO, D_MODEL, ODD_IN_COLS), D_MODEL ** -0.5),
        "od_b_in": nrm(ks[18], (NO, ODD_IN_COLS), 0.02),
        "hgrn_lb_logits": nrm(ks[19], (NO + 1, HGRN_W), 0.5),
        "hgrn_head_norm": 1.0 + nrm(ks[20], (NO, HGRN_W), 0.02),
        "od_w_out": nrm(ks[21], (NO, HGRN_W, D_MODEL), HGRN_W ** -0.5),
    }


def reference(x, norm_w, ev_w_in, ev_b_in, mlstm_f_bias, mlstm_conv_w, mlstm_conv_b, mlstm_head_norm,
              nsa_q_norm, nsa_k_norm, cmp_k_pos, cmp_k_w1, cmp_k_w2, cmp_v_pos, cmp_v_w1, cmp_v_w2,
              ev_w_out, od_w_in, od_b_in, hgrn_lb_logits, hgrn_head_norm, od_w_out):
    lbs = jnp.cumsum(jax.nn.softmax(hgrn_lb_logits.astype(jnp.float32), axis=0), axis=0)
    for layer in range(DEPTH):
        h = rms_norm(x, norm_w[layer])
        j = layer // 2
        if layer % 2 == 0:
            y = even_layer(h, ev_w_in[j], ev_b_in[j], mlstm_f_bias[j], mlstm_conv_w[j], mlstm_conv_b[j],
                           mlstm_head_norm[j], nsa_q_norm[j], nsa_k_norm[j], cmp_k_pos[j], cmp_k_w1[j],
                           cmp_k_w2[j], cmp_v_pos[j], cmp_v_w1[j], cmp_v_w2[j], ev_w_out[j])
        else:
            y = hgrn2_layer(h, od_w_in[j], od_b_in[j], lbs[j], hgrn_head_norm[j], od_w_out[j])
        x = x + y.astype(x.dtype)
    return x
```

```cpp
#include <hip/hip_runtime.h>
#include <hip/hip_cooperative_groups.h>
#include <stdint.h>
#include <cstdio>
namespace cg = cooperative_groups;

typedef unsigned short bf16_t;
typedef __attribute__((ext_vector_type(8))) short bf16x8;
typedef __attribute__((ext_vector_type(4))) float f32x4;
typedef __attribute__((ext_vector_type(4))) unsigned int u32x4;

#define DEVI __device__ __forceinline__
#define EPSF 1e-6f
#define LDT 72
#define SLD 68
#define NEGS (-1e30f)
#define LAUNDER(ptr) asm volatile("" : "+s"(ptr))

struct Params {
  const float* x; const float* norm_w; const float* ev_w_in; const float* ev_b_in; const float* f_bias;
  const float* conv_w; const float* conv_b; const float* m_hn; const float* q_norm; const float* k_norm;
  const float* ck_pos; const float* ck_w1; const float* ck_w2; const float* cv_pos; const float* cv_w1; const float* cv_w2;
  const float* ev_w_out; const float* od_w_in; const float* od_b_in; const float* lb_logits; const float* h_hn; const float* od_w_out;
  float* out; unsigned char* ws;
};

constexpr size_t MiB = 1048576;
constexpr size_t OFF_WIN0 = 0;
constexpr size_t OFF_WOUT0 = OFF_WIN0 + 4480ull * 1024 * 2;
constexpr size_t OFF_WIN1 = OFF_WOUT0 + 2 * MiB;
constexpr size_t OFF_WOUT1 = OFF_WIN1 + 8 * MiB;
constexpr size_t OFF_WCK = OFF_WOUT1 + 2 * MiB;
constexpr size_t OFF_WCV = OFF_WCK + 512 * 1024;
constexpr size_t OFF_ROPE = OFF_WCV + 512 * 1024;
constexpr size_t OFF_PB = OFF_ROPE + 512 * 1024;
constexpr size_t OFF_LB = OFF_PB + 1024;
constexpr size_t OFF_BAR = OFF_LB + 4096;
constexpr size_t OFF_BASE = 24 * MiB;
constexpr size_t L0_H = OFF_BASE;
constexpr size_t L0_QKRAW = L0_H + 32 * MiB;
constexpr size_t L0_QC = L0_QKRAW + 32 * MiB;
constexpr size_t L0_KC = L0_QC + 16 * MiB;
constexpr size_t L0_KCT = L0_KC + 16 * MiB;
constexpr size_t L0_MVT = L0_KCT + 16 * MiB;
constexpr size_t L0_MO = L0_MVT + 16 * MiB;
constexpr size_t L0_MZ = L0_MO + 16 * MiB;
constexpr size_t L0_QN = L0_MZ + 16 * MiB;
constexpr size_t L0_NZ = L0_QN + 16 * MiB;
constexpr size_t L0_KCRAW = L0_NZ + 16 * MiB;
constexpr size_t L0_VCRAW = L0_KCRAW + 4 * MiB;
constexpr size_t L0_KS = L0_VCRAW + 4 * MiB;
constexpr size_t L0_KW = L0_KS + 4 * MiB;
constexpr size_t L0_VST = L0_KW + 4 * MiB;
constexpr size_t L0_VWT = L0_VST + 4 * MiB;
constexpr size_t L0_HID = L0_VWT + 4 * MiB;
constexpr size_t L0_KCMP = L0_HID + 2 * MiB;
constexpr size_t L0_VCMPT = L0_KCMP + 256 * 1024;
constexpr size_t L0_IG = L0_VCMPT + 256 * 1024;
constexpr size_t L0_LOGF = L0_IG + 256 * 1024;
constexpr size_t L0_GATES = L0_LOGF + 256 * 1024;
constexpr size_t L0_DN = L0_GATES + 1536 * 1024;
constexpr size_t L0_BL = L0_DN + 256 * 1024;
constexpr size_t L0_MLOC = L0_BL + 4096;
constexpr size_t L0_MIN = L0_MLOC + 4096;
constexpr size_t L0_END = L0_MIN + 4096;
static_assert(L0_END <= 256 * MiB, "ws overflow L0");
constexpr size_t L1_H = OFF_BASE;
constexpr size_t L1_FP = L1_H + 32 * MiB;
constexpr size_t L1_Q = L1_FP + 32 * MiB;
constexpr size_t L1_VT = L1_Q + 32 * MiB;
constexpr size_t L1_Z = L1_VT + 32 * MiB;
constexpr size_t L1_ST = L1_Z + 32 * MiB;
constexpr size_t L1_BL = L1_ST + 64 * MiB;
constexpr size_t L1_END = L1_BL + 1 * MiB;
static_assert(L1_END <= 256 * MiB, "ws overflow L1");

DEVI bf16_t f2bf(float f) { unsigned u = __float_as_uint(f); u += 0x7fffu + ((u >> 16) & 1u); return (bf16_t)(u >> 16); }
DEVI float bf2f(bf16_t b) { return __uint_as_float(((unsigned)b) << 16); }
DEVI unsigned pack2(float a, float b) { return (unsigned)f2bf(a) | ((unsigned)f2bf(b) << 16); }
DEVI float lo2f(unsigned u) { return __uint_as_float(u << 16); }
DEVI float hi2f(unsigned u) { return __uint_as_float(u & 0xffff0000u); }
DEVI float sigm(float x) { return 1.f / (1.f + __expf(-x)); }
DEVI float siluf(float x) { return x * sigm(x); }
DEVI float wave_sum(float v) { for (int o = 32; o > 0; o >>= 1) v += __shfl_xor(v, o); return v; }
DEVI float grp16_sum(float v) { v += __shfl_xor(v, 1); v += __shfl_xor(v, 2); v += __shfl_xor(v, 4); v += __shfl_xor(v, 8); return v; }
DEVI int oldcol(int n) {
  return n < 2560 ? n : (n < 3840 ? n + 8 : (n < 4352 ? n + 32 : (n < 4360 ? n - 4352 + 2560 : n - 4360 + 3848)));
}

template <int MT, int NTL, int KS>
DEVI void mma_lds(const bf16_t* sA, const bf16_t* sB, f32x4 (&acc)[MT][NTL], int lane) {
  const int r = lane & 15, q = lane >> 4;
#pragma unroll
  for (int ks = 0; ks < KS; ++ks) {
    bf16x8 a[MT], b[NTL];
#pragma unroll
    for (int mt = 0; mt < MT; ++mt) a[mt] = *(const bf16x8*)(sA + (mt * 16 + r) * LDT + ks * 32 + q * 8);
#pragma unroll
    for (int nt = 0; nt < NTL; ++nt) b[nt] = *(const bf16x8*)(sB + (nt * 16 + r) * LDT + ks * 32 + q * 8);
#pragma unroll
    for (int mt = 0; mt < MT; ++mt)
#pragma unroll
      for (int nt = 0; nt < NTL; ++nt) acc[mt][nt] = __builtin_amdgcn_mfma_f32_16x16x32_bf16(a[mt], b[nt], acc[mt][nt], 0, 0, 0);
  }
}

DEVI void load_tile128(bf16_t* s, const bf16_t* g, long ld) {
  const int tid = threadIdx.x, lr = tid >> 3, lk = (tid & 7) * 8;
#pragma unroll
  for (int j = 0; j < 4; ++j) *(uint4*)(s + (lr + 32 * j) * LDT + lk) = *(const uint4*)(g + (long)(lr + 32 * j) * ld + lk);
}
DEVI void load_tile64(bf16_t* s, const bf16_t* g, long ld) {
  const int tid = threadIdx.x, lr = tid >> 3, lk = (tid & 7) * 8;
#pragma unroll
  for (int j = 0; j < 2; ++j) *(uint4*)(s + (lr + 32 * j) * LDT + lk) = *(const uint4*)(g + (long)(lr + 32 * j) * ld + lk);
}

template <class Epi>
DEVI void gemm128(const bf16_t* A, long lda, int amax, const bf16_t* B, long ldb, int bmax, int K, int m0, int n0,
                  bf16_t* sA, bf16_t* sB, Epi&& epi) {
  const int tid = threadIdx.x, lane = tid & 63, w = tid >> 6, wr = w >> 1, wc = w & 1;
  const int lr = tid >> 3, lk = (tid & 7) * 8;
  f32x4 acc[4][4];
#pragma unroll
  for (int mt = 0; mt < 4; ++mt)
#pragma unroll
    for (int nt = 0; nt < 4; ++nt) acc[mt][nt] = f32x4{0.f, 0.f, 0.f, 0.f};
  const bf16_t* ap[4];
  const bf16_t* bp[4];
#pragma unroll
  for (int j = 0; j < 4; ++j) {
    int ra = min(m0 + lr + 32 * j, amax);
    ap[j] = A + (long)ra * lda + lk;
    int rb = min(n0 + lr + 32 * j, bmax);
    bp[j] = B + (long)rb * ldb + lk;
  }
  u32x4 va0, va1, va2, va3, vb0, vb1, vb2, vb3;
  va0 = *(const u32x4*)(ap[0]); va1 = *(const u32x4*)(ap[1]); va2 = *(const u32x4*)(ap[2]); va3 = *(const u32x4*)(ap[3]);
  vb0 = *(const u32x4*)(bp[0]); vb1 = *(const u32x4*)(bp[1]); vb2 = *(const u32x4*)(bp[2]); vb3 = *(const u32x4*)(bp[3]);
  const int KT = K >> 6;
  for (int kt = 0; kt < KT; ++kt) {
    *(u32x4*)(sA + (lr + 0) * LDT + lk) = va0; *(u32x4*)(sA + (lr + 32) * LDT + lk) = va1;
    *(u32x4*)(sA + (lr + 64) * LDT + lk) = va2; *(u32x4*)(sA + (lr + 96) * LDT + lk) = va3;
    *(u32x4*)(sB + (lr + 0) * LDT + lk) = vb0; *(u32x4*)(sB + (lr + 32) * LDT + lk) = vb1;
    *(u32x4*)(sB + (lr + 64) * LDT + lk) = vb2; *(u32x4*)(sB + (lr + 96) * LDT + lk) = vb3;
    __syncthreads();
    if (kt + 1 < KT) {
      const int ko = (kt + 1) * 64;
      va0 = *(const u32x4*)(ap[0] + ko); va1 = *(const u32x4*)(ap[1] + ko); va2 = *(const u32x4*)(ap[2] + ko); va3 = *(const u32x4*)(ap[3] + ko);
      vb0 = *(const u32x4*)(bp[0] + ko); vb1 = *(const u32x4*)(bp[1] + ko); vb2 = *(const u32x4*)(bp[2] + ko); vb3 = *(const u32x4*)(bp[3] + ko);
    }
    mma_lds<4, 4, 2>(sA + wr * 64 * LDT, sB + wc * 64 * LDT, acc, lane);
    __syncthreads();
  }
  epi(acc, m0 + wr * 64, n0 + wc * 64, lane);
}

DEVI void transpose_tile(const float* src, int N, int ldsrc, bf16_t* dst, int K, int ktile, int ntile, bool perm, float* sT) {
  const int tid = threadIdx.x;
  const int k0 = ktile * 64, n0 = ntile * 64;
#pragma unroll
  for (int j = 0; j < 4; ++j) {
    int idx = tid + 256 * j;
    int kk = idx >> 4, n4 = (idx & 15) * 4;
    int n = n0 + n4;
    float4 v = make_float4(0.f, 0.f, 0.f, 0.f);
    if (n < N) { int oc = perm ? oldcol(n) : n; v = *(const float4*)(src + (long)(k0 + kk) * ldsrc + oc); }
    sT[kk * 65 + n4 + 0] = v.x; sT[kk * 65 + n4 + 1] = v.y; sT[kk * 65 + n4 + 2] = v.z; sT[kk * 65 + n4 + 3] = v.w;
  }
  __syncthreads();
#pragma unroll
  for (int j = 0; j < 2; ++j) {
    int idx = tid + 256 * j;
    int nn = idx >> 3, kc = (idx & 7) * 8;
    if (n0 + nn < N) {
      uint4 o;
      o.x = pack2(sT[(kc + 0) * 65 + nn], sT[(kc + 1) * 65 + nn]);
      o.y = pack2(sT[(kc + 2) * 65 + nn], sT[(kc + 3) * 65 + nn]);
      o.z = pack2(sT[(kc + 4) * 65 + nn], sT[(kc + 5) * 65 + nn]);
      o.w = pack2(sT[(kc + 6) * 65 + nn], sT[(kc + 7) * 65 + nn]);
      *(uint4*)(dst + (long)(n0 + nn) * K + k0 + kc) = o;
    }
  }
  __syncthreads();
}

DEVI void rmsnorm_row(const float* X, const float* w, bf16_t* H, int row, int lane) {
  const float4* xr = (const float4*)(X + (long)row * 1024);
  float4 v[4];
  float ss = 0.f;
#pragma unroll
  for (int j = 0; j < 4; ++j) { v[j] = xr[lane + 64 * j]; ss += v[j].x * v[j].x + v[j].y * v[j].y + v[j].z * v[j].z + v[j].w * v[j].w; }
  ss = wave_sum(ss);
  float rinv = rsqrtf(ss * (1.f / 1024.f) + EPSF);
#pragma unroll
  for (int j = 0; j < 4; ++j) {
    float4 ww = ((const float4*)w)[lane + 64 * j];
    uint2 o;
    o.x = pack2(v[j].x * rinv * ww.x, v[j].y * rinv * ww.y);
    o.y = pack2(v[j].z * rinv * ww.z, v[j].w * rinv * ww.w);
    *(uint2*)(H + (long)row * 1024 + (lane + 64 * j) * 4) = o;
  }
}

DEVI void phase0(const Params& p, unsigned char* smem) {
  const int G = gridDim.x, bid = blockIdx.x, tid = threadIdx.x, lane = tid & 63, w = tid >> 6;
  unsigned char* ws = p.ws;
  float* sT = (float*)smem;
  for (int it = bid; it < 69 * 16; it += G) transpose_tile(p.ev_w_in, 4384, 4384, (bf16_t*)(ws + OFF_WIN0), 1024, it / 69, it % 69, true, sT);
  for (int it = bid; it < 16 * 16; it += G) transpose_tile(p.ev_w_out, 1024, 1024, (bf16_t*)(ws + OFF_WOUT0), 1024, it / 16, it % 16, false, sT);
  for (int it = bid; it < 64 * 16; it += G) transpose_tile(p.od_w_in, 4096, 4096, (bf16_t*)(ws + OFF_WIN1), 1024, it / 64, it % 64, false, sT);
  for (int it = bid; it < 16 * 16; it += G) transpose_tile(p.od_w_out, 1024, 1024, (bf16_t*)(ws + OFF_WOUT1), 1024, it / 16, it % 16, false, sT);
  for (int it = bid; it < 2 * 32; it += G) transpose_tile(p.ck_w1, 128, 128, (bf16_t*)(ws + OFF_WCK), 2048, it / 2, it % 2, false, sT);
  for (int it = bid; it < 2 * 32; it += G) transpose_tile(p.cv_w1, 128, 128, (bf16_t*)(ws + OFF_WCV), 2048, it / 2, it % 2, false, sT);
  for (int row = bid * 4 + w; row < 16384; row += G * 4) rmsnorm_row(p.x, p.norm_w, (bf16_t*)(ws + L0_H), row, lane);
  for (int idx = bid * 256 + tid; idx < 8192 * 8; idx += G * 256) {
    int t = idx >> 3, i = idx & 7;
    float invf = powf(500000.0f, -(float)i / 8.0f);
    float ang = (float)t * invf;
    double a = (double)ang;
    float2 cs;
    cs.x = (float)cos(a);
    cs.y = (float)sin(a);
    ((float2*)(ws + OFF_ROPE))[idx] = cs;
  }
  if (bid == G - 1) {
    int kv = tid >> 7, j = tid & 127;
    const float* pos = kv ? p.cv_pos : p.ck_pos;
    const float* w1 = kv ? p.cv_w1 : p.ck_w1;
    float s = 0.f;
    for (int i = 0; i < 2048; ++i) s += pos[i] * w1[i * 128 + j];
    ((float*)(ws + OFF_PB))[tid] = s;
  }
  if (bid == G - 2 || G < 2) {
    for (int c = tid; c < 1024; c += 256) {
      float l0 = p.lb_logits[c], l1 = p.lb_logits[1024 + c];
      ((float*)(ws + OFF_LB))[c] = 1.f / (1.f + expf(l1 - l0));
    }
  }
}

template <int MODE>
DEVI void store_rm(bf16_t* dst, int ld, int colbase, f32x4 (&acc)[4][4], const float* bias, int mb, int lane) {
  const int r = lane & 15, q = lane >> 4;
#pragma unroll
  for (int mt = 0; mt < 4; ++mt)
#pragma unroll
    for (int i = 0; i < 4; ++i) {
      long row = mb + mt * 16 + q * 4 + i;
#pragma unroll
      for (int nt = 0; nt < 4; ++nt) {
        float v = acc[mt][nt][i] + bias[nt];
        if (MODE == 1) v = sigm(v);
        if (MODE == 2) v = siluf(v);
        dst[row * ld + colbase + nt * 16 + r] = f2bf(v);
      }
    }
}
template <int MODE>
DEVI void store_T(bf16_t* dst, long featbase, f32x4 (&acc)[4][4], const float* bias, int tl0, int lane) {
  const int r = lane & 15, q = lane >> 4;
#pragma unroll
  for (int mt = 0; mt < 4; ++mt)
#pragma unroll
    for (int nt = 0; nt < 4; ++nt) {
      int t = tl0 + mt * 16 + q * 4;
      float b = bias[nt];
      uint2 o;
      o.x = pack2(acc[mt][nt][0] + b, acc[mt][nt][1] + b);
      o.y = pack2(acc[mt][nt][2] + b, acc[mt][nt][3] + b);
      *(uint2*)(dst + (featbase + nt * 16 + r) * 8192 + t) = o;
    }
}
DEVI void norm_rope_store(bf16_t* dst, long rowbase, int ld, int colbase, f32x4 (&acc)[4][4], const float* bias, const float* nw,
                          float scale, const float2* rope, int mb, int lane) {
  const int r = lane & 15, q = lane >> 4;
  float wv[4];
#pragma unroll
  for (int nt = 0; nt < 4; ++nt) wv[nt] = nw[nt * 16 + r];
#pragma unroll
  for (int mt = 0; mt < 4; ++mt)
#pragma unroll
    for (int i = 0; i < 4; ++i) {
      int row = mb + mt * 16 + q * 4 + i;
      int t = row & 8191;
      float v[4];
      float ss = 0.f;
#pragma unroll
      for (int nt = 0; nt < 4; ++nt) { v[nt] = acc[mt][nt][i] + bias[nt]; ss += v[nt] * v[nt]; }
      ss = grp16_sum(ss);
      float rinv = rsqrtf(ss * (1.f / 64.f) + EPSF);
#pragma unroll
      for (int nt = 0; nt < 4; ++nt) v[nt] = v[nt] * rinv * wv[nt];
      float partner = __shfl_xor(v[0], 8);
      float2 cs = rope[t * 8 + (r & 7)];
      float x1 = (r < 8) ? v[0] : partner, x2 = (r < 8) ? partner : v[0];
      v[0] = (r < 8) ? (x1 * cs.x - x2 * cs.y) : (x1 * cs.y + x2 * cs.x);
#pragma unroll
      for (int nt = 0; nt < 4; ++nt) dst[(rowbase + t) * ld + colbase + nt * 16 + r] = f2bf(v[nt] * scale);
    }
}

DEVI void epi_proj0(const Params& p, f32x4 (&acc)[4][4], int mb, int nb, int lane) {
  if (nb >= 4384) return;
  unsigned char* ws = p.ws;
  const int r = lane & 15, q = lane >> 4;
  float bias[4];
#pragma unroll
  for (int nt = 0; nt < 4; ++nt) { int n = nb + nt * 16 + r; bias[nt] = (n < 4384) ? p.ev_b_in[oldcol(n)] : 0.f; }
  const int b = mb >> 13;
  const int tl0 = mb & 8191;
  const float2* rope = (const float2*)(ws + OFF_ROPE);
  if (nb < 1024) {
    store_rm<0>((bf16_t*)(ws + L0_QKRAW), 1024, nb, acc, bias, mb, lane);
  } else if (nb < 1536) {
    store_T<0>((bf16_t*)(ws + L0_MVT), (long)b * 512 + (nb - 1024), acc, bias, tl0, lane);
  } else if (nb < 2048) {
    store_rm<1>((bf16_t*)(ws + L0_MO), 512, nb - 1536, acc, bias, mb, lane);
  } else if (nb < 2560) {
    store_rm<2>((bf16_t*)(ws + L0_MZ), 512, nb - 2048, acc, bias, mb, lane);
  } else if (nb < 3072) {
    int head = (nb - 2560) >> 6, g = head >> 2, rr = head & 3;
    norm_rope_store((bf16_t*)(ws + L0_QN), (long)(b * 2 + g) * 8192, 256, rr * 64, acc, bias, p.q_norm, 0.125f, rope, mb, lane);
  } else if (nb < 3328) {
    int g = ((nb - 3072) >> 6) & 1;
    bf16_t* dst = (bf16_t*)(ws + (nb < 3200 ? L0_KCRAW : L0_VCRAW));
    const long rowbase = (long)(b * 2 + g) * 8192;
#pragma unroll
    for (int mt = 0; mt < 4; ++mt)
#pragma unroll
      for (int i = 0; i < 4; ++i) {
        int t = (mb + mt * 16 + q * 4 + i) & 8191;
#pragma unroll
        for (int nt = 0; nt < 4; ++nt) dst[(rowbase + t) * 64 + nt * 16 + r] = f2bf(acc[mt][nt][i] + bias[nt]);
      }
  } else if (nb < 3456) {
    int g = (nb - 3328) >> 6;
    norm_rope_store((bf16_t*)(ws + L0_KS), (long)(b * 2 + g) * 8192, 64, 0, acc, bias, p.k_norm + 64, 1.f, rope, mb, lane);
  } else if (nb < 3584) {
    store_T<0>((bf16_t*)(ws + L0_VST), (long)b * 128 + (nb - 3456), acc, bias, tl0, lane);
  } else if (nb < 3712) {
    int g = (nb - 3584) >> 6;
    norm_rope_store((bf16_t*)(ws + L0_KW), (long)(b * 2 + g) * 8192, 64, 0, acc, bias, p.k_norm + 128, 1.f, rope, mb, lane);
  } else if (nb < 3840) {
    store_T<0>((bf16_t*)(ws + L0_VWT), (long)b * 128 + (nb - 3712), acc, bias, tl0, lane);
  } else if (nb < 4352) {
    store_rm<2>((bf16_t*)(ws + L0_NZ), 512, nb - 3840, acc, bias, mb, lane);
  } else {
    float* IG = (float*)(ws + L0_IG);
    float* LF = (float*)(ws + L0_LOGF);
    float* GT = (float*)(ws + L0_GATES);
#pragma unroll
    for (int mt = 0; mt < 4; ++mt)
#pragma unroll
      for (int i = 0; i < 4; ++i) {
        long row = mb + mt * 16 + q * 4 + i;
#pragma unroll
        for (int nt = 0; nt < 2; ++nt) {
          int c = nt * 16 + r;
          float v = acc[mt][nt][i] + bias[nt];
          if (c < 4) IG[row * 4 + c] = v;
          else if (c < 8) { float xx = v + p.f_bias[c - 4]; LF[row * 4 + c - 4] = fminf(xx, 0.f) - log1pf(__expf(-fabsf(xx))); }
          else GT[row * 24 + c - 8] = sigm(v);
        }
      }
  }
}

DEVI void epi_cmp_hidden(const Params& p, f32x4 (&acc)[4][4], int mb, int nb, int lane, int kv, int bg) {
  const int r = lane & 15, q = lane >> 4;
  const float* pb = (const float*)(p.ws + OFF_PB) + kv * 128;
  float* hid = (float*)(p.ws + L0_HID) + ((long)(kv * 4 + bg) * 512) * 128;
#pragma unroll
  for (int mt = 0; mt < 4; ++mt)
#pragma unroll
    for (int i = 0; i < 4; ++i) {
      int row = mb + mt * 16 + q * 4 + i;
#pragma unroll
      for (int nt = 0; nt < 4; ++nt) {
        int c = nb + nt * 16 + r;
        float xx = acc[mt][nt][i] + pb[c];
        float g = 0.5f * xx * (1.f + tanhf(0.7978845608028654f * (xx + 0.044715f * xx * xx * xx)));
        hid[(long)row * 128 + c] = g;
      }
    }
}

DEVI void epi_out_resid(const float* resid, float* out, f32x4 (&acc)[4][4], int mb, int nb, int lane) {
  const int r = lane & 15, q = lane >> 4;
#pragma unroll
  for (int mt = 0; mt < 4; ++mt)
#pragma unroll
    for (int i = 0; i < 4; ++i) {
      long row = mb + mt * 16 + q * 4 + i;
#pragma unroll
      for (int nt = 0; nt < 4; ++nt) {
        long idx = row * 1024 + nb + nt * 16 + r;
        out[idx] = resid[idx] + acc[mt][nt][i];
      }
    }
}

DEVI void epi_proj1(const Params& p, f32x4 (&acc)[4][4], int mb, int nb, int lane) {
  unsigned char* ws = p.ws;
  const int r = lane & 15;
  float bias[4];
#pragma unroll
  for (int nt = 0; nt < 4; ++nt) bias[nt] = p.od_b_in[nb + nt * 16 + r];
  const int b = mb >> 13, tl0 = mb & 8191;
  if (nb < 1024) store_rm<0>((bf16_t*)(ws + L1_FP), 1024, nb, acc, bias, mb, lane);
  else if (nb < 2048) store_T<0>((bf16_t*)(ws + L1_VT), (long)b * 1024 + (nb - 1024), acc, bias, tl0, lane);
  else if (nb < 3072) store_rm<2>((bf16_t*)(ws + L1_Q), 1024, nb - 2048, acc, bias, mb, lane);
  else store_rm<2>((bf16_t*)(ws + L1_Z), 1024, nb - 3072, acc, bias, mb, lane);
}

DEVI void conv_tile(const Params& p, int item, unsigned char* smem) {
  const int tid = threadIdx.x;
  const int ctile = item & 7, ttile = item >> 3;
  const int t0g = ttile * 64;
  const int b = t0g >> 13, tl0 = t0g & 8191;
  unsigned char* ws = p.ws;
  float* sRaw = (float*)smem;
  bf16_t* sOutT = (bf16_t*)(smem + 67 * 128 * 4);
  const bf16_t* raw = (const bf16_t*)(ws + L0_QKRAW);
  for (int idx = tid; idx < 67 * 16; idx += 256) {
    int rr = idx >> 4, ch = (idx & 15) * 8;
    int tl = tl0 + rr - 3;
    uint4 v = make_uint4(0, 0, 0, 0);
    if (tl >= 0) v = *(const uint4*)(raw + (long)(b * 8192 + tl) * 1024 + ctile * 128 + ch);
    float* d = sRaw + rr * 128 + ch;
    d[0] = lo2f(v.x); d[1] = hi2f(v.x); d[2] = lo2f(v.y); d[3] = hi2f(v.y);
    d[4] = lo2f(v.z); d[5] = hi2f(v.z); d[6] = lo2f(v.w); d[7] = hi2f(v.w);
  }
  __syncthreads();
  const int c = tid & 127, th = tid >> 7;
  const int cg_ = ctile * 128 + c;
  const float w0 = p.conv_w[cg_], w1 = p.conv_w[1024 + cg_], w2 = p.conv_w[2048 + cg_], w3 = p.conv_w[3072 + cg_];
  const float cb = p.conv_b[cg_];
  const bool isk = ctile >= 4;
  bf16_t* dst = (bf16_t*)(ws + (isk ? L0_KC : L0_QC));
  const int cc = isk ? cg_ - 512 : cg_;
  const float sc = isk ? 0.08838834764831845f : 1.f;
  for (int t = th * 32; t < th * 32 + 32; ++t) {
    float a = cb + w0 * sRaw[t * 128 + c] + w1 * sRaw[(t + 1) * 128 + c] + w2 * sRaw[(t + 2) * 128 + c] + w3 * sRaw[(t + 3) * 128 + c];
    bf16_t o = f2bf(siluf(a) * sc);
    dst[(long)(t0g + t) * 512 + cc] = o;
    sOutT[c * LDT + t] = o;
  }
  __syncthreads();
  if (isk) {
    bf16_t* kct = (bf16_t*)(ws + L0_KCT);
#pragma unroll
    for (int j = 0; j < 4; ++j) {
      int idx = tid + 256 * j;
      int cr = idx >> 3, tc = (idx & 7) * 8;
      *(uint4*)(kct + ((long)(b * 512 + (ctile - 4) * 128 + cr)) * 8192 + tl0 + tc) = *(const uint4*)(sOutT + cr * LDT + tc);
    }
  }
  __syncthreads();
}

DEVI void cmp_finalize(const Params& p, int task, int lane) {
  const int n = task & 511, bg = (task >> 9) & 3, kv = task >> 11;
  unsigned char* ws = p.ws;
  bf16_t* KCMP = (bf16_t*)(ws + L0_KCMP);
  bf16_t* VCMPT = (bf16_t*)(ws + L0_VCMPT);
  if (n == 511) {
    if (kv == 0) KCMP[((long)bg * 512 + 511) * 64 + lane] = 0;
    else VCMPT[((long)bg * 64 + lane) * 512 + 511] = 0;
    return;
  }
  const float* hid = (const float*)(ws + L0_HID) + ((long)(kv * 4 + bg) * 512 + n) * 128;
  const float* w2 = kv ? p.cv_w2 : p.ck_w2;
  float a = 0.f;
  for (int j = 0; j < 128; ++j) a += hid[j] * w2[j * 64 + lane];
  if (kv == 0) {
    float ss = wave_sum(a * a);
    float rinv = rsqrtf(ss * (1.f / 64.f) + EPSF);
    float v = a * rinv * p.k_norm[lane];
    float partner = __shfl_xor(v, 8);
    int pos = 16 * n + 31;
    float2 cs = ((const float2*)(ws + OFF_ROPE))[pos * 8 + (lane & 7)];
    float o = v;
    if (lane < 8) o = v * cs.x - partner * cs.y;
    else if (lane < 16) o = partner * cs.y + v * cs.x;
    KCMP[((long)bg * 512 + n) * 64 + lane] = f2bf(o);
  } else {
    VCMPT[((long)bg * 64 + lane) * 512 + n] = f2bf(a);
  }
}

DEVI void mlstm_local(const Params& p, int unit, unsigned char* smem) {
  const int tid = threadIdx.x, lane = tid & 63, w = tid >> 6, wr = w >> 1, wc = w & 1;
  const int bh = unit >> 6, c = unit & 63, b = bh >> 2, h = bh & 3, t0 = c * 128;
  const long R0 = (long)b * 8192 + t0;
  unsigned char* ws = p.ws;
  bf16_t* sA = (bf16_t*)smem;
  bf16_t* sB = (bf16_t*)(smem + 18432);
  float* sIg = (float*)(smem + 36864);
  float* sLf = sIg + 128;
  float* sW = sLf + 128;
  const float* IG = (const float*)(ws + L0_IG);
  const float* LF = (const float*)(ws + L0_LOGF);
  if (tid < 128) { sIg[tid] = IG[(R0 + tid) * 4 + h]; sLf[tid] = LF[(R0 + tid) * 4 + h]; }
  __syncthreads();
  if (tid == 0) {
    float cum = 0.f;
#pragma unroll 1
    for (int s = 0; s < 128; ++s) { cum += sLf[s]; sLf[s] = cum; }
    float bL = cum, ml = -3.0e38f;
#pragma unroll 1
    for (int s = 0; s < 128; ++s) { float dl = bL - sLf[s] + sIg[s]; sW[s] = dl; ml = fmaxf(ml, dl); }
#pragma unroll 1
    for (int s = 0; s < 128; ++s) sW[s] = __expf(sW[s] - ml);
    ((float*)(ws + L0_BL))[unit] = bL;
    ((float*)(ws + L0_MLOC))[unit] = ml;
  }
  __syncthreads();
  f32x4 acc[4][4];
#pragma unroll
  for (int mt = 0; mt < 4; ++mt)
#pragma unroll
    for (int nt = 0; nt < 4; ++nt) acc[mt][nt] = f32x4{0.f, 0.f, 0.f, 0.f};
  float dn = 0.f;
  const bf16_t* vt = (const bf16_t*)(ws + L0_MVT) + ((long)(b * 512 + h * 128)) * 8192 + t0;
  const bf16_t* kt_ = (const bf16_t*)(ws + L0_KCT) + ((long)(b * 512 + h * 128)) * 8192 + t0;
  const int lr = tid >> 3, lk = (tid & 7) * 8;
  for (int kt = 0; kt < 2; ++kt) {
    load_tile128(sA, vt + kt * 64, 8192);
#pragma unroll
    for (int j = 0; j < 4; ++j) {
      uint4 v = *(const uint4*)(kt_ + (long)(lr + 32 * j) * 8192 + kt * 64 + lk);
      const float* ww = sW + kt * 64 + lk;
      uint4 o;
      o.x = pack2(lo2f(v.x) * ww[0], hi2f(v.x) * ww[1]);
      o.y = pack2(lo2f(v.y) * ww[2], hi2f(v.y) * ww[3]);
      o.z = pack2(lo2f(v.z) * ww[4], hi2f(v.z) * ww[5]);
      o.w = pack2(lo2f(v.w) * ww[6], hi2f(v.w) * ww[7]);
      *(uint4*)(sB + (lr + 32 * j) * LDT + lk) = o;
    }
    __syncthreads();
    if (tid < 128) {
#pragma unroll 8
      for (int s = 0; s < 64; ++s) dn += bf2f(sB[tid * LDT + s]);
    }
    mma_lds<4, 4, 2>(sA + wr * 64 * LDT, sB + wc * 64 * LDT, acc, lane);
    __syncthreads();
  }
  float* dct = (float*)(ws + L0_H) + (long)unit * 16384;
  const int r = lane & 15, q = lane >> 4;
#pragma unroll
  for (int mt = 0; mt < 4; ++mt)
#pragma unroll
    for (int i = 0; i < 4; ++i) {
      int e = wr * 64 + mt * 16 + q * 4 + i;
#pragma unroll
      for (int nt = 0; nt < 4; ++nt) dct[e * 128 + wc * 64 + nt * 16 + r] = acc[mt][nt][i];
    }
  if (tid < 128) ((float*)(ws + L0_DN))[unit * 128 + tid] = dn;
}

DEVI void mlstm_scan(const Params& p) {
  unsigned char* ws = p.ws;
  const float* BL = (const float*)(ws + L0_BL);
  const float* ML = (const float*)(ws + L0_MLOC);
  float* MIN_ = (float*)(ws + L0_MIN);
  const int total = 8 * 16384 + 8 * 128;
  for (int idx = blockIdx.x * 256 + threadIdx.x; idx < total; idx += gridDim.x * 256) {
    float* ptr; int stride; int bh; bool wm = false;
    if (idx < 131072) { bh = idx >> 14; int off = idx & 16383; ptr = (float*)(ws + L0_H) + (long)bh * 64 * 16384 + off; stride = 16384; wm = (off == 0); }
    else { int j = idx - 131072; bh = j >> 7; int off = j & 127; ptr = (float*)(ws + L0_DN) + (long)bh * 64 * 128 + off; stride = 128; }
    float m = 0.f, C = 0.f;
    for (int c = 0; c < 64; ++c) {
      int unit = bh * 64 + c;
      float bL = BL[unit], ml = ML[unit];
      float d = ptr[(long)c * stride];
      ptr[(long)c * stride] = C;
      if (wm) MIN_[unit] = m;
      float mn = fmaxf(bL + m, ml);
      C = __expf(bL + m - mn) * C + __expf(ml - mn) * d;
      m = mn;
    }
  }
}

DEVI void mlstm_out(const Params& p, int unit, unsigned char* smem) {
  const int tid = threadIdx.x, lane = tid & 63, w = tid >> 6, wr = w >> 1, wc = w & 1;
  const int r = lane & 15, q = lane >> 4;
  const int bh = unit >> 6, c = unit & 63, b = bh >> 2, h = bh & 3, t0 = c * 128;
  const long R0 = (long)b * 8192 + t0;
  unsigned char* ws = p.ws;
  bf16_t* sA = (bf16_t*)smem;
  bf16_t* sB = (bf16_t*)(smem + 18432);
  bf16_t* sS0 = (bf16_t*)(smem + 36864);
  bf16_t* sS1 = (bf16_t*)(smem + 55296);
  float* fl = (float*)(smem + 73728);
  float* sIg = fl; float* sLf = fl + 128; float* sRj = fl + 256; float* sCs = fl + 384; float* sWi = fl + 512;
  float* sEm = fl + 640; float* sQn = fl + 768; float* sNin = fl + 896; float* sDen = fl + 1024; float* sSs = fl + 1280;
  const float* IG = (const float*)(ws + L0_IG);
  const float* LF = (const float*)(ws + L0_LOGF);
  const bf16_t* QC = (const bf16_t*)(ws + L0_QC) + R0 * 512 + h * 128;
  const bf16_t* KC = (const bf16_t*)(ws + L0_KC) + R0 * 512 + h * 128;
  if (tid < 128) { sIg[tid] = IG[(R0 + tid) * 4 + h]; sLf[tid] = LF[(R0 + tid) * 4 + h]; sNin[tid] = ((const float*)(ws + L0_DN))[unit * 128 + tid]; }
  const float m_in = ((const float*)(ws + L0_MIN))[unit];
  __syncthreads();
  if (tid == 0) {
    float cum = 0.f, cmx = -3.0e38f;
#pragma unroll 1
    for (int s = 0; s < 128; ++s) {
      cum += sLf[s];
      float a = sIg[s] - cum;
      cmx = fmaxf(cmx, a);
      float mx = fmaxf(cmx, m_in);
      sCs[s] = a; sRj[s] = -mx; sWi[s] = __expf(m_in - mx); sEm[s] = __expf(-(cum + mx));
    }
  }
  if (tid >= 128) {
    int j = tid - 128;
    const bf16_t* qr = QC + (long)j * 512;
    float s = 0.f;
#pragma unroll 2
    for (int ch = 0; ch < 16; ++ch) {
      uint4 v = *(const uint4*)(qr + ch * 8);
      const float* nn = sNin + ch * 8;
      s += lo2f(v.x) * nn[0] + hi2f(v.x) * nn[1] + lo2f(v.y) * nn[2] + hi2f(v.y) * nn[3] + lo2f(v.z) * nn[4] + hi2f(v.z) * nn[5] + lo2f(v.w) * nn[6] + hi2f(v.w) * nn[7];
    }
    sQn[j] = s;
  }
  __syncthreads();
  f32x4 acc[4][4];
#pragma unroll
  for (int mt = 0; mt < 4; ++mt)
#pragma unroll
    for (int nt = 0; nt < 4; ++nt) acc[mt][nt] = f32x4{0.f, 0.f, 0.f, 0.f};
  const bool skipS = (wr == 0 && wc == 1);
  for (int kt = 0; kt < 2; ++kt) {
    LAUNDER(QC); LAUNDER(KC);
    load_tile128(sA, QC + kt * 64, 512);
    load_tile128(sB, KC + kt * 64, 512);
    __syncthreads();
    if (!skipS) mma_lds<4, 4, 2>(sA + wr * 64 * LDT, sB + wc * 64 * LDT, acc, lane);
    __syncthreads();
  }
  {
    bf16_t* sS = wc ? sS1 : sS0;
#pragma unroll
    for (int mt = 0; mt < 4; ++mt)
#pragma unroll
      for (int i = 0; i < 4; ++i) {
        int j = wr * 64 + mt * 16 + q * 4 + i;
        float rj = sRj[j], rs = 0.f;
#pragma unroll
        for (int nt = 0; nt < 4; ++nt) {
          int sl = nt * 16 + r, s = wc * 64 + sl;
          float val = (s <= j) ? acc[mt][nt][i] * __expf(rj + sCs[s]) : 0.f;
          rs += val;
          sS[j * LDT + sl] = f2bf(val);
        }
        rs = grp16_sum(rs);
        if (r == 0) sDen[wc * 128 + j] = rs;
      }
  }
#pragma unroll
  for (int mt = 0; mt < 4; ++mt)
#pragma unroll
    for (int nt = 0; nt < 4; ++nt) acc[mt][nt] = f32x4{0.f, 0.f, 0.f, 0.f};
  const bf16_t* vt = (const bf16_t*)(ws + L0_MVT) + ((long)(b * 512 + h * 128)) * 8192 + t0;
  LAUNDER(vt);
  load_tile128(sB, vt, 8192);
  __syncthreads();
  mma_lds<4, 4, 2>(sS0 + wr * 64 * LDT, sB + wc * 64 * LDT, acc, lane);
  __syncthreads();
  LAUNDER(vt);
  load_tile128(sB, vt + 64, 8192);
  __syncthreads();
  if (wr == 1) mma_lds<4, 4, 2>(sS1 + wr * 64 * LDT, sB + wc * 64 * LDT, acc, lane);
  __syncthreads();
  const float* ct = (const float*)(ws + L0_H) + (long)unit * 16384;
  const int lr = tid >> 3, lk = (tid & 7) * 8;
  for (int kt = 0; kt < 2; ++kt) {
    LAUNDER(QC); LAUNDER(ct);
#pragma unroll
    for (int j = 0; j < 4; ++j) {
      int row = lr + 32 * j;
      uint4 v = *(const uint4*)(QC + (long)row * 512 + kt * 64 + lk);
      float wi = sWi[row];
      uint4 o;
      o.x = pack2(lo2f(v.x) * wi, hi2f(v.x) * wi);
      o.y = pack2(lo2f(v.y) * wi, hi2f(v.y) * wi);
      o.z = pack2(lo2f(v.z) * wi, hi2f(v.z) * wi);
      o.w = pack2(lo2f(v.w) * wi, hi2f(v.w) * wi);
      *(uint4*)(sA + row * LDT + lk) = o;
    }
#pragma unroll
    for (int j = 0; j < 8; ++j) {
      int e = (tid >> 4) + 16 * j, c4 = (tid & 15) * 4;
      float4 v = *(const float4*)(ct + (long)e * 128 + kt * 64 + c4);
      uint2 o;
      o.x = pack2(v.x, v.y);
      o.y = pack2(v.z, v.w);
      *(uint2*)(sB + e * LDT + c4) = o;
    }
    __syncthreads();
    mma_lds<4, 4, 2>(sA + wr * 64 * LDT, sB + wc * 64 * LDT, acc, lane);
    __syncthreads();
  }
#pragma unroll
  for (int mt = 0; mt < 4; ++mt)
#pragma unroll
    for (int i = 0; i < 4; ++i) {
      int j = wr * 64 + mt * 16 + q * 4 + i;
      float den = sDen[j] + sDen[128 + j] + sWi[j] * sQn[j];
      float dinv = 1.f / fmaxf(fabsf(den), sEm[j]);
      float ss = 0.f;
#pragma unroll
      for (int nt = 0; nt < 4; ++nt) { float v = acc[mt][nt][i] * dinv; acc[mt][nt][i] = v; ss += v * v; }
      ss = grp16_sum(ss);
      if (r == 0) sSs[wc * 128 + j] = ss;
    }
  __syncthreads();
  const bf16_t* MO = (const bf16_t*)(ws + L0_MO);
  const bf16_t* MZ = (const bf16_t*)(ws + L0_MZ);
  bf16_t* Y = (bf16_t*)(ws + L0_QKRAW);
#pragma unroll
  for (int mt = 0; mt < 4; ++mt)
#pragma unroll
    for (int i = 0; i < 4; ++i) {
      int j = wr * 64 + mt * 16 + q * 4 + i;
      float rinv = rsqrtf((sSs[j] + sSs[128 + j]) * (1.f / 128.f) + EPSF);
      long row = R0 + j;
#pragma unroll
      for (int nt = 0; nt < 4; ++nt) {
        int col = h * 128 + wc * 64 + nt * 16 + r;
        float v = acc[mt][nt][i] * rinv * p.m_hn[col] * bf2f(MO[row * 512 + col]) * bf2f(MZ[row * 512 + col]);
        Y[row * 1024 + col] = f2bf(v);
      }
    }
  __syncthreads();
}

struct AttnSm {
  bf16_t* sK; bf16_t* sV; float* sS; bf16_t* sP; float* sM; float* sL; float* sAl; float* sImp; unsigned* sSel; unsigned* sUn; float* sCarry;
};

template <int MODE, class MaskF>
DEVI void attn_keytile(const AttnSm& sm, const bf16_t* Kg, const bf16_t* Vtg, long ldv, const bf16x8 (&qf)[2], f32x4 (&O)[4], MaskF mask, int kt) {
  const int tid = threadIdx.x, lane = tid & 63, w = tid >> 6, r = lane & 15, q = lane >> 4;
  load_tile64(sm.sK, Kg, 64);
  if (MODE != 1) load_tile64(sm.sV, Vtg, ldv);
  __syncthreads();
  f32x4 sacc[4];
#pragma unroll
  for (int nt = 0; nt < 4; ++nt) sacc[nt] = f32x4{0.f, 0.f, 0.f, 0.f};
#pragma unroll
  for (int ks = 0; ks < 2; ++ks)
#pragma unroll
    for (int nt = 0; nt < 4; ++nt) {
      bf16x8 bb = *(const bf16x8*)(sm.sK + (nt * 16 + r) * LDT + ks * 32 + q * 8);
      sacc[nt] = __builtin_amdgcn_mfma_f32_16x16x32_bf16(qf[ks], bb, sacc[nt], 0, 0, 0);
    }
#pragma unroll
  for (int nt = 0; nt < 4; ++nt)
#pragma unroll
    for (int i = 0; i < 4; ++i) {
      int row = 16 * w + q * 4 + i, key = nt * 16 + r;
      sm.sS[row * SLD + key] = mask(row, key) ? sacc[nt][i] : NEGS;
    }
  __syncthreads();
  {
    const int row = tid >> 2, part = tid & 3;
    float s[16];
#pragma unroll
    for (int i4 = 0; i4 < 4; ++i4) {
      float4 v = *(const float4*)(sm.sS + row * SLD + part * 16 + i4 * 4);
      s[i4 * 4 + 0] = v.x; s[i4 * 4 + 1] = v.y; s[i4 * 4 + 2] = v.z; s[i4 * 4 + 3] = v.w;
    }
    if (MODE != 2) {
      float tm = NEGS;
#pragma unroll
      for (int i = 0; i < 16; ++i) tm = fmaxf(tm, s[i]);
      tm = fmaxf(tm, __shfl_xor(tm, 1));
      tm = fmaxf(tm, __shfl_xor(tm, 2));
      const float mo = sm.sM[row];
      const float mn = fmaxf(mo, tm);
      float ps = 0.f;
      float pv[16];
#pragma unroll
      for (int i = 0; i < 16; ++i) { pv[i] = (s[i] > -1e29f) ? __expf(s[i] - mn) : 0.f; ps += pv[i]; }
      ps += __shfl_xor(ps, 1);
      ps += __shfl_xor(ps, 2);
      const float al = __expf(mo - mn);
      const float lo = sm.sL[row];
      if (MODE == 0) {
#pragma unroll
        for (int i8 = 0; i8 < 2; ++i8) {
          uint4 o;
          o.x = pack2(pv[i8 * 8 + 0], pv[i8 * 8 + 1]); o.y = pack2(pv[i8 * 8 + 2], pv[i8 * 8 + 3]);
          o.z = pack2(pv[i8 * 8 + 4], pv[i8 * 8 + 5]); o.w = pack2(pv[i8 * 8 + 6], pv[i8 * 8 + 7]);
          *(uint4*)(sm.sP + row * LDT + part * 16 + i8 * 8) = o;
        }
      }
      if (part == 0) { sm.sM[row] = mn; sm.sL[row] = al * lo + ps; sm.sAl[row] = al; }
    } else {
      const float mrow = sm.sM[row], il = sm.sL[row];
      float pv[16];
#pragma unroll
      for (int i = 0; i < 16; ++i) pv[i] = (s[i] > -1e29f) ? __expf(s[i] - mrow) * il : 0.f;
#pragma unroll
      for (int i8 = 0; i8 < 2; ++i8) {
        uint4 o;
        o.x = pack2(pv[i8 * 8 + 0], pv[i8 * 8 + 1]); o.y = pack2(pv[i8 * 8 + 2], pv[i8 * 8 + 3]);
        o.z = pack2(pv[i8 * 8 + 4], pv[i8 * 8 + 5]); o.w = pack2(pv[i8 * 8 + 6], pv[i8 * 8 + 7]);
        *(uint4*)(sm.sP + row * LDT + part * 16 + i8 * 8) = o;
      }
#pragma unroll
      for (int i4 = 0; i4 < 4; ++i4)
        *(float4*)(sm.sS + row * SLD + part * 16 + i4 * 4) = make_float4(pv[i4 * 4], pv[i4 * 4 + 1], pv[i4 * 4 + 2], pv[i4 * 4 + 3]);
    }
  }
  __syncthreads();
  if (MODE == 2) {
    const int ti = tid >> 4, mm = tid & 15;
    const float* cin = sm.sCarry + ((kt & 1) ^ 1) * 64;
    float* cout = sm.sCarry + (kt & 1) * 64;
    float sum = 0.f;
#pragma unroll
    for (int rr = 0; rr < 4; ++rr) {
      int rho = ti * 4 + rr;
      float4 pp = *(const float4*)(sm.sS + rho * SLD + 4 * mm);
      float pm1 = (mm > 0) ? sm.sS[rho * SLD + 4 * mm - 1] : cin[rho];
      sum += 16.f * pm1 + 32.f * (pp.x + pp.y + pp.z) + 16.f * pp.w;
      if (mm == 15) cout[rho] = pp.w;
    }
    sm.sImp[ti * 128 + kt * 16 + mm] = sum;
  }
  if (MODE != 1) {
    if (MODE == 0) {
#pragma unroll
      for (int i = 0; i < 4; ++i) {
        float al = sm.sAl[16 * w + q * 4 + i];
#pragma unroll
        for (int nt = 0; nt < 4; ++nt) O[nt][i] *= al;
      }
    }
#pragma unroll
    for (int ks = 0; ks < 2; ++ks) {
      bf16x8 a = *(const bf16x8*)(sm.sP + (16 * w + r) * LDT + ks * 32 + q * 8);
#pragma unroll
      for (int nt = 0; nt < 4; ++nt) {
        bf16x8 bb = *(const bf16x8*)(sm.sV + (nt * 16 + r) * LDT + ks * 32 + q * 8);
        O[nt] = __builtin_amdgcn_mfma_f32_16x16x32_bf16(a, bb, O[nt], 0, 0, 0);
      }
    }
  }
  __syncthreads();
}

DEVI void nsa_tile(const Params& p, int tileidx, unsigned char* smem) {
  const int tid = threadIdx.x, lane = tid & 63, w = tid >> 6, r = lane & 15, q = lane >> 4;
  const int bg = tileidx & 3, tt = tileidx >> 2, b = bg >> 1, g = bg & 1, t0 = tt * 16;
  unsigned char* ws = p.ws;
  AttnSm sm;
  sm.sK = (bf16_t*)smem; sm.sV = (bf16_t*)(smem + 9216); sm.sP = (bf16_t*)(smem + 18432);
  sm.sS = (float*)(smem + 27648);
  sm.sM = (float*)(smem + 45056); sm.sL = sm.sM + 64; sm.sAl = sm.sM + 128;
  sm.sCarry = sm.sM + 192;
  sm.sSel = (unsigned*)(sm.sM + 320);
  sm.sUn = sm.sSel + 64;
  sm.sImp = (float*)(smem + 45056 + 2048);
  bf16x8 qf[2];
  {
    const bf16_t* qn = (const bf16_t*)(ws + L0_QN) + ((long)bg * 8192 + t0) * 256 + (16 * w + r) * 64 + q * 8;
    qf[0] = *(const bf16x8*)(qn);
    qf[1] = *(const bf16x8*)(qn + 32);
  }
  const float* GT = (const float*)(ws + L0_GATES);
  f32x4 outacc[4], O[4];
#pragma unroll
  for (int nt = 0; nt < 4; ++nt) outacc[nt] = f32x4{0.f, 0.f, 0.f, 0.f};
  const int cur = t0 >> 6;
  for (int i = tid; i < 16 * 128; i += 256) sm.sImp[i] = 0.f;
  if (tid < 64) { sm.sM[tid] = NEGS; sm.sL[tid] = 0.f; sm.sCarry[tid] = 0.f; sm.sCarry[64 + tid] = 0.f; }
  __syncthreads();
  const int nvmax = (t0 + 15 >= 31) ? (((t0 + 15 - 31) >> 4) + 1) : 0;
#ifdef DBG_NO_CMP
  const int nkt = 0;
#else
  const int nkt = (nvmax + 63) >> 6;
#endif
  const bf16_t* KCMP = (const bf16_t*)(ws + L0_KCMP) + (long)bg * 512 * 64;
  const bf16_t* VCMPT = (const bf16_t*)(ws + L0_VCMPT) + (long)bg * 64 * 512;
#pragma unroll
  for (int nt = 0; nt < 4; ++nt) O[nt] = f32x4{0.f, 0.f, 0.f, 0.f};
  for (int kt = 0; kt < nkt; ++kt) {
    auto mk = [&](int row, int key) { return 16 * (kt * 64 + key) + 31 <= t0 + (row >> 2); };
    attn_keytile<1>(sm, KCMP + kt * 64 * 64, VCMPT + kt * 64, 512, qf, O, mk, kt);
  }
  if (tid < 64) { float l = sm.sL[tid]; sm.sL[tid] = (l > 0.f) ? 1.f / l : 0.f; }
  __syncthreads();
  for (int kt = 0; kt < nkt; ++kt) {
    auto mk = [&](int row, int key) { return 16 * (kt * 64 + key) + 31 <= t0 + (row >> 2); };
    attn_keytile<2>(sm, KCMP + kt * 64 * 64, VCMPT + kt * 64, 512, qf, O, mk, kt);
  }
#pragma unroll
  for (int i = 0; i < 4; ++i) {
    int row = 16 * w + q * 4 + i, ti = row >> 2, rr = row & 3;
    float gc = GT[((long)b * 8192 + t0 + ti) * 24 + (g * 4 + rr) * 3 + 0];
#pragma unroll
    for (int nt = 0; nt < 4; ++nt) outacc[nt][i] += gc * O[nt][i];
  }
  {
    const int ncand = (cur - 2 > 0) ? cur - 2 : 0;
    const int nf = (cur >= 2) ? 3 : cur + 1;
    const int kk = 16 - nf;
    for (int tq = 0; tq < 4; ++tq) {
      const int ti = w * 4 + tq;
      const float* imp = sm.sImp + ti * 128;
      const int m0 = lane, m1 = lane + 64;
      const float v0 = imp[m0], v1 = imp[m1];
      const bool c0 = (m0 >= 1 && m0 <= cur - 2), c1 = (m1 <= cur - 2);
      bool s0, s1;
      if (ncand <= kk) { s0 = c0; s1 = c1; }
      else {
        int r0 = 0, r1 = 0;
        for (int mp = 1; mp <= cur - 2; ++mp) {
          float vm = imp[mp];
          r0 += (vm > v0 || (vm == v0 && mp < m0)) ? 1 : 0;
          r1 += (vm > v1 || (vm == v1 && mp < m1)) ? 1 : 0;
        }
        s0 = c0 && (r0 < kk);
        s1 = c1 && (r1 < kk);
      }
      s0 = s0 || (m0 == 0) || (m0 == cur) || (m0 == cur - 1);
      s1 = s1 || (m1 == cur) || (m1 == cur - 1);
      unsigned long long lo = __ballot(s0), hi = __ballot(s1);
      if (lane == 0) {
        sm.sSel[ti * 4 + 0] = (unsigned)lo; sm.sSel[ti * 4 + 1] = (unsigned)(lo >> 32);
        sm.sSel[ti * 4 + 2] = (unsigned)hi; sm.sSel[ti * 4 + 3] = (unsigned)(hi >> 32);
      }
    }
  }
  __syncthreads();
  if (tid < 4) { unsigned u = 0; for (int ti = 0; ti < 16; ++ti) u |= sm.sSel[ti * 4 + tid]; sm.sUn[tid] = u; }
  if (tid < 64) { sm.sM[tid] = NEGS; sm.sL[tid] = 0.f; }
  __syncthreads();
#pragma unroll
  for (int nt = 0; nt < 4; ++nt) O[nt] = f32x4{0.f, 0.f, 0.f, 0.f};
  {
    const bf16_t* KS = (const bf16_t*)(ws + L0_KS) + (long)bg * 8192 * 64;
    const bf16_t* VST = (const bf16_t*)(ws + L0_VST) + (long)bg * 64 * 8192;
#ifdef DBG_NO_SEL
    for (int j = 0; j < 0; ++j) {
#else
    for (int j = 0; j <= cur; ++j) {
#endif
      if (!((sm.sUn[j >> 5] >> (j & 31)) & 1u)) continue;
      auto mk = [&](int row, int key) {
        int ti = row >> 2;
        return (((sm.sSel[ti * 4 + (j >> 5)] >> (j & 31)) & 1u) != 0) && (j * 64 + key <= t0 + ti);
      };
      attn_keytile<0>(sm, KS + (long)j * 64 * 64, VST + j * 64, 8192, qf, O, mk, j);
    }
  }
#pragma unroll
  for (int i = 0; i < 4; ++i) {
    int row = 16 * w + q * 4 + i, ti = row >> 2, rr = row & 3;
    float l = sm.sL[row];
    float gs = GT[((long)b * 8192 + t0 + ti) * 24 + (g * 4 + rr) * 3 + 1] * ((l > 0.f) ? 1.f / l : 0.f);
#pragma unroll
    for (int nt = 0; nt < 4; ++nt) outacc[nt][i] += gs * O[nt][i];
  }
  __syncthreads();
  if (tid < 64) { sm.sM[tid] = NEGS; sm.sL[tid] = 0.f; }
  __syncthreads();
#pragma unroll
  for (int nt = 0; nt < 4; ++nt) O[nt] = f32x4{0.f, 0.f, 0.f, 0.f};
  {
    const bf16_t* KW = (const bf16_t*)(ws + L0_KW) + (long)bg * 8192 * 64;
    const bf16_t* VWT = (const bf16_t*)(ws + L0_VWT) + (long)bg * 64 * 8192;
    const int jlo = ((t0 - 511 > 0) ? (t0 - 511) : 0) >> 6;
#ifdef DBG_NO_WIN
    for (int j = jlo; j < jlo; ++j) {
#else
    for (int j = jlo; j <= cur; ++j) {
#endif
      auto mk = [&](int row, int key) {
        int t = t0 + (row >> 2), s = j * 64 + key;
        return (s <= t) && (t - s < 512);
      };
      attn_keytile<0>(sm, KW + (long)j * 64 * 64, VWT + j * 64, 8192, qf, O, mk, j);
    }
  }
  const bf16_t* NZ = (const bf16_t*)(ws + L0_NZ);
  bf16_t* Y = (bf16_t*)(ws + L0_QKRAW);
#pragma unroll
  for (int i = 0; i < 4; ++i) {
    int row = 16 * w + q * 4 + i, ti = row >> 2, rr = row & 3;
    float l = sm.sL[row];
    long tok = (long)b * 8192 + t0 + ti;
    int head = g * 4 + rr;
    float gw = GT[tok * 24 + head * 3 + 2] * ((l > 0.f) ? 1.f / l : 0.f);
#pragma unroll
    for (int nt = 0; nt < 4; ++nt) {
      float v = outacc[nt][i] + gw * O[nt][i];
      int d = nt * 16 + r;
      float z = bf2f(NZ[tok * 512 + head * 64 + d]);
      Y[tok * 1024 + 512 + head * 64 + d] = f2bf(v * z);
    }
  }
  __syncthreads();
}

DEVI void hgrn_local(const Params& p, int unit, unsigned char* smem) {
  const int tid = threadIdx.x, lane = tid & 63, w = tid >> 6, wr = w >> 1, wc = w & 1;
  const int bh = unit >> 7, c = unit & 127, b = bh >> 3, h = bh & 7, t0 = c * 64;
  const long R0 = (long)b * 8192 + t0;
  unsigned char* ws = p.ws;
  bf16_t* sA = (bf16_t*)smem;
  bf16_t* sB = (bf16_t*)(smem + 18432);
  float* psum = (float*)(smem + 36864);
  const int cch = tid & 127, half = tid >> 7;
  const float lb = ((const float*)(ws + OFF_LB))[h * 128 + cch];
  const bf16_t* FP = (const bf16_t*)(ws + L1_FP) + R0 * 1024 + h * 128 + cch;
  load_tile128(sA, (const bf16_t*)(ws + L1_VT) + ((long)(b * 1024 + h * 128)) * 8192 + t0, 8192);
  float sum = 0.f;
  for (int s = half * 32; s < half * 32 + 32; ++s) {
    float fp = bf2f(FP[(long)s * 1024]);
    float f = lb + (1.f - lb) * sigm(fp);
    sum += __logf(f);
  }
  psum[half * 128 + cch] = sum;
  __syncthreads();
  const float bL = psum[cch] + psum[128 + cch];
  float run = half ? psum[cch] : 0.f;
  for (int s = half * 32; s < half * 32 + 32; ++s) {
    float fp = bf2f(FP[(long)s * 1024]);
    float sg = sigm(fp);
    float f = lb + (1.f - lb) * sg;
    run += __logf(f);
    float k = (1.f - lb) * (1.f - sg);
    sB[cch * LDT + s] = f2bf(k * __expf(bL - run));
  }
  if (half == 0) ((float*)(ws + L1_BL))[(long)unit * 128 + cch] = bL;
  __syncthreads();
  f32x4 acc[4][4];
#pragma unroll
  for (int mt = 0; mt < 4; ++mt)
#pragma unroll
    for (int nt = 0; nt < 4; ++nt) acc[mt][nt] = f32x4{0.f, 0.f, 0.f, 0.f};
  mma_lds<4, 4, 2>(sA + wr * 64 * LDT, sB + wc * 64 * LDT, acc, lane);
  bf16_t* st = (bf16_t*)(ws + L1_ST) + (long)unit * 16384;
  const int r = lane & 15, q = lane >> 4;
#pragma unroll
  for (int mt = 0; mt < 4; ++mt)
#pragma unroll
    for (int i = 0; i < 4; ++i) {
      int v = wr * 64 + mt * 16 + q * 4 + i;
#pragma unroll
      for (int nt = 0; nt < 4; ++nt) st[v * 128 + wc * 64 + nt * 16 + r] = f2bf(acc[mt][nt][i]);
    }
  __syncthreads();
}

DEVI void hgrn_scan(const Params& p) {
  unsigned char* ws = p.ws;
  const float* BL = (const float*)(ws + L1_BL);
  for (int idx = blockIdx.x * 256 + threadIdx.x; idx < 16 * 8192; idx += gridDim.x * 256) {
    int bh = idx >> 13, pr = idx & 8191;
    int c2 = (pr & 63) * 2;
    unsigned* ptr = (unsigned*)(ws + L1_ST) + (long)bh * 128 * 8192 + pr;
    float s0 = 0.f, s1 = 0.f;
    for (int c = 0; c < 128; ++c) {
      int unit = bh * 128 + c;
      float2 bl = *(const float2*)(BL + (long)unit * 128 + c2);
      unsigned d = ptr[(long)c * 8192];
      ptr[(long)c * 8192] = pack2(s0, s1);
      s0 = __expf(bl.x) * s0 + lo2f(d);
      s1 = __expf(bl.y) * s1 + hi2f(d);
    }
  }
}

DEVI void hgrn_out(const Params& p, int unit, unsigned char* smem) {
  const int tid = threadIdx.x, lane = tid & 63, w = tid >> 6, wr = w >> 1, wc = w & 1;
  const int r = lane & 15, q = lane >> 4;
  const int bh = unit >> 7, c = unit & 127, b = bh >> 3, h = bh & 7, t0 = c * 64;
  const long R0 = (long)b * 8192 + t0;
  unsigned char* ws = p.ws;
  bf16_t* sQ0 = (bf16_t*)smem; bf16_t* sQ1 = (bf16_t*)(smem + 9216);
  bf16_t* sK0 = (bf16_t*)(smem + 18432); bf16_t* sK1 = (bf16_t*)(smem + 27648);
  bf16_t* sAm = (bf16_t*)(smem + 36864);
  bf16_t* sB = (bf16_t*)(smem + 46080);
  float* psum = (float*)(smem + 64512);
  float* sSs = psum + 256;
  const int cch = tid & 127, half = tid >> 7, cc = cch & 63;
  const float lb = ((const float*)(ws + OFF_LB))[h * 128 + cch];
  const bf16_t* FP = (const bf16_t*)(ws + L1_FP) + R0 * 1024 + h * 128 + cch;
  const bf16_t* Q1 = (const bf16_t*)(ws + L1_Q) + R0 * 1024 + h * 128 + cch;
  const bf16_t* vt = (const bf16_t*)(ws + L1_VT) + ((long)(b * 1024 + h * 128)) * 8192 + t0;
  load_tile128(sB, vt, 8192);
  float sum = 0.f;
  for (int s = half * 32; s < half * 32 + 32; ++s) {
    float fp = bf2f(FP[(long)s * 1024]);
    float f = lb + (1.f - lb) * sigm(fp);
    sum += __logf(f);
  }
  psum[half * 128 + cch] = sum;
  __syncthreads();
  float run = half ? psum[cch] : 0.f;
  bf16_t* sQ = (cch < 64) ? sQ0 : sQ1;
  bf16_t* sK = (cch < 64) ? sK0 : sK1;
  for (int s = half * 32; s < half * 32 + 32; ++s) {
    float fp = bf2f(FP[(long)s * 1024]);
    float sg = sigm(fp);
    float f = lb + (1.f - lb) * sg;
    run += __logf(f);
    float k = (1.f - lb) * (1.f - sg);
    float qv = bf2f(Q1[(long)s * 1024]);
    sQ[s * LDT + cc] = f2bf(qv * __expf(run));
    sK[s * LDT + cc] = f2bf(k * __expf(fminf(-run, 80.f)));
  }
  __syncthreads();
  {
    f32x4 a1[2][2];
#pragma unroll
    for (int mt = 0; mt < 2; ++mt)
#pragma unroll
      for (int nt = 0; nt < 2; ++nt) a1[mt][nt] = f32x4{0.f, 0.f, 0.f, 0.f};
    if (!(wr == 0 && wc == 1)) {
      mma_lds<2, 2, 2>(sQ0 + wr * 32 * LDT, sK0 + wc * 32 * LDT, a1, lane);
      mma_lds<2, 2, 2>(sQ1 + wr * 32 * LDT, sK1 + wc * 32 * LDT, a1, lane);
    }
#pragma unroll
    for (int mt = 0; mt < 2; ++mt)
#pragma unroll
      for (int i = 0; i < 4; ++i) {
        int j = wr * 32 + mt * 16 + q * 4 + i;
#pragma unroll
        for (int nt = 0; nt < 2; ++nt) {
          int s = wc * 32 + nt * 16 + r;
          sAm[j * LDT + s] = f2bf((s <= j) ? a1[mt][nt][i] : 0.f);
        }
      }
  }
  __syncthreads();
  f32x4 o[2][4];
#pragma unroll
  for (int mt = 0; mt < 2; ++mt)
#pragma unroll
    for (int nt = 0; nt < 4; ++nt) o[mt][nt] = f32x4{0.f, 0.f, 0.f, 0.f};
  mma_lds<2, 4, 2>(sAm + wr * 32 * LDT, sB + wc * 64 * LDT, o, lane);
  __syncthreads();
  const bf16_t* st = (const bf16_t*)(ws + L1_ST) + (long)unit * 16384;
  load_tile128(sB, st, 128);
  __syncthreads();
  mma_lds<2, 4, 2>(sQ0 + wr * 32 * LDT, sB + wc * 64 * LDT, o, lane);
  __syncthreads();
  load_tile128(sB, st + 64, 128);
  __syncthreads();
  mma_lds<2, 4, 2>(sQ1 + wr * 32 * LDT, sB + wc * 64 * LDT, o, lane);
#pragma unroll
  for (int mt = 0; mt < 2; ++mt)
#pragma unroll
    for (int i = 0; i < 4; ++i) {
      int j = wr * 32 + mt * 16 + q * 4 + i;
      float ss = 0.f;
#pragma unroll
      for (int nt = 0; nt < 4; ++nt) ss += o[mt][nt][i] * o[mt][nt][i];
      ss = grp16_sum(ss);
      if (r == 0) sSs[wc * 64 + j] = ss;
    }
  __syncthreads();
  const bf16_t* Z1 = (const bf16_t*)(ws + L1_Z);
  bf16_t* Y1 = (bf16_t*)(ws + L1_H);
#pragma unroll
  for (int mt = 0; mt < 2; ++mt)
#pragma unroll
    for (int i = 0; i < 4; ++i) {
      int j = wr * 32 + mt * 16 + q * 4 + i;
      float rinv = rsqrtf((sSs[j] + sSs[64 + j]) * (1.f / 128.f) + EPSF);
      long row = R0 + j;
#pragma unroll
      for (int nt = 0; nt < 4; ++nt) {
        int col = h * 128 + wc * 64 + nt * 16 + r;
        Y1[row * 1024 + col] = f2bf(o[mt][nt][i] * rinv * p.h_hn[col] * bf2f(Z1[row * 1024 + col]));
      }
    }
  __syncthreads();
}

DEVI void grid_barrier(unsigned* ctr, unsigned& epoch) {
  asm volatile("s_waitcnt vmcnt(0) lgkmcnt(0)" ::: "memory");
  __syncthreads();
  if (threadIdx.x == 0) {
    epoch += 1;
    const unsigned target = epoch * gridDim.x;
    __builtin_amdgcn_fence(__ATOMIC_RELEASE, "agent");
    asm volatile("s_waitcnt vmcnt(0)" ::: "memory");
    __hip_atomic_fetch_add(ctr, 1u, __ATOMIC_RELAXED, __HIP_MEMORY_SCOPE_AGENT);
    while (__hip_atomic_load(ctr, __ATOMIC_RELAXED, __HIP_MEMORY_SCOPE_AGENT) < target) __builtin_amdgcn_s_sleep(2);
    __builtin_amdgcn_fence(__ATOMIC_ACQUIRE, "agent");
    asm volatile("s_waitcnt vmcnt(0)" ::: "memory");
  }
  __syncthreads();
}

#ifndef DBG_STOP
#define DBG_STOP 99
#endif
DEVI void dbg_probe_bf16(const Params& p, size_t off, long n) {
  const bf16_t* b = (const bf16_t*)(p.ws + off);
  for (long i = (long)blockIdx.x * 256 + threadIdx.x; i < 16384L * 1024; i += (long)gridDim.x * 256) {
    float v = bf2f(b[i % n]);
    if (!(v == v) || fabsf(v) > 1e30f) v = 777.f;
    p.out[i] = v;
  }
}
DEVI void dbg_probe_f32(const Params& p, size_t off, long n) {
  const float* b = (const float*)(p.ws + off);
  for (long i = (long)blockIdx.x * 256 + threadIdx.x; i < 16384L * 1024; i += (long)gridDim.x * 256) {
    float v = b[i % n];
    if (!(v == v) || fabsf(v) > 1e30f) v = 777.f;
    p.out[i] = v;
  }
}
DEVI void dbg_probe_combo(const Params& p) {
  const bf16_t* qn = (const bf16_t*)(p.ws + L0_QN);
  const bf16_t* ks = (const bf16_t*)(p.ws + L0_KS);
  const bf16_t* nz = (const bf16_t*)(p.ws + L0_NZ);
  const float* ig = (const float*)(p.ws + L0_IG);
  for (long i = (long)blockIdx.x * 256 + threadIdx.x; i < 16384L * 1024; i += (long)gridDim.x * 256) {
    float v = bf2f(qn[i % (16384L * 512)]) + bf2f(ks[i % (4L * 8192 * 64 * 4)]) + bf2f(nz[i % (16384L * 512)]) + ig[i % (16384L * 32)];
    if (!(v == v) || fabsf(v) > 1e30f) v = 777.f;
    p.out[i] = v;
  }
}
#define DBG_AT(k, stmt) if (DBG_STOP == k) { stmt; return; }

#define GSYNC() grid_barrier(bar_ctr, bar_epoch)

__global__ void __launch_bounds__(256, 1) mega(Params p) {
  __shared__ __attribute__((aligned(16))) unsigned char smem[81920];
  cg::grid_group grid = cg::this_grid();
  const int G = gridDim.x, bid = blockIdx.x, tid = threadIdx.x, lane = tid & 63, w = tid >> 6;
  unsigned char* ws = p.ws;
  bf16_t* sA = (bf16_t*)smem;
  bf16_t* sB = (bf16_t*)(smem + 18432);
  unsigned* bar_ctr = (unsigned*)(ws + OFF_BAR);
  unsigned bar_epoch = 0;
  grid.sync();

  phase0(p, smem);
  GSYNC();
  DBG_AT(0, dbg_probe_bf16(p, L0_H, 16384L*1024))
  for (int it = bid; it < 128 * 35; it += G) {
    int tn = it % 35, tm = it / 35;
    gemm128((const bf16_t*)(ws + L0_H), 1024, 16383, (const bf16_t*)(ws + OFF_WIN0), 1024, 4383, 1024, tm * 128, tn * 128, sA, sB,
            [&](f32x4 (&acc)[4][4], int mb, int nb, int ln) { epi_proj0(p, acc, mb, nb, ln); });
  }
  GSYNC();
  DBG_AT(1, dbg_probe_bf16(p, L0_QKRAW, 16384L*1024)) DBG_AT(101, dbg_probe_combo(p)) DBG_AT(102, dbg_probe_bf16(p, L0_KS, 4L*8192*64*4)) DBG_AT(103, dbg_probe_f32(p, L0_IG, 16384L*4*2+16384L*24)) DBG_AT(104, dbg_probe_bf16(p, L0_MVT, 16384L*512*3))
  for (int it = bid; it < 32 + 2048; it += G) {
    if (it < 32) {
      int kv = it >> 4, bg = (it >> 2) & 3, tm = it & 3;
      const bf16_t* A = (const bf16_t*)(ws + (kv ? L0_VCRAW : L0_KCRAW)) + (long)bg * 8192 * 64;
      const bf16_t* B = (const bf16_t*)(ws + (kv ? OFF_WCV : OFF_WCK));
      gemm128(A, 1024, 510, B, 2048, 127, 2048, tm * 128, 0, sA, sB,
              [&](f32x4 (&acc)[4][4], int mb, int nb, int ln) { epi_cmp_hidden(p, acc, mb, nb, ln, kv, bg); });
    } else {
      conv_tile(p, it - 32, smem);
    }
  }
  GSYNC();
  DBG_AT(2, dbg_probe_bf16(p, L0_QC, 16384L*512*3)) DBG_AT(201, dbg_probe_f32(p, L0_HID, 2L*4*512*128))
  for (int it = bid; it < 512 + 1024; it += G) {
    if (it < 512) mlstm_local(p, it, smem);
    else cmp_finalize(p, (it - 512) * 4 + w, lane);
  }
  GSYNC();
  DBG_AT(3, dbg_probe_f32(p, L0_H, 512L*16384)) DBG_AT(301, dbg_probe_bf16(p, L0_KCMP, 4L*512*64*2)) DBG_AT(302, dbg_probe_f32(p, L0_DN, 512L*128 + 2048))
  mlstm_scan(p);
  GSYNC();
  DBG_AT(4, dbg_probe_f32(p, L0_H, 512L*16384)) DBG_AT(401, dbg_probe_f32(p, L0_DN, 512L*128 + 3072))
  for (int it = bid; it < 2048 + 512; it += G) {
    if (it < 2048) {
      int k = it >> 9, i = it & 511;
      int idx = (k & 1) ? (k * 512 + 511 - i) : it;
#ifndef DBG_SKIP_NSA
      nsa_tile(p, idx, smem);
#endif
    } else {
#ifndef DBG_SKIP_MOUT
      mlstm_out(p, it - 2048, smem);
#endif
    }
  }
  GSYNC();
  DBG_AT(5, dbg_probe_bf16(p, L0_QKRAW, 16384L*1024))
  for (int it = bid; it < 128 * 8; it += G) {
    int tn = it & 7, tm = it >> 3;
    gemm128((const bf16_t*)(ws + L0_QKRAW), 1024, 16383, (const bf16_t*)(ws + OFF_WOUT0), 1024, 1023, 1024, tm * 128, tn * 128, sA, sB,
            [&](f32x4 (&acc)[4][4], int mb, int nb, int ln) { epi_out_resid(p.x, p.out, acc, mb, nb, ln); });
  }
  GSYNC();
  DBG_AT(6, (void)0)
  for (int row = bid * 4 + w; row < 16384; row += G * 4) rmsnorm_row(p.out, p.norm_w + 1024, (bf16_t*)(ws + L1_H), row, lane);
  GSYNC();
  DBG_AT(7, dbg_probe_bf16(p, L1_H, 16384L*1024))
  for (int it = bid; it < 128 * 32; it += G) {
    int tn = it & 31, tm = it >> 5;
    gemm128((const bf16_t*)(ws + L1_H), 1024, 16383, (const bf16_t*)(ws + OFF_WIN1), 1024, 4095, 1024, tm * 128, tn * 128, sA, sB,
            [&](f32x4 (&acc)[4][4], int mb, int nb, int ln) { epi_proj1(p, acc, mb, nb, ln); });
  }
  GSYNC();
  DBG_AT(8, dbg_probe_bf16(p, L1_FP, 16384L*1024*4))
  for (int it = bid; it < 2048; it += G) hgrn_local(p, it, smem);
  GSYNC();
  DBG_AT(9, dbg_probe_bf16(p, L1_ST, 2048L*16384))
  hgrn_scan(p);
  GSYNC();
  DBG_AT(10, dbg_probe_bf16(p, L1_ST, 2048L*16384))
  for (int it = bid; it < 2048; it += G) hgrn_out(p, it, smem);
  GSYNC();
  DBG_AT(11, dbg_probe_bf16(p, L1_H, 16384L*1024))
  for (int it = bid; it < 128 * 8; it += G) {
    int tn = it & 7, tm = it >> 3;
    gemm128((const bf16_t*)(ws + L1_H), 1024, 16383, (const bf16_t*)(ws + OFF_WOUT1), 1024, 1023, 1024, tm * 128, tn * 128, sA, sB,
            [&](f32x4 (&acc)[4][4], int mb, int nb, int ln) { epi_out_resid(p.out, p.out, acc, mb, nb, ln); });
  }
}

extern "C" void kernel_launch(void* const* d_in, const int* in_sizes, int n_in, void* d_out, int out_size, void* d_ws, size_t ws_size,
                              hipStream_t stream) {
  static int grid_blocks = 0;
  if (!grid_blocks) {
    int dev = 0, cus = 0, per_cu = 0;
    (void)hipGetDevice(&dev);
    (void)hipDeviceGetAttribute(&cus, hipDeviceAttributeMultiprocessorCount, dev);
    (void)hipOccupancyMaxActiveBlocksPerMultiprocessor(&per_cu, mega, 256, 0);
    if (per_cu > 2) per_cu = 2;
    if (per_cu < 1) per_cu = 1;
    grid_blocks = cus * per_cu;
  }
  Params p{};
  const float** pf = (const float**)&p;
  for (int i = 0; i < 22; ++i) pf[i] = (const float*)d_in[i];
  p.out = (float*)d_out;
  p.ws = (unsigned char*)d_ws;
  (void)hipMemsetAsync((unsigned char*)d_ws + OFF_BAR, 0, 256, stream);
  void* args[] = {&p};
  hipError_t e = hipLaunchCooperativeKernel((void*)mega, dim3(grid_blocks), dim3(256), args, 0, stream);
  if (e != hipSuccess) fprintf(stderr, "cooperative launch failed: %s (grid %d)\n", hipGetErrorString(e), grid_blocks);
}
```

```cpp
#include <hip/hip_runtime.h>
#include <hip/hip_cooperative_groups.h>
#include <stdint.h>
#include <cstdio>
namespace cg = cooperative_groups;

typedef unsigned short bf16_t;
typedef __attribute__((ext_vector_type(8))) short bf16x8;
typedef __attribute__((ext_vector_type(4))) float f32x4;
typedef __attribute__((ext_vector_type(4))) unsigned int u32x4;

#define DEVI __device__ __forceinline__
#define EPSF 1e-6f
#define LDT 72
#define SLD 68
#define NEGS (-1e30f)
#define LAUNDER(ptr) asm volatile("" : "+s"(ptr))

struct Params {
  const float* x; const float* norm_w; const float* ev_w_in; const float* ev_b_in; const float* f_bias;
  const float* conv_w; const float* conv_b; const float* m_hn; const float* q_norm; const float* k_norm;
  const float* ck_pos; const float* ck_w1; const float* ck_w2; const float* cv_pos; const float* cv_w1; const float* cv_w2;
  const float* ev_w_out; const float* od_w_in; const float* od_b_in; const float* lb_logits; const float* h_hn; const float* od_w_out;
  float* out; unsigned char* ws;
};

constexpr size_t MiB = 1048576;
constexpr size_t OFF_WIN0 = 0;
constexpr size_t OFF_WOUT0 = OFF_WIN0 + 4480ull * 1024 * 2;
constexpr size_t OFF_WIN1 = OFF_WOUT0 + 2 * MiB;
constexpr size_t OFF_WOUT1 = OFF_WIN1 + 8 * MiB;
constexpr size_t OFF_WCK = OFF_WOUT1 + 2 * MiB;
constexpr size_t OFF_WCV = OFF_WCK + 512 * 1024;
constexpr size_t OFF_ROPE = OFF_WCV + 512 * 1024;
constexpr size_t OFF_PB = OFF_ROPE + 512 * 1024;
constexpr size_t OFF_LB = OFF_PB + 1024;
constexpr size_t OFF_BAR = OFF_LB + 4096;
constexpr size_t OFF_BASE = 24 * MiB;
constexpr size_t L0_H = OFF_BASE;
constexpr size_t L0_QKRAW = L0_H + 32 * MiB;
constexpr size_t L0_QC = L0_QKRAW + 32 * MiB;
constexpr size_t L0_KC = L0_QC + 16 * MiB;
constexpr size_t L0_KCT = L0_KC + 16 * MiB;
constexpr size_t L0_MVT = L0_KCT + 16 * MiB;
constexpr size_t L0_MO = L0_MVT + 16 * MiB;
constexpr size_t L0_MZ = L0_MO + 16 * MiB;
constexpr size_t L0_QN = L0_MZ + 16 * MiB;
constexpr size_t L0_NZ = L0_QN + 16 * MiB;
constexpr size_t L0_KCRAW = L0_NZ + 16 * MiB;
constexpr size_t L0_VCRAW = L0_KCRAW + 4 * MiB;
constexpr size_t L0_KS = L0_VCRAW + 4 * MiB;
constexpr size_t L0_KW = L0_KS + 4 * MiB;
constexpr size_t L0_VST = L0_KW + 4 * MiB;
constexpr size_t L0_VWT = L0_VST + 4 * MiB;
constexpr size_t L0_HID = L0_VWT + 4 * MiB;
constexpr size_t L0_KCMP = L0_HID + 2 * MiB;
constexpr size_t L0_VCMPT = L0_KCMP + 256 * 1024;
constexpr size_t L0_IG = L0_VCMPT + 256 * 1024;
constexpr size_t L0_LOGF = L0_IG + 256 * 1024;
constexpr size_t L0_GATES = L0_LOGF + 256 * 1024;
constexpr size_t L0_DN = L0_GATES + 1536 * 1024;
constexpr size_t L0_BL = L0_DN + 256 * 1024;
constexpr size_t L0_MLOC = L0_BL + 4096;
constexpr size_t L0_MIN = L0_MLOC + 4096;
constexpr size_t L0_END = L0_MIN + 4096;
static_assert(L0_END <= 256 * MiB, "ws overflow L0");
constexpr size_t L1_H = OFF_BASE;
constexpr size_t L1_FP = L1_H + 32 * MiB;
constexpr size_t L1_Q = L1_FP + 32 * MiB;
constexpr size_t L1_VT = L1_Q + 32 * MiB;
constexpr size_t L1_Z = L1_VT + 32 * MiB;
constexpr size_t L1_ST = L1_Z + 32 * MiB;
constexpr size_t L1_BL = L1_ST + 64 * MiB;
constexpr size_t L1_END = L1_BL + 1 * MiB;
static_assert(L1_END <= 256 * MiB, "ws overflow L1");

DEVI bf16_t f2bf(float f) { unsigned u = __float_as_uint(f); u += 0x7fffu + ((u >> 16) & 1u); return (bf16_t)(u >> 16); }
DEVI float bf2f(bf16_t b) { return __uint_as_float(((unsigned)b) << 16); }
DEVI unsigned pack2(float a, float b) { return (unsigned)f2bf(a) | ((unsigned)f2bf(b) << 16); }
DEVI float lo2f(unsigned u) { return __uint_as_float(u << 16); }
DEVI float hi2f(unsigned u) { return __uint_as_float(u & 0xffff0000u); }
DEVI float sigm(float x) { return 1.f / (1.f + __expf(-x)); }
DEVI float siluf(float x) { return x * sigm(x); }
DEVI float wave_sum(float v) { for (int o = 32; o > 0; o >>= 1) v += __shfl_xor(v, o); return v; }
DEVI float grp16_sum(float v) { v += __shfl_xor(v, 1); v += __shfl_xor(v, 2); v += __shfl_xor(v, 4); v += __shfl_xor(v, 8); return v; }
DEVI int oldcol(int n) {
  return n < 2560 ? n : (n < 3840 ? n + 8 : (n < 4352 ? n + 32 : (n < 4360 ? n - 4352 + 2560 : n - 4360 + 3848)));
}

template <int MT, int NTL, int KS>
DEVI void mma_lds(const bf16_t* sA, const bf16_t* sB, f32x4 (&acc)[MT][NTL], int lane) {
  const int r = lane & 15, q = lane >> 4;
#pragma unroll
  for (int ks = 0; ks < KS; ++ks) {
    bf16x8 a[MT], b[NTL];
#pragma unroll
    for (int mt = 0; mt < MT; ++mt) a[mt] = *(const bf16x8*)(sA + (mt * 16 + r) * LDT + ks * 32 + q * 8);
#pragma unroll
    for (int nt = 0; nt < NTL; ++nt) b[nt] = *(const bf16x8*)(sB + (nt * 16 + r) * LDT + ks * 32 + q * 8);
#pragma unroll
    for (int mt = 0; mt < MT; ++mt)
#pragma unroll
      for (int nt = 0; nt < NTL; ++nt) acc[mt][nt] = __builtin_amdgcn_mfma_f32_16x16x32_bf16(a[mt], b[nt], acc[mt][nt], 0, 0, 0);
  }
}

DEVI void load_tile128(bf16_t* s, const bf16_t* g, long ld) {
  const int tid = threadIdx.x, lr = tid >> 3, lk = (tid & 7) * 8;
#pragma unroll
  for (int j = 0; j < 4; ++j) *(uint4*)(s + (lr + 32 * j) * LDT + lk) = *(const uint4*)(g + (long)(lr + 32 * j) * ld + lk);
}
DEVI void load_tile64(bf16_t* s, const bf16_t* g, long ld) {
  const int tid = threadIdx.x, lr = tid >> 3, lk = (tid & 7) * 8;
#pragma unroll
  for (int j = 0; j < 2; ++j) *(uint4*)(s + (lr + 32 * j) * LDT + lk) = *(const uint4*)(g + (long)(lr + 32 * j) * ld + lk);
}

template <class Epi>
DEVI void gemm128(const bf16_t* A, long lda, int amax, const bf16_t* B, long ldb, int bmax, int K, int m0, int n0,
                  bf16_t* sA, bf16_t* sB, Epi&& epi) {
  const int tid = threadIdx.x, lane = tid & 63, w = tid >> 6, wr = w >> 1, wc = w & 1;
  const int lr = tid >> 3, lk = (tid & 7) * 8;
  f32x4 acc[4][4];
#pragma unroll
  for (int mt = 0; mt < 4; ++mt)
#pragma unroll
    for (int nt = 0; nt < 4; ++nt) acc[mt][nt] = f32x4{0.f, 0.f, 0.f, 0.f};
  const bf16_t* ap[4];
  const bf16_t* bp[4];
#pragma unroll
  for (int j = 0; j < 4; ++j) {
    int ra = min(m0 + lr + 32 * j, amax);
    ap[j] = A + (long)ra * lda + lk;
    int rb = min(n0 + lr + 32 * j, bmax);
    bp[j] = B + (long)rb * ldb + lk;
  }
  u32x4 va0, va1, va2, va3, vb0, vb1, vb2, vb3;
  va0 = *(const u32x4*)(ap[0]); va1 = *(const u32x4*)(ap[1]); va2 = *(const u32x4*)(ap[2]); va3 = *(const u32x4*)(ap[3]);
  vb0 = *(const u32x4*)(bp[0]); vb1 = *(const u32x4*)(bp[1]); vb2 = *(const u32x4*)(bp[2]); vb3 = *(const u32x4*)(bp[3]);
  const int KT = K >> 6;
  for (int kt = 0; kt < KT; ++kt) {
    *(u32x4*)(sA + (lr + 0) * LDT + lk) = va0; *(u32x4*)(sA + (lr + 32) * LDT + lk) = va1;
    *(u32x4*)(sA + (lr + 64) * LDT + lk) = va2; *(u32x4*)(sA + (lr + 96) * LDT + lk) = va3;
    *(u32x4*)(sB + (lr + 0) * LDT + lk) = vb0; *(u32x4*)(sB + (lr + 32) * LDT + lk) = vb1;
    *(u32x4*)(sB + (lr + 64) * LDT + lk) = vb2; *(u32x4*)(sB + (lr + 96) * LDT + lk) = vb3;
    __syncthreads();
    if (kt + 1 < KT) {
      const int ko = (kt + 1) * 64;
      va0 = *(const u32x4*)(ap[0] + ko); va1 = *(const u32x4*)(ap[1] + ko); va2 = *(const u32x4*)(ap[2] + ko); va3 = *(const u32x4*)(ap[3] + ko);
      vb0 = *(const u32x4*)(bp[0] + ko); vb1 = *(const u32x4*)(bp[1] + ko); vb2 = *(const u32x4*)(bp[2] + ko); vb3 = *(const u32x4*)(bp[3] + ko);
    }
    mma_lds<4, 4, 2>(sA + wr * 64 * LDT, sB + wc * 64 * LDT, acc, lane);
    __syncthreads();
  }
  epi(acc, m0 + wr * 64, n0 + wc * 64, lane);
}

DEVI void transpose_tile(const float* src, int N, int ldsrc, bf16_t* dst, int K, int ktile, int ntile, bool perm, float* sT) {
  const int tid = threadIdx.x;
  const int k0 = ktile * 64, n0 = ntile * 64;
#pragma unroll
  for (int j = 0; j < 4; ++j) {
    int idx = tid + 256 * j;
    int kk = idx >> 4, n4 = (idx & 15) * 4;
    int n = n0 + n4;
    float4 v = make_float4(0.f, 0.f, 0.f, 0.f);
    if (n < N) { int oc = perm ? oldcol(n) : n; v = *(const float4*)(src + (long)(k0 + kk) * ldsrc + oc); }
    sT[kk * 65 + n4 + 0] = v.x; sT[kk * 65 + n4 + 1] = v.y; sT[kk * 65 + n4 + 2] = v.z; sT[kk * 65 + n4 + 3] = v.w;
  }
  __syncthreads();
#pragma unroll
  for (int j = 0; j < 2; ++j) {
    int idx = tid + 256 * j;
    int nn = idx >> 3, kc = (idx & 7) * 8;
    if (n0 + nn < N) {
      uint4 o;
      o.x = pack2(sT[(kc + 0) * 65 + nn], sT[(kc + 1) * 65 + nn]);
      o.y = pack2(sT[(kc + 2) * 65 + nn], sT[(kc + 3) * 65 + nn]);
      o.z = pack2(sT[(kc + 4) * 65 + nn], sT[(kc + 5) * 65 + nn]);
      o.w = pack2(sT[(kc + 6) * 65 + nn], sT[(kc + 7) * 65 + nn]);
      *(uint4*)(dst + (long)(n0 + nn) * K + k0 + kc) = o;
    }
  }
  __syncthreads();
}

DEVI void rmsnorm_row(const float* X, const float* w, bf16_t* H, int row, int lane) {
  const float4* xr = (const float4*)(X + (long)row * 1024);
  float4 v[4];
  float ss = 0.f;
#pragma unroll
  for (int j = 0; j < 4; ++j) { v[j] = xr[lane + 64 * j]; ss += v[j].x * v[j].x + v[j].y * v[j].y + v[j].z * v[j].z + v[j].w * v[j].w; }
  ss = wave_sum(ss);
  float rinv = rsqrtf(ss * (1.f / 1024.f) + EPSF);
#pragma unroll
  for (int j = 0; j < 4; ++j) {
    float4 ww = ((const float4*)w)[lane + 64 * j];
    uint2 o;
    o.x = pack2(v[j].x * rinv * ww.x, v[j].y * rinv * ww.y);
    o.y = pack2(v[j].z * rinv * ww.z, v[j].w * rinv * ww.w);
    *(uint2*)(H + (long)row * 1024 + (lane + 64 * j) * 4) = o;
  }
}

DEVI void phase0(const Params& p, unsigned char* smem) {
  const int G = gridDim.x, bid = blockIdx.x, tid = threadIdx.x, lane = tid & 63, w = tid >> 6;
  unsigned char* ws = p.ws;
  float* sT = (float*)smem;
  for (int it = bid; it < 69 * 16; it += G) transpose_tile(p.ev_w_in, 4384, 4384, (bf16_t*)(ws + OFF_WIN0), 1024, it / 69, it % 69, true, sT);
  for (int it = bid; it < 16 * 16; it += G) transpose_tile(p.ev_w_out, 1024, 1024, (bf16_t*)(ws + OFF_WOUT0), 1024, it / 16, it % 16, false, sT);
  for (int it = bid; it < 64 * 16; it += G) transpose_tile(p.od_w_in, 4096, 4096, (bf16_t*)(ws + OFF_WIN1), 1024, it / 64, it % 64, false, sT);
  for (int it = bid; it < 16 * 16; it += G) transpose_tile(p.od_w_out, 1024, 1024, (bf16_t*)(ws + OFF_WOUT1), 1024, it / 16, it % 16, false, sT);
  for (int it = bid; it < 2 * 32; it += G) transpose_tile(p.ck_w1, 128, 128, (bf16_t*)(ws + OFF_WCK), 2048, it / 2, it % 2, false, sT);
  for (int it = bid; it < 2 * 32; it += G) transpose_tile(p.cv_w1, 128, 128, (bf16_t*)(ws + OFF_WCV), 2048, it / 2, it % 2, false, sT);
  for (int row = bid * 4 + w; row < 16384; row += G * 4) rmsnorm_row(p.x, p.norm_w, (bf16_t*)(ws + L0_H), row, lane);
  for (int idx = bid * 256 + tid; idx < 8192 * 8; idx += G * 256) {
    int t = idx >> 3, i = idx & 7;
    float invf = powf(500000.0f, -(float)i / 8.0f);
    float ang = (float)t * invf;
    double a = (double)ang;
    float2 cs;
    cs.x = (float)cos(a);
    cs.y = (float)sin(a);
    ((float2*)(ws + OFF_ROPE))[idx] = cs;
  }
  if (bid == G - 1) {
    int kv = tid >> 7, j = tid & 127;
    const float* pos = kv ? p.cv_pos : p.ck_pos;
    const float* w1 = kv ? p.cv_w1 : p.ck_w1;
    float s = 0.f;
    for (int i = 0; i < 2048; ++i) s += pos[i] * w1[i * 128 + j];
    ((float*)(ws + OFF_PB))[tid] = s;
  }
  if (bid == G - 2 || G < 2) {
    for (int c = tid; c < 1024; c += 256) {
      float l0 = p.lb_logits[c], l1 = p.lb_logits[1024 + c];
      ((float*)(ws + OFF_LB))[c] = 1.f / (1.f + expf(l1 - l0));
    }
  }
}

template <int MODE>
DEVI void store_rm(bf16_t* dst, int ld, int colbase, f32x4 (&acc)[4][4], const float* bias, int mb, int lane) {
  const int r = lane & 15, q = lane >> 4;
#pragma unroll
  for (int mt = 0; mt < 4; ++mt)
#pragma unroll
    for (int i = 0; i < 4; ++i) {
      long row = mb + mt * 16 + q * 4 + i;
#pragma unroll
      for (int nt = 0; nt < 4; ++nt) {
        float v = acc[mt][nt][i] + bias[nt];
        if (MODE == 1) v = sigm(v);
        if (MODE == 2) v = siluf(v);
        dst[row * ld + colbase + nt * 16 + r] = f2bf(v);
      }
    }
}
template <int MODE>
DEVI void store_T(bf16_t* dst, long featbase, f32x4 (&acc)[4][4], const float* bias, int tl0, int lane) {
  const int r = lane & 15, q = lane >> 4;
#pragma unroll
  for (int mt = 0; mt < 4; ++mt)
#pragma unroll
    for (int nt = 0; nt < 4; ++nt) {
      int t = tl0 + mt * 16 + q * 4;
      float b = bias[nt];
      uint2 o;
      o.x = pack2(acc[mt][nt][0] + b, acc[mt][nt][1] + b);
      o.y = pack2(acc[mt][nt][2] + b, acc[mt][nt][3] + b);
      *(uint2*)(dst + (featbase + nt * 16 + r) * 8192 + t) = o;
    }
}
DEVI void norm_rope_store(bf16_t* dst, long rowbase, int ld, int colbase, f32x4 (&acc)[4][4], const float* bias, const float* nw,
                          float scale, const float2* rope, int mb, int lane) {
  const int r = lane & 15, q = lane >> 4;
  float wv[4];
#pragma unroll
  for (int nt = 0; nt < 4; ++nt) wv[nt] = nw[nt * 16 + r];
#pragma unroll
  for (int mt = 0; mt < 4; ++mt)
#pragma unroll
    for (int i = 0; i < 4; ++i) {
      int row = mb + mt * 16 + q * 4 + i;
      int t = row & 8191;
      float v[4];
      float ss = 0.f;
#pragma unroll
      for (int nt = 0; nt < 4; ++nt) { v[nt] = acc[mt][nt][i] + bias[nt]; ss += v[nt] * v[nt]; }
      ss = grp16_sum(ss);
      float rinv = rsqrtf(ss * (1.f / 64.f) + EPSF);
#pragma unroll
      for (int nt = 0; nt < 4; ++nt) v[nt] = v[nt] * rinv * wv[nt];
      float partner = __shfl_xor(v[0], 8);
      float2 cs = rope[t * 8 + (r & 7)];
      float x1 = (r < 8) ? v[0] : partner, x2 = (r < 8) ? partner : v[0];
      v[0] = (r < 8) ? (x1 * cs.x - x2 * cs.y) : (x1 * cs.y + x2 * cs.x);
#pragma unroll
      for (int nt = 0; nt < 4; ++nt) dst[(rowbase + t) * ld + colbase + nt * 16 + r] = f2bf(v[nt] * scale);
    }
}

DEVI void epi_proj0(const Params& p, f32x4 (&acc)[4][4], int mb, int nb, int lane) {
  if (nb >= 4384) return;
  unsigned char* ws = p.ws;
  const int r = lane & 15, q = lane >> 4;
  float bias[4];
#pragma unroll
  for (int nt = 0; nt < 4; ++nt) { int n = nb + nt * 16 + r; bias[nt] = (n < 4384) ? p.ev_b_in[oldcol(n)] : 0.f; }
  const int b = mb >> 13;
  const int tl0 = mb & 8191;
  const float2* rope = (const float2*)(ws + OFF_ROPE);
  if (nb < 1024) {
    store_rm<0>((bf16_t*)(ws + L0_QKRAW), 1024, nb, acc, bias, mb, lane);
  } else if (nb < 1536) {
    store_T<0>((bf16_t*)(ws + L0_MVT), (long)b * 512 + (nb - 1024), acc, bias, tl0, lane);
  } else if (nb < 2048) {
    store_rm<1>((bf16_t*)(ws + L0_MO), 512, nb - 1536, acc, bias, mb, lane);
  } else if (nb < 2560) {
    store_rm<2>((bf16_t*)(ws + L0_MZ), 512, nb - 2048, acc, bias, mb, lane);
  } else if (nb < 3072) {
    int head = (nb - 2560) >> 6, g = head >> 2, rr = head & 3;
    norm_rope_store((bf16_t*)(ws + L0_QN), (long)(b * 2 + g) * 8192, 256, rr * 64, acc, bias, p.q_norm, 0.125f, rope, mb, lane);
  } else if (nb < 3328) {
    int g = ((nb - 3072) >> 6) & 1;
    bf16_t* dst = (bf16_t*)(ws + (nb < 3200 ? L0_KCRAW : L0_VCRAW));
    const long rowbase = (long)(b * 2 + g) * 8192;
#pragma unroll
    for (int mt = 0; mt < 4; ++mt)
#pragma unroll
      for (int i = 0; i < 4; ++i) {
        int t = (mb + mt * 16 + q * 4 + i) & 8191;
#pragma unroll
        for (int nt = 0; nt < 4; ++nt) dst[(rowbase + t) * 64 + nt * 16 + r] = f2bf(acc[mt][nt][i] + bias[nt]);
      }
  } else if (nb < 3456) {
    int g = (nb - 3328) >> 6;
    norm_rope_store((bf16_t*)(ws + L0_KS), (long)(b * 2 + g) * 8192, 64, 0, acc, bias, p.k_norm + 64, 1.f, rope, mb, lane);
  } else if (nb < 3584) {
    store_T<0>((bf16_t*)(ws + L0_VST), (long)b * 128 + (nb - 3456), acc, bias, tl0, lane);
  } else if (nb < 3712) {
    int g = (nb - 3584) >> 6;
    norm_rope_store((bf16_t*)(ws + L0_KW), (long)(b * 2 + g) * 8192, 64, 0, acc, bias, p.k_norm + 128, 1.f, rope, mb, lane);
  } else if (nb < 3840) {
    store_T<0>((bf16_t*)(ws + L0_VWT), (long)b * 128 + (nb - 3712), acc, bias, tl0, lane);
  } else if (nb < 4352) {
    store_rm<2>((bf16_t*)(ws + L0_NZ), 512, nb - 3840, acc, bias, mb, lane);
  } else {
    float* IG = (float*)(ws + L0_IG);
    float* LF = (float*)(ws + L0_LOGF);
    float* GT = (float*)(ws + L0_GATES);
#pragma unroll
    for (int mt = 0; mt < 4; ++mt)
#pragma unroll
      for (int i = 0; i < 4; ++i) {
        long row = mb + mt * 16 + q * 4 + i;
#pragma unroll
        for (int nt = 0; nt < 2; ++nt) {
          int c = nt * 16 + r;
          float v = acc[mt][nt][i] + bias[nt];
          if (c < 4) IG[row * 4 + c] = v;
          else if (c < 8) { float xx = v + p.f_bias[c - 4]; LF[row * 4 + c - 4] = fminf(xx, 0.f) - log1pf(__expf(-fabsf(xx))); }
          else GT[row * 24 + c - 8] = sigm(v);
        }
      }
  }
}

DEVI void epi_cmp_hidden(const Params& p, f32x4 (&acc)[4][4], int mb, int nb, int lane, int kv, int bg) {
  const int r = lane & 15, q = lane >> 4;
  const float* pb = (const float*)(p.ws + OFF_PB) + kv * 128;
  float* hid = (float*)(p.ws + L0_HID) + ((long)(kv * 4 + bg) * 512) * 128;
#pragma unroll
  for (int mt = 0; mt < 4; ++mt)
#pragma unroll
    for (int i = 0; i < 4; ++i) {
      int row = mb + mt * 16 + q * 4 + i;
#pragma unroll
      for (int nt = 0; nt < 4; ++nt) {
        int c = nb + nt * 16 + r;
        float xx = acc[mt][nt][i] + pb[c];
        float g = 0.5f * xx * (1.f + tanhf(0.7978845608028654f * (xx + 0.044715f * xx * xx * xx)));
        hid[(long)row * 128 + c] = g;
      }
    }
}

DEVI void epi_out_resid(const float* resid, float* out, f32x4 (&acc)[4][4], int mb, int nb, int lane) {
  const int r = lane & 15, q = lane >> 4;
#pragma unroll
  for (int mt = 0; mt < 4; ++mt)
#pragma unroll
    for (int i = 0; i < 4; ++i) {
      long row = mb + mt * 16 + q * 4 + i;
#pragma unroll
      for (int nt = 0; nt < 4; ++nt) {
        long idx = row * 1024 + nb + nt * 16 + r;
        out[idx] = resid[idx] + acc[mt][nt][i];
      }
    }
}

DEVI void epi_proj1(const Params& p, f32x4 (&acc)[4][4], int mb, int nb, int lane) {
  unsigned char* ws = p.ws;
  const int r = lane & 15;
  float bias[4];
#pragma unroll
  for (int nt = 0; nt < 4; ++nt) bias[nt] = p.od_b_in[nb + nt * 16 + r];
  const int b = mb >> 13, tl0 = mb & 8191;
  if (nb < 1024) store_rm<0>((bf16_t*)(ws + L1_FP), 1024, nb, acc, bias, mb, lane);
  else if (nb < 2048) store_T<0>((bf16_t*)(ws + L1_VT), (long)b * 1024 + (nb - 1024), acc, bias, tl0, lane);
  else if (nb < 3072) store_rm<2>((bf16_t*)(ws + L1_Q), 1024, nb - 2048, acc, bias, mb, lane);
  else store_rm<2>((bf16_t*)(ws + L1_Z), 1024, nb - 3072, acc, bias, mb, lane);
}

DEVI void conv_tile(const Params& p, int item, unsigned char* smem) {
  const int tid = threadIdx.x;
  const int ctile = item & 7, ttile = item >> 3;
  const int t0g = ttile * 64;
  const int b = t0g >> 13, tl0 = t0g & 8191;
  unsigned char* ws = p.ws;
  float* sRaw = (float*)smem;
  bf16_t* sOutT = (bf16_t*)(smem + 67 * 128 * 4);
  const bf16_t* raw = (const bf16_t*)(ws + L0_QKRAW);
  for (int idx = tid; idx < 67 * 16; idx += 256) {
    int rr = idx >> 4, ch = (idx & 15) * 8;
    int tl = tl0 + rr - 3;
    uint4 v = make_uint4(0, 0, 0, 0);
    if (tl >= 0) v = *(const uint4*)(raw + (long)(b * 8192 + tl) * 1024 + ctile * 128 + ch);
    float* d = sRaw + rr * 128 + ch;
    d[0] = lo2f(v.x); d[1] = hi2f(v.x); d[2] = lo2f(v.y); d[3] = hi2f(v.y);
    d[4] = lo2f(v.z); d[5] = hi2f(v.z); d[6] = lo2f(v.w); d[7] = hi2f(v.w);
  }
  __syncthreads();
  const int c = tid & 127, th = tid >> 7;
  const int cg_ = ctile * 128 + c;
  const float w0 = p.conv_w[cg_], w1 = p.conv_w[1024 + cg_], w2 = p.conv_w[2048 + cg_], w3 = p.conv_w[3072 + cg_];
  const float cb = p.conv_b[cg_];
  const bool isk = ctile >= 4;
  bf16_t* dst = (bf16_t*)(ws + (isk ? L0_KC : L0_QC));
  const int cc = isk ? cg_ - 512 : cg_;
  const float sc = isk ? 0.08838834764831845f : 1.f;
  for (int t = th * 32; t < th * 32 + 32; ++t) {
    float a = cb + w0 * sRaw[t * 128 + c] + w1 * sRaw[(t + 1) * 128 + c] + w2 * sRaw[(t + 2) * 128 + c] + w3 * sRaw[(t + 3) * 128 + c];
    bf16_t o = f2bf(siluf(a) * sc);
    dst[(long)(t0g + t) * 512 + cc] = o;
    sOutT[c * LDT + t] = o;
  }
  __syncthreads();
  if (isk) {
    bf16_t* kct = (bf16_t*)(ws + L0_KCT);
#pragma unroll
    for (int j = 0; j < 4; ++j) {
      int idx = tid + 256 * j;
      int cr = idx >> 3, tc = (idx & 7) * 8;
      *(uint4*)(kct + ((long)(b * 512 + (ctile - 4) * 128 + cr)) * 8192 + tl0 + tc) = *(const uint4*)(sOutT + cr * LDT + tc);
    }
  }
  __syncthreads();
}

DEVI void cmp_finalize(const Params& p, int task, int lane) {
  const int n = task & 511, bg = (task >> 9) & 3, kv = task >> 11;
  unsigned char* ws = p.ws;
  bf16_t* KCMP = (bf16_t*)(ws + L0_KCMP);
  bf16_t* VCMPT = (bf16_t*)(ws + L0_VCMPT);
  if (n == 511) {
    if (kv == 0) KCMP[((long)bg * 512 + 511) * 64 + lane] = 0;
    else VCMPT[((long)bg * 64 + lane) * 512 + 511] = 0;
    return;
  }
  const float* hid = (const float*)(ws + L0_HID) + ((long)(kv * 4 + bg) * 512 + n) * 128;
  const float* w2 = kv ? p.cv_w2 : p.ck_w2;
  float a = 0.f;
  for (int j = 0; j < 128; ++j) a += hid[j] * w2[j * 64 + lane];
  if (kv == 0) {
    float ss = wave_sum(a * a);
    float rinv = rsqrtf(ss * (1.f / 64.f) + EPSF);
    float v = a * rinv * p.k_norm[lane];
    float partner = __shfl_xor(v, 8);
    int pos = 16 * n + 31;
    float2 cs = ((const float2*)(ws + OFF_ROPE))[pos * 8 + (lane & 7)];
    float o = v;
    if (lane < 8) o = v * cs.x - partner * cs.y;
    else if (lane < 16) o = partner * cs.y + v * cs.x;
    KCMP[((long)bg * 512 + n) * 64 + lane] = f2bf(o);
  } else {
    VCMPT[((long)bg * 64 + lane) * 512 + n] = f2bf(a);
  }
}

DEVI void mlstm_local(const Params& p, int unit, unsigned char* smem) {
  const int tid = threadIdx.x, lane = tid & 63, w = tid >> 6, wr = w >> 1, wc = w & 1;
  const int bh = unit >> 6, c = unit & 63, b = bh >> 2, h = bh & 3, t0 = c * 128;
  const long R0 = (long)b * 8192 + t0;
  unsigned char* ws = p.ws;
  bf16_t* sA = (bf16_t*)smem;
  bf16_t* sB = (bf16_t*)(smem + 18432);
  float* sIg = (float*)(smem + 36864);
  float* sLf = sIg + 128;
  float* sW = sLf + 128;
  const float* IG = (const float*)(ws + L0_IG);
  const float* LF = (const float*)(ws + L0_LOGF);
  if (tid < 128) { sIg[tid] = IG[(R0 + tid) * 4 + h]; sLf[tid] = LF[(R0 + tid) * 4 + h]; }
  __syncthreads();
  if (tid == 0) {
    float cum = 0.f;
#pragma unroll 1
    for (int s = 0; s < 128; ++s) { cum += sLf[s]; sLf[s] = cum; }
    float bL = cum, ml = -3.0e38f;
#pragma unroll 1
    for (int s = 0; s < 128; ++s) { float dl = bL - sLf[s] + sIg[s]; sW[s] = dl; ml = fmaxf(ml, dl); }
#pragma unroll 1
    for (int s = 0; s < 128; ++s) sW[s] = __expf(sW[s] - ml);
    ((float*)(ws + L0_BL))[unit] = bL;
    ((float*)(ws + L0_MLOC))[unit] = ml;
  }
  __syncthreads();
  f32x4 acc[4][4];
#pragma unroll
  for (int mt = 0; mt < 4; ++mt)
#pragma unroll
    for (int nt = 0; nt < 4; ++nt) acc[mt][nt] = f32x4{0.f, 0.f, 0.f, 0.f};
  float dn = 0.f;
  const bf16_t* vt = (const bf16_t*)(ws + L0_MVT) + ((long)(b * 512 + h * 128)) * 8192 + t0;
  const bf16_t* kt_ = (const bf16_t*)(ws + L0_KCT) + ((long)(b * 512 + h * 128)) * 8192 + t0;
  const int lr = tid >> 3, lk = (tid & 7) * 8;
  for (int kt = 0; kt < 2; ++kt) {
    load_tile128(sA, vt + kt * 64, 8192);
#pragma unroll
    for (int j = 0; j < 4; ++j) {
      uint4 v = *(const uint4*)(kt_ + (long)(lr + 32 * j) * 8192 + kt * 64 + lk);
      const float* ww = sW + kt * 64 + lk;
      uint4 o;
      o.x = pack2(lo2f(v.x) * ww[0], hi2f(v.x) * ww[1]);
      o.y = pack2(lo2f(v.y) * ww[2], hi2f(v.y) * ww[3]);
      o.z = pack2(lo2f(v.z) * ww[4], hi2f(v.z) * ww[5]);
      o.w = pack2(lo2f(v.w) * ww[6], hi2f(v.w) * ww[7]);
      *(uint4*)(sB + (lr + 32 * j) * LDT + lk) = o;
    }
    __syncthreads();
    if (tid < 128) {
#pragma unroll 8
      for (int s = 0; s < 64; ++s) dn += bf2f(sB[tid * LDT + s]);
    }
    mma_lds<4, 4, 2>(sA + wr * 64 * LDT, sB + wc * 64 * LDT, acc, lane);
    __syncthreads();
  }
  float* dct = (float*)(ws + L0_H) + (long)unit * 16384;
  const int r = lane & 15, q = lane >> 4;
#pragma unroll
  for (int mt = 0; mt < 4; ++mt)
#pragma unroll
    for (int i = 0; i < 4; ++i) {
      int e = wr * 64 + mt * 16 + q * 4 + i;
#pragma unroll
      for (int nt = 0; nt < 4; ++nt) dct[e * 128 + wc * 64 + nt * 16 + r] = acc[mt][nt][i];
    }
  if (tid < 128) ((float*)(ws + L0_DN))[unit * 128 + tid] = dn;
}

DEVI void mlstm_scan(const Params& p) {
  unsigned char* ws = p.ws;
  const float* BL = (const float*)(ws + L0_BL);
  const float* ML = (const float*)(ws + L0_MLOC);
  float* MIN_ = (float*)(ws + L0_MIN);
  const int total = 8 * 16384 + 8 * 128;
  for (int idx = blockIdx.x * 256 + threadIdx.x; idx < total; idx += gridDim.x * 256) {
    float* ptr; int stride; int bh; bool wm = false;
    if (idx < 131072) { bh = idx >> 14; int off = idx & 16383; ptr = (float*)(ws + L0_H) + (long)bh * 64 * 16384 + off; stride = 16384; wm = (off == 0); }
    else { int j = idx - 131072; bh = j >> 7; int off = j & 127; ptr = (float*)(ws + L0_DN) + (long)bh * 64 * 128 + off; stride = 128; }
    float m = 0.f, C = 0.f;
    for (int c = 0; c < 64; ++c) {
      int unit = bh * 64 + c;
      float bL = BL[unit], ml = ML[unit];
      float d = ptr[(long)c * stride];
      ptr[(long)c * stride] = C;
      if (wm) MIN_[unit] = m;
      float mn = fmaxf(bL + m, ml);
      C = __expf(bL + m - mn) * C + __expf(ml - mn) * d;
      m = mn;
    }
  }
}

DEVI void mlstm_out(const Params& p, int item, unsigned char* smem) {
  const int tid = threadIdx.x, lane = tid & 63, w = tid >> 6, wr = w >> 1, wc = w & 1;
  const int r = lane & 15, q = lane >> 4;
  const int unit = item >> 1, u = item & 1;
  const int bh = unit >> 6, c = unit & 63, b = bh >> 2, h = bh & 3, t0 = c * 128;
  const long R0 = (long)b * 8192 + t0;
  const int J0 = u * 64;
  unsigned char* ws = p.ws;
  bf16_t* sA = (bf16_t*)smem;
  bf16_t* sB = (bf16_t*)(smem + 9216);
  bf16_t* sS0 = (bf16_t*)(smem + 27648);
  bf16_t* sS1 = (bf16_t*)(smem + 36864);
  float* fl = (float*)(smem + 46080);
  float* sIg = fl; float* sLf = fl + 128; float* sRj = fl + 256; float* sCs = fl + 384; float* sWi = fl + 512;
  float* sEm = fl + 640; float* sQn = fl + 768; float* sNin = fl + 896; float* sDen = fl + 1024; float* sSs = fl + 1280;
  const float* IG = (const float*)(ws + L0_IG);
  const float* LF = (const float*)(ws + L0_LOGF);
  const bf16_t* QC = (const bf16_t*)(ws + L0_QC) + (R0 + J0) * 512 + h * 128;
  const bf16_t* KC = (const bf16_t*)(ws + L0_KC) + R0 * 512 + h * 128;
  if (tid < 128) { sIg[tid] = IG[(R0 + tid) * 4 + h]; sLf[tid] = LF[(R0 + tid) * 4 + h]; sNin[tid] = ((const float*)(ws + L0_DN))[unit * 128 + tid]; }
  const float m_in = ((const float*)(ws + L0_MIN))[unit];
  __syncthreads();
  if (tid == 0) {
    float cum = 0.f, cmx = -3.0e38f;
#pragma unroll 1
    for (int s = 0; s < 128; ++s) {
      cum += sLf[s];
      float a = sIg[s] - cum;
      cmx = fmaxf(cmx, a);
      float mx = fmaxf(cmx, m_in);
      sCs[s] = a; sRj[s] = -mx; sWi[s] = __expf(m_in - mx); sEm[s] = __expf(-(cum + mx));
    }
  }
  if (tid >= 128 && tid < 192) {
    int jl = tid - 128;
    const bf16_t* qr = QC + (long)jl * 512;
    float s = 0.f;
#pragma unroll 2
    for (int ch = 0; ch < 16; ++ch) {
      uint4 v = *(const uint4*)(qr + ch * 8);
      const float* nn = sNin + ch * 8;
      s += lo2f(v.x) * nn[0] + hi2f(v.x) * nn[1] + lo2f(v.y) * nn[2] + hi2f(v.y) * nn[3] + lo2f(v.z) * nn[4] + hi2f(v.z) * nn[5] + lo2f(v.w) * nn[6] + hi2f(v.w) * nn[7];
    }
    sQn[jl] = s;
  }
  __syncthreads();
  f32x4 acc[2][4];
#pragma unroll
  for (int mt = 0; mt < 2; ++mt)
#pragma unroll
    for (int nt = 0; nt < 4; ++nt) acc[mt][nt] = f32x4{0.f, 0.f, 0.f, 0.f};
  const bool skipS = (wc > u);
#pragma unroll 1
  for (int kt = 0; kt < 2; ++kt) {
    load_tile64(sA, QC + kt * 64, 512);
    load_tile128(sB, KC + kt * 64, 512);
    __syncthreads();
    if (!skipS) mma_lds<2, 4, 2>(sA + wr * 32 * LDT, sB + wc * 64 * LDT, acc, lane);
    __syncthreads();
  }
  {
    bf16_t* sS = wc ? sS1 : sS0;
#pragma unroll
    for (int mt = 0; mt < 2; ++mt)
#pragma unroll
      for (int i = 0; i < 4; ++i) {
        int jl = wr * 32 + mt * 16 + q * 4 + i;
        int j = J0 + jl;
        float rj = sRj[j], rs = 0.f;
#pragma unroll
        for (int nt = 0; nt < 4; ++nt) {
          int sl = nt * 16 + r, s = wc * 64 + sl;
          float val = (s <= j) ? acc[mt][nt][i] * __expf(rj + sCs[s]) : 0.f;
          rs += val;
          sS[jl * LDT + sl] = f2bf(val);
        }
        rs = grp16_sum(rs);
        if (r == 0) sDen[wc * 64 + jl] = rs;
      }
  }
#pragma unroll
  for (int mt = 0; mt < 2; ++mt)
#pragma unroll
    for (int nt = 0; nt < 4; ++nt) acc[mt][nt] = f32x4{0.f, 0.f, 0.f, 0.f};
  const bf16_t* vt = (const bf16_t*)(ws + L0_MVT) + ((long)(b * 512 + h * 128)) * 8192 + t0;
  const float* ct = (const float*)(ws + L0_H) + (long)unit * 16384;
  const int lr = tid >> 3, lk = (tid & 7) * 8;
#pragma unroll 1
  for (int kt = 0; kt < 4; ++kt) {
    if (kt == 1 && u == 0) continue;
    const bf16_t* aS;
    if (kt < 2) {
      load_tile128(sB, vt + kt * 64, 8192);
      aS = kt ? sS1 : sS0;
    } else {
      const int k2 = kt - 2;
#pragma unroll
      for (int j = 0; j < 2; ++j) {
        int row = lr + 32 * j;
        uint4 v = *(const uint4*)(QC + (long)row * 512 + k2 * 64 + lk);
        float wi = sWi[J0 + row];
        uint4 o;
        o.x = pack2(lo2f(v.x) * wi, hi2f(v.x) * wi);
        o.y = pack2(lo2f(v.y) * wi, hi2f(v.y) * wi);
        o.z = pack2(lo2f(v.z) * wi, hi2f(v.z) * wi);
        o.w = pack2(lo2f(v.w) * wi, hi2f(v.w) * wi);
        *(uint4*)(sA + row * LDT + lk) = o;
      }
#pragma unroll
      for (int j = 0; j < 8; ++j) {
        int e = (tid >> 4) + 16 * j, c4 = (tid & 15) * 4;
        float4 v = *(const float4*)(ct + (long)e * 128 + k2 * 64 + c4);
        uint2 o;
        o.x = pack2(v.x, v.y);
        o.y = pack2(v.z, v.w);
        *(uint2*)(sB + e * LDT + c4) = o;
      }
      aS = sA;
    }
    __syncthreads();
    mma_lds<2, 4, 2>(aS + wr * 32 * LDT, sB + wc * 64 * LDT, acc, lane);
    __syncthreads();
  }
#pragma unroll
  for (int mt = 0; mt < 2; ++mt)
#pragma unroll
    for (int i = 0; i < 4; ++i) {
      int jl = wr * 32 + mt * 16 + q * 4 + i;
      int j = J0 + jl;
      float den = sDen[jl] + sDen[64 + jl] + sWi[j] * sQn[jl];
      float dinv = 1.f / fmaxf(fabsf(den), sEm[j]);
      float ss = 0.f;
#pragma unroll
      for (int nt = 0; nt < 4; ++nt) { float v = acc[mt][nt][i] * dinv; acc[mt][nt][i] = v; ss += v * v; }
      ss = grp16_sum(ss);
      if (r == 0) sSs[wc * 64 + jl] = ss;
    }
  __syncthreads();
  const bf16_t* MO = (const bf16_t*)(ws + L0_MO);
  const bf16_t* MZ = (const bf16_t*)(ws + L0_MZ);
  bf16_t* Y = (bf16_t*)(ws + L0_QKRAW);
#pragma unroll
  for (int mt = 0; mt < 2; ++mt)
#pragma unroll
    for (int i = 0; i < 4; ++i) {
      int jl = wr * 32 + mt * 16 + q * 4 + i;
      float rinv = rsqrtf((sSs[jl] + sSs[64 + jl]) * (1.f / 128.f) + EPSF);
      long row = R0 + J0 + jl;
#pragma unroll
      for (int nt = 0; nt < 4; ++nt) {
        int col = h * 128 + wc * 64 + nt * 16 + r;
        float v = acc[mt][nt][i] * rinv * p.m_hn[col] * bf2f(MO[row * 512 + col]) * bf2f(MZ[row * 512 + col]);
        Y[row * 1024 + col] = f2bf(v);
      }
    }
  __syncthreads();
}

struct AttnSm {
  bf16_t* sK; bf16_t* sV; float* sS; bf16_t* sP; float* sM; float* sL; float* sAl; float* sImp; unsigned* sSel; unsigned* sUn; float* sCarry;
};

template <int MODE, class MaskF>
DEVI void attn_keytile(const AttnSm& sm, const bf16_t* Kg, const bf16_t* Vtg, long ldv, const bf16x8 (&qf)[2], f32x4 (&O)[4], MaskF mask, int kt) {
  const int tid = threadIdx.x, lane = tid & 63, w = tid >> 6, r = lane & 15, q = lane >> 4;
  load_tile64(sm.sK, Kg, 64);
  if (MODE != 1) load_tile64(sm.sV, Vtg, ldv);
  __syncthreads();
  f32x4 sacc[4];
#pragma unroll
  for (int nt = 0; nt < 4; ++nt) sacc[nt] = f32x4{0.f, 0.f, 0.f, 0.f};
#pragma unroll
  for (int ks = 0; ks < 2; ++ks)
#pragma unroll
    for (int nt = 0; nt < 4; ++nt) {
      bf16x8 bb = *(const bf16x8*)(sm.sK + (nt * 16 + r) * LDT + ks * 32 + q * 8);
      sacc[nt] = __builtin_amdgcn_mfma_f32_16x16x32_bf16(qf[ks], bb, sacc[nt], 0, 0, 0);
    }
#pragma unroll
  for (int nt = 0; nt < 4; ++nt)
#pragma unroll
    for (int i = 0; i < 4; ++i) {
      int row = 16 * w + q * 4 + i, key = nt * 16 + r;
      sm.sS[row * SLD + key] = mask(row, key) ? sacc[nt][i] : NEGS;
    }
  __syncthreads();
  {
    const int row = tid >> 2, part = tid & 3;
    float s[16];
#pragma unroll
    for (int i4 = 0; i4 < 4; ++i4) {
      float4 v = *(const float4*)(sm.sS + row * SLD + part * 16 + i4 * 4);
      s[i4 * 4 + 0] = v.x; s[i4 * 4 + 1] = v.y; s[i4 * 4 + 2] = v.z; s[i4 * 4 + 3] = v.w;
    }
    if (MODE != 2) {
      float tm = NEGS;
#pragma unroll
      for (int i = 0; i < 16; ++i) tm = fmaxf(tm, s[i]);
      tm = fmaxf(tm, __shfl_xor(tm, 1));
      tm = fmaxf(tm, __shfl_xor(tm, 2));
      const float mo = sm.sM[row];
      const float mn = fmaxf(mo, tm);
      float ps = 0.f;
      float pv[16];
#pragma unroll
      for (int i = 0; i < 16; ++i) { pv[i] = (s[i] > -1e29f) ? __expf(s[i] - mn) : 0.f; ps += pv[i]; }
      ps += __shfl_xor(ps, 1);
      ps += __shfl_xor(ps, 2);
      const float al = __expf(mo - mn);
      const float lo = sm.sL[row];
      if (MODE == 0) {
#pragma unroll
        for (int i8 = 0; i8 < 2; ++i8) {
          uint4 o;
          o.x = pack2(pv[i8 * 8 + 0], pv[i8 * 8 + 1]); o.y = pack2(pv[i8 * 8 + 2], pv[i8 * 8 + 3]);
          o.z = pack2(pv[i8 * 8 + 4], pv[i8 * 8 + 5]); o.w = pack2(pv[i8 * 8 + 6], pv[i8 * 8 + 7]);
          *(uint4*)(sm.sP + row * LDT + part * 16 + i8 * 8) = o;
        }
      }
      if (part == 0) { sm.sM[row] = mn; sm.sL[row] = al * lo + ps; sm.sAl[row] = al; }
    } else {
      const float mrow = sm.sM[row], il = sm.sL[row];
      float pv[16];
#pragma unroll
      for (int i = 0; i < 16; ++i) pv[i] = (s[i] > -1e29f) ? __expf(s[i] - mrow) * il : 0.f;
#pragma unroll
      for (int i8 = 0; i8 < 2; ++i8) {
        uint4 o;
        o.x = pack2(pv[i8 * 8 + 0], pv[i8 * 8 + 1]); o.y = pack2(pv[i8 * 8 + 2], pv[i8 * 8 + 3]);
        o.z = pack2(pv[i8 * 8 + 4], pv[i8 * 8 + 5]); o.w = pack2(pv[i8 * 8 + 6], pv[i8 * 8 + 7]);
        *(uint4*)(sm.sP + row * LDT + part * 16 + i8 * 8) = o;
      }
#pragma unroll
      for (int i4 = 0; i4 < 4; ++i4)
        *(float4*)(sm.sS + row * SLD + part * 16 + i4 * 4) = make_float4(pv[i4 * 4], pv[i4 * 4 + 1], pv[i4 * 4 + 2], pv[i4 * 4 + 3]);
    }
  }
  __syncthreads();
  if (MODE == 2) {
    const int ti = tid >> 4, mm = tid & 15;
    const float* cin = sm.sCarry + ((kt & 1) ^ 1) * 64;
    float* cout = sm.sCarry + (kt & 1) * 64;
    float sum = 0.f;
#pragma unroll
    for (int rr = 0; rr < 4; ++rr) {
      int rho = ti * 4 + rr;
      float4 pp = *(const float4*)(sm.sS + rho * SLD + 4 * mm);
      float pm1 = (mm > 0) ? sm.sS[rho * SLD + 4 * mm - 1] : cin[rho];
      sum += 16.f * pm1 + 32.f * (pp.x + pp.y + pp.z) + 16.f * pp.w;
      if (mm == 15) cout[rho] = pp.w;
    }
    sm.sImp[ti * 128 + kt * 16 + mm] = sum;
  }
  if (MODE != 1) {
    if (MODE == 0) {
#pragma unroll
      for (int i = 0; i < 4; ++i) {
        float al = sm.sAl[16 * w + q * 4 + i];
#pragma unroll
        for (int nt = 0; nt < 4; ++nt) O[nt][i] *= al;
      }
    }
#pragma unroll
    for (int ks = 0; ks < 2; ++ks) {
      bf16x8 a = *(const bf16x8*)(sm.sP + (16 * w + r) * LDT + ks * 32 + q * 8);
#pragma unroll
      for (int nt = 0; nt < 4; ++nt) {
        bf16x8 bb = *(const bf16x8*)(sm.sV + (nt * 16 + r) * LDT + ks * 32 + q * 8);
        O[nt] = __builtin_amdgcn_mfma_f32_16x16x32_bf16(a, bb, O[nt], 0, 0, 0);
      }
    }
  }
  __syncthreads();
}

DEVI void nsa_tile(const Params& p, int tileidx, unsigned char* smem) {
  const int tid = threadIdx.x, lane = tid & 63, w = tid >> 6, r = lane & 15, q = lane >> 4;
  const int bg = tileidx & 3, tt = tileidx >> 2, b = bg >> 1, g = bg & 1, t0 = tt * 16;
  unsigned char* ws = p.ws;
  AttnSm sm;
  sm.sK = (bf16_t*)smem; sm.sV = (bf16_t*)(smem + 9216); sm.sP = (bf16_t*)(smem + 18432);
  sm.sS = (float*)(smem + 27648);
  sm.sM = (float*)(smem + 45056); sm.sL = sm.sM + 64; sm.sAl = sm.sM + 128;
  sm.sCarry = sm.sM + 192;
  sm.sSel = (unsigned*)(sm.sM + 320);
  sm.sUn = sm.sSel + 64;
  sm.sImp = (float*)(smem + 45056 + 2048);
  bf16x8 qf[2];
  {
    const bf16_t* qn = (const bf16_t*)(ws + L0_QN) + ((long)bg * 8192 + t0) * 256 + (16 * w + r) * 64 + q * 8;
    qf[0] = *(const bf16x8*)(qn);
    qf[1] = *(const bf16x8*)(qn + 32);
  }
  const float* GT = (const float*)(ws + L0_GATES);
  f32x4 outacc[4], O[4];
#pragma unroll
  for (int nt = 0; nt < 4; ++nt) outacc[nt] = f32x4{0.f, 0.f, 0.f, 0.f};
  const int cur = t0 >> 6;
  for (int i = tid; i < 16 * 128; i += 256) sm.sImp[i] = 0.f;
  if (tid < 64) { sm.sM[tid] = NEGS; sm.sL[tid] = 0.f; sm.sCarry[tid] = 0.f; sm.sCarry[64 + tid] = 0.f; }
  __syncthreads();
  const int nvmax = (t0 + 15 >= 31) ? (((t0 + 15 - 31) >> 4) + 1) : 0;
#ifdef DBG_NO_CMP
  const int nkt = 0;
#else
  const int nkt = (nvmax + 63) >> 6;
#endif
  const bf16_t* KCMP = (const bf16_t*)(ws + L0_KCMP) + (long)bg * 512 * 64;
  const bf16_t* VCMPT = (const bf16_t*)(ws + L0_VCMPT) + (long)bg * 64 * 512;
#pragma unroll
  for (int nt = 0; nt < 4; ++nt) O[nt] = f32x4{0.f, 0.f, 0.f, 0.f};
  for (int kt = 0; kt < nkt; ++kt) {
    auto mk = [&](int row, int key) { return 16 * (kt * 64 + key) + 31 <= t0 + (row >> 2); };
    attn_keytile<1>(sm, KCMP + kt * 64 * 64, VCMPT + kt * 64, 512, qf, O, mk, kt);
  }
  if (tid < 64) { float l = sm.sL[tid]; sm.sL[tid] = (l > 0.f) ? 1.f / l : 0.f; }
  __syncthreads();
  for (int kt = 0; kt < nkt; ++kt) {
    auto mk = [&](int row, int key) { return 16 * (kt * 64 + key) + 31 <= t0 + (row >> 2); };
    attn_keytile<2>(sm, KCMP + kt * 64 * 64, VCMPT + kt * 64, 512, qf, O, mk, kt);
  }
#pragma unroll
  for (int i = 0; i < 4; ++i) {
    int row = 16 * w + q * 4 + i, ti = row >> 2, rr = row & 3;
    float gc = GT[((long)b * 8192 + t0 + ti) * 24 + (g * 4 + rr) * 3 + 0];
#pragma unroll
    for (int nt = 0; nt < 4; ++nt) outacc[nt][i] += gc * O[nt][i];
  }
  {
    const int ncand = (cur - 2 > 0) ? cur - 2 : 0;
    const int nf = (cur >= 2) ? 3 : cur + 1;
    const int kk = 16 - nf;
    for (int tq = 0; tq < 4; ++tq) {
      const int ti = w * 4 + tq;
      const float* imp = sm.sImp + ti * 128;
      const int m0 = lane, m1 = lane + 64;
      const float v0 = imp[m0], v1 = imp[m1];
      const bool c0 = (m0 >= 1 && m0 <= cur - 2), c1 = (m1 <= cur - 2);
      bool s0, s1;
      if (ncand <= kk) { s0 = c0; s1 = c1; }
      else {
        int r0 = 0, r1 = 0;
        for (int mp = 1; mp <= cur - 2; ++mp) {
          float vm = imp[mp];
          r0 += (vm > v0 || (vm == v0 && mp < m0)) ? 1 : 0;
          r1 += (vm > v1 || (vm == v1 && mp < m1)) ? 1 : 0;
        }
        s0 = c0 && (r0 < kk);
        s1 = c1 && (r1 < kk);
      }
      s0 = s0 || (m0 == 0) || (m0 == cur) || (m0 == cur - 1);
      s1 = s1 || (m1 == cur) || (m1 == cur - 1);
      unsigned long long lo = __ballot(s0), hi = __ballot(s1);
      if (lane == 0) {
        sm.sSel[ti * 4 + 0] = (unsigned)lo; sm.sSel[ti * 4 + 1] = (unsigned)(lo >> 32);
        sm.sSel[ti * 4 + 2] = (unsigned)hi; sm.sSel[ti * 4 + 3] = (unsigned)(hi >> 32);
      }
    }
  }
  __syncthreads();
  if (tid < 4) { unsigned u = 0; for (int ti = 0; ti < 16; ++ti) u |= sm.sSel[ti * 4 + tid]; sm.sUn[tid] = u; }
  if (tid < 64) { sm.sM[tid] = NEGS; sm.sL[tid] = 0.f; }
  __syncthreads();
#pragma unroll
  for (int nt = 0; nt < 4; ++nt) O[nt] = f32x4{0.f, 0.f, 0.f, 0.f};
  {
    const bf16_t* KS = (const bf16_t*)(ws + L0_KS) + (long)bg * 8192 * 64;
    const bf16_t* VST = (const bf16_t*)(ws + L0_VST) + (long)bg * 64 * 8192;
#ifdef DBG_NO_SEL
    for (int j = 0; j < 0; ++j) {
#else
    for (int j = 0; j <= cur; ++j) {
#endif
      if (!((sm.sUn[j >> 5] >> (j & 31)) & 1u)) continue;
      auto mk = [&](int row, int key) {
        int ti = row >> 2;
        return (((sm.sSel[ti * 4 + (j >> 5)] >> (j & 31)) & 1u) != 0) && (j * 64 + key <= t0 + ti);
      };
      attn_keytile<0>(sm, KS + (long)j * 64 * 64, VST + j * 64, 8192, qf, O, mk, j);
    }
  }
#pragma unroll
  for (int i = 0; i < 4; ++i) {
    int row = 16 * w + q * 4 + i, ti = row >> 2, rr = row & 3;
    float l = sm.sL[row];
    float gs = GT[((long)b * 8192 + t0 + ti) * 24 + (g * 4 + rr) * 3 + 1] * ((l > 0.f) ? 1.f / l : 0.f);
#pragma unroll
    for (int nt = 0; nt < 4; ++nt) outacc[nt][i] += gs * O[nt][i];
  }
  __syncthreads();
  if (tid < 64) { sm.sM[tid] = NEGS; sm.sL[tid] = 0.f; }
  __syncthreads();
#pragma unroll
  for (int nt = 0; nt < 4; ++nt) O[nt] = f32x4{0.f, 0.f, 0.f, 0.f};
  {
    const bf16_t* KW = (const bf16_t*)(ws + L0_KW) + (long)bg * 8192 * 64;
    const bf16_t* VWT = (const bf16_t*)(ws + L0_VWT) + (long)bg * 64 * 8192;
    const int jlo = ((t0 - 511 > 0) ? (t0 - 511) : 0) >> 6;
#ifdef DBG_NO_WIN
    for (int j = jlo; j < jlo; ++j) {
#else
    for (int j = jlo; j <= cur; ++j) {
#endif
      auto mk = [&](int row, int key) {
        int t = t0 + (row >> 2), s = j * 64 + key;
        return (s <= t) && (t - s < 512);
      };
      attn_keytile<0>(sm, KW + (long)j * 64 * 64, VWT + j * 64, 8192, qf, O, mk, j);
    }
  }
  const bf16_t* NZ = (const bf16_t*)(ws + L0_NZ);
  bf16_t* Y = (bf16_t*)(ws + L0_QKRAW);
#pragma unroll
  for (int i = 0; i < 4; ++i) {
    int row = 16 * w + q * 4 + i, ti = row >> 2, rr = row & 3;
    float l = sm.sL[row];
    long tok = (long)b * 8192 + t0 + ti;
    int head = g * 4 + rr;
    float gw = GT[tok * 24 + head * 3 + 2] * ((l > 0.f) ? 1.f / l : 0.f);
#pragma unroll
    for (int nt = 0; nt < 4; ++nt) {
      float v = outacc[nt][i] + gw * O[nt][i];
      int d = nt * 16 + r;
      float z = bf2f(NZ[tok * 512 + head * 64 + d]);
      Y[tok * 1024 + 512 + head * 64 + d] = f2bf(v * z);
    }
  }
  __syncthreads();
}

DEVI void hgrn_local(const Params& p, int unit, unsigned char* smem) {
  const int tid = threadIdx.x, lane = tid & 63, w = tid >> 6, wr = w >> 1, wc = w & 1;
  const int bh = unit >> 7, c = unit & 127, b = bh >> 3, h = bh & 7, t0 = c * 64;
  const long R0 = (long)b * 8192 + t0;
  unsigned char* ws = p.ws;
  bf16_t* sA = (bf16_t*)smem;
  bf16_t* sB = (bf16_t*)(smem + 18432);
  float* psum = (float*)(smem + 36864);
  const int cch = tid & 127, half = tid >> 7;
  const float lb = ((const float*)(ws + OFF_LB))[h * 128 + cch];
  const bf16_t* FP = (const bf16_t*)(ws + L1_FP) + R0 * 1024 + h * 128 + cch;
  load_tile128(sA, (const bf16_t*)(ws + L1_VT) + ((long)(b * 1024 + h * 128)) * 8192 + t0, 8192);
  float sum = 0.f;
  for (int s = half * 32; s < half * 32 + 32; ++s) {
    float fp = bf2f(FP[(long)s * 1024]);
    float f = lb + (1.f - lb) * sigm(fp);
    sum += __logf(f);
  }
  psum[half * 128 + cch] = sum;
  __syncthreads();
  const float bL = psum[cch] + psum[128 + cch];
  float run = half ? psum[cch] : 0.f;
  for (int s = half * 32; s < half * 32 + 32; ++s) {
    float fp = bf2f(FP[(long)s * 1024]);
    float sg = sigm(fp);
    float f = lb + (1.f - lb) * sg;
    run += __logf(f);
    float k = (1.f - lb) * (1.f - sg);
    sB[cch * LDT + s] = f2bf(k * __expf(bL - run));
  }
  if (half == 0) ((float*)(ws + L1_BL))[(long)unit * 128 + cch] = bL;
  __syncthreads();
  f32x4 acc[4][4];
#pragma unroll
  for (int mt = 0; mt < 4; ++mt)
#pragma unroll
    for (int nt = 0; nt < 4; ++nt) acc[mt][nt] = f32x4{0.f, 0.f, 0.f, 0.f};
  mma_lds<4, 4, 2>(sA + wr * 64 * LDT, sB + wc * 64 * LDT, acc, lane);
  bf16_t* st = (bf16_t*)(ws + L1_ST) + (long)unit * 16384;
  const int r = lane & 15, q = lane >> 4;
#pragma unroll
  for (int mt = 0; mt < 4; ++mt)
#pragma unroll
    for (int i = 0; i < 4; ++i) {
      int v = wr * 64 + mt * 16 + q * 4 + i;
#pragma unroll
      for (int nt = 0; nt < 4; ++nt) st[v * 128 + wc * 64 + nt * 16 + r] = f2bf(acc[mt][nt][i]);
    }
  __syncthreads();
}

DEVI void hgrn_scan(const Params& p) {
  unsigned char* ws = p.ws;
  const float* BL = (const float*)(ws + L1_BL);
  for (int idx = blockIdx.x * 256 + threadIdx.x; idx < 16 * 8192; idx += gridDim.x * 256) {
    int bh = idx >> 13, pr = idx & 8191;
    int c2 = (pr & 63) * 2;
    unsigned* ptr = (unsigned*)(ws + L1_ST) + (long)bh * 128 * 8192 + pr;
    float s0 = 0.f, s1 = 0.f;
    for (int c = 0; c < 128; ++c) {
      int unit = bh * 128 + c;
      float2 bl = *(const float2*)(BL + (long)unit * 128 + c2);
      unsigned d = ptr[(long)c * 8192];
      ptr[(long)c * 8192] = pack2(s0, s1);
      s0 = __expf(bl.x) * s0 + lo2f(d);
      s1 = __expf(bl.y) * s1 + hi2f(d);
    }
  }
}

DEVI void hgrn_out(const Params& p, int unit, unsigned char* smem) {
  const int tid = threadIdx.x, lane = tid & 63, w = tid >> 6, wr = w >> 1, wc = w & 1;
  const int r = lane & 15, q = lane >> 4;
  const int bh = unit >> 7, c = unit & 127, b = bh >> 3, h = bh & 7, t0 = c * 64;
  const long R0 = (long)b * 8192 + t0;
  unsigned char* ws = p.ws;
  bf16_t* sQ0 = (bf16_t*)smem; bf16_t* sQ1 = (bf16_t*)(smem + 9216);
  bf16_t* sK0 = (bf16_t*)(smem + 18432); bf16_t* sK1 = (bf16_t*)(smem + 27648);
  bf16_t* sAm = (bf16_t*)(smem + 36864);
  bf16_t* sB = (bf16_t*)(smem + 46080);
  float* psum = (float*)(smem + 64512);
  float* sSs = psum + 256;
  const int cch = tid & 127, half = tid >> 7, cc = cch & 63;
  const float lb = ((const float*)(ws + OFF_LB))[h * 128 + cch];
  const bf16_t* FP = (const bf16_t*)(ws + L1_FP) + R0 * 1024 + h * 128 + cch;
  const bf16_t* Q1 = (const bf16_t*)(ws + L1_Q) + R0 * 1024 + h * 128 + cch;
  const bf16_t* vt = (const bf16_t*)(ws + L1_VT) + ((long)(b * 1024 + h * 128)) * 8192 + t0;
  load_tile128(sB, vt, 8192);
  float sum = 0.f;
  for (int s = half * 32; s < half * 32 + 32; ++s) {
    float fp = bf2f(FP[(long)s * 1024]);
    float f = lb + (1.f - lb) * sigm(fp);
    sum += __logf(f);
  }
  psum[half * 128 + cch] = sum;
  __syncthreads();
  float run = half ? psum[cch] : 0.f;
  bf16_t* sQ = (cch < 64) ? sQ0 : sQ1;
  bf16_t* sK = (cch < 64) ? sK0 : sK1;
  for (int s = half * 32; s < half * 32 + 32; ++s) {
    float fp = bf2f(FP[(long)s * 1024]);
    float sg = sigm(fp);
    float f = lb + (1.f - lb) * sg;
    run += __logf(f);
    float k = (1.f - lb) * (1.f - sg);
    float qv = bf2f(Q1[(long)s * 1024]);
    sQ[s * LDT + cc] = f2bf(qv * __expf(run));
    sK[s * LDT + cc] = f2bf(k * __expf(fminf(-run, 80.f)));
  }
  __syncthreads();
  {
    f32x4 a1[2][2];
#pragma unroll
    for (int mt = 0; mt < 2; ++mt)
#pragma unroll
      for (int nt = 0; nt < 2; ++nt) a1[mt][nt] = f32x4{0.f, 0.f, 0.f, 0.f};
    if (!(wr == 0 && wc == 1)) {
      mma_lds<2, 2, 2>(sQ0 + wr * 32 * LDT, sK0 + wc * 32 * LDT, a1, lane);
      mma_lds<2, 2, 2>(sQ1 + wr * 32 * LDT, sK1 + wc * 32 * LDT, a1, lane);
    }
#pragma unroll
    for (int mt = 0; mt < 2; ++mt)
#pragma unroll
      for (int i = 0; i < 4; ++i) {
        int j = wr * 32 + mt * 16 + q * 4 + i;
#pragma unroll
        for (int nt = 0; nt < 2; ++nt) {
          int s = wc * 32 + nt * 16 + r;
          sAm[j * LDT + s] = f2bf((s <= j) ? a1[mt][nt][i] : 0.f);
        }
      }
  }
  __syncthreads();
  f32x4 o[2][4];
#pragma unroll
  for (int mt = 0; mt < 2; ++mt)
#pragma unroll
    for (int nt = 0; nt < 4; ++nt) o[mt][nt] = f32x4{0.f, 0.f, 0.f, 0.f};
  mma_lds<2, 4, 2>(sAm + wr * 32 * LDT, sB + wc * 64 * LDT, o, lane);
  __syncthreads();
  const bf16_t* st = (const bf16_t*)(ws + L1_ST) + (long)unit * 16384;
  load_tile128(sB, st, 128);
  __syncthreads();
  mma_lds<2, 4, 2>(sQ0 + wr * 32 * LDT, sB + wc * 64 * LDT, o, lane);
  __syncthreads();
  load_tile128(sB, st + 64, 128);
  __syncthreads();
  mma_lds<2, 4, 2>(sQ1 + wr * 32 * LDT, sB + wc * 64 * LDT, o, lane);
#pragma unroll
  for (int mt = 0; mt < 2; ++mt)
#pragma unroll
    for (int i = 0; i < 4; ++i) {
      int j = wr * 32 + mt * 16 + q * 4 + i;
      float ss = 0.f;
#pragma unroll
      for (int nt = 0; nt < 4; ++nt) ss += o[mt][nt][i] * o[mt][nt][i];
      ss = grp16_sum(ss);
      if (r == 0) sSs[wc * 64 + j] = ss;
    }
  __syncthreads();
  const bf16_t* Z1 = (const bf16_t*)(ws + L1_Z);
  bf16_t* Y1 = (bf16_t*)(ws + L1_H);
#pragma unroll
  for (int mt = 0; mt < 2; ++mt)
#pragma unroll
    for (int i = 0; i < 4; ++i) {
      int j = wr * 32 + mt * 16 + q * 4 + i;
      float rinv = rsqrtf((sSs[j] + sSs[64 + j]) * (1.f / 128.f) + EPSF);
      long row = R0 + j;
#pragma unroll
      for (int nt = 0; nt < 4; ++nt) {
        int col = h * 128 + wc * 64 + nt * 16 + r;
        Y1[row * 1024 + col] = f2bf(o[mt][nt][i] * rinv * p.h_hn[col] * bf2f(Z1[row * 1024 + col]));
      }
    }
  __syncthreads();
}

DEVI void grid_barrier(unsigned* ctr, unsigned& epoch) {
  asm volatile("s_waitcnt vmcnt(0) lgkmcnt(0)" ::: "memory");
  __syncthreads();
  if (threadIdx.x == 0) {
    epoch += 1;
    const unsigned target = epoch * gridDim.x;
    __builtin_amdgcn_fence(__ATOMIC_RELEASE, "agent");
    asm volatile("s_waitcnt vmcnt(0)" ::: "memory");
    __hip_atomic_fetch_add(ctr, 1u, __ATOMIC_RELAXED, __HIP_MEMORY_SCOPE_AGENT);
    while (__hip_atomic_load(ctr, __ATOMIC_RELAXED, __HIP_MEMORY_SCOPE_AGENT) < target) __builtin_amdgcn_s_sleep(2);
    __builtin_amdgcn_fence(__ATOMIC_ACQUIRE, "agent");
    asm volatile("s_waitcnt vmcnt(0)" ::: "memory");
  }
  __syncthreads();
}

#ifndef DBG_STOP
#define DBG_STOP 99
#endif
DEVI void dbg_probe_bf16(const Params& p, size_t off, long n) {
  const bf16_t* b = (const bf16_t*)(p.ws + off);
  for (long i = (long)blockIdx.x * 256 + threadIdx.x; i < 16384L * 1024; i += (long)gridDim.x * 256) {
    float v = bf2f(b[i % n]);
    if (!(v == v) || fabsf(v) > 1e30f) v = 777.f;
    p.out[i] = v;
  }
}
DEVI void dbg_probe_f32(const Params& p, size_t off, long n) {
  const float* b = (const float*)(p.ws + off);
  for (long i = (long)blockIdx.x * 256 + threadIdx.x; i < 16384L * 1024; i += (long)gridDim.x * 256) {
    float v = b[i % n];
    if (!(v == v) || fabsf(v) > 1e30f) v = 777.f;
    p.out[i] = v;
  }
}
DEVI void dbg_probe_combo(const Params& p) {
  const bf16_t* qn = (const bf16_t*)(p.ws + L0_QN);
  const bf16_t* ks = (const bf16_t*)(p.ws + L0_KS);
  const bf16_t* nz = (const bf16_t*)(p.ws + L0_NZ);
  const float* ig = (const float*)(p.ws + L0_IG);
  for (long i = (long)blockIdx.x * 256 + threadIdx.x; i < 16384L * 1024; i += (long)gridDim.x * 256) {
    float v = bf2f(qn[i % (16384L * 512)]) + bf2f(ks[i % (4L * 8192 * 64 * 4)]) + bf2f(nz[i % (16384L * 512)]) + ig[i % (16384L * 32)];
    if (!(v == v) || fabsf(v) > 1e30f) v = 777.f;
    p.out[i] = v;
  }
}
#define DBG_AT(k, stmt) if (DBG_STOP == k) { stmt; return; }

#define GSYNC() grid_barrier(bar_ctr, bar_epoch)

__global__ void __launch_bounds__(256, 2) mega(Params p) {
  __shared__ __attribute__((aligned(16))) unsigned char smem[81920];
  cg::grid_group grid = cg::this_grid();
  const int G = gridDim.x, bid = blockIdx.x, tid = threadIdx.x, lane = tid & 63, w = tid >> 6;
  unsigned char* ws = p.ws;
  bf16_t* sA = (bf16_t*)smem;
  bf16_t* sB = (bf16_t*)(smem + 18432);
  unsigned* bar_ctr = (unsigned*)(ws + OFF_BAR);
  unsigned bar_epoch = 0;
  grid.sync();

  phase0(p, smem);
  GSYNC();
  DBG_AT(0, dbg_probe_bf16(p, L0_H, 16384L*1024))
  for (int it = bid; it < 128 * 35; it += G) {
    int tn = it % 35, tm = it / 35;
    gemm128((const bf16_t*)(ws + L0_H), 1024, 16383, (const bf16_t*)(ws + OFF_WIN0), 1024, 4383, 1024, tm * 128, tn * 128, sA, sB,
            [&](f32x4 (&acc)[4][4], int mb, int nb, int ln) { epi_proj0(p, acc, mb, nb, ln); });
  }
  GSYNC();
  DBG_AT(1, dbg_probe_bf16(p, L0_QKRAW, 16384L*1024)) DBG_AT(101, dbg_probe_combo(p)) DBG_AT(102, dbg_probe_bf16(p, L0_KS, 4L*8192*64*4)) DBG_AT(103, dbg_probe_f32(p, L0_IG, 16384L*4*2+16384L*24)) DBG_AT(104, dbg_probe_bf16(p, L0_MVT, 16384L*512*3))
  for (int it = bid; it < 32 + 2048; it += G) {
    if (it < 32) {
      int kv = it >> 4, bg = (it >> 2) & 3, tm = it & 3;
      const bf16_t* A = (const bf16_t*)(ws + (kv ? L0_VCRAW : L0_KCRAW)) + (long)bg * 8192 * 64;
      const bf16_t* B = (const bf16_t*)(ws + (kv ? OFF_WCV : OFF_WCK));
      gemm128(A, 1024, 510, B, 2048, 127, 2048, tm * 128, 0, sA, sB,
              [&](f32x4 (&acc)[4][4], int mb, int nb, int ln) { epi_cmp_hidden(p, acc, mb, nb, ln, kv, bg); });
    } else {
      conv_tile(p, it - 32, smem);
    }
  }
  GSYNC();
  DBG_AT(2, dbg_probe_bf16(p, L0_QC, 16384L*512*3)) DBG_AT(201, dbg_probe_f32(p, L0_HID, 2L*4*512*128))
  for (int it = bid; it < 512 + 1024; it += G) {
    if (it < 512) mlstm_local(p, it, smem);
    else cmp_finalize(p, (it - 512) * 4 + w, lane);
  }
  GSYNC();
  DBG_AT(3, dbg_probe_f32(p, L0_H, 512L*16384)) DBG_AT(301, dbg_probe_bf16(p, L0_KCMP, 4L*512*64*2)) DBG_AT(302, dbg_probe_f32(p, L0_DN, 512L*128 + 2048))
  mlstm_scan(p);
  GSYNC();
  DBG_AT(4, dbg_probe_f32(p, L0_H, 512L*16384)) DBG_AT(401, dbg_probe_f32(p, L0_DN, 512L*128 + 3072))
  for (int it = bid; it < 2048 + 1024; it += G) {
    if (it < 2048) {
      int k = it >> 9, i = it & 511;
      int idx = (k & 1) ? (k * 512 + 511 - i) : it;
#ifndef DBG_SKIP_NSA
      nsa_tile(p, idx, smem);
#endif
    } else {
#ifndef DBG_SKIP_MOUT
      mlstm_out(p, it - 2048, smem);
#endif
    }
  }
  GSYNC();
  DBG_AT(5, dbg_probe_bf16(p, L0_QKRAW, 16384L*1024))
  for (int it = bid; it < 128 * 8; it += G) {
    int tn = it & 7, tm = it >> 3;
    gemm128((const bf16_t*)(ws + L0_QKRAW), 1024, 16383, (const bf16_t*)(ws + OFF_WOUT0), 1024, 1023, 1024, tm * 128, tn * 128, sA, sB,
            [&](f32x4 (&acc)[4][4], int mb, int nb, int ln) { epi_out_resid(p.x, p.out, acc, mb, nb, ln); });
  }
  GSYNC();
  DBG_AT(6, (void)0)
  for (int row = bid * 4 + w; row < 16384; row += G * 4) rmsnorm_row(p.out, p.norm_w + 1024, (bf16_t*)(ws + L1_H), row, lane);
  GSYNC();
  DBG_AT(7, dbg_probe_bf16(p, L1_H, 16384L*1024))
  for (int it = bid; it < 128 * 32; it += G) {
    int tn = it & 31, tm = it >> 5;
    gemm128((const bf16_t*)(ws + L1_H), 1024, 16383, (const bf16_t*)(ws + OFF_WIN1), 1024, 4095, 1024, tm * 128, tn * 128, sA, sB,
            [&](f32x4 (&acc)[4][4], int mb, int nb, int ln) { epi_proj1(p, acc, mb, nb, ln); });
  }
  GSYNC();
  DBG_AT(8, dbg_probe_bf16(p, L1_FP, 16384L*1024*4))
  for (int it = bid; it < 2048; it += G) hgrn_local(p, it, smem);
  GSYNC();
  DBG_AT(9, dbg_probe_bf16(p, L1_ST, 2048L*16384))
  hgrn_scan(p);
  GSYNC();
  DBG_AT(10, dbg_probe_bf16(p, L1_ST, 2048L*16384))
  for (int it = bid; it < 2048; it += G) hgrn_out(p, it, smem);
  GSYNC();
  DBG_AT(11, dbg_probe_bf16(p, L1_H, 16384L*1024))
  for (int it = bid; it < 128 * 8; it += G) {
    int tn = it & 7, tm = it >> 3;
    gemm128((const bf16_t*)(ws + L1_H), 1024, 16383, (const bf16_t*)(ws + OFF_WOUT1), 1024, 1023, 1024, tm * 128, tn * 128, sA, sB,
            [&](f32x4 (&acc)[4][4], int mb, int nb, int ln) { epi_out_resid(p.out, p.out, acc, mb, nb, ln); });
  }
}

extern "C" void kernel_launch(void* const* d_in, const int* in_sizes, int n_in, void* d_out, int out_size, void* d_ws, size_t ws_size,
                              hipStream_t stream) {
  static int grid_blocks = 0;
  if (!grid_blocks) {
    int dev = 0, cus = 0, per_cu = 0;
    (void)hipGetDevice(&dev);
    (void)hipDeviceGetAttribute(&cus, hipDeviceAttributeMultiprocessorCount, dev);
    (void)hipOccupancyMaxActiveBlocksPerMultiprocessor(&per_cu, mega, 256, 0);
    if (per_cu > 2) per_cu = 2;
    if (per_cu < 1) per_cu = 1;
    grid_blocks = cus * per_cu;
  }
  Params p{};
  const float** pf = (const float**)&p;
  for (int i = 0; i < 22; ++i) pf[i] = (const float*)d_in[i];
  p.out = (float*)d_out;
  p.ws = (unsigned char*)d_ws;
  (void)hipMemsetAsync((unsigned char*)d_ws + OFF_BAR, 0, 256, stream);
  void* args[] = {&p};
  hipError_t e = hipLaunchCooperativeKernel((void*)mega, dim3(grid_blocks), dim3(256), args, 0, stream);
  if (e != hipSuccess) fprintf(stderr, "cooperative launch failed: %s (grid %d)\n", hipGetErrorString(e), grid_blocks);
}
```

```cpp
#include <hip/hip_runtime.h>
#include <hip/hip_cooperative_groups.h>
#include <stdint.h>
#include <cstdio>
namespace cg = cooperative_groups;

typedef unsigned short bf16_t;
typedef __attribute__((ext_vector_type(8))) short bf16x8;
typedef __attribute__((ext_vector_type(4))) float f32x4;
typedef __attribute__((ext_vector_type(4))) unsigned int u32x4;

#define DEVI __device__ __forceinline__
#define EPSF 1e-6f
#define LDT 72
#define SLD 68
#define NEGS (-1e30f)
#define LAUNDER(ptr) asm volatile("" : "+s"(ptr))

struct Params {
  const float* x; const float* norm_w; const float* ev_w_in; const float* ev_b_in; const float* f_bias;
  const float* conv_w; const float* conv_b; const float* m_hn; const float* q_norm; const float* k_norm;
  const float* ck_pos; const float* ck_w1; const float* ck_w2; const float* cv_pos; const float* cv_w1; const float* cv_w2;
  const float* ev_w_out; const float* od_w_in; const float* od_b_in; const float* lb_logits; const float* h_hn; const float* od_w_out;
  float* out; unsigned char* ws;
};

constexpr size_t MiB = 1048576;
constexpr size_t OFF_WIN0 = 0;
constexpr size_t OFF_WOUT0 = OFF_WIN0 + 4480ull * 1024 * 2;
constexpr size_t OFF_WIN1 = OFF_WOUT0 + 2 * MiB;
constexpr size_t OFF_WOUT1 = OFF_WIN1 + 8 * MiB;
constexpr size_t OFF_WCK = OFF_WOUT1 + 2 * MiB;
constexpr size_t OFF_WCV = OFF_WCK + 512 * 1024;
constexpr size_t OFF_ROPE = OFF_WCV + 512 * 1024;
constexpr size_t OFF_PB = OFF_ROPE + 512 * 1024;
constexpr size_t OFF_LB = OFF_PB + 1024;
constexpr size_t OFF_BAR = OFF_LB + 4096;
constexpr size_t OFF_BASE = 24 * MiB;
constexpr size_t L0_H = OFF_BASE;
constexpr size_t L0_QKRAW = L0_H + 32 * MiB;
constexpr size_t L0_QC = L0_QKRAW + 32 * MiB;
constexpr size_t L0_KC = L0_QC + 16 * MiB;
constexpr size_t L0_KCT = L0_KC + 16 * MiB;
constexpr size_t L0_MVT = L0_KCT + 16 * MiB;
constexpr size_t L0_MO = L0_MVT + 16 * MiB;
constexpr size_t L0_MZ = L0_MO + 16 * MiB;
constexpr size_t L0_QN = L0_MZ + 16 * MiB;
constexpr size_t L0_NZ = L0_QN + 16 * MiB;
constexpr size_t L0_KCRAW = L0_NZ + 16 * MiB;
constexpr size_t L0_VCRAW = L0_KCRAW + 4 * MiB;
constexpr size_t L0_KS = L0_VCRAW + 4 * MiB;
constexpr size_t L0_KW = L0_KS + 4 * MiB;
constexpr size_t L0_VST = L0_KW + 4 * MiB;
constexpr size_t L0_VWT = L0_VST + 4 * MiB;
constexpr size_t L0_HID = L0_VWT + 4 * MiB;
constexpr size_t L0_KCMP = L0_HID + 2 * MiB;
constexpr size_t L0_VCMPT = L0_KCMP + 256 * 1024;
constexpr size_t L0_IG = L0_VCMPT + 256 * 1024;
constexpr size_t L0_LOGF = L0_IG + 256 * 1024;
constexpr size_t L0_GATES = L0_LOGF + 256 * 1024;
constexpr size_t L0_DN = L0_GATES + 1536 * 1024;
constexpr size_t L0_BL = L0_DN + 256 * 1024;
constexpr size_t L0_MLOC = L0_BL + 4096;
constexpr size_t L0_MIN = L0_MLOC + 4096;
constexpr size_t L0_HIDP = L0_MIN + 4096;
constexpr size_t L0_END = L0_HIDP + 8 * MiB;
static_assert(L0_END <= 256 * MiB, "ws overflow L0");
constexpr size_t L1_H = OFF_BASE;
constexpr size_t L1_FP = L1_H + 32 * MiB;
constexpr size_t L1_Q = L1_FP + 32 * MiB;
constexpr size_t L1_VT = L1_Q + 32 * MiB;
constexpr size_t L1_Z = L1_VT + 32 * MiB;
constexpr size_t L1_ST = L1_Z + 32 * MiB;
constexpr size_t L1_BL = L1_ST + 64 * MiB;
constexpr size_t L1_END = L1_BL + 1 * MiB;
static_assert(L1_END <= 256 * MiB, "ws overflow L1");

DEVI int opaque_tid() { int t = threadIdx.x; asm volatile("" : "+v"(t)); return t; }
typedef __bf16 bf16v2_t __attribute__((ext_vector_type(2)));
typedef float f32v2_t __attribute__((ext_vector_type(2)));
DEVI bf16_t f2bf(float f) { __bf16 h = (__bf16)f; return __builtin_bit_cast(unsigned short, h); }
DEVI float bf2f(bf16_t b) { return __uint_as_float(((unsigned)b) << 16); }
DEVI unsigned pack2(float a, float b) { f32v2_t f = {a, b}; bf16v2_t h = __builtin_convertvector(f, bf16v2_t); return __builtin_bit_cast(unsigned, h); }
DEVI float lo2f(unsigned u) { return __uint_as_float(u << 16); }
DEVI float hi2f(unsigned u) { return __uint_as_float(u & 0xffff0000u); }
DEVI float sigm(float x) { return 1.f / (1.f + __expf(-x)); }
DEVI float siluf(float x) { return x * sigm(x); }
DEVI float wave_sum(float v) { for (int o = 32; o > 0; o >>= 1) v += __shfl_xor(v, o); return v; }
DEVI float grp16_sum(float v) { v += __shfl_xor(v, 1); v += __shfl_xor(v, 2); v += __shfl_xor(v, 4); v += __shfl_xor(v, 8); return v; }

DEVI void wave_scan_sum128(float& a, float& b, int lane) {
  float t = a + b;
  float s = t;
#pragma unroll
  for (int o = 1; o < 64; o <<= 1) { float u = __shfl_up(s, o); if (lane >= o) s += u; }
  const float excl = s - t;
  a = excl + a;
  b = a + b;
}
DEVI void wave_scan_max128(float& a, float& b, int lane) {
  float t = fmaxf(a, b);
  float s = t;
#pragma unroll
  for (int o = 1; o < 64; o <<= 1) { float u = __shfl_up(s, o); if (lane >= o) s = fmaxf(s, u); }
  float prev = __shfl_up(s, 1);
  if (lane == 0) prev = -3.0e38f;
  a = fmaxf(prev, a);
  b = fmaxf(a, b);
}
DEVI float wave_max(float v) { for (int o = 32; o > 0; o >>= 1) v = fmaxf(v, __shfl_xor(v, o)); return v; }
DEVI int oldcol(int n) {
  return n < 2560 ? n : (n < 3840 ? n + 8 : (n < 4352 ? n + 32 : (n < 4360 ? n - 4352 + 2560 : n - 4360 + 3848)));
}

template <int MT, int NTL, int KS>
DEVI void mma_lds(const bf16_t* sA, const bf16_t* sB, f32x4 (&acc)[MT][NTL], int lane, bool neg = false) {
  const int r = lane & 15, q = lane >> 4;
#pragma unroll
  for (int ks = 0; ks < KS; ++ks) {
    bf16x8 a[MT], b[NTL];
#pragma unroll
    for (int mt = 0; mt < MT; ++mt) a[mt] = *(const bf16x8*)(sA + (mt * 16 + r) * LDT + ks * 32 + q * 8);
    if (neg) {
#pragma unroll
      for (int mt = 0; mt < MT; ++mt) a[mt] ^= (short)0x8000;
    }
#pragma unroll
    for (int nt = 0; nt < NTL; ++nt) b[nt] = *(const bf16x8*)(sB + (nt * 16 + r) * LDT + ks * 32 + q * 8);
#pragma unroll
    for (int mt = 0; mt < MT; ++mt)
#pragma unroll
      for (int nt = 0; nt < NTL; ++nt) acc[mt][nt] = __builtin_amdgcn_mfma_f32_16x16x32_bf16(a[mt], b[nt], acc[mt][nt], 0, 0, 0);
  }
}
template <int MT, int NTL, int KS>
DEVI void mma_lds_sw(const bf16_t* sA, const bf16_t* sB, f32x4 (&acc)[MT][NTL], int lane, bool neg = false) {
  const int r = lane & 15, q = lane >> 4;
#pragma unroll
  for (int ks = 0; ks < KS; ++ks) {
    bf16x8 a[MT], b[NTL];
#pragma unroll
    for (int mt = 0; mt < MT; ++mt) a[mt] = *(const bf16x8*)(sA + (mt * 16 + r) * LDT + ks * 32 + q * 8);
    if (neg) {
#pragma unroll
      for (int mt = 0; mt < MT; ++mt) a[mt] ^= (short)0x8000;
    }
#pragma unroll
    for (int nt = 0; nt < NTL; ++nt) b[nt] = *(const bf16x8*)(sB + (nt * 16 + r) * LDT + ks * 32 + q * 8);
#pragma unroll
    for (int mt = 0; mt < MT; ++mt)
#pragma unroll
      for (int nt = 0; nt < NTL; ++nt) acc[mt][nt] = __builtin_amdgcn_mfma_f32_16x16x32_bf16(b[nt], a[mt], acc[mt][nt], 0, 0, 0);
  }
}


template <int MT, int NTL, bool SWAP>
DEVI void mma_swz(const bf16_t* sA, const bf16_t* sB, f32x4 (&acc)[MT][NTL], int lane, bool neg) {
  const int r = lane & 15, q = lane >> 4, r7 = r & 7;
#pragma unroll
  for (int ks = 0; ks < 2; ++ks) {
    bf16x8 a[MT], b[NTL];
    const int co = ((ks * 4 + q) ^ r7) * 8;
#pragma unroll
    for (int mt = 0; mt < MT; ++mt) a[mt] = *(const bf16x8*)(sA + (mt * 16 + r) * 64 + co);
#pragma unroll
    for (int nt = 0; nt < NTL; ++nt) b[nt] = *(const bf16x8*)(sB + (nt * 16 + r) * 64 + co);
    if (neg) {
#pragma unroll
      for (int mt = 0; mt < MT; ++mt) a[mt] ^= (short)0x8000;
    }
#pragma unroll
    for (int mt = 0; mt < MT; ++mt)
#pragma unroll
      for (int nt = 0; nt < NTL; ++nt) {
        if (SWAP) acc[mt][nt] = __builtin_amdgcn_mfma_f32_16x16x32_bf16(b[nt], a[mt], acc[mt][nt], 0, 0, 0);
        else acc[mt][nt] = __builtin_amdgcn_mfma_f32_16x16x32_bf16(a[mt], b[nt], acc[mt][nt], 0, 0, 0);
      }
  }
}

DEVI void load_tile128(bf16_t* s, const bf16_t* g, long ld) {
  const int tid = opaque_tid(), lr = tid >> 3, lk = (tid & 7) * 8;
#pragma unroll
  for (int j = 0; j < 4; ++j) *(uint4*)(s + (lr + 32 * j) * LDT + lk) = *(const uint4*)(g + (long)(lr + 32 * j) * ld + lk);
}
DEVI void load_tile64(bf16_t* s, const bf16_t* g, long ld) {
  const int tid = opaque_tid(), lr = tid >> 3, lk = (tid & 7) * 8;
#pragma unroll
  for (int j = 0; j < 2; ++j) *(uint4*)(s + (lr + 32 * j) * LDT + lk) = *(const uint4*)(g + (long)(lr + 32 * j) * ld + lk);
}

template <bool SWAP, class Epi>
DEVI void gemm128(const bf16_t* A, long lda, int amax, const bf16_t* B, long ldb, int bmax, int K, int m0, int n0,
                  bf16_t* sA, bf16_t* sB, Epi&& epi) {
  const int tid = opaque_tid(), lane = tid & 63, w = tid >> 6, wr = w >> 1, wc = w & 1;
  const int lr = tid >> 3, lk = (tid & 7) * 8;
  const int lsw = (((tid & 7) ^ (lr & 7)) * 8);
  f32x4 acc[4][4];
#pragma unroll
  for (int mt = 0; mt < 4; ++mt)
#pragma unroll
    for (int nt = 0; nt < 4; ++nt) acc[mt][nt] = f32x4{0.f, 0.f, 0.f, 0.f};
  const bf16_t* ap[4];
  const bf16_t* bp[4];
#pragma unroll
  for (int j = 0; j < 4; ++j) {
    int ra = min(m0 + lr + 32 * j, amax);
    ap[j] = A + (long)ra * lda + lk;
    int rb = min(n0 + lr + 32 * j, bmax);
    bp[j] = B + (long)rb * ldb + lk;
  }
#ifndef GEMM_PASSES
#define GEMM_PASSES 1
#endif
  for (int pass_ = 0; pass_ < GEMM_PASSES; ++pass_) {
  u32x4 va0, va1, va2, va3, vb0, vb1, vb2, vb3;
  va0 = *(const u32x4*)(ap[0]); va1 = *(const u32x4*)(ap[1]); va2 = *(const u32x4*)(ap[2]); va3 = *(const u32x4*)(ap[3]);
  vb0 = *(const u32x4*)(bp[0]); vb1 = *(const u32x4*)(bp[1]); vb2 = *(const u32x4*)(bp[2]); vb3 = *(const u32x4*)(bp[3]);
  const int KT = K >> 6;
  *(u32x4*)(sA + (lr + 0) * 64 + lsw) = va0; *(u32x4*)(sA + (lr + 32) * 64 + lsw) = va1;
  *(u32x4*)(sA + (lr + 64) * 64 + lsw) = va2; *(u32x4*)(sA + (lr + 96) * 64 + lsw) = va3;
  *(u32x4*)(sB + (lr + 0) * 64 + lsw) = vb0; *(u32x4*)(sB + (lr + 32) * 64 + lsw) = vb1;
  *(u32x4*)(sB + (lr + 64) * 64 + lsw) = vb2; *(u32x4*)(sB + (lr + 96) * 64 + lsw) = vb3;
  if (KT > 1) {
    va0 = *(const u32x4*)(ap[0] + 64); va1 = *(const u32x4*)(ap[1] + 64); va2 = *(const u32x4*)(ap[2] + 64); va3 = *(const u32x4*)(ap[3] + 64);
    vb0 = *(const u32x4*)(bp[0] + 64); vb1 = *(const u32x4*)(bp[1] + 64); vb2 = *(const u32x4*)(bp[2] + 64); vb3 = *(const u32x4*)(bp[3] + 64);
  }
  __syncthreads();
  for (int kt = 0; kt < KT; ++kt) {
    const int st = (kt & 1) * 16384;
    const int sn = ((kt + 1) & 1) * 16384;
    if (kt + 1 < KT) {
      *(u32x4*)(sA + sn + (lr + 0) * 64 + lsw) = va0; *(u32x4*)(sA + sn + (lr + 32) * 64 + lsw) = va1;
      *(u32x4*)(sA + sn + (lr + 64) * 64 + lsw) = va2; *(u32x4*)(sA + sn + (lr + 96) * 64 + lsw) = va3;
      *(u32x4*)(sB + sn + (lr + 0) * 64 + lsw) = vb0; *(u32x4*)(sB + sn + (lr + 32) * 64 + lsw) = vb1;
      *(u32x4*)(sB + sn + (lr + 64) * 64 + lsw) = vb2; *(u32x4*)(sB + sn + (lr + 96) * 64 + lsw) = vb3;
    }
    if (kt + 2 < KT) {
      const int ko = (kt + 2) * 64;
      va0 = *(const u32x4*)(ap[0] + ko); va1 = *(const u32x4*)(ap[1] + ko); va2 = *(const u32x4*)(ap[2] + ko); va3 = *(const u32x4*)(ap[3] + ko);
      vb0 = *(const u32x4*)(bp[0] + ko); vb1 = *(const u32x4*)(bp[1] + ko); vb2 = *(const u32x4*)(bp[2] + ko); vb3 = *(const u32x4*)(bp[3] + ko);
    }
    __builtin_amdgcn_sched_barrier(0);
    mma_swz<4, 4, SWAP>(sA + st + wr * 64 * 64, sB + st + wc * 64 * 64, acc, lane, (pass_ & 1) != 0);
    __syncthreads();
  }
  }
  epi(acc, m0 + wr * 64, n0 + wc * 64, lane);
}


DEVI bool gemm_tile_xcd(int bid, int G, int k, int NTN, int& tm, int& tn) {
  const int x = bid & 7, per = G >> 3;
  const int u = (bid >> 3) + per * k;
  const int full_groups = NTN >> 3, rem = NTN & 7;
  const int n_full = full_groups * 2 * 64;
  if (u < n_full) {
    const int sb = u >> 6, wi = u & 63;
    const int tg = sb >> 1, th = sb & 1;
    tm = x * 16 + th * 8 + (wi >> 3);
    tn = tg * 8 + (wi & 7);
    return true;
  }
  const int v = u - n_full;
  if (v >= 16 * rem) return false;
  tm = x * 16 + v / rem;
  tn = full_groups * 8 + v % rem;
  return true;
}

DEVI void transpose_tile(const float* src, int N, int ldsrc, bf16_t* dst, int K, int ktile, int ntile, bool perm, float* sT) {
  const int tid = opaque_tid();
  const int k0 = ktile * 64, n0 = ntile * 64;
#pragma unroll
  for (int j = 0; j < 4; ++j) {
    int idx = tid + 256 * j;
    int kk = idx >> 4, n4 = (idx & 15) * 4;
    int n = n0 + n4;
    float4 v = make_float4(0.f, 0.f, 0.f, 0.f);
    if (n < N) { int oc = perm ? oldcol(n) : n; v = *(const float4*)(src + (long)(k0 + kk) * ldsrc + oc); }
    sT[kk * 65 + n4 + 0] = v.x; sT[kk * 65 + n4 + 1] = v.y; sT[kk * 65 + n4 + 2] = v.z; sT[kk * 65 + n4 + 3] = v.w;
  }
  __syncthreads();
#pragma unroll
  for (int j = 0; j < 2; ++j) {
    int idx = tid + 256 * j;
    int nn = idx >> 3, kc = (idx & 7) * 8;
    if (n0 + nn < N) {
      uint4 o;
      o.x = pack2(sT[(kc + 0) * 65 + nn], sT[(kc + 1) * 65 + nn]);
      o.y = pack2(sT[(kc + 2) * 65 + nn], sT[(kc + 3) * 65 + nn]);
      o.z = pack2(sT[(kc + 4) * 65 + nn], sT[(kc + 5) * 65 + nn]);
      o.w = pack2(sT[(kc + 6) * 65 + nn], sT[(kc + 7) * 65 + nn]);
      *(uint4*)(dst + (long)(n0 + nn) * K + k0 + kc) = o;
    }
  }
  __syncthreads();
}

DEVI void rmsnorm_row2(const float* X, const float* w, bf16_t* H, int row0, int row1, int lane) {
  const float4* xa = (const float4*)(X + (long)row0 * 1024);
  const float4* xb = (const float4*)(X + (long)row1 * 1024);
  float4 va[4], vb[4], ww[4];
#pragma unroll
  for (int j = 0; j < 4; ++j) { va[j] = xa[lane + 64 * j]; vb[j] = xb[lane + 64 * j]; ww[j] = ((const float4*)w)[lane + 64 * j]; }
  float sa = 0.f, sb = 0.f;
#pragma unroll
  for (int j = 0; j < 4; ++j) {
    sa += va[j].x * va[j].x + va[j].y * va[j].y + va[j].z * va[j].z + va[j].w * va[j].w;
    sb += vb[j].x * vb[j].x + vb[j].y * vb[j].y + vb[j].z * vb[j].z + vb[j].w * vb[j].w;
  }
  sa = wave_sum(sa); sb = wave_sum(sb);
  const float ra = rsqrtf(sa * (1.f / 1024.f) + EPSF), rb = rsqrtf(sb * (1.f / 1024.f) + EPSF);
#pragma unroll
  for (int j = 0; j < 4; ++j) {
    uint2 o;
    o.x = pack2(va[j].x * ra * ww[j].x, va[j].y * ra * ww[j].y);
    o.y = pack2(va[j].z * ra * ww[j].z, va[j].w * ra * ww[j].w);
    *(uint2*)(H + (long)row0 * 1024 + (lane + 64 * j) * 4) = o;
    o.x = pack2(vb[j].x * rb * ww[j].x, vb[j].y * rb * ww[j].y);
    o.y = pack2(vb[j].z * rb * ww[j].z, vb[j].w * rb * ww[j].w);
    *(uint2*)(H + (long)row1 * 1024 + (lane + 64 * j) * 4) = o;
  }
}

DEVI void phase0(const Params& p, unsigned char* smem) {
  const int G = gridDim.x, bid = blockIdx.x, tid = threadIdx.x, lane = tid & 63, w = tid >> 6;
  unsigned char* ws = p.ws;
  float* sT = (float*)smem;
  for (int it = bid; it < 69 * 16; it += G) transpose_tile(p.ev_w_in, 4384, 4384, (bf16_t*)(ws + OFF_WIN0), 1024, it / 69, it % 69, true, sT);
  for (int it = bid; it < 16 * 16; it += G) transpose_tile(p.ev_w_out, 1024, 1024, (bf16_t*)(ws + OFF_WOUT0), 1024, it / 16, it % 16, false, sT);
  for (int it = bid; it < 64 * 16; it += G) transpose_tile(p.od_w_in, 4096, 4096, (bf16_t*)(ws + OFF_WIN1), 1024, it / 64, it % 64, false, sT);
  for (int it = bid; it < 16 * 16; it += G) transpose_tile(p.od_w_out, 1024, 1024, (bf16_t*)(ws + OFF_WOUT1), 1024, it / 16, it % 16, false, sT);
  for (int it = bid; it < 2 * 32; it += G) transpose_tile(p.ck_w1, 128, 128, (bf16_t*)(ws + OFF_WCK), 2048, it / 2, it % 2, false, sT);
  for (int it = bid; it < 2 * 32; it += G) transpose_tile(p.cv_w1, 128, 128, (bf16_t*)(ws + OFF_WCV), 2048, it / 2, it % 2, false, sT);
  for (int row = (bid * 4 + w) * 2; row < 16384; row += G * 8) rmsnorm_row2(p.x, p.norm_w, (bf16_t*)(ws + L0_H), row, row + 1, lane);
  for (int idx = bid * 256 + tid; idx < 8192 * 8; idx += G * 256) {
    int t = idx >> 3, i = idx & 7;
    float invf = powf(500000.0f, -(float)i / 8.0f);
    float ang = (float)t * invf;
    double a = (double)ang;
    float2 cs;
    cs.x = (float)cos(a);
    cs.y = (float)sin(a);
    ((float2*)(ws + OFF_ROPE))[idx] = cs;
  }
  for (int o = bid * 4 + w; o < 256; o += G * 4) {
    int kv = o >> 7, j = o & 127;
    const float* pos = kv ? p.cv_pos : p.ck_pos;
    const float* w1 = kv ? p.cv_w1 : p.ck_w1;
    float sacc_ = 0.f;
#pragma unroll 8
    for (int i = lane; i < 2048; i += 64) sacc_ += pos[i] * w1[i * 128 + j];
    sacc_ = wave_sum(sacc_);
    if (lane == 0) ((float*)(ws + OFF_PB))[o] = sacc_;
  }
  if (bid == G - 2 || G < 2) {
    for (int c = tid; c < 1024; c += 256) {
      float l0 = p.lb_logits[c], l1 = p.lb_logits[1024 + c];
      ((float*)(ws + OFF_LB))[c] = 1.f / (1.f + expf(l1 - l0));
    }
  }
}

template <int MODE>
DEVI void store_rm(bf16_t* dst, int ld, int colbase, f32x4 (&acc)[4][4], const float* bias, int mb, int lane) {
  const int r = lane & 15, q = lane >> 4;
#pragma unroll
  for (int mt = 0; mt < 4; ++mt)
#pragma unroll
    for (int i = 0; i < 4; ++i) {
      long row = mb + mt * 16 + q * 4 + i;
#pragma unroll
      for (int nt = 0; nt < 4; ++nt) {
        float v = acc[mt][nt][i] + bias[nt];
        if (MODE == 1) v = sigm(v);
        if (MODE == 2) v = siluf(v);
        dst[row * ld + colbase + nt * 16 + r] = f2bf(v);
      }
    }
}
template <int MODE>
DEVI void store_T(bf16_t* dst, int bgrp, int F, int featoff, f32x4 (&acc)[4][4], const float* bias, int tl0, int lane) {
  const int r = lane & 15, q = lane >> 4;
#pragma unroll
  for (int mt = 0; mt < 4; ++mt)
#pragma unroll
    for (int nt = 0; nt < 4; ++nt) {
      int t = tl0 + mt * 16 + q * 4;
      float b = bias[nt];
      uint2 o;
      o.x = pack2(acc[mt][nt][0] + b, acc[mt][nt][1] + b);
      o.y = pack2(acc[mt][nt][2] + b, acc[mt][nt][3] + b);
      *(uint2*)(dst + (((long)bgrp * 128 + (t >> 6)) * F + featoff + nt * 16 + r) * 64 + (t & 63)) = o;
    }
}
DEVI void norm_rope_store(bf16_t* dst, long rowbase, int ld, int colbase, f32x4 (&acc)[4][4], const float* bias, const float* nw,
                          float scale, const float2* rope, int mb, int lane) {
  const int r = lane & 15, q = lane >> 4;
  float wv[4];
#pragma unroll
  for (int nt = 0; nt < 4; ++nt) wv[nt] = nw[nt * 16 + r];
  float2 csv[4][4];
#pragma unroll
  for (int mt = 0; mt < 4; ++mt)
#pragma unroll
    for (int i = 0; i < 4; ++i) csv[mt][i] = rope[((mb + mt * 16 + q * 4 + i) & 8191) * 8 + (r & 7)];
#pragma unroll
  for (int mt = 0; mt < 4; ++mt)
#pragma unroll
    for (int i = 0; i < 4; ++i) {
      int row = mb + mt * 16 + q * 4 + i;
      int t = row & 8191;
      float v[4];
      float ss = 0.f;
#pragma unroll
      for (int nt = 0; nt < 4; ++nt) { v[nt] = acc[mt][nt][i] + bias[nt]; ss += v[nt] * v[nt]; }
      ss = grp16_sum(ss);
      float rinv = rsqrtf(ss * (1.f / 64.f) + EPSF);
#pragma unroll
      for (int nt = 0; nt < 4; ++nt) v[nt] = v[nt] * rinv * wv[nt];
      float partner = __shfl_xor(v[0], 8);
      float2 cs = csv[mt][i];
      float x1 = (r < 8) ? v[0] : partner, x2 = (r < 8) ? partner : v[0];
      v[0] = (r < 8) ? (x1 * cs.x - x2 * cs.y) : (x1 * cs.y + x2 * cs.x);
#pragma unroll
      for (int nt = 0; nt < 4; ++nt) dst[(rowbase + t) * ld + colbase + nt * 16 + r] = f2bf(v[nt] * scale);
    }
}

DEVI void epi_proj0(const Params& p, f32x4 (&acc)[4][4], int mb, int nb, int lane) {
  if (nb >= 4384) return;
  unsigned char* ws = p.ws;
  const int r = lane & 15, q = lane >> 4;
  float bias[4];
#pragma unroll
  for (int nt = 0; nt < 4; ++nt) { int n = nb + nt * 16 + r; bias[nt] = (n < 4384) ? p.ev_b_in[oldcol(n)] : 0.f; }
  const int b = mb >> 13;
  const int tl0 = mb & 8191;
  const float2* rope = (const float2*)(ws + OFF_ROPE);
  if (nb < 1024) {
    store_rm<0>((bf16_t*)(ws + L0_QKRAW), 1024, nb, acc, bias, mb, lane);
  } else if (nb < 1536) {
    store_T<0>((bf16_t*)(ws + L0_MVT), b * 4 + ((nb - 1024) >> 7), 128, (nb - 1024) & 127, acc, bias, tl0, lane);
  } else if (nb < 2048) {
    store_rm<1>((bf16_t*)(ws + L0_MO), 512, nb - 1536, acc, bias, mb, lane);
  } else if (nb < 2560) {
    store_rm<2>((bf16_t*)(ws + L0_MZ), 512, nb - 2048, acc, bias, mb, lane);
  } else if (nb < 3072) {
    int head = (nb - 2560) >> 6, g = head >> 2, rr = head & 3;
    norm_rope_store((bf16_t*)(ws + L0_QN), (long)(b * 2 + g) * 8192, 256, rr * 64, acc, bias, p.q_norm, 0.125f * 1.4426950408889634f, rope, mb, lane);
  } else if (nb < 3328) {
    int g = ((nb - 3072) >> 6) & 1;
    bf16_t* dst = (bf16_t*)(ws + (nb < 3200 ? L0_KCRAW : L0_VCRAW));
    const long rowbase = (long)(b * 2 + g) * 8192;
#pragma unroll
    for (int mt = 0; mt < 4; ++mt)
#pragma unroll
      for (int i = 0; i < 4; ++i) {
        int t = (mb + mt * 16 + q * 4 + i) & 8191;
#pragma unroll
        for (int nt = 0; nt < 4; ++nt) dst[(rowbase + t) * 64 + nt * 16 + r] = f2bf(acc[mt][nt][i] + bias[nt]);
      }
  } else if (nb < 3456) {
    int g = (nb - 3328) >> 6;
    norm_rope_store((bf16_t*)(ws + L0_KS), (long)(b * 2 + g) * 8192, 64, 0, acc, bias, p.k_norm + 64, 1.f, rope, mb, lane);
  } else if (nb < 3584) {
    store_T<0>((bf16_t*)(ws + L0_VST), b * 2 + ((nb - 3456) >> 6), 64, 0, acc, bias, tl0, lane);
  } else if (nb < 3712) {
    int g = (nb - 3584) >> 6;
    norm_rope_store((bf16_t*)(ws + L0_KW), (long)(b * 2 + g) * 8192, 64, 0, acc, bias, p.k_norm + 128, 1.f, rope, mb, lane);
  } else if (nb < 3840) {
    store_T<0>((bf16_t*)(ws + L0_VWT), b * 2 + ((nb - 3712) >> 6), 64, 0, acc, bias, tl0, lane);
  } else if (nb < 4352) {
    store_rm<2>((bf16_t*)(ws + L0_NZ), 512, nb - 3840, acc, bias, mb, lane);
  } else {
    float* IG = (float*)(ws + L0_IG);
    float* LF = (float*)(ws + L0_LOGF);
    float* GT = (float*)(ws + L0_GATES);
#pragma unroll
    for (int mt = 0; mt < 4; ++mt)
#pragma unroll
      for (int i = 0; i < 4; ++i) {
        long row = mb + mt * 16 + q * 4 + i;
#pragma unroll
        for (int nt = 0; nt < 2; ++nt) {
          int c = nt * 16 + r;
          float v = acc[mt][nt][i] + bias[nt];
          if (c < 4) IG[row * 4 + c] = v;
          else if (c < 8) { float xx = v + p.f_bias[c - 4]; LF[row * 4 + c - 4] = fminf(xx, 0.f) - log1pf(__expf(-fabsf(xx))); }
          else GT[row * 24 + c - 8] = sigm(v);
        }
      }
  }
}

DEVI void epi_cmp_hidden(const Params& p, f32x4 (&acc)[4][4], int mb, int nb, int lane, int kv, int bg, int ksp) {
  const int r = lane & 15, q = lane >> 4;
  float* hid = (float*)(p.ws + L0_HIDP) + ((long)((ksp * 2 + kv) * 4 + bg) * 512) * 128;
#pragma unroll
  for (int mt = 0; mt < 4; ++mt)
#pragma unroll
    for (int i = 0; i < 4; ++i) {
      int row = mb + mt * 16 + q * 4 + i;
#pragma unroll
      for (int nt = 0; nt < 4; ++nt) hid[(long)row * 128 + nb + nt * 16 + r] = acc[mt][nt][i];
    }
}

DEVI void epi_out_resid(const float* resid, float* out, f32x4 (&acc)[4][4], int mb, int nb, int lane) {
  const int r = lane & 15, q = lane >> 4;
#pragma unroll
  for (int mt = 0; mt < 4; ++mt) {
    float rv[4][4];
#pragma unroll
    for (int i = 0; i < 4; ++i)
#pragma unroll
      for (int nt = 0; nt < 4; ++nt) rv[i][nt] = resid[(long)(mb + mt * 16 + q * 4 + i) * 1024 + nb + nt * 16 + r];
#pragma unroll
    for (int i = 0; i < 4; ++i)
#pragma unroll
      for (int nt = 0; nt < 4; ++nt) out[(long)(mb + mt * 16 + q * 4 + i) * 1024 + nb + nt * 16 + r] = rv[i][nt] + acc[mt][nt][i];
  }
}

DEVI void epi_proj1(const Params& p, f32x4 (&acc)[4][4], int mb, int nb, int lane) {
  unsigned char* ws = p.ws;
  const int r = lane & 15;
  float bias[4];
#pragma unroll
  for (int nt = 0; nt < 4; ++nt) bias[nt] = p.od_b_in[nb + nt * 16 + r];
  const int b = mb >> 13, tl0 = mb & 8191;
  if (nb < 1024) store_rm<0>((bf16_t*)(ws + L1_FP), 1024, nb, acc, bias, mb, lane);
  else if (nb < 2048) store_T<0>((bf16_t*)(ws + L1_VT), b * 8 + ((nb - 1024) >> 7), 128, (nb - 1024) & 127, acc, bias, tl0, lane);
  else if (nb < 3072) store_rm<2>((bf16_t*)(ws + L1_Q), 1024, nb - 2048, acc, bias, mb, lane);
  else store_rm<2>((bf16_t*)(ws + L1_Z), 1024, nb - 3072, acc, bias, mb, lane);
}

DEVI void conv_tile(const Params& p, int item, unsigned char* smem) {
  const int tid = opaque_tid();
  const int ctile = item & 7, ttile = item >> 3;
  const int t0g = ttile * 64;
  const int b = t0g >> 13, tl0 = t0g & 8191;
  unsigned char* ws = p.ws;
  float* sRaw = (float*)smem;
  bf16_t* sOutT = (bf16_t*)(smem + 67 * 128 * 4);
  const bf16_t* raw = (const bf16_t*)(ws + L0_QKRAW);
  for (int idx = tid; idx < 67 * 16; idx += 256) {
    int rr = idx >> 4, ch = (idx & 15) * 8;
    int tl = tl0 + rr - 3;
    uint4 v = make_uint4(0, 0, 0, 0);
    if (tl >= 0) v = *(const uint4*)(raw + (long)(b * 8192 + tl) * 1024 + ctile * 128 + ch);
    float* d = sRaw + rr * 128 + ch;
    d[0] = lo2f(v.x); d[1] = hi2f(v.x); d[2] = lo2f(v.y); d[3] = hi2f(v.y);
    d[4] = lo2f(v.z); d[5] = hi2f(v.z); d[6] = lo2f(v.w); d[7] = hi2f(v.w);
  }
  __syncthreads();
  const int c = tid & 127, th = tid >> 7;
  const int cg_ = ctile * 128 + c;
  const float w0 = p.conv_w[cg_], w1 = p.conv_w[1024 + cg_], w2 = p.conv_w[2048 + cg_], w3 = p.conv_w[3072 + cg_];
  const float cb = p.conv_b[cg_];
  const bool isk = ctile >= 4;
  bf16_t* dst = (bf16_t*)(ws + (isk ? L0_KC : L0_QC));
  const int cc = isk ? cg_ - 512 : cg_;
  const float sc = isk ? 0.08838834764831845f : 1.f;
  for (int t = th * 32; t < th * 32 + 32; ++t) {
    float a = cb + w0 * sRaw[t * 128 + c] + w1 * sRaw[(t + 1) * 128 + c] + w2 * sRaw[(t + 2) * 128 + c] + w3 * sRaw[(t + 3) * 128 + c];
    bf16_t o = f2bf(siluf(a) * sc);
    dst[(long)(t0g + t) * 512 + cc] = o;
    sOutT[c * LDT + t] = o;
  }
  __syncthreads();
  if (isk) {
    bf16_t* kct = (bf16_t*)(ws + L0_KCT);
#pragma unroll
    for (int j = 0; j < 4; ++j) {
      int idx = tid + 256 * j;
      int cr = idx >> 3, tc = (idx & 7) * 8;
      *(uint4*)(kct + ((((long)(b * 4 + (ctile - 4)) * 128 + (tl0 >> 6)) * 128 + cr) * 64) + tc) = *(const uint4*)(sOutT + cr * LDT + tc);
    }
  }
  __syncthreads();
}

DEVI void cmp_finalize(const Params& p, int task, int lane) {
  const int n = task & 511, bg = (task >> 9) & 3, kv = task >> 11;
  unsigned char* ws = p.ws;
  bf16_t* KCMP = (bf16_t*)(ws + L0_KCMP);
  bf16_t* VCMPT = (bf16_t*)(ws + L0_VCMPT);
  if (n == 511) {
    if (kv == 0) KCMP[((long)bg * 512 + 511) * 64 + lane] = 0;
    else VCMPT[((long)bg * 64 + lane) * 512 + 511] = 0;
    return;
  }
  const float* hid = (const float*)(ws + L0_HIDP) + ((long)(kv * 4 + bg) * 512 + n) * 128;
  const float* pbv = (const float*)(ws + OFF_PB) + kv * 128;
  const float* w2 = kv ? p.cv_w2 : p.ck_w2;
  float g0, g1;
  {
    float x0 = ((hid[lane] + hid[lane + 524288]) + (hid[lane + 2 * 524288] + hid[lane + 3 * 524288])) + pbv[lane];
    float x1 = ((hid[lane + 64] + hid[lane + 64 + 524288]) + (hid[lane + 64 + 2 * 524288] + hid[lane + 64 + 3 * 524288])) + pbv[lane + 64];
    g0 = 0.5f * x0 * (1.f + tanhf(0.7978845608028654f * (x0 + 0.044715f * x0 * x0 * x0)));
    g1 = 0.5f * x1 * (1.f + tanhf(0.7978845608028654f * (x1 + 0.044715f * x1 * x1 * x1)));
  }
  float a = 0.f;
  for (int j0 = 0; j0 < 64; j0 += 16) {
    float wv[16], wu[16];
#pragma unroll
    for (int k = 0; k < 16; ++k) { wv[k] = w2[(j0 + k) * 64 + lane]; wu[k] = w2[(64 + j0 + k) * 64 + lane]; }
#pragma unroll
    for (int k = 0; k < 16; ++k) a += __shfl(g0, j0 + k) * wv[k] + __shfl(g1, j0 + k) * wu[k];
  }
  if (kv == 0) {
    float ss = wave_sum(a * a);
    float rinv = rsqrtf(ss * (1.f / 64.f) + EPSF);
    float v = a * rinv * p.k_norm[lane];
    float partner = __shfl_xor(v, 8);
    int pos = 16 * n + 31;
    float2 cs = ((const float2*)(ws + OFF_ROPE))[pos * 8 + (lane & 7)];
    float o = v;
    if (lane < 8) o = v * cs.x - partner * cs.y;
    else if (lane < 16) o = partner * cs.y + v * cs.x;
    KCMP[((long)bg * 512 + n) * 64 + lane] = f2bf(o);
  } else {
    VCMPT[((long)bg * 64 + lane) * 512 + n] = f2bf(a);
  }
}

DEVI void mlstm_local(const Params& p, int unit, unsigned char* smem) {
  const int tid = opaque_tid(), lane = tid & 63, w = tid >> 6, wr = w >> 1, wc = w & 1;
  const int bh = unit >> 6, c = unit & 63, b = bh >> 2, h = bh & 3, t0 = c * 128;
  const long R0 = (long)b * 8192 + t0;
  unsigned char* ws = p.ws;
  bf16_t* sA = (bf16_t*)smem;
  bf16_t* sB = (bf16_t*)(smem + 18432);
  float* sIg = (float*)(smem + 36864);
  float* sLf = sIg + 128;
  float* sW = sLf + 128;
  const float* IG = (const float*)(ws + L0_IG);
  const float* LF = (const float*)(ws + L0_LOGF);
  if (tid < 128) { sIg[tid] = IG[(R0 + tid) * 4 + h]; sLf[tid] = LF[(R0 + tid) * 4 + h]; }
  __syncthreads();
  if (tid < 64) {
    float c0 = sLf[2 * tid], c1 = sLf[2 * tid + 1];
    wave_scan_sum128(c0, c1, tid);
    const float bL = __shfl(c1, 63);
    float d0 = bL - c0 + sIg[2 * tid], d1 = bL - c1 + sIg[2 * tid + 1];
    const float ml = wave_max(fmaxf(d0, d1));
    sW[2 * tid] = __expf(d0 - ml); sW[2 * tid + 1] = __expf(d1 - ml);
    if (tid == 0) { ((float*)(ws + L0_BL))[unit] = bL; ((float*)(ws + L0_MLOC))[unit] = ml; }
  }
  __syncthreads();
  f32x4 acc[4][4];
#pragma unroll
  for (int mt = 0; mt < 4; ++mt)
#pragma unroll
    for (int nt = 0; nt < 4; ++nt) acc[mt][nt] = f32x4{0.f, 0.f, 0.f, 0.f};
  float dn = 0.f;
  const bf16_t* vt = (const bf16_t*)(ws + L0_MVT) + (((long)(b * 4 + h) * 128 + (t0 >> 6)) * 128) * 64;
  const bf16_t* kt_ = (const bf16_t*)(ws + L0_KCT) + (((long)(b * 4 + h) * 128 + (t0 >> 6)) * 128) * 64;
  const int lr = tid >> 3, lk = (tid & 7) * 8;
  for (int kt = 0; kt < 2; ++kt) {
    load_tile128(sA, vt + kt * 8192, 64);
#pragma unroll
    for (int j = 0; j < 4; ++j) {
      uint4 v = *(const uint4*)(kt_ + (long)kt * 8192 + (lr + 32 * j) * 64 + lk);
      const float* ww = sW + kt * 64 + lk;
      uint4 o;
      o.x = pack2(lo2f(v.x) * ww[0], hi2f(v.x) * ww[1]);
      o.y = pack2(lo2f(v.y) * ww[2], hi2f(v.y) * ww[3]);
      o.z = pack2(lo2f(v.z) * ww[4], hi2f(v.z) * ww[5]);
      o.w = pack2(lo2f(v.w) * ww[6], hi2f(v.w) * ww[7]);
      *(uint4*)(sB + (lr + 32 * j) * LDT + lk) = o;
    }
    __syncthreads();
    if (tid < 128) {
#pragma unroll 8
      for (int s = 0; s < 64; ++s) dn += bf2f(sB[tid * LDT + s]);
    }
    mma_lds<4, 4, 2>(sA + wr * 64 * LDT, sB + wc * 64 * LDT, acc, lane);
    __syncthreads();
  }
  float* dct = (float*)(ws + L0_H) + (long)unit * 16384;
  const int r = lane & 15, q = lane >> 4;
#pragma unroll
  for (int mt = 0; mt < 4; ++mt)
#pragma unroll
    for (int i = 0; i < 4; ++i) {
      int e = wr * 64 + mt * 16 + q * 4 + i;
#pragma unroll
      for (int nt = 0; nt < 4; ++nt) dct[e * 128 + wc * 64 + nt * 16 + r] = acc[mt][nt][i];
    }
  if (tid < 128) ((float*)(ws + L0_DN))[unit * 128 + tid] = dn;
}

template <bool DUMMY>
DEVI void mlstm_scan(const Params& p, unsigned char* smem) {
  unsigned char* ws = p.ws;
  const float* BL = (const float*)(ws + L0_BL);
  const float* ML = (const float*)(ws + L0_MLOC);
  float* MIN_ = (float*)(ws + L0_MIN);
  float* sDec = (float*)smem;
  float* sWn = sDec + 128;
  const int tid = opaque_tid();
  const int total = 8 * 16384 + 8 * 128;
  for (int base = blockIdx.x * 256; base < total; base += gridDim.x * 256) {
    const int bh0 = (base < 131072) ? (base >> 14) : ((base - 131072) >> 7);
    __syncthreads();
    if (tid < 2) {
      const int bh = bh0 + tid;
      if (bh < 8) {
        float m = 0.f;
        for (int c = 0; c < 64; ++c) {
          const int unit = bh * 64 + c;
          const float bL = BL[unit], ml = ML[unit];
          if (!DUMMY && base < 131072 && (base & 16383) == 0 && tid == 0) MIN_[unit] = m;
          const float mn = fmaxf(bL + m, ml);
          sDec[tid * 64 + c] = __expf(bL + m - mn);
          sWn[tid * 64 + c] = __expf(ml - mn);
          m = mn;
        }
      }
    }
    __syncthreads();
    const int idx = base + tid;
    if (idx < total) {
      float* ptr; long stride; int sel;
      if (idx < 131072) { const int bh = idx >> 14; ptr = (float*)(ws + L0_H) + (long)bh * 64 * 16384 + (idx & 16383); stride = 16384; sel = bh - bh0; }
      else { const int j = idx - 131072; const int bh = j >> 7; ptr = (float*)(ws + L0_DN) + (long)bh * 64 * 128 + (j & 127); stride = 128; sel = bh - bh0; }
      const float* dec = sDec + sel * 64;
      const float* wn = sWn + sel * 64;
      float C = 0.f;
      for (int c0 = 0; c0 < 64; c0 += 8) {
        float dv[8];
#pragma unroll
        for (int k = 0; k < 8; ++k) dv[k] = ptr[(long)(c0 + k) * stride];
#pragma unroll
        for (int k = 0; k < 8; ++k) {
          if (!DUMMY) ptr[(long)(c0 + k) * stride] = C;
          C = dec[c0 + k] * C + wn[c0 + k] * dv[k];
        }
      }
      if (DUMMY && C == 123.456f) MIN_[0] = C;
    }
  }
}

DEVI void mlstm_out(const Params& p, int item, unsigned char* smem) {
  const int tid = opaque_tid(), lane = tid & 63, w = tid >> 6, wr = w >> 1, wc = w & 1;
  const int r = lane & 15, q = lane >> 4;
  const int unit = item >> 1, u = item & 1;
  const int bh = unit >> 6, c = unit & 63, b = bh >> 2, h = bh & 3, t0 = c * 128;
  const long R0 = (long)b * 8192 + t0;
  const int J0 = u * 64;
  unsigned char* ws = p.ws;
  bf16_t* sA = (bf16_t*)smem;
  bf16_t* sB = (bf16_t*)(smem + 9216);
  bf16_t* sS0 = (bf16_t*)(smem + 27648);
  bf16_t* sS1 = (bf16_t*)(smem + 36864);
  float* fl = (float*)(smem + 46080);
  float* sIg = fl; float* sLf = fl + 128; float* sRj = fl + 256; float* sCs = fl + 384; float* sWi = fl + 512;
  float* sEm = fl + 640; float* sQn = fl + 768; float* sNin = fl + 896; float* sDen = fl + 1024; float* sSs = fl + 1280;
  const float* IG = (const float*)(ws + L0_IG);
  const float* LF = (const float*)(ws + L0_LOGF);
  const bf16_t* QC = (const bf16_t*)(ws + L0_QC) + (R0 + J0) * 512 + h * 128;
  const bf16_t* KC = (const bf16_t*)(ws + L0_KC) + R0 * 512 + h * 128;
  if (tid < 128) { sIg[tid] = IG[(R0 + tid) * 4 + h]; sLf[tid] = LF[(R0 + tid) * 4 + h]; sNin[tid] = ((const float*)(ws + L0_DN))[unit * 128 + tid]; }
  const float m_in = ((const float*)(ws + L0_MIN))[unit];
  __syncthreads();
  if (tid < 64) {
    float c0 = sLf[2 * tid], c1 = sLf[2 * tid + 1];
    wave_scan_sum128(c0, c1, tid);
    const float a0 = sIg[2 * tid] - c0, a1 = sIg[2 * tid + 1] - c1;
    float x0 = a0, x1 = a1;
    wave_scan_max128(x0, x1, tid);
    const float mx0 = fmaxf(x0, m_in), mx1 = fmaxf(x1, m_in);
    sCs[2 * tid] = a0; sCs[2 * tid + 1] = a1;
    sRj[2 * tid] = -mx0; sRj[2 * tid + 1] = -mx1;
    sWi[2 * tid] = __expf(m_in - mx0); sWi[2 * tid + 1] = __expf(m_in - mx1);
    sEm[2 * tid] = __expf(-(c0 + mx0)); sEm[2 * tid + 1] = __expf(-(c1 + mx1));
  }
  if (tid >= 128 && tid < 192) {
    int jl = tid - 128;
    const bf16_t* qr = QC + (long)jl * 512;
    float s = 0.f;
#pragma unroll 2
    for (int ch = 0; ch < 16; ++ch) {
      uint4 v = *(const uint4*)(qr + ch * 8);
      const float* nn = sNin + ch * 8;
      s += lo2f(v.x) * nn[0] + hi2f(v.x) * nn[1] + lo2f(v.y) * nn[2] + hi2f(v.y) * nn[3] + lo2f(v.z) * nn[4] + hi2f(v.z) * nn[5] + lo2f(v.w) * nn[6] + hi2f(v.w) * nn[7];
    }
    sQn[jl] = s;
  }
  __syncthreads();
  f32x4 acc[2][4];
#pragma unroll
  for (int mt = 0; mt < 2; ++mt)
#pragma unroll
    for (int nt = 0; nt < 4; ++nt) acc[mt][nt] = f32x4{0.f, 0.f, 0.f, 0.f};
  const bool skipS = (wc > u);
  const int lr = tid >> 3, lk = (tid & 7) * 8;
  {
    u32x4 qa0, qa1, kb0, kb1, kb2, kb3;
    qa0 = *(const u32x4*)(QC + (long)lr * 512 + lk); qa1 = *(const u32x4*)(QC + (long)(lr + 32) * 512 + lk);
    kb0 = *(const u32x4*)(KC + (long)lr * 512 + lk); kb1 = *(const u32x4*)(KC + (long)(lr + 32) * 512 + lk);
    kb2 = *(const u32x4*)(KC + (long)(lr + 64) * 512 + lk); kb3 = *(const u32x4*)(KC + (long)(lr + 96) * 512 + lk);
#pragma unroll 1
    for (int kt = 0; kt < 2; ++kt) {
      *(u32x4*)(sA + lr * LDT + lk) = qa0; *(u32x4*)(sA + (lr + 32) * LDT + lk) = qa1;
      *(u32x4*)(sB + lr * LDT + lk) = kb0; *(u32x4*)(sB + (lr + 32) * LDT + lk) = kb1;
      *(u32x4*)(sB + (lr + 64) * LDT + lk) = kb2; *(u32x4*)(sB + (lr + 96) * LDT + lk) = kb3;
      __syncthreads();
      if (kt == 0) {
        qa0 = *(const u32x4*)(QC + (long)lr * 512 + 64 + lk); qa1 = *(const u32x4*)(QC + (long)(lr + 32) * 512 + 64 + lk);
        kb0 = *(const u32x4*)(KC + (long)lr * 512 + 64 + lk); kb1 = *(const u32x4*)(KC + (long)(lr + 32) * 512 + 64 + lk);
        kb2 = *(const u32x4*)(KC + (long)(lr + 64) * 512 + 64 + lk); kb3 = *(const u32x4*)(KC + (long)(lr + 96) * 512 + 64 + lk);
      }
      if (!skipS) mma_lds<2, 4, 2>(sA + wr * 32 * LDT, sB + wc * 64 * LDT, acc, lane);
      __syncthreads();
    }
  }
  {
    bf16_t* sS = wc ? sS1 : sS0;
#pragma unroll
    for (int mt = 0; mt < 2; ++mt)
#pragma unroll
      for (int i = 0; i < 4; ++i) {
        int jl = wr * 32 + mt * 16 + q * 4 + i;
        int j = J0 + jl;
        float rj = sRj[j], rs = 0.f;
#pragma unroll
        for (int nt = 0; nt < 4; ++nt) {
          int sl = nt * 16 + r, s = wc * 64 + sl;
          float val = (s <= j) ? acc[mt][nt][i] * __expf(rj + sCs[s]) : 0.f;
          rs += val;
          sS[jl * LDT + sl] = f2bf(val);
        }
        rs = grp16_sum(rs);
        if (r == 0) sDen[wc * 64 + jl] = rs;
      }
  }
#pragma unroll
  for (int mt = 0; mt < 2; ++mt)
#pragma unroll
    for (int nt = 0; nt < 4; ++nt) acc[mt][nt] = f32x4{0.f, 0.f, 0.f, 0.f};
  const bf16_t* vt = (const bf16_t*)(ws + L0_MVT) + (((long)(b * 4 + h) * 128 + (t0 >> 6)) * 128) * 64;
  const float* ct = (const float*)(ws + L0_H) + (long)unit * 16384;
  {
    u32x4 vb0, vb1, vb2, vb3;
    u32x4 qa0, qa1;
    float4 cv[8];
    const int nsteps = u ? 4 : 3;
    auto kind_of = [&](int sidx) { return u ? sidx : (sidx == 0 ? 0 : sidx + 1); };
    auto fetch = [&](int kind) {
      if (kind < 2) {
        const bf16_t* vp = vt + (long)kind * 8192 + lr * 64 + lk;
        vb0 = *(const u32x4*)vp; vb1 = *(const u32x4*)(vp + 32 * 64); vb2 = *(const u32x4*)(vp + 64 * 64); vb3 = *(const u32x4*)(vp + 96 * 64);
      } else {
        const int k2 = kind - 2;
        qa0 = *(const u32x4*)(QC + (long)lr * 512 + k2 * 64 + lk); qa1 = *(const u32x4*)(QC + (long)(lr + 32) * 512 + k2 * 64 + lk);
#pragma unroll
        for (int j = 0; j < 8; ++j) cv[j] = *(const float4*)(ct + (long)((tid >> 4) + 16 * j) * 128 + k2 * 64 + (tid & 15) * 4);
      }
    };
    fetch(0);
#pragma unroll 1
    for (int sidx = 0; sidx < nsteps; ++sidx) {
      const int kind = kind_of(sidx);
      const bf16_t* aS;
      if (kind < 2) {
        *(u32x4*)(sB + lr * LDT + lk) = vb0; *(u32x4*)(sB + (lr + 32) * LDT + lk) = vb1;
        *(u32x4*)(sB + (lr + 64) * LDT + lk) = vb2; *(u32x4*)(sB + (lr + 96) * LDT + lk) = vb3;
        aS = kind ? sS1 : sS0;
      } else {
        const float w0 = sWi[J0 + lr], w1 = sWi[J0 + lr + 32];
        u32x4 o0, o1;
        o0[0] = pack2(lo2f(qa0[0]) * w0, hi2f(qa0[0]) * w0); o0[1] = pack2(lo2f(qa0[1]) * w0, hi2f(qa0[1]) * w0);
        o0[2] = pack2(lo2f(qa0[2]) * w0, hi2f(qa0[2]) * w0); o0[3] = pack2(lo2f(qa0[3]) * w0, hi2f(qa0[3]) * w0);
        o1[0] = pack2(lo2f(qa1[0]) * w1, hi2f(qa1[0]) * w1); o1[1] = pack2(lo2f(qa1[1]) * w1, hi2f(qa1[1]) * w1);
        o1[2] = pack2(lo2f(qa1[2]) * w1, hi2f(qa1[2]) * w1); o1[3] = pack2(lo2f(qa1[3]) * w1, hi2f(qa1[3]) * w1);
        *(u32x4*)(sA + lr * LDT + lk) = o0; *(u32x4*)(sA + (lr + 32) * LDT + lk) = o1;
#pragma unroll
        for (int j = 0; j < 8; ++j) {
          uint2 o;
          o.x = pack2(cv[j].x, cv[j].y);
          o.y = pack2(cv[j].z, cv[j].w);
          *(uint2*)(sB + ((tid >> 4) + 16 * j) * LDT + (tid & 15) * 4) = o;
        }
        aS = sA;
      }
      __syncthreads();
      if (sidx + 1 < nsteps) fetch(kind_of(sidx + 1));
      mma_lds<2, 4, 2>(aS + wr * 32 * LDT, sB + wc * 64 * LDT, acc, lane);
      __syncthreads();
    }
  }
#pragma unroll
  for (int mt = 0; mt < 2; ++mt)
#pragma unroll
    for (int i = 0; i < 4; ++i) {
      int jl = wr * 32 + mt * 16 + q * 4 + i;
      int j = J0 + jl;
      float den = sDen[jl] + sDen[64 + jl] + sWi[j] * sQn[jl];
      float dinv = 1.f / fmaxf(fabsf(den), sEm[j]);
      float ss = 0.f;
#pragma unroll
      for (int nt = 0; nt < 4; ++nt) { float v = acc[mt][nt][i] * dinv; acc[mt][nt][i] = v; ss += v * v; }
      ss = grp16_sum(ss);
      if (r == 0) sSs[wc * 64 + jl] = ss;
    }
  __syncthreads();
  const bf16_t* MO = (const bf16_t*)(ws + L0_MO);
  const bf16_t* MZ = (const bf16_t*)(ws + L0_MZ);
  bf16_t* Y = (bf16_t*)(ws + L0_QKRAW);
  float hn[4];
#pragma unroll
  for (int nt = 0; nt < 4; ++nt) hn[nt] = p.m_hn[h * 128 + wc * 64 + nt * 16 + r];
#pragma unroll
  for (int mt = 0; mt < 2; ++mt) {
    float gv[4][4];
#pragma unroll
    for (int i = 0; i < 4; ++i) {
      long row = R0 + J0 + wr * 32 + mt * 16 + q * 4 + i;
#pragma unroll
      for (int nt = 0; nt < 4; ++nt) {
        int col = h * 128 + wc * 64 + nt * 16 + r;
        gv[i][nt] = bf2f(MO[row * 512 + col]) * bf2f(MZ[row * 512 + col]);
      }
    }
#pragma unroll
    for (int i = 0; i < 4; ++i) {
      int jl = wr * 32 + mt * 16 + q * 4 + i;
      float rinv = rsqrtf((sSs[jl] + sSs[64 + jl]) * (1.f / 128.f) + EPSF);
      long row = R0 + J0 + jl;
#pragma unroll
      for (int nt = 0; nt < 4; ++nt) {
        int col = h * 128 + wc * 64 + nt * 16 + r;
        Y[row * 1024 + col] = f2bf(acc[mt][nt][i] * rinv * hn[nt] * gv[i][nt]);
      }
    }
  }
  __syncthreads();
}

struct NsaSm {
  bf16_t* sK; bf16_t* sV;
  float* sImpA; float* sImpB;
  unsigned* sSel; unsigned* sGrp; unsigned* sUn;
};

DEVI int next_bit(unsigned long long lo, unsigned long long hi, int from) {
  if (from < 64) {
    unsigned long long v = lo & (~0ull << from);
    if (v) return __builtin_ctzll(v);
    if (hi) return 64 + __builtin_ctzll(hi);
    return -1;
  }
  if (from >= 128) return -1;
  unsigned long long v = hi & (~0ull << (from - 64));
  if (v) return 64 + __builtin_ctzll(v);
  return -1;
}

template <int MODE, bool DUMMY = false, class MaskF, class ActF>
DEVI void nsa_branch(const NsaSm& sm, unsigned long long tmlo, unsigned long long tmhi,
                     const bf16_t* Kg, const bf16_t* Vg, long vstep, long ldv,
                     const bf16x8 (&qf)[2][2], f32x4 (&O)[4][2], float (&mrow)[2], float (&lrow)[2], const float (&invl)[2],
                     MaskF mask, ActF actf, int tokbase, int tid) {
  const int lane = tid & 63, r = lane & 15, q = lane >> 4;
  const int lr = tid >> 3, lk = (tid & 7) * 8;
  int j = next_bit(tmlo, tmhi, 0);
  if (j < 0) return;
  u32x4 k0, k1, v0, v1;
  u32x4 k2, k3, v2, v3;
  if (!DUMMY) {
    const bf16_t* kp = Kg + (long)j * 4096 + lr * 64 + lk;
    k0 = *(const u32x4*)kp; k1 = *(const u32x4*)(kp + 32 * 64);
    if (MODE != 1) {
      const bf16_t* vp = Vg + (long)j * vstep + (long)lr * ldv + lk;
      v0 = *(const u32x4*)vp; v1 = *(const u32x4*)(vp + 32 * ldv);
    }
    *(u32x4*)(sm.sK + lr * LDT + lk) = k0; *(u32x4*)(sm.sK + (lr + 32) * LDT + lk) = k1;
    if (MODE != 1) { *(u32x4*)(sm.sV + lr * LDT + lk) = v0; *(u32x4*)(sm.sV + (lr + 32) * LDT + lk) = v1; }
  }
  int j1 = next_bit(tmlo, tmhi, j + 1);
  if (!DUMMY && j1 >= 0) {
    const bf16_t* kp = Kg + (long)j1 * 4096 + lr * 64 + lk;
    k0 = *(const u32x4*)kp; k1 = *(const u32x4*)(kp + 32 * 64);
    if (MODE != 1) {
      const bf16_t* vp = Vg + (long)j1 * vstep + (long)lr * ldv + lk;
      v0 = *(const u32x4*)vp; v1 = *(const u32x4*)(vp + 32 * ldv);
    }
  }
  if (!DUMMY) __syncthreads();
  int buf = 0;
  while (true) {
    const int jn = j1;
    const int j2 = (j1 >= 0) ? next_bit(tmlo, tmhi, j1 + 1) : -1;
    if (!DUMMY && j2 >= 0) {
      const bf16_t* kp = Kg + (long)j2 * 4096 + lr * 64 + lk;
      k2 = *(const u32x4*)kp; k3 = *(const u32x4*)(kp + 32 * 64);
      if (MODE != 1) {
        const bf16_t* vp = Vg + (long)j2 * vstep + (long)lr * ldv + lk;
        v2 = *(const u32x4*)vp; v3 = *(const u32x4*)(vp + 32 * ldv);
      }
    }
    const bf16_t* sK = sm.sK + buf * (64 * LDT);
    const bf16_t* sV = sm.sV + buf * (64 * LDT);
    const bool a0 = actf(0, j), a1 = actf(1, j);
    __builtin_amdgcn_sched_barrier(0);
    if (a0 || a1) {
      const bool full = mask.full(j);
      f32x4 sacc[4][2];
#pragma unroll
      for (int mt = 0; mt < 4; ++mt) { sacc[mt][0] = f32x4{0.f, 0.f, 0.f, 0.f}; sacc[mt][1] = f32x4{0.f, 0.f, 0.f, 0.f}; }
#pragma unroll
      for (int ks = 0; ks < 2; ++ks)
#pragma unroll
        for (int mt = 0; mt < 4; ++mt) {
          bf16x8 a = *(const bf16x8*)(sK + (mt * 16 + r) * LDT + ks * 32 + q * 8);
          if (a0) sacc[mt][0] = __builtin_amdgcn_mfma_f32_16x16x32_bf16(a, qf[0][ks], sacc[mt][0], 0, 0, 0);
          if (a1) sacc[mt][1] = __builtin_amdgcn_mfma_f32_16x16x32_bf16(a, qf[1][ks], sacc[mt][1], 0, 0, 0);
        }
      __builtin_amdgcn_sched_barrier(0);
#pragma unroll
      for (int nt = 0; nt < 2; ++nt) {
        const bool act = nt ? a1 : a0;
        if (act) {
          const bool lb = mask.bit(nt, j);
          if (!full) {
#pragma unroll
            for (int mt = 0; mt < 4; ++mt)
#pragma unroll
              for (int i = 0; i < 4; ++i) sacc[mt][nt][i] = mask.elem(mt * 16 + q * 4 + i, nt, j) ? sacc[mt][nt][i] : NEGS;
          }
          if (MODE != 2) {
            float tmx = fmaxf(fmaxf(sacc[0][nt][0], sacc[0][nt][1]), fmaxf(sacc[0][nt][2], sacc[0][nt][3]));
#pragma unroll
            for (int mt = 1; mt < 4; ++mt)
              tmx = fmaxf(tmx, fmaxf(fmaxf(sacc[mt][nt][0], sacc[mt][nt][1]), fmaxf(sacc[mt][nt][2], sacc[mt][nt][3])));
            if (MaskF::HASBIT) tmx = lb ? tmx : NEGS;
            tmx = fmaxf(tmx, __shfl_xor(tmx, 16));
            tmx = fmaxf(tmx, __shfl_xor(tmx, 32));
            const float mo = mrow[nt];
            const float mn = fmaxf(mo, tmx);
            float mnc = fmaxf(mn, -1e20f);
            if (MaskF::HASBIT) mnc = lb ? mnc : 1e30f;
            mrow[nt] = mn;
            f32x4 psv = f32x4{0.f, 0.f, 0.f, 0.f};
#pragma unroll
            for (int mt = 0; mt < 4; ++mt) {
              f32x4 dd = sacc[mt][nt] - mnc;
              f32x4 pp;
              pp[0] = __builtin_amdgcn_exp2f(dd[0]); pp[1] = __builtin_amdgcn_exp2f(dd[1]);
              pp[2] = __builtin_amdgcn_exp2f(dd[2]); pp[3] = __builtin_amdgcn_exp2f(dd[3]);
              sacc[mt][nt] = pp;
              psv += pp;
            }
            const float ps = (psv[0] + psv[1]) + (psv[2] + psv[3]);
            const float al = __builtin_amdgcn_exp2f(mo - mn);
            lrow[nt] = lrow[nt] * al + ps;
            if (MODE == 0) {
              if (__any(al != 1.f)) {
#pragma unroll
                for (int dt = 0; dt < 4; ++dt) O[dt][nt] *= al;
              }
            }
          } else {
            const float mmc = fmaxf(mrow[nt], -1e20f), il = invl[nt];
            const int tok = tokbase + nt * 4 + (r >> 2);
#pragma unroll
            for (int mt = 0; mt < 4; ++mt) {
              float pp[4];
#pragma unroll
              for (int i = 0; i < 4; ++i) {
                pp[i] = __builtin_amdgcn_exp2f(sacc[mt][nt][i] - mmc) * il;
                sacc[mt][nt][i] = pp[i];
              }
              float mainv = 32.f * (pp[0] + pp[1] + pp[2]) + 16.f * pp[3];
              float carry = 16.f * pp[3];
              mainv += __shfl_xor(mainv, 1); mainv += __shfl_xor(mainv, 2);
              carry += __shfl_xor(carry, 1); carry += __shfl_xor(carry, 2);
              if ((r & 3) == 0) {
                const int mp = j * 16 + mt * 4 + q;
                sm.sImpA[tok * 128 + mp] = mainv;
                if (mp + 1 < 128) sm.sImpB[tok * 128 + mp + 1] = carry;
              }
            }
          }
        }
      }
      __builtin_amdgcn_sched_barrier(0);
      if (MODE != 1) {
#pragma unroll
        for (int ks = 0; ks < 2; ++ks) {
          bf16x8 pb[2];
#pragma unroll
          for (int nt = 0; nt < 2; ++nt) {
            union { u32x4 u; bf16x8 h; } cv;
            cv.u[0] = pack2(sacc[2 * ks][nt][0], sacc[2 * ks][nt][1]);
            cv.u[1] = pack2(sacc[2 * ks][nt][2], sacc[2 * ks][nt][3]);
            cv.u[2] = pack2(sacc[2 * ks + 1][nt][0], sacc[2 * ks + 1][nt][1]);
            cv.u[3] = pack2(sacc[2 * ks + 1][nt][2], sacc[2 * ks + 1][nt][3]);
            pb[nt] = cv.h;
          }
#pragma unroll
          for (int dt = 0; dt < 4; ++dt) {
            union { u32x4 u; bf16x8 h; } av;
            const uint2 lo = *(const uint2*)(sV + (dt * 16 + r) * LDT + (2 * ks) * 16 + q * 4);
            const uint2 hi = *(const uint2*)(sV + (dt * 16 + r) * LDT + (2 * ks + 1) * 16 + q * 4);
            av.u[0] = lo.x; av.u[1] = lo.y; av.u[2] = hi.x; av.u[3] = hi.y;
            if (a0) O[dt][0] = __builtin_amdgcn_mfma_f32_16x16x32_bf16(av.h, pb[0], O[dt][0], 0, 0, 0);
            if (a1) O[dt][1] = __builtin_amdgcn_mfma_f32_16x16x32_bf16(av.h, pb[1], O[dt][1], 0, 0, 0);
          }
        }
      }
    }
    __builtin_amdgcn_sched_barrier(0);
    if (!DUMMY && jn >= 0) {
      bf16_t* dK = sm.sK + (buf ^ 1) * (64 * LDT);
      bf16_t* dV = sm.sV + (buf ^ 1) * (64 * LDT);
      *(u32x4*)(dK + lr * LDT + lk) = k0; *(u32x4*)(dK + (lr + 32) * LDT + lk) = k1;
      if (MODE != 1) { *(u32x4*)(dV + lr * LDT + lk) = v0; *(u32x4*)(dV + (lr + 32) * LDT + lk) = v1; }
    }
    if (!DUMMY) __syncthreads();
    if (jn < 0) break;
    j = jn;
    j1 = j2;
    k0 = k2; k1 = k3; v0 = v2; v1 = v3;
    buf ^= 1;
  }
}

struct MaskC {
      static constexpr bool HASBIT = false;
      int t0_, t1_, tmin_;
      DEVI bool full(int jt) const { return 16 * (jt * 64 + 63) + 31 <= tmin_; }
      DEVI bool bit(int nt, int jt) const { return true; }
      DEVI bool elem(int key, int nt, int jt) const { return 16 * (jt * 64 + key) + 31 <= (nt ? t1_ : t0_); }
};

struct MaskS {
      static constexpr bool HASBIT = true;
      const unsigned* sel0; const unsigned* sel1; int t0_, t1_, cur_;
      DEVI bool full(int jt) const { return jt < cur_; }
      DEVI bool bit(int nt, int jt) const { return (((nt ? sel1 : sel0)[jt >> 5] >> (jt & 31)) & 1u) != 0u; }
      DEVI bool elem(int key, int nt, int jt) const { return jt * 64 + key <= (nt ? t1_ : t0_); }
};

struct MaskW {
      static constexpr bool HASBIT = false;
      int t0_, t1_, tmin_, tmax_;
      DEVI bool full(int jt) const { return (jt * 64 + 63 <= tmin_) && (tmax_ - jt * 64 < 512); }
      DEVI bool bit(int nt, int jt) const { return true; }
      DEVI bool elem(int key, int nt, int jt) const { const int s_ = jt * 64 + key, t_ = nt ? t1_ : t0_; return (s_ <= t_) && (t_ - s_ < 512); }
};

DEVI void nsa_tile(const Params& p, int tileidx, unsigned char* smem) {
  const int tid = opaque_tid(), lane = tid & 63, w = tid >> 6, r = lane & 15, q = lane >> 4;
  const int bg = tileidx & 3, tt = tileidx >> 2, b = bg >> 1, g = bg & 1, t0 = tt * 32;
  unsigned char* ws = p.ws;
  NsaSm sm;
  sm.sK = (bf16_t*)smem; sm.sV = (bf16_t*)(smem + 18432);
  sm.sImpA = (float*)(smem + 36864); sm.sImpB = (float*)(smem + 53248);
  sm.sSel = (unsigned*)(smem + 69632); sm.sGrp = sm.sSel + 128; sm.sUn = sm.sGrp + 32;
  const int tokbase = 8 * w;
  bf16x8 qf[2][2];
  {
    const bf16_t* qn = (const bf16_t*)(ws + L0_QN) + ((long)bg * 8192 + t0) * 256 + (32 * w + r) * 64 + q * 8;
    qf[0][0] = *(const bf16x8*)(qn); qf[0][1] = *(const bf16x8*)(qn + 32);
    qf[1][0] = *(const bf16x8*)(qn + 16 * 64); qf[1][1] = *(const bf16x8*)(qn + 16 * 64 + 32);
  }
  int tq[2];
  const float* GT = (const float*)(ws + L0_GATES);
#pragma unroll
  for (int nt = 0; nt < 2; ++nt) tq[nt] = t0 + tokbase + nt * 4 + (r >> 2);
#define GATE(nt, k) (GT[((long)b * 8192 + tq[nt]) * 24 + (g * 4 + (r & 3)) * 3 + (k)])
  f32x4 O[4][2];
  f32x4* sOut = (f32x4*)(smem + 36864) + (w * 8) * 64 + lane;
  const int cur = t0 >> 6;
  float mrow[2], lrow[2], invl[2];
  for (int i = tid; i < 32 * 128; i += 256) { sm.sImpA[i] = 0.f; sm.sImpB[i] = 0.f; }
  __syncthreads();
  {
    const int nvmax = (t0 + 31 >= 31) ? (((t0 + 31 - 31) >> 4) + 1) : 0;
    int nkt = (nvmax + 63) >> 6;
    if (nkt > 8) nkt = 8;
    const unsigned long long cm0 = (1ull << nkt) - 1ull;
    const bf16_t* KCMP = (const bf16_t*)(ws + L0_KCMP) + (long)bg * 512 * 64;
    const bf16_t* VCMPT = (const bf16_t*)(ws + L0_VCMPT) + (long)bg * 64 * 512;
    MaskC mk{tq[0], tq[1], t0 + tokbase};
    auto act = [&](int nt, int jt) { return true; };
    mrow[0] = mrow[1] = NEGS; lrow[0] = lrow[1] = 0.f; invl[0] = invl[1] = 0.f;
    nsa_branch<1>(sm, cm0, 0ull, KCMP, VCMPT, 64, 512, qf, O, mrow, lrow, invl, mk, act, tokbase, tid);
#pragma unroll
    for (int nt = 0; nt < 2; ++nt) {
      float l = lrow[nt];
      l += __shfl_xor(l, 16); l += __shfl_xor(l, 32);
      invl[nt] = (l > 0.f) ? 1.f / l : 0.f;
    }
#pragma unroll
    for (int dt = 0; dt < 4; ++dt) { O[dt][0] = f32x4{0.f, 0.f, 0.f, 0.f}; O[dt][1] = f32x4{0.f, 0.f, 0.f, 0.f}; }
    nsa_branch<2>(sm, cm0, 0ull, KCMP, VCMPT, 64, 512, qf, O, mrow, lrow, invl, mk, act, tokbase, tid);
  }
  __syncthreads();
  {
    const int ncand = (cur - 2 > 0) ? cur - 2 : 0;
    const int nf = (cur >= 2) ? 3 : cur + 1;
    const int kk = 16 - nf;
    const int m0i = lane, m1i = lane + 64;
    const bool c0 = (m0i >= 1 && m0i <= cur - 2), c1 = (m1i <= cur - 2);
    for (int tqi = 0; tqi < 8; ++tqi) {
      const int tok = tokbase + tqi;
      bool s0, s1;
      if (ncand <= kk) { s0 = c0; s1 = c1; }
      else {
        const float f0 = sm.sImpA[tok * 128 + m0i] + sm.sImpB[tok * 128 + m0i];
        const float f1 = sm.sImpA[tok * 128 + m1i] + sm.sImpB[tok * 128 + m1i];
        const unsigned k0 = c0 ? (__float_as_uint(f0) + 1u) : 0u;
        const unsigned k1 = c1 ? (__float_as_uint(f1) + 1u) : 0u;
        unsigned prefix = 0u;
        for (int bit = 31; bit >= 0; --bit) {
          const unsigned cand = prefix | (1u << bit);
          const int cnt = __popcll(__ballot(k0 >= cand)) + __popcll(__ballot(k1 >= cand));
          if (cnt >= kk) prefix = cand;
        }
        const bool g0 = k0 > prefix, g1 = k1 > prefix;
        const int ng = __popcll(__ballot(g0)) + __popcll(__ballot(g1));
        const bool e0 = (k0 == prefix), e1 = (k1 == prefix);
        const unsigned long long be0 = __ballot(e0), be1 = __ballot(e1);
        const unsigned long long lm = (1ull << lane) - 1ull;
        const int re0 = __popcll(be0 & lm), re1 = __popcll(be0) + __popcll(be1 & lm);
        const int need = kk - ng;
        s0 = g0 || (e0 && re0 < need);
        s1 = g1 || (e1 && re1 < need);
      }
      s0 = s0 || (m0i == 0) || (m0i == cur) || (m0i == cur - 1);
      s1 = s1 || (m1i == cur) || (m1i == cur - 1);
      const unsigned long long lo = __ballot(s0), hi = __ballot(s1);
      if (lane == 0) {
        sm.sSel[tok * 4 + 0] = (unsigned)lo; sm.sSel[tok * 4 + 1] = (unsigned)(lo >> 32);
        sm.sSel[tok * 4 + 2] = (unsigned)hi; sm.sSel[tok * 4 + 3] = (unsigned)(hi >> 32);
      }
    }
  }
  __syncthreads();
  if (tid < 32) { int gi = tid >> 2, wd = tid & 3; unsigned u = 0; for (int k = 0; k < 4; ++k) u |= sm.sSel[(gi * 4 + k) * 4 + wd]; sm.sGrp[tid] = u; }
  __syncthreads();
  if (tid < 4) { unsigned u = 0; for (int gi = 0; gi < 8; ++gi) u |= sm.sGrp[gi * 4 + tid]; sm.sUn[tid] = u; }
  __syncthreads();
#pragma unroll
  for (int nt = 0; nt < 2; ++nt)
#pragma unroll
    for (int dt = 0; dt < 4; ++dt) sOut[(nt * 4 + dt) * 64] = O[dt][nt] * GATE(nt, 0);
  {
    const bf16_t* KS = (const bf16_t*)(ws + L0_KS) + (long)bg * 8192 * 64;
    const bf16_t* VST = (const bf16_t*)(ws + L0_VST) + (long)bg * 128 * 4096;
    const unsigned long long ulo = (unsigned long long)sm.sUn[0] | ((unsigned long long)sm.sUn[1] << 32);
    const unsigned long long uhi = (unsigned long long)sm.sUn[2] | ((unsigned long long)sm.sUn[3] << 32);
    const int tk0 = tokbase + (r >> 2), tk1 = tokbase + 4 + (r >> 2);
    MaskS mk{sm.sSel + tk0 * 4, sm.sSel + tk1 * 4, tq[0], tq[1], cur};
    auto act = [&](int nt, int jt) { return ((sm.sGrp[(2 * w + nt) * 4 + (jt >> 5)] >> (jt & 31)) & 1u) != 0u; };
    mrow[0] = mrow[1] = NEGS; lrow[0] = lrow[1] = 0.f;
#pragma unroll
    for (int dt = 0; dt < 4; ++dt) { O[dt][0] = f32x4{0.f, 0.f, 0.f, 0.f}; O[dt][1] = f32x4{0.f, 0.f, 0.f, 0.f}; }
#ifdef NSA_DUMMY_SEL
    {
      nsa_branch<0, true>(sm, ulo, uhi, KS, VST, 4096, 64, qf, O, mrow, lrow, invl, mk, act, tokbase, tid);
      float chk = lrow[0] + lrow[1];
#pragma unroll
      for (int dt = 0; dt < 4; ++dt) chk += O[dt][0][0] + O[dt][0][1] + O[dt][0][2] + O[dt][0][3] + O[dt][1][0] + O[dt][1][1] + O[dt][1][2] + O[dt][1][3];
      if (chk == 123.456f) sm.sUn[0] = 1u;
      mrow[0] = mrow[1] = NEGS; lrow[0] = lrow[1] = 0.f;
#pragma unroll
      for (int dt = 0; dt < 4; ++dt) { O[dt][0] = f32x4{0.f, 0.f, 0.f, 0.f}; O[dt][1] = f32x4{0.f, 0.f, 0.f, 0.f}; }
      __syncthreads();
    }
#endif
    nsa_branch<0>(sm, ulo, uhi, KS, VST, 4096, 64, qf, O, mrow, lrow, invl, mk, act, tokbase, tid);
#pragma unroll
    for (int nt = 0; nt < 2; ++nt) {
      float l = lrow[nt];
      l += __shfl_xor(l, 16); l += __shfl_xor(l, 32);
      const float f = GATE(nt, 1) * ((l > 0.f) ? 1.f / l : 0.f);
#pragma unroll
      for (int dt = 0; dt < 4; ++dt) sOut[(nt * 4 + dt) * 64] += O[dt][nt] * f;
    }
  }
  {
    const bf16_t* KW = (const bf16_t*)(ws + L0_KW) + (long)bg * 8192 * 64;
    const bf16_t* VWT = (const bf16_t*)(ws + L0_VWT) + (long)bg * 128 * 4096;
    const int jlo = ((t0 - 511 > 0) ? (t0 - 511) : 0) >> 6;
    unsigned long long wlo = 0ull, whi = 0ull;
    for (int jj = jlo; jj <= cur; ++jj) { if (jj < 64) wlo |= (1ull << jj); else whi |= (1ull << (jj - 64)); }
    MaskW mk{tq[0], tq[1], t0 + tokbase, t0 + tokbase + 7};
    auto act = [&](int nt, int jt) { return true; };
    mrow[0] = mrow[1] = NEGS; lrow[0] = lrow[1] = 0.f;
#pragma unroll
    for (int dt = 0; dt < 4; ++dt) { O[dt][0] = f32x4{0.f, 0.f, 0.f, 0.f}; O[dt][1] = f32x4{0.f, 0.f, 0.f, 0.f}; }
    nsa_branch<0>(sm, wlo, whi, KW, VWT, 4096, 64, qf, O, mrow, lrow, invl, mk, act, tokbase, tid);
#pragma unroll
    for (int nt = 0; nt < 2; ++nt) {
      float l = lrow[nt];
      l += __shfl_xor(l, 16); l += __shfl_xor(l, 32);
      const float f = GATE(nt, 2) * ((l > 0.f) ? 1.f / l : 0.f);
#pragma unroll
      for (int dt = 0; dt < 4; ++dt) O[dt][nt] = sOut[(nt * 4 + dt) * 64] + O[dt][nt] * f;
    }
  }
  const bf16_t* NZ = (const bf16_t*)(ws + L0_NZ);
  bf16_t* Y = (bf16_t*)(ws + L0_QKRAW);
  uint2 zzv[2][4];
#pragma unroll
  for (int nt = 0; nt < 2; ++nt)
#pragma unroll
    for (int dt = 0; dt < 4; ++dt)
      zzv[nt][dt] = *(const uint2*)(NZ + ((long)b * 8192 + tq[nt]) * 512 + (g * 4 + (r & 3)) * 64 + dt * 16 + q * 4);
#pragma unroll
  for (int nt = 0; nt < 2; ++nt) {
    const long tok = (long)b * 8192 + tq[nt];
    const int head = g * 4 + (r & 3);
#pragma unroll
    for (int dt = 0; dt < 4; ++dt) {
      const int d = dt * 16 + q * 4;
      const uint2 zz = zzv[nt][dt];
      uint2 o;
      o.x = pack2(O[dt][nt][0] * lo2f(zz.x), O[dt][nt][1] * hi2f(zz.x));
      o.y = pack2(O[dt][nt][2] * lo2f(zz.y), O[dt][nt][3] * hi2f(zz.y));
      *(uint2*)(Y + tok * 1024 + 512 + head * 64 + d) = o;
    }
  }
  __syncthreads();
}

DEVI void hgrn_local(const Params& p, int unit, unsigned char* smem) {
  const int tid = opaque_tid(), lane = tid & 63, w = tid >> 6, wr = w >> 1, wc = w & 1;
  const int bh = unit >> 7, c = unit & 127, b = bh >> 3, h = bh & 7, t0 = c * 64;
  const long R0 = (long)b * 8192 + t0;
  unsigned char* ws = p.ws;
  bf16_t* sA = (bf16_t*)smem;
  bf16_t* sB = (bf16_t*)(smem + 18432);
  float* psum = (float*)(smem + 36864);
  const int cch = tid & 127, half = tid >> 7;
  const float lb = ((const float*)(ws + OFF_LB))[h * 128 + cch];
  const bf16_t* FP = (const bf16_t*)(ws + L1_FP) + R0 * 1024 + h * 128 + cch;
#ifndef R9C
#define R9C 1
#endif
  for (int r9_ = 0; r9_ < R9C; ++r9_) load_tile128(sA, (const bf16_t*)(ws + L1_VT) + (((long)(b * 8 + h) * 128 + c) * 128) * 64, 64);
  float sgv[32], lgv[32];
  {
    bf16_t fpr[32];
#pragma unroll
    for (int k = 0; k < 32; ++k) fpr[k] = FP[(long)(half * 32 + k) * 1024];
#pragma unroll
    for (int k = 0; k < 32; ++k) { sgv[k] = sigm(bf2f(fpr[k])); lgv[k] = __logf(lb + (1.f - lb) * sgv[k]); }
  }
  float sum = 0.f;
#pragma unroll
  for (int k = 0; k < 32; ++k) sum += lgv[k];
  psum[half * 128 + cch] = sum;
  __syncthreads();
  const float bL = psum[cch] + psum[128 + cch];
  float run = half ? psum[cch] : 0.f;
#pragma unroll
  for (int k = 0; k < 32; ++k) {
    run += lgv[k];
    float kk_ = (1.f - lb) * (1.f - sgv[k]);
    sB[cch * LDT + half * 32 + k] = f2bf(kk_ * __expf(bL - run));
  }
  if (half == 0) ((float*)(ws + L1_BL))[(long)unit * 128 + cch] = bL;
  __syncthreads();
  f32x4 acc[4][4];
#pragma unroll
  for (int mt = 0; mt < 4; ++mt)
#pragma unroll
    for (int nt = 0; nt < 4; ++nt) acc[mt][nt] = f32x4{0.f, 0.f, 0.f, 0.f};
  mma_lds_sw<4, 4, 2>(sA + wr * 64 * LDT, sB + wc * 64 * LDT, acc, lane);
#ifndef R9B
#define R9B 1
#endif
  for (int r9_ = 0; r9_ < R9B; ++r9_) {
  bf16_t* st = (bf16_t*)(ws + L1_ST) + (long)unit * 16384;
  const int r = lane & 15, q = lane >> 4;
#pragma unroll
  for (int mt = 0; mt < 4; ++mt) {
    const int v = wr * 64 + mt * 16 + r;
#pragma unroll
    for (int nt = 0; nt < 4; ++nt) {
      uint2 o;
      o.x = pack2(acc[mt][nt][0], acc[mt][nt][1]);
      o.y = pack2(acc[mt][nt][2], acc[mt][nt][3]);
      *(uint2*)(st + v * 128 + wc * 64 + nt * 16 + q * 4) = o;
    }
  }
  }
  __syncthreads();
}

template <bool DUMMY>
DEVI void hgrn_scan(const Params& p) {
  unsigned char* ws = p.ws;
  const float* BL = (const float*)(ws + L1_BL);
  for (int idx = blockIdx.x * 256 + opaque_tid(); idx < 16 * 8192; idx += gridDim.x * 256) {
    const int bh = idx >> 13, pr = idx & 8191;
    const int c2 = (pr & 63) * 2;
    unsigned* ptr = (unsigned*)(ws + L1_ST) + (long)bh * 128 * 8192 + pr;
    const float* blp = BL + (long)bh * 128 * 128 + c2;
    float s0 = 0.f, s1 = 0.f;
    for (int c0 = 0; c0 < 128; c0 += 8) {
      unsigned dv[8]; float2 bl[8];
#pragma unroll
      for (int k = 0; k < 8; ++k) { dv[k] = ptr[(long)(c0 + k) * 8192]; bl[k] = *(const float2*)(blp + (long)(c0 + k) * 128); }
#pragma unroll
      for (int k = 0; k < 8; ++k) {
        if (!DUMMY) ptr[(long)(c0 + k) * 8192] = pack2(s0, s1);
        s0 = __expf(bl[k].x) * s0 + lo2f(dv[k]);
        s1 = __expf(bl[k].y) * s1 + hi2f(dv[k]);
      }
    }
    if (DUMMY && s0 == 123.456f) ptr[0] = pack2(s0, s1);
  }
}

DEVI void hgrn_out(const Params& p, int unit, unsigned char* smem) {
  const int tid = opaque_tid(), lane = tid & 63, w = tid >> 6, wr = w >> 1, wc = w & 1;
  const int r = lane & 15, q = lane >> 4;
  const int bh = unit >> 7, c = unit & 127, b = bh >> 3, h = bh & 7, t0 = c * 64;
  const long R0 = (long)b * 8192 + t0;
  unsigned char* ws = p.ws;
  bf16_t* sQ0 = (bf16_t*)smem; bf16_t* sQ1 = (bf16_t*)(smem + 9216);
  bf16_t* sK0 = (bf16_t*)(smem + 18432); bf16_t* sK1 = (bf16_t*)(smem + 27648);
  bf16_t* sAm = (bf16_t*)(smem + 36864);
  bf16_t* sB = (bf16_t*)(smem + 46080);
  float* psum = (float*)(smem + 64512);
  float* sSs = psum + 256;
  const int cch = tid & 127, half = tid >> 7, cc = cch & 63;
  const float lb = ((const float*)(ws + OFF_LB))[h * 128 + cch];
  const bf16_t* FP = (const bf16_t*)(ws + L1_FP) + R0 * 1024 + h * 128 + cch;
  const bf16_t* Q1 = (const bf16_t*)(ws + L1_Q) + R0 * 1024 + h * 128 + cch;
  const bf16_t* vt = (const bf16_t*)(ws + L1_VT) + (((long)(b * 8 + h) * 128 + c) * 128) * 64;
  load_tile128(sB, vt, 64);
  float sgv[32], lgv[32];
  bf16_t qr[32];
  {
    bf16_t fpr[32];
#pragma unroll
    for (int k = 0; k < 32; ++k) { fpr[k] = FP[(long)(half * 32 + k) * 1024]; qr[k] = Q1[(long)(half * 32 + k) * 1024]; }
#pragma unroll
    for (int k = 0; k < 32; ++k) { sgv[k] = sigm(bf2f(fpr[k])); lgv[k] = __logf(lb + (1.f - lb) * sgv[k]); }
  }
  float sum = 0.f;
#pragma unroll
  for (int k = 0; k < 32; ++k) sum += lgv[k];
  psum[half * 128 + cch] = sum;
  __syncthreads();
  float run = half ? psum[cch] : 0.f;
  bf16_t* sQ = (cch < 64) ? sQ0 : sQ1;
  bf16_t* sK = (cch < 64) ? sK0 : sK1;
#pragma unroll
  for (int k = 0; k < 32; ++k) {
    const int s_ = half * 32 + k;
    run += lgv[k];
    float kk_ = (1.f - lb) * (1.f - sgv[k]);
    sQ[s_ * LDT + cc] = f2bf(bf2f(qr[k]) * __expf(run));
    sK[s_ * LDT + cc] = f2bf(kk_ * __expf(fminf(-run, 80.f)));
  }
  __syncthreads();
  {
    f32x4 a1[2][2];
#pragma unroll
    for (int mt = 0; mt < 2; ++mt)
#pragma unroll
      for (int nt = 0; nt < 2; ++nt) a1[mt][nt] = f32x4{0.f, 0.f, 0.f, 0.f};
    if (!(wr == 0 && wc == 1)) {
      mma_lds<2, 2, 2>(sQ0 + wr * 32 * LDT, sK0 + wc * 32 * LDT, a1, lane);
      mma_lds<2, 2, 2>(sQ1 + wr * 32 * LDT, sK1 + wc * 32 * LDT, a1, lane);
    }
#pragma unroll
    for (int mt = 0; mt < 2; ++mt)
#pragma unroll
      for (int i = 0; i < 4; ++i) {
        int j = wr * 32 + mt * 16 + q * 4 + i;
#pragma unroll
        for (int nt = 0; nt < 2; ++nt) {
          int s = wc * 32 + nt * 16 + r;
          sAm[j * LDT + s] = f2bf((s <= j) ? a1[mt][nt][i] : 0.f);
        }
      }
  }
  __syncthreads();
  f32x4 o[2][4];
#pragma unroll
  for (int mt = 0; mt < 2; ++mt)
#pragma unroll
    for (int nt = 0; nt < 4; ++nt) o[mt][nt] = f32x4{0.f, 0.f, 0.f, 0.f};
  mma_lds<2, 4, 2>(sAm + wr * 32 * LDT, sB + wc * 64 * LDT, o, lane);
  __syncthreads();
  const bf16_t* st = (const bf16_t*)(ws + L1_ST) + (long)unit * 16384;
  load_tile128(sB, st, 128);
  __syncthreads();
  mma_lds<2, 4, 2>(sQ0 + wr * 32 * LDT, sB + wc * 64 * LDT, o, lane);
  __syncthreads();
  load_tile128(sB, st + 64, 128);
  __syncthreads();
  mma_lds<2, 4, 2>(sQ1 + wr * 32 * LDT, sB + wc * 64 * LDT, o, lane);
#pragma unroll
  for (int mt = 0; mt < 2; ++mt)
#pragma unroll
    for (int i = 0; i < 4; ++i) {
      int j = wr * 32 + mt * 16 + q * 4 + i;
      float ss = 0.f;
#pragma unroll
      for (int nt = 0; nt < 4; ++nt) ss += o[mt][nt][i] * o[mt][nt][i];
      ss = grp16_sum(ss);
      if (r == 0) sSs[wc * 64 + j] = ss;
    }
  __syncthreads();
  const bf16_t* Z1 = (const bf16_t*)(ws + L1_Z);
  bf16_t* Y1 = (bf16_t*)(ws + L1_H);
  float hn[4];
#pragma unroll
  for (int nt = 0; nt < 4; ++nt) hn[nt] = p.h_hn[h * 128 + wc * 64 + nt * 16 + r];
#pragma unroll
  for (int mt = 0; mt < 2; ++mt) {
    float zv[4][4];
#pragma unroll
    for (int i = 0; i < 4; ++i) {
      long row = R0 + wr * 32 + mt * 16 + q * 4 + i;
#pragma unroll
      for (int nt = 0; nt < 4; ++nt) zv[i][nt] = bf2f(Z1[row * 1024 + h * 128 + wc * 64 + nt * 16 + r]);
    }
#pragma unroll
    for (int i = 0; i < 4; ++i) {
      int j = wr * 32 + mt * 16 + q * 4 + i;
      float rinv = rsqrtf((sSs[j] + sSs[64 + j]) * (1.f / 128.f) + EPSF);
      long row = R0 + j;
#pragma unroll
      for (int nt = 0; nt < 4; ++nt) {
        int col = h * 128 + wc * 64 + nt * 16 + r;
        Y1[row * 1024 + col] = f2bf(o[mt][nt][i] * rinv * hn[nt] * zv[i][nt]);
      }
    }
  }
  __syncthreads();
}

#define XB_TMO      128
#define XB_XCNT(j)  (256  + 64 * (j))
#define XB_XSUB(j)  (1280 + 64 * (j))
#define XB_XGEN(j)  (2304 + 64 * (j))
#define XB_TOP      3328
#define XB_TOPGEN   3392
#define XCD_BAR_WORDS 3456
#define XB_SPIN_CAP (1u << 22)
DEVI unsigned xb_ld(unsigned* p) { return __hip_atomic_load(p, __ATOMIC_RELAXED, __HIP_MEMORY_SCOPE_AGENT); }
DEVI unsigned xb_add(unsigned* p, unsigned v) { return __hip_atomic_fetch_add(p, v, __ATOMIC_RELAXED, __HIP_MEMORY_SCOPE_AGENT); }
DEVI unsigned xb_xcc_id() { return (unsigned)__builtin_amdgcn_s_getreg((3 << 11) | 20) & 0xFu; }
#define XB_SPIN(cond, bar) do { unsigned _sp = 0; while (cond) { __builtin_amdgcn_s_sleep(1); \
    if ((++_sp & 255u) == 0u) { if (xb_ld(&(bar)[XB_TMO])) break; if (_sp > XB_SPIN_CAP) { atomicAdd(&(bar)[XB_TMO], 1u); break; } } } } while (0)

DEVI void xcd_barrier_complete(unsigned* bar, unsigned x, unsigned& nloc, unsigned& nx) {
  const unsigned G = gridDim.x;
  unsigned sum, cnt, mine, sp = 0u;
  for (;;) {
    sum = 0u; cnt = 0u; mine = 0u;
#pragma unroll
    for (unsigned j = 0; j < 16; ++j) { const unsigned c = xb_ld(&bar[XB_XCNT(j)]); sum += c; cnt += (c > 0u) ? 1u : 0u; mine = (j == x) ? c : mine; }
    if (sum == G) break;
    __builtin_amdgcn_s_sleep(1);
    if ((++sp & 255u) == 0u) { if (xb_ld(&bar[XB_TMO])) break; if (sp > XB_SPIN_CAP) { atomicAdd(&bar[XB_TMO], 1u); break; } }
  }
  nloc = mine > 0u ? mine : 1u; nx = cnt > 0u ? cnt : 1u;
}

DEVI void grid_barrier(unsigned* bar, unsigned xcc, volatile unsigned* st) {
  asm volatile("s_waitcnt vmcnt(0)" ::: "memory");
  __syncthreads();
  if (threadIdx.x == 0) {
    __builtin_amdgcn_s_waitcnt(0);
    unsigned nloc = st[0], nx = st[1];
    if (nloc == 0u) { xcd_barrier_complete(bar, xcc, nloc, nx); st[0] = nloc; st[1] = nx; }
    const unsigned old = xb_add(&bar[XB_XSUB(xcc)], 1u);
    const unsigned gen = old / nloc;
    if (old + 1u == (gen + 1u) * nloc) {
      __builtin_amdgcn_fence(__ATOMIC_RELEASE, "agent");
      asm volatile("s_waitcnt vmcnt(0)" ::: "memory");
      const unsigned og = xb_add(&bar[XB_TOP], 1u);
      const unsigned tg = og / nx;
      if (og + 1u == (tg + 1u) * nx) xb_add(&bar[XB_TOPGEN], 1u);
      else XB_SPIN(xb_ld(&bar[XB_TOPGEN]) == tg, bar);
      __builtin_amdgcn_fence(__ATOMIC_ACQUIRE, "agent");
      xb_add(&bar[XB_XGEN(xcc)], 1u);
      asm volatile("s_waitcnt vmcnt(0)" ::: "memory");
    } else {
      XB_SPIN(xb_ld(&bar[XB_XGEN(xcc)]) == gen, bar);
      __builtin_amdgcn_fence(__ATOMIC_ACQUIRE, "agent");
      asm volatile("s_waitcnt vmcnt(0)" ::: "memory");
    }
  }
  __syncthreads();
}

#ifndef REP_NSA
#define REP_NSA 1
#endif
#ifndef REP_P0
#define REP_P0 1
#endif
#ifndef REP_P1
#define REP_P1 1
#endif
#ifndef REP_P2
#define REP_P2 1
#endif
#ifndef REP_P3
#define REP_P3 1
#endif
#ifndef REP_P4
#define REP_P4 1
#endif
#ifndef REP_P5
#define REP_P5 1
#endif
#ifndef REP_P6
#define REP_P6 1
#endif
#ifndef REP_P7
#define REP_P7 1
#endif
#ifndef REP_P8
#define REP_P8 1
#endif
#ifndef REP_P9
#define REP_P9 1
#endif
#ifndef REP_P10
#define REP_P10 1
#endif
#ifndef REP_P11
#define REP_P11 1
#endif
#ifndef REP_P12
#define REP_P12 1
#endif
#ifndef DBG_STOP
#define DBG_STOP 99
#endif
DEVI void dbg_probe_bf16(const Params& p, size_t off, long n) {
  const bf16_t* b = (const bf16_t*)(p.ws + off);
  for (long i = (long)blockIdx.x * 256 + threadIdx.x; i < 16384L * 1024; i += (long)gridDim.x * 256) {
    float v = bf2f(b[i % n]);
    if (!(v == v) || fabsf(v) > 1e30f) v = 777.f;
    p.out[i] = v;
  }
}
DEVI void dbg_probe_f32(const Params& p, size_t off, long n) {
  const float* b = (const float*)(p.ws + off);
  for (long i = (long)blockIdx.x * 256 + threadIdx.x; i < 16384L * 1024; i += (long)gridDim.x * 256) {
    float v = b[i % n];
    if (!(v == v) || fabsf(v) > 1e30f) v = 777.f;
    p.out[i] = v;
  }
}
DEVI void dbg_probe_combo(const Params& p) {
  const bf16_t* qn = (const bf16_t*)(p.ws + L0_QN);
  const bf16_t* ks = (const bf16_t*)(p.ws + L0_KS);
  const bf16_t* nz = (const bf16_t*)(p.ws + L0_NZ);
  const float* ig = (const float*)(p.ws + L0_IG);
  for (long i = (long)blockIdx.x * 256 + threadIdx.x; i < 16384L * 1024; i += (long)gridDim.x * 256) {
    float v = bf2f(qn[i % (16384L * 512)]) + bf2f(ks[i % (4L * 8192 * 64 * 4)]) + bf2f(nz[i % (16384L * 512)]) + ig[i % (16384L * 32)];
    if (!(v == v) || fabsf(v) > 1e30f) v = 777.f;
    p.out[i] = v;
  }
}
#define DBG_AT(k, stmt) if (DBG_STOP == k) { stmt; return; }

#define GSYNC() grid_barrier(bar_ctr, bar_xcc, bar_st)

__global__ void __launch_bounds__(256, 2) mega(Params p) {
  __shared__ __attribute__((aligned(16))) unsigned char smem[79872];
  cg::grid_group grid = cg::this_grid();
  const int G = gridDim.x, bid = blockIdx.x, tid = threadIdx.x, lane = tid & 63, w = tid >> 6;
  unsigned char* ws = p.ws;
  bf16_t* sA = (bf16_t*)smem;
  bf16_t* sB = (bf16_t*)(smem + 16384);
  unsigned* bar_ctr = (unsigned*)(ws + OFF_BAR);
  __shared__ uint4 xb_words;
  if (tid == 0) xb_words = make_uint4(0u, 0u, 0u, 0u);
  __syncthreads();
  volatile unsigned* bar_st = (volatile unsigned*)&xb_words;
  const unsigned bar_xcc = xb_xcc_id();
  if (tid == 0) (void)xb_add(&bar_ctr[XB_XCNT(bar_xcc)], 1u);
  if (p.ws == nullptr) grid.sync();

#ifdef EXTRA_SYNCS
  for (int e_ = 0; e_ < EXTRA_SYNCS; ++e_) GSYNC();
#endif
  for (int rep_ = 0; rep_ < REP_P0; ++rep_) {
  phase0(p, smem);
  GSYNC();
  }
  DBG_AT(0, dbg_probe_bf16(p, L0_H, 16384L*1024))
  for (int rep_ = 0; rep_ < REP_P1; ++rep_) {
  for (int k_ = 0; k_ * (G >> 3) < 16 * 35; ++k_) {
    int tm, tn;
    if (!gemm_tile_xcd(bid, G, k_, 35, tm, tn)) continue;
    gemm128<false>((const bf16_t*)(ws + L0_H), 1024, 16383, (const bf16_t*)(ws + OFF_WIN0), 1024, 4383, 1024, tm * 128, tn * 128, sA, sB,
            [&](f32x4 (&acc)[4][4], int mb, int nb, int ln) { epi_proj0(p, acc, mb, nb, ln); });
  }
  GSYNC();
  }
  DBG_AT(1, dbg_probe_bf16(p, L0_QKRAW, 16384L*1024)) DBG_AT(101, dbg_probe_combo(p)) DBG_AT(102, dbg_probe_bf16(p, L0_KS, 4L*8192*64*4)) DBG_AT(103, dbg_probe_f32(p, L0_IG, 16384L*4*2+16384L*24)) DBG_AT(104, dbg_probe_bf16(p, L0_MVT, 16384L*512*3))
  for (int rep_ = 0; rep_ < REP_P2; ++rep_) {
  for (int it = bid; it < 128 + 2048; it += G) {
    if (it < 128) {
      int ksp = it >> 5, kv = (it >> 4) & 1, bg = (it >> 2) & 3, tm = it & 3;
      const bf16_t* A = (const bf16_t*)(ws + (kv ? L0_VCRAW : L0_KCRAW)) + (long)bg * 8192 * 64 + ksp * 512;
      const bf16_t* B = (const bf16_t*)(ws + (kv ? OFF_WCV : OFF_WCK)) + ksp * 512;
      gemm128<false>(A, 1024, 510, B, 2048, 127, 512, tm * 128, 0, sA, sB,
              [&](f32x4 (&acc)[4][4], int mb, int nb, int ln) { epi_cmp_hidden(p, acc, mb, nb, ln, kv, bg, ksp); });
    } else {
      conv_tile(p, it - 128, smem);
    }
  }
  GSYNC();
  }
  DBG_AT(2, dbg_probe_bf16(p, L0_QC, 16384L*512*3)) DBG_AT(201, dbg_probe_f32(p, L0_HID, 2L*4*512*128))
  for (int rep_ = 0; rep_ < REP_P3; ++rep_) {
  for (int it = bid; it < 512 + 1024; it += G) {
    if (it < 512) mlstm_local(p, it, smem);
    else { const int t_ = opaque_tid(); cmp_finalize(p, (it - 512) * 4 + (t_ >> 6), t_ & 63); }
  }
  GSYNC();
  }
  DBG_AT(3, dbg_probe_f32(p, L0_H, 512L*16384)) DBG_AT(301, dbg_probe_bf16(p, L0_KCMP, 4L*512*64*2)) DBG_AT(302, dbg_probe_f32(p, L0_DN, 512L*128 + 2048))
  for (int rep_ = 0; rep_ < REP_P4; ++rep_) {
#ifdef DUMMY_P4
  mlstm_scan<true>(p, smem);
  GSYNC();
#endif
  mlstm_scan<false>(p, smem);
  GSYNC();
  }
  DBG_AT(4, dbg_probe_f32(p, L0_H, 512L*16384)) DBG_AT(401, dbg_probe_f32(p, L0_DN, 512L*128 + 3072))
  for (int rep_ = 0; rep_ < REP_P5; ++rep_) {
  for (int it = bid; it < 1024 + 1024; it += G) {
    if (it < 1024) {
      int k = it >> 9, i = it & 511;
      int idx = (k & 1) ? (k * 512 + 511 - i) : it;
#ifndef DBG_SKIP_NSA
      for (int r2_ = 0; r2_ < REP_NSA; ++r2_) nsa_tile(p, idx, smem);
#endif
    } else {
#ifndef DBG_SKIP_MOUT
      mlstm_out(p, it - 1024, smem);
#endif
    }
  }
  GSYNC();
  }
  DBG_AT(5, dbg_probe_bf16(p, L0_QKRAW, 16384L*1024))
  for (int rep_ = 0; rep_ < REP_P6; ++rep_) {
  for (int k_ = 0; k_ * (G >> 3) < 16 * 8; ++k_) {
    int tm, tn;
    if (!gemm_tile_xcd(bid, G, k_, 8, tm, tn)) continue;
    gemm128<false>((const bf16_t*)(ws + L0_QKRAW), 1024, 16383, (const bf16_t*)(ws + OFF_WOUT0), 1024, 1023, 1024, tm * 128, tn * 128, sA, sB,
            [&](f32x4 (&acc)[4][4], int mb, int nb, int ln) { epi_out_resid(p.x, p.out, acc, mb, nb, ln); });
  }
  GSYNC();
  }
  DBG_AT(6, (void)0)
  for (int rep_ = 0; rep_ < REP_P7; ++rep_) {
  { const int t_ = opaque_tid(); for (int row = (bid * 4 + (t_ >> 6)) * 2; row < 16384; row += G * 8) rmsnorm_row2(p.out, p.norm_w + 1024, (bf16_t*)(ws + L1_H), row, row + 1, t_ & 63); }
  GSYNC();
  }
  DBG_AT(7, dbg_probe_bf16(p, L1_H, 16384L*1024))
  for (int rep_ = 0; rep_ < REP_P8; ++rep_) {
  for (int k_ = 0; k_ * (G >> 3) < 16 * 32; ++k_) {
    int tm, tn;
    if (!gemm_tile_xcd(bid, G, k_, 32, tm, tn)) continue;
    gemm128<false>((const bf16_t*)(ws + L1_H), 1024, 16383, (const bf16_t*)(ws + OFF_WIN1), 1024, 4095, 1024, tm * 128, tn * 128, sA, sB,
            [&](f32x4 (&acc)[4][4], int mb, int nb, int ln) { epi_proj1(p, acc, mb, nb, ln); });
  }
  GSYNC();
  }
  DBG_AT(8, dbg_probe_bf16(p, L1_FP, 16384L*1024*4))
  for (int rep_ = 0; rep_ < REP_P9; ++rep_) {
  for (int it = bid; it < 2048; it += G) hgrn_local(p, it, smem);
  GSYNC();
  }
  DBG_AT(9, dbg_probe_bf16(p, L1_ST, 2048L*16384))
  for (int rep_ = 0; rep_ < REP_P10; ++rep_) {
#ifdef DUMMY_P10
  hgrn_scan<true>(p);
  GSYNC();
#endif
  hgrn_scan<false>(p);
  GSYNC();
  }
  DBG_AT(10, dbg_probe_bf16(p, L1_ST, 2048L*16384))
  for (int rep_ = 0; rep_ < REP_P11; ++rep_) {
  for (int it = bid; it < 2048; it += G) hgrn_out(p, it, smem);
  GSYNC();
  }
  DBG_AT(11, dbg_probe_bf16(p, L1_H, 16384L*1024))
  for (int rep_ = 0; rep_ < REP_P12; ++rep_) {
  for (int k_ = 0; k_ * (G >> 3) < 16 * 8; ++k_) {
    int tm, tn;
    if (!gemm_tile_xcd(bid, G, k_, 8, tm, tn)) continue;
    gemm128<false>((const bf16_t*)(ws + L1_H), 1024, 16383, (const bf16_t*)(ws + OFF_WOUT1), 1024, 1023, 1024, tm * 128, tn * 128, sA, sB,
            [&](f32x4 (&acc)[4][4], int mb, int nb, int ln) { epi_out_resid(p.out, p.out, acc, mb, nb, ln); });
  }
  }
}

extern "C" void kernel_launch(void* const* d_in, const int* in_sizes, int n_in, void* d_out, int out_size, void* d_ws, size_t ws_size,
                              hipStream_t stream) {
  static int grid_blocks = 0;
  if (!grid_blocks) {
    int dev = 0, cus = 0, per_cu = 0;
    (void)hipGetDevice(&dev);
    (void)hipDeviceGetAttribute(&cus, hipDeviceAttributeMultiprocessorCount, dev);
    (void)hipOccupancyMaxActiveBlocksPerMultiprocessor(&per_cu, mega, 256, 0);
    if (per_cu > 2) per_cu = 2;
    if (per_cu < 1) per_cu = 1;
    grid_blocks = cus * per_cu;
  }
  Params p{};
  const float** pf = (const float**)&p;
  for (int i = 0; i < 22; ++i) pf[i] = (const float*)d_in[i];
  p.out = (float*)d_out;
  p.ws = (unsigned char*)d_ws;
  (void)hipMemsetAsync((unsigned char*)d_ws + OFF_BAR, 0, 16384, stream);
  void* args[] = {&p};
  hipError_t e = hipLaunchCooperativeKernel((void*)mega, dim3(grid_blocks), dim3(256), args, 0, stream);
  if (e != hipSuccess) fprintf(stderr, "cooperative launch failed: %s (grid %d)\n", hipGetErrorString(e), grid_blocks);
}
```

```cpp
#include <hip/hip_runtime.h>
#include <hip/hip_cooperative_groups.h>
#include <stdint.h>
#include <cstdio>
namespace cg = cooperative_groups;

typedef unsigned short bf16_t;
typedef __attribute__((ext_vector_type(8))) short bf16x8;
typedef __attribute__((ext_vector_type(4))) float f32x4;
typedef __attribute__((ext_vector_type(4))) unsigned int u32x4;

#define DEVI __device__ __forceinline__
#define EPSF 1e-6f
#define LDT 72
#define SLD 68
#define NEGS (-1e30f)
#define LAUNDER(ptr) asm volatile("" : "+s"(ptr))

struct Params {
  const float* x; const float* norm_w; const float* ev_w_in; const float* ev_b_in; const float* f_bias;
  const float* conv_w; const float* conv_b; const float* m_hn; const float* q_norm; const float* k_norm;
  const float* ck_pos; const float* ck_w1; const float* ck_w2; const float* cv_pos; const float* cv_w1; const float* cv_w2;
  const float* ev_w_out; const float* od_w_in; const float* od_b_in; const float* lb_logits; const float* h_hn; const float* od_w_out;
  float* out; unsigned char* ws;
};

constexpr size_t MiB = 1048576;
constexpr size_t OFF_WIN0 = 0;
constexpr size_t OFF_WOUT0 = OFF_WIN0 + 4480ull * 1024 * 2;
constexpr size_t OFF_WIN1 = OFF_WOUT0 + 2 * MiB;
constexpr size_t OFF_WOUT1 = OFF_WIN1 + 8 * MiB;
constexpr size_t OFF_WCK = OFF_WOUT1 + 2 * MiB;
constexpr size_t OFF_WCV = OFF_WCK + 512 * 1024;
constexpr size_t OFF_ROPE = OFF_WCV + 512 * 1024;
constexpr size_t OFF_PB = OFF_ROPE + 512 * 1024;
constexpr size_t OFF_LB = OFF_PB + 1024;
constexpr size_t OFF_BAR = OFF_LB + 4096;
constexpr size_t OFF_BASE = 24 * MiB;
constexpr size_t L0_H = OFF_BASE;
constexpr size_t L0_QKRAW = L0_H + 32 * MiB;
constexpr size_t L0_QC = L0_QKRAW + 32 * MiB;
constexpr size_t L0_KC = L0_QC + 16 * MiB;
constexpr size_t L0_KCT = L0_KC + 16 * MiB;
constexpr size_t L0_MVT = L0_KCT + 16 * MiB;
constexpr size_t L0_MO = L0_MVT + 16 * MiB;
constexpr size_t L0_MZ = L0_MO + 16 * MiB;
constexpr size_t L0_QN = L0_MZ + 16 * MiB;
constexpr size_t L0_NZ = L0_QN + 16 * MiB;
constexpr size_t L0_KCRAW = L0_NZ + 16 * MiB;
constexpr size_t L0_VCRAW = L0_KCRAW + 4 * MiB;
constexpr size_t L0_KS = L0_VCRAW + 4 * MiB;
constexpr size_t L0_KW = L0_KS + 4 * MiB;
constexpr size_t L0_VST = L0_KW + 4 * MiB;
constexpr size_t L0_VWT = L0_VST + 4 * MiB;
constexpr size_t L0_HID = L0_VWT + 4 * MiB;
constexpr size_t L0_KCMP = L0_HID + 2 * MiB;
constexpr size_t L0_VCMPT = L0_KCMP + 256 * 1024;
constexpr size_t L0_IG = L0_VCMPT + 256 * 1024;
constexpr size_t L0_LOGF = L0_IG + 256 * 1024;
constexpr size_t L0_GATES = L0_LOGF + 256 * 1024;
constexpr size_t L0_DN = L0_GATES + 1536 * 1024;
constexpr size_t L0_BL = L0_DN + 256 * 1024;
constexpr size_t L0_MLOC = L0_BL + 4096;
constexpr size_t L0_MIN = L0_MLOC + 4096;
constexpr size_t L0_HIDP = L0_MIN + 4096;
constexpr size_t L0_END = L0_HIDP + 8 * MiB;
static_assert(L0_END <= 256 * MiB, "ws overflow L0");
constexpr size_t L1_H = OFF_BASE;
constexpr size_t L1_FP = L1_H + 32 * MiB;
constexpr size_t L1_Q = L1_FP + 32 * MiB;
constexpr size_t L1_VT = L1_Q + 32 * MiB;
constexpr size_t L1_Z = L1_VT + 32 * MiB;
constexpr size_t L1_ST = L1_Z + 32 * MiB;
constexpr size_t L1_BL = L1_ST + 64 * MiB;
constexpr size_t L1_END = L1_BL + 1 * MiB;
static_assert(L1_END <= 256 * MiB, "ws overflow L1");

DEVI int opaque_tid() { int t = threadIdx.x; asm volatile("" : "+v"(t)); return t; }
typedef __bf16 bf16v2_t __attribute__((ext_vector_type(2)));
typedef float f32v2_t __attribute__((ext_vector_type(2)));
DEVI bf16_t f2bf(float f) { __bf16 h = (__bf16)f; return __builtin_bit_cast(unsigned short, h); }
DEVI float bf2f(bf16_t b) { return __uint_as_float(((unsigned)b) << 16); }
DEVI unsigned pack2(float a, float b) { f32v2_t f = {a, b}; bf16v2_t h = __builtin_convertvector(f, bf16v2_t); return __builtin_bit_cast(unsigned, h); }
DEVI float lo2f(unsigned u) { return __uint_as_float(u << 16); }
DEVI float hi2f(unsigned u) { return __uint_as_float(u & 0xffff0000u); }
DEVI float sigm(float x) { return 1.f / (1.f + __expf(-x)); }
DEVI float siluf(float x) { return x * sigm(x); }
DEVI float wave_sum(float v) { for (int o = 32; o > 0; o >>= 1) v += __shfl_xor(v, o); return v; }
DEVI float grp16_sum(float v) { v += __shfl_xor(v, 1); v += __shfl_xor(v, 2); v += __shfl_xor(v, 4); v += __shfl_xor(v, 8); return v; }

DEVI void wave_scan_sum128(float& a, float& b, int lane) {
  float t = a + b;
  float s = t;
#pragma unroll
  for (int o = 1; o < 64; o <<= 1) { float u = __shfl_up(s, o); if (lane >= o) s += u; }
  const float excl = s - t;
  a = excl + a;
  b = a + b;
}
DEVI void wave_scan_max128(float& a, float& b, int lane) {
  float t = fmaxf(a, b);
  float s = t;
#pragma unroll
  for (int o = 1; o < 64; o <<= 1) { float u = __shfl_up(s, o); if (lane >= o) s = fmaxf(s, u); }
  float prev = __shfl_up(s, 1);
  if (lane == 0) prev = -3.0e38f;
  a = fmaxf(prev, a);
  b = fmaxf(a, b);
}
DEVI float wave_max(float v) { for (int o = 32; o > 0; o >>= 1) v = fmaxf(v, __shfl_xor(v, o)); return v; }
DEVI int oldcol(int n) {
  return n < 2560 ? n : (n < 3840 ? n + 8 : (n < 4352 ? n + 32 : (n < 4360 ? n - 4352 + 2560 : n - 4360 + 3848)));
}

template <int MT, int NTL, int KS>
DEVI void mma_lds(const bf16_t* sA, const bf16_t* sB, f32x4 (&acc)[MT][NTL], int lane, bool neg = false) {
  const int r = lane & 15, q = lane >> 4;
#pragma unroll
  for (int ks = 0; ks < KS; ++ks) {
    bf16x8 a[MT], b[NTL];
#pragma unroll
    for (int mt = 0; mt < MT; ++mt) a[mt] = *(const bf16x8*)(sA + (mt * 16 + r) * LDT + ks * 32 + q * 8);
    if (neg) {
#pragma unroll
      for (int mt = 0; mt < MT; ++mt) a[mt] ^= (short)0x8000;
    }
#pragma unroll
    for (int nt = 0; nt < NTL; ++nt) b[nt] = *(const bf16x8*)(sB + (nt * 16 + r) * LDT + ks * 32 + q * 8);
#pragma unroll
    for (int mt = 0; mt < MT; ++mt)
#pragma unroll
      for (int nt = 0; nt < NTL; ++nt) acc[mt][nt] = __builtin_amdgcn_mfma_f32_16x16x32_bf16(a[mt], b[nt], acc[mt][nt], 0, 0, 0);
  }
}
template <int MT, int NTL, int KS>
DEVI void mma_lds_sw(const bf16_t* sA, const bf16_t* sB, f32x4 (&acc)[MT][NTL], int lane, bool neg = false) {
  const int r = lane & 15, q = lane >> 4;
#pragma unroll
  for (int ks = 0; ks < KS; ++ks) {
    bf16x8 a[MT], b[NTL];
#pragma unroll
    for (int mt = 0; mt < MT; ++mt) a[mt] = *(const bf16x8*)(sA + (mt * 16 + r) * LDT + ks * 32 + q * 8);
    if (neg) {
#pragma unroll
      for (int mt = 0; mt < MT; ++mt) a[mt] ^= (short)0x8000;
    }
#pragma unroll
    for (int nt = 0; nt < NTL; ++nt) b[nt] = *(const bf16x8*)(sB + (nt * 16 + r) * LDT + ks * 32 + q * 8);
#pragma unroll
    for (int mt = 0; mt < MT; ++mt)
#pragma unroll
      for (int nt = 0; nt < NTL; ++nt) acc[mt][nt] = __builtin_amdgcn_mfma_f32_16x16x32_bf16(b[nt], a[mt], acc[mt][nt], 0, 0, 0);
  }
}


template <int MT, int NTL, bool SWAP>
DEVI void mma_swz(const bf16_t* sA, const bf16_t* sB, f32x4 (&acc)[MT][NTL], int lane, bool neg) {
  const int r = lane & 15, q = lane >> 4, r7 = r & 7;
#pragma unroll
  for (int ks = 0; ks < 2; ++ks) {
    bf16x8 a[MT], b[NTL];
    const int co = ((ks * 4 + q) ^ r7) * 8;
#pragma unroll
    for (int mt = 0; mt < MT; ++mt) a[mt] = *(const bf16x8*)(sA + (mt * 16 + r) * 64 + co);
#pragma unroll
    for (int nt = 0; nt < NTL; ++nt) b[nt] = *(const bf16x8*)(sB + (nt * 16 + r) * 64 + co);
    if (neg) {
#pragma unroll
      for (int mt = 0; mt < MT; ++mt) a[mt] ^= (short)0x8000;
    }
#pragma unroll
    for (int mt = 0; mt < MT; ++mt)
#pragma unroll
      for (int nt = 0; nt < NTL; ++nt) {
        if (SWAP) acc[mt][nt] = __builtin_amdgcn_mfma_f32_16x16x32_bf16(b[nt], a[mt], acc[mt][nt], 0, 0, 0);
        else acc[mt][nt] = __builtin_amdgcn_mfma_f32_16x16x32_bf16(a[mt], b[nt], acc[mt][nt], 0, 0, 0);
      }
  }
}

DEVI void load_tile128(bf16_t* s, const bf16_t* g, long ld) {
  const int tid = opaque_tid(), lr = tid >> 3, lk = (tid & 7) * 8;
#pragma unroll
  for (int j = 0; j < 4; ++j) *(uint4*)(s + (lr + 32 * j) * LDT + lk) = *(const uint4*)(g + (long)(lr + 32 * j) * ld + lk);
}
DEVI void load_tile64(bf16_t* s, const bf16_t* g, long ld) {
  const int tid = opaque_tid(), lr = tid >> 3, lk = (tid & 7) * 8;
#pragma unroll
  for (int j = 0; j < 2; ++j) *(uint4*)(s + (lr + 32 * j) * LDT + lk) = *(const uint4*)(g + (long)(lr + 32 * j) * ld + lk);
}

template <bool SWAP, class Epi>
DEVI void gemm128(const bf16_t* A, long lda, int amax, const bf16_t* B, long ldb, int bmax, int K, int m0, int n0,
                  bf16_t* sA, bf16_t* sB, Epi&& epi) {
  const int tid = opaque_tid(), lane = tid & 63, w = tid >> 6, wr = w >> 1, wc = w & 1;
  const int lr = tid >> 3, lk = (tid & 7) * 8;
  const int lsw = (((tid & 7) ^ (lr & 7)) * 8);
  f32x4 acc[4][4];
#pragma unroll
  for (int mt = 0; mt < 4; ++mt)
#pragma unroll
    for (int nt = 0; nt < 4; ++nt) acc[mt][nt] = f32x4{0.f, 0.f, 0.f, 0.f};
  const bf16_t* ap[4];
  const bf16_t* bp[4];
#pragma unroll
  for (int j = 0; j < 4; ++j) {
    int ra = min(m0 + lr + 32 * j, amax);
    ap[j] = A + (long)ra * lda + lk;
    int rb = min(n0 + lr + 32 * j, bmax);
    bp[j] = B + (long)rb * ldb + lk;
  }
#ifndef GEMM_PASSES
#define GEMM_PASSES 1
#endif
  for (int pass_ = 0; pass_ < GEMM_PASSES; ++pass_) {
  u32x4 va0, va1, va2, va3, vb0, vb1, vb2, vb3;
  va0 = *(const u32x4*)(ap[0]); va1 = *(const u32x4*)(ap[1]); va2 = *(const u32x4*)(ap[2]); va3 = *(const u32x4*)(ap[3]);
  vb0 = *(const u32x4*)(bp[0]); vb1 = *(const u32x4*)(bp[1]); vb2 = *(const u32x4*)(bp[2]); vb3 = *(const u32x4*)(bp[3]);
  const int KT = K >> 6;
  *(u32x4*)(sA + (lr + 0) * 64 + lsw) = va0; *(u32x4*)(sA + (lr + 32) * 64 + lsw) = va1;
  *(u32x4*)(sA + (lr + 64) * 64 + lsw) = va2; *(u32x4*)(sA + (lr + 96) * 64 + lsw) = va3;
  *(u32x4*)(sB + (lr + 0) * 64 + lsw) = vb0; *(u32x4*)(sB + (lr + 32) * 64 + lsw) = vb1;
  *(u32x4*)(sB + (lr + 64) * 64 + lsw) = vb2; *(u32x4*)(sB + (lr + 96) * 64 + lsw) = vb3;
  if (KT > 1) {
    va0 = *(const u32x4*)(ap[0] + 64); va1 = *(const u32x4*)(ap[1] + 64); va2 = *(const u32x4*)(ap[2] + 64); va3 = *(const u32x4*)(ap[3] + 64);
    vb0 = *(const u32x4*)(bp[0] + 64); vb1 = *(const u32x4*)(bp[1] + 64); vb2 = *(const u32x4*)(bp[2] + 64); vb3 = *(const u32x4*)(bp[3] + 64);
  }
  __syncthreads();
  for (int kt = 0; kt < KT; ++kt) {
    const int st = (kt & 1) * 16384;
    const int sn = ((kt + 1) & 1) * 16384;
    if (kt + 1 < KT) {
      *(u32x4*)(sA + sn + (lr + 0) * 64 + lsw) = va0; *(u32x4*)(sA + sn + (lr + 32) * 64 + lsw) = va1;
      *(u32x4*)(sA + sn + (lr + 64) * 64 + lsw) = va2; *(u32x4*)(sA + sn + (lr + 96) * 64 + lsw) = va3;
      *(u32x4*)(sB + sn + (lr + 0) * 64 + lsw) = vb0; *(u32x4*)(sB + sn + (lr + 32) * 64 + lsw) = vb1;
      *(u32x4*)(sB + sn + (lr + 64) * 64 + lsw) = vb2; *(u32x4*)(sB + sn + (lr + 96) * 64 + lsw) = vb3;
    }
    if (kt + 2 < KT) {
      const int ko = (kt + 2) * 64;
      va0 = *(const u32x4*)(ap[0] + ko); va1 = *(const u32x4*)(ap[1] + ko); va2 = *(const u32x4*)(ap[2] + ko); va3 = *(const u32x4*)(ap[3] + ko);
      vb0 = *(const u32x4*)(bp[0] + ko); vb1 = *(const u32x4*)(bp[1] + ko); vb2 = *(const u32x4*)(bp[2] + ko); vb3 = *(const u32x4*)(bp[3] + ko);
    }
    __builtin_amdgcn_sched_barrier(0);
    __builtin_amdgcn_s_setprio(2);
    mma_swz<4, 4, SWAP>(sA + st + wr * 64 * 64, sB + st + wc * 64 * 64, acc, lane, (pass_ & 1) != 0);
    __builtin_amdgcn_s_setprio(0);
    __syncthreads();
  }
  }
  epi(acc, m0 + wr * 64, n0 + wc * 64, lane);
}


DEVI bool gemm_tile_xcd(int bid, int G, int k, int NTN, int& tm, int& tn) {
  const int x = bid & 7, per = G >> 3;
  const int u = (bid >> 3) + per * k;
  const int full_groups = NTN >> 3, rem = NTN & 7;
  const int n_full = full_groups * 2 * 64;
  if (u < n_full) {
    const int sb = u >> 6, wi = u & 63;
    const int tg = sb >> 1, th = sb & 1;
    tm = x * 16 + th * 8 + (wi >> 3);
    tn = tg * 8 + (wi & 7);
    return true;
  }
  const int v = u - n_full;
  if (v >= 16 * rem) return false;
  tm = x * 16 + v / rem;
  tn = full_groups * 8 + v % rem;
  return true;
}

DEVI void transpose_tile(const float* src, int N, int ldsrc, bf16_t* dst, int K, int ktile, int ntile, bool perm, float* sT) {
  const int tid = opaque_tid();
  const int k0 = ktile * 64, n0 = ntile * 64;
#pragma unroll
  for (int j = 0; j < 4; ++j) {
    int idx = tid + 256 * j;
    int kk = idx >> 4, n4 = (idx & 15) * 4;
    int n = n0 + n4;
    float4 v = make_float4(0.f, 0.f, 0.f, 0.f);
    if (n < N) { int oc = perm ? oldcol(n) : n; v = *(const float4*)(src + (long)(k0 + kk) * ldsrc + oc); }
    sT[kk * 65 + n4 + 0] = v.x; sT[kk * 65 + n4 + 1] = v.y; sT[kk * 65 + n4 + 2] = v.z; sT[kk * 65 + n4 + 3] = v.w;
  }
  __syncthreads();
#pragma unroll
  for (int j = 0; j < 2; ++j) {
    int idx = tid + 256 * j;
    int nn = idx >> 3, kc = (idx & 7) * 8;
    if (n0 + nn < N) {
      uint4 o;
      o.x = pack2(sT[(kc + 0) * 65 + nn], sT[(kc + 1) * 65 + nn]);
      o.y = pack2(sT[(kc + 2) * 65 + nn], sT[(kc + 3) * 65 + nn]);
      o.z = pack2(sT[(kc + 4) * 65 + nn], sT[(kc + 5) * 65 + nn]);
      o.w = pack2(sT[(kc + 6) * 65 + nn], sT[(kc + 7) * 65 + nn]);
      *(uint4*)(dst + (long)(n0 + nn) * K + k0 + kc) = o;
    }
  }
  __syncthreads();
}

DEVI void rmsnorm_row2(const float* X, const float* w, bf16_t* H, int row0, int row1, int lane) {
  const float4* xa = (const float4*)(X + (long)row0 * 1024);
  const float4* xb = (const float4*)(X + (long)row1 * 1024);
  float4 va[4], vb[4], ww[4];
#pragma unroll
  for (int j = 0; j < 4; ++j) { va[j] = xa[lane + 64 * j]; vb[j] = xb[lane + 64 * j]; ww[j] = ((const float4*)w)[lane + 64 * j]; }
  float sa = 0.f, sb = 0.f;
#pragma unroll
  for (int j = 0; j < 4; ++j) {
    sa += va[j].x * va[j].x + va[j].y * va[j].y + va[j].z * va[j].z + va[j].w * va[j].w;
    sb += vb[j].x * vb[j].x + vb[j].y * vb[j].y + vb[j].z * vb[j].z + vb[j].w * vb[j].w;
  }
  sa = wave_sum(sa); sb = wave_sum(sb);
  const float ra = rsqrtf(sa * (1.f / 1024.f) + EPSF), rb = rsqrtf(sb * (1.f / 1024.f) + EPSF);
#pragma unroll
  for (int j = 0; j < 4; ++j) {
    uint2 o;
    o.x = pack2(va[j].x * ra * ww[j].x, va[j].y * ra * ww[j].y);
    o.y = pack2(va[j].z * ra * ww[j].z, va[j].w * ra * ww[j].w);
    *(uint2*)(H + (long)row0 * 1024 + (lane + 64 * j) * 4) = o;
    o.x = pack2(vb[j].x * rb * ww[j].x, vb[j].y * rb * ww[j].y);
    o.y = pack2(vb[j].z * rb * ww[j].z, vb[j].w * rb * ww[j].w);
    *(uint2*)(H + (long)row1 * 1024 + (lane + 64 * j) * 4) = o;
  }
}

DEVI void phase0(const Params& p, unsigned char* smem) {
  const int G = gridDim.x, bid = blockIdx.x, tid = threadIdx.x, lane = tid & 63, w = tid >> 6;
  unsigned char* ws = p.ws;
  float* sT = (float*)smem;
  for (int it = bid; it < 69 * 16; it += G) transpose_tile(p.ev_w_in, 4384, 4384, (bf16_t*)(ws + OFF_WIN0), 1024, it / 69, it % 69, true, sT);
  for (int it = bid; it < 16 * 16; it += G) transpose_tile(p.ev_w_out, 1024, 1024, (bf16_t*)(ws + OFF_WOUT0), 1024, it / 16, it % 16, false, sT);
  for (int it = bid; it < 64 * 16; it += G) transpose_tile(p.od_w_in, 4096, 4096, (bf16_t*)(ws + OFF_WIN1), 1024, it / 64, it % 64, false, sT);
  for (int it = bid; it < 16 * 16; it += G) transpose_tile(p.od_w_out, 1024, 1024, (bf16_t*)(ws + OFF_WOUT1), 1024, it / 16, it % 16, false, sT);
  for (int it = bid; it < 2 * 32; it += G) transpose_tile(p.ck_w1, 128, 128, (bf16_t*)(ws + OFF_WCK), 2048, it / 2, it % 2, false, sT);
  for (int it = bid; it < 2 * 32; it += G) transpose_tile(p.cv_w1, 128, 128, (bf16_t*)(ws + OFF_WCV), 2048, it / 2, it % 2, false, sT);
  for (int row = (bid * 4 + w) * 2; row < 16384; row += G * 8) rmsnorm_row2(p.x, p.norm_w, (bf16_t*)(ws + L0_H), row, row + 1, lane);
  for (int idx = bid * 256 + tid; idx < 8192 * 8; idx += G * 256) {
    int t = idx >> 3, i = idx & 7;
    float invf = powf(500000.0f, -(float)i / 8.0f);
    float ang = (float)t * invf;
    double a = (double)ang;
    float2 cs;
    cs.x = (float)cos(a);
    cs.y = (float)sin(a);
    ((float2*)(ws + OFF_ROPE))[idx] = cs;
  }
  for (int o = bid * 4 + w; o < 256; o += G * 4) {
    int kv = o >> 7, j = o & 127;
    const float* pos = kv ? p.cv_pos : p.ck_pos;
    const float* w1 = kv ? p.cv_w1 : p.ck_w1;
    float sacc_ = 0.f;
#pragma unroll 8
    for (int i = lane; i < 2048; i += 64) sacc_ += pos[i] * w1[i * 128 + j];
    sacc_ = wave_sum(sacc_);
    if (lane == 0) ((float*)(ws + OFF_PB))[o] = sacc_;
  }
  if (bid == G - 2 || G < 2) {
    for (int c = tid; c < 1024; c += 256) {
      float l0 = p.lb_logits[c], l1 = p.lb_logits[1024 + c];
      ((float*)(ws + OFF_LB))[c] = 1.f / (1.f + expf(l1 - l0));
    }
  }
}

template <int MODE>
DEVI void store_rm(bf16_t* dst, int ld, int colbase, f32x4 (&acc)[4][4], const float* bias, int mb, int lane) {
  const int r = lane & 15, q = lane >> 4;
#pragma unroll
  for (int mt = 0; mt < 4; ++mt)
#pragma unroll
    for (int i = 0; i < 4; ++i) {
      long row = mb + mt * 16 + q * 4 + i;
#pragma unroll
      for (int nt = 0; nt < 4; ++nt) {
        float v = acc[mt][nt][i] + bias[nt];
        if (MODE == 1) v = sigm(v);
        if (MODE == 2) v = siluf(v);
        dst[row * ld + colbase + nt * 16 + r] = f2bf(v);
      }
    }
}
template <int MODE>
DEVI void store_T(bf16_t* dst, int bgrp, int F, int featoff, f32x4 (&acc)[4][4], const float* bias, int tl0, int lane) {
  const int r = lane & 15, q = lane >> 4;
#pragma unroll
  for (int mt = 0; mt < 4; ++mt)
#pragma unroll
    for (int nt = 0; nt < 4; ++nt) {
      int t = tl0 + mt * 16 + q * 4;
      float b = bias[nt];
      uint2 o;
      o.x = pack2(acc[mt][nt][0] + b, acc[mt][nt][1] + b);
      o.y = pack2(acc[mt][nt][2] + b, acc[mt][nt][3] + b);
      *(uint2*)(dst + (((long)bgrp * 128 + (t >> 6)) * F + featoff + nt * 16 + r) * 64 + (t & 63)) = o;
    }
}
DEVI void norm_rope_store(bf16_t* dst, long rowbase, int ld, int colbase, f32x4 (&acc)[4][4], const float* bias, const float* nw,
                          float scale, const float2* rope, int mb, int lane) {
  const int r = lane & 15, q = lane >> 4;
  float wv[4];
#pragma unroll
  for (int nt = 0; nt < 4; ++nt) wv[nt] = nw[nt * 16 + r];
  float2 csv[4][4];
#pragma unroll
  for (int mt = 0; mt < 4; ++mt)
#pragma unroll
    for (int i = 0; i < 4; ++i) csv[mt][i] = rope[((mb + mt * 16 + q * 4 + i) & 8191) * 8 + (r & 7)];
#pragma unroll
  for (int mt = 0; mt < 4; ++mt)
#pragma unroll
    for (int i = 0; i < 4; ++i) {
      int row = mb + mt * 16 + q * 4 + i;
      int t = row & 8191;
      float v[4];
      float ss = 0.f;
#pragma unroll
      for (int nt = 0; nt < 4; ++nt) { v[nt] = acc[mt][nt][i] + bias[nt]; ss += v[nt] * v[nt]; }
      ss = grp16_sum(ss);
      float rinv = rsqrtf(ss * (1.f / 64.f) + EPSF);
#pragma unroll
      for (int nt = 0; nt < 4; ++nt) v[nt] = v[nt] * rinv * wv[nt];
      float partner = __shfl_xor(v[0], 8);
      float2 cs = csv[mt][i];
      float x1 = (r < 8) ? v[0] : partner, x2 = (r < 8) ? partner : v[0];
      v[0] = (r < 8) ? (x1 * cs.x - x2 * cs.y) : (x1 * cs.y + x2 * cs.x);
#pragma unroll
      for (int nt = 0; nt < 4; ++nt) dst[(rowbase + t) * ld + colbase + nt * 16 + r] = f2bf(v[nt] * scale);
    }
}

DEVI void epi_proj0(const Params& p, f32x4 (&acc)[4][4], int mb, int nb, int lane) {
  if (nb >= 4384) return;
  unsigned char* ws = p.ws;
  const int r = lane & 15, q = lane >> 4;
  float bias[4];
#pragma unroll
  for (int nt = 0; nt < 4; ++nt) { int n = nb + nt * 16 + r; bias[nt] = (n < 4384) ? p.ev_b_in[oldcol(n)] : 0.f; }
  const int b = mb >> 13;
  const int tl0 = mb & 8191;
  const float2* rope = (const float2*)(ws + OFF_ROPE);
  if (nb < 1024) {
    store_rm<0>((bf16_t*)(ws + L0_QKRAW), 1024, nb, acc, bias, mb, lane);
  } else if (nb < 1536) {
    store_T<0>((bf16_t*)(ws + L0_MVT), b * 4 + ((nb - 1024) >> 7), 128, (nb - 1024) & 127, acc, bias, tl0, lane);
  } else if (nb < 2048) {
    store_rm<1>((bf16_t*)(ws + L0_MO), 512, nb - 1536, acc, bias, mb, lane);
  } else if (nb < 2560) {
    store_rm<2>((bf16_t*)(ws + L0_MZ), 512, nb - 2048, acc, bias, mb, lane);
  } else if (nb < 3072) {
    int head = (nb - 2560) >> 6, g = head >> 2, rr = head & 3;
    norm_rope_store((bf16_t*)(ws + L0_QN), (long)(b * 2 + g) * 8192, 256, rr * 64, acc, bias, p.q_norm, 0.125f * 1.4426950408889634f, rope, mb, lane);
  } else if (nb < 3328) {
    int g = ((nb - 3072) >> 6) & 1;
    bf16_t* dst = (bf16_t*)(ws + (nb < 3200 ? L0_KCRAW : L0_VCRAW));
    const long rowbase = (long)(b * 2 + g) * 8192;
#pragma unroll
    for (int mt = 0; mt < 4; ++mt)
#pragma unroll
      for (int i = 0; i < 4; ++i) {
        int t = (mb + mt * 16 + q * 4 + i) & 8191;
#pragma unroll
        for (int nt = 0; nt < 4; ++nt) dst[(rowbase + t) * 64 + nt * 16 + r] = f2bf(acc[mt][nt][i] + bias[nt]);
      }
  } else if (nb < 3456) {
    int g = (nb - 3328) >> 6;
    norm_rope_store((bf16_t*)(ws + L0_KS), (long)(b * 2 + g) * 8192, 64, 0, acc, bias, p.k_norm + 64, 1.f, rope, mb, lane);
  } else if (nb < 3584) {
    store_T<0>((bf16_t*)(ws + L0_VST), b * 2 + ((nb - 3456) >> 6), 64, 0, acc, bias, tl0, lane);
  } else if (nb < 3712) {
    int g = (nb - 3584) >> 6;
    norm_rope_store((bf16_t*)(ws + L0_KW), (long)(b * 2 + g) * 8192, 64, 0, acc, bias, p.k_norm + 128, 1.f, rope, mb, lane);
  } else if (nb < 3840) {
    store_T<0>((bf16_t*)(ws + L0_VWT), b * 2 + ((nb - 3712) >> 6), 64, 0, acc, bias, tl0, lane);
  } else if (nb < 4352) {
    store_rm<2>((bf16_t*)(ws + L0_NZ), 512, nb - 3840, acc, bias, mb, lane);
  } else {
    float* IG = (float*)(ws + L0_IG);
    float* LF = (float*)(ws + L0_LOGF);
    float* GT = (float*)(ws + L0_GATES);
#pragma unroll
    for (int mt = 0; mt < 4; ++mt)
#pragma unroll
      for (int i = 0; i < 4; ++i) {
        long row = mb + mt * 16 + q * 4 + i;
#pragma unroll
        for (int nt = 0; nt < 2; ++nt) {
          int c = nt * 16 + r;
          float v = acc[mt][nt][i] + bias[nt];
          if (c < 4) IG[row * 4 + c] = v;
          else if (c < 8) { float xx = v + p.f_bias[c - 4]; LF[row * 4 + c - 4] = fminf(xx, 0.f) - log1pf(__expf(-fabsf(xx))); }
          else GT[row * 24 + c - 8] = sigm(v);
        }
      }
  }
}

DEVI void epi_cmp_hidden(const Params& p, f32x4 (&acc)[4][4], int mb, int nb, int lane, int kv, int bg, int ksp) {
  const int r = lane & 15, q = lane >> 4;
  float* hid = (float*)(p.ws + L0_HIDP) + ((long)((ksp * 2 + kv) * 4 + bg) * 512) * 128;
#pragma unroll
  for (int mt = 0; mt < 4; ++mt)
#pragma unroll
    for (int i = 0; i < 4; ++i) {
      int row = mb + mt * 16 + q * 4 + i;
#pragma unroll
      for (int nt = 0; nt < 4; ++nt) hid[(long)row * 128 + nb + nt * 16 + r] = acc[mt][nt][i];
    }
}

DEVI void epi_out_resid(const float* resid, float* out, f32x4 (&acc)[4][4], int mb, int nb, int lane) {
  const int r = lane & 15, q = lane >> 4;
#pragma unroll
  for (int mt = 0; mt < 4; ++mt) {
    float rv[4][4];
#pragma unroll
    for (int i = 0; i < 4; ++i)
#pragma unroll
      for (int nt = 0; nt < 4; ++nt) rv[i][nt] = resid[(long)(mb + mt * 16 + q * 4 + i) * 1024 + nb + nt * 16 + r];
#pragma unroll
    for (int i = 0; i < 4; ++i)
#pragma unroll
      for (int nt = 0; nt < 4; ++nt) out[(long)(mb + mt * 16 + q * 4 + i) * 1024 + nb + nt * 16 + r] = rv[i][nt] + acc[mt][nt][i];
  }
}

DEVI void epi_proj1(const Params& p, f32x4 (&acc)[4][4], int mb, int nb, int lane) {
  unsigned char* ws = p.ws;
  const int r = lane & 15;
  float bias[4];
#pragma unroll
  for (int nt = 0; nt < 4; ++nt) bias[nt] = p.od_b_in[nb + nt * 16 + r];
  const int b = mb >> 13, tl0 = mb & 8191;
  if (nb < 1024) store_rm<0>((bf16_t*)(ws + L1_FP), 1024, nb, acc, bias, mb, lane);
  else if (nb < 2048) store_T<0>((bf16_t*)(ws + L1_VT), b * 8 + ((nb - 1024) >> 7), 128, (nb - 1024) & 127, acc, bias, tl0, lane);
  else if (nb < 3072) store_rm<2>((bf16_t*)(ws + L1_Q), 1024, nb - 2048, acc, bias, mb, lane);
  else store_rm<2>((bf16_t*)(ws + L1_Z), 1024, nb - 3072, acc, bias, mb, lane);
}

DEVI void conv_tile(const Params& p, int item, unsigned char* smem) {
  const int tid = opaque_tid();
  const int ctile = item & 7, ttile = item >> 3;
  const int t0g = ttile * 64;
  const int b = t0g >> 13, tl0 = t0g & 8191;
  unsigned char* ws = p.ws;
  float* sRaw = (float*)smem;
  bf16_t* sOutT = (bf16_t*)(smem + 67 * 128 * 4);
  const bf16_t* raw = (const bf16_t*)(ws + L0_QKRAW);
  for (int idx = tid; idx < 67 * 16; idx += 256) {
    int rr = idx >> 4, ch = (idx & 15) * 8;
    int tl = tl0 + rr - 3;
    uint4 v = make_uint4(0, 0, 0, 0);
    if (tl >= 0) v = *(const uint4*)(raw + (long)(b * 8192 + tl) * 1024 + ctile * 128 + ch);
    float* d = sRaw + rr * 128 + ch;
    d[0] = lo2f(v.x); d[1] = hi2f(v.x); d[2] = lo2f(v.y); d[3] = hi2f(v.y);
    d[4] = lo2f(v.z); d[5] = hi2f(v.z); d[6] = lo2f(v.w); d[7] = hi2f(v.w);
  }
  __syncthreads();
  const int c = tid & 127, th = tid >> 7;
  const int cg_ = ctile * 128 + c;
  const float w0 = p.conv_w[cg_], w1 = p.conv_w[1024 + cg_], w2 = p.conv_w[2048 + cg_], w3 = p.conv_w[3072 + cg_];
  const float cb = p.conv_b[cg_];
  const bool isk = ctile >= 4;
  bf16_t* dst = (bf16_t*)(ws + (isk ? L0_KC : L0_QC));
  const int cc = isk ? cg_ - 512 : cg_;
  const float sc = isk ? 0.08838834764831845f : 1.f;
  for (int t = th * 32; t < th * 32 + 32; ++t) {
    float a = cb + w0 * sRaw[t * 128 + c] + w1 * sRaw[(t + 1) * 128 + c] + w2 * sRaw[(t + 2) * 128 + c] + w3 * sRaw[(t + 3) * 128 + c];
    bf16_t o = f2bf(siluf(a) * sc);
    dst[(long)(t0g + t) * 512 + cc] = o;
    sOutT[c * LDT + t] = o;
  }
  __syncthreads();
  if (isk) {
    bf16_t* kct = (bf16_t*)(ws + L0_KCT);
#pragma unroll
    for (int j = 0; j < 4; ++j) {
      int idx = tid + 256 * j;
      int cr = idx >> 3, tc = (idx & 7) * 8;
      *(uint4*)(kct + ((((long)(b * 4 + (ctile - 4)) * 128 + (tl0 >> 6)) * 128 + cr) * 64) + tc) = *(const uint4*)(sOutT + cr * LDT + tc);
    }
  }
  __syncthreads();
}

DEVI void cmp_finalize(const Params& p, int task, int lane) {
  const int n = task & 511, bg = (task >> 9) & 3, kv = task >> 11;
  unsigned char* ws = p.ws;
  bf16_t* KCMP = (bf16_t*)(ws + L0_KCMP);
  bf16_t* VCMPT = (bf16_t*)(ws + L0_VCMPT);
  if (n == 511) {
    if (kv == 0) KCMP[((long)bg * 512 + 511) * 64 + lane] = 0;
    else VCMPT[((long)bg * 64 + lane) * 512 + 511] = 0;
    return;
  }
  const float* hid = (const float*)(ws + L0_HIDP) + ((long)(kv * 4 + bg) * 512 + n) * 128;
  const float* pbv = (const float*)(ws + OFF_PB) + kv * 128;
  const float* w2 = kv ? p.cv_w2 : p.ck_w2;
  float g0, g1;
  {
    float x0 = ((hid[lane] + hid[lane + 524288]) + (hid[lane + 2 * 524288] + hid[lane + 3 * 524288])) + pbv[lane];
    float x1 = ((hid[lane + 64] + hid[lane + 64 + 524288]) + (hid[lane + 64 + 2 * 524288] + hid[lane + 64 + 3 * 524288])) + pbv[lane + 64];
    g0 = 0.5f * x0 * (1.f + tanhf(0.7978845608028654f * (x0 + 0.044715f * x0 * x0 * x0)));
    g1 = 0.5f * x1 * (1.f + tanhf(0.7978845608028654f * (x1 + 0.044715f * x1 * x1 * x1)));
  }
  float a = 0.f;
  for (int j0 = 0; j0 < 64; j0 += 16) {
    float wv[16], wu[16];
#pragma unroll
    for (int k = 0; k < 16; ++k) { wv[k] = w2[(j0 + k) * 64 + lane]; wu[k] = w2[(64 + j0 + k) * 64 + lane]; }
#pragma unroll
    for (int k = 0; k < 16; ++k) a += __shfl(g0, j0 + k) * wv[k] + __shfl(g1, j0 + k) * wu[k];
  }
  if (kv == 0) {
    float ss = wave_sum(a * a);
    float rinv = rsqrtf(ss * (1.f / 64.f) + EPSF);
    float v = a * rinv * p.k_norm[lane];
    float partner = __shfl_xor(v, 8);
    int pos = 16 * n + 31;
    float2 cs = ((const float2*)(ws + OFF_ROPE))[pos * 8 + (lane & 7)];
    float o = v;
    if (lane < 8) o = v * cs.x - partner * cs.y;
    else if (lane < 16) o = partner * cs.y + v * cs.x;
    KCMP[((long)bg * 512 + n) * 64 + lane] = f2bf(o);
  } else {
    VCMPT[((long)bg * 64 + lane) * 512 + n] = f2bf(a);
  }
}

DEVI void mlstm_local(const Params& p, int unit, unsigned char* smem) {
  const int tid = opaque_tid(), lane = tid & 63, w = tid >> 6, wr = w >> 1, wc = w & 1;
  const int bh = unit >> 6, c = unit & 63, b = bh >> 2, h = bh & 3, t0 = c * 128;
  const long R0 = (long)b * 8192 + t0;
  unsigned char* ws = p.ws;
  bf16_t* sA = (bf16_t*)smem;
  bf16_t* sB = (bf16_t*)(smem + 18432);
  float* sIg = (float*)(smem + 36864);
  float* sLf = sIg + 128;
  float* sW = sLf + 128;
  const float* IG = (const float*)(ws + L0_IG);
  const float* LF = (const float*)(ws + L0_LOGF);
  if (tid < 128) { sIg[tid] = IG[(R0 + tid) * 4 + h]; sLf[tid] = LF[(R0 + tid) * 4 + h]; }
  __syncthreads();
  if (tid < 64) {
    float c0 = sLf[2 * tid], c1 = sLf[2 * tid + 1];
    wave_scan_sum128(c0, c1, tid);
    const float bL = __shfl(c1, 63);
    float d0 = bL - c0 + sIg[2 * tid], d1 = bL - c1 + sIg[2 * tid + 1];
    const float ml = wave_max(fmaxf(d0, d1));
    sW[2 * tid] = __expf(d0 - ml); sW[2 * tid + 1] = __expf(d1 - ml);
    if (tid == 0) { ((float*)(ws + L0_BL))[unit] = bL; ((float*)(ws + L0_MLOC))[unit] = ml; }
  }
  __syncthreads();
  f32x4 acc[4][4];
#pragma unroll
  for (int mt = 0; mt < 4; ++mt)
#pragma unroll
    for (int nt = 0; nt < 4; ++nt) acc[mt][nt] = f32x4{0.f, 0.f, 0.f, 0.f};
  float dn = 0.f;
  const bf16_t* vt = (const bf16_t*)(ws + L0_MVT) + (((long)(b * 4 + h) * 128 + (t0 >> 6)) * 128) * 64;
  const bf16_t* kt_ = (const bf16_t*)(ws + L0_KCT) + (((long)(b * 4 + h) * 128 + (t0 >> 6)) * 128) * 64;
  const int lr = tid >> 3, lk = (tid & 7) * 8;
  for (int kt = 0; kt < 2; ++kt) {
    load_tile128(sA, vt + kt * 8192, 64);
#pragma unroll
    for (int j = 0; j < 4; ++j) {
      uint4 v = *(const uint4*)(kt_ + (long)kt * 8192 + (lr + 32 * j) * 64 + lk);
      const float* ww = sW + kt * 64 + lk;
      uint4 o;
      o.x = pack2(lo2f(v.x) * ww[0], hi2f(v.x) * ww[1]);
      o.y = pack2(lo2f(v.y) * ww[2], hi2f(v.y) * ww[3]);
      o.z = pack2(lo2f(v.z) * ww[4], hi2f(v.z) * ww[5]);
      o.w = pack2(lo2f(v.w) * ww[6], hi2f(v.w) * ww[7]);
      *(uint4*)(sB + (lr + 32 * j) * LDT + lk) = o;
    }
    __syncthreads();
    if (tid < 128) {
#pragma unroll 8
      for (int s = 0; s < 64; ++s) dn += bf2f(sB[tid * LDT + s]);
    }
    mma_lds<4, 4, 2>(sA + wr * 64 * LDT, sB + wc * 64 * LDT, acc, lane);
    __syncthreads();
  }
  float* dct = (float*)(ws + L0_H) + (long)unit * 16384;
  const int r = lane & 15, q = lane >> 4;
#pragma unroll
  for (int mt = 0; mt < 4; ++mt)
#pragma unroll
    for (int i = 0; i < 4; ++i) {
      int e = wr * 64 + mt * 16 + q * 4 + i;
#pragma unroll
      for (int nt = 0; nt < 4; ++nt) dct[e * 128 + wc * 64 + nt * 16 + r] = acc[mt][nt][i];
    }
  if (tid < 128) ((float*)(ws + L0_DN))[unit * 128 + tid] = dn;
}

template <bool DUMMY>
DEVI void mlstm_scan(const Params& p, unsigned char* smem) {
  unsigned char* ws = p.ws;
  const float* BL = (const float*)(ws + L0_BL);
  const float* ML = (const float*)(ws + L0_MLOC);
  float* MIN_ = (float*)(ws + L0_MIN);
  float* sDec = (float*)smem;
  float* sWn = sDec + 128;
  const int tid = opaque_tid();
  const int total = 8 * 16384 + 8 * 128;
  for (int base = blockIdx.x * 256; base < total; base += gridDim.x * 256) {
    const int bh0 = (base < 131072) ? (base >> 14) : ((base - 131072) >> 7);
    __syncthreads();
    if (tid < 2) {
      const int bh = bh0 + tid;
      if (bh < 8) {
        float m = 0.f;
        for (int c = 0; c < 64; ++c) {
          const int unit = bh * 64 + c;
          const float bL = BL[unit], ml = ML[unit];
          if (!DUMMY && base < 131072 && (base & 16383) == 0 && tid == 0) MIN_[unit] = m;
          const float mn = fmaxf(bL + m, ml);
          sDec[tid * 64 + c] = __expf(bL + m - mn);
          sWn[tid * 64 + c] = __expf(ml - mn);
          m = mn;
        }
      }
    }
    __syncthreads();
    const int idx = base + tid;
    if (idx < total) {
      float* ptr; long stride; int sel;
      if (idx < 131072) { const int bh = idx >> 14; ptr = (float*)(ws + L0_H) + (long)bh * 64 * 16384 + (idx & 16383); stride = 16384; sel = bh - bh0; }
      else { const int j = idx - 131072; const int bh = j >> 7; ptr = (float*)(ws + L0_DN) + (long)bh * 64 * 128 + (j & 127); stride = 128; sel = bh - bh0; }
      const float* dec = sDec + sel * 64;
      const float* wn = sWn + sel * 64;
      float C = 0.f;
      for (int c0 = 0; c0 < 64; c0 += 8) {
        float dv[8];
#pragma unroll
        for (int k = 0; k < 8; ++k) dv[k] = ptr[(long)(c0 + k) * stride];
#pragma unroll
        for (int k = 0; k < 8; ++k) {
          if (!DUMMY) ptr[(long)(c0 + k) * stride] = C;
          C = dec[c0 + k] * C + wn[c0 + k] * dv[k];
        }
      }
      if (DUMMY && C == 123.456f) MIN_[0] = C;
    }
  }
}

DEVI void mlstm_out(const Params& p, int item, unsigned char* smem) {
  const int tid = opaque_tid(), lane = tid & 63, w = tid >> 6, wr = w >> 1, wc = w & 1;
  const int r = lane & 15, q = lane >> 4;
  const int unit = item >> 1, u = item & 1;
  const int bh = unit >> 6, c = unit & 63, b = bh >> 2, h = bh & 3, t0 = c * 128;
  const long R0 = (long)b * 8192 + t0;
  const int J0 = u * 64;
  unsigned char* ws = p.ws;
  bf16_t* sA = (bf16_t*)smem;
  bf16_t* sB = (bf16_t*)(smem + 9216);
  bf16_t* sS0 = (bf16_t*)(smem + 27648);
  bf16_t* sS1 = (bf16_t*)(smem + 36864);
  float* fl = (float*)(smem + 46080);
  float* sIg = fl; float* sLf = fl + 128; float* sRj = fl + 256; float* sCs = fl + 384; float* sWi = fl + 512;
  float* sEm = fl + 640; float* sQn = fl + 768; float* sNin = fl + 896; float* sDen = fl + 1024; float* sSs = fl + 1280;
  const float* IG = (const float*)(ws + L0_IG);
  const float* LF = (const float*)(ws + L0_LOGF);
  const bf16_t* QC = (const bf16_t*)(ws + L0_QC) + (R0 + J0) * 512 + h * 128;
  const bf16_t* KC = (const bf16_t*)(ws + L0_KC) + R0 * 512 + h * 128;
  if (tid < 128) { sIg[tid] = IG[(R0 + tid) * 4 + h]; sLf[tid] = LF[(R0 + tid) * 4 + h]; sNin[tid] = ((const float*)(ws + L0_DN))[unit * 128 + tid]; }
  const float m_in = ((const float*)(ws + L0_MIN))[unit];
  __syncthreads();
  if (tid < 64) {
    float c0 = sLf[2 * tid], c1 = sLf[2 * tid + 1];
    wave_scan_sum128(c0, c1, tid);
    const float a0 = sIg[2 * tid] - c0, a1 = sIg[2 * tid + 1] - c1;
    float x0 = a0, x1 = a1;
    wave_scan_max128(x0, x1, tid);
    const float mx0 = fmaxf(x0, m_in), mx1 = fmaxf(x1, m_in);
    sCs[2 * tid] = a0; sCs[2 * tid + 1] = a1;
    sRj[2 * tid] = -mx0; sRj[2 * tid + 1] = -mx1;
    sWi[2 * tid] = __expf(m_in - mx0); sWi[2 * tid + 1] = __expf(m_in - mx1);
    sEm[2 * tid] = __expf(-(c0 + mx0)); sEm[2 * tid + 1] = __expf(-(c1 + mx1));
  }
  if (tid >= 128 && tid < 192) {
    int jl = tid - 128;
    const bf16_t* qr = QC + (long)jl * 512;
    float s = 0.f;
#pragma unroll 2
    for (int ch = 0; ch < 16; ++ch) {
      uint4 v = *(const uint4*)(qr + ch * 8);
      const float* nn = sNin + ch * 8;
      s += lo2f(v.x) * nn[0] + hi2f(v.x) * nn[1] + lo2f(v.y) * nn[2] + hi2f(v.y) * nn[3] + lo2f(v.z) * nn[4] + hi2f(v.z) * nn[5] + lo2f(v.w) * nn[6] + hi2f(v.w) * nn[7];
    }
    sQn[jl] = s;
  }
  __syncthreads();
  f32x4 acc[2][4];
#pragma unroll
  for (int mt = 0; mt < 2; ++mt)
#pragma unroll
    for (int nt = 0; nt < 4; ++nt) acc[mt][nt] = f32x4{0.f, 0.f, 0.f, 0.f};
  const bool skipS = (wc > u);
  const int lr = tid >> 3, lk = (tid & 7) * 8;
  {
    u32x4 qa0, qa1, kb0, kb1, kb2, kb3;
    qa0 = *(const u32x4*)(QC + (long)lr * 512 + lk); qa1 = *(const u32x4*)(QC + (long)(lr + 32) * 512 + lk);
    kb0 = *(const u32x4*)(KC + (long)lr * 512 + lk); kb1 = *(const u32x4*)(KC + (long)(lr + 32) * 512 + lk);
    kb2 = *(const u32x4*)(KC + (long)(lr + 64) * 512 + lk); kb3 = *(const u32x4*)(KC + (long)(lr + 96) * 512 + lk);
#pragma unroll 1
    for (int kt = 0; kt < 2; ++kt) {
      *(u32x4*)(sA + lr * LDT + lk) = qa0; *(u32x4*)(sA + (lr + 32) * LDT + lk) = qa1;
      *(u32x4*)(sB + lr * LDT + lk) = kb0; *(u32x4*)(sB + (lr + 32) * LDT + lk) = kb1;
      *(u32x4*)(sB + (lr + 64) * LDT + lk) = kb2; *(u32x4*)(sB + (lr + 96) * LDT + lk) = kb3;
      __syncthreads();
      if (kt == 0) {
        qa0 = *(const u32x4*)(QC + (long)lr * 512 + 64 + lk); qa1 = *(const u32x4*)(QC + (long)(lr + 32) * 512 + 64 + lk);
        kb0 = *(const u32x4*)(KC + (long)lr * 512 + 64 + lk); kb1 = *(const u32x4*)(KC + (long)(lr + 32) * 512 + 64 + lk);
        kb2 = *(const u32x4*)(KC + (long)(lr + 64) * 512 + 64 + lk); kb3 = *(const u32x4*)(KC + (long)(lr + 96) * 512 + 64 + lk);
      }
      if (!skipS) mma_lds<2, 4, 2>(sA + wr * 32 * LDT, sB + wc * 64 * LDT, acc, lane);
      __syncthreads();
    }
  }
  {
    bf16_t* sS = wc ? sS1 : sS0;
#pragma unroll
    for (int mt = 0; mt < 2; ++mt)
#pragma unroll
      for (int i = 0; i < 4; ++i) {
        int jl = wr * 32 + mt * 16 + q * 4 + i;
        int j = J0 + jl;
        float rj = sRj[j], rs = 0.f;
#pragma unroll
        for (int nt = 0; nt < 4; ++nt) {
          int sl = nt * 16 + r, s = wc * 64 + sl;
          float val = (s <= j) ? acc[mt][nt][i] * __expf(rj + sCs[s]) : 0.f;
          rs += val;
          sS[jl * LDT + sl] = f2bf(val);
        }
        rs = grp16_sum(rs);
        if (r == 0) sDen[wc * 64 + jl] = rs;
      }
  }
#pragma unroll
  for (int mt = 0; mt < 2; ++mt)
#pragma unroll
    for (int nt = 0; nt < 4; ++nt) acc[mt][nt] = f32x4{0.f, 0.f, 0.f, 0.f};
  const bf16_t* vt = (const bf16_t*)(ws + L0_MVT) + (((long)(b * 4 + h) * 128 + (t0 >> 6)) * 128) * 64;
  const float* ct = (const float*)(ws + L0_H) + (long)unit * 16384;
  {
    u32x4 vb0, vb1, vb2, vb3;
    u32x4 qa0, qa1;
    float4 cv[8];
    const int nsteps = u ? 4 : 3;
    auto kind_of = [&](int sidx) { return u ? sidx : (sidx == 0 ? 0 : sidx + 1); };
    auto fetch = [&](int kind) {
      if (kind < 2) {
        const bf16_t* vp = vt + (long)kind * 8192 + lr * 64 + lk;
        vb0 = *(const u32x4*)vp; vb1 = *(const u32x4*)(vp + 32 * 64); vb2 = *(const u32x4*)(vp + 64 * 64); vb3 = *(const u32x4*)(vp + 96 * 64);
      } else {
        const int k2 = kind - 2;
        qa0 = *(const u32x4*)(QC + (long)lr * 512 + k2 * 64 + lk); qa1 = *(const u32x4*)(QC + (long)(lr + 32) * 512 + k2 * 64 + lk);
#pragma unroll
        for (int j = 0; j < 8; ++j) cv[j] = *(const float4*)(ct + (long)((tid >> 4) + 16 * j) * 128 + k2 * 64 + (tid & 15) * 4);
      }
    };
    fetch(0);
#pragma unroll 1
    for (int sidx = 0; sidx < nsteps; ++sidx) {
      const int kind = kind_of(sidx);
      const bf16_t* aS;
      if (kind < 2) {
        *(u32x4*)(sB + lr * LDT + lk) = vb0; *(u32x4*)(sB + (lr + 32) * LDT + lk) = vb1;
        *(u32x4*)(sB + (lr + 64) * LDT + lk) = vb2; *(u32x4*)(sB + (lr + 96) * LDT + lk) = vb3;
        aS = kind ? sS1 : sS0;
      } else {
        const float w0 = sWi[J0 + lr], w1 = sWi[J0 + lr + 32];
        u32x4 o0, o1;
        o0[0] = pack2(lo2f(qa0[0]) * w0, hi2f(qa0[0]) * w0); o0[1] = pack2(lo2f(qa0[1]) * w0, hi2f(qa0[1]) * w0);
        o0[2] = pack2(lo2f(qa0[2]) * w0, hi2f(qa0[2]) * w0); o0[3] = pack2(lo2f(qa0[3]) * w0, hi2f(qa0[3]) * w0);
        o1[0] = pack2(lo2f(qa1[0]) * w1, hi2f(qa1[0]) * w1); o1[1] = pack2(lo2f(qa1[1]) * w1, hi2f(qa1[1]) * w1);
        o1[2] = pack2(lo2f(qa1[2]) * w1, hi2f(qa1[2]) * w1); o1[3] = pack2(lo2f(qa1[3]) * w1, hi2f(qa1[3]) * w1);
        *(u32x4*)(sA + lr * LDT + lk) = o0; *(u32x4*)(sA + (lr + 32) * LDT + lk) = o1;
#pragma unroll
        for (int j = 0; j < 8; ++j) {
          uint2 o;
          o.x = pack2(cv[j].x, cv[j].y);
          o.y = pack2(cv[j].z, cv[j].w);
          *(uint2*)(sB + ((tid >> 4) + 16 * j) * LDT + (tid & 15) * 4) = o;
        }
        aS = sA;
      }
      __syncthreads();
      if (sidx + 1 < nsteps) fetch(kind_of(sidx + 1));
      mma_lds<2, 4, 2>(aS + wr * 32 * LDT, sB + wc * 64 * LDT, acc, lane);
      __syncthreads();
    }
  }
#pragma unroll
  for (int mt = 0; mt < 2; ++mt)
#pragma unroll
    for (int i = 0; i < 4; ++i) {
      int jl = wr * 32 + mt * 16 + q * 4 + i;
      int j = J0 + jl;
      float den = sDen[jl] + sDen[64 + jl] + sWi[j] * sQn[jl];
      float dinv = 1.f / fmaxf(fabsf(den), sEm[j]);
      float ss = 0.f;
#pragma unroll
      for (int nt = 0; nt < 4; ++nt) { float v = acc[mt][nt][i] * dinv; acc[mt][nt][i] = v; ss += v * v; }
      ss = grp16_sum(ss);
      if (r == 0) sSs[wc * 64 + jl] = ss;
    }
  __syncthreads();
  const bf16_t* MO = (const bf16_t*)(ws + L0_MO);
  const bf16_t* MZ = (const bf16_t*)(ws + L0_MZ);
  bf16_t* Y = (bf16_t*)(ws + L0_QKRAW);
  float hn[4];
#pragma unroll
  for (int nt = 0; nt < 4; ++nt) hn[nt] = p.m_hn[h * 128 + wc * 64 + nt * 16 + r];
#pragma unroll
  for (int mt = 0; mt < 2; ++mt) {
    float gv[4][4];
#pragma unroll
    for (int i = 0; i < 4; ++i) {
      long row = R0 + J0 + wr * 32 + mt * 16 + q * 4 + i;
#pragma unroll
      for (int nt = 0; nt < 4; ++nt) {
        int col = h * 128 + wc * 64 + nt * 16 + r;
        gv[i][nt] = bf2f(MO[row * 512 + col]) * bf2f(MZ[row * 512 + col]);
      }
    }
#pragma unroll
    for (int i = 0; i < 4; ++i) {
      int jl = wr * 32 + mt * 16 + q * 4 + i;
      float rinv = rsqrtf((sSs[jl] + sSs[64 + jl]) * (1.f / 128.f) + EPSF);
      long row = R0 + J0 + jl;
#pragma unroll
      for (int nt = 0; nt < 4; ++nt) {
        int col = h * 128 + wc * 64 + nt * 16 + r;
        Y[row * 1024 + col] = f2bf(acc[mt][nt][i] * rinv * hn[nt] * gv[i][nt]);
      }
    }
  }
  __syncthreads();
}

struct NsaSm {
  bf16_t* sK; bf16_t* sV;
  float* sImpA; float* sImpB;
  unsigned* sSel; unsigned* sGrp; unsigned* sUn;
};

DEVI int next_bit(unsigned long long lo, unsigned long long hi, int from) {
  if (from < 64) {
    unsigned long long v = lo & (~0ull << from);
    if (v) return __builtin_ctzll(v);
    if (hi) return 64 + __builtin_ctzll(hi);
    return -1;
  }
  if (from >= 128) return -1;
  unsigned long long v = hi & (~0ull << (from - 64));
  if (v) return 64 + __builtin_ctzll(v);
  return -1;
}

template <int MODE, bool DUMMY = false, class MaskF, class ActF>
DEVI void nsa_branch(const NsaSm& sm, unsigned long long tmlo, unsigned long long tmhi,
                     const bf16_t* Kg, const bf16_t* Vg, long vstep, long ldv,
                     const bf16x8 (&qf)[2][2], f32x4 (&O)[4][2], float (&mrow)[2], float (&lrow)[2], const float (&invl)[2],
                     MaskF mask, ActF actf, int tokbase, int tid) {
  const int lane = tid & 63, r = lane & 15, q = lane >> 4;
  const int lr = tid >> 3, lk = (tid & 7) * 8;
  int j = next_bit(tmlo, tmhi, 0);
  if (j < 0) return;
  u32x4 k0, k1, v0, v1;
  u32x4 k2, k3, v2, v3;
  if (!DUMMY) {
    const bf16_t* kp = Kg + (long)j * 4096 + lr * 64 + lk;
    k0 = *(const u32x4*)kp; k1 = *(const u32x4*)(kp + 32 * 64);
    if (MODE != 1) {
      const bf16_t* vp = Vg + (long)j * vstep + (long)lr * ldv + lk;
      v0 = *(const u32x4*)vp; v1 = *(const u32x4*)(vp + 32 * ldv);
    }
    *(u32x4*)(sm.sK + lr * LDT + lk) = k0; *(u32x4*)(sm.sK + (lr + 32) * LDT + lk) = k1;
    if (MODE != 1) { *(u32x4*)(sm.sV + lr * LDT + lk) = v0; *(u32x4*)(sm.sV + (lr + 32) * LDT + lk) = v1; }
  }
  int j1 = next_bit(tmlo, tmhi, j + 1);
  if (!DUMMY && j1 >= 0) {
    const bf16_t* kp = Kg + (long)j1 * 4096 + lr * 64 + lk;
    k0 = *(const u32x4*)kp; k1 = *(const u32x4*)(kp + 32 * 64);
    if (MODE != 1) {
      const bf16_t* vp = Vg + (long)j1 * vstep + (long)lr * ldv + lk;
      v0 = *(const u32x4*)vp; v1 = *(const u32x4*)(vp + 32 * ldv);
    }
  }
  if (!DUMMY) __syncthreads();
  int buf = 0;
  while (true) {
    const int jn = j1;
    const int j2 = (j1 >= 0) ? next_bit(tmlo, tmhi, j1 + 1) : -1;
    if (!DUMMY && j2 >= 0) {
      const bf16_t* kp = Kg + (long)j2 * 4096 + lr * 64 + lk;
      k2 = *(const u32x4*)kp; k3 = *(const u32x4*)(kp + 32 * 64);
      if (MODE != 1) {
        const bf16_t* vp = Vg + (long)j2 * vstep + (long)lr * ldv + lk;
        v2 = *(const u32x4*)vp; v3 = *(const u32x4*)(vp + 32 * ldv);
      }
    }
    const bf16_t* sK = sm.sK + buf * (64 * LDT);
    const bf16_t* sV = sm.sV + buf * (64 * LDT);
    const bool a0 = actf(0, j), a1 = actf(1, j);
    __builtin_amdgcn_sched_barrier(0);
    if (a0 || a1) {
      const bool full = mask.full(j);
      f32x4 sacc[4][2];
#pragma unroll
      for (int mt = 0; mt < 4; ++mt) { sacc[mt][0] = f32x4{0.f, 0.f, 0.f, 0.f}; sacc[mt][1] = f32x4{0.f, 0.f, 0.f, 0.f}; }
      __builtin_amdgcn_s_setprio(2);
#pragma unroll
      for (int ks = 0; ks < 2; ++ks)
#pragma unroll
        for (int mt = 0; mt < 4; ++mt) {
          bf16x8 a = *(const bf16x8*)(sK + (mt * 16 + r) * LDT + ks * 32 + q * 8);
          if (a0) sacc[mt][0] = __builtin_amdgcn_mfma_f32_16x16x32_bf16(a, qf[0][ks], sacc[mt][0], 0, 0, 0);
          if (a1) sacc[mt][1] = __builtin_amdgcn_mfma_f32_16x16x32_bf16(a, qf[1][ks], sacc[mt][1], 0, 0, 0);
        }
      __builtin_amdgcn_s_setprio(0);
      __builtin_amdgcn_sched_barrier(0);
#pragma unroll
      for (int nt = 0; nt < 2; ++nt) {
        const bool act = nt ? a1 : a0;
        if (act) {
          const bool lb = mask.bit(nt, j);
          if (!full) {
#pragma unroll
            for (int mt = 0; mt < 4; ++mt)
#pragma unroll
              for (int i = 0; i < 4; ++i) sacc[mt][nt][i] = mask.elem(mt * 16 + q * 4 + i, nt, j) ? sacc[mt][nt][i] : NEGS;
          }
          if (MODE != 2) {
            float tmx = fmaxf(fmaxf(sacc[0][nt][0], sacc[0][nt][1]), fmaxf(sacc[0][nt][2], sacc[0][nt][3]));
#pragma unroll
            for (int mt = 1; mt < 4; ++mt)
              tmx = fmaxf(tmx, fmaxf(fmaxf(sacc[mt][nt][0], sacc[mt][nt][1]), fmaxf(sacc[mt][nt][2], sacc[mt][nt][3])));
            if (MaskF::HASBIT) tmx = lb ? tmx : NEGS;
            tmx = fmaxf(tmx, __shfl_xor(tmx, 16));
            tmx = fmaxf(tmx, __shfl_xor(tmx, 32));
            const float mo = mrow[nt];
            const float mn = fmaxf(mo, tmx);
            float mnc = fmaxf(mn, -1e20f);
            if (MaskF::HASBIT) mnc = lb ? mnc : 1e30f;
            mrow[nt] = mn;
            f32x4 psv = f32x4{0.f, 0.f, 0.f, 0.f};
#pragma unroll
            for (int mt = 0; mt < 4; ++mt) {
              f32x4 dd = sacc[mt][nt] - mnc;
              f32x4 pp;
              pp[0] = __builtin_amdgcn_exp2f(dd[0]); pp[1] = __builtin_amdgcn_exp2f(dd[1]);
              pp[2] = __builtin_amdgcn_exp2f(dd[2]); pp[3] = __builtin_amdgcn_exp2f(dd[3]);
              sacc[mt][nt] = pp;
              psv += pp;
            }
            const float ps = (psv[0] + psv[1]) + (psv[2] + psv[3]);
            const float al = __builtin_amdgcn_exp2f(mo - mn);
            lrow[nt] = lrow[nt] * al + ps;
            if (MODE == 0) {
              if (__any(al != 1.f)) {
#pragma unroll
                for (int dt = 0; dt < 4; ++dt) O[dt][nt] *= al;
              }
            }
          } else {
            const float mmc = fmaxf(mrow[nt], -1e20f), il = invl[nt];
            const int tok = tokbase + nt * 4 + (r >> 2);
#pragma unroll
            for (int mt = 0; mt < 4; ++mt) {
              float pp[4];
#pragma unroll
              for (int i = 0; i < 4; ++i) {
                pp[i] = __builtin_amdgcn_exp2f(sacc[mt][nt][i] - mmc) * il;
                sacc[mt][nt][i] = pp[i];
              }
              float mainv = 32.f * (pp[0] + pp[1] + pp[2]) + 16.f * pp[3];
              float carry = 16.f * pp[3];
              mainv += __shfl_xor(mainv, 1); mainv += __shfl_xor(mainv, 2);
              carry += __shfl_xor(carry, 1); carry += __shfl_xor(carry, 2);
              if ((r & 3) == 0) {
                const int mp = j * 16 + mt * 4 + q;
                sm.sImpA[tok * 128 + mp] = mainv;
                if (mp + 1 < 128) sm.sImpB[tok * 128 + mp + 1] = carry;
              }
            }
          }
        }
      }
      __builtin_amdgcn_sched_barrier(0);
      if (MODE != 1) {
        __builtin_amdgcn_s_setprio(2);
#pragma unroll
        for (int ks = 0; ks < 2; ++ks) {
          bf16x8 pb[2];
#pragma unroll
          for (int nt = 0; nt < 2; ++nt) {
            union { u32x4 u; bf16x8 h; } cv;
            cv.u[0] = pack2(sacc[2 * ks][nt][0], sacc[2 * ks][nt][1]);
            cv.u[1] = pack2(sacc[2 * ks][nt][2], sacc[2 * ks][nt][3]);
            cv.u[2] = pack2(sacc[2 * ks + 1][nt][0], sacc[2 * ks + 1][nt][1]);
            cv.u[3] = pack2(sacc[2 * ks + 1][nt][2], sacc[2 * ks + 1][nt][3]);
            pb[nt] = cv.h;
          }
#pragma unroll
          for (int dt = 0; dt < 4; ++dt) {
            union { u32x4 u; bf16x8 h; } av;
            const uint2 lo = *(const uint2*)(sV + (dt * 16 + r) * LDT + (2 * ks) * 16 + q * 4);
            const uint2 hi = *(const uint2*)(sV + (dt * 16 + r) * LDT + (2 * ks + 1) * 16 + q * 4);
            av.u[0] = lo.x; av.u[1] = lo.y; av.u[2] = hi.x; av.u[3] = hi.y;
            if (a0) O[dt][0] = __builtin_amdgcn_mfma_f32_16x16x32_bf16(av.h, pb[0], O[dt][0], 0, 0, 0);
            if (a1) O[dt][1] = __builtin_amdgcn_mfma_f32_16x16x32_bf16(av.h, pb[1], O[dt][1], 0, 0, 0);
          }
        }
        __builtin_amdgcn_s_setprio(0);
      }
    }
    __builtin_amdgcn_sched_barrier(0);
    if (!DUMMY && jn >= 0) {
      bf16_t* dK = sm.sK + (buf ^ 1) * (64 * LDT);
      bf16_t* dV = sm.sV + (buf ^ 1) * (64 * LDT);
      *(u32x4*)(dK + lr * LDT + lk) = k0; *(u32x4*)(dK + (lr + 32) * LDT + lk) = k1;
      if (MODE != 1) { *(u32x4*)(dV + lr * LDT + lk) = v0; *(u32x4*)(dV + (lr + 32) * LDT + lk) = v1; }
    }
    if (!DUMMY) __syncthreads();
    if (jn < 0) break;
    j = jn;
    j1 = j2;
    k0 = k2; k1 = k3; v0 = v2; v1 = v3;
    buf ^= 1;
  }
}

struct MaskC {
      static constexpr bool HASBIT = false;
      int t0_, t1_, tmin_;
      DEVI bool full(int jt) const { return 16 * (jt * 64 + 63) + 31 <= tmin_; }
      DEVI bool bit(int nt, int jt) const { return true; }
      DEVI bool elem(int key, int nt, int jt) const { return 16 * (jt * 64 + key) + 31 <= (nt ? t1_ : t0_); }
};

struct MaskS {
      static constexpr bool HASBIT = true;
      unsigned long long a_lo, a_hi, b_lo, b_hi; int t0_, t1_, cur_;
      DEVI bool full(int jt) const { return jt < cur_; }
      DEVI bool bit(int nt, int jt) const {
        const unsigned long long lo = nt ? b_lo : a_lo, hi = nt ? b_hi : a_hi;
        const unsigned long long wd = (jt < 64) ? (lo >> jt) : (hi >> (jt - 64));
        return (wd & 1ull) != 0ull;
      }
      DEVI bool elem(int key, int nt, int jt) const { return jt * 64 + key <= (nt ? t1_ : t0_); }
};

struct MaskW {
      static constexpr bool HASBIT = false;
      int t0_, t1_, tmin_, tmax_;
      DEVI bool full(int jt) const { return (jt * 64 + 63 <= tmin_) && (tmax_ - jt * 64 < 512); }
      DEVI bool bit(int nt, int jt) const { return true; }
      DEVI bool elem(int key, int nt, int jt) const { const int s_ = jt * 64 + key, t_ = nt ? t1_ : t0_; return (s_ <= t_) && (t_ - s_ < 512); }
};

DEVI void nsa_tile(const Params& p, int tileidx, unsigned char* smem) {
  const int tid = opaque_tid(), lane = tid & 63, w = tid >> 6, r = lane & 15, q = lane >> 4;
  const int bg = tileidx & 3, tt = tileidx >> 2, b = bg >> 1, g = bg & 1, t0 = tt * 32;
  unsigned char* ws = p.ws;
  NsaSm sm;
  sm.sK = (bf16_t*)smem; sm.sV = (bf16_t*)(smem + 18432);
  sm.sImpA = (float*)(smem + 36864); sm.sImpB = (float*)(smem + 53248);
  sm.sSel = (unsigned*)(smem + 69632); sm.sGrp = sm.sSel + 128; sm.sUn = sm.sGrp + 32;
  const int tokbase = 8 * w;
  bf16x8 qf[2][2];
  {
    const bf16_t* qn = (const bf16_t*)(ws + L0_QN) + ((long)bg * 8192 + t0) * 256 + (32 * w + r) * 64 + q * 8;
    qf[0][0] = *(const bf16x8*)(qn); qf[0][1] = *(const bf16x8*)(qn + 32);
    qf[1][0] = *(const bf16x8*)(qn + 16 * 64); qf[1][1] = *(const bf16x8*)(qn + 16 * 64 + 32);
  }
  int tq[2];
  const float* GT = (const float*)(ws + L0_GATES);
#pragma unroll
  for (int nt = 0; nt < 2; ++nt) tq[nt] = t0 + tokbase + nt * 4 + (r >> 2);
#define GATE(nt, k) (GT[((long)b * 8192 + tq[nt]) * 24 + (g * 4 + (r & 3)) * 3 + (k)])
  f32x4 O[4][2];
  f32x4* sOut = (f32x4*)(smem + 36864) + (w * 8) * 64 + lane;
  const int cur = t0 >> 6;
  float mrow[2], lrow[2], invl[2];
  for (int i = tid; i < 32 * 128; i += 256) { sm.sImpA[i] = 0.f; sm.sImpB[i] = 0.f; }
  __syncthreads();
  {
    const int nvmax = (t0 + 31 >= 31) ? (((t0 + 31 - 31) >> 4) + 1) : 0;
    int nkt = (nvmax + 63) >> 6;
    if (nkt > 8) nkt = 8;
    const unsigned long long cm0 = (1ull << nkt) - 1ull;
    const bf16_t* KCMP = (const bf16_t*)(ws + L0_KCMP) + (long)bg * 512 * 64;
    const bf16_t* VCMPT = (const bf16_t*)(ws + L0_VCMPT) + (long)bg * 64 * 512;
    MaskC mk{tq[0], tq[1], t0 + tokbase};
    auto act = [&](int nt, int jt) { return true; };
    mrow[0] = mrow[1] = NEGS; lrow[0] = lrow[1] = 0.f; invl[0] = invl[1] = 0.f;
    nsa_branch<1>(sm, cm0, 0ull, KCMP, VCMPT, 64, 512, qf, O, mrow, lrow, invl, mk, act, tokbase, tid);
#pragma unroll
    for (int nt = 0; nt < 2; ++nt) {
      float l = lrow[nt];
      l += __shfl_xor(l, 16); l += __shfl_xor(l, 32);
      invl[nt] = (l > 0.f) ? 1.f / l : 0.f;
    }
#pragma unroll
    for (int dt = 0; dt < 4; ++dt) { O[dt][0] = f32x4{0.f, 0.f, 0.f, 0.f}; O[dt][1] = f32x4{0.f, 0.f, 0.f, 0.f}; }
    nsa_branch<2>(sm, cm0, 0ull, KCMP, VCMPT, 64, 512, qf, O, mrow, lrow, invl, mk, act, tokbase, tid);
  }
  __syncthreads();
  {
    const int ncand = (cur - 2 > 0) ? cur - 2 : 0;
    const int nf = (cur >= 2) ? 3 : cur + 1;
    const int kk = 16 - nf;
    const int m0i = lane, m1i = lane + 64;
    const bool c0 = (m0i >= 1 && m0i <= cur - 2), c1 = (m1i <= cur - 2);
    for (int tqi = 0; tqi < 8; ++tqi) {
      const int tok = tokbase + tqi;
      bool s0, s1;
      if (ncand <= kk) { s0 = c0; s1 = c1; }
      else {
        const float f0 = sm.sImpA[tok * 128 + m0i] + sm.sImpB[tok * 128 + m0i];
        const float f1 = sm.sImpA[tok * 128 + m1i] + sm.sImpB[tok * 128 + m1i];
        const unsigned k0 = c0 ? (__float_as_uint(f0) + 1u) : 0u;
        const unsigned k1 = c1 ? (__float_as_uint(f1) + 1u) : 0u;
        unsigned prefix = 0u;
        for (int bit = 31; bit >= 0; --bit) {
          const unsigned cand = prefix | (1u << bit);
          const int cnt = __popcll(__ballot(k0 >= cand)) + __popcll(__ballot(k1 >= cand));
          if (cnt >= kk) prefix = cand;
        }
        const bool g0 = k0 > prefix, g1 = k1 > prefix;
        const int ng = __popcll(__ballot(g0)) + __popcll(__ballot(g1));
        const bool e0 = (k0 == prefix), e1 = (k1 == prefix);
        const unsigned long long be0 = __ballot(e0), be1 = __ballot(e1);
        const unsigned long long lm = (1ull << lane) - 1ull;
        const int re0 = __popcll(be0 & lm), re1 = __popcll(be0) + __popcll(be1 & lm);
        const int need = kk - ng;
        s0 = g0 || (e0 && re0 < need);
        s1 = g1 || (e1 && re1 < need);
      }
      s0 = s0 || (m0i == 0) || (m0i == cur) || (m0i == cur - 1);
      s1 = s1 || (m1i == cur) || (m1i == cur - 1);
      const unsigned long long lo = __ballot(s0), hi = __ballot(s1);
      if (lane == 0) {
        sm.sSel[tok * 4 + 0] = (unsigned)lo; sm.sSel[tok * 4 + 1] = (unsigned)(lo >> 32);
        sm.sSel[tok * 4 + 2] = (unsigned)hi; sm.sSel[tok * 4 + 3] = (unsigned)(hi >> 32);
      }
    }
  }
  __syncthreads();
  if (tid < 32) { int gi = tid >> 2, wd = tid & 3; unsigned u = 0; for (int k = 0; k < 4; ++k) u |= sm.sSel[(gi * 4 + k) * 4 + wd]; sm.sGrp[tid] = u; }
  __syncthreads();
  if (tid < 4) { unsigned u = 0; for (int gi = 0; gi < 8; ++gi) u |= sm.sGrp[gi * 4 + tid]; sm.sUn[tid] = u; }
  __syncthreads();
#pragma unroll
  for (int nt = 0; nt < 2; ++nt)
#pragma unroll
    for (int dt = 0; dt < 4; ++dt) sOut[(nt * 4 + dt) * 64] = O[dt][nt] * GATE(nt, 0);
  {
    const bf16_t* KS = (const bf16_t*)(ws + L0_KS) + (long)bg * 8192 * 64;
    const bf16_t* VST = (const bf16_t*)(ws + L0_VST) + (long)bg * 128 * 4096;
    const unsigned long long ulo = (unsigned long long)sm.sUn[0] | ((unsigned long long)sm.sUn[1] << 32);
    const unsigned long long uhi = (unsigned long long)sm.sUn[2] | ((unsigned long long)sm.sUn[3] << 32);
    const int tk0 = tokbase + (r >> 2), tk1 = tokbase + 4 + (r >> 2);
    MaskS mk{(unsigned long long)sm.sSel[tk0 * 4 + 0] | ((unsigned long long)sm.sSel[tk0 * 4 + 1] << 32),
             (unsigned long long)sm.sSel[tk0 * 4 + 2] | ((unsigned long long)sm.sSel[tk0 * 4 + 3] << 32),
             (unsigned long long)sm.sSel[tk1 * 4 + 0] | ((unsigned long long)sm.sSel[tk1 * 4 + 1] << 32),
             (unsigned long long)sm.sSel[tk1 * 4 + 2] | ((unsigned long long)sm.sSel[tk1 * 4 + 3] << 32), tq[0], tq[1], cur};
    unsigned long long g0lo, g0hi, g1lo, g1hi;
    {
      const unsigned* gp = sm.sGrp + (2 * w) * 4;
      g0lo = (unsigned long long)__builtin_amdgcn_readfirstlane(gp[0]) | ((unsigned long long)__builtin_amdgcn_readfirstlane(gp[1]) << 32);
      g0hi = (unsigned long long)__builtin_amdgcn_readfirstlane(gp[2]) | ((unsigned long long)__builtin_amdgcn_readfirstlane(gp[3]) << 32);
      g1lo = (unsigned long long)__builtin_amdgcn_readfirstlane(gp[4]) | ((unsigned long long)__builtin_amdgcn_readfirstlane(gp[5]) << 32);
      g1hi = (unsigned long long)__builtin_amdgcn_readfirstlane(gp[6]) | ((unsigned long long)__builtin_amdgcn_readfirstlane(gp[7]) << 32);
    }
    auto act = [&](int nt, int jt) {
      const unsigned long long lo = nt ? g1lo : g0lo, hi = nt ? g1hi : g0hi;
      const unsigned long long wd = (jt < 64) ? (lo >> jt) : (hi >> (jt - 64));
      return (wd & 1ull) != 0ull;
    };
    mrow[0] = mrow[1] = NEGS; lrow[0] = lrow[1] = 0.f;
#pragma unroll
    for (int dt = 0; dt < 4; ++dt) { O[dt][0] = f32x4{0.f, 0.f, 0.f, 0.f}; O[dt][1] = f32x4{0.f, 0.f, 0.f, 0.f}; }
#ifdef NSA_DUMMY_SEL
    {
      nsa_branch<0, true>(sm, ulo, uhi, KS, VST, 4096, 64, qf, O, mrow, lrow, invl, mk, act, tokbase, tid);
      float chk = lrow[0] + lrow[1];
#pragma unroll
      for (int dt = 0; dt < 4; ++dt) chk += O[dt][0][0] + O[dt][0][1] + O[dt][0][2] + O[dt][0][3] + O[dt][1][0] + O[dt][1][1] + O[dt][1][2] + O[dt][1][3];
      if (chk == 123.456f) sm.sUn[0] = 1u;
      mrow[0] = mrow[1] = NEGS; lrow[0] = lrow[1] = 0.f;
#pragma unroll
      for (int dt = 0; dt < 4; ++dt) { O[dt][0] = f32x4{0.f, 0.f, 0.f, 0.f}; O[dt][1] = f32x4{0.f, 0.f, 0.f, 0.f}; }
      __syncthreads();
    }
#endif
    nsa_branch<0>(sm, ulo, uhi, KS, VST, 4096, 64, qf, O, mrow, lrow, invl, mk, act, tokbase, tid);
#pragma unroll
    for (int nt = 0; nt < 2; ++nt) {
      float l = lrow[nt];
      l += __shfl_xor(l, 16); l += __shfl_xor(l, 32);
      const float f = GATE(nt, 1) * ((l > 0.f) ? 1.f / l : 0.f);
#pragma unroll
      for (int dt = 0; dt < 4; ++dt) sOut[(nt * 4 + dt) * 64] += O[dt][nt] * f;
    }
  }
  {
    const bf16_t* KW = (const bf16_t*)(ws + L0_KW) + (long)bg * 8192 * 64;
    const bf16_t* VWT = (const bf16_t*)(ws + L0_VWT) + (long)bg * 128 * 4096;
    const int jlo = ((t0 - 511 > 0) ? (t0 - 511) : 0) >> 6;
    unsigned long long wlo = 0ull, whi = 0ull;
    for (int jj = jlo; jj <= cur; ++jj) { if (jj < 64) wlo |= (1ull << jj); else whi |= (1ull << (jj - 64)); }
    MaskW mk{tq[0], tq[1], t0 + tokbase, t0 + tokbase + 7};
    auto act = [&](int nt, int jt) { return true; };
    mrow[0] = mrow[1] = NEGS; lrow[0] = lrow[1] = 0.f;
#pragma unroll
    for (int dt = 0; dt < 4; ++dt) { O[dt][0] = f32x4{0.f, 0.f, 0.f, 0.f}; O[dt][1] = f32x4{0.f, 0.f, 0.f, 0.f}; }
    nsa_branch<0>(sm, wlo, whi, KW, VWT, 4096, 64, qf, O, mrow, lrow, invl, mk, act, tokbase, tid);
#pragma unroll
    for (int nt = 0; nt < 2; ++nt) {
      float l = lrow[nt];
      l += __shfl_xor(l, 16); l += __shfl_xor(l, 32);
      const float f = GATE(nt, 2) * ((l > 0.f) ? 1.f / l : 0.f);
#pragma unroll
      for (int dt = 0; dt < 4; ++dt) O[dt][nt] = sOut[(nt * 4 + dt) * 64] + O[dt][nt] * f;
    }
  }
  const bf16_t* NZ = (const bf16_t*)(ws + L0_NZ);
  bf16_t* Y = (bf16_t*)(ws + L0_QKRAW);
  uint2 zzv[2][4];
#pragma unroll
  for (int nt = 0; nt < 2; ++nt)
#pragma unroll
    for (int dt = 0; dt < 4; ++dt)
      zzv[nt][dt] = *(const uint2*)(NZ + ((long)b * 8192 + tq[nt]) * 512 + (g * 4 + (r & 3)) * 64 + dt * 16 + q * 4);
#pragma unroll
  for (int nt = 0; nt < 2; ++nt) {
    const long tok = (long)b * 8192 + tq[nt];
    const int head = g * 4 + (r & 3);
#pragma unroll
    for (int dt = 0; dt < 4; ++dt) {
      const int d = dt * 16 + q * 4;
      const uint2 zz = zzv[nt][dt];
      uint2 o;
      o.x = pack2(O[dt][nt][0] * lo2f(zz.x), O[dt][nt][1] * hi2f(zz.x));
      o.y = pack2(O[dt][nt][2] * lo2f(zz.y), O[dt][nt][3] * hi2f(zz.y));
      *(uint2*)(Y + tok * 1024 + 512 + head * 64 + d) = o;
    }
  }
  __syncthreads();
}

DEVI void hgrn_local(const Params& p, int unit, unsigned char* smem) {
  const int tid = opaque_tid(), lane = tid & 63, w = tid >> 6, wr = w >> 1, wc = w & 1;
  const int bh = unit >> 7, c = unit & 127, b = bh >> 3, h = bh & 7, t0 = c * 64;
  const long R0 = (long)b * 8192 + t0;
  unsigned char* ws = p.ws;
  bf16_t* sA = (bf16_t*)smem;
  bf16_t* sB = (bf16_t*)(smem + 18432);
  float* psum = (float*)(smem + 36864);
  const int cch = tid & 127, half = tid >> 7;
  const float lb = ((const float*)(ws + OFF_LB))[h * 128 + cch];
  const bf16_t* FP = (const bf16_t*)(ws + L1_FP) + R0 * 1024 + h * 128 + cch;
  float sgv[32], lgv[32];
  {
    const bf16_t* vtp = (const bf16_t*)(ws + L1_VT) + (((long)(b * 8 + h) * 128 + c) * 128) * 64 + (tid >> 3) * 64 + (tid & 7) * 8;
    u32x4 t0_ = *(const u32x4*)vtp, t1_ = *(const u32x4*)(vtp + 32 * 64), t2_ = *(const u32x4*)(vtp + 64 * 64), t3_ = *(const u32x4*)(vtp + 96 * 64);
    bf16_t fpr[32];
#pragma unroll
    for (int k = 0; k < 32; ++k) fpr[k] = FP[(long)(half * 32 + k) * 1024];
    {
      bf16_t* sp = sA + (tid >> 3) * LDT + (tid & 7) * 8;
      *(u32x4*)sp = t0_; *(u32x4*)(sp + 32 * LDT) = t1_; *(u32x4*)(sp + 64 * LDT) = t2_; *(u32x4*)(sp + 96 * LDT) = t3_;
    }
#pragma unroll
    for (int k = 0; k < 32; ++k) { sgv[k] = sigm(bf2f(fpr[k])); lgv[k] = __logf(lb + (1.f - lb) * sgv[k]); }
  }
  float sum = 0.f;
#pragma unroll
  for (int k = 0; k < 32; ++k) sum += lgv[k];
  psum[half * 128 + cch] = sum;
  __syncthreads();
  const float bL = psum[cch] + psum[128 + cch];
  float run = half ? psum[cch] : 0.f;
#pragma unroll
  for (int k = 0; k < 32; ++k) {
    run += lgv[k];
    float kk_ = (1.f - lb) * (1.f - sgv[k]);
    sB[cch * LDT + half * 32 + k] = f2bf(kk_ * __expf(bL - run));
  }
  if (half == 0) ((float*)(ws + L1_BL))[(long)unit * 128 + cch] = bL;
  __syncthreads();
  f32x4 acc[4][4];
#pragma unroll
  for (int mt = 0; mt < 4; ++mt)
#pragma unroll
    for (int nt = 0; nt < 4; ++nt) acc[mt][nt] = f32x4{0.f, 0.f, 0.f, 0.f};
  mma_lds_sw<4, 4, 2>(sA + wr * 64 * LDT, sB + wc * 64 * LDT, acc, lane);
#ifndef R9B
#define R9B 1
#endif
  for (int r9_ = 0; r9_ < R9B; ++r9_) {
  bf16_t* st = (bf16_t*)(ws + L1_ST) + (long)unit * 16384;
  const int r = lane & 15, q = lane >> 4;
#pragma unroll
  for (int mt = 0; mt < 4; ++mt) {
    const int v = wr * 64 + mt * 16 + r;
#pragma unroll
    for (int nt = 0; nt < 4; ++nt) {
      uint2 o;
      o.x = pack2(acc[mt][nt][0], acc[mt][nt][1]);
      o.y = pack2(acc[mt][nt][2], acc[mt][nt][3]);
      *(uint2*)(st + v * 128 + wc * 64 + nt * 16 + q * 4) = o;
    }
  }
  }
  __syncthreads();
}

template <bool DUMMY>
DEVI void hgrn_scan(const Params& p) {
  unsigned char* ws = p.ws;
  const float* BL = (const float*)(ws + L1_BL);
  for (int idx = blockIdx.x * 256 + opaque_tid(); idx < 16 * 8192; idx += gridDim.x * 256) {
    const int bh = idx >> 13, pr = idx & 8191;
    const int c2 = (pr & 63) * 2;
    unsigned* ptr = (unsigned*)(ws + L1_ST) + (long)bh * 128 * 8192 + pr;
    const float* blp = BL + (long)bh * 128 * 128 + c2;
    float s0 = 0.f, s1 = 0.f;
    for (int c0 = 0; c0 < 128; c0 += 8) {
      unsigned dv[8]; float2 bl[8];
#pragma unroll
      for (int k = 0; k < 8; ++k) { dv[k] = ptr[(long)(c0 + k) * 8192]; bl[k] = *(const float2*)(blp + (long)(c0 + k) * 128); }
#pragma unroll
      for (int k = 0; k < 8; ++k) {
        if (!DUMMY) ptr[(long)(c0 + k) * 8192] = pack2(s0, s1);
        s0 = __expf(bl[k].x) * s0 + lo2f(dv[k]);
        s1 = __expf(bl[k].y) * s1 + hi2f(dv[k]);
      }
    }
    if (DUMMY && s0 == 123.456f) ptr[0] = pack2(s0, s1);
  }
}

DEVI void hgrn_out(const Params& p, int unit, unsigned char* smem) {
  const int tid = opaque_tid(), lane = tid & 63, w = tid >> 6, wr = w >> 1, wc = w & 1;
  const int r = lane & 15, q = lane >> 4;
  const int bh = unit >> 7, c = unit & 127, b = bh >> 3, h = bh & 7, t0 = c * 64;
  const long R0 = (long)b * 8192 + t0;
  unsigned char* ws = p.ws;
  bf16_t* sQ0 = (bf16_t*)smem; bf16_t* sQ1 = (bf16_t*)(smem + 9216);
  bf16_t* sK0 = (bf16_t*)(smem + 18432); bf16_t* sK1 = (bf16_t*)(smem + 27648);
  bf16_t* sAm = (bf16_t*)(smem + 36864);
  bf16_t* sB = (bf16_t*)(smem + 46080);
  float* psum = (float*)(smem + 64512);
  float* sSs = psum + 256;
  const int cch = tid & 127, half = tid >> 7, cc = cch & 63;
  const float lb = ((const float*)(ws + OFF_LB))[h * 128 + cch];
  const bf16_t* FP = (const bf16_t*)(ws + L1_FP) + R0 * 1024 + h * 128 + cch;
  const bf16_t* Q1 = (const bf16_t*)(ws + L1_Q) + R0 * 1024 + h * 128 + cch;
  const bf16_t* vt = (const bf16_t*)(ws + L1_VT) + (((long)(b * 8 + h) * 128 + c) * 128) * 64;
  const bf16_t* st = (const bf16_t*)(ws + L1_ST) + (long)unit * 16384;
  const int tl_r = tid >> 3, tl_k = (tid & 7) * 8;
  u32x4 vv0, vv1, vv2, vv3, sa0, sa1, sa2, sa3, sb0, sb1, sb2, sb3;
  {
    const bf16_t* vp = vt + tl_r * 64 + tl_k;
    vv0 = *(const u32x4*)vp; vv1 = *(const u32x4*)(vp + 32 * 64); vv2 = *(const u32x4*)(vp + 64 * 64); vv3 = *(const u32x4*)(vp + 96 * 64);
    const bf16_t* sp = st + tl_r * 128 + tl_k;
    sa0 = *(const u32x4*)sp; sa1 = *(const u32x4*)(sp + 32 * 128); sa2 = *(const u32x4*)(sp + 64 * 128); sa3 = *(const u32x4*)(sp + 96 * 128);
    sb0 = *(const u32x4*)(sp + 64); sb1 = *(const u32x4*)(sp + 32 * 128 + 64); sb2 = *(const u32x4*)(sp + 64 * 128 + 64); sb3 = *(const u32x4*)(sp + 96 * 128 + 64);
  }
  float sgv[32], lgv[32];
  bf16_t qr[32];
  {
    bf16_t fpr[32];
#pragma unroll
    for (int k = 0; k < 32; ++k) { fpr[k] = FP[(long)(half * 32 + k) * 1024]; qr[k] = Q1[(long)(half * 32 + k) * 1024]; }
    { bf16_t* dp = sB + tl_r * LDT + tl_k; *(u32x4*)dp = vv0; *(u32x4*)(dp + 32 * LDT) = vv1; *(u32x4*)(dp + 64 * LDT) = vv2; *(u32x4*)(dp + 96 * LDT) = vv3; }
#pragma unroll
    for (int k = 0; k < 32; ++k) { sgv[k] = sigm(bf2f(fpr[k])); lgv[k] = __logf(lb + (1.f - lb) * sgv[k]); }
  }
  float sum = 0.f;
#pragma unroll
  for (int k = 0; k < 32; ++k) sum += lgv[k];
  psum[half * 128 + cch] = sum;
  __syncthreads();
  float run = half ? psum[cch] : 0.f;
  bf16_t* sQ = (cch < 64) ? sQ0 : sQ1;
  bf16_t* sK = (cch < 64) ? sK0 : sK1;
#pragma unroll
  for (int k = 0; k < 32; ++k) {
    const int s_ = half * 32 + k;
    run += lgv[k];
    float kk_ = (1.f - lb) * (1.f - sgv[k]);
    sQ[s_ * LDT + cc] = f2bf(bf2f(qr[k]) * __expf(run));
    sK[s_ * LDT + cc] = f2bf(kk_ * __expf(fminf(-run, 80.f)));
  }
  __syncthreads();
  {
    f32x4 a1[2][2];
#pragma unroll
    for (int mt = 0; mt < 2; ++mt)
#pragma unroll
      for (int nt = 0; nt < 2; ++nt) a1[mt][nt] = f32x4{0.f, 0.f, 0.f, 0.f};
    if (!(wr == 0 && wc == 1)) {
      mma_lds<2, 2, 2>(sQ0 + wr * 32 * LDT, sK0 + wc * 32 * LDT, a1, lane);
      mma_lds<2, 2, 2>(sQ1 + wr * 32 * LDT, sK1 + wc * 32 * LDT, a1, lane);
    }
#pragma unroll
    for (int mt = 0; mt < 2; ++mt)
#pragma unroll
      for (int i = 0; i < 4; ++i) {
        int j = wr * 32 + mt * 16 + q * 4 + i;
#pragma unroll
        for (int nt = 0; nt < 2; ++nt) {
          int s = wc * 32 + nt * 16 + r;
          sAm[j * LDT + s] = f2bf((s <= j) ? a1[mt][nt][i] : 0.f);
        }
      }
  }
  __syncthreads();
  f32x4 o[2][4];
#pragma unroll
  for (int mt = 0; mt < 2; ++mt)
#pragma unroll
    for (int nt = 0; nt < 4; ++nt) o[mt][nt] = f32x4{0.f, 0.f, 0.f, 0.f};
  mma_lds<2, 4, 2>(sAm + wr * 32 * LDT, sB + wc * 64 * LDT, o, lane);
  __syncthreads();
  { bf16_t* dp = sB + tl_r * LDT + tl_k; *(u32x4*)dp = sa0; *(u32x4*)(dp + 32 * LDT) = sa1; *(u32x4*)(dp + 64 * LDT) = sa2; *(u32x4*)(dp + 96 * LDT) = sa3; }
  __syncthreads();
  mma_lds<2, 4, 2>(sQ0 + wr * 32 * LDT, sB + wc * 64 * LDT, o, lane);
  __syncthreads();
  { bf16_t* dp = sB + tl_r * LDT + tl_k; *(u32x4*)dp = sb0; *(u32x4*)(dp + 32 * LDT) = sb1; *(u32x4*)(dp + 64 * LDT) = sb2; *(u32x4*)(dp + 96 * LDT) = sb3; }
  __syncthreads();
  mma_lds<2, 4, 2>(sQ1 + wr * 32 * LDT, sB + wc * 64 * LDT, o, lane);
#pragma unroll
  for (int mt = 0; mt < 2; ++mt)
#pragma unroll
    for (int i = 0; i < 4; ++i) {
      int j = wr * 32 + mt * 16 + q * 4 + i;
      float ss = 0.f;
#pragma unroll
      for (int nt = 0; nt < 4; ++nt) ss += o[mt][nt][i] * o[mt][nt][i];
      ss = grp16_sum(ss);
      if (r == 0) sSs[wc * 64 + j] = ss;
    }
  __syncthreads();
  const bf16_t* Z1 = (const bf16_t*)(ws + L1_Z);
  bf16_t* Y1 = (bf16_t*)(ws + L1_H);
  float hn[4];
#pragma unroll
  for (int nt = 0; nt < 4; ++nt) hn[nt] = p.h_hn[h * 128 + wc * 64 + nt * 16 + r];
#pragma unroll
  for (int mt = 0; mt < 2; ++mt) {
    float zv[4][4];
#pragma unroll
    for (int i = 0; i < 4; ++i) {
      long row = R0 + wr * 32 + mt * 16 + q * 4 + i;
#pragma unroll
      for (int nt = 0; nt < 4; ++nt) zv[i][nt] = bf2f(Z1[row * 1024 + h * 128 + wc * 64 + nt * 16 + r]);
    }
#pragma unroll
    for (int i = 0; i < 4; ++i) {
      int j = wr * 32 + mt * 16 + q * 4 + i;
      float rinv = rsqrtf((sSs[j] + sSs[64 + j]) * (1.f / 128.f) + EPSF);
      long row = R0 + j;
#pragma unroll
      for (int nt = 0; nt < 4; ++nt) {
        int col = h * 128 + wc * 64 + nt * 16 + r;
        Y1[row * 1024 + col] = f2bf(o[mt][nt][i] * rinv * hn[nt] * zv[i][nt]);
      }
    }
  }
  __syncthreads();
}

#define XB_TMO      128
#define XB_XCNT(j)  (256  + 64 * (j))
#define XB_XSUB(j)  (1280 + 64 * (j))
#define XB_XGEN(j)  (2304 + 64 * (j))
#define XB_TOP      3328
#define XB_TOPGEN   3392
#define XCD_BAR_WORDS 3456
#define XB_SPIN_CAP (1u << 22)
DEVI unsigned xb_ld(unsigned* p) { return __hip_atomic_load(p, __ATOMIC_RELAXED, __HIP_MEMORY_SCOPE_AGENT); }
DEVI unsigned xb_add(unsigned* p, unsigned v) { return __hip_atomic_fetch_add(p, v, __ATOMIC_RELAXED, __HIP_MEMORY_SCOPE_AGENT); }
DEVI unsigned xb_xcc_id() { return (unsigned)__builtin_amdgcn_s_getreg((3 << 11) | 20) & 0xFu; }
#define XB_SPIN(cond, bar) do { unsigned _sp = 0; while (cond) { __builtin_amdgcn_s_sleep(1); \
    if ((++_sp & 255u) == 0u) { if (xb_ld(&(bar)[XB_TMO])) break; if (_sp > XB_SPIN_CAP) { atomicAdd(&(bar)[XB_TMO], 1u); break; } } } } while (0)

DEVI void xcd_barrier_complete(unsigned* bar, unsigned x, unsigned& nloc, unsigned& nx) {
  const unsigned G = gridDim.x;
  unsigned sum, cnt, mine, sp = 0u;
  for (;;) {
    sum = 0u; cnt = 0u; mine = 0u;
#pragma unroll
    for (unsigned j = 0; j < 16; ++j) { const unsigned c = xb_ld(&bar[XB_XCNT(j)]); sum += c; cnt += (c > 0u) ? 1u : 0u; mine = (j == x) ? c : mine; }
    if (sum == G) break;
    __builtin_amdgcn_s_sleep(1);
    if ((++sp & 255u) == 0u) { if (xb_ld(&bar[XB_TMO])) break; if (sp > XB_SPIN_CAP) { atomicAdd(&bar[XB_TMO], 1u); break; } }
  }
  nloc = mine > 0u ? mine : 1u; nx = cnt > 0u ? cnt : 1u;
}

DEVI void grid_barrier(unsigned* bar, unsigned xcc, volatile unsigned* st) {
  asm volatile("s_waitcnt vmcnt(0)" ::: "memory");
  __syncthreads();
  if (threadIdx.x == 0) {
    __builtin_amdgcn_s_waitcnt(0);
    unsigned nloc = st[0], nx = st[1];
    if (nloc == 0u) { xcd_barrier_complete(bar, xcc, nloc, nx); st[0] = nloc; st[1] = nx; }
    const unsigned old = xb_add(&bar[XB_XSUB(xcc)], 1u);
    const unsigned gen = old / nloc;
    if (old + 1u == (gen + 1u) * nloc) {
      __builtin_amdgcn_fence(__ATOMIC_RELEASE, "agent");
      asm volatile("s_waitcnt vmcnt(0)" ::: "memory");
      const unsigned og = xb_add(&bar[XB_TOP], 1u);
      const unsigned tg = og / nx;
      if (og + 1u == (tg + 1u) * nx) xb_add(&bar[XB_TOPGEN], 1u);
      else XB_SPIN(xb_ld(&bar[XB_TOPGEN]) == tg, bar);
      __builtin_amdgcn_fence(__ATOMIC_ACQUIRE, "agent");
      xb_add(&bar[XB_XGEN(xcc)], 1u);
      asm volatile("s_waitcnt vmcnt(0)" ::: "memory");
    } else {
      XB_SPIN(xb_ld(&bar[XB_XGEN(xcc)]) == gen, bar);
      __builtin_amdgcn_fence(__ATOMIC_ACQUIRE, "agent");
      asm volatile("s_waitcnt vmcnt(0)" ::: "memory");
    }
  }
  __syncthreads();
}

#ifndef REP_NSA
#define REP_NSA 1
#endif
#ifndef REP_P0
#define REP_P0 1
#endif
#ifndef REP_P1
#define REP_P1 1
#endif
#ifndef REP_P2
#define REP_P2 1
#endif
#ifndef REP_P3
#define REP_P3 1
#endif
#ifndef REP_P4
#define REP_P4 1
#endif
#ifndef REP_P5
#define REP_P5 1
#endif
#ifndef REP_P6
#define REP_P6 1
#endif
#ifndef REP_P7
#define REP_P7 1
#endif
#ifndef REP_P8
#define REP_P8 1
#endif
#ifndef REP_P9
#define REP_P9 1
#endif
#ifndef REP_P10
#define REP_P10 1
#endif
#ifndef REP_P11
#define REP_P11 1
#endif
#ifndef REP_P12
#define REP_P12 1
#endif
#ifndef DBG_STOP
#define DBG_STOP 99
#endif
DEVI void dbg_probe_bf16(const Params& p, size_t off, long n) {
  const bf16_t* b = (const bf16_t*)(p.ws + off);
  for (long i = (long)blockIdx.x * 256 + threadIdx.x; i < 16384L * 1024; i += (long)gridDim.x * 256) {
    float v = bf2f(b[i % n]);
    if (!(v == v) || fabsf(v) > 1e30f) v = 777.f;
    p.out[i] = v;
  }
}
DEVI void dbg_probe_f32(const Params& p, size_t off, long n) {
  const float* b = (const float*)(p.ws + off);
  for (long i = (long)blockIdx.x * 256 + threadIdx.x; i < 16384L * 1024; i += (long)gridDim.x * 256) {
    float v = b[i % n];
    if (!(v == v) || fabsf(v) > 1e30f) v = 777.f;
    p.out[i] = v;
  }
}
DEVI void dbg_probe_combo(const Params& p) {
  const bf16_t* qn = (const bf16_t*)(p.ws + L0_QN);
  const bf16_t* ks = (const bf16_t*)(p.ws + L0_KS);
  const bf16_t* nz = (const bf16_t*)(p.ws + L0_NZ);
  const float* ig = (const float*)(p.ws + L0_IG);
  for (long i = (long)blockIdx.x * 256 + threadIdx.x; i < 16384L * 1024; i += (long)gridDim.x * 256) {
    float v = bf2f(qn[i % (16384L * 512)]) + bf2f(ks[i % (4L * 8192 * 64 * 4)]) + bf2f(nz[i % (16384L * 512)]) + ig[i % (16384L * 32)];
    if (!(v == v) || fabsf(v) > 1e30f) v = 777.f;
    p.out[i] = v;
  }
}
#define DBG_AT(k, stmt) if (DBG_STOP == k) { stmt; return; }

#define GSYNC() grid_barrier(bar_ctr, bar_xcc, bar_st)

__global__ void __launch_bounds__(256, 2) mega(Params p) {
  __shared__ __attribute__((aligned(16))) unsigned char smem[79872];
  cg::grid_group grid = cg::this_grid();
  const int G = gridDim.x, bid = blockIdx.x, tid = threadIdx.x, lane = tid & 63, w = tid >> 6;
  unsigned char* ws = p.ws;
  bf16_t* sA = (bf16_t*)smem;
  bf16_t* sB = (bf16_t*)(smem + 16384);
  unsigned* bar_ctr = (unsigned*)(ws + OFF_BAR);
  __shared__ uint4 xb_words;
  if (tid == 0) xb_words = make_uint4(0u, 0u, 0u, 0u);
  __syncthreads();
  volatile unsigned* bar_st = (volatile unsigned*)&xb_words;
  const unsigned bar_xcc = xb_xcc_id();
  if (tid == 0) (void)xb_add(&bar_ctr[XB_XCNT(bar_xcc)], 1u);
  if (p.ws == nullptr) grid.sync();

#ifdef EXTRA_SYNCS
  for (int e_ = 0; e_ < EXTRA_SYNCS; ++e_) GSYNC();
#endif
  for (int rep_ = 0; rep_ < REP_P0; ++rep_) {
  phase0(p, smem);
  GSYNC();
  }
  DBG_AT(0, dbg_probe_bf16(p, L0_H, 16384L*1024))
  for (int rep_ = 0; rep_ < REP_P1; ++rep_) {
  for (int k_ = 0; k_ * (G >> 3) < 16 * 35; ++k_) {
    int tm, tn;
    if (!gemm_tile_xcd(bid, G, k_, 35, tm, tn)) continue;
    gemm128<false>((const bf16_t*)(ws + L0_H), 1024, 16383, (const bf16_t*)(ws + OFF_WIN0), 1024, 4383, 1024, tm * 128, tn * 128, sA, sB,
            [&](f32x4 (&acc)[4][4], int mb, int nb, int ln) { epi_proj0(p, acc, mb, nb, ln); });
  }
  GSYNC();
  }
  DBG_AT(1, dbg_probe_bf16(p, L0_QKRAW, 16384L*1024)) DBG_AT(101, dbg_probe_combo(p)) DBG_AT(102, dbg_probe_bf16(p, L0_KS, 4L*8192*64*4)) DBG_AT(103, dbg_probe_f32(p, L0_IG, 16384L*4*2+16384L*24)) DBG_AT(104, dbg_probe_bf16(p, L0_MVT, 16384L*512*3))
  for (int rep_ = 0; rep_ < REP_P2; ++rep_) {
  for (int it = bid; it < 128 + 2048; it += G) {
    if (it < 128) {
      int ksp = it >> 5, kv = (it >> 4) & 1, bg = (it >> 2) & 3, tm = it & 3;
      const bf16_t* A = (const bf16_t*)(ws + (kv ? L0_VCRAW : L0_KCRAW)) + (long)bg * 8192 * 64 + ksp * 512;
      const bf16_t* B = (const bf16_t*)(ws + (kv ? OFF_WCV : OFF_WCK)) + ksp * 512;
      gemm128<false>(A, 1024, 510, B, 2048, 127, 512, tm * 128, 0, sA, sB,
              [&](f32x4 (&acc)[4][4], int mb, int nb, int ln) { epi_cmp_hidden(p, acc, mb, nb, ln, kv, bg, ksp); });
    } else {
      conv_tile(p, it - 128, smem);
    }
  }
  GSYNC();
  }
  DBG_AT(2, dbg_probe_bf16(p, L0_QC, 16384L*512*3)) DBG_AT(201, dbg_probe_f32(p, L0_HID, 2L*4*512*128))
  for (int rep_ = 0; rep_ < REP_P3; ++rep_) {
  for (int it = bid; it < 512 + 1024; it += G) {
    if (it < 512) mlstm_local(p, it, smem);
    else { const int t_ = opaque_tid(); cmp_finalize(p, (it - 512) * 4 + (t_ >> 6), t_ & 63); }
  }
  GSYNC();
  }
  DBG_AT(3, dbg_probe_f32(p, L0_H, 512L*16384)) DBG_AT(301, dbg_probe_bf16(p, L0_KCMP, 4L*512*64*2)) DBG_AT(302, dbg_probe_f32(p, L0_DN, 512L*128 + 2048))
  for (int rep_ = 0; rep_ < REP_P4; ++rep_) {
#ifdef DUMMY_P4
  mlstm_scan<true>(p, smem);
  GSYNC();
#endif
  mlstm_scan<false>(p, smem);
  GSYNC();
  }
  DBG_AT(4, dbg_probe_f32(p, L0_H, 512L*16384)) DBG_AT(401, dbg_probe_f32(p, L0_DN, 512L*128 + 3072))
  for (int rep_ = 0; rep_ < REP_P5; ++rep_) {
  for (int it = bid; it < 1024 + 1024; it += G) {
    if (it < 1024) {
      int k = it >> 9, i = it & 511;
      int idx = (k & 1) ? (k * 512 + 511 - i) : it;
#ifndef DBG_SKIP_NSA
      for (int r2_ = 0; r2_ < REP_NSA; ++r2_) nsa_tile(p, idx, smem);
#endif
    } else {
#ifndef DBG_SKIP_MOUT
      mlstm_out(p, it - 1024, smem);
#endif
    }
  }
  GSYNC();
  }
  DBG_AT(5, dbg_probe_bf16(p, L0_QKRAW, 16384L*1024))
  for (int rep_ = 0; rep_ < REP_P6; ++rep_) {
  for (int k_ = 0; k_ * (G >> 3) < 16 * 8; ++k_) {
    int tm, tn;
    if (!gemm_tile_xcd(bid, G, k_, 8, tm, tn)) continue;
    gemm128<false>((const bf16_t*)(ws + L0_QKRAW), 1024, 16383, (const bf16_t*)(ws + OFF_WOUT0), 1024, 1023, 1024, tm * 128, tn * 128, sA, sB,
            [&](f32x4 (&acc)[4][4], int mb, int nb, int ln) { epi_out_resid(p.x, p.out, acc, mb, nb, ln); });
  }
  GSYNC();
  }
  DBG_AT(6, (void)0)
  for (int rep_ = 0; rep_ < REP_P7; ++rep_) {
  { const int t_ = opaque_tid(); for (int row = (bid * 4 + (t_ >> 6)) * 2; row < 16384; row += G * 8) rmsnorm_row2(p.out, p.norm_w + 1024, (bf16_t*)(ws + L1_H), row, row + 1, t_ & 63); }
  GSYNC();
  }
  DBG_AT(7, dbg_probe_bf16(p, L1_H, 16384L*1024))
  for (int rep_ = 0; rep_ < REP_P8; ++rep_) {
  for (int k_ = 0; k_ * (G >> 3) < 16 * 32; ++k_) {
    int tm, tn;
    if (!gemm_tile_xcd(bid, G, k_, 32, tm, tn)) continue;
    gemm128<false>((const bf16_t*)(ws + L1_H), 1024, 16383, (const bf16_t*)(ws + OFF_WIN1), 1024, 4095, 1024, tm * 128, tn * 128, sA, sB,
            [&](f32x4 (&acc)[4][4], int mb, int nb, int ln) { epi_proj1(p, acc, mb, nb, ln); });
  }
  GSYNC();
  }
  DBG_AT(8, dbg_probe_bf16(p, L1_FP, 16384L*1024*4))
  for (int rep_ = 0; rep_ < REP_P9; ++rep_) {
  for (int it = bid; it < 2048; it += G) hgrn_local(p, it, smem);
  GSYNC();
  }
  DBG_AT(9, dbg_probe_bf16(p, L1_ST, 2048L*16384))
  for (int rep_ = 0; rep_ < REP_P10; ++rep_) {
#ifdef DUMMY_P10
  hgrn_scan<true>(p);
  GSYNC();
#endif
  hgrn_scan<false>(p);
  GSYNC();
  }
  DBG_AT(10, dbg_probe_bf16(p, L1_ST, 2048L*16384))
  for (int rep_ = 0; rep_ < REP_P11; ++rep_) {
  for (int it = bid; it < 2048; it += G) hgrn_out(p, it, smem);
  GSYNC();
  }
  DBG_AT(11, dbg_probe_bf16(p, L1_H, 16384L*1024))
  for (int rep_ = 0; rep_ < REP_P12; ++rep_) {
  for (int k_ = 0; k_ * (G >> 3) < 16 * 8; ++k_) {
    int tm, tn;
    if (!gemm_tile_xcd(bid, G, k_, 8, tm, tn)) continue;
    gemm128<false>((const bf16_t*)(ws + L1_H), 1024, 16383, (const bf16_t*)(ws + OFF_WOUT1), 1024, 1023, 1024, tm * 128, tn * 128, sA, sB,
            [&](f32x4 (&acc)[4][4], int mb, int nb, int ln) { epi_out_resid(p.out, p.out, acc, mb, nb, ln); });
  }
  }
}

extern "C" void kernel_launch(void* const* d_in, const int* in_sizes, int n_in, void* d_out, int out_size, void* d_ws, size_t ws_size,
                              hipStream_t stream) {
  static int grid_blocks = 0;
  if (!grid_blocks) {
    int dev = 0, cus = 0, per_cu = 0;
    (void)hipGetDevice(&dev);
    (void)hipDeviceGetAttribute(&cus, hipDeviceAttributeMultiprocessorCount, dev);
    (void)hipOccupancyMaxActiveBlocksPerMultiprocessor(&per_cu, mega, 256, 0);
    if (per_cu > 2) per_cu = 2;
    if (per_cu < 1) per_cu = 1;
    grid_blocks = cus * per_cu;
  }
  Params p{};
  const float** pf = (const float**)&p;
  for (int i = 0; i < 22; ++i) pf[i] = (const float*)d_in[i];
  p.out = (float*)d_out;
  p.ws = (unsigned char*)d_ws;
  (void)hipMemsetAsync((unsigned char*)d_ws + OFF_BAR, 0, 16384, stream);
  void* args[] = {&p};
  hipError_t e = hipLaunchCooperativeKernel((void*)mega, dim3(grid_blocks), dim3(256), args, 0, stream);
  if (e != hipSuccess) fprintf(stderr, "cooperative launch failed: %s (grid %d)\n", hipGetErrorString(e), grid_blocks);
}
```

```cpp
#include <hip/hip_runtime.h>
#define USE_G256 1
#include <hip/hip_cooperative_groups.h>
#include <stdint.h>
#include <cstdio>
namespace cg = cooperative_groups;

typedef unsigned short bf16_t;
typedef __attribute__((ext_vector_type(8))) short bf16x8;
typedef __attribute__((ext_vector_type(4))) float f32x4;
typedef __attribute__((ext_vector_type(4))) unsigned int u32x4;

#define DEVI __device__ __forceinline__
#define EPSF 1e-6f
#define LDT 72
#define SLD 68
#define NEGS (-1e30f)
#define LAUNDER(ptr) asm volatile("" : "+s"(ptr))

struct Params {
  const float* x; const float* norm_w; const float* ev_w_in; const float* ev_b_in; const float* f_bias;
  const float* conv_w; const float* conv_b; const float* m_hn; const float* q_norm; const float* k_norm;
  const float* ck_pos; const float* ck_w1; const float* ck_w2; const float* cv_pos; const float* cv_w1; const float* cv_w2;
  const float* ev_w_out; const float* od_w_in; const float* od_b_in; const float* lb_logits; const float* h_hn; const float* od_w_out;
  float* out; unsigned char* ws;
};

constexpr size_t MiB = 1048576;
constexpr size_t OFF_WIN0 = 0;
constexpr size_t OFF_WOUT0 = OFF_WIN0 + 4480ull * 1024 * 2;
constexpr size_t OFF_WIN1 = OFF_WOUT0 + 2 * MiB;
constexpr size_t OFF_WOUT1 = OFF_WIN1 + 8 * MiB;
constexpr size_t OFF_WCK = OFF_WOUT1 + 2 * MiB;
constexpr size_t OFF_WCV = OFF_WCK + 512 * 1024;
constexpr size_t OFF_ROPE = OFF_WCV + 512 * 1024;
constexpr size_t OFF_PB = OFF_ROPE + 512 * 1024;
constexpr size_t OFF_LB = OFF_PB + 1024;
constexpr size_t OFF_BAR = OFF_LB + 4096;
constexpr size_t OFF_BASE = 24 * MiB;
constexpr size_t L0_H = OFF_BASE;
constexpr size_t L0_QKRAW = L0_H + 32 * MiB;
constexpr size_t L0_QC = L0_QKRAW + 32 * MiB;
constexpr size_t L0_KC = L0_QC + 16 * MiB;
constexpr size_t L0_KCT = L0_KC + 16 * MiB;
constexpr size_t L0_MVT = L0_KCT + 16 * MiB;
constexpr size_t L0_MO = L0_MVT + 16 * MiB;
constexpr size_t L0_MZ = L0_MO + 16 * MiB;
constexpr size_t L0_QN = L0_MZ + 16 * MiB;
constexpr size_t L0_NZ = L0_QN + 16 * MiB;
constexpr size_t L0_KCRAW = L0_NZ + 16 * MiB;
constexpr size_t L0_VCRAW = L0_KCRAW + 4 * MiB;
constexpr size_t L0_KS = L0_VCRAW + 4 * MiB;
constexpr size_t L0_KW = L0_KS + 4 * MiB;
constexpr size_t L0_VST = L0_KW + 4 * MiB;
constexpr size_t L0_VWT = L0_VST + 4 * MiB;
constexpr size_t L0_HID = L0_VWT + 4 * MiB;
constexpr size_t L0_KCMP = L0_HID + 2 * MiB;
constexpr size_t L0_VCMPT = L0_KCMP + 256 * 1024;
constexpr size_t L0_IG = L0_VCMPT + 256 * 1024;
constexpr size_t L0_LOGF = L0_IG + 256 * 1024;
constexpr size_t L0_GATES = L0_LOGF + 256 * 1024;
constexpr size_t L0_DN = L0_GATES + 1536 * 1024;
constexpr size_t L0_BL = L0_DN + 256 * 1024;
constexpr size_t L0_MLOC = L0_BL + 4096;
constexpr size_t L0_MIN = L0_MLOC + 4096;
constexpr size_t L0_HIDP = L0_MIN + 4096;
constexpr size_t L0_END = L0_HIDP + 8 * MiB;
static_assert(L0_END <= 256 * MiB, "ws overflow L0");
constexpr size_t L1_H = OFF_BASE;
constexpr size_t L1_FP = L1_H + 32 * MiB;
constexpr size_t L1_Q = L1_FP + 32 * MiB;
constexpr size_t L1_VT = L1_Q + 32 * MiB;
constexpr size_t L1_Z = L1_VT + 32 * MiB;
constexpr size_t L1_ST = L1_Z + 32 * MiB;
constexpr size_t L1_BL = L1_ST + 64 * MiB;
constexpr size_t L1_END = L1_BL + 1 * MiB;
static_assert(L1_END <= 256 * MiB, "ws overflow L1");

DEVI int opaque_tid() { int t = threadIdx.x; asm volatile("" : "+v"(t)); return t; }
typedef __bf16 bf16v2_t __attribute__((ext_vector_type(2)));
typedef float f32v2_t __attribute__((ext_vector_type(2)));
DEVI bf16_t f2bf(float f) { __bf16 h = (__bf16)f; return __builtin_bit_cast(unsigned short, h); }
DEVI float bf2f(bf16_t b) { return __uint_as_float(((unsigned)b) << 16); }
DEVI unsigned pack2(float a, float b) { f32v2_t f = {a, b}; bf16v2_t h = __builtin_convertvector(f, bf16v2_t); return __builtin_bit_cast(unsigned, h); }
DEVI float lo2f(unsigned u) { return __uint_as_float(u << 16); }
DEVI float hi2f(unsigned u) { return __uint_as_float(u & 0xffff0000u); }
DEVI float sigm(float x) { return 1.f / (1.f + __expf(-x)); }
DEVI float siluf(float x) { return x * sigm(x); }
DEVI float wave_sum(float v) { for (int o = 32; o > 0; o >>= 1) v += __shfl_xor(v, o); return v; }
DEVI float grp16_sum(float v) { v += __shfl_xor(v, 1); v += __shfl_xor(v, 2); v += __shfl_xor(v, 4); v += __shfl_xor(v, 8); return v; }

DEVI void wave_scan_sum128(float& a, float& b, int lane) {
  float t = a + b;
  float s = t;
#pragma unroll
  for (int o = 1; o < 64; o <<= 1) { float u = __shfl_up(s, o); if (lane >= o) s += u; }
  const float excl = s - t;
  a = excl + a;
  b = a + b;
}
DEVI void wave_scan_max128(float& a, float& b, int lane) {
  float t = fmaxf(a, b);
  float s = t;
#pragma unroll
  for (int o = 1; o < 64; o <<= 1) { float u = __shfl_up(s, o); if (lane >= o) s = fmaxf(s, u); }
  float prev = __shfl_up(s, 1);
  if (lane == 0) prev = -3.0e38f;
  a = fmaxf(prev, a);
  b = fmaxf(a, b);
}
DEVI float wave_max(float v) { for (int o = 32; o > 0; o >>= 1) v = fmaxf(v, __shfl_xor(v, o)); return v; }
DEVI int oldcol(int n) {
  return n < 2560 ? n : (n < 3840 ? n + 8 : (n < 4352 ? n + 32 : (n < 4360 ? n - 4352 + 2560 : n - 4360 + 3848)));
}

template <int MT, int NTL, int KS>
DEVI void mma_lds(const bf16_t* sA, const bf16_t* sB, f32x4 (&acc)[MT][NTL], int lane, bool neg = false) {
  const int r = lane & 15, q = lane >> 4;
#pragma unroll
  for (int ks = 0; ks < KS; ++ks) {
    bf16x8 a[MT], b[NTL];
#pragma unroll
    for (int mt = 0; mt < MT; ++mt) a[mt] = *(const bf16x8*)(sA + (mt * 16 + r) * LDT + ks * 32 + q * 8);
    if (neg) {
#pragma unroll
      for (int mt = 0; mt < MT; ++mt) a[mt] ^= (short)0x8000;
    }
#pragma unroll
    for (int nt = 0; nt < NTL; ++nt) b[nt] = *(const bf16x8*)(sB + (nt * 16 + r) * LDT + ks * 32 + q * 8);
#pragma unroll
    for (int mt = 0; mt < MT; ++mt)
#pragma unroll
      for (int nt = 0; nt < NTL; ++nt) acc[mt][nt] = __builtin_amdgcn_mfma_f32_16x16x32_bf16(a[mt], b[nt], acc[mt][nt], 0, 0, 0);
  }
}
template <int MT, int NTL, int KS>
DEVI void mma_lds_sw(const bf16_t* sA, const bf16_t* sB, f32x4 (&acc)[MT][NTL], int lane, bool neg = false) {
  const int r = lane & 15, q = lane >> 4;
#pragma unroll
  for (int ks = 0; ks < KS; ++ks) {
    bf16x8 a[MT], b[NTL];
#pragma unroll
    for (int mt = 0; mt < MT; ++mt) a[mt] = *(const bf16x8*)(sA + (mt * 16 + r) * LDT + ks * 32 + q * 8);
    if (neg) {
#pragma unroll
      for (int mt = 0; mt < MT; ++mt) a[mt] ^= (short)0x8000;
    }
#pragma unroll
    for (int nt = 0; nt < NTL; ++nt) b[nt] = *(const bf16x8*)(sB + (nt * 16 + r) * LDT + ks * 32 + q * 8);
#pragma unroll
    for (int mt = 0; mt < MT; ++mt)
#pragma unroll
      for (int nt = 0; nt < NTL; ++nt) acc[mt][nt] = __builtin_amdgcn_mfma_f32_16x16x32_bf16(b[nt], a[mt], acc[mt][nt], 0, 0, 0);
  }
}


template <int MT, int NTL, bool SWAP>
DEVI void mma_swz(const bf16_t* sA, const bf16_t* sB, f32x4 (&acc)[MT][NTL], int lane, bool neg) {
  const int r = lane & 15, q = lane >> 4, r7 = r & 7;
#pragma unroll
  for (int ks = 0; ks < 2; ++ks) {
    bf16x8 a[MT], b[NTL];
    const int co = ((ks * 4 + q) ^ r7) * 8;
#pragma unroll
    for (int mt = 0; mt < MT; ++mt) a[mt] = *(const bf16x8*)(sA + (mt * 16 + r) * 64 + co);
#pragma unroll
    for (int nt = 0; nt < NTL; ++nt) b[nt] = *(const bf16x8*)(sB + (nt * 16 + r) * 64 + co);
    if (neg) {
#pragma unroll
      for (int mt = 0; mt < MT; ++mt) a[mt] ^= (short)0x8000;
    }
#pragma unroll
    for (int mt = 0; mt < MT; ++mt)
#pragma unroll
      for (int nt = 0; nt < NTL; ++nt) {
        if (SWAP) acc[mt][nt] = __builtin_amdgcn_mfma_f32_16x16x32_bf16(b[nt], a[mt], acc[mt][nt], 0, 0, 0);
        else acc[mt][nt] = __builtin_amdgcn_mfma_f32_16x16x32_bf16(a[mt], b[nt], acc[mt][nt], 0, 0, 0);
      }
  }
}

DEVI void load_tile128(bf16_t* s, const bf16_t* g, long ld) {
  const int tid = opaque_tid(), lr = tid >> 3, lk = (tid & 7) * 8;
#pragma unroll
  for (int j = 0; j < 4; ++j) *(uint4*)(s + (lr + 32 * j) * LDT + lk) = *(const uint4*)(g + (long)(lr + 32 * j) * ld + lk);
}
DEVI void load_tile64(bf16_t* s, const bf16_t* g, long ld) {
  const int tid = opaque_tid(), lr = tid >> 3, lk = (tid & 7) * 8;
#pragma unroll
  for (int j = 0; j < 2; ++j) *(uint4*)(s + (lr + 32 * j) * LDT + lk) = *(const uint4*)(g + (long)(lr + 32 * j) * ld + lk);
}

template <bool SWAP, class Epi>
DEVI void gemm128(const bf16_t* A, long lda, int amax, const bf16_t* B, long ldb, int bmax, int K, int m0, int n0,
                  bf16_t* sA, bf16_t* sB, Epi&& epi) {
  const int tid = opaque_tid(), lane = tid & 63, w = tid >> 6, wr = w >> 1, wc = w & 1;
  const int lr = tid >> 3, lk = (tid & 7) * 8;
  const int lsw = (((tid & 7) ^ (lr & 7)) * 8);
  f32x4 acc[4][4];
#pragma unroll
  for (int mt = 0; mt < 4; ++mt)
#pragma unroll
    for (int nt = 0; nt < 4; ++nt) acc[mt][nt] = f32x4{0.f, 0.f, 0.f, 0.f};
  const bf16_t* ap[4];
  const bf16_t* bp[4];
#pragma unroll
  for (int j = 0; j < 4; ++j) {
    int ra = min(m0 + lr + 32 * j, amax);
    ap[j] = A + (long)ra * lda + lk;
    int rb = min(n0 + lr + 32 * j, bmax);
    bp[j] = B + (long)rb * ldb + lk;
  }
#ifndef GEMM_PASSES
#define GEMM_PASSES 1
#endif
  for (int pass_ = 0; pass_ < GEMM_PASSES; ++pass_) {
  u32x4 va0, va1, va2, va3, vb0, vb1, vb2, vb3;
  va0 = *(const u32x4*)(ap[0]); va1 = *(const u32x4*)(ap[1]); va2 = *(const u32x4*)(ap[2]); va3 = *(const u32x4*)(ap[3]);
  vb0 = *(const u32x4*)(bp[0]); vb1 = *(const u32x4*)(bp[1]); vb2 = *(const u32x4*)(bp[2]); vb3 = *(const u32x4*)(bp[3]);
  const int KT = K >> 6;
  *(u32x4*)(sA + (lr + 0) * 64 + lsw) = va0; *(u32x4*)(sA + (lr + 32) * 64 + lsw) = va1;
  *(u32x4*)(sA + (lr + 64) * 64 + lsw) = va2; *(u32x4*)(sA + (lr + 96) * 64 + lsw) = va3;
  *(u32x4*)(sB + (lr + 0) * 64 + lsw) = vb0; *(u32x4*)(sB + (lr + 32) * 64 + lsw) = vb1;
  *(u32x4*)(sB + (lr + 64) * 64 + lsw) = vb2; *(u32x4*)(sB + (lr + 96) * 64 + lsw) = vb3;
  if (KT > 1) {
    va0 = *(const u32x4*)(ap[0] + 64); va1 = *(const u32x4*)(ap[1] + 64); va2 = *(const u32x4*)(ap[2] + 64); va3 = *(const u32x4*)(ap[3] + 64);
    vb0 = *(const u32x4*)(bp[0] + 64); vb1 = *(const u32x4*)(bp[1] + 64); vb2 = *(const u32x4*)(bp[2] + 64); vb3 = *(const u32x4*)(bp[3] + 64);
  }
  __syncthreads();
  for (int kt = 0; kt < KT; ++kt) {
    const int st = (kt & 1) * 16384;
    const int sn = ((kt + 1) & 1) * 16384;
    if (kt + 1 < KT) {
      *(u32x4*)(sA + sn + (lr + 0) * 64 + lsw) = va0; *(u32x4*)(sA + sn + (lr + 32) * 64 + lsw) = va1;
      *(u32x4*)(sA + sn + (lr + 64) * 64 + lsw) = va2; *(u32x4*)(sA + sn + (lr + 96) * 64 + lsw) = va3;
      *(u32x4*)(sB + sn + (lr + 0) * 64 + lsw) = vb0; *(u32x4*)(sB + sn + (lr + 32) * 64 + lsw) = vb1;
      *(u32x4*)(sB + sn + (lr + 64) * 64 + lsw) = vb2; *(u32x4*)(sB + sn + (lr + 96) * 64 + lsw) = vb3;
    }
    if (kt + 2 < KT) {
      const int ko = (kt + 2) * 64;
      va0 = *(const u32x4*)(ap[0] + ko); va1 = *(const u32x4*)(ap[1] + ko); va2 = *(const u32x4*)(ap[2] + ko); va3 = *(const u32x4*)(ap[3] + ko);
      vb0 = *(const u32x4*)(bp[0] + ko); vb1 = *(const u32x4*)(bp[1] + ko); vb2 = *(const u32x4*)(bp[2] + ko); vb3 = *(const u32x4*)(bp[3] + ko);
    }
    __builtin_amdgcn_sched_barrier(0);
    __builtin_amdgcn_s_setprio(2);
    mma_swz<4, 4, SWAP>(sA + st + wr * 64 * 64, sB + st + wc * 64 * 64, acc, lane, (pass_ & 1) != 0);
    __builtin_amdgcn_s_setprio(0);
    __syncthreads();
  }
  }
  epi(acc, m0 + wr * 64, n0 + wc * 64, lane);
}


DEVI bool gemm_tile_xcd(int bid, int G, int k, int NTN, int& tm, int& tn) {
  const int x = bid & 7, per = G >> 3;
  const int u = (bid >> 3) + per * k;
  const int full_groups = NTN >> 3, rem = NTN & 7;
  const int n_full = full_groups * 2 * 64;
  if (u < n_full) {
    const int sb = u >> 6, wi = u & 63;
    const int tg = sb >> 1, th = sb & 1;
    tm = x * 16 + th * 8 + (wi >> 3);
    tn = tg * 8 + (wi & 7);
    return true;
  }
  const int v = u - n_full;
  if (v >= 16 * rem) return false;
  tm = x * 16 + v / rem;
  tn = full_groups * 8 + v % rem;
  return true;
}


template <class Epi>
DEVI void gemm256(const bf16_t* A, long lda, const bf16_t* B, long ldb, int K, int m0, int n0, bf16_t* sA, bf16_t* sB, Epi&& epi) {
  const int tid = opaque_tid(), lane = tid & 63, w = tid >> 6, wr = w >> 1, wc = w & 1;
  const int lr = tid >> 3, lk = (tid & 7) * 8;
  const int lsw = (((tid & 7) ^ (lr & 7)) * 8);
  const int r = lane & 15, q = lane >> 4, r7 = r & 7;
  f32x4 acc[2][4][4];
#pragma unroll
  for (int hh = 0; hh < 2; ++hh)
#pragma unroll
    for (int mt = 0; mt < 4; ++mt)
#pragma unroll
      for (int nt = 0; nt < 4; ++nt) acc[hh][mt][nt] = f32x4{0.f, 0.f, 0.f, 0.f};
  const bf16_t* abase = A + (long)(m0 + lr) * lda + lk;
  const bf16_t* bbase = B + (long)(n0 + lr) * ldb + lk;
  u32x4 va[8], vb[4];
#pragma unroll
  for (int j = 0; j < 8; ++j) va[j] = *(const u32x4*)(abase + (long)(32 * j) * lda);
#pragma unroll
  for (int j = 0; j < 4; ++j) vb[j] = *(const u32x4*)(bbase + (long)(32 * j) * ldb);
  const int KT = K >> 6;
  for (int kt = 0; kt < KT; ++kt) {
#pragma unroll
    for (int j = 0; j < 8; ++j) *(u32x4*)(sA + (lr + 32 * j) * 64 + lsw) = va[j];
#pragma unroll
    for (int j = 0; j < 4; ++j) *(u32x4*)(sB + (lr + 32 * j) * 64 + lsw) = vb[j];
    __syncthreads();
    if (kt + 1 < KT) {
      const int ko = (kt + 1) * 64;
#pragma unroll
      for (int j = 0; j < 8; ++j) va[j] = *(const u32x4*)(abase + (long)(32 * j) * lda + ko);
#pragma unroll
      for (int j = 0; j < 4; ++j) vb[j] = *(const u32x4*)(bbase + (long)(32 * j) * ldb + ko);
    }
    __builtin_amdgcn_sched_barrier(0);
    __builtin_amdgcn_s_setprio(2);
#pragma unroll
    for (int ks = 0; ks < 2; ++ks) {
      const int co = ((ks * 4 + q) ^ r7) * 8;
      bf16x8 b[4];
#pragma unroll
      for (int nt = 0; nt < 4; ++nt) b[nt] = *(const bf16x8*)(sB + (wc * 64 + nt * 16 + r) * 64 + co);
#pragma unroll
      for (int hh = 0; hh < 2; ++hh) {
        bf16x8 a[4];
#pragma unroll
        for (int mt = 0; mt < 4; ++mt) a[mt] = *(const bf16x8*)(sA + (wr * 128 + hh * 64 + mt * 16 + r) * 64 + co);
#pragma unroll
        for (int mt = 0; mt < 4; ++mt)
#pragma unroll
          for (int nt = 0; nt < 4; ++nt) acc[hh][mt][nt] = __builtin_amdgcn_mfma_f32_16x16x32_bf16(a[mt], b[nt], acc[hh][mt][nt], 0, 0, 0);
      }
    }
    __builtin_amdgcn_s_setprio(0);
    __syncthreads();
  }
  epi(acc[0], m0 + wr * 128, n0 + wc * 64, lane);
  epi(acc[1], m0 + wr * 128 + 64, n0 + wc * 64, lane);
}

DEVI bool gemm_tile_xcd256(int bid, int G, int k, int NTN, int& tm, int& tn) {
  const int x = bid & 7, per = G >> 3;
  const int u = (bid >> 3) + per * k;
  if (u >= 8 * NTN) return false;
  const int tg = u >> 6, wi = u & 63;
  tm = x * 8 + (wi >> 3);
  tn = tg * 8 + (wi & 7);
  return true;
}

DEVI void transpose_tile(const float* src, int N, int ldsrc, bf16_t* dst, int K, int ktile, int ntile, bool perm, float* sT) {
  const int tid = opaque_tid();
  const int k0 = ktile * 64, n0 = ntile * 64;
#pragma unroll
  for (int j = 0; j < 4; ++j) {
    int idx = tid + 256 * j;
    int kk = idx >> 4, n4 = (idx & 15) * 4;
    int n = n0 + n4;
    float4 v = make_float4(0.f, 0.f, 0.f, 0.f);
    if (n < N) { int oc = perm ? oldcol(n) : n; v = *(const float4*)(src + (long)(k0 + kk) * ldsrc + oc); }
    sT[kk * 65 + n4 + 0] = v.x; sT[kk * 65 + n4 + 1] = v.y; sT[kk * 65 + n4 + 2] = v.z; sT[kk * 65 + n4 + 3] = v.w;
  }
  __syncthreads();
#pragma unroll
  for (int j = 0; j < 2; ++j) {
    int idx = tid + 256 * j;
    int nn = idx >> 3, kc = (idx & 7) * 8;
    if (n0 + nn < N) {
      uint4 o;
      o.x = pack2(sT[(kc + 0) * 65 + nn], sT[(kc + 1) * 65 + nn]);
      o.y = pack2(sT[(kc + 2) * 65 + nn], sT[(kc + 3) * 65 + nn]);
      o.z = pack2(sT[(kc + 4) * 65 + nn], sT[(kc + 5) * 65 + nn]);
      o.w = pack2(sT[(kc + 6) * 65 + nn], sT[(kc + 7) * 65 + nn]);
      *(uint4*)(dst + (long)(n0 + nn) * K + k0 + kc) = o;
    }
  }
  __syncthreads();
}

DEVI void rmsnorm_row2(const float* X, const float* w, bf16_t* H, int row0, int row1, int lane) {
  const float4* xa = (const float4*)(X + (long)row0 * 1024);
  const float4* xb = (const float4*)(X + (long)row1 * 1024);
  float4 va[4], vb[4], ww[4];
#pragma unroll
  for (int j = 0; j < 4; ++j) { va[j] = xa[lane + 64 * j]; vb[j] = xb[lane + 64 * j]; ww[j] = ((const float4*)w)[lane + 64 * j]; }
  float sa = 0.f, sb = 0.f;
#pragma unroll
  for (int j = 0; j < 4; ++j) {
    sa += va[j].x * va[j].x + va[j].y * va[j].y + va[j].z * va[j].z + va[j].w * va[j].w;
    sb += vb[j].x * vb[j].x + vb[j].y * vb[j].y + vb[j].z * vb[j].z + vb[j].w * vb[j].w;
  }
  sa = wave_sum(sa); sb = wave_sum(sb);
  const float ra = rsqrtf(sa * (1.f / 1024.f) + EPSF), rb = rsqrtf(sb * (1.f / 1024.f) + EPSF);
#pragma unroll
  for (int j = 0; j < 4; ++j) {
    uint2 o;
    o.x = pack2(va[j].x * ra * ww[j].x, va[j].y * ra * ww[j].y);
    o.y = pack2(va[j].z * ra * ww[j].z, va[j].w * ra * ww[j].w);
    *(uint2*)(H + (long)row0 * 1024 + (lane + 64 * j) * 4) = o;
    o.x = pack2(vb[j].x * rb * ww[j].x, vb[j].y * rb * ww[j].y);
    o.y = pack2(vb[j].z * rb * ww[j].z, vb[j].w * rb * ww[j].w);
    *(uint2*)(H + (long)row1 * 1024 + (lane + 64 * j) * 4) = o;
  }
}

DEVI void phase0(const Params& p, unsigned char* smem) {
  const int G = gridDim.x, bid = blockIdx.x, tid = threadIdx.x, lane = tid & 63, w = tid >> 6;
  unsigned char* ws = p.ws;
  float* sT = (float*)smem;
  for (int it = bid; it < 69 * 16; it += G) transpose_tile(p.ev_w_in, 4384, 4384, (bf16_t*)(ws + OFF_WIN0), 1024, it / 69, it % 69, true, sT);
  for (int it = bid; it < 16 * 16; it += G) transpose_tile(p.ev_w_out, 1024, 1024, (bf16_t*)(ws + OFF_WOUT0), 1024, it / 16, it % 16, false, sT);
  for (int it = bid; it < 64 * 16; it += G) transpose_tile(p.od_w_in, 4096, 4096, (bf16_t*)(ws + OFF_WIN1), 1024, it / 64, it % 64, false, sT);
  for (int it = bid; it < 16 * 16; it += G) transpose_tile(p.od_w_out, 1024, 1024, (bf16_t*)(ws + OFF_WOUT1), 1024, it / 16, it % 16, false, sT);
  for (int it = bid; it < 2 * 32; it += G) transpose_tile(p.ck_w1, 128, 128, (bf16_t*)(ws + OFF_WCK), 2048, it / 2, it % 2, false, sT);
  for (int it = bid; it < 2 * 32; it += G) transpose_tile(p.cv_w1, 128, 128, (bf16_t*)(ws + OFF_WCV), 2048, it / 2, it % 2, false, sT);
  for (int row = (bid * 4 + w) * 2; row < 16384; row += G * 8) rmsnorm_row2(p.x, p.norm_w, (bf16_t*)(ws + L0_H), row, row + 1, lane);
  for (int idx = bid * 256 + tid; idx < 8192 * 8; idx += G * 256) {
    int t = idx >> 3, i = idx & 7;
    float invf = powf(500000.0f, -(float)i / 8.0f);
    float ang = (float)t * invf;
    double a = (double)ang;
    float2 cs;
    cs.x = (float)cos(a);
    cs.y = (float)sin(a);
    ((float2*)(ws + OFF_ROPE))[idx] = cs;
  }
  for (int o = bid * 4 + w; o < 256; o += G * 4) {
    int kv = o >> 7, j = o & 127;
    const float* pos = kv ? p.cv_pos : p.ck_pos;
    const float* w1 = kv ? p.cv_w1 : p.ck_w1;
    float sacc_ = 0.f;
#pragma unroll 8
    for (int i = lane; i < 2048; i += 64) sacc_ += pos[i] * w1[i * 128 + j];
    sacc_ = wave_sum(sacc_);
    if (lane == 0) ((float*)(ws + OFF_PB))[o] = sacc_;
  }
  if (bid == G - 2 || G < 2) {
    for (int c = tid; c < 1024; c += 256) {
      float l0 = p.lb_logits[c], l1 = p.lb_logits[1024 + c];
      ((float*)(ws + OFF_LB))[c] = 1.f / (1.f + expf(l1 - l0));
    }
  }
}

template <int MODE>
DEVI void store_rm(bf16_t* dst, int ld, int colbase, f32x4 (&acc)[4][4], const float* bias, int mb, int lane) {
  const int r = lane & 15, q = lane >> 4;
#pragma unroll
  for (int mt = 0; mt < 4; ++mt)
#pragma unroll
    for (int i = 0; i < 4; ++i) {
      long row = mb + mt * 16 + q * 4 + i;
#pragma unroll
      for (int nt = 0; nt < 4; ++nt) {
        float v = acc[mt][nt][i] + bias[nt];
        if (MODE == 1) v = sigm(v);
        if (MODE == 2) v = siluf(v);
        dst[row * ld + colbase + nt * 16 + r] = f2bf(v);
      }
    }
}
template <int MODE>
DEVI void store_T(bf16_t* dst, int bgrp, int F, int featoff, f32x4 (&acc)[4][4], const float* bias, int tl0, int lane) {
  const int r = lane & 15, q = lane >> 4;
#pragma unroll
  for (int mt = 0; mt < 4; ++mt)
#pragma unroll
    for (int nt = 0; nt < 4; ++nt) {
      int t = tl0 + mt * 16 + q * 4;
      float b = bias[nt];
      uint2 o;
      o.x = pack2(acc[mt][nt][0] + b, acc[mt][nt][1] + b);
      o.y = pack2(acc[mt][nt][2] + b, acc[mt][nt][3] + b);
      *(uint2*)(dst + (((long)bgrp * 128 + (t >> 6)) * F + featoff + nt * 16 + r) * 64 + (t & 63)) = o;
    }
}
DEVI void norm_rope_store(bf16_t* dst, long rowbase, int ld, int colbase, f32x4 (&acc)[4][4], const float* bias, const float* nw,
                          float scale, const float2* rope, int mb, int lane) {
  const int r = lane & 15, q = lane >> 4;
  float wv[4];
#pragma unroll
  for (int nt = 0; nt < 4; ++nt) wv[nt] = nw[nt * 16 + r];
  float2 csv[4][4];
#pragma unroll
  for (int mt = 0; mt < 4; ++mt)
#pragma unroll
    for (int i = 0; i < 4; ++i) csv[mt][i] = rope[((mb + mt * 16 + q * 4 + i) & 8191) * 8 + (r & 7)];
#pragma unroll
  for (int mt = 0; mt < 4; ++mt)
#pragma unroll
    for (int i = 0; i < 4; ++i) {
      int row = mb + mt * 16 + q * 4 + i;
      int t = row & 8191;
      float v[4];
      float ss = 0.f;
#pragma unroll
      for (int nt = 0; nt < 4; ++nt) { v[nt] = acc[mt][nt][i] + bias[nt]; ss += v[nt] * v[nt]; }
      ss = grp16_sum(ss);
      float rinv = rsqrtf(ss * (1.f / 64.f) + EPSF);
#pragma unroll
      for (int nt = 0; nt < 4; ++nt) v[nt] = v[nt] * rinv * wv[nt];
      float partner = __shfl_xor(v[0], 8);
      float2 cs = csv[mt][i];
      float x1 = (r < 8) ? v[0] : partner, x2 = (r < 8) ? partner : v[0];
      v[0] = (r < 8) ? (x1 * cs.x - x2 * cs.y) : (x1 * cs.y + x2 * cs.x);
#pragma unroll
      for (int nt = 0; nt < 4; ++nt) dst[(rowbase + t) * ld + colbase + nt * 16 + r] = f2bf(v[nt] * scale);
    }
}

DEVI void epi_proj0(const Params& p, f32x4 (&acc)[4][4], int mb, int nb, int lane) {
  if (nb >= 4384) return;
  unsigned char* ws = p.ws;
  const int r = lane & 15, q = lane >> 4;
  float bias[4];
#pragma unroll
  for (int nt = 0; nt < 4; ++nt) { int n = nb + nt * 16 + r; bias[nt] = (n < 4384) ? p.ev_b_in[oldcol(n)] : 0.f; }
  const int b = mb >> 13;
  const int tl0 = mb & 8191;
  const float2* rope = (const float2*)(ws + OFF_ROPE);
  if (nb < 1024) {
    store_rm<0>((bf16_t*)(ws + L0_QKRAW), 1024, nb, acc, bias, mb, lane);
  } else if (nb < 1536) {
    store_T<0>((bf16_t*)(ws + L0_MVT), b * 4 + ((nb - 1024) >> 7), 128, (nb - 1024) & 127, acc, bias, tl0, lane);
  } else if (nb < 2048) {
    store_rm<1>((bf16_t*)(ws + L0_MO), 512, nb - 1536, acc, bias, mb, lane);
  } else if (nb < 2560) {
    store_rm<2>((bf16_t*)(ws + L0_MZ), 512, nb - 2048, acc, bias, mb, lane);
  } else if (nb < 3072) {
    int head = (nb - 2560) >> 6, g = head >> 2, rr = head & 3;
    norm_rope_store((bf16_t*)(ws + L0_QN), (long)(b * 2 + g) * 8192, 256, rr * 64, acc, bias, p.q_norm, 0.125f * 1.4426950408889634f, rope, mb, lane);
  } else if (nb < 3328) {
    int g = ((nb - 3072) >> 6) & 1;
    bf16_t* dst = (bf16_t*)(ws + (nb < 3200 ? L0_KCRAW : L0_VCRAW));
    const long rowbase = (long)(b * 2 + g) * 8192;
#pragma unroll
    for (int mt = 0; mt < 4; ++mt)
#pragma unroll
      for (int i = 0; i < 4; ++i) {
        int t = (mb + mt * 16 + q * 4 + i) & 8191;
#pragma unroll
        for (int nt = 0; nt < 4; ++nt) dst[(rowbase + t) * 64 + nt * 16 + r] = f2bf(acc[mt][nt][i] + bias[nt]);
      }
  } else if (nb < 3456) {
    int g = (nb - 3328) >> 6;
    norm_rope_store((bf16_t*)(ws + L0_KS), (long)(b * 2 + g) * 8192, 64, 0, acc, bias, p.k_norm + 64, 1.f, rope, mb, lane);
  } else if (nb < 3584) {
    store_T<0>((bf16_t*)(ws + L0_VST), b * 2 + ((nb - 3456) >> 6), 64, 0, acc, bias, tl0, lane);
  } else if (nb < 3712) {
    int g = (nb - 3584) >> 6;
    norm_rope_store((bf16_t*)(ws + L0_KW), (long)(b * 2 + g) * 8192, 64, 0, acc, bias, p.k_norm + 128, 1.f, rope, mb, lane);
  } else if (nb < 3840) {
    store_T<0>((bf16_t*)(ws + L0_VWT), b * 2 + ((nb - 3712) >> 6), 64, 0, acc, bias, tl0, lane);
  } else if (nb < 4352) {
    store_rm<2>((bf16_t*)(ws + L0_NZ), 512, nb - 3840, acc, bias, mb, lane);
  } else {
    float* IG = (float*)(ws + L0_IG);
    float* LF = (float*)(ws + L0_LOGF);
    float* GT = (float*)(ws + L0_GATES);
#pragma unroll
    for (int mt = 0; mt < 4; ++mt)
#pragma unroll
      for (int i = 0; i < 4; ++i) {
        long row = mb + mt * 16 + q * 4 + i;
#pragma unroll
        for (int nt = 0; nt < 2; ++nt) {
          int c = nt * 16 + r;
          float v = acc[mt][nt][i] + bias[nt];
          if (c < 4) IG[row * 4 + c] = v;
          else if (c < 8) { float xx = v + p.f_bias[c - 4]; LF[row * 4 + c - 4] = fminf(xx, 0.f) - log1pf(__expf(-fabsf(xx))); }
          else GT[row * 24 + c - 8] = sigm(v);
        }
      }
  }
}

DEVI void epi_cmp_hidden(const Params& p, f32x4 (&acc)[4][4], int mb, int nb, int lane, int kv, int bg, int ksp) {
  const int r = lane & 15, q = lane >> 4;
  float* hid = (float*)(p.ws + L0_HIDP) + ((long)((ksp * 2 + kv) * 4 + bg) * 512) * 128;
#pragma unroll
  for (int mt = 0; mt < 4; ++mt)
#pragma unroll
    for (int i = 0; i < 4; ++i) {
      int row = mb + mt * 16 + q * 4 + i;
#pragma unroll
      for (int nt = 0; nt < 4; ++nt) hid[(long)row * 128 + nb + nt * 16 + r] = acc[mt][nt][i];
    }
}

DEVI void epi_out_resid(const float* resid, float* out, f32x4 (&acc)[4][4], int mb, int nb, int lane) {
  const int r = lane & 15, q = lane >> 4;
#pragma unroll
  for (int mt = 0; mt < 4; ++mt) {
    float rv[4][4];
#pragma unroll
    for (int i = 0; i < 4; ++i)
#pragma unroll
      for (int nt = 0; nt < 4; ++nt) rv[i][nt] = resid[(long)(mb + mt * 16 + q * 4 + i) * 1024 + nb + nt * 16 + r];
#pragma unroll
    for (int i = 0; i < 4; ++i)
#pragma unroll
      for (int nt = 0; nt < 4; ++nt) out[(long)(mb + mt * 16 + q * 4 + i) * 1024 + nb + nt * 16 + r] = rv[i][nt] + acc[mt][nt][i];
  }
}

DEVI void epi_proj1(const Params& p, f32x4 (&acc)[4][4], int mb, int nb, int lane) {
  unsigned char* ws = p.ws;
  const int r = lane & 15;
  float bias[4];
#pragma unroll
  for (int nt = 0; nt < 4; ++nt) bias[nt] = p.od_b_in[nb + nt * 16 + r];
  const int b = mb >> 13, tl0 = mb & 8191;
  if (nb < 1024) store_rm<0>((bf16_t*)(ws + L1_FP), 1024, nb, acc, bias, mb, lane);
  else if (nb < 2048) store_T<0>((bf16_t*)(ws + L1_VT), b * 8 + ((nb - 1024) >> 7), 128, (nb - 1024) & 127, acc, bias, tl0, lane);
  else if (nb < 3072) store_rm<2>((bf16_t*)(ws + L1_Q), 1024, nb - 2048, acc, bias, mb, lane);
  else store_rm<2>((bf16_t*)(ws + L1_Z), 1024, nb - 3072, acc, bias, mb, lane);
}

DEVI void conv_tile(const Params& p, int item, unsigned char* smem) {
  const int tid = opaque_tid();
  const int ctile = item & 7, ttile = item >> 3;
  const int t0g = ttile * 64;
  const int b = t0g >> 13, tl0 = t0g & 8191;
  unsigned char* ws = p.ws;
  float* sRaw = (float*)smem;
  bf16_t* sOutT = (bf16_t*)(smem + 67 * 128 * 4);
  const bf16_t* raw = (const bf16_t*)(ws + L0_QKRAW);
  for (int idx = tid; idx < 67 * 16; idx += 256) {
    int rr = idx >> 4, ch = (idx & 15) * 8;
    int tl = tl0 + rr - 3;
    uint4 v = make_uint4(0, 0, 0, 0);
    if (tl >= 0) v = *(const uint4*)(raw + (long)(b * 8192 + tl) * 1024 + ctile * 128 + ch);
    float* d = sRaw + rr * 128 + ch;
    d[0] = lo2f(v.x); d[1] = hi2f(v.x); d[2] = lo2f(v.y); d[3] = hi2f(v.y);
    d[4] = lo2f(v.z); d[5] = hi2f(v.z); d[6] = lo2f(v.w); d[7] = hi2f(v.w);
  }
  __syncthreads();
  const int c = tid & 127, th = tid >> 7;
  const int cg_ = ctile * 128 + c;
  const float w0 = p.conv_w[cg_], w1 = p.conv_w[1024 + cg_], w2 = p.conv_w[2048 + cg_], w3 = p.conv_w[3072 + cg_];
  const float cb = p.conv_b[cg_];
  const bool isk = ctile >= 4;
  bf16_t* dst = (bf16_t*)(ws + (isk ? L0_KC : L0_QC));
  const int cc = isk ? cg_ - 512 : cg_;
  const float sc = isk ? 0.08838834764831845f : 1.f;
  for (int t = th * 32; t < th * 32 + 32; ++t) {
    float a = cb + w0 * sRaw[t * 128 + c] + w1 * sRaw[(t + 1) * 128 + c] + w2 * sRaw[(t + 2) * 128 + c] + w3 * sRaw[(t + 3) * 128 + c];
    bf16_t o = f2bf(siluf(a) * sc);
    dst[(long)(t0g + t) * 512 + cc] = o;
    sOutT[c * LDT + t] = o;
  }
  __syncthreads();
  if (isk) {
    bf16_t* kct = (bf16_t*)(ws + L0_KCT);
#pragma unroll
    for (int j = 0; j < 4; ++j) {
      int idx = tid + 256 * j;
      int cr = idx >> 3, tc = (idx & 7) * 8;
      *(uint4*)(kct + ((((long)(b * 4 + (ctile - 4)) * 128 + (tl0 >> 6)) * 128 + cr) * 64) + tc) = *(const uint4*)(sOutT + cr * LDT + tc);
    }
  }
  __syncthreads();
}

DEVI void cmp_finalize(const Params& p, int task, int lane) {
  const int n = task & 511, bg = (task >> 9) & 3, kv = task >> 11;
  unsigned char* ws = p.ws;
  bf16_t* KCMP = (bf16_t*)(ws + L0_KCMP);
  bf16_t* VCMPT = (bf16_t*)(ws + L0_VCMPT);
  if (n == 511) {
    if (kv == 0) KCMP[((long)bg * 512 + 511) * 64 + lane] = 0;
    else VCMPT[((long)bg * 64 + lane) * 512 + 511] = 0;
    return;
  }
  const float* hid = (const float*)(ws + L0_HIDP) + ((long)(kv * 4 + bg) * 512 + n) * 128;
  const float* pbv = (const float*)(ws + OFF_PB) + kv * 128;
  const float* w2 = kv ? p.cv_w2 : p.ck_w2;
  float g0, g1;
  {
    float x0 = ((hid[lane] + hid[lane + 524288]) + (hid[lane + 2 * 524288] + hid[lane + 3 * 524288])) + pbv[lane];
    float x1 = ((hid[lane + 64] + hid[lane + 64 + 524288]) + (hid[lane + 64 + 2 * 524288] + hid[lane + 64 + 3 * 524288])) + pbv[lane + 64];
    g0 = 0.5f * x0 * (1.f + tanhf(0.7978845608028654f * (x0 + 0.044715f * x0 * x0 * x0)));
    g1 = 0.5f * x1 * (1.f + tanhf(0.7978845608028654f * (x1 + 0.044715f * x1 * x1 * x1)));
  }
  float a = 0.f;
  for (int j0 = 0; j0 < 64; j0 += 16) {
    float wv[16], wu[16];
#pragma unroll
    for (int k = 0; k < 16; ++k) { wv[k] = w2[(j0 + k) * 64 + lane]; wu[k] = w2[(64 + j0 + k) * 64 + lane]; }
#pragma unroll
    for (int k = 0; k < 16; ++k) a += __shfl(g0, j0 + k) * wv[k] + __shfl(g1, j0 + k) * wu[k];
  }
  if (kv == 0) {
    float ss = wave_sum(a * a);
    float rinv = rsqrtf(ss * (1.f / 64.f) + EPSF);
    float v = a * rinv * p.k_norm[lane];
    float partner = __shfl_xor(v, 8);
    int pos = 16 * n + 31;
    float2 cs = ((const float2*)(ws + OFF_ROPE))[pos * 8 + (lane & 7)];
    float o = v;
    if (lane < 8) o = v * cs.x - partner * cs.y;
    else if (lane < 16) o = partner * cs.y + v * cs.x;
    KCMP[((long)bg * 512 + n) * 64 + lane] = f2bf(o);
  } else {
    VCMPT[((long)bg * 64 + lane) * 512 + n] = f2bf(a);
  }
}

DEVI void mlstm_local(const Params& p, int unit, unsigned char* smem) {
  const int tid = opaque_tid(), lane = tid & 63, w = tid >> 6, wr = w >> 1, wc = w & 1;
  const int bh = unit >> 6, c = unit & 63, b = bh >> 2, h = bh & 3, t0 = c * 128;
  const long R0 = (long)b * 8192 + t0;
  unsigned char* ws = p.ws;
  bf16_t* sA = (bf16_t*)smem;
  bf16_t* sB = (bf16_t*)(smem + 18432);
  float* sIg = (float*)(smem + 36864);
  float* sLf = sIg + 128;
  float* sW = sLf + 128;
  const float* IG = (const float*)(ws + L0_IG);
  const float* LF = (const float*)(ws + L0_LOGF);
  if (tid < 128) { sIg[tid] = IG[(R0 + tid) * 4 + h]; sLf[tid] = LF[(R0 + tid) * 4 + h]; }
  __syncthreads();
  if (tid < 64) {
    float c0 = sLf[2 * tid], c1 = sLf[2 * tid + 1];
    wave_scan_sum128(c0, c1, tid);
    const float bL = __shfl(c1, 63);
    float d0 = bL - c0 + sIg[2 * tid], d1 = bL - c1 + sIg[2 * tid + 1];
    const float ml = wave_max(fmaxf(d0, d1));
    sW[2 * tid] = __expf(d0 - ml); sW[2 * tid + 1] = __expf(d1 - ml);
    if (tid == 0) { ((float*)(ws + L0_BL))[unit] = bL; ((float*)(ws + L0_MLOC))[unit] = ml; }
  }
  __syncthreads();
  f32x4 acc[4][4];
#pragma unroll
  for (int mt = 0; mt < 4; ++mt)
#pragma unroll
    for (int nt = 0; nt < 4; ++nt) acc[mt][nt] = f32x4{0.f, 0.f, 0.f, 0.f};
  float dn = 0.f;
  const bf16_t* vt = (const bf16_t*)(ws + L0_MVT) + (((long)(b * 4 + h) * 128 + (t0 >> 6)) * 128) * 64;
  const bf16_t* kt_ = (const bf16_t*)(ws + L0_KCT) + (((long)(b * 4 + h) * 128 + (t0 >> 6)) * 128) * 64;
  const int lr = tid >> 3, lk = (tid & 7) * 8;
  for (int kt = 0; kt < 2; ++kt) {
    load_tile128(sA, vt + kt * 8192, 64);
#pragma unroll
    for (int j = 0; j < 4; ++j) {
      uint4 v = *(const uint4*)(kt_ + (long)kt * 8192 + (lr + 32 * j) * 64 + lk);
      const float* ww = sW + kt * 64 + lk;
      uint4 o;
      o.x = pack2(lo2f(v.x) * ww[0], hi2f(v.x) * ww[1]);
      o.y = pack2(lo2f(v.y) * ww[2], hi2f(v.y) * ww[3]);
      o.z = pack2(lo2f(v.z) * ww[4], hi2f(v.z) * ww[5]);
      o.w = pack2(lo2f(v.w) * ww[6], hi2f(v.w) * ww[7]);
      *(uint4*)(sB + (lr + 32 * j) * LDT + lk) = o;
    }
    __syncthreads();
    if (tid < 128) {
#pragma unroll 8
      for (int s = 0; s < 64; ++s) dn += bf2f(sB[tid * LDT + s]);
    }
    mma_lds<4, 4, 2>(sA + wr * 64 * LDT, sB + wc * 64 * LDT, acc, lane);
    __syncthreads();
  }
  float* dct = (float*)(ws + L0_H) + (long)unit * 16384;
  const int r = lane & 15, q = lane >> 4;
#pragma unroll
  for (int mt = 0; mt < 4; ++mt)
#pragma unroll
    for (int i = 0; i < 4; ++i) {
      int e = wr * 64 + mt * 16 + q * 4 + i;
#pragma unroll
      for (int nt = 0; nt < 4; ++nt) dct[e * 128 + wc * 64 + nt * 16 + r] = acc[mt][nt][i];
    }
  if (tid < 128) ((float*)(ws + L0_DN))[unit * 128 + tid] = dn;
}

template <bool DUMMY>
DEVI void mlstm_scan(const Params& p, unsigned char* smem) {
  unsigned char* ws = p.ws;
  const float* BL = (const float*)(ws + L0_BL);
  const float* ML = (const float*)(ws + L0_MLOC);
  float* MIN_ = (float*)(ws + L0_MIN);
  float* sDec = (float*)smem;
  float* sWn = sDec + 128;
  const int tid = opaque_tid();
  const int total = 8 * 16384 + 8 * 128;
  for (int base = blockIdx.x * 256; base < total; base += gridDim.x * 256) {
    const int bh0 = (base < 131072) ? (base >> 14) : ((base - 131072) >> 7);
    __syncthreads();
    if (tid < 2) {
      const int bh = bh0 + tid;
      if (bh < 8) {
        float m = 0.f;
        for (int c = 0; c < 64; ++c) {
          const int unit = bh * 64 + c;
          const float bL = BL[unit], ml = ML[unit];
          if (!DUMMY && base < 131072 && (base & 16383) == 0 && tid == 0) MIN_[unit] = m;
          const float mn = fmaxf(bL + m, ml);
          sDec[tid * 64 + c] = __expf(bL + m - mn);
          sWn[tid * 64 + c] = __expf(ml - mn);
          m = mn;
        }
      }
    }
    __syncthreads();
    const int idx = base + tid;
    if (idx < total) {
      float* ptr; long stride; int sel;
      if (idx < 131072) { const int bh = idx >> 14; ptr = (float*)(ws + L0_H) + (long)bh * 64 * 16384 + (idx & 16383); stride = 16384; sel = bh - bh0; }
      else { const int j = idx - 131072; const int bh = j >> 7; ptr = (float*)(ws + L0_DN) + (long)bh * 64 * 128 + (j & 127); stride = 128; sel = bh - bh0; }
      const float* dec = sDec + sel * 64;
      const float* wn = sWn + sel * 64;
      float C = 0.f;
      for (int c0 = 0; c0 < 64; c0 += 8) {
        float dv[8];
#pragma unroll
        for (int k = 0; k < 8; ++k) dv[k] = ptr[(long)(c0 + k) * stride];
#pragma unroll
        for (int k = 0; k < 8; ++k) {
          if (!DUMMY) ptr[(long)(c0 + k) * stride] = C;
          C = dec[c0 + k] * C + wn[c0 + k] * dv[k];
        }
      }
      if (DUMMY && C == 123.456f) MIN_[0] = C;
    }
  }
}

DEVI void mlstm_out(const Params& p, int item, unsigned char* smem) {
  const int tid = opaque_tid(), lane = tid & 63, w = tid >> 6, wr = w >> 1, wc = w & 1;
  const int r = lane & 15, q = lane >> 4;
  const int unit = item >> 1, u = item & 1;
  const int bh = unit >> 6, c = unit & 63, b = bh >> 2, h = bh & 3, t0 = c * 128;
  const long R0 = (long)b * 8192 + t0;
  const int J0 = u * 64;
  unsigned char* ws = p.ws;
  bf16_t* sA = (bf16_t*)smem;
  bf16_t* sB = (bf16_t*)(smem + 9216);
  bf16_t* sS0 = (bf16_t*)(smem + 27648);
  bf16_t* sS1 = (bf16_t*)(smem + 36864);
  float* fl = (float*)(smem + 46080);
  float* sIg = fl; float* sLf = fl + 128; float* sRj = fl + 256; float* sCs = fl + 384; float* sWi = fl + 512;
  float* sEm = fl + 640; float* sQn = fl + 768; float* sNin = fl + 896; float* sDen = fl + 1024; float* sSs = fl + 1280;
  const float* IG = (const float*)(ws + L0_IG);
  const float* LF = (const float*)(ws + L0_LOGF);
  const bf16_t* QC = (const bf16_t*)(ws + L0_QC) + (R0 + J0) * 512 + h * 128;
  const bf16_t* KC = (const bf16_t*)(ws + L0_KC) + R0 * 512 + h * 128;
  if (tid < 128) { sIg[tid] = IG[(R0 + tid) * 4 + h]; sLf[tid] = LF[(R0 + tid) * 4 + h]; sNin[tid] = ((const float*)(ws + L0_DN))[unit * 128 + tid]; }
  const float m_in = ((const float*)(ws + L0_MIN))[unit];
  __syncthreads();
  if (tid < 64) {
    float c0 = sLf[2 * tid], c1 = sLf[2 * tid + 1];
    wave_scan_sum128(c0, c1, tid);
    const float a0 = sIg[2 * tid] - c0, a1 = sIg[2 * tid + 1] - c1;
    float x0 = a0, x1 = a1;
    wave_scan_max128(x0, x1, tid);
    const float mx0 = fmaxf(x0, m_in), mx1 = fmaxf(x1, m_in);
    sCs[2 * tid] = a0; sCs[2 * tid + 1] = a1;
    sRj[2 * tid] = -mx0; sRj[2 * tid + 1] = -mx1;
    sWi[2 * tid] = __expf(m_in - mx0); sWi[2 * tid + 1] = __expf(m_in - mx1);
    sEm[2 * tid] = __expf(-(c0 + mx0)); sEm[2 * tid + 1] = __expf(-(c1 + mx1));
  }
  if (tid >= 128 && tid < 192) {
    int jl = tid - 128;
    const bf16_t* qr = QC + (long)jl * 512;
    float s = 0.f;
#pragma unroll 2
    for (int ch = 0; ch < 16; ++ch) {
      uint4 v = *(const uint4*)(qr + ch * 8);
      const float* nn = sNin + ch * 8;
      s += lo2f(v.x) * nn[0] + hi2f(v.x) * nn[1] + lo2f(v.y) * nn[2] + hi2f(v.y) * nn[3] + lo2f(v.z) * nn[4] + hi2f(v.z) * nn[5] + lo2f(v.w) * nn[6] + hi2f(v.w) * nn[7];
    }
    sQn[jl] = s;
  }
  __syncthreads();
  f32x4 acc[2][4];
#pragma unroll
  for (int mt = 0; mt < 2; ++mt)
#pragma unroll
    for (int nt = 0; nt < 4; ++nt) acc[mt][nt] = f32x4{0.f, 0.f, 0.f, 0.f};
  const bool skipS = (wc > u);
  const int lr = tid >> 3, lk = (tid & 7) * 8;
  {
    u32x4 qa0, qa1, kb0, kb1, kb2, kb3;
    qa0 = *(const u32x4*)(QC + (long)lr * 512 + lk); qa1 = *(const u32x4*)(QC + (long)(lr + 32) * 512 + lk);
    kb0 = *(const u32x4*)(KC + (long)lr * 512 + lk); kb1 = *(const u32x4*)(KC + (long)(lr + 32) * 512 + lk);
    kb2 = *(const u32x4*)(KC + (long)(lr + 64) * 512 + lk); kb3 = *(const u32x4*)(KC + (long)(lr + 96) * 512 + lk);
#pragma unroll 1
    for (int kt = 0; kt < 2; ++kt) {
      *(u32x4*)(sA + lr * LDT + lk) = qa0; *(u32x4*)(sA + (lr + 32) * LDT + lk) = qa1;
      *(u32x4*)(sB + lr * LDT + lk) = kb0; *(u32x4*)(sB + (lr + 32) * LDT + lk) = kb1;
      *(u32x4*)(sB + (lr + 64) * LDT + lk) = kb2; *(u32x4*)(sB + (lr + 96) * LDT + lk) = kb3;
      __syncthreads();
      if (kt == 0) {
        qa0 = *(const u32x4*)(QC + (long)lr * 512 + 64 + lk); qa1 = *(const u32x4*)(QC + (long)(lr + 32) * 512 + 64 + lk);
        kb0 = *(const u32x4*)(KC + (long)lr * 512 + 64 + lk); kb1 = *(const u32x4*)(KC + (long)(lr + 32) * 512 + 64 + lk);
        kb2 = *(const u32x4*)(KC + (long)(lr + 64) * 512 + 64 + lk); kb3 = *(const u32x4*)(KC + (long)(lr + 96) * 512 + 64 + lk);
      }
      if (!skipS) mma_lds<2, 4, 2>(sA + wr * 32 * LDT, sB + wc * 64 * LDT, acc, lane);
      __syncthreads();
    }
  }
  {
    bf16_t* sS = wc ? sS1 : sS0;
#pragma unroll
    for (int mt = 0; mt < 2; ++mt)
#pragma unroll
      for (int i = 0; i < 4; ++i) {
        int jl = wr * 32 + mt * 16 + q * 4 + i;
        int j = J0 + jl;
        float rj = sRj[j], rs = 0.f;
#pragma unroll
        for (int nt = 0; nt < 4; ++nt) {
          int sl = nt * 16 + r, s = wc * 64 + sl;
          float val = (s <= j) ? acc[mt][nt][i] * __expf(rj + sCs[s]) : 0.f;
          rs += val;
          sS[jl * LDT + sl] = f2bf(val);
        }
        rs = grp16_sum(rs);
        if (r == 0) sDen[wc * 64 + jl] = rs;
      }
  }
#pragma unroll
  for (int mt = 0; mt < 2; ++mt)
#pragma unroll
    for (int nt = 0; nt < 4; ++nt) acc[mt][nt] = f32x4{0.f, 0.f, 0.f, 0.f};
  const bf16_t* vt = (const bf16_t*)(ws + L0_MVT) + (((long)(b * 4 + h) * 128 + (t0 >> 6)) * 128) * 64;
  const float* ct = (const float*)(ws + L0_H) + (long)unit * 16384;
  {
    u32x4 vb0, vb1, vb2, vb3;
    u32x4 qa0, qa1;
    float4 cv[8];
    const int nsteps = u ? 4 : 3;
    auto kind_of = [&](int sidx) { return u ? sidx : (sidx == 0 ? 0 : sidx + 1); };
    auto fetch = [&](int kind) {
      if (kind < 2) {
        const bf16_t* vp = vt + (long)kind * 8192 + lr * 64 + lk;
        vb0 = *(const u32x4*)vp; vb1 = *(const u32x4*)(vp + 32 * 64); vb2 = *(const u32x4*)(vp + 64 * 64); vb3 = *(const u32x4*)(vp + 96 * 64);
      } else {
        const int k2 = kind - 2;
        qa0 = *(const u32x4*)(QC + (long)lr * 512 + k2 * 64 + lk); qa1 = *(const u32x4*)(QC + (long)(lr + 32) * 512 + k2 * 64 + lk);
#pragma unroll
        for (int j = 0; j < 8; ++j) cv[j] = *(const float4*)(ct + (long)((tid >> 4) + 16 * j) * 128 + k2 * 64 + (tid & 15) * 4);
      }
    };
    fetch(0);
#pragma unroll 1
    for (int sidx = 0; sidx < nsteps; ++sidx) {
      const int kind = kind_of(sidx);
      const bf16_t* aS;
      if (kind < 2) {
        *(u32x4*)(sB + lr * LDT + lk) = vb0; *(u32x4*)(sB + (lr + 32) * LDT + lk) = vb1;
        *(u32x4*)(sB + (lr + 64) * LDT + lk) = vb2; *(u32x4*)(sB + (lr + 96) * LDT + lk) = vb3;
        aS = kind ? sS1 : sS0;
      } else {
        const float w0 = sWi[J0 + lr], w1 = sWi[J0 + lr + 32];
        u32x4 o0, o1;
        o0[0] = pack2(lo2f(qa0[0]) * w0, hi2f(qa0[0]) * w0); o0[1] = pack2(lo2f(qa0[1]) * w0, hi2f(qa0[1]) * w0);
        o0[2] = pack2(lo2f(qa0[2]) * w0, hi2f(qa0[2]) * w0); o0[3] = pack2(lo2f(qa0[3]) * w0, hi2f(qa0[3]) * w0);
        o1[0] = pack2(lo2f(qa1[0]) * w1, hi2f(qa1[0]) * w1); o1[1] = pack2(lo2f(qa1[1]) * w1, hi2f(qa1[1]) * w1);
        o1[2] = pack2(lo2f(qa1[2]) * w1, hi2f(qa1[2]) * w1); o1[3] = pack2(lo2f(qa1[3]) * w1, hi2f(qa1[3]) * w1);
        *(u32x4*)(sA + lr * LDT + lk) = o0; *(u32x4*)(sA + (lr + 32) * LDT + lk) = o1;
#pragma unroll
        for (int j = 0; j < 8; ++j) {
          uint2 o;
          o.x = pack2(cv[j].x, cv[j].y);
          o.y = pack2(cv[j].z, cv[j].w);
          *(uint2*)(sB + ((tid >> 4) + 16 * j) * LDT + (tid & 15) * 4) = o;
        }
        aS = sA;
      }
      __syncthreads();
      if (sidx + 1 < nsteps) fetch(kind_of(sidx + 1));
      mma_lds<2, 4, 2>(aS + wr * 32 * LDT, sB + wc * 64 * LDT, acc, lane);
      __syncthreads();
    }
  }
#pragma unroll
  for (int mt = 0; mt < 2; ++mt)
#pragma unroll
    for (int i = 0; i < 4; ++i) {
      int jl = wr * 32 + mt * 16 + q * 4 + i;
      int j = J0 + jl;
      float den = sDen[jl] + sDen[64 + jl] + sWi[j] * sQn[jl];
      float dinv = 1.f / fmaxf(fabsf(den), sEm[j]);
      float ss = 0.f;
#pragma unroll
      for (int nt = 0; nt < 4; ++nt) { float v = acc[mt][nt][i] * dinv; acc[mt][nt][i] = v; ss += v * v; }
      ss = grp16_sum(ss);
      if (r == 0) sSs[wc * 64 + jl] = ss;
    }
  __syncthreads();
  const bf16_t* MO = (const bf16_t*)(ws + L0_MO);
  const bf16_t* MZ = (const bf16_t*)(ws + L0_MZ);
  bf16_t* Y = (bf16_t*)(ws + L0_QKRAW);
  float hn[4];
#pragma unroll
  for (int nt = 0; nt < 4; ++nt) hn[nt] = p.m_hn[h * 128 + wc * 64 + nt * 16 + r];
#pragma unroll
  for (int mt = 0; mt < 2; ++mt) {
    float gv[4][4];
#pragma unroll
    for (int i = 0; i < 4; ++i) {
      long row = R0 + J0 + wr * 32 + mt * 16 + q * 4 + i;
#pragma unroll
      for (int nt = 0; nt < 4; ++nt) {
        int col = h * 128 + wc * 64 + nt * 16 + r;
        gv[i][nt] = bf2f(MO[row * 512 + col]) * bf2f(MZ[row * 512 + col]);
      }
    }
#pragma unroll
    for (int i = 0; i < 4; ++i) {
      int jl = wr * 32 + mt * 16 + q * 4 + i;
      float rinv = rsqrtf((sSs[jl] + sSs[64 + jl]) * (1.f / 128.f) + EPSF);
      long row = R0 + J0 + jl;
#pragma unroll
      for (int nt = 0; nt < 4; ++nt) {
        int col = h * 128 + wc * 64 + nt * 16 + r;
        Y[row * 1024 + col] = f2bf(acc[mt][nt][i] * rinv * hn[nt] * gv[i][nt]);
      }
    }
  }
  __syncthreads();
}

struct NsaSm {
  bf16_t* sK; bf16_t* sV;
  float* sImpA; float* sImpB;
  unsigned* sSel; unsigned* sGrp; unsigned* sUn;
};

DEVI int next_bit(unsigned long long lo, unsigned long long hi, int from) {
  if (from < 64) {
    unsigned long long v = lo & (~0ull << from);
    if (v) return __builtin_ctzll(v);
    if (hi) return 64 + __builtin_ctzll(hi);
    return -1;
  }
  if (from >= 128) return -1;
  unsigned long long v = hi & (~0ull << (from - 64));
  if (v) return 64 + __builtin_ctzll(v);
  return -1;
}

template <int MODE, bool DUMMY = false, class MaskF, class ActF>
DEVI void nsa_branch(const NsaSm& sm, unsigned long long tmlo, unsigned long long tmhi,
                     const bf16_t* Kg, const bf16_t* Vg, long vstep, long ldv,
                     const bf16x8 (&qf)[2][2], f32x4 (&O)[4][2], float (&mrow)[2], float (&lrow)[2], const float (&invl)[2],
                     MaskF mask, ActF actf, int tokbase, int tid) {
  const int lane = tid & 63, r = lane & 15, q = lane >> 4;
  const int lr = tid >> 3, lk = (tid & 7) * 8;
  int j = next_bit(tmlo, tmhi, 0);
  if (j < 0) return;
  u32x4 k0, k1, v0, v1;
  u32x4 k2, k3, v2, v3;
  if (!DUMMY) {
    const bf16_t* kp = Kg + (long)j * 4096 + lr * 64 + lk;
    k0 = *(const u32x4*)kp; k1 = *(const u32x4*)(kp + 32 * 64);
    if (MODE != 1) {
      const bf16_t* vp = Vg + (long)j * vstep + (long)lr * ldv + lk;
      v0 = *(const u32x4*)vp; v1 = *(const u32x4*)(vp + 32 * ldv);
    }
    *(u32x4*)(sm.sK + lr * LDT + lk) = k0; *(u32x4*)(sm.sK + (lr + 32) * LDT + lk) = k1;
    if (MODE != 1) { *(u32x4*)(sm.sV + lr * LDT + lk) = v0; *(u32x4*)(sm.sV + (lr + 32) * LDT + lk) = v1; }
  }
  int j1 = next_bit(tmlo, tmhi, j + 1);
  if (!DUMMY && j1 >= 0) {
    const bf16_t* kp = Kg + (long)j1 * 4096 + lr * 64 + lk;
    k0 = *(const u32x4*)kp; k1 = *(const u32x4*)(kp + 32 * 64);
    if (MODE != 1) {
      const bf16_t* vp = Vg + (long)j1 * vstep + (long)lr * ldv + lk;
      v0 = *(const u32x4*)vp; v1 = *(const u32x4*)(vp + 32 * ldv);
    }
  }
  if (!DUMMY) __syncthreads();
  int buf = 0;
  while (true) {
    const int jn = j1;
    const int j2 = (j1 >= 0) ? next_bit(tmlo, tmhi, j1 + 1) : -1;
    if (!DUMMY && j2 >= 0) {
      const bf16_t* kp = Kg + (long)j2 * 4096 + lr * 64 + lk;
      k2 = *(const u32x4*)kp; k3 = *(const u32x4*)(kp + 32 * 64);
      if (MODE != 1) {
        const bf16_t* vp = Vg + (long)j2 * vstep + (long)lr * ldv + lk;
        v2 = *(const u32x4*)vp; v3 = *(const u32x4*)(vp + 32 * ldv);
      }
    }
    const bf16_t* sK = sm.sK + buf * (64 * LDT);
    const bf16_t* sV = sm.sV + buf * (64 * LDT);
    const bool a0 = actf(0, j), a1 = actf(1, j);
    __builtin_amdgcn_sched_barrier(0);
    if (a0 || a1) {
      const bool full = mask.full(j);
      f32x4 sacc[4][2];
#pragma unroll
      for (int mt = 0; mt < 4; ++mt) { sacc[mt][0] = f32x4{0.f, 0.f, 0.f, 0.f}; sacc[mt][1] = f32x4{0.f, 0.f, 0.f, 0.f}; }
      __builtin_amdgcn_s_setprio(2);
#pragma unroll
      for (int ks = 0; ks < 2; ++ks)
#pragma unroll
        for (int mt = 0; mt < 4; ++mt) {
          bf16x8 a = *(const bf16x8*)(sK + (mt * 16 + r) * LDT + ks * 32 + q * 8);
          if (a0) sacc[mt][0] = __builtin_amdgcn_mfma_f32_16x16x32_bf16(a, qf[0][ks], sacc[mt][0], 0, 0, 0);
          if (a1) sacc[mt][1] = __builtin_amdgcn_mfma_f32_16x16x32_bf16(a, qf[1][ks], sacc[mt][1], 0, 0, 0);
        }
      __builtin_amdgcn_s_setprio(0);
      __builtin_amdgcn_sched_barrier(0);
#pragma unroll
      for (int nt = 0; nt < 2; ++nt) {
        const bool act = nt ? a1 : a0;
        if (act) {
          const bool lb = mask.bit(nt, j);
          if (!full) {
#pragma unroll
            for (int mt = 0; mt < 4; ++mt)
#pragma unroll
              for (int i = 0; i < 4; ++i) sacc[mt][nt][i] = mask.elem(mt * 16 + q * 4 + i, nt, j) ? sacc[mt][nt][i] : NEGS;
          }
          if (MODE != 2) {
            float tmx = fmaxf(fmaxf(sacc[0][nt][0], sacc[0][nt][1]), fmaxf(sacc[0][nt][2], sacc[0][nt][3]));
#pragma unroll
            for (int mt = 1; mt < 4; ++mt)
              tmx = fmaxf(tmx, fmaxf(fmaxf(sacc[mt][nt][0], sacc[mt][nt][1]), fmaxf(sacc[mt][nt][2], sacc[mt][nt][3])));
            if (MaskF::HASBIT) tmx = lb ? tmx : NEGS;
            tmx = fmaxf(tmx, __shfl_xor(tmx, 16));
            tmx = fmaxf(tmx, __shfl_xor(tmx, 32));
            const float mo = mrow[nt];
            const float mn = fmaxf(mo, tmx);
            float mnc = fmaxf(mn, -1e20f);
            if (MaskF::HASBIT) mnc = lb ? mnc : 1e30f;
            mrow[nt] = mn;
            f32x4 psv = f32x4{0.f, 0.f, 0.f, 0.f};
#pragma unroll
            for (int mt = 0; mt < 4; ++mt) {
              f32x4 dd = sacc[mt][nt] - mnc;
              f32x4 pp;
              pp[0] = __builtin_amdgcn_exp2f(dd[0]); pp[1] = __builtin_amdgcn_exp2f(dd[1]);
              pp[2] = __builtin_amdgcn_exp2f(dd[2]); pp[3] = __builtin_amdgcn_exp2f(dd[3]);
              sacc[mt][nt] = pp;
              psv += pp;
            }
            const float ps = (psv[0] + psv[1]) + (psv[2] + psv[3]);
            const float al = __builtin_amdgcn_exp2f(mo - mn);
            lrow[nt] = lrow[nt] * al + ps;
            if (MODE == 0) {
              if (__any(al != 1.f)) {
#pragma unroll
                for (int dt = 0; dt < 4; ++dt) O[dt][nt] *= al;
              }
            }
          } else {
            const float mmc = fmaxf(mrow[nt], -1e20f), il = invl[nt];
            const int tok = tokbase + nt * 4 + (r >> 2);
#pragma unroll
            for (int mt = 0; mt < 4; ++mt) {
              float pp[4];
#pragma unroll
              for (int i = 0; i < 4; ++i) {
                pp[i] = __builtin_amdgcn_exp2f(sacc[mt][nt][i] - mmc) * il;
                sacc[mt][nt][i] = pp[i];
              }
              float mainv = 32.f * (pp[0] + pp[1] + pp[2]) + 16.f * pp[3];
              float carry = 16.f * pp[3];
              mainv += __shfl_xor(mainv, 1); mainv += __shfl_xor(mainv, 2);
              carry += __shfl_xor(carry, 1); carry += __shfl_xor(carry, 2);
              if ((r & 3) == 0) {
                const int mp = j * 16 + mt * 4 + q;
                sm.sImpA[tok * 128 + mp] = mainv;
                if (mp + 1 < 128) sm.sImpB[tok * 128 + mp + 1] = carry;
              }
            }
          }
        }
      }
      __builtin_amdgcn_sched_barrier(0);
      if (MODE != 1) {
        __builtin_amdgcn_s_setprio(2);
#pragma unroll
        for (int ks = 0; ks < 2; ++ks) {
          bf16x8 pb[2];
#pragma unroll
          for (int nt = 0; nt < 2; ++nt) {
            union { u32x4 u; bf16x8 h; } cv;
            cv.u[0] = pack2(sacc[2 * ks][nt][0], sacc[2 * ks][nt][1]);
            cv.u[1] = pack2(sacc[2 * ks][nt][2], sacc[2 * ks][nt][3]);
            cv.u[2] = pack2(sacc[2 * ks + 1][nt][0], sacc[2 * ks + 1][nt][1]);
            cv.u[3] = pack2(sacc[2 * ks + 1][nt][2], sacc[2 * ks + 1][nt][3]);
            pb[nt] = cv.h;
          }
#pragma unroll
          for (int dt = 0; dt < 4; ++dt) {
            union { u32x4 u; bf16x8 h; } av;
            const uint2 lo = *(const uint2*)(sV + (dt * 16 + r) * LDT + (2 * ks) * 16 + q * 4);
            const uint2 hi = *(const uint2*)(sV + (dt * 16 + r) * LDT + (2 * ks + 1) * 16 + q * 4);
            av.u[0] = lo.x; av.u[1] = lo.y; av.u[2] = hi.x; av.u[3] = hi.y;
            if (a0) O[dt][0] = __builtin_amdgcn_mfma_f32_16x16x32_bf16(av.h, pb[0], O[dt][0], 0, 0, 0);
            if (a1) O[dt][1] = __builtin_amdgcn_mfma_f32_16x16x32_bf16(av.h, pb[1], O[dt][1], 0, 0, 0);
          }
        }
        __builtin_amdgcn_s_setprio(0);
      }
    }
    __builtin_amdgcn_sched_barrier(0);
    if (!DUMMY && jn >= 0) {
      bf16_t* dK = sm.sK + (buf ^ 1) * (64 * LDT);
      bf16_t* dV = sm.sV + (buf ^ 1) * (64 * LDT);
      *(u32x4*)(dK + lr * LDT + lk) = k0; *(u32x4*)(dK + (lr + 32) * LDT + lk) = k1;
      if (MODE != 1) { *(u32x4*)(dV + lr * LDT + lk) = v0; *(u32x4*)(dV + (lr + 32) * LDT + lk) = v1; }
    }
    if (!DUMMY) __syncthreads();
    if (jn < 0) break;
    j = jn;
    j1 = j2;
    k0 = k2; k1 = k3; v0 = v2; v1 = v3;
    buf ^= 1;
  }
}

struct MaskC {
      static constexpr bool HASBIT = false;
      int t0_, t1_, tmin_;
      DEVI bool full(int jt) const { return 16 * (jt * 64 + 63) + 31 <= tmin_; }
      DEVI bool bit(int nt, int jt) const { return true; }
      DEVI bool elem(int key, int nt, int jt) const { return 16 * (jt * 64 + key) + 31 <= (nt ? t1_ : t0_); }
};

struct MaskS {
      static constexpr bool HASBIT = true;
      unsigned long long a_lo, a_hi, b_lo, b_hi; int t0_, t1_, cur_;
      DEVI bool full(int jt) const { return jt < cur_; }
      DEVI bool bit(int nt, int jt) const {
        const unsigned long long lo = nt ? b_lo : a_lo, hi = nt ? b_hi : a_hi;
        const unsigned long long wd = (jt < 64) ? (lo >> jt) : (hi >> (jt - 64));
        return (wd & 1ull) != 0ull;
      }
      DEVI bool elem(int key, int nt, int jt) const { return jt * 64 + key <= (nt ? t1_ : t0_); }
};

struct MaskW {
      static constexpr bool HASBIT = false;
      int t0_, t1_, tmin_, tmax_;
      DEVI bool full(int jt) const { return (jt * 64 + 63 <= tmin_) && (tmax_ - jt * 64 < 512); }
      DEVI bool bit(int nt, int jt) const { return true; }
      DEVI bool elem(int key, int nt, int jt) const { const int s_ = jt * 64 + key, t_ = nt ? t1_ : t0_; return (s_ <= t_) && (t_ - s_ < 512); }
};

DEVI void nsa_tile(const Params& p, int tileidx, unsigned char* smem) {
  const int tid = opaque_tid(), lane = tid & 63, w = tid >> 6, r = lane & 15, q = lane >> 4;
  const int bg = tileidx & 3, tt = tileidx >> 2, b = bg >> 1, g = bg & 1, t0 = tt * 32;
  unsigned char* ws = p.ws;
  NsaSm sm;
  sm.sK = (bf16_t*)smem; sm.sV = (bf16_t*)(smem + 18432);
  sm.sImpA = (float*)(smem + 36864); sm.sImpB = (float*)(smem + 53248);
  sm.sSel = (unsigned*)(smem + 69632); sm.sGrp = sm.sSel + 128; sm.sUn = sm.sGrp + 32;
  const int tokbase = 8 * w;
  bf16x8 qf[2][2];
  {
    const bf16_t* qn = (const bf16_t*)(ws + L0_QN) + ((long)bg * 8192 + t0) * 256 + (32 * w + r) * 64 + q * 8;
    qf[0][0] = *(const bf16x8*)(qn); qf[0][1] = *(const bf16x8*)(qn + 32);
    qf[1][0] = *(const bf16x8*)(qn + 16 * 64); qf[1][1] = *(const bf16x8*)(qn + 16 * 64 + 32);
  }
  int tq[2];
  const float* GT = (const float*)(ws + L0_GATES);
#pragma unroll
  for (int nt = 0; nt < 2; ++nt) tq[nt] = t0 + tokbase + nt * 4 + (r >> 2);
#define GATE(nt, k) (GT[((long)b * 8192 + tq[nt]) * 24 + (g * 4 + (r & 3)) * 3 + (k)])
  f32x4 O[4][2];
  f32x4* sOut = (f32x4*)(smem + 36864) + (w * 8) * 64 + lane;
  const int cur = t0 >> 6;
  float mrow[2], lrow[2], invl[2];
  for (int i = tid; i < 32 * 128; i += 256) { sm.sImpA[i] = 0.f; sm.sImpB[i] = 0.f; }
  __syncthreads();
  {
    const int nvmax = (t0 + 31 >= 31) ? (((t0 + 31 - 31) >> 4) + 1) : 0;
    int nkt = (nvmax + 63) >> 6;
    if (nkt > 8) nkt = 8;
    const unsigned long long cm0 = (1ull << nkt) - 1ull;
    const bf16_t* KCMP = (const bf16_t*)(ws + L0_KCMP) + (long)bg * 512 * 64;
    const bf16_t* VCMPT = (const bf16_t*)(ws + L0_VCMPT) + (long)bg * 64 * 512;
    MaskC mk{tq[0], tq[1], t0 + tokbase};
    auto act = [&](int nt, int jt) { return true; };
    mrow[0] = mrow[1] = NEGS; lrow[0] = lrow[1] = 0.f; invl[0] = invl[1] = 0.f;
    nsa_branch<1>(sm, cm0, 0ull, KCMP, VCMPT, 64, 512, qf, O, mrow, lrow, invl, mk, act, tokbase, tid);
#pragma unroll
    for (int nt = 0; nt < 2; ++nt) {
      float l = lrow[nt];
      l += __shfl_xor(l, 16); l += __shfl_xor(l, 32);
      invl[nt] = (l > 0.f) ? 1.f / l : 0.f;
    }
#pragma unroll
    for (int dt = 0; dt < 4; ++dt) { O[dt][0] = f32x4{0.f, 0.f, 0.f, 0.f}; O[dt][1] = f32x4{0.f, 0.f, 0.f, 0.f}; }
    nsa_branch<2>(sm, cm0, 0ull, KCMP, VCMPT, 64, 512, qf, O, mrow, lrow, invl, mk, act, tokbase, tid);
  }
  __syncthreads();
  {
    const int ncand = (cur - 2 > 0) ? cur - 2 : 0;
    const int nf = (cur >= 2) ? 3 : cur + 1;
    const int kk = 16 - nf;
    const int m0i = lane, m1i = lane + 64;
    const bool c0 = (m0i >= 1 && m0i <= cur - 2), c1 = (m1i <= cur - 2);
    for (int tqi = 0; tqi < 8; ++tqi) {
      const int tok = tokbase + tqi;
      bool s0, s1;
      if (ncand <= kk) { s0 = c0; s1 = c1; }
      else {
        const float f0 = sm.sImpA[tok * 128 + m0i] + sm.sImpB[tok * 128 + m0i];
        const float f1 = sm.sImpA[tok * 128 + m1i] + sm.sImpB[tok * 128 + m1i];
        const unsigned k0 = c0 ? (__float_as_uint(f0) + 1u) : 0u;
        const unsigned k1 = c1 ? (__float_as_uint(f1) + 1u) : 0u;
        unsigned prefix = 0u;
        for (int bit = 31; bit >= 0; --bit) {
          const unsigned cand = prefix | (1u << bit);
          const int cnt = __popcll(__ballot(k0 >= cand)) + __popcll(__ballot(k1 >= cand));
          if (cnt >= kk) prefix = cand;
        }
        const bool g0 = k0 > prefix, g1 = k1 > prefix;
        const int ng = __popcll(__ballot(g0)) + __popcll(__ballot(g1));
        const bool e0 = (k0 == prefix), e1 = (k1 == prefix);
        const unsigned long long be0 = __ballot(e0), be1 = __ballot(e1);
        const unsigned long long lm = (1ull << lane) - 1ull;
        const int re0 = __popcll(be0 & lm), re1 = __popcll(be0) + __popcll(be1 & lm);
        const int need = kk - ng;
        s0 = g0 || (e0 && re0 < need);
        s1 = g1 || (e1 && re1 < need);
      }
      s0 = s0 || (m0i == 0) || (m0i == cur) || (m0i == cur - 1);
      s1 = s1 || (m1i == cur) || (m1i == cur - 1);
      const unsigned long long lo = __ballot(s0), hi = __ballot(s1);
      if (lane == 0) {
        sm.sSel[tok * 4 + 0] = (unsigned)lo; sm.sSel[tok * 4 + 1] = (unsigned)(lo >> 32);
        sm.sSel[tok * 4 + 2] = (unsigned)hi; sm.sSel[tok * 4 + 3] = (unsigned)(hi >> 32);
      }
    }
  }
  __syncthreads();
  if (tid < 32) { int gi = tid >> 2, wd = tid & 3; unsigned u = 0; for (int k = 0; k < 4; ++k) u |= sm.sSel[(gi * 4 + k) * 4 + wd]; sm.sGrp[tid] = u; }
  __syncthreads();
  if (tid < 4) { unsigned u = 0; for (int gi = 0; gi < 8; ++gi) u |= sm.sGrp[gi * 4 + tid]; sm.sUn[tid] = u; }
  __syncthreads();
#pragma unroll
  for (int nt = 0; nt < 2; ++nt)
#pragma unroll
    for (int dt = 0; dt < 4; ++dt) sOut[(nt * 4 + dt) * 64] = O[dt][nt] * GATE(nt, 0);
  {
    const bf16_t* KS = (const bf16_t*)(ws + L0_KS) + (long)bg * 8192 * 64;
    const bf16_t* VST = (const bf16_t*)(ws + L0_VST) + (long)bg * 128 * 4096;
    const unsigned long long ulo = (unsigned long long)sm.sUn[0] | ((unsigned long long)sm.sUn[1] << 32);
    const unsigned long long uhi = (unsigned long long)sm.sUn[2] | ((unsigned long long)sm.sUn[3] << 32);
    const int tk0 = tokbase + (r >> 2), tk1 = tokbase + 4 + (r >> 2);
    MaskS mk{(unsigned long long)sm.sSel[tk0 * 4 + 0] | ((unsigned long long)sm.sSel[tk0 * 4 + 1] << 32),
             (unsigned long long)sm.sSel[tk0 * 4 + 2] | ((unsigned long long)sm.sSel[tk0 * 4 + 3] << 32),
             (unsigned long long)sm.sSel[tk1 * 4 + 0] | ((unsigned long long)sm.sSel[tk1 * 4 + 1] << 32),
             (unsigned long long)sm.sSel[tk1 * 4 + 2] | ((unsigned long long)sm.sSel[tk1 * 4 + 3] << 32), tq[0], tq[1], cur};
    unsigned long long g0lo, g0hi, g1lo, g1hi;
    {
      const unsigned* gp = sm.sGrp + (2 * w) * 4;
      g0lo = (unsigned long long)__builtin_amdgcn_readfirstlane(gp[0]) | ((unsigned long long)__builtin_amdgcn_readfirstlane(gp[1]) << 32);
      g0hi = (unsigned long long)__builtin_amdgcn_readfirstlane(gp[2]) | ((unsigned long long)__builtin_amdgcn_readfirstlane(gp[3]) << 32);
      g1lo = (unsigned long long)__builtin_amdgcn_readfirstlane(gp[4]) | ((unsigned long long)__builtin_amdgcn_readfirstlane(gp[5]) << 32);
      g1hi = (unsigned long long)__builtin_amdgcn_readfirstlane(gp[6]) | ((unsigned long long)__builtin_amdgcn_readfirstlane(gp[7]) << 32);
    }
    auto act = [&](int nt, int jt) {
      const unsigned long long lo = nt ? g1lo : g0lo, hi = nt ? g1hi : g0hi;
      const unsigned long long wd = (jt < 64) ? (lo >> jt) : (hi >> (jt - 64));
      return (wd & 1ull) != 0ull;
    };
    mrow[0] = mrow[1] = NEGS; lrow[0] = lrow[1] = 0.f;
#pragma unroll
    for (int dt = 0; dt < 4; ++dt) { O[dt][0] = f32x4{0.f, 0.f, 0.f, 0.f}; O[dt][1] = f32x4{0.f, 0.f, 0.f, 0.f}; }
#ifdef NSA_DUMMY_SEL
    {
      nsa_branch<0, true>(sm, ulo, uhi, KS, VST, 4096, 64, qf, O, mrow, lrow, invl, mk, act, tokbase, tid);
      float chk = lrow[0] + lrow[1];
#pragma unroll
      for (int dt = 0; dt < 4; ++dt) chk += O[dt][0][0] + O[dt][0][1] + O[dt][0][2] + O[dt][0][3] + O[dt][1][0] + O[dt][1][1] + O[dt][1][2] + O[dt][1][3];
      if (chk == 123.456f) sm.sUn[0] = 1u;
      mrow[0] = mrow[1] = NEGS; lrow[0] = lrow[1] = 0.f;
#pragma unroll
      for (int dt = 0; dt < 4; ++dt) { O[dt][0] = f32x4{0.f, 0.f, 0.f, 0.f}; O[dt][1] = f32x4{0.f, 0.f, 0.f, 0.f}; }
      __syncthreads();
    }
#endif
    nsa_branch<0>(sm, ulo, uhi, KS, VST, 4096, 64, qf, O, mrow, lrow, invl, mk, act, tokbase, tid);
#pragma unroll
    for (int nt = 0; nt < 2; ++nt) {
      float l = lrow[nt];
      l += __shfl_xor(l, 16); l += __shfl_xor(l, 32);
      const float f = GATE(nt, 1) * ((l > 0.f) ? 1.f / l : 0.f);
#pragma unroll
      for (int dt = 0; dt < 4; ++dt) sOut[(nt * 4 + dt) * 64] += O[dt][nt] * f;
    }
  }
  {
    const bf16_t* KW = (const bf16_t*)(ws + L0_KW) + (long)bg * 8192 * 64;
    const bf16_t* VWT = (const bf16_t*)(ws + L0_VWT) + (long)bg * 128 * 4096;
    const int jlo = ((t0 - 511 > 0) ? (t0 - 511) : 0) >> 6;
    unsigned long long wlo = 0ull, whi = 0ull;
    for (int jj = jlo; jj <= cur; ++jj) { if (jj < 64) wlo |= (1ull << jj); else whi |= (1ull << (jj - 64)); }
    MaskW mk{tq[0], tq[1], t0 + tokbase, t0 + tokbase + 7};
    auto act = [&](int nt, int jt) { return true; };
    mrow[0] = mrow[1] = NEGS; lrow[0] = lrow[1] = 0.f;
#pragma unroll
    for (int dt = 0; dt < 4; ++dt) { O[dt][0] = f32x4{0.f, 0.f, 0.f, 0.f}; O[dt][1] = f32x4{0.f, 0.f, 0.f, 0.f}; }
    nsa_branch<0>(sm, wlo, whi, KW, VWT, 4096, 64, qf, O, mrow, lrow, invl, mk, act, tokbase, tid);
#pragma unroll
    for (int nt = 0; nt < 2; ++nt) {
      float l = lrow[nt];
      l += __shfl_xor(l, 16); l += __shfl_xor(l, 32);
      const float f = GATE(nt, 2) * ((l > 0.f) ? 1.f / l : 0.f);
#pragma unroll
      for (int dt = 0; dt < 4; ++dt) O[dt][nt] = sOut[(nt * 4 + dt) * 64] + O[dt][nt] * f;
    }
  }
  const bf16_t* NZ = (const bf16_t*)(ws + L0_NZ);
  bf16_t* Y = (bf16_t*)(ws + L0_QKRAW);
  uint2 zzv[2][4];
#pragma unroll
  for (int nt = 0; nt < 2; ++nt)
#pragma unroll
    for (int dt = 0; dt < 4; ++dt)
      zzv[nt][dt] = *(const uint2*)(NZ + ((long)b * 8192 + tq[nt]) * 512 + (g * 4 + (r & 3)) * 64 + dt * 16 + q * 4);
#pragma unroll
  for (int nt = 0; nt < 2; ++nt) {
    const long tok = (long)b * 8192 + tq[nt];
    const int head = g * 4 + (r & 3);
#pragma unroll
    for (int dt = 0; dt < 4; ++dt) {
      const int d = dt * 16 + q * 4;
      const uint2 zz = zzv[nt][dt];
      uint2 o;
      o.x = pack2(O[dt][nt][0] * lo2f(zz.x), O[dt][nt][1] * hi2f(zz.x));
      o.y = pack2(O[dt][nt][2] * lo2f(zz.y), O[dt][nt][3] * hi2f(zz.y));
      *(uint2*)(Y + tok * 1024 + 512 + head * 64 + d) = o;
    }
  }
  __syncthreads();
}

DEVI void hgrn_local(const Params& p, int unit, unsigned char* smem) {
  const int tid = opaque_tid(), lane = tid & 63, w = tid >> 6, wr = w >> 1, wc = w & 1;
  const int bh = unit >> 7, c = unit & 127, b = bh >> 3, h = bh & 7, t0 = c * 64;
  const long R0 = (long)b * 8192 + t0;
  unsigned char* ws = p.ws;
  bf16_t* sA = (bf16_t*)smem;
  bf16_t* sB = (bf16_t*)(smem + 18432);
  float* psum = (float*)(smem + 36864);
  const int cch = tid & 127, half = tid >> 7;
  const float lb = ((const float*)(ws + OFF_LB))[h * 128 + cch];
  const bf16_t* FP = (const bf16_t*)(ws + L1_FP) + R0 * 1024 + h * 128 + cch;
  float sgv[32], lgv[32];
  {
    const bf16_t* vtp = (const bf16_t*)(ws + L1_VT) + (((long)(b * 8 + h) * 128 + c) * 128) * 64 + (tid >> 3) * 64 + (tid & 7) * 8;
    u32x4 t0_ = *(const u32x4*)vtp, t1_ = *(const u32x4*)(vtp + 32 * 64), t2_ = *(const u32x4*)(vtp + 64 * 64), t3_ = *(const u32x4*)(vtp + 96 * 64);
    bf16_t fpr[32];
#pragma unroll
    for (int k = 0; k < 32; ++k) fpr[k] = FP[(long)(half * 32 + k) * 1024];
    {
      bf16_t* sp = sA + (tid >> 3) * LDT + (tid & 7) * 8;
      *(u32x4*)sp = t0_; *(u32x4*)(sp + 32 * LDT) = t1_; *(u32x4*)(sp + 64 * LDT) = t2_; *(u32x4*)(sp + 96 * LDT) = t3_;
    }
#pragma unroll
    for (int k = 0; k < 32; ++k) { sgv[k] = sigm(bf2f(fpr[k])); lgv[k] = __logf(lb + (1.f - lb) * sgv[k]); }
  }
  float sum = 0.f;
#pragma unroll
  for (int k = 0; k < 32; ++k) sum += lgv[k];
  psum[half * 128 + cch] = sum;
  __syncthreads();
  const float bL = psum[cch] + psum[128 + cch];
  float run = half ? psum[cch] : 0.f;
#pragma unroll
  for (int k = 0; k < 32; ++k) {
    run += lgv[k];
    float kk_ = (1.f - lb) * (1.f - sgv[k]);
    sB[cch * LDT + half * 32 + k] = f2bf(kk_ * __expf(bL - run));
  }
  if (half == 0) ((float*)(ws + L1_BL))[(long)unit * 128 + cch] = bL;
  __syncthreads();
  f32x4 acc[4][4];
#pragma unroll
  for (int mt = 0; mt < 4; ++mt)
#pragma unroll
    for (int nt = 0; nt < 4; ++nt) acc[mt][nt] = f32x4{0.f, 0.f, 0.f, 0.f};
  mma_lds_sw<4, 4, 2>(sA + wr * 64 * LDT, sB + wc * 64 * LDT, acc, lane);
#ifndef R9B
#define R9B 1
#endif
  for (int r9_ = 0; r9_ < R9B; ++r9_) {
  bf16_t* st = (bf16_t*)(ws + L1_ST) + (long)unit * 16384;
  const int r = lane & 15, q = lane >> 4;
#pragma unroll
  for (int mt = 0; mt < 4; ++mt) {
    const int v = wr * 64 + mt * 16 + r;
#pragma unroll
    for (int nt = 0; nt < 4; ++nt) {
      uint2 o;
      o.x = pack2(acc[mt][nt][0], acc[mt][nt][1]);
      o.y = pack2(acc[mt][nt][2], acc[mt][nt][3]);
      *(uint2*)(st + v * 128 + wc * 64 + nt * 16 + q * 4) = o;
    }
  }
  }
  __syncthreads();
}

template <bool DUMMY>
DEVI void hgrn_scan(const Params& p) {
  unsigned char* ws = p.ws;
  const float* BL = (const float*)(ws + L1_BL);
  for (int idx = blockIdx.x * 256 + opaque_tid(); idx < 16 * 8192; idx += gridDim.x * 256) {
    const int bh = idx >> 13, pr = idx & 8191;
    const int c2 = (pr & 63) * 2;
    unsigned* ptr = (unsigned*)(ws + L1_ST) + (long)bh * 128 * 8192 + pr;
    const float* blp = BL + (long)bh * 128 * 128 + c2;
    float s0 = 0.f, s1 = 0.f;
    for (int c0 = 0; c0 < 128; c0 += 8) {
      unsigned dv[8]; float2 bl[8];
#pragma unroll
      for (int k = 0; k < 8; ++k) { dv[k] = ptr[(long)(c0 + k) * 8192]; bl[k] = *(const float2*)(blp + (long)(c0 + k) * 128); }
#pragma unroll
      for (int k = 0; k < 8; ++k) {
        if (!DUMMY) ptr[(long)(c0 + k) * 8192] = pack2(s0, s1);
        s0 = __expf(bl[k].x) * s0 + lo2f(dv[k]);
        s1 = __expf(bl[k].y) * s1 + hi2f(dv[k]);
      }
    }
    if (DUMMY && s0 == 123.456f) ptr[0] = pack2(s0, s1);
  }
}

DEVI void hgrn_out(const Params& p, int unit, unsigned char* smem) {
  const int tid = opaque_tid(), lane = tid & 63, w = tid >> 6, wr = w >> 1, wc = w & 1;
  const int r = lane & 15, q = lane >> 4;
  const int bh = unit >> 7, c = unit & 127, b = bh >> 3, h = bh & 7, t0 = c * 64;
  const long R0 = (long)b * 8192 + t0;
  unsigned char* ws = p.ws;
  bf16_t* sQ0 = (bf16_t*)smem; bf16_t* sQ1 = (bf16_t*)(smem + 9216);
  bf16_t* sK0 = (bf16_t*)(smem + 18432); bf16_t* sK1 = (bf16_t*)(smem + 27648);
  bf16_t* sAm = (bf16_t*)(smem + 36864);
  bf16_t* sB = (bf16_t*)(smem + 46080);
  float* psum = (float*)(smem + 64512);
  float* sSs = psum + 256;
  const int cch = tid & 127, half = tid >> 7, cc = cch & 63;
  const float lb = ((const float*)(ws + OFF_LB))[h * 128 + cch];
  const bf16_t* FP = (const bf16_t*)(ws + L1_FP) + R0 * 1024 + h * 128 + cch;
  const bf16_t* Q1 = (const bf16_t*)(ws + L1_Q) + R0 * 1024 + h * 128 + cch;
  const bf16_t* vt = (const bf16_t*)(ws + L1_VT) + (((long)(b * 8 + h) * 128 + c) * 128) * 64;
  const bf16_t* st = (const bf16_t*)(ws + L1_ST) + (long)unit * 16384;
  const int tl_r = tid >> 3, tl_k = (tid & 7) * 8;
  u32x4 vv0, vv1, vv2, vv3, sa0, sa1, sa2, sa3, sb0, sb1, sb2, sb3;
  {
    const bf16_t* vp = vt + tl_r * 64 + tl_k;
    vv0 = *(const u32x4*)vp; vv1 = *(const u32x4*)(vp + 32 * 64); vv2 = *(const u32x4*)(vp + 64 * 64); vv3 = *(const u32x4*)(vp + 96 * 64);
    const bf16_t* sp = st + tl_r * 128 + tl_k;
    sa0 = *(const u32x4*)sp; sa1 = *(const u32x4*)(sp + 32 * 128); sa2 = *(const u32x4*)(sp + 64 * 128); sa3 = *(const u32x4*)(sp + 96 * 128);
    sb0 = *(const u32x4*)(sp + 64); sb1 = *(const u32x4*)(sp + 32 * 128 + 64); sb2 = *(const u32x4*)(sp + 64 * 128 + 64); sb3 = *(const u32x4*)(sp + 96 * 128 + 64);
  }
  float sgv[32], lgv[32];
  bf16_t qr[32];
  {
    bf16_t fpr[32];
#pragma unroll
    for (int k = 0; k < 32; ++k) { fpr[k] = FP[(long)(half * 32 + k) * 1024]; qr[k] = Q1[(long)(half * 32 + k) * 1024]; }
    { bf16_t* dp = sB + tl_r * LDT + tl_k; *(u32x4*)dp = vv0; *(u32x4*)(dp + 32 * LDT) = vv1; *(u32x4*)(dp + 64 * LDT) = vv2; *(u32x4*)(dp + 96 * LDT) = vv3; }
#pragma unroll
    for (int k = 0; k < 32; ++k) { sgv[k] = sigm(bf2f(fpr[k])); lgv[k] = __logf(lb + (1.f - lb) * sgv[k]); }
  }
  float sum = 0.f;
#pragma unroll
  for (int k = 0; k < 32; ++k) sum += lgv[k];
  psum[half * 128 + cch] = sum;
  __syncthreads();
  float run = half ? psum[cch] : 0.f;
  bf16_t* sQ = (cch < 64) ? sQ0 : sQ1;
  bf16_t* sK = (cch < 64) ? sK0 : sK1;
#pragma unroll
  for (int k = 0; k < 32; ++k) {
    const int s_ = half * 32 + k;
    run += lgv[k];
    float kk_ = (1.f - lb) * (1.f - sgv[k]);
    sQ[s_ * LDT + cc] = f2bf(bf2f(qr[k]) * __expf(run));
    sK[s_ * LDT + cc] = f2bf(kk_ * __expf(fminf(-run, 80.f)));
  }
  __syncthreads();
  {
    f32x4 a1[2][2];
#pragma unroll
    for (int mt = 0; mt < 2; ++mt)
#pragma unroll
      for (int nt = 0; nt < 2; ++nt) a1[mt][nt] = f32x4{0.f, 0.f, 0.f, 0.f};
    if (!(wr == 0 && wc == 1)) {
      mma_lds<2, 2, 2>(sQ0 + wr * 32 * LDT, sK0 + wc * 32 * LDT, a1, lane);
      mma_lds<2, 2, 2>(sQ1 + wr * 32 * LDT, sK1 + wc * 32 * LDT, a1, lane);
    }
#pragma unroll
    for (int mt = 0; mt < 2; ++mt)
#pragma unroll
      for (int i = 0; i < 4; ++i) {
        int j = wr * 32 + mt * 16 + q * 4 + i;
#pragma unroll
        for (int nt = 0; nt < 2; ++nt) {
          int s = wc * 32 + nt * 16 + r;
          sAm[j * LDT + s] = f2bf((s <= j) ? a1[mt][nt][i] : 0.f);
        }
      }
  }
  __syncthreads();
  f32x4 o[2][4];
#pragma unroll
  for (int mt = 0; mt < 2; ++mt)
#pragma unroll
    for (int nt = 0; nt < 4; ++nt) o[mt][nt] = f32x4{0.f, 0.f, 0.f, 0.f};
  mma_lds<2, 4, 2>(sAm + wr * 32 * LDT, sB + wc * 64 * LDT, o, lane);
  __syncthreads();
  { bf16_t* dp = sB + tl_r * LDT + tl_k; *(u32x4*)dp = sa0; *(u32x4*)(dp + 32 * LDT) = sa1; *(u32x4*)(dp + 64 * LDT) = sa2; *(u32x4*)(dp + 96 * LDT) = sa3; }
  __syncthreads();
  mma_lds<2, 4, 2>(sQ0 + wr * 32 * LDT, sB + wc * 64 * LDT, o, lane);
  __syncthreads();
  { bf16_t* dp = sB + tl_r * LDT + tl_k; *(u32x4*)dp = sb0; *(u32x4*)(dp + 32 * LDT) = sb1; *(u32x4*)(dp + 64 * LDT) = sb2; *(u32x4*)(dp + 96 * LDT) = sb3; }
  __syncthreads();
  mma_lds<2, 4, 2>(sQ1 + wr * 32 * LDT, sB + wc * 64 * LDT, o, lane);
#pragma unroll
  for (int mt = 0; mt < 2; ++mt)
#pragma unroll
    for (int i = 0; i < 4; ++i) {
      int j = wr * 32 + mt * 16 + q * 4 + i;
      float ss = 0.f;
#pragma unroll
      for (int nt = 0; nt < 4; ++nt) ss += o[mt][nt][i] * o[mt][nt][i];
      ss = grp16_sum(ss);
      if (r == 0) sSs[wc * 64 + j] = ss;
    }
  __syncthreads();
  const bf16_t* Z1 = (const bf16_t*)(ws + L1_Z);
  bf16_t* Y1 = (bf16_t*)(ws + L1_H);
  float hn[4];
#pragma unroll
  for (int nt = 0; nt < 4; ++nt) hn[nt] = p.h_hn[h * 128 + wc * 64 + nt * 16 + r];
#pragma unroll
  for (int mt = 0; mt < 2; ++mt) {
    float zv[4][4];
#pragma unroll
    for (int i = 0; i < 4; ++i) {
      long row = R0 + wr * 32 + mt * 16 + q * 4 + i;
#pragma unroll
      for (int nt = 0; nt < 4; ++nt) zv[i][nt] = bf2f(Z1[row * 1024 + h * 128 + wc * 64 + nt * 16 + r]);
    }
#pragma unroll
    for (int i = 0; i < 4; ++i) {
      int j = wr * 32 + mt * 16 + q * 4 + i;
      float rinv = rsqrtf((sSs[j] + sSs[64 + j]) * (1.f / 128.f) + EPSF);
      long row = R0 + j;
#pragma unroll
      for (int nt = 0; nt < 4; ++nt) {
        int col = h * 128 + wc * 64 + nt * 16 + r;
        Y1[row * 1024 + col] = f2bf(o[mt][nt][i] * rinv * hn[nt] * zv[i][nt]);
      }
    }
  }
  __syncthreads();
}

#define XB_TMO      128
#define XB_XCNT(j)  (256  + 64 * (j))
#define XB_XSUB(j)  (1280 + 64 * (j))
#define XB_XGEN(j)  (2304 + 64 * (j))
#define XB_TOP      3328
#define XB_TOPGEN   3392
#define XCD_BAR_WORDS 3456
#define XB_SPIN_CAP (1u << 22)
DEVI unsigned xb_ld(unsigned* p) { return __hip_atomic_load(p, __ATOMIC_RELAXED, __HIP_MEMORY_SCOPE_AGENT); }
DEVI unsigned xb_add(unsigned* p, unsigned v) { return __hip_atomic_fetch_add(p, v, __ATOMIC_RELAXED, __HIP_MEMORY_SCOPE_AGENT); }
DEVI unsigned xb_xcc_id() { return (unsigned)__builtin_amdgcn_s_getreg((3 << 11) | 20) & 0xFu; }
#define XB_SPIN(cond, bar) do { unsigned _sp = 0; while (cond) { __builtin_amdgcn_s_sleep(1); \
    if ((++_sp & 255u) == 0u) { if (xb_ld(&(bar)[XB_TMO])) break; if (_sp > XB_SPIN_CAP) { atomicAdd(&(bar)[XB_TMO], 1u); break; } } } } while (0)

DEVI void xcd_barrier_complete(unsigned* bar, unsigned x, unsigned& nloc, unsigned& nx) {
  const unsigned G = gridDim.x;
  unsigned sum, cnt, mine, sp = 0u;
  for (;;) {
    sum = 0u; cnt = 0u; mine = 0u;
#pragma unroll
    for (unsigned j = 0; j < 16; ++j) { const unsigned c = xb_ld(&bar[XB_XCNT(j)]); sum += c; cnt += (c > 0u) ? 1u : 0u; mine = (j == x) ? c : mine; }
    if (sum == G) break;
    __builtin_amdgcn_s_sleep(1);
    if ((++sp & 255u) == 0u) { if (xb_ld(&bar[XB_TMO])) break; if (sp > XB_SPIN_CAP) { atomicAdd(&bar[XB_TMO], 1u); break; } }
  }
  nloc = mine > 0u ? mine : 1u; nx = cnt > 0u ? cnt : 1u;
}

DEVI void grid_barrier(unsigned* bar, unsigned xcc, volatile unsigned* st) {
  asm volatile("s_waitcnt vmcnt(0)" ::: "memory");
  __syncthreads();
  if (threadIdx.x == 0) {
    __builtin_amdgcn_s_waitcnt(0);
    unsigned nloc = st[0], nx = st[1];
    if (nloc == 0u) { xcd_barrier_complete(bar, xcc, nloc, nx); st[0] = nloc; st[1] = nx; }
    const unsigned old = xb_add(&bar[XB_XSUB(xcc)], 1u);
    const unsigned gen = old / nloc;
    if (old + 1u == (gen + 1u) * nloc) {
      __builtin_amdgcn_fence(__ATOMIC_RELEASE, "agent");
      asm volatile("s_waitcnt vmcnt(0)" ::: "memory");
      const unsigned og = xb_add(&bar[XB_TOP], 1u);
      const unsigned tg = og / nx;
      if (og + 1u == (tg + 1u) * nx) xb_add(&bar[XB_TOPGEN], 1u);
      else XB_SPIN(xb_ld(&bar[XB_TOPGEN]) == tg, bar);
      __builtin_amdgcn_fence(__ATOMIC_ACQUIRE, "agent");
      xb_add(&bar[XB_XGEN(xcc)], 1u);
      asm volatile("s_waitcnt vmcnt(0)" ::: "memory");
    } else {
      XB_SPIN(xb_ld(&bar[XB_XGEN(xcc)]) == gen, bar);
      __builtin_amdgcn_fence(__ATOMIC_ACQUIRE, "agent");
      asm volatile("s_waitcnt vmcnt(0)" ::: "memory");
    }
  }
  __syncthreads();
}

#ifndef REP_NSA
#define REP_NSA 1
#endif
#ifndef REP_P0
#define REP_P0 1
#endif
#ifndef REP_P1
#define REP_P1 1
#endif
#ifndef REP_P2
#define REP_P2 1
#endif
#ifndef REP_P3
#define REP_P3 1
#endif
#ifndef REP_P4
#define REP_P4 1
#endif
#ifndef REP_P5
#define REP_P5 1
#endif
#ifndef REP_P6
#define REP_P6 1
#endif
#ifndef REP_P7
#define REP_P7 1
#endif
#ifndef REP_P8
#define REP_P8 1
#endif
#ifndef REP_P9
#define REP_P9 1
#endif
#ifndef REP_P10
#define REP_P10 1
#endif
#ifndef REP_P11
#define REP_P11 1
#endif
#ifndef REP_P12
#define REP_P12 1
#endif
#ifndef DBG_STOP
#define DBG_STOP 99
#endif
DEVI void dbg_probe_bf16(const Params& p, size_t off, long n) {
  const bf16_t* b = (const bf16_t*)(p.ws + off);
  for (long i = (long)blockIdx.x * 256 + threadIdx.x; i < 16384L * 1024; i += (long)gridDim.x * 256) {
    float v = bf2f(b[i % n]);
    if (!(v == v) || fabsf(v) > 1e30f) v = 777.f;
    p.out[i] = v;
  }
}
DEVI void dbg_probe_f32(const Params& p, size_t off, long n) {
  const float* b = (const float*)(p.ws + off);
  for (long i = (long)blockIdx.x * 256 + threadIdx.x; i < 16384L * 1024; i += (long)gridDim.x * 256) {
    float v = b[i % n];
    if (!(v == v) || fabsf(v) > 1e30f) v = 777.f;
    p.out[i] = v;
  }
}
DEVI void dbg_probe_combo(const Params& p) {
  const bf16_t* qn = (const bf16_t*)(p.ws + L0_QN);
  const bf16_t* ks = (const bf16_t*)(p.ws + L0_KS);
  const bf16_t* nz = (const bf16_t*)(p.ws + L0_NZ);
  const float* ig = (const float*)(p.ws + L0_IG);
  for (long i = (long)blockIdx.x * 256 + threadIdx.x; i < 16384L * 1024; i += (long)gridDim.x * 256) {
    float v = bf2f(qn[i % (16384L * 512)]) + bf2f(ks[i % (4L * 8192 * 64 * 4)]) + bf2f(nz[i % (16384L * 512)]) + ig[i % (16384L * 32)];
    if (!(v == v) || fabsf(v) > 1e30f) v = 777.f;
    p.out[i] = v;
  }
}
#define DBG_AT(k, stmt) if (DBG_STOP == k) { stmt; return; }

#define GSYNC() grid_barrier(bar_ctr, bar_xcc, bar_st)

__global__ void __launch_bounds__(256, 2) mega(Params p) {
  __shared__ __attribute__((aligned(16))) unsigned char smem[79872];
  cg::grid_group grid = cg::this_grid();
  const int G = gridDim.x, bid = blockIdx.x, tid = threadIdx.x, lane = tid & 63, w = tid >> 6;
  unsigned char* ws = p.ws;
  bf16_t* sA = (bf16_t*)smem;
  bf16_t* sB = (bf16_t*)(smem + 16384);
  unsigned* bar_ctr = (unsigned*)(ws + OFF_BAR);
  __shared__ uint4 xb_words;
  if (tid == 0) xb_words = make_uint4(0u, 0u, 0u, 0u);
  __syncthreads();
  volatile unsigned* bar_st = (volatile unsigned*)&xb_words;
  const unsigned bar_xcc = xb_xcc_id();
  if (tid == 0) (void)xb_add(&bar_ctr[XB_XCNT(bar_xcc)], 1u);
  if (p.ws == nullptr) grid.sync();

#ifdef EXTRA_SYNCS
  for (int e_ = 0; e_ < EXTRA_SYNCS; ++e_) GSYNC();
#endif
  for (int rep_ = 0; rep_ < REP_P0; ++rep_) {
  phase0(p, smem);
  GSYNC();
  }
  DBG_AT(0, dbg_probe_bf16(p, L0_H, 16384L*1024))
  for (int rep_ = 0; rep_ < REP_P1; ++rep_) {
  for (int k_ = 0; k_ * (G >> 3) < 16 * 35; ++k_) {
    int tm, tn;
    if (!gemm_tile_xcd(bid, G, k_, 35, tm, tn)) continue;
    gemm128<false>((const bf16_t*)(ws + L0_H), 1024, 16383, (const bf16_t*)(ws + OFF_WIN0), 1024, 4383, 1024, tm * 128, tn * 128, sA, sB,
            [&](f32x4 (&acc)[4][4], int mb, int nb, int ln) { epi_proj0(p, acc, mb, nb, ln); });
  }
  GSYNC();
  }
  DBG_AT(1, dbg_probe_bf16(p, L0_QKRAW, 16384L*1024)) DBG_AT(101, dbg_probe_combo(p)) DBG_AT(102, dbg_probe_bf16(p, L0_KS, 4L*8192*64*4)) DBG_AT(103, dbg_probe_f32(p, L0_IG, 16384L*4*2+16384L*24)) DBG_AT(104, dbg_probe_bf16(p, L0_MVT, 16384L*512*3))
  for (int rep_ = 0; rep_ < REP_P2; ++rep_) {
  for (int it = bid; it < 128 + 2048; it += G) {
    if (it < 128) {
      int ksp = it >> 5, kv = (it >> 4) & 1, bg = (it >> 2) & 3, tm = it & 3;
      const bf16_t* A = (const bf16_t*)(ws + (kv ? L0_VCRAW : L0_KCRAW)) + (long)bg * 8192 * 64 + ksp * 512;
      const bf16_t* B = (const bf16_t*)(ws + (kv ? OFF_WCV : OFF_WCK)) + ksp * 512;
      gemm128<false>(A, 1024, 510, B, 2048, 127, 512, tm * 128, 0, sA, sB,
              [&](f32x4 (&acc)[4][4], int mb, int nb, int ln) { epi_cmp_hidden(p, acc, mb, nb, ln, kv, bg, ksp); });
    } else {
      conv_tile(p, it - 128, smem);
    }
  }
  GSYNC();
  }
  DBG_AT(2, dbg_probe_bf16(p, L0_QC, 16384L*512*3)) DBG_AT(201, dbg_probe_f32(p, L0_HID, 2L*4*512*128))
  for (int rep_ = 0; rep_ < REP_P3; ++rep_) {
  for (int it = bid; it < 512 + 1024; it += G) {
    if (it < 512) mlstm_local(p, it, smem);
    else { const int t_ = opaque_tid(); cmp_finalize(p, (it - 512) * 4 + (t_ >> 6), t_ & 63); }
  }
  GSYNC();
  }
  DBG_AT(3, dbg_probe_f32(p, L0_H, 512L*16384)) DBG_AT(301, dbg_probe_bf16(p, L0_KCMP, 4L*512*64*2)) DBG_AT(302, dbg_probe_f32(p, L0_DN, 512L*128 + 2048))
  for (int rep_ = 0; rep_ < REP_P4; ++rep_) {
#ifdef DUMMY_P4
  mlstm_scan<true>(p, smem);
  GSYNC();
#endif
  mlstm_scan<false>(p, smem);
  GSYNC();
  }
  DBG_AT(4, dbg_probe_f32(p, L0_H, 512L*16384)) DBG_AT(401, dbg_probe_f32(p, L0_DN, 512L*128 + 3072))
  for (int rep_ = 0; rep_ < REP_P5; ++rep_) {
  for (int it = bid; it < 1024 + 1024; it += G) {
    if (it < 1024) {
      int k = it >> 9, i = it & 511;
      int idx = (k & 1) ? (k * 512 + 511 - i) : it;
#ifndef DBG_SKIP_NSA
      for (int r2_ = 0; r2_ < REP_NSA; ++r2_) nsa_tile(p, idx, smem);
#endif
    } else {
#ifndef DBG_SKIP_MOUT
      mlstm_out(p, it - 1024, smem);
#endif
    }
  }
  GSYNC();
  }
  DBG_AT(5, dbg_probe_bf16(p, L0_QKRAW, 16384L*1024))
  for (int rep_ = 0; rep_ < REP_P6; ++rep_) {
#ifdef USE_G256
  for (int k_ = 0; k_ * (G >> 3) < 8 * 8; ++k_) {
    int tm, tn;
    if (!gemm_tile_xcd256(bid, G, k_, 8, tm, tn)) continue;
    gemm256((const bf16_t*)(ws + L0_QKRAW), 1024, (const bf16_t*)(ws + OFF_WOUT0), 1024, 1024, tm * 256, tn * 128, sA, (bf16_t*)(smem + 32768),
            [&](f32x4 (&acc)[4][4], int mb, int nb, int ln) { epi_out_resid(p.x, p.out, acc, mb, nb, ln); });
  }
#else
  for (int k_ = 0; k_ * (G >> 3) < 16 * 8; ++k_) {
    int tm, tn;
    if (!gemm_tile_xcd(bid, G, k_, 8, tm, tn)) continue;
    gemm128<false>((const bf16_t*)(ws + L0_QKRAW), 1024, 16383, (const bf16_t*)(ws + OFF_WOUT0), 1024, 1023, 1024, tm * 128, tn * 128, sA, sB,
            [&](f32x4 (&acc)[4][4], int mb, int nb, int ln) { epi_out_resid(p.x, p.out, acc, mb, nb, ln); });
  }
#endif
  GSYNC();
  }
  DBG_AT(6, (void)0)
  for (int rep_ = 0; rep_ < REP_P7; ++rep_) {
  { const int t_ = opaque_tid(); for (int row = (bid * 4 + (t_ >> 6)) * 2; row < 16384; row += G * 8) rmsnorm_row2(p.out, p.norm_w + 1024, (bf16_t*)(ws + L1_H), row, row + 1, t_ & 63); }
  GSYNC();
  }
  DBG_AT(7, dbg_probe_bf16(p, L1_H, 16384L*1024))
  for (int rep_ = 0; rep_ < REP_P8; ++rep_) {
#ifdef USE_G256
  for (int k_ = 0; k_ * (G >> 3) < 8 * 32; ++k_) {
    int tm, tn;
    if (!gemm_tile_xcd256(bid, G, k_, 32, tm, tn)) continue;
    gemm256((const bf16_t*)(ws + L1_H), 1024, (const bf16_t*)(ws + OFF_WIN1), 1024, 1024, tm * 256, tn * 128, sA, (bf16_t*)(smem + 32768),
            [&](f32x4 (&acc)[4][4], int mb, int nb, int ln) { epi_proj1(p, acc, mb, nb, ln); });
  }
#else
  for (int k_ = 0; k_ * (G >> 3) < 16 * 32; ++k_) {
    int tm, tn;
    if (!gemm_tile_xcd(bid, G, k_, 32, tm, tn)) continue;
    gemm128<false>((const bf16_t*)(ws + L1_H), 1024, 16383, (const bf16_t*)(ws + OFF_WIN1), 1024, 4095, 1024, tm * 128, tn * 128, sA, sB,
            [&](f32x4 (&acc)[4][4], int mb, int nb, int ln) { epi_proj1(p, acc, mb, nb, ln); });
  }
#endif
  GSYNC();
  }
  DBG_AT(8, dbg_probe_bf16(p, L1_FP, 16384L*1024*4))
  for (int rep_ = 0; rep_ < REP_P9; ++rep_) {
  for (int it = bid; it < 2048; it += G) hgrn_local(p, it, smem);
  GSYNC();
  }
  DBG_AT(9, dbg_probe_bf16(p, L1_ST, 2048L*16384))
  for (int rep_ = 0; rep_ < REP_P10; ++rep_) {
#ifdef DUMMY_P10
  hgrn_scan<true>(p);
  GSYNC();
#endif
  hgrn_scan<false>(p);
  GSYNC();
  }
  DBG_AT(10, dbg_probe_bf16(p, L1_ST, 2048L*16384))
  for (int rep_ = 0; rep_ < REP_P11; ++rep_) {
  for (int it = bid; it < 2048; it += G) hgrn_out(p, it, smem);
  GSYNC();
  }
  DBG_AT(11, dbg_probe_bf16(p, L1_H, 16384L*1024))
  for (int rep_ = 0; rep_ < REP_P12; ++rep_) {
#ifdef USE_G256
  for (int k_ = 0; k_ * (G >> 3) < 8 * 8; ++k_) {
    int tm, tn;
    if (!gemm_tile_xcd256(bid, G, k_, 8, tm, tn)) continue;
    gemm256((const bf16_t*)(ws + L1_H), 1024, (const bf16_t*)(ws + OFF_WOUT1), 1024, 1024, tm * 256, tn * 128, sA, (bf16_t*)(smem + 32768),
            [&](f32x4 (&acc)[4][4], int mb, int nb, int ln) { epi_out_resid(p.out, p.out, acc, mb, nb, ln); });
  }
#else
  for (int k_ = 0; k_ * (G >> 3) < 16 * 8; ++k_) {
    int tm, tn;
    if (!gemm_tile_xcd(bid, G, k_, 8, tm, tn)) continue;
    gemm128<false>((const bf16_t*)(ws + L1_H), 1024, 16383, (const bf16_t*)(ws + OFF_WOUT1), 1024, 1023, 1024, tm * 128, tn * 128, sA, sB,
            [&](f32x4 (&acc)[4][4], int mb, int nb, int ln) { epi_out_resid(p.out, p.out, acc, mb, nb, ln); });
  }
#endif
  }
}

extern "C" void kernel_launch(void* const* d_in, const int* in_sizes, int n_in, void* d_out, int out_size, void* d_ws, size_t ws_size,
                              hipStream_t stream) {
  static int grid_blocks = 0;
  if (!grid_blocks) {
    int dev = 0, cus = 0, per_cu = 0;
    (void)hipGetDevice(&dev);
    (void)hipDeviceGetAttribute(&cus, hipDeviceAttributeMultiprocessorCount, dev);
    (void)hipOccupancyMaxActiveBlocksPerMultiprocessor(&per_cu, mega, 256, 0);
    if (per_cu > 2) per_cu = 2;
    if (per_cu < 1) per_cu = 1;
    grid_blocks = cus * per_cu;
  }
  Params p{};
  const float** pf = (const float**)&p;
  for (int i = 0; i < 22; ++i) pf[i] = (const float*)d_in[i];
  p.out = (float*)d_out;
  p.ws = (unsigned char*)d_ws;
  (void)hipMemsetAsync((unsigned char*)d_ws + OFF_BAR, 0, 16384, stream);
  void* args[] = {&p};
  hipError_t e = hipLaunchCooperativeKernel((void*)mega, dim3(grid_blocks), dim3(256), args, 0, stream);
  if (e != hipSuccess) fprintf(stderr, "cooperative launch failed: %s (grid %d)\n", hipGetErrorString(e), grid_blocks);
}
```

```cpp
#include <hip/hip_runtime.h>
#define USE_G256 1
#include <hip/hip_cooperative_groups.h>
#include <stdint.h>
#include <cstdio>
namespace cg = cooperative_groups;

typedef unsigned short bf16_t;
typedef __attribute__((ext_vector_type(8))) short bf16x8;
typedef __attribute__((ext_vector_type(4))) float f32x4;
typedef __attribute__((ext_vector_type(4))) unsigned int u32x4;

#define DEVI __device__ __forceinline__
#define EPSF 1e-6f
#define LDT 72
#define SLD 68
#define NEGS (-1e30f)
#define LAUNDER(ptr) asm volatile("" : "+s"(ptr))

struct Params {
  const float* x; const float* norm_w; const float* ev_w_in; const float* ev_b_in; const float* f_bias;
  const float* conv_w; const float* conv_b; const float* m_hn; const float* q_norm; const float* k_norm;
  const float* ck_pos; const float* ck_w1; const float* ck_w2; const float* cv_pos; const float* cv_w1; const float* cv_w2;
  const float* ev_w_out; const float* od_w_in; const float* od_b_in; const float* lb_logits; const float* h_hn; const float* od_w_out;
  float* out; unsigned char* ws;
};

constexpr size_t MiB = 1048576;
constexpr size_t OFF_WIN0 = 0;
constexpr size_t OFF_WOUT0 = OFF_WIN0 + 4480ull * 1024 * 2;
constexpr size_t OFF_WIN1 = OFF_WOUT0 + 2 * MiB;
constexpr size_t OFF_WOUT1 = OFF_WIN1 + 8 * MiB;
constexpr size_t OFF_WCK = OFF_WOUT1 + 2 * MiB;
constexpr size_t OFF_WCV = OFF_WCK + 512 * 1024;
constexpr size_t OFF_ROPE = OFF_WCV + 512 * 1024;
constexpr size_t OFF_PB = OFF_ROPE + 512 * 1024;
constexpr size_t OFF_LB = OFF_PB + 1024;
constexpr size_t OFF_BAR = OFF_LB + 4096;
constexpr size_t OFF_BASE = 24 * MiB;
constexpr size_t L0_H = OFF_BASE;
constexpr size_t L0_QKRAW = L0_H + 32 * MiB;
constexpr size_t L0_QC = L0_QKRAW + 32 * MiB;
constexpr size_t L0_KC = L0_QC + 16 * MiB;
constexpr size_t L0_KCT = L0_KC + 16 * MiB;
constexpr size_t L0_MVT = L0_KCT + 16 * MiB;
constexpr size_t L0_MO = L0_MVT + 16 * MiB;
constexpr size_t L0_MZ = L0_MO + 16 * MiB;
constexpr size_t L0_QN = L0_MZ + 16 * MiB;
constexpr size_t L0_NZ = L0_QN + 16 * MiB;
constexpr size_t L0_KCRAW = L0_NZ + 16 * MiB;
constexpr size_t L0_VCRAW = L0_KCRAW + 4 * MiB;
constexpr size_t L0_KS = L0_VCRAW + 4 * MiB;
constexpr size_t L0_KW = L0_KS + 4 * MiB;
constexpr size_t L0_VST = L0_KW + 4 * MiB;
constexpr size_t L0_VWT = L0_VST + 4 * MiB;
constexpr size_t L0_HID = L0_VWT + 4 * MiB;
constexpr size_t L0_KCMP = L0_HID + 2 * MiB;
constexpr size_t L0_VCMPT = L0_KCMP + 256 * 1024;
constexpr size_t L0_IG = L0_VCMPT + 256 * 1024;
constexpr size_t L0_LOGF = L0_IG + 256 * 1024;
constexpr size_t L0_GATES = L0_LOGF + 256 * 1024;
constexpr size_t L0_DN = L0_GATES + 1536 * 1024;
constexpr size_t L0_BL = L0_DN + 256 * 1024;
constexpr size_t L0_MLOC = L0_BL + 4096;
constexpr size_t L0_MIN = L0_MLOC + 4096;
constexpr size_t L0_HIDP = L0_MIN + 4096;
constexpr size_t L0_END = L0_HIDP + 8 * MiB;
static_assert(L0_END <= 256 * MiB, "ws overflow L0");
constexpr size_t L1_H = OFF_BASE;
constexpr size_t L1_FP = L1_H + 32 * MiB;
constexpr size_t L1_Q = L1_FP + 32 * MiB;
constexpr size_t L1_VT = L1_Q + 32 * MiB;
constexpr size_t L1_Z = L1_VT + 32 * MiB;
constexpr size_t L1_ST = L1_Z + 32 * MiB;
constexpr size_t L1_BL = L1_ST + 64 * MiB;
constexpr size_t L1_END = L1_BL + 1 * MiB;
static_assert(L1_END <= 256 * MiB, "ws overflow L1");

DEVI int opaque_tid() { int t = threadIdx.x; asm volatile("" : "+v"(t)); return t; }
typedef __bf16 bf16v2_t __attribute__((ext_vector_type(2)));
typedef float f32v2_t __attribute__((ext_vector_type(2)));
DEVI bf16_t f2bf(float f) { __bf16 h = (__bf16)f; return __builtin_bit_cast(unsigned short, h); }
DEVI float bf2f(bf16_t b) { return __uint_as_float(((unsigned)b) << 16); }
DEVI unsigned pack2(float a, float b) { f32v2_t f = {a, b}; bf16v2_t h = __builtin_convertvector(f, bf16v2_t); return __builtin_bit_cast(unsigned, h); }
DEVI float lo2f(unsigned u) { return __uint_as_float(u << 16); }
DEVI float hi2f(unsigned u) { return __uint_as_float(u & 0xffff0000u); }
DEVI float sigm(float x) { return __builtin_amdgcn_rcpf(1.f + __expf(-x)); }
DEVI float siluf(float x) { return x * sigm(x); }
DEVI float wave_sum(float v) { for (int o = 32; o > 0; o >>= 1) v += __shfl_xor(v, o); return v; }
DEVI float grp16_sum(float v) { v += __shfl_xor(v, 1); v += __shfl_xor(v, 2); v += __shfl_xor(v, 4); v += __shfl_xor(v, 8); return v; }

DEVI void wave_scan_sum128(float& a, float& b, int lane) {
  float t = a + b;
  float s = t;
#pragma unroll
  for (int o = 1; o < 64; o <<= 1) { float u = __shfl_up(s, o); if (lane >= o) s += u; }
  const float excl = s - t;
  a = excl + a;
  b = a + b;
}
DEVI void wave_scan_max128(float& a, float& b, int lane) {
  float t = fmaxf(a, b);
  float s = t;
#pragma unroll
  for (int o = 1; o < 64; o <<= 1) { float u = __shfl_up(s, o); if (lane >= o) s = fmaxf(s, u); }
  float prev = __shfl_up(s, 1);
  if (lane == 0) prev = -3.0e38f;
  a = fmaxf(prev, a);
  b = fmaxf(a, b);
}
DEVI float wave_max(float v) { for (int o = 32; o > 0; o >>= 1) v = fmaxf(v, __shfl_xor(v, o)); return v; }
DEVI int oldcol(int n) {
  return n < 2560 ? n : (n < 3840 ? n + 8 : (n < 4352 ? n + 32 : (n < 4360 ? n - 4352 + 2560 : n - 4360 + 3848)));
}

template <int MT, int NTL, int KS>
DEVI void mma_lds(const bf16_t* sA, const bf16_t* sB, f32x4 (&acc)[MT][NTL], int lane, bool neg = false) {
  const int r = lane & 15, q = lane >> 4;
#pragma unroll
  for (int ks = 0; ks < KS; ++ks) {
    bf16x8 a[MT], b[NTL];
#pragma unroll
    for (int mt = 0; mt < MT; ++mt) a[mt] = *(const bf16x8*)(sA + (mt * 16 + r) * LDT + ks * 32 + q * 8);
    if (neg) {
#pragma unroll
      for (int mt = 0; mt < MT; ++mt) a[mt] ^= (short)0x8000;
    }
#pragma unroll
    for (int nt = 0; nt < NTL; ++nt) b[nt] = *(const bf16x8*)(sB + (nt * 16 + r) * LDT + ks * 32 + q * 8);
#pragma unroll
    for (int mt = 0; mt < MT; ++mt)
#pragma unroll
      for (int nt = 0; nt < NTL; ++nt) acc[mt][nt] = __builtin_amdgcn_mfma_f32_16x16x32_bf16(a[mt], b[nt], acc[mt][nt], 0, 0, 0);
  }
}
template <int MT, int NTL, int KS>
DEVI void mma_lds_sw(const bf16_t* sA, const bf16_t* sB, f32x4 (&acc)[MT][NTL], int lane, bool neg = false) {
  const int r = lane & 15, q = lane >> 4;
#pragma unroll
  for (int ks = 0; ks < KS; ++ks) {
    bf16x8 a[MT], b[NTL];
#pragma unroll
    for (int mt = 0; mt < MT; ++mt) a[mt] = *(const bf16x8*)(sA + (mt * 16 + r) * LDT + ks * 32 + q * 8);
    if (neg) {
#pragma unroll
      for (int mt = 0; mt < MT; ++mt) a[mt] ^= (short)0x8000;
    }
#pragma unroll
    for (int nt = 0; nt < NTL; ++nt) b[nt] = *(const bf16x8*)(sB + (nt * 16 + r) * LDT + ks * 32 + q * 8);
#pragma unroll
    for (int mt = 0; mt < MT; ++mt)
#pragma unroll
      for (int nt = 0; nt < NTL; ++nt) acc[mt][nt] = __builtin_amdgcn_mfma_f32_16x16x32_bf16(b[nt], a[mt], acc[mt][nt], 0, 0, 0);
  }
}


template <int MT, int NTL, bool SWAP>
DEVI void mma_swz(const bf16_t* sA, const bf16_t* sB, f32x4 (&acc)[MT][NTL], int lane, bool neg) {
  const int r = lane & 15, q = lane >> 4, r7 = r & 7;
#pragma unroll
  for (int ks = 0; ks < 2; ++ks) {
    bf16x8 a[MT], b[NTL];
    const int co = ((ks * 4 + q) ^ r7) * 8;
#pragma unroll
    for (int mt = 0; mt < MT; ++mt) a[mt] = *(const bf16x8*)(sA + (mt * 16 + r) * 64 + co);
#pragma unroll
    for (int nt = 0; nt < NTL; ++nt) b[nt] = *(const bf16x8*)(sB + (nt * 16 + r) * 64 + co);
    if (neg) {
#pragma unroll
      for (int mt = 0; mt < MT; ++mt) a[mt] ^= (short)0x8000;
    }
#pragma unroll
    for (int mt = 0; mt < MT; ++mt)
#pragma unroll
      for (int nt = 0; nt < NTL; ++nt) {
        if (SWAP) acc[mt][nt] = __builtin_amdgcn_mfma_f32_16x16x32_bf16(b[nt], a[mt], acc[mt][nt], 0, 0, 0);
        else acc[mt][nt] = __builtin_amdgcn_mfma_f32_16x16x32_bf16(a[mt], b[nt], acc[mt][nt], 0, 0, 0);
      }
  }
}

DEVI void load_tile128(bf16_t* s, const bf16_t* g, long ld) {
  const int tid = opaque_tid(), lr = tid >> 3, lk = (tid & 7) * 8;
#pragma unroll
  for (int j = 0; j < 4; ++j) *(uint4*)(s + (lr + 32 * j) * LDT + lk) = *(const uint4*)(g + (long)(lr + 32 * j) * ld + lk);
}
DEVI void load_tile64(bf16_t* s, const bf16_t* g, long ld) {
  const int tid = opaque_tid(), lr = tid >> 3, lk = (tid & 7) * 8;
#pragma unroll
  for (int j = 0; j < 2; ++j) *(uint4*)(s + (lr + 32 * j) * LDT + lk) = *(const uint4*)(g + (long)(lr + 32 * j) * ld + lk);
}

template <bool SWAP, class Epi>
DEVI void gemm128(const bf16_t* A, long lda, int amax, const bf16_t* B, long ldb, int bmax, int K, int m0, int n0,
                  bf16_t* sA, bf16_t* sB, Epi&& epi) {
  const int tid = opaque_tid(), lane = tid & 63, w = tid >> 6, wr = w >> 1, wc = w & 1;
  const int lr = tid >> 3, lk = (tid & 7) * 8;
  const int lsw = (((tid & 7) ^ (lr & 7)) * 8);
  f32x4 acc[4][4];
#pragma unroll
  for (int mt = 0; mt < 4; ++mt)
#pragma unroll
    for (int nt = 0; nt < 4; ++nt) acc[mt][nt] = f32x4{0.f, 0.f, 0.f, 0.f};
  const bf16_t* ap[4];
  const bf16_t* bp[4];
#pragma unroll
  for (int j = 0; j < 4; ++j) {
    int ra = min(m0 + lr + 32 * j, amax);
    ap[j] = A + (long)ra * lda + lk;
    int rb = min(n0 + lr + 32 * j, bmax);
    bp[j] = B + (long)rb * ldb + lk;
  }
#ifndef GEMM_PASSES
#define GEMM_PASSES 1
#endif
  for (int pass_ = 0; pass_ < GEMM_PASSES; ++pass_) {
  u32x4 va0, va1, va2, va3, vb0, vb1, vb2, vb3;
  va0 = *(const u32x4*)(ap[0]); va1 = *(const u32x4*)(ap[1]); va2 = *(const u32x4*)(ap[2]); va3 = *(const u32x4*)(ap[3]);
  vb0 = *(const u32x4*)(bp[0]); vb1 = *(const u32x4*)(bp[1]); vb2 = *(const u32x4*)(bp[2]); vb3 = *(const u32x4*)(bp[3]);
  const int KT = K >> 6;
  *(u32x4*)(sA + (lr + 0) * 64 + lsw) = va0; *(u32x4*)(sA + (lr + 32) * 64 + lsw) = va1;
  *(u32x4*)(sA + (lr + 64) * 64 + lsw) = va2; *(u32x4*)(sA + (lr + 96) * 64 + lsw) = va3;
  *(u32x4*)(sB + (lr + 0) * 64 + lsw) = vb0; *(u32x4*)(sB + (lr + 32) * 64 + lsw) = vb1;
  *(u32x4*)(sB + (lr + 64) * 64 + lsw) = vb2; *(u32x4*)(sB + (lr + 96) * 64 + lsw) = vb3;
  if (KT > 1) {
    va0 = *(const u32x4*)(ap[0] + 64); va1 = *(const u32x4*)(ap[1] + 64); va2 = *(const u32x4*)(ap[2] + 64); va3 = *(const u32x4*)(ap[3] + 64);
    vb0 = *(const u32x4*)(bp[0] + 64); vb1 = *(const u32x4*)(bp[1] + 64); vb2 = *(const u32x4*)(bp[2] + 64); vb3 = *(const u32x4*)(bp[3] + 64);
  }
  __syncthreads();
  for (int kt = 0; kt < KT; ++kt) {
    const int st = (kt & 1) * 16384;
    const int sn = ((kt + 1) & 1) * 16384;
    if (kt + 1 < KT) {
      *(u32x4*)(sA + sn + (lr + 0) * 64 + lsw) = va0; *(u32x4*)(sA + sn + (lr + 32) * 64 + lsw) = va1;
      *(u32x4*)(sA + sn + (lr + 64) * 64 + lsw) = va2; *(u32x4*)(sA + sn + (lr + 96) * 64 + lsw) = va3;
      *(u32x4*)(sB + sn + (lr + 0) * 64 + lsw) = vb0; *(u32x4*)(sB + sn + (lr + 32) * 64 + lsw) = vb1;
      *(u32x4*)(sB + sn + (lr + 64) * 64 + lsw) = vb2; *(u32x4*)(sB + sn + (lr + 96) * 64 + lsw) = vb3;
    }
    if (kt + 2 < KT) {
      const int ko = (kt + 2) * 64;
      va0 = *(const u32x4*)(ap[0] + ko); va1 = *(const u32x4*)(ap[1] + ko); va2 = *(const u32x4*)(ap[2] + ko); va3 = *(const u32x4*)(ap[3] + ko);
      vb0 = *(const u32x4*)(bp[0] + ko); vb1 = *(const u32x4*)(bp[1] + ko); vb2 = *(const u32x4*)(bp[2] + ko); vb3 = *(const u32x4*)(bp[3] + ko);
    }
    __builtin_amdgcn_sched_barrier(0);
    __builtin_amdgcn_s_setprio(2);
    mma_swz<4, 4, SWAP>(sA + st + wr * 64 * 64, sB + st + wc * 64 * 64, acc, lane, (pass_ & 1) != 0);
    __builtin_amdgcn_s_setprio(0);
    __syncthreads();
  }
  }
  epi(acc, m0 + wr * 64, n0 + wc * 64, lane);
}


DEVI bool gemm_tile_xcd(int bid, int G, int k, int NTN, int& tm, int& tn) {
  const int x = bid & 7, per = G >> 3;
  const int u = (bid >> 3) + per * k;
  const int full_groups = NTN >> 3, rem = NTN & 7;
  const int n_full = full_groups * 2 * 64;
  if (u < n_full) {
    const int sb = u >> 6, wi = u & 63;
    const int tg = sb >> 1, th = sb & 1;
    tm = x * 16 + th * 8 + (wi >> 3);
    tn = tg * 8 + (wi & 7);
    return true;
  }
  const int v = u - n_full;
  if (v >= 16 * rem) return false;
  tm = x * 16 + v / rem;
  tn = full_groups * 8 + v % rem;
  return true;
}


template <class Epi>
DEVI void gemm256(const bf16_t* A, long lda, const bf16_t* B, long ldb, int K, int m0, int n0, bf16_t* sA, bf16_t* sB, Epi&& epi) {
  const int tid = opaque_tid(), lane = tid & 63, w = tid >> 6, wr = w >> 1, wc = w & 1;
  const int lr = tid >> 3, lk = (tid & 7) * 8;
  const int lsw = (((tid & 7) ^ (lr & 7)) * 8);
  const int r = lane & 15, q = lane >> 4, r7 = r & 7;
  f32x4 acc[2][4][4];
#pragma unroll
  for (int hh = 0; hh < 2; ++hh)
#pragma unroll
    for (int mt = 0; mt < 4; ++mt)
#pragma unroll
      for (int nt = 0; nt < 4; ++nt) acc[hh][mt][nt] = f32x4{0.f, 0.f, 0.f, 0.f};
  const bf16_t* abase = A + (long)(m0 + lr) * lda + lk;
  const bf16_t* bbase = B + (long)(n0 + lr) * ldb + lk;
  u32x4 va[8], vb[4];
#pragma unroll
  for (int j = 0; j < 8; ++j) va[j] = *(const u32x4*)(abase + (long)(32 * j) * lda);
#pragma unroll
  for (int j = 0; j < 4; ++j) vb[j] = *(const u32x4*)(bbase + (long)(32 * j) * ldb);
  const int KT = K >> 6;
  for (int kt = 0; kt < KT; ++kt) {
#pragma unroll
    for (int j = 0; j < 8; ++j) *(u32x4*)(sA + (lr + 32 * j) * 64 + lsw) = va[j];
#pragma unroll
    for (int j = 0; j < 4; ++j) *(u32x4*)(sB + (lr + 32 * j) * 64 + lsw) = vb[j];
    __syncthreads();
    if (kt + 1 < KT) {
      const int ko = (kt + 1) * 64;
#pragma unroll
      for (int j = 0; j < 8; ++j) va[j] = *(const u32x4*)(abase + (long)(32 * j) * lda + ko);
#pragma unroll
      for (int j = 0; j < 4; ++j) vb[j] = *(const u32x4*)(bbase + (long)(32 * j) * ldb + ko);
    }
    __builtin_amdgcn_sched_barrier(0);
    __builtin_amdgcn_s_setprio(2);
#pragma unroll
    for (int ks = 0; ks < 2; ++ks) {
      const int co = ((ks * 4 + q) ^ r7) * 8;
      bf16x8 b[4];
#pragma unroll
      for (int nt = 0; nt < 4; ++nt) b[nt] = *(const bf16x8*)(sB + (wc * 64 + nt * 16 + r) * 64 + co);
#pragma unroll
      for (int hh = 0; hh < 2; ++hh) {
        bf16x8 a[4];
#pragma unroll
        for (int mt = 0; mt < 4; ++mt) a[mt] = *(const bf16x8*)(sA + (wr * 128 + hh * 64 + mt * 16 + r) * 64 + co);
#pragma unroll
        for (int mt = 0; mt < 4; ++mt)
#pragma unroll
          for (int nt = 0; nt < 4; ++nt) acc[hh][mt][nt] = __builtin_amdgcn_mfma_f32_16x16x32_bf16(a[mt], b[nt], acc[hh][mt][nt], 0, 0, 0);
      }
    }
    __builtin_amdgcn_s_setprio(0);
    __syncthreads();
  }
  epi(acc[0], m0 + wr * 128, n0 + wc * 64, lane);
  epi(acc[1], m0 + wr * 128 + 64, n0 + wc * 64, lane);
}

DEVI bool gemm_tile_xcd256(int bid, int G, int k, int NTN, int& tm, int& tn) {
  const int x = bid & 7, per = G >> 3;
  const int u = (bid >> 3) + per * k;
  if (u >= 8 * NTN) return false;
  const int tg = u >> 6, wi = u & 63;
  tm = x * 8 + (wi >> 3);
  tn = tg * 8 + (wi & 7);
  return true;
}

DEVI void transpose_tile(const float* src, int N, int ldsrc, bf16_t* dst, int K, int ktile, int ntile, bool perm, float* sT) {
  const int tid = opaque_tid();
  const int k0 = ktile * 64, n0 = ntile * 64;
#pragma unroll
  for (int j = 0; j < 4; ++j) {
    int idx = tid + 256 * j;
    int kk = idx >> 4, n4 = (idx & 15) * 4;
    int n = n0 + n4;
    float4 v = make_float4(0.f, 0.f, 0.f, 0.f);
    if (n < N) { int oc = perm ? oldcol(n) : n; v = *(const float4*)(src + (long)(k0 + kk) * ldsrc + oc); }
    sT[kk * 65 + n4 + 0] = v.x; sT[kk * 65 + n4 + 1] = v.y; sT[kk * 65 + n4 + 2] = v.z; sT[kk * 65 + n4 + 3] = v.w;
  }
  __syncthreads();
#pragma unroll
  for (int j = 0; j < 2; ++j) {
    int idx = tid + 256 * j;
    int nn = idx >> 3, kc = (idx & 7) * 8;
    if (n0 + nn < N) {
      uint4 o;
      o.x = pack2(sT[(kc + 0) * 65 + nn], sT[(kc + 1) * 65 + nn]);
      o.y = pack2(sT[(kc + 2) * 65 + nn], sT[(kc + 3) * 65 + nn]);
      o.z = pack2(sT[(kc + 4) * 65 + nn], sT[(kc + 5) * 65 + nn]);
      o.w = pack2(sT[(kc + 6) * 65 + nn], sT[(kc + 7) * 65 + nn]);
      *(uint4*)(dst + (long)(n0 + nn) * K + k0 + kc) = o;
    }
  }
  __syncthreads();
}

DEVI void rmsnorm_row2(const float* X, const float* w, bf16_t* H, int row0, int row1, int lane) {
  const float4* xa = (const float4*)(X + (long)row0 * 1024);
  const float4* xb = (const float4*)(X + (long)row1 * 1024);
  float4 va[4], vb[4], ww[4];
#pragma unroll
  for (int j = 0; j < 4; ++j) { va[j] = xa[lane + 64 * j]; vb[j] = xb[lane + 64 * j]; ww[j] = ((const float4*)w)[lane + 64 * j]; }
  float sa = 0.f, sb = 0.f;
#pragma unroll
  for (int j = 0; j < 4; ++j) {
    sa += va[j].x * va[j].x + va[j].y * va[j].y + va[j].z * va[j].z + va[j].w * va[j].w;
    sb += vb[j].x * vb[j].x + vb[j].y * vb[j].y + vb[j].z * vb[j].z + vb[j].w * vb[j].w;
  }
  sa = wave_sum(sa); sb = wave_sum(sb);
  const float ra = rsqrtf(sa * (1.f / 1024.f) + EPSF), rb = rsqrtf(sb * (1.f / 1024.f) + EPSF);
#pragma unroll
  for (int j = 0; j < 4; ++j) {
    uint2 o;
    o.x = pack2(va[j].x * ra * ww[j].x, va[j].y * ra * ww[j].y);
    o.y = pack2(va[j].z * ra * ww[j].z, va[j].w * ra * ww[j].w);
    *(uint2*)(H + (long)row0 * 1024 + (lane + 64 * j) * 4) = o;
    o.x = pack2(vb[j].x * rb * ww[j].x, vb[j].y * rb * ww[j].y);
    o.y = pack2(vb[j].z * rb * ww[j].z, vb[j].w * rb * ww[j].w);
    *(uint2*)(H + (long)row1 * 1024 + (lane + 64 * j) * 4) = o;
  }
}

DEVI void phase0(const Params& p, unsigned char* smem) {
  const int G = gridDim.x, bid = blockIdx.x, tid = threadIdx.x, lane = tid & 63, w = tid >> 6;
  unsigned char* ws = p.ws;
  float* sT = (float*)smem;
  for (int it = bid; it < 69 * 16; it += G) transpose_tile(p.ev_w_in, 4384, 4384, (bf16_t*)(ws + OFF_WIN0), 1024, it / 69, it % 69, true, sT);
  for (int it = bid; it < 16 * 16; it += G) transpose_tile(p.ev_w_out, 1024, 1024, (bf16_t*)(ws + OFF_WOUT0), 1024, it / 16, it % 16, false, sT);
  for (int it = bid; it < 64 * 16; it += G) transpose_tile(p.od_w_in, 4096, 4096, (bf16_t*)(ws + OFF_WIN1), 1024, it / 64, it % 64, false, sT);
  for (int it = bid; it < 16 * 16; it += G) transpose_tile(p.od_w_out, 1024, 1024, (bf16_t*)(ws + OFF_WOUT1), 1024, it / 16, it % 16, false, sT);
  for (int it = bid; it < 2 * 32; it += G) transpose_tile(p.ck_w1, 128, 128, (bf16_t*)(ws + OFF_WCK), 2048, it / 2, it % 2, false, sT);
  for (int it = bid; it < 2 * 32; it += G) transpose_tile(p.cv_w1, 128, 128, (bf16_t*)(ws + OFF_WCV), 2048, it / 2, it % 2, false, sT);
  for (int row = (bid * 4 + w) * 2; row < 16384; row += G * 8) rmsnorm_row2(p.x, p.norm_w, (bf16_t*)(ws + L0_H), row, row + 1, lane);
  for (int idx = bid * 256 + tid; idx < 8192 * 8; idx += G * 256) {
    int t = idx >> 3, i = idx & 7;
    float invf = powf(500000.0f, -(float)i / 8.0f);
    float ang = (float)t * invf;
    double a = (double)ang;
    float2 cs;
    cs.x = (float)cos(a);
    cs.y = (float)sin(a);
    ((float2*)(ws + OFF_ROPE))[idx] = cs;
  }
  for (int o = bid * 4 + w; o < 256; o += G * 4) {
    int kv = o >> 7, j = o & 127;
    const float* pos = kv ? p.cv_pos : p.ck_pos;
    const float* w1 = kv ? p.cv_w1 : p.ck_w1;
    float sacc_ = 0.f;
#pragma unroll 8
    for (int i = lane; i < 2048; i += 64) sacc_ += pos[i] * w1[i * 128 + j];
    sacc_ = wave_sum(sacc_);
    if (lane == 0) ((float*)(ws + OFF_PB))[o] = sacc_;
  }
  if (bid == G - 2 || G < 2) {
    for (int c = tid; c < 1024; c += 256) {
      float l0 = p.lb_logits[c], l1 = p.lb_logits[1024 + c];
      ((float*)(ws + OFF_LB))[c] = 1.f / (1.f + expf(l1 - l0));
    }
  }
}

template <int MODE>
DEVI void store_rm(bf16_t* dst, int ld, int colbase, f32x4 (&acc)[4][4], const float* bias, int mb, int lane) {
  const int r = lane & 15, q = lane >> 4;
#pragma unroll
  for (int mt = 0; mt < 4; ++mt)
#pragma unroll
    for (int i = 0; i < 4; ++i) {
      long row = mb + mt * 16 + q * 4 + i;
#pragma unroll
      for (int nt = 0; nt < 4; ++nt) {
        float v = acc[mt][nt][i] + bias[nt];
        if (MODE == 1) v = sigm(v);
        if (MODE == 2) v = siluf(v);
        dst[row * ld + colbase + nt * 16 + r] = f2bf(v);
      }
    }
}
template <int MODE>
DEVI void store_T(bf16_t* dst, int bgrp, int F, int featoff, f32x4 (&acc)[4][4], const float* bias, int tl0, int lane) {
  const int r = lane & 15, q = lane >> 4;
#pragma unroll
  for (int mt = 0; mt < 4; ++mt)
#pragma unroll
    for (int nt = 0; nt < 4; ++nt) {
      int t = tl0 + mt * 16 + q * 4;
      float b = bias[nt];
      uint2 o;
      o.x = pack2(acc[mt][nt][0] + b, acc[mt][nt][1] + b);
      o.y = pack2(acc[mt][nt][2] + b, acc[mt][nt][3] + b);
      *(uint2*)(dst + (((long)bgrp * 128 + (t >> 6)) * F + featoff + nt * 16 + r) * 64 + (t & 63)) = o;
    }
}
DEVI void norm_rope_store(bf16_t* dst, long rowbase, int ld, int colbase, f32x4 (&acc)[4][4], const float* bias, const float* nw,
                          float scale, const float2* rope, int mb, int lane) {
  const int r = lane & 15, q = lane >> 4;
  float wv[4];
#pragma unroll
  for (int nt = 0; nt < 4; ++nt) wv[nt] = nw[nt * 16 + r];
  float2 csv[4][4];
#pragma unroll
  for (int mt = 0; mt < 4; ++mt)
#pragma unroll
    for (int i = 0; i < 4; ++i) csv[mt][i] = rope[((mb + mt * 16 + q * 4 + i) & 8191) * 8 + (r & 7)];
#pragma unroll
  for (int mt = 0; mt < 4; ++mt)
#pragma unroll
    for (int i = 0; i < 4; ++i) {
      int row = mb + mt * 16 + q * 4 + i;
      int t = row & 8191;
      float v[4];
      float ss = 0.f;
#pragma unroll
      for (int nt = 0; nt < 4; ++nt) { v[nt] = acc[mt][nt][i] + bias[nt]; ss += v[nt] * v[nt]; }
      ss = grp16_sum(ss);
      float rinv = rsqrtf(ss * (1.f / 64.f) + EPSF);
#pragma unroll
      for (int nt = 0; nt < 4; ++nt) v[nt] = v[nt] * rinv * wv[nt];
      float partner = __shfl_xor(v[0], 8);
      float2 cs = csv[mt][i];
      float x1 = (r < 8) ? v[0] : partner, x2 = (r < 8) ? partner : v[0];
      v[0] = (r < 8) ? (x1 * cs.x - x2 * cs.y) : (x1 * cs.y + x2 * cs.x);
#pragma unroll
      for (int nt = 0; nt < 4; ++nt) dst[(rowbase + t) * ld + colbase + nt * 16 + r] = f2bf(v[nt] * scale);
    }
}

DEVI void epi_proj0(const Params& p, f32x4 (&acc)[4][4], int mb, int nb, int lane) {
  if (nb >= 4384) return;
  unsigned char* ws = p.ws;
  const int r = lane & 15, q = lane >> 4;
  float bias[4];
#pragma unroll
  for (int nt = 0; nt < 4; ++nt) { int n = nb + nt * 16 + r; bias[nt] = (n < 4384) ? p.ev_b_in[oldcol(n)] : 0.f; }
  const int b = mb >> 13;
  const int tl0 = mb & 8191;
  const float2* rope = (const float2*)(ws + OFF_ROPE);
  if (nb < 1024) {
    store_rm<0>((bf16_t*)(ws + L0_QKRAW), 1024, nb, acc, bias, mb, lane);
  } else if (nb < 1536) {
    store_T<0>((bf16_t*)(ws + L0_MVT), b * 4 + ((nb - 1024) >> 7), 128, (nb - 1024) & 127, acc, bias, tl0, lane);
  } else if (nb < 2048) {
    store_rm<1>((bf16_t*)(ws + L0_MO), 512, nb - 1536, acc, bias, mb, lane);
  } else if (nb < 2560) {
    store_rm<2>((bf16_t*)(ws + L0_MZ), 512, nb - 2048, acc, bias, mb, lane);
  } else if (nb < 3072) {
    int head = (nb - 2560) >> 6, g = head >> 2, rr = head & 3;
    norm_rope_store((bf16_t*)(ws + L0_QN), (long)(b * 2 + g) * 8192, 256, rr * 64, acc, bias, p.q_norm, 0.125f * 1.4426950408889634f, rope, mb, lane);
  } else if (nb < 3328) {
    int g = ((nb - 3072) >> 6) & 1;
    bf16_t* dst = (bf16_t*)(ws + (nb < 3200 ? L0_KCRAW : L0_VCRAW));
    const long rowbase = (long)(b * 2 + g) * 8192;
#pragma unroll
    for (int mt = 0; mt < 4; ++mt)
#pragma unroll
      for (int i = 0; i < 4; ++i) {
        int t = (mb + mt * 16 + q * 4 + i) & 8191;
#pragma unroll
        for (int nt = 0; nt < 4; ++nt) dst[(rowbase + t) * 64 + nt * 16 + r] = f2bf(acc[mt][nt][i] + bias[nt]);
      }
  } else if (nb < 3456) {
    int g = (nb - 3328) >> 6;
    norm_rope_store((bf16_t*)(ws + L0_KS), (long)(b * 2 + g) * 8192, 64, 0, acc, bias, p.k_norm + 64, 1.f, rope, mb, lane);
  } else if (nb < 3584) {
    store_T<0>((bf16_t*)(ws + L0_VST), b * 2 + ((nb - 3456) >> 6), 64, 0, acc, bias, tl0, lane);
  } else if (nb < 3712) {
    int g = (nb - 3584) >> 6;
    norm_rope_store((bf16_t*)(ws + L0_KW), (long)(b * 2 + g) * 8192, 64, 0, acc, bias, p.k_norm + 128, 1.f, rope, mb, lane);
  } else if (nb < 3840) {
    store_T<0>((bf16_t*)(ws + L0_VWT), b * 2 + ((nb - 3712) >> 6), 64, 0, acc, bias, tl0, lane);
  } else if (nb < 4352) {
    store_rm<2>((bf16_t*)(ws + L0_NZ), 512, nb - 3840, acc, bias, mb, lane);
  } else {
    float* IG = (float*)(ws + L0_IG);
    float* LF = (float*)(ws + L0_LOGF);
    float* GT = (float*)(ws + L0_GATES);
#pragma unroll
    for (int mt = 0; mt < 4; ++mt)
#pragma unroll
      for (int i = 0; i < 4; ++i) {
        long row = mb + mt * 16 + q * 4 + i;
#pragma unroll
        for (int nt = 0; nt < 2; ++nt) {
          int c = nt * 16 + r;
          float v = acc[mt][nt][i] + bias[nt];
          if (c < 4) IG[row * 4 + c] = v;
          else if (c < 8) { float xx = v + p.f_bias[c - 4]; LF[row * 4 + c - 4] = fminf(xx, 0.f) - log1pf(__expf(-fabsf(xx))); }
          else GT[row * 24 + c - 8] = sigm(v);
        }
      }
  }
}

DEVI void epi_cmp_hidden(const Params& p, f32x4 (&acc)[4][4], int mb, int nb, int lane, int kv, int bg, int ksp) {
  const int r = lane & 15, q = lane >> 4;
  float* hid = (float*)(p.ws + L0_HIDP) + ((long)((ksp * 2 + kv) * 4 + bg) * 512) * 128;
#pragma unroll
  for (int mt = 0; mt < 4; ++mt)
#pragma unroll
    for (int i = 0; i < 4; ++i) {
      int row = mb + mt * 16 + q * 4 + i;
#pragma unroll
      for (int nt = 0; nt < 4; ++nt) hid[(long)row * 128 + nb + nt * 16 + r] = acc[mt][nt][i];
    }
}

DEVI void epi_out_resid(const float* resid, float* out, f32x4 (&acc)[4][4], int mb, int nb, int lane) {
  const int r = lane & 15, q = lane >> 4;
#pragma unroll
  for (int mt = 0; mt < 4; ++mt) {
    float rv[4][4];
#pragma unroll
    for (int i = 0; i < 4; ++i)
#pragma unroll
      for (int nt = 0; nt < 4; ++nt) rv[i][nt] = resid[(long)(mb + mt * 16 + q * 4 + i) * 1024 + nb + nt * 16 + r];
#pragma unroll
    for (int i = 0; i < 4; ++i)
#pragma unroll
      for (int nt = 0; nt < 4; ++nt) out[(long)(mb + mt * 16 + q * 4 + i) * 1024 + nb + nt * 16 + r] = rv[i][nt] + acc[mt][nt][i];
  }
}

DEVI void epi_proj1(const Params& p, f32x4 (&acc)[4][4], int mb, int nb, int lane) {
  unsigned char* ws = p.ws;
  const int r = lane & 15;
  float bias[4];
#pragma unroll
  for (int nt = 0; nt < 4; ++nt) bias[nt] = p.od_b_in[nb + nt * 16 + r];
  const int b = mb >> 13, tl0 = mb & 8191;
  if (nb < 1024) store_rm<0>((bf16_t*)(ws + L1_FP), 1024, nb, acc, bias, mb, lane);
  else if (nb < 2048) store_T<0>((bf16_t*)(ws + L1_VT), b * 8 + ((nb - 1024) >> 7), 128, (nb - 1024) & 127, acc, bias, tl0, lane);
  else if (nb < 3072) store_rm<2>((bf16_t*)(ws + L1_Q), 1024, nb - 2048, acc, bias, mb, lane);
  else store_rm<2>((bf16_t*)(ws + L1_Z), 1024, nb - 3072, acc, bias, mb, lane);
}

DEVI void conv_tile(const Params& p, int item, unsigned char* smem) {
  const int tid = opaque_tid();
  const int ctile = item & 7, ttile = item >> 3;
  const int t0g = ttile * 64;
  const int b = t0g >> 13, tl0 = t0g & 8191;
  unsigned char* ws = p.ws;
  float* sRaw = (float*)smem;
  bf16_t* sOutT = (bf16_t*)(smem + 67 * 128 * 4);
  const bf16_t* raw = (const bf16_t*)(ws + L0_QKRAW);
  for (int idx = tid; idx < 67 * 16; idx += 256) {
    int rr = idx >> 4, ch = (idx & 15) * 8;
    int tl = tl0 + rr - 3;
    uint4 v = make_uint4(0, 0, 0, 0);
    if (tl >= 0) v = *(const uint4*)(raw + (long)(b * 8192 + tl) * 1024 + ctile * 128 + ch);
    float* d = sRaw + rr * 128 + ch;
    d[0] = lo2f(v.x); d[1] = hi2f(v.x); d[2] = lo2f(v.y); d[3] = hi2f(v.y);
    d[4] = lo2f(v.z); d[5] = hi2f(v.z); d[6] = lo2f(v.w); d[7] = hi2f(v.w);
  }
  __syncthreads();
  const int c = tid & 127, th = tid >> 7;
  const int cg_ = ctile * 128 + c;
  const float w0 = p.conv_w[cg_], w1 = p.conv_w[1024 + cg_], w2 = p.conv_w[2048 + cg_], w3 = p.conv_w[3072 + cg_];
  const float cb = p.conv_b[cg_];
  const bool isk = ctile >= 4;
  bf16_t* dst = (bf16_t*)(ws + (isk ? L0_KC : L0_QC));
  const int cc = isk ? cg_ - 512 : cg_;
  const float sc = isk ? 0.08838834764831845f : 1.f;
  for (int t = th * 32; t < th * 32 + 32; ++t) {
    float a = cb + w0 * sRaw[t * 128 + c] + w1 * sRaw[(t + 1) * 128 + c] + w2 * sRaw[(t + 2) * 128 + c] + w3 * sRaw[(t + 3) * 128 + c];
    bf16_t o = f2bf(siluf(a) * sc);
    dst[(long)(t0g + t) * 512 + cc] = o;
    sOutT[c * LDT + t] = o;
  }
  __syncthreads();
  if (isk) {
    bf16_t* kct = (bf16_t*)(ws + L0_KCT);
#pragma unroll
    for (int j = 0; j < 4; ++j) {
      int idx = tid + 256 * j;
      int cr = idx >> 3, tc = (idx & 7) * 8;
      *(uint4*)(kct + ((((long)(b * 4 + (ctile - 4)) * 128 + (tl0 >> 6)) * 128 + cr) * 64) + tc) = *(const uint4*)(sOutT + cr * LDT + tc);
    }
  }
  __syncthreads();
}

DEVI void cmp_finalize(const Params& p, int task, int lane) {
  const int n = task & 511, bg = (task >> 9) & 3, kv = task >> 11;
  unsigned char* ws = p.ws;
  bf16_t* KCMP = (bf16_t*)(ws + L0_KCMP);
  bf16_t* VCMPT = (bf16_t*)(ws + L0_VCMPT);
  if (n == 511) {
    if (kv == 0) KCMP[((long)bg * 512 + 511) * 64 + lane] = 0;
    else VCMPT[((long)bg * 64 + lane) * 512 + 511] = 0;
    return;
  }
  const float* hid = (const float*)(ws + L0_HIDP) + ((long)(kv * 4 + bg) * 512 + n) * 128;
  const float* pbv = (const float*)(ws + OFF_PB) + kv * 128;
  const float* w2 = kv ? p.cv_w2 : p.ck_w2;
  float g0, g1;
  {
    float x0 = ((hid[lane] + hid[lane + 524288]) + (hid[lane + 2 * 524288] + hid[lane + 3 * 524288])) + pbv[lane];
    float x1 = ((hid[lane + 64] + hid[lane + 64 + 524288]) + (hid[lane + 64 + 2 * 524288] + hid[lane + 64 + 3 * 524288])) + pbv[lane + 64];
    g0 = 0.5f * x0 * (1.f + tanhf(0.7978845608028654f * (x0 + 0.044715f * x0 * x0 * x0)));
    g1 = 0.5f * x1 * (1.f + tanhf(0.7978845608028654f * (x1 + 0.044715f * x1 * x1 * x1)));
  }
  float a = 0.f;
  for (int j0 = 0; j0 < 64; j0 += 16) {
    float wv[16], wu[16];
#pragma unroll
    for (int k = 0; k < 16; ++k) { wv[k] = w2[(j0 + k) * 64 + lane]; wu[k] = w2[(64 + j0 + k) * 64 + lane]; }
#pragma unroll
    for (int k = 0; k < 16; ++k) a += __shfl(g0, j0 + k) * wv[k] + __shfl(g1, j0 + k) * wu[k];
  }
  if (kv == 0) {
    float ss = wave_sum(a * a);
    float rinv = rsqrtf(ss * (1.f / 64.f) + EPSF);
    float v = a * rinv * p.k_norm[lane];
    float partner = __shfl_xor(v, 8);
    int pos = 16 * n + 31;
    float2 cs = ((const float2*)(ws + OFF_ROPE))[pos * 8 + (lane & 7)];
    float o = v;
    if (lane < 8) o = v * cs.x - partner * cs.y;
    else if (lane < 16) o = partner * cs.y + v * cs.x;
    KCMP[((long)bg * 512 + n) * 64 + lane] = f2bf(o);
  } else {
    VCMPT[((long)bg * 64 + lane) * 512 + n] = f2bf(a);
  }
}

DEVI void mlstm_local(const Params& p, int unit, unsigned char* smem) {
  const int tid = opaque_tid(), lane = tid & 63, w = tid >> 6, wr = w >> 1, wc = w & 1;
  const int bh = unit >> 6, c = unit & 63, b = bh >> 2, h = bh & 3, t0 = c * 128;
  const long R0 = (long)b * 8192 + t0;
  unsigned char* ws = p.ws;
  bf16_t* sA = (bf16_t*)smem;
  bf16_t* sB = (bf16_t*)(smem + 18432);
  float* sIg = (float*)(smem + 36864);
  float* sLf = sIg + 128;
  float* sW = sLf + 128;
  const float* IG = (const float*)(ws + L0_IG);
  const float* LF = (const float*)(ws + L0_LOGF);
  if (tid < 128) { sIg[tid] = IG[(R0 + tid) * 4 + h]; sLf[tid] = LF[(R0 + tid) * 4 + h]; }
  __syncthreads();
  if (tid < 64) {
    float c0 = sLf[2 * tid], c1 = sLf[2 * tid + 1];
    wave_scan_sum128(c0, c1, tid);
    const float bL = __shfl(c1, 63);
    float d0 = bL - c0 + sIg[2 * tid], d1 = bL - c1 + sIg[2 * tid + 1];
    const float ml = wave_max(fmaxf(d0, d1));
    sW[2 * tid] = __expf(d0 - ml); sW[2 * tid + 1] = __expf(d1 - ml);
    if (tid == 0) { ((float*)(ws + L0_BL))[unit] = bL; ((float*)(ws + L0_MLOC))[unit] = ml; }
  }
  __syncthreads();
  f32x4 acc[4][4];
#pragma unroll
  for (int mt = 0; mt < 4; ++mt)
#pragma unroll
    for (int nt = 0; nt < 4; ++nt) acc[mt][nt] = f32x4{0.f, 0.f, 0.f, 0.f};
  float dn = 0.f;
  const bf16_t* vt = (const bf16_t*)(ws + L0_MVT) + (((long)(b * 4 + h) * 128 + (t0 >> 6)) * 128) * 64;
  const bf16_t* kt_ = (const bf16_t*)(ws + L0_KCT) + (((long)(b * 4 + h) * 128 + (t0 >> 6)) * 128) * 64;
  const int lr = tid >> 3, lk = (tid & 7) * 8;
  for (int kt = 0; kt < 2; ++kt) {
    load_tile128(sA, vt + kt * 8192, 64);
#pragma unroll
    for (int j = 0; j < 4; ++j) {
      uint4 v = *(const uint4*)(kt_ + (long)kt * 8192 + (lr + 32 * j) * 64 + lk);
      const float* ww = sW + kt * 64 + lk;
      uint4 o;
      o.x = pack2(lo2f(v.x) * ww[0], hi2f(v.x) * ww[1]);
      o.y = pack2(lo2f(v.y) * ww[2], hi2f(v.y) * ww[3]);
      o.z = pack2(lo2f(v.z) * ww[4], hi2f(v.z) * ww[5]);
      o.w = pack2(lo2f(v.w) * ww[6], hi2f(v.w) * ww[7]);
      *(uint4*)(sB + (lr + 32 * j) * LDT + lk) = o;
    }
    __syncthreads();
    if (tid < 128) {
#pragma unroll 8
      for (int s = 0; s < 64; ++s) dn += bf2f(sB[tid * LDT + s]);
    }
    mma_lds<4, 4, 2>(sA + wr * 64 * LDT, sB + wc * 64 * LDT, acc, lane);
    __syncthreads();
  }
  float* dct = (float*)(ws + L0_H) + (long)unit * 16384;
  const int r = lane & 15, q = lane >> 4;
#pragma unroll
  for (int mt = 0; mt < 4; ++mt)
#pragma unroll
    for (int i = 0; i < 4; ++i) {
      int e = wr * 64 + mt * 16 + q * 4 + i;
#pragma unroll
      for (int nt = 0; nt < 4; ++nt) dct[e * 128 + wc * 64 + nt * 16 + r] = acc[mt][nt][i];
    }
  if (tid < 128) ((float*)(ws + L0_DN))[unit * 128 + tid] = dn;
}

template <bool DUMMY>
DEVI void mlstm_scan(const Params& p, unsigned char* smem) {
  unsigned char* ws = p.ws;
  const float* BL = (const float*)(ws + L0_BL);
  const float* ML = (const float*)(ws + L0_MLOC);
  float* MIN_ = (float*)(ws + L0_MIN);
  float* sDec = (float*)smem;
  float* sWn = sDec + 128;
  const int tid = opaque_tid();
  const int total = 8 * 16384 + 8 * 128;
  for (int base = blockIdx.x * 256; base < total; base += gridDim.x * 256) {
    const int bh0 = (base < 131072) ? (base >> 14) : ((base - 131072) >> 7);
    __syncthreads();
    if (tid < 2) {
      const int bh = bh0 + tid;
      if (bh < 8) {
        float m = 0.f;
        for (int c = 0; c < 64; ++c) {
          const int unit = bh * 64 + c;
          const float bL = BL[unit], ml = ML[unit];
          if (!DUMMY && base < 131072 && (base & 16383) == 0 && tid == 0) MIN_[unit] = m;
          const float mn = fmaxf(bL + m, ml);
          sDec[tid * 64 + c] = __expf(bL + m - mn);
          sWn[tid * 64 + c] = __expf(ml - mn);
          m = mn;
        }
      }
    }
    __syncthreads();
    const int idx = base + tid;
    if (idx < total) {
      float* ptr; long stride; int sel;
      if (idx < 131072) { const int bh = idx >> 14; ptr = (float*)(ws + L0_H) + (long)bh * 64 * 16384 + (idx & 16383); stride = 16384; sel = bh - bh0; }
      else { const int j = idx - 131072; const int bh = j >> 7; ptr = (float*)(ws + L0_DN) + (long)bh * 64 * 128 + (j & 127); stride = 128; sel = bh - bh0; }
      const float* dec = sDec + sel * 64;
      const float* wn = sWn + sel * 64;
      float C = 0.f;
      for (int c0 = 0; c0 < 64; c0 += 8) {
        float dv[8];
#pragma unroll
        for (int k = 0; k < 8; ++k) dv[k] = ptr[(long)(c0 + k) * stride];
#pragma unroll
        for (int k = 0; k < 8; ++k) {
          if (!DUMMY) ptr[(long)(c0 + k) * stride] = C;
          C = dec[c0 + k] * C + wn[c0 + k] * dv[k];
        }
      }
      if (DUMMY && C == 123.456f) MIN_[0] = C;
    }
  }
}

DEVI void mlstm_out(const Params& p, int item, unsigned char* smem) {
  const int tid = opaque_tid(), lane = tid & 63, w = tid >> 6, wr = w >> 1, wc = w & 1;
  const int r = lane & 15, q = lane >> 4;
  const int unit = item >> 1, u = item & 1;
  const int bh = unit >> 6, c = unit & 63, b = bh >> 2, h = bh & 3, t0 = c * 128;
  const long R0 = (long)b * 8192 + t0;
  const int J0 = u * 64;
  unsigned char* ws = p.ws;
  bf16_t* sA = (bf16_t*)smem;
  bf16_t* sB = (bf16_t*)(smem + 9216);
  bf16_t* sS0 = (bf16_t*)(smem + 27648);
  bf16_t* sS1 = (bf16_t*)(smem + 36864);
  float* fl = (float*)(smem + 46080);
  float* sIg = fl; float* sLf = fl + 128; float* sRj = fl + 256; float* sCs = fl + 384; float* sWi = fl + 512;
  float* sEm = fl + 640; float* sQn = fl + 768; float* sNin = fl + 896; float* sDen = fl + 1024; float* sSs = fl + 1280;
  const float* IG = (const float*)(ws + L0_IG);
  const float* LF = (const float*)(ws + L0_LOGF);
  const bf16_t* QC = (const bf16_t*)(ws + L0_QC) + (R0 + J0) * 512 + h * 128;
  const bf16_t* KC = (const bf16_t*)(ws + L0_KC) + R0 * 512 + h * 128;
  if (tid < 128) { sIg[tid] = IG[(R0 + tid) * 4 + h]; sLf[tid] = LF[(R0 + tid) * 4 + h]; sNin[tid] = ((const float*)(ws + L0_DN))[unit * 128 + tid]; }
  const float m_in = ((const float*)(ws + L0_MIN))[unit];
  __syncthreads();
  if (tid < 64) {
    float c0 = sLf[2 * tid], c1 = sLf[2 * tid + 1];
    wave_scan_sum128(c0, c1, tid);
    const float a0 = sIg[2 * tid] - c0, a1 = sIg[2 * tid + 1] - c1;
    float x0 = a0, x1 = a1;
    wave_scan_max128(x0, x1, tid);
    const float mx0 = fmaxf(x0, m_in), mx1 = fmaxf(x1, m_in);
    sCs[2 * tid] = a0; sCs[2 * tid + 1] = a1;
    sRj[2 * tid] = -mx0; sRj[2 * tid + 1] = -mx1;
    sWi[2 * tid] = __expf(m_in - mx0); sWi[2 * tid + 1] = __expf(m_in - mx1);
    sEm[2 * tid] = __expf(-(c0 + mx0)); sEm[2 * tid + 1] = __expf(-(c1 + mx1));
  }
  if (tid >= 128 && tid < 192) {
    int jl = tid - 128;
    const bf16_t* qr = QC + (long)jl * 512;
    float s = 0.f;
#pragma unroll 2
    for (int ch = 0; ch < 16; ++ch) {
      uint4 v = *(const uint4*)(qr + ch * 8);
      const float* nn = sNin + ch * 8;
      s += lo2f(v.x) * nn[0] + hi2f(v.x) * nn[1] + lo2f(v.y) * nn[2] + hi2f(v.y) * nn[3] + lo2f(v.z) * nn[4] + hi2f(v.z) * nn[5] + lo2f(v.w) * nn[6] + hi2f(v.w) * nn[7];
    }
    sQn[jl] = s;
  }
  __syncthreads();
  f32x4 acc[2][4];
#pragma unroll
  for (int mt = 0; mt < 2; ++mt)
#pragma unroll
    for (int nt = 0; nt < 4; ++nt) acc[mt][nt] = f32x4{0.f, 0.f, 0.f, 0.f};
  const bool skipS = (wc > u);
  const int lr = tid >> 3, lk = (tid & 7) * 8;
  {
    u32x4 qa0, qa1, kb0, kb1, kb2, kb3;
    qa0 = *(const u32x4*)(QC + (long)lr * 512 + lk); qa1 = *(const u32x4*)(QC + (long)(lr + 32) * 512 + lk);
    kb0 = *(const u32x4*)(KC + (long)lr * 512 + lk); kb1 = *(const u32x4*)(KC + (long)(lr + 32) * 512 + lk);
    kb2 = *(const u32x4*)(KC + (long)(lr + 64) * 512 + lk); kb3 = *(const u32x4*)(KC + (long)(lr + 96) * 512 + lk);
#pragma unroll 1
    for (int kt = 0; kt < 2; ++kt) {
      *(u32x4*)(sA + lr * LDT + lk) = qa0; *(u32x4*)(sA + (lr + 32) * LDT + lk) = qa1;
      *(u32x4*)(sB + lr * LDT + lk) = kb0; *(u32x4*)(sB + (lr + 32) * LDT + lk) = kb1;
      *(u32x4*)(sB + (lr + 64) * LDT + lk) = kb2; *(u32x4*)(sB + (lr + 96) * LDT + lk) = kb3;
      __syncthreads();
      if (kt == 0) {
        qa0 = *(const u32x4*)(QC + (long)lr * 512 + 64 + lk); qa1 = *(const u32x4*)(QC + (long)(lr + 32) * 512 + 64 + lk);
        kb0 = *(const u32x4*)(KC + (long)lr * 512 + 64 + lk); kb1 = *(const u32x4*)(KC + (long)(lr + 32) * 512 + 64 + lk);
        kb2 = *(const u32x4*)(KC + (long)(lr + 64) * 512 + 64 + lk); kb3 = *(const u32x4*)(KC + (long)(lr + 96) * 512 + 64 + lk);
      }
      if (!skipS) mma_lds<2, 4, 2>(sA + wr * 32 * LDT, sB + wc * 64 * LDT, acc, lane);
      __syncthreads();
    }
  }
  {
    bf16_t* sS = wc ? sS1 : sS0;
#pragma unroll
    for (int mt = 0; mt < 2; ++mt)
#pragma unroll
      for (int i = 0; i < 4; ++i) {
        int jl = wr * 32 + mt * 16 + q * 4 + i;
        int j = J0 + jl;
        float rj = sRj[j], rs = 0.f;
#pragma unroll
        for (int nt = 0; nt < 4; ++nt) {
          int sl = nt * 16 + r, s = wc * 64 + sl;
          float val = (s <= j) ? acc[mt][nt][i] * __expf(rj + sCs[s]) : 0.f;
          rs += val;
          sS[jl * LDT + sl] = f2bf(val);
        }
        rs = grp16_sum(rs);
        if (r == 0) sDen[wc * 64 + jl] = rs;
      }
  }
#pragma unroll
  for (int mt = 0; mt < 2; ++mt)
#pragma unroll
    for (int nt = 0; nt < 4; ++nt) acc[mt][nt] = f32x4{0.f, 0.f, 0.f, 0.f};
  const bf16_t* vt = (const bf16_t*)(ws + L0_MVT) + (((long)(b * 4 + h) * 128 + (t0 >> 6)) * 128) * 64;
  const float* ct = (const float*)(ws + L0_H) + (long)unit * 16384;
  {
    u32x4 vb0, vb1, vb2, vb3;
    u32x4 qa0, qa1;
    float4 cv[8];
    const int nsteps = u ? 4 : 3;
    auto kind_of = [&](int sidx) { return u ? sidx : (sidx == 0 ? 0 : sidx + 1); };
    auto fetch = [&](int kind) {
      if (kind < 2) {
        const bf16_t* vp = vt + (long)kind * 8192 + lr * 64 + lk;
        vb0 = *(const u32x4*)vp; vb1 = *(const u32x4*)(vp + 32 * 64); vb2 = *(const u32x4*)(vp + 64 * 64); vb3 = *(const u32x4*)(vp + 96 * 64);
      } else {
        const int k2 = kind - 2;
        qa0 = *(const u32x4*)(QC + (long)lr * 512 + k2 * 64 + lk); qa1 = *(const u32x4*)(QC + (long)(lr + 32) * 512 + k2 * 64 + lk);
#pragma unroll
        for (int j = 0; j < 8; ++j) cv[j] = *(const float4*)(ct + (long)((tid >> 4) + 16 * j) * 128 + k2 * 64 + (tid & 15) * 4);
      }
    };
    fetch(0);
#pragma unroll 1
    for (int sidx = 0; sidx < nsteps; ++sidx) {
      const int kind = kind_of(sidx);
      const bf16_t* aS;
      if (kind < 2) {
        *(u32x4*)(sB + lr * LDT + lk) = vb0; *(u32x4*)(sB + (lr + 32) * LDT + lk) = vb1;
        *(u32x4*)(sB + (lr + 64) * LDT + lk) = vb2; *(u32x4*)(sB + (lr + 96) * LDT + lk) = vb3;
        aS = kind ? sS1 : sS0;
      } else {
        const float w0 = sWi[J0 + lr], w1 = sWi[J0 + lr + 32];
        u32x4 o0, o1;
        o0[0] = pack2(lo2f(qa0[0]) * w0, hi2f(qa0[0]) * w0); o0[1] = pack2(lo2f(qa0[1]) * w0, hi2f(qa0[1]) * w0);
        o0[2] = pack2(lo2f(qa0[2]) * w0, hi2f(qa0[2]) * w0); o0[3] = pack2(lo2f(qa0[3]) * w0, hi2f(qa0[3]) * w0);
        o1[0] = pack2(lo2f(qa1[0]) * w1, hi2f(qa1[0]) * w1); o1[1] = pack2(lo2f(qa1[1]) * w1, hi2f(qa1[1]) * w1);
        o1[2] = pack2(lo2f(qa1[2]) * w1, hi2f(qa1[2]) * w1); o1[3] = pack2(lo2f(qa1[3]) * w1, hi2f(qa1[3]) * w1);
        *(u32x4*)(sA + lr * LDT + lk) = o0; *(u32x4*)(sA + (lr + 32) * LDT + lk) = o1;
#pragma unroll
        for (int j = 0; j < 8; ++j) {
          uint2 o;
          o.x = pack2(cv[j].x, cv[j].y);
          o.y = pack2(cv[j].z, cv[j].w);
          *(uint2*)(sB + ((tid >> 4) + 16 * j) * LDT + (tid & 15) * 4) = o;
        }
        aS = sA;
      }
      __syncthreads();
      if (sidx + 1 < nsteps) fetch(kind_of(sidx + 1));
      mma_lds<2, 4, 2>(aS + wr * 32 * LDT, sB + wc * 64 * LDT, acc, lane);
      __syncthreads();
    }
  }
#pragma unroll
  for (int mt = 0; mt < 2; ++mt)
#pragma unroll
    for (int i = 0; i < 4; ++i) {
      int jl = wr * 32 + mt * 16 + q * 4 + i;
      int j = J0 + jl;
      float den = sDen[jl] + sDen[64 + jl] + sWi[j] * sQn[jl];
      float dinv = 1.f / fmaxf(fabsf(den), sEm[j]);
      float ss = 0.f;
#pragma unroll
      for (int nt = 0; nt < 4; ++nt) { float v = acc[mt][nt][i] * dinv; acc[mt][nt][i] = v; ss += v * v; }
      ss = grp16_sum(ss);
      if (r == 0) sSs[wc * 64 + jl] = ss;
    }
  __syncthreads();
  const bf16_t* MO = (const bf16_t*)(ws + L0_MO);
  const bf16_t* MZ = (const bf16_t*)(ws + L0_MZ);
  bf16_t* Y = (bf16_t*)(ws + L0_QKRAW);
  float hn[4];
#pragma unroll
  for (int nt = 0; nt < 4; ++nt) hn[nt] = p.m_hn[h * 128 + wc * 64 + nt * 16 + r];
#pragma unroll
  for (int mt = 0; mt < 2; ++mt) {
    float gv[4][4];
#pragma unroll
    for (int i = 0; i < 4; ++i) {
      long row = R0 + J0 + wr * 32 + mt * 16 + q * 4 + i;
#pragma unroll
      for (int nt = 0; nt < 4; ++nt) {
        int col = h * 128 + wc * 64 + nt * 16 + r;
        gv[i][nt] = bf2f(MO[row * 512 + col]) * bf2f(MZ[row * 512 + col]);
      }
    }
#pragma unroll
    for (int i = 0; i < 4; ++i) {
      int jl = wr * 32 + mt * 16 + q * 4 + i;
      float rinv = rsqrtf((sSs[jl] + sSs[64 + jl]) * (1.f / 128.f) + EPSF);
      long row = R0 + J0 + jl;
#pragma unroll
      for (int nt = 0; nt < 4; ++nt) {
        int col = h * 128 + wc * 64 + nt * 16 + r;
        Y[row * 1024 + col] = f2bf(acc[mt][nt][i] * rinv * hn[nt] * gv[i][nt]);
      }
    }
  }
  __syncthreads();
}

struct NsaSm {
  bf16_t* sK; bf16_t* sV;
  float* sImpA; float* sImpB;
  unsigned* sSel; unsigned* sGrp; unsigned* sUn;
};

DEVI int next_bit(unsigned long long lo, unsigned long long hi, int from) {
  if (from < 64) {
    unsigned long long v = lo & (~0ull << from);
    if (v) return __builtin_ctzll(v);
    if (hi) return 64 + __builtin_ctzll(hi);
    return -1;
  }
  if (from >= 128) return -1;
  unsigned long long v = hi & (~0ull << (from - 64));
  if (v) return 64 + __builtin_ctzll(v);
  return -1;
}

template <int MODE, bool DUMMY = false, class MaskF, class ActF>
DEVI void nsa_branch(const NsaSm& sm, unsigned long long tmlo, unsigned long long tmhi,
                     const bf16_t* Kg, const bf16_t* Vg, long vstep, long ldv,
                     const bf16x8 (&qf)[2][2], f32x4 (&O)[4][2], float (&mrow)[2], float (&lrow)[2], const float (&invl)[2],
                     MaskF mask, ActF actf, int tokbase, int tid) {
  const int lane = tid & 63, r = lane & 15, q = lane >> 4;
  const int lr = tid >> 3, lk = (tid & 7) * 8;
  int j = next_bit(tmlo, tmhi, 0);
  if (j < 0) return;
  u32x4 k0, k1, v0, v1;
  u32x4 k2, k3, v2, v3;
  if (!DUMMY) {
    const bf16_t* kp = Kg + (long)j * 4096 + lr * 64 + lk;
    k0 = *(const u32x4*)kp; k1 = *(const u32x4*)(kp + 32 * 64);
    if (MODE != 1) {
      const bf16_t* vp = Vg + (long)j * vstep + (long)lr * ldv + lk;
      v0 = *(const u32x4*)vp; v1 = *(const u32x4*)(vp + 32 * ldv);
    }
    *(u32x4*)(sm.sK + lr * LDT + lk) = k0; *(u32x4*)(sm.sK + (lr + 32) * LDT + lk) = k1;
    if (MODE != 1) { *(u32x4*)(sm.sV + lr * LDT + lk) = v0; *(u32x4*)(sm.sV + (lr + 32) * LDT + lk) = v1; }
  }
  int j1 = next_bit(tmlo, tmhi, j + 1);
  if (!DUMMY && j1 >= 0) {
    const bf16_t* kp = Kg + (long)j1 * 4096 + lr * 64 + lk;
    k0 = *(const u32x4*)kp; k1 = *(const u32x4*)(kp + 32 * 64);
    if (MODE != 1) {
      const bf16_t* vp = Vg + (long)j1 * vstep + (long)lr * ldv + lk;
      v0 = *(const u32x4*)vp; v1 = *(const u32x4*)(vp + 32 * ldv);
    }
  }
  if (!DUMMY) __syncthreads();
  int buf = 0;
  while (true) {
    const int jn = j1;
    const int j2 = (j1 >= 0) ? next_bit(tmlo, tmhi, j1 + 1) : -1;
    if (!DUMMY && j2 >= 0) {
      const bf16_t* kp = Kg + (long)j2 * 4096 + lr * 64 + lk;
      k2 = *(const u32x4*)kp; k3 = *(const u32x4*)(kp + 32 * 64);
      if (MODE != 1) {
        const bf16_t* vp = Vg + (long)j2 * vstep + (long)lr * ldv + lk;
        v2 = *(const u32x4*)vp; v3 = *(const u32x4*)(vp + 32 * ldv);
      }
    }
    const bf16_t* sK = sm.sK + buf * (64 * LDT);
    const bf16_t* sV = sm.sV + buf * (64 * LDT);
    const bool a0 = actf(0, j), a1 = actf(1, j);
    __builtin_amdgcn_sched_barrier(0);
    if (a0 || a1) {
      const bool full = mask.full(j);
      f32x4 sacc[4][2];
#pragma unroll
      for (int mt = 0; mt < 4; ++mt) { sacc[mt][0] = f32x4{0.f, 0.f, 0.f, 0.f}; sacc[mt][1] = f32x4{0.f, 0.f, 0.f, 0.f}; }
      __builtin_amdgcn_s_setprio(2);
#pragma unroll
      for (int ks = 0; ks < 2; ++ks)
#pragma unroll
        for (int mt = 0; mt < 4; ++mt) {
          bf16x8 a = *(const bf16x8*)(sK + (mt * 16 + r) * LDT + ks * 32 + q * 8);
          if (a0) sacc[mt][0] = __builtin_amdgcn_mfma_f32_16x16x32_bf16(a, qf[0][ks], sacc[mt][0], 0, 0, 0);
          if (a1) sacc[mt][1] = __builtin_amdgcn_mfma_f32_16x16x32_bf16(a, qf[1][ks], sacc[mt][1], 0, 0, 0);
        }
      __builtin_amdgcn_s_setprio(0);
      __builtin_amdgcn_sched_barrier(0);
#pragma unroll
      for (int nt = 0; nt < 2; ++nt) {
        const bool act = nt ? a1 : a0;
        if (act) {
          const bool lb = mask.bit(nt, j);
          if (!full) {
#pragma unroll
            for (int mt = 0; mt < 4; ++mt)
#pragma unroll
              for (int i = 0; i < 4; ++i) sacc[mt][nt][i] = mask.elem(mt * 16 + q * 4 + i, nt, j) ? sacc[mt][nt][i] : NEGS;
          }
          if (MODE != 2) {
            float tmx = fmaxf(fmaxf(sacc[0][nt][0], sacc[0][nt][1]), fmaxf(sacc[0][nt][2], sacc[0][nt][3]));
#pragma unroll
            for (int mt = 1; mt < 4; ++mt)
              tmx = fmaxf(tmx, fmaxf(fmaxf(sacc[mt][nt][0], sacc[mt][nt][1]), fmaxf(sacc[mt][nt][2], sacc[mt][nt][3])));
            if (MaskF::HASBIT) tmx = lb ? tmx : NEGS;
            tmx = fmaxf(tmx, __shfl_xor(tmx, 16));
            tmx = fmaxf(tmx, __shfl_xor(tmx, 32));
            const float mo = mrow[nt];
            const float mn = fmaxf(mo, tmx);
            float mnc = fmaxf(mn, -1e20f);
            if (MaskF::HASBIT) mnc = lb ? mnc : 1e30f;
            mrow[nt] = mn;
            f32x4 psv = f32x4{0.f, 0.f, 0.f, 0.f};
#pragma unroll
            for (int mt = 0; mt < 4; ++mt) {
              f32x4 dd = sacc[mt][nt] - mnc;
              f32x4 pp;
              pp[0] = __builtin_amdgcn_exp2f(dd[0]); pp[1] = __builtin_amdgcn_exp2f(dd[1]);
              pp[2] = __builtin_amdgcn_exp2f(dd[2]); pp[3] = __builtin_amdgcn_exp2f(dd[3]);
              sacc[mt][nt] = pp;
              psv += pp;
            }
            const float ps = (psv[0] + psv[1]) + (psv[2] + psv[3]);
            const float al = __builtin_amdgcn_exp2f(mo - mn);
            lrow[nt] = lrow[nt] * al + ps;
            if (MODE == 0) {
              if (__any(al != 1.f)) {
#pragma unroll
                for (int dt = 0; dt < 4; ++dt) O[dt][nt] *= al;
              }
            }
          } else {
            const float mmc = fmaxf(mrow[nt], -1e20f), il = invl[nt];
            const int tok = tokbase + nt * 4 + (r >> 2);
#pragma unroll
            for (int mt = 0; mt < 4; ++mt) {
              float pp[4];
#pragma unroll
              for (int i = 0; i < 4; ++i) {
                pp[i] = __builtin_amdgcn_exp2f(sacc[mt][nt][i] - mmc) * il;
                sacc[mt][nt][i] = pp[i];
              }
              float mainv = 32.f * (pp[0] + pp[1] + pp[2]) + 16.f * pp[3];
              float carry = 16.f * pp[3];
              mainv += __shfl_xor(mainv, 1); mainv += __shfl_xor(mainv, 2);
              carry += __shfl_xor(carry, 1); carry += __shfl_xor(carry, 2);
              if ((r & 3) == 0) {
                const int mp = j * 16 + mt * 4 + q;
                sm.sImpA[tok * 128 + mp] = mainv;
                if (mp + 1 < 128) sm.sImpB[tok * 128 + mp + 1] = carry;
              }
            }
          }
        }
      }
      __builtin_amdgcn_sched_barrier(0);
      if (MODE != 1) {
        __builtin_amdgcn_s_setprio(2);
#pragma unroll
        for (int ks = 0; ks < 2; ++ks) {
          bf16x8 pb[2];
#pragma unroll
          for (int nt = 0; nt < 2; ++nt) {
            union { u32x4 u; bf16x8 h; } cv;
            cv.u[0] = pack2(sacc[2 * ks][nt][0], sacc[2 * ks][nt][1]);
            cv.u[1] = pack2(sacc[2 * ks][nt][2], sacc[2 * ks][nt][3]);
            cv.u[2] = pack2(sacc[2 * ks + 1][nt][0], sacc[2 * ks + 1][nt][1]);
            cv.u[3] = pack2(sacc[2 * ks + 1][nt][2], sacc[2 * ks + 1][nt][3]);
            pb[nt] = cv.h;
          }
#pragma unroll
          for (int dt = 0; dt < 4; ++dt) {
            union { u32x4 u; bf16x8 h; } av;
            const uint2 lo = *(const uint2*)(sV + (dt * 16 + r) * LDT + (2 * ks) * 16 + q * 4);
            const uint2 hi = *(const uint2*)(sV + (dt * 16 + r) * LDT + (2 * ks + 1) * 16 + q * 4);
            av.u[0] = lo.x; av.u[1] = lo.y; av.u[2] = hi.x; av.u[3] = hi.y;
            if (a0) O[dt][0] = __builtin_amdgcn_mfma_f32_16x16x32_bf16(av.h, pb[0], O[dt][0], 0, 0, 0);
            if (a1) O[dt][1] = __builtin_amdgcn_mfma_f32_16x16x32_bf16(av.h, pb[1], O[dt][1], 0, 0, 0);
          }
        }
        __builtin_amdgcn_s_setprio(0);
      }
    }
    __builtin_amdgcn_sched_barrier(0);
    if (!DUMMY && jn >= 0) {
      bf16_t* dK = sm.sK + (buf ^ 1) * (64 * LDT);
      bf16_t* dV = sm.sV + (buf ^ 1) * (64 * LDT);
      *(u32x4*)(dK + lr * LDT + lk) = k0; *(u32x4*)(dK + (lr + 32) * LDT + lk) = k1;
      if (MODE != 1) { *(u32x4*)(dV + lr * LDT + lk) = v0; *(u32x4*)(dV + (lr + 32) * LDT + lk) = v1; }
    }
    if (!DUMMY) __syncthreads();
    if (jn < 0) break;
    j = jn;
    j1 = j2;
    k0 = k2; k1 = k3; v0 = v2; v1 = v3;
    buf ^= 1;
  }
}

struct MaskC {
      static constexpr bool HASBIT = false;
      int t0_, t1_, tmin_;
      DEVI bool full(int jt) const { return 16 * (jt * 64 + 63) + 31 <= tmin_; }
      DEVI bool bit(int nt, int jt) const { return true; }
      DEVI bool elem(int key, int nt, int jt) const { return 16 * (jt * 64 + key) + 31 <= (nt ? t1_ : t0_); }
};

struct MaskS {
      static constexpr bool HASBIT = true;
      unsigned long long a_lo, a_hi, b_lo, b_hi; int t0_, t1_, cur_;
      DEVI bool full(int jt) const { return jt < cur_; }
      DEVI bool bit(int nt, int jt) const {
        const unsigned long long lo = nt ? b_lo : a_lo, hi = nt ? b_hi : a_hi;
        const unsigned long long wd = (jt < 64) ? (lo >> jt) : (hi >> (jt - 64));
        return (wd & 1ull) != 0ull;
      }
      DEVI bool elem(int key, int nt, int jt) const { return jt * 64 + key <= (nt ? t1_ : t0_); }
};

struct MaskW {
      static constexpr bool HASBIT = false;
      int t0_, t1_, tmin_, tmax_;
      DEVI bool full(int jt) const { return (jt * 64 + 63 <= tmin_) && (tmax_ - jt * 64 < 512); }
      DEVI bool bit(int nt, int jt) const { return true; }
      DEVI bool elem(int key, int nt, int jt) const { const int s_ = jt * 64 + key, t_ = nt ? t1_ : t0_; return (s_ <= t_) && (t_ - s_ < 512); }
};

DEVI void nsa_tile(const Params& p, int tileidx, unsigned char* smem) {
  const int tid = opaque_tid(), lane = tid & 63, w = tid >> 6, r = lane & 15, q = lane >> 4;
  const int bg = tileidx & 3, tt = tileidx >> 2, b = bg >> 1, g = bg & 1, t0 = tt * 32;
  unsigned char* ws = p.ws;
  NsaSm sm;
  sm.sK = (bf16_t*)smem; sm.sV = (bf16_t*)(smem + 18432);
  sm.sImpA = (float*)(smem + 36864); sm.sImpB = (float*)(smem + 53248);
  sm.sSel = (unsigned*)(smem + 69632); sm.sGrp = sm.sSel + 128; sm.sUn = sm.sGrp + 32;
  const int tokbase = 8 * w;
  bf16x8 qf[2][2];
  {
    const bf16_t* qn = (const bf16_t*)(ws + L0_QN) + ((long)bg * 8192 + t0) * 256 + (32 * w + r) * 64 + q * 8;
    qf[0][0] = *(const bf16x8*)(qn); qf[0][1] = *(const bf16x8*)(qn + 32);
    qf[1][0] = *(const bf16x8*)(qn + 16 * 64); qf[1][1] = *(const bf16x8*)(qn + 16 * 64 + 32);
  }
  int tq[2];
  const float* GT = (const float*)(ws + L0_GATES);
#pragma unroll
  for (int nt = 0; nt < 2; ++nt) tq[nt] = t0 + tokbase + nt * 4 + (r >> 2);
#define GATE(nt, k) (GT[((long)b * 8192 + tq[nt]) * 24 + (g * 4 + (r & 3)) * 3 + (k)])
  f32x4 O[4][2];
  f32x4* sOut = (f32x4*)(smem + 36864) + (w * 8) * 64 + lane;
  const int cur = t0 >> 6;
  float mrow[2], lrow[2], invl[2];
  for (int i = tid; i < 32 * 128; i += 256) { sm.sImpA[i] = 0.f; sm.sImpB[i] = 0.f; }
  __syncthreads();
  {
    const int nvmax = (t0 + 31 >= 31) ? (((t0 + 31 - 31) >> 4) + 1) : 0;
    int nkt = (nvmax + 63) >> 6;
    if (nkt > 8) nkt = 8;
    const unsigned long long cm0 = (1ull << nkt) - 1ull;
    const bf16_t* KCMP = (const bf16_t*)(ws + L0_KCMP) + (long)bg * 512 * 64;
    const bf16_t* VCMPT = (const bf16_t*)(ws + L0_VCMPT) + (long)bg * 64 * 512;
    MaskC mk{tq[0], tq[1], t0 + tokbase};
    auto act = [&](int nt, int jt) { return true; };
    mrow[0] = mrow[1] = NEGS; lrow[0] = lrow[1] = 0.f; invl[0] = invl[1] = 0.f;
    nsa_branch<1>(sm, cm0, 0ull, KCMP, VCMPT, 64, 512, qf, O, mrow, lrow, invl, mk, act, tokbase, tid);
#pragma unroll
    for (int nt = 0; nt < 2; ++nt) {
      float l = lrow[nt];
      l += __shfl_xor(l, 16); l += __shfl_xor(l, 32);
      invl[nt] = (l > 0.f) ? 1.f / l : 0.f;
    }
#pragma unroll
    for (int dt = 0; dt < 4; ++dt) { O[dt][0] = f32x4{0.f, 0.f, 0.f, 0.f}; O[dt][1] = f32x4{0.f, 0.f, 0.f, 0.f}; }
    nsa_branch<2>(sm, cm0, 0ull, KCMP, VCMPT, 64, 512, qf, O, mrow, lrow, invl, mk, act, tokbase, tid);
  }
  __syncthreads();
  {
    const int ncand = (cur - 2 > 0) ? cur - 2 : 0;
    const int nf = (cur >= 2) ? 3 : cur + 1;
    const int kk = 16 - nf;
    const int m0i = lane, m1i = lane + 64;
    const bool c0 = (m0i >= 1 && m0i <= cur - 2), c1 = (m1i <= cur - 2);
    for (int tqi = 0; tqi < 8; ++tqi) {
      const int tok = tokbase + tqi;
      bool s0, s1;
      if (ncand <= kk) { s0 = c0; s1 = c1; }
      else {
        const float f0 = sm.sImpA[tok * 128 + m0i] + sm.sImpB[tok * 128 + m0i];
        const float f1 = sm.sImpA[tok * 128 + m1i] + sm.sImpB[tok * 128 + m1i];
        const unsigned k0 = c0 ? (__float_as_uint(f0) + 1u) : 0u;
        const unsigned k1 = c1 ? (__float_as_uint(f1) + 1u) : 0u;
        unsigned prefix = 0u;
        for (int bit = 31; bit >= 0; --bit) {
          const unsigned cand = prefix | (1u << bit);
          const int cnt = __popcll(__ballot(k0 >= cand)) + __popcll(__ballot(k1 >= cand));
          if (cnt >= kk) prefix = cand;
        }
        const bool g0 = k0 > prefix, g1 = k1 > prefix;
        const int ng = __popcll(__ballot(g0)) + __popcll(__ballot(g1));
        const bool e0 = (k0 == prefix), e1 = (k1 == prefix);
        const unsigned long long be0 = __ballot(e0), be1 = __ballot(e1);
        const unsigned long long lm = (1ull << lane) - 1ull;
        const int re0 = __popcll(be0 & lm), re1 = __popcll(be0) + __popcll(be1 & lm);
        const int need = kk - ng;
        s0 = g0 || (e0 && re0 < need);
        s1 = g1 || (e1 && re1 < need);
      }
      s0 = s0 || (m0i == 0) || (m0i == cur) || (m0i == cur - 1);
      s1 = s1 || (m1i == cur) || (m1i == cur - 1);
      const unsigned long long lo = __ballot(s0), hi = __ballot(s1);
      if (lane == 0) {
        sm.sSel[tok * 4 + 0] = (unsigned)lo; sm.sSel[tok * 4 + 1] = (unsigned)(lo >> 32);
        sm.sSel[tok * 4 + 2] = (unsigned)hi; sm.sSel[tok * 4 + 3] = (unsigned)(hi >> 32);
      }
    }
  }
  __syncthreads();
  if (tid < 32) { int gi = tid >> 2, wd = tid & 3; unsigned u = 0; for (int k = 0; k < 4; ++k) u |= sm.sSel[(gi * 4 + k) * 4 + wd]; sm.sGrp[tid] = u; }
  __syncthreads();
  if (tid < 4) { unsigned u = 0; for (int gi = 0; gi < 8; ++gi) u |= sm.sGrp[gi * 4 + tid]; sm.sUn[tid] = u; }
  __syncthreads();
#pragma unroll
  for (int nt = 0; nt < 2; ++nt)
#pragma unroll
    for (int dt = 0; dt < 4; ++dt) sOut[(nt * 4 + dt) * 64] = O[dt][nt] * GATE(nt, 0);
  {
    const bf16_t* KS = (const bf16_t*)(ws + L0_KS) + (long)bg * 8192 * 64;
    const bf16_t* VST = (const bf16_t*)(ws + L0_VST) + (long)bg * 128 * 4096;
    const unsigned long long ulo = (unsigned long long)sm.sUn[0] | ((unsigned long long)sm.sUn[1] << 32);
    const unsigned long long uhi = (unsigned long long)sm.sUn[2] | ((unsigned long long)sm.sUn[3] << 32);
    const int tk0 = tokbase + (r >> 2), tk1 = tokbase + 4 + (r >> 2);
    MaskS mk{(unsigned long long)sm.sSel[tk0 * 4 + 0] | ((unsigned long long)sm.sSel[tk0 * 4 + 1] << 32),
             (unsigned long long)sm.sSel[tk0 * 4 + 2] | ((unsigned long long)sm.sSel[tk0 * 4 + 3] << 32),
             (unsigned long long)sm.sSel[tk1 * 4 + 0] | ((unsigned long long)sm.sSel[tk1 * 4 + 1] << 32),
             (unsigned long long)sm.sSel[tk1 * 4 + 2] | ((unsigned long long)sm.sSel[tk1 * 4 + 3] << 32), tq[0], tq[1], cur};
    unsigned long long g0lo, g0hi, g1lo, g1hi;
    {
      const unsigned* gp = sm.sGrp + (2 * w) * 4;
      g0lo = (unsigned long long)__builtin_amdgcn_readfirstlane(gp[0]) | ((unsigned long long)__builtin_amdgcn_readfirstlane(gp[1]) << 32);
      g0hi = (unsigned long long)__builtin_amdgcn_readfirstlane(gp[2]) | ((unsigned long long)__builtin_amdgcn_readfirstlane(gp[3]) << 32);
      g1lo = (unsigned long long)__builtin_amdgcn_readfirstlane(gp[4]) | ((unsigned long long)__builtin_amdgcn_readfirstlane(gp[5]) << 32);
      g1hi = (unsigned long long)__builtin_amdgcn_readfirstlane(gp[6]) | ((unsigned long long)__builtin_amdgcn_readfirstlane(gp[7]) << 32);
    }
    auto act = [&](int nt, int jt) {
      const unsigned long long lo = nt ? g1lo : g0lo, hi = nt ? g1hi : g0hi;
      const unsigned long long wd = (jt < 64) ? (lo >> jt) : (hi >> (jt - 64));
      return (wd & 1ull) != 0ull;
    };
    mrow[0] = mrow[1] = NEGS; lrow[0] = lrow[1] = 0.f;
#pragma unroll
    for (int dt = 0; dt < 4; ++dt) { O[dt][0] = f32x4{0.f, 0.f, 0.f, 0.f}; O[dt][1] = f32x4{0.f, 0.f, 0.f, 0.f}; }
#ifdef NSA_DUMMY_SEL
    {
      nsa_branch<0, true>(sm, ulo, uhi, KS, VST, 4096, 64, qf, O, mrow, lrow, invl, mk, act, tokbase, tid);
      float chk = lrow[0] + lrow[1];
#pragma unroll
      for (int dt = 0; dt < 4; ++dt) chk += O[dt][0][0] + O[dt][0][1] + O[dt][0][2] + O[dt][0][3] + O[dt][1][0] + O[dt][1][1] + O[dt][1][2] + O[dt][1][3];
      if (chk == 123.456f) sm.sUn[0] = 1u;
      mrow[0] = mrow[1] = NEGS; lrow[0] = lrow[1] = 0.f;
#pragma unroll
      for (int dt = 0; dt < 4; ++dt) { O[dt][0] = f32x4{0.f, 0.f, 0.f, 0.f}; O[dt][1] = f32x4{0.f, 0.f, 0.f, 0.f}; }
      __syncthreads();
    }
#endif
    nsa_branch<0>(sm, ulo, uhi, KS, VST, 4096, 64, qf, O, mrow, lrow, invl, mk, act, tokbase, tid);
#pragma unroll
    for (int nt = 0; nt < 2; ++nt) {
      float l = lrow[nt];
      l += __shfl_xor(l, 16); l += __shfl_xor(l, 32);
      const float f = GATE(nt, 1) * ((l > 0.f) ? 1.f / l : 0.f);
#pragma unroll
      for (int dt = 0; dt < 4; ++dt) sOut[(nt * 4 + dt) * 64] += O[dt][nt] * f;
    }
  }
  {
    const bf16_t* KW = (const bf16_t*)(ws + L0_KW) + (long)bg * 8192 * 64;
    const bf16_t* VWT = (const bf16_t*)(ws + L0_VWT) + (long)bg * 128 * 4096;
    const int jlo = ((t0 - 511 > 0) ? (t0 - 511) : 0) >> 6;
    unsigned long long wlo = 0ull, whi = 0ull;
    for (int jj = jlo; jj <= cur; ++jj) { if (jj < 64) wlo |= (1ull << jj); else whi |= (1ull << (jj - 64)); }
    MaskW mk{tq[0], tq[1], t0 + tokbase, t0 + tokbase + 7};
    auto act = [&](int nt, int jt) { return true; };
    mrow[0] = mrow[1] = NEGS; lrow[0] = lrow[1] = 0.f;
#pragma unroll
    for (int dt = 0; dt < 4; ++dt) { O[dt][0] = f32x4{0.f, 0.f, 0.f, 0.f}; O[dt][1] = f32x4{0.f, 0.f, 0.f, 0.f}; }
    nsa_branch<0>(sm, wlo, whi, KW, VWT, 4096, 64, qf, O, mrow, lrow, invl, mk, act, tokbase, tid);
#pragma unroll
    for (int nt = 0; nt < 2; ++nt) {
      float l = lrow[nt];
      l += __shfl_xor(l, 16); l += __shfl_xor(l, 32);
      const float f = GATE(nt, 2) * ((l > 0.f) ? 1.f / l : 0.f);
#pragma unroll
      for (int dt = 0; dt < 4; ++dt) O[dt][nt] = sOut[(nt * 4 + dt) * 64] + O[dt][nt] * f;
    }
  }
  const bf16_t* NZ = (const bf16_t*)(ws + L0_NZ);
  bf16_t* Y = (bf16_t*)(ws + L0_QKRAW);
  uint2 zzv[2][4];
#pragma unroll
  for (int nt = 0; nt < 2; ++nt)
#pragma unroll
    for (int dt = 0; dt < 4; ++dt)
      zzv[nt][dt] = *(const uint2*)(NZ + ((long)b * 8192 + tq[nt]) * 512 + (g * 4 + (r & 3)) * 64 + dt * 16 + q * 4);
#pragma unroll
  for (int nt = 0; nt < 2; ++nt) {
    const long tok = (long)b * 8192 + tq[nt];
    const int head = g * 4 + (r & 3);
#pragma unroll
    for (int dt = 0; dt < 4; ++dt) {
      const int d = dt * 16 + q * 4;
      const uint2 zz = zzv[nt][dt];
      uint2 o;
      o.x = pack2(O[dt][nt][0] * lo2f(zz.x), O[dt][nt][1] * hi2f(zz.x));
      o.y = pack2(O[dt][nt][2] * lo2f(zz.y), O[dt][nt][3] * hi2f(zz.y));
      *(uint2*)(Y + tok * 1024 + 512 + head * 64 + d) = o;
    }
  }
  __syncthreads();
}

DEVI void hgrn_local(const Params& p, int unit, unsigned char* smem) {
  const int tid = opaque_tid(), lane = tid & 63, w = tid >> 6, wr = w >> 1, wc = w & 1;
  const int bh = unit >> 7, c = unit & 127, b = bh >> 3, h = bh & 7, t0 = c * 64;
  const long R0 = (long)b * 8192 + t0;
  unsigned char* ws = p.ws;
  bf16_t* sA = (bf16_t*)smem;
  bf16_t* sB = (bf16_t*)(smem + 18432);
  float* psum = (float*)(smem + 36864);
  const int cch = tid & 127, half = tid >> 7;
  const float lb = ((const float*)(ws + OFF_LB))[h * 128 + cch];
  const bf16_t* FP = (const bf16_t*)(ws + L1_FP) + R0 * 1024 + h * 128 + cch;
  float sgv[32], lgv[32];
  {
    const bf16_t* vtp = (const bf16_t*)(ws + L1_VT) + (((long)(b * 8 + h) * 128 + c) * 128) * 64 + (tid >> 3) * 64 + (tid & 7) * 8;
    u32x4 t0_ = *(const u32x4*)vtp, t1_ = *(const u32x4*)(vtp + 32 * 64), t2_ = *(const u32x4*)(vtp + 64 * 64), t3_ = *(const u32x4*)(vtp + 96 * 64);
    bf16_t fpr[32];
#pragma unroll
    for (int k = 0; k < 32; ++k) fpr[k] = FP[(long)(half * 32 + k) * 1024];
    {
      bf16_t* sp = sA + (tid >> 3) * LDT + (tid & 7) * 8;
      *(u32x4*)sp = t0_; *(u32x4*)(sp + 32 * LDT) = t1_; *(u32x4*)(sp + 64 * LDT) = t2_; *(u32x4*)(sp + 96 * LDT) = t3_;
    }
#pragma unroll
    for (int k = 0; k < 32; ++k) { sgv[k] = sigm(bf2f(fpr[k])); lgv[k] = __logf(lb + (1.f - lb) * sgv[k]); }
  }
  float sum = 0.f;
#pragma unroll
  for (int k = 0; k < 32; ++k) sum += lgv[k];
  psum[half * 128 + cch] = sum;
  __syncthreads();
  const float bL = psum[cch] + psum[128 + cch];
  float run = half ? psum[cch] : 0.f;
#pragma unroll
  for (int k = 0; k < 32; ++k) {
    run += lgv[k];
    float kk_ = (1.f - lb) * (1.f - sgv[k]);
    sB[cch * LDT + half * 32 + k] = f2bf(kk_ * __expf(bL - run));
  }
  if (half == 0) ((float*)(ws + L1_BL))[(long)unit * 128 + cch] = bL;
  __syncthreads();
  f32x4 acc[4][4];
#pragma unroll
  for (int mt = 0; mt < 4; ++mt)
#pragma unroll
    for (int nt = 0; nt < 4; ++nt) acc[mt][nt] = f32x4{0.f, 0.f, 0.f, 0.f};
  mma_lds_sw<4, 4, 2>(sA + wr * 64 * LDT, sB + wc * 64 * LDT, acc, lane);
#ifndef R9B
#define R9B 1
#endif
  for (int r9_ = 0; r9_ < R9B; ++r9_) {
  bf16_t* st = (bf16_t*)(ws + L1_ST) + (long)unit * 16384;
  const int r = lane & 15, q = lane >> 4;
#pragma unroll
  for (int mt = 0; mt < 4; ++mt) {
    const int v = wr * 64 + mt * 16 + r;
#pragma unroll
    for (int nt = 0; nt < 4; ++nt) {
      uint2 o;
      o.x = pack2(acc[mt][nt][0], acc[mt][nt][1]);
      o.y = pack2(acc[mt][nt][2], acc[mt][nt][3]);
      *(uint2*)(st + v * 128 + wc * 64 + nt * 16 + q * 4) = o;
    }
  }
  }
  __syncthreads();
}

template <bool DUMMY>
DEVI void hgrn_scan(const Params& p) {
  unsigned char* ws = p.ws;
  const float* BL = (const float*)(ws + L1_BL);
  for (int idx = blockIdx.x * 256 + opaque_tid(); idx < 16 * 8192; idx += gridDim.x * 256) {
    const int bh = idx >> 13, pr = idx & 8191;
    const int c2 = (pr & 63) * 2;
    unsigned* ptr = (unsigned*)(ws + L1_ST) + (long)bh * 128 * 8192 + pr;
    const float* blp = BL + (long)bh * 128 * 128 + c2;
    float s0 = 0.f, s1 = 0.f;
    for (int c0 = 0; c0 < 128; c0 += 8) {
      unsigned dv[8]; float2 bl[8];
#pragma unroll
      for (int k = 0; k < 8; ++k) { dv[k] = ptr[(long)(c0 + k) * 8192]; bl[k] = *(const float2*)(blp + (long)(c0 + k) * 128); }
#pragma unroll
      for (int k = 0; k < 8; ++k) {
        if (!DUMMY) ptr[(long)(c0 + k) * 8192] = pack2(s0, s1);
        s0 = __expf(bl[k].x) * s0 + lo2f(dv[k]);
        s1 = __expf(bl[k].y) * s1 + hi2f(dv[k]);
      }
    }
    if (DUMMY && s0 == 123.456f) ptr[0] = pack2(s0, s1);
  }
}

DEVI void hgrn_out(const Params& p, int unit, unsigned char* smem) {
  const int tid = opaque_tid(), lane = tid & 63, w = tid >> 6, wr = w >> 1, wc = w & 1;
  const int r = lane & 15, q = lane >> 4;
  const int bh = unit >> 7, c = unit & 127, b = bh >> 3, h = bh & 7, t0 = c * 64;
  const long R0 = (long)b * 8192 + t0;
  unsigned char* ws = p.ws;
  bf16_t* sQ0 = (bf16_t*)smem; bf16_t* sQ1 = (bf16_t*)(smem + 9216);
  bf16_t* sK0 = (bf16_t*)(smem + 18432); bf16_t* sK1 = (bf16_t*)(smem + 27648);
  bf16_t* sAm = (bf16_t*)(smem + 36864);
  bf16_t* sB = (bf16_t*)(smem + 46080);
  float* psum = (float*)(smem + 64512);
  float* sSs = psum + 256;
  const int cch = tid & 127, half = tid >> 7, cc = cch & 63;
  const float lb = ((const float*)(ws + OFF_LB))[h * 128 + cch];
  const bf16_t* FP = (const bf16_t*)(ws + L1_FP) + R0 * 1024 + h * 128 + cch;
  const bf16_t* Q1 = (const bf16_t*)(ws + L1_Q) + R0 * 1024 + h * 128 + cch;
  const bf16_t* vt = (const bf16_t*)(ws + L1_VT) + (((long)(b * 8 + h) * 128 + c) * 128) * 64;
  const bf16_t* st = (const bf16_t*)(ws + L1_ST) + (long)unit * 16384;
  const int tl_r = tid >> 3, tl_k = (tid & 7) * 8;
  u32x4 vv0, vv1, vv2, vv3, sa0, sa1, sa2, sa3, sb0, sb1, sb2, sb3;
  {
    const bf16_t* vp = vt + tl_r * 64 + tl_k;
    vv0 = *(const u32x4*)vp; vv1 = *(const u32x4*)(vp + 32 * 64); vv2 = *(const u32x4*)(vp + 64 * 64); vv3 = *(const u32x4*)(vp + 96 * 64);
    const bf16_t* sp = st + tl_r * 128 + tl_k;
    sa0 = *(const u32x4*)sp; sa1 = *(const u32x4*)(sp + 32 * 128); sa2 = *(const u32x4*)(sp + 64 * 128); sa3 = *(const u32x4*)(sp + 96 * 128);
    sb0 = *(const u32x4*)(sp + 64); sb1 = *(const u32x4*)(sp + 32 * 128 + 64); sb2 = *(const u32x4*)(sp + 64 * 128 + 64); sb3 = *(const u32x4*)(sp + 96 * 128 + 64);
  }
  float sgv[32], lgv[32];
  bf16_t qr[32];
  {
    bf16_t fpr[32];
#pragma unroll
    for (int k = 0; k < 32; ++k) { fpr[k] = FP[(long)(half * 32 + k) * 1024]; qr[k] = Q1[(long)(half * 32 + k) * 1024]; }
    { bf16_t* dp = sB + tl_r * LDT + tl_k; *(u32x4*)dp = vv0; *(u32x4*)(dp + 32 * LDT) = vv1; *(u32x4*)(dp + 64 * LDT) = vv2; *(u32x4*)(dp + 96 * LDT) = vv3; }
#pragma unroll
    for (int k = 0; k < 32; ++k) { sgv[k] = sigm(bf2f(fpr[k])); lgv[k] = __logf(lb + (1.f - lb) * sgv[k]); }
  }
  float sum = 0.f;
#pragma unroll
  for (int k = 0; k < 32; ++k) sum += lgv[k];
  psum[half * 128 + cch] = sum;
  __syncthreads();
  float run = half ? psum[cch] : 0.f;
  bf16_t* sQ = (cch < 64) ? sQ0 : sQ1;
  bf16_t* sK = (cch < 64) ? sK0 : sK1;
#pragma unroll
  for (int k = 0; k < 32; ++k) {
    const int s_ = half * 32 + k;
    run += lgv[k];
    float kk_ = (1.f - lb) * (1.f - sgv[k]);
    sQ[s_ * LDT + cc] = f2bf(bf2f(qr[k]) * __expf(run));
    sK[s_ * LDT + cc] = f2bf(kk_ * __expf(fminf(-run, 80.f)));
  }
  __syncthreads();
  {
    f32x4 a1[2][2];
#pragma unroll
    for (int mt = 0; mt < 2; ++mt)
#pragma unroll
      for (int nt = 0; nt < 2; ++nt) a1[mt][nt] = f32x4{0.f, 0.f, 0.f, 0.f};
    if (!(wr == 0 && wc == 1)) {
      mma_lds<2, 2, 2>(sQ0 + wr * 32 * LDT, sK0 + wc * 32 * LDT, a1, lane);
      mma_lds<2, 2, 2>(sQ1 + wr * 32 * LDT, sK1 + wc * 32 * LDT, a1, lane);
    }
#pragma unroll
    for (int mt = 0; mt < 2; ++mt)
#pragma unroll
      for (int i = 0; i < 4; ++i) {
        int j = wr * 32 + mt * 16 + q * 4 + i;
#pragma unroll
        for (int nt = 0; nt < 2; ++nt) {
          int s = wc * 32 + nt * 16 + r;
          sAm[j * LDT + s] = f2bf((s <= j) ? a1[mt][nt][i] : 0.f);
        }
      }
  }
  __syncthreads();
  f32x4 o[2][4];
#pragma unroll
  for (int mt = 0; mt < 2; ++mt)
#pragma unroll
    for (int nt = 0; nt < 4; ++nt) o[mt][nt] = f32x4{0.f, 0.f, 0.f, 0.f};
  mma_lds<2, 4, 2>(sAm + wr * 32 * LDT, sB + wc * 64 * LDT, o, lane);
  __syncthreads();
  { bf16_t* dp = sB + tl_r * LDT + tl_k; *(u32x4*)dp = sa0; *(u32x4*)(dp + 32 * LDT) = sa1; *(u32x4*)(dp + 64 * LDT) = sa2; *(u32x4*)(dp + 96 * LDT) = sa3; }
  __syncthreads();
  mma_lds<2, 4, 2>(sQ0 + wr * 32 * LDT, sB + wc * 64 * LDT, o, lane);
  __syncthreads();
  { bf16_t* dp = sB + tl_r * LDT + tl_k; *(u32x4*)dp = sb0; *(u32x4*)(dp + 32 * LDT) = sb1; *(u32x4*)(dp + 64 * LDT) = sb2; *(u32x4*)(dp + 96 * LDT) = sb3; }
  __syncthreads();
  mma_lds<2, 4, 2>(sQ1 + wr * 32 * LDT, sB + wc * 64 * LDT, o, lane);
#pragma unroll
  for (int mt = 0; mt < 2; ++mt)
#pragma unroll
    for (int i = 0; i < 4; ++i) {
      int j = wr * 32 + mt * 16 + q * 4 + i;
      float ss = 0.f;
#pragma unroll
      for (int nt = 0; nt < 4; ++nt) ss += o[mt][nt][i] * o[mt][nt][i];
      ss = grp16_sum(ss);
      if (r == 0) sSs[wc * 64 + j] = ss;
    }
  __syncthreads();
  const bf16_t* Z1 = (const bf16_t*)(ws + L1_Z);
  bf16_t* Y1 = (bf16_t*)(ws + L1_H);
  float hn[4];
#pragma unroll
  for (int nt = 0; nt < 4; ++nt) hn[nt] = p.h_hn[h * 128 + wc * 64 + nt * 16 + r];
#pragma unroll
  for (int mt = 0; mt < 2; ++mt) {
    float zv[4][4];
#pragma unroll
    for (int i = 0; i < 4; ++i) {
      long row = R0 + wr * 32 + mt * 16 + q * 4 + i;
#pragma unroll
      for (int nt = 0; nt < 4; ++nt) zv[i][nt] = bf2f(Z1[row * 1024 + h * 128 + wc * 64 + nt * 16 + r]);
    }
#pragma unroll
    for (int i = 0; i < 4; ++i) {
      int j = wr * 32 + mt * 16 + q * 4 + i;
      float rinv = rsqrtf((sSs[j] + sSs[64 + j]) * (1.f / 128.f) + EPSF);
      long row = R0 + j;
#pragma unroll
      for (int nt = 0; nt < 4; ++nt) {
        int col = h * 128 + wc * 64 + nt * 16 + r;
        Y1[row * 1024 + col] = f2bf(o[mt][nt][i] * rinv * hn[nt] * zv[i][nt]);
      }
    }
  }
  __syncthreads();
}

#define XB_TMO      128
#define XB_XCNT(j)  (256  + 64 * (j))
#define XB_XSUB(j)  (1280 + 64 * (j))
#define XB_XGEN(j)  (2304 + 64 * (j))
#define XB_TOP      3328
#define XB_TOPGEN   3392
#define XCD_BAR_WORDS 3456
#define XB_SPIN_CAP (1u << 22)
DEVI unsigned xb_ld(unsigned* p) { return __hip_atomic_load(p, __ATOMIC_RELAXED, __HIP_MEMORY_SCOPE_AGENT); }
DEVI unsigned xb_add(unsigned* p, unsigned v) { return __hip_atomic_fetch_add(p, v, __ATOMIC_RELAXED, __HIP_MEMORY_SCOPE_AGENT); }
DEVI unsigned xb_xcc_id() { return (unsigned)__builtin_amdgcn_s_getreg((3 << 11) | 20) & 0xFu; }
#define XB_SPIN(cond, bar) do { unsigned _sp = 0; while (cond) { __builtin_amdgcn_s_sleep(1); \
    if ((++_sp & 255u) == 0u) { if (xb_ld(&(bar)[XB_TMO])) break; if (_sp > XB_SPIN_CAP) { atomicAdd(&(bar)[XB_TMO], 1u); break; } } } } while (0)

DEVI void xcd_barrier_complete(unsigned* bar, unsigned x, unsigned& nloc, unsigned& nx) {
  const unsigned G = gridDim.x;
  unsigned sum, cnt, mine, sp = 0u;
  for (;;) {
    sum = 0u; cnt = 0u; mine = 0u;
#pragma unroll
    for (unsigned j = 0; j < 16; ++j) { const unsigned c = xb_ld(&bar[XB_XCNT(j)]); sum += c; cnt += (c > 0u) ? 1u : 0u; mine = (j == x) ? c : mine; }
    if (sum == G) break;
    __builtin_amdgcn_s_sleep(1);
    if ((++sp & 255u) == 0u) { if (xb_ld(&bar[XB_TMO])) break; if (sp > XB_SPIN_CAP) { atomicAdd(&bar[XB_TMO], 1u); break; } }
  }
  nloc = mine > 0u ? mine : 1u; nx = cnt > 0u ? cnt : 1u;
}

DEVI void grid_barrier(unsigned* bar, unsigned xcc, volatile unsigned* st) {
  asm volatile("s_waitcnt vmcnt(0)" ::: "memory");
  __syncthreads();
  if (threadIdx.x == 0) {
    __builtin_amdgcn_s_waitcnt(0);
    unsigned nloc = st[0], nx = st[1];
    if (nloc == 0u) { xcd_barrier_complete(bar, xcc, nloc, nx); st[0] = nloc; st[1] = nx; }
    const unsigned old = xb_add(&bar[XB_XSUB(xcc)], 1u);
    const unsigned gen = old / nloc;
    if (old + 1u == (gen + 1u) * nloc) {
      __builtin_amdgcn_fence(__ATOMIC_RELEASE, "agent");
      asm volatile("s_waitcnt vmcnt(0)" ::: "memory");
      const unsigned og = xb_add(&bar[XB_TOP], 1u);
      const unsigned tg = og / nx;
      if (og + 1u == (tg + 1u) * nx) xb_add(&bar[XB_TOPGEN], 1u);
      else XB_SPIN(xb_ld(&bar[XB_TOPGEN]) == tg, bar);
      __builtin_amdgcn_fence(__ATOMIC_ACQUIRE, "agent");
      xb_add(&bar[XB_XGEN(xcc)], 1u);
      asm volatile("s_waitcnt vmcnt(0)" ::: "memory");
    } else {
      XB_SPIN(xb_ld(&bar[XB_XGEN(xcc)]) == gen, bar);
      __builtin_amdgcn_fence(__ATOMIC_ACQUIRE, "agent");
      asm volatile("s_waitcnt vmcnt(0)" ::: "memory");
    }
  }
  __syncthreads();
}

#ifndef REP_NSA
#define REP_NSA 1
#endif
#ifndef REP_P0
#define REP_P0 1
#endif
#ifndef REP_P1
#define REP_P1 1
#endif
#ifndef REP_P2
#define REP_P2 1
#endif
#ifndef REP_P3
#define REP_P3 1
#endif
#ifndef REP_P4
#define REP_P4 1
#endif
#ifndef REP_P5
#define REP_P5 1
#endif
#ifndef REP_P6
#define REP_P6 1
#endif
#ifndef REP_P7
#define REP_P7 1
#endif
#ifndef REP_P8
#define REP_P8 1
#endif
#ifndef REP_P9
#define REP_P9 1
#endif
#ifndef REP_P10
#define REP_P10 1
#endif
#ifndef REP_P11
#define REP_P11 1
#endif
#ifndef REP_P12
#define REP_P12 1
#endif
#ifndef DBG_STOP
#define DBG_STOP 99
#endif
DEVI void dbg_probe_bf16(const Params& p, size_t off, long n) {
  const bf16_t* b = (const bf16_t*)(p.ws + off);
  for (long i = (long)blockIdx.x * 256 + threadIdx.x; i < 16384L * 1024; i += (long)gridDim.x * 256) {
    float v = bf2f(b[i % n]);
    if (!(v == v) || fabsf(v) > 1e30f) v = 777.f;
    p.out[i] = v;
  }
}
DEVI void dbg_probe_f32(const Params& p, size_t off, long n) {
  const float* b = (const float*)(p.ws + off);
  for (long i = (long)blockIdx.x * 256 + threadIdx.x; i < 16384L * 1024; i += (long)gridDim.x * 256) {
    float v = b[i % n];
    if (!(v == v) || fabsf(v) > 1e30f) v = 777.f;
    p.out[i] = v;
  }
}
DEVI void dbg_probe_combo(const Params& p) {
  const bf16_t* qn = (const bf16_t*)(p.ws + L0_QN);
  const bf16_t* ks = (const bf16_t*)(p.ws + L0_KS);
  const bf16_t* nz = (const bf16_t*)(p.ws + L0_NZ);
  const float* ig = (const float*)(p.ws + L0_IG);
  for (long i = (long)blockIdx.x * 256 + threadIdx.x; i < 16384L * 1024; i += (long)gridDim.x * 256) {
    float v = bf2f(qn[i % (16384L * 512)]) + bf2f(ks[i % (4L * 8192 * 64 * 4)]) + bf2f(nz[i % (16384L * 512)]) + ig[i % (16384L * 32)];
    if (!(v == v) || fabsf(v) > 1e30f) v = 777.f;
    p.out[i] = v;
  }
}
#define DBG_AT(k, stmt) if (DBG_STOP == k) { stmt; return; }

#define GSYNC() grid_barrier(bar_ctr, bar_xcc, bar_st)

__global__ void __launch_bounds__(256, 2) mega(Params p) {
  __shared__ __attribute__((aligned(16))) unsigned char smem[79872];
  cg::grid_group grid = cg::this_grid();
  const int G = gridDim.x, bid = blockIdx.x, tid = threadIdx.x, lane = tid & 63, w = tid >> 6;
  unsigned char* ws = p.ws;
  bf16_t* sA = (bf16_t*)smem;
  bf16_t* sB = (bf16_t*)(smem + 16384);
  unsigned* bar_ctr = (unsigned*)(ws + OFF_BAR);
  __shared__ uint4 xb_words;
  if (tid == 0) xb_words = make_uint4(0u, 0u, 0u, 0u);
  __syncthreads();
  volatile unsigned* bar_st = (volatile unsigned*)&xb_words;
  const unsigned bar_xcc = xb_xcc_id();
  if (tid == 0) (void)xb_add(&bar_ctr[XB_XCNT(bar_xcc)], 1u);
  if (p.ws == nullptr) grid.sync();

#ifdef EXTRA_SYNCS
  for (int e_ = 0; e_ < EXTRA_SYNCS; ++e_) GSYNC();
#endif
  for (int rep_ = 0; rep_ < REP_P0; ++rep_) {
  phase0(p, smem);
  GSYNC();
  }
  DBG_AT(0, dbg_probe_bf16(p, L0_H, 16384L*1024))
  for (int rep_ = 0; rep_ < REP_P1; ++rep_) {
#ifdef USE_G256
  for (int k_ = 0; k_ * (G >> 3) < 8 * 32; ++k_) {
    int tm, tn;
    if (!gemm_tile_xcd256(bid, G, k_, 32, tm, tn)) continue;
    gemm256((const bf16_t*)(ws + L0_H), 1024, (const bf16_t*)(ws + OFF_WIN0), 1024, 1024, tm * 256, tn * 128, sA, (bf16_t*)(smem + 32768),
            [&](f32x4 (&acc)[4][4], int mb, int nb, int ln) { epi_proj0(p, acc, mb, nb, ln); });
  }
  for (int v_ = (bid >> 3); v_ < 48; v_ += (G >> 3)) {
    const int tm = (bid & 7) * 16 + v_ / 3, tn = 32 + v_ % 3;
    gemm128<false>((const bf16_t*)(ws + L0_H), 1024, 16383, (const bf16_t*)(ws + OFF_WIN0), 1024, 4383, 1024, tm * 128, tn * 128, sA, sB,
            [&](f32x4 (&acc)[4][4], int mb, int nb, int ln) { epi_proj0(p, acc, mb, nb, ln); });
  }
#else
  for (int k_ = 0; k_ * (G >> 3) < 16 * 35; ++k_) {
    int tm, tn;
    if (!gemm_tile_xcd(bid, G, k_, 35, tm, tn)) continue;
    gemm128<false>((const bf16_t*)(ws + L0_H), 1024, 16383, (const bf16_t*)(ws + OFF_WIN0), 1024, 4383, 1024, tm * 128, tn * 128, sA, sB,
            [&](f32x4 (&acc)[4][4], int mb, int nb, int ln) { epi_proj0(p, acc, mb, nb, ln); });
  }
#endif
  GSYNC();
  }
  DBG_AT(1, dbg_probe_bf16(p, L0_QKRAW, 16384L*1024)) DBG_AT(101, dbg_probe_combo(p)) DBG_AT(102, dbg_probe_bf16(p, L0_KS, 4L*8192*64*4)) DBG_AT(103, dbg_probe_f32(p, L0_IG, 16384L*4*2+16384L*24)) DBG_AT(104, dbg_probe_bf16(p, L0_MVT, 16384L*512*3))
  for (int rep_ = 0; rep_ < REP_P2; ++rep_) {
  for (int it = bid; it < 128 + 2048; it += G) {
    if (it < 128) {
      int ksp = it >> 5, kv = (it >> 4) & 1, bg = (it >> 2) & 3, tm = it & 3;
      const bf16_t* A = (const bf16_t*)(ws + (kv ? L0_VCRAW : L0_KCRAW)) + (long)bg * 8192 * 64 + ksp * 512;
      const bf16_t* B = (const bf16_t*)(ws + (kv ? OFF_WCV : OFF_WCK)) + ksp * 512;
      gemm128<false>(A, 1024, 510, B, 2048, 127, 512, tm * 128, 0, sA, sB,
              [&](f32x4 (&acc)[4][4], int mb, int nb, int ln) { epi_cmp_hidden(p, acc, mb, nb, ln, kv, bg, ksp); });
    } else {
      conv_tile(p, it - 128, smem);
    }
  }
  GSYNC();
  }
  DBG_AT(2, dbg_probe_bf16(p, L0_QC, 16384L*512*3)) DBG_AT(201, dbg_probe_f32(p, L0_HID, 2L*4*512*128))
  for (int rep_ = 0; rep_ < REP_P3; ++rep_) {
  for (int it = bid; it < 512 + 1024; it += G) {
    if (it < 512) mlstm_local(p, it, smem);
    else { const int t_ = opaque_tid(); cmp_finalize(p, (it - 512) * 4 + (t_ >> 6), t_ & 63); }
  }
  GSYNC();
  }
  DBG_AT(3, dbg_probe_f32(p, L0_H, 512L*16384)) DBG_AT(301, dbg_probe_bf16(p, L0_KCMP, 4L*512*64*2)) DBG_AT(302, dbg_probe_f32(p, L0_DN, 512L*128 + 2048))
  for (int rep_ = 0; rep_ < REP_P4; ++rep_) {
#ifdef DUMMY_P4
  mlstm_scan<true>(p, smem);
  GSYNC();
#endif
  mlstm_scan<false>(p, smem);
  GSYNC();
  }
  DBG_AT(4, dbg_probe_f32(p, L0_H, 512L*16384)) DBG_AT(401, dbg_probe_f32(p, L0_DN, 512L*128 + 3072))
  for (int rep_ = 0; rep_ < REP_P5; ++rep_) {
  for (int it = bid; it < 1024 + 1024; it += G) {
    if (it < 1024) {
      int k = it >> 9, i = it & 511;
      int idx = (k & 1) ? (k * 512 + 511 - i) : it;
#ifndef DBG_SKIP_NSA
      for (int r2_ = 0; r2_ < REP_NSA; ++r2_) nsa_tile(p, idx, smem);
#endif
    } else {
#ifndef DBG_SKIP_MOUT
      mlstm_out(p, it - 1024, smem);
#endif
    }
  }
  GSYNC();
  }
  DBG_AT(5, dbg_probe_bf16(p, L0_QKRAW, 16384L*1024))
  for (int rep_ = 0; rep_ < REP_P6; ++rep_) {
#ifdef USE_G256
  for (int k_ = 0; k_ * (G >> 3) < 8 * 8; ++k_) {
    int tm, tn;
    if (!gemm_tile_xcd256(bid, G, k_, 8, tm, tn)) continue;
    gemm256((const bf16_t*)(ws + L0_QKRAW), 1024, (const bf16_t*)(ws + OFF_WOUT0), 1024, 1024, tm * 256, tn * 128, sA, (bf16_t*)(smem + 32768),
            [&](f32x4 (&acc)[4][4], int mb, int nb, int ln) { epi_out_resid(p.x, p.out, acc, mb, nb, ln); });
  }
#else
  for (int k_ = 0; k_ * (G >> 3) < 16 * 8; ++k_) {
    int tm, tn;
    if (!gemm_tile_xcd(bid, G, k_, 8, tm, tn)) continue;
    gemm128<false>((const bf16_t*)(ws + L0_QKRAW), 1024, 16383, (const bf16_t*)(ws + OFF_WOUT0), 1024, 1023, 1024, tm * 128, tn * 128, sA, sB,
            [&](f32x4 (&acc)[4][4], int mb, int nb, int ln) { epi_out_resid(p.x, p.out, acc, mb, nb, ln); });
  }
#endif
  GSYNC();
  }
  DBG_AT(6, (void)0)
  for (int rep_ = 0; rep_ < REP_P7; ++rep_) {
  { const int t_ = opaque_tid(); for (int row = (bid * 4 + (t_ >> 6)) * 2; row < 16384; row += G * 8) rmsnorm_row2(p.out, p.norm_w + 1024, (bf16_t*)(ws + L1_H), row, row + 1, t_ & 63); }
  GSYNC();
  }
  DBG_AT(7, dbg_probe_bf16(p, L1_H, 16384L*1024))
  for (int rep_ = 0; rep_ < REP_P8; ++rep_) {
#ifdef USE_G256
  for (int k_ = 0; k_ * (G >> 3) < 8 * 32; ++k_) {
    int tm, tn;
    if (!gemm_tile_xcd256(bid, G, k_, 32, tm, tn)) continue;
    gemm256((const bf16_t*)(ws + L1_H), 1024, (const bf16_t*)(ws + OFF_WIN1), 1024, 1024, tm * 256, tn * 128, sA, (bf16_t*)(smem + 32768),
            [&](f32x4 (&acc)[4][4], int mb, int nb, int ln) { epi_proj1(p, acc, mb, nb, ln); });
  }
#else
  for (int k_ = 0; k_ * (G >> 3) < 16 * 32; ++k_) {
    int tm, tn;
    if (!gemm_tile_xcd(bid, G, k_, 32, tm, tn)) continue;
    gemm128<false>((const bf16_t*)(ws + L1_H), 1024, 16383, (const bf16_t*)(ws + OFF_WIN1), 1024, 4095, 1024, tm * 128, tn * 128, sA, sB,
            [&](f32x4 (&acc)[4][4], int mb, int nb, int ln) { epi_proj1(p, acc, mb, nb, ln); });
  }
#endif
  GSYNC();
  }
  DBG_AT(8, dbg_probe_bf16(p, L1_FP, 16384L*1024*4))
  for (int rep_ = 0; rep_ < REP_P9; ++rep_) {
  for (int it = bid; it < 2048; it += G) hgrn_local(p, it, smem);
  GSYNC();
  }
  DBG_AT(9, dbg_probe_bf16(p, L1_ST, 2048L*16384))
  for (int rep_ = 0; rep_ < REP_P10; ++rep_) {
#ifdef DUMMY_P10
  hgrn_scan<true>(p);
  GSYNC();
#endif
  hgrn_scan<false>(p);
  GSYNC();
  }
  DBG_AT(10, dbg_probe_bf16(p, L1_ST, 2048L*16384))
  for (int rep_ = 0; rep_ < REP_P11; ++rep_) {
  for (int it = bid; it < 2048; it += G) hgrn_out(p, it, smem);
  GSYNC();
  }
  DBG_AT(11, dbg_probe_bf16(p, L1_H, 16384L*1024))
  for (int rep_ = 0; rep_ < REP_P12; ++rep_) {
#ifdef USE_G256
  for (int k_ = 0; k_ * (G >> 3) < 8 * 8; ++k_) {
    int tm, tn;
    if (!gemm_tile_xcd256(bid, G, k_, 8, tm, tn)) continue;
    gemm256((const bf16_t*)(ws + L1_H), 1024, (const bf16_t*)(ws + OFF_WOUT1), 1024, 1024, tm * 256, tn * 128, sA, (bf16_t*)(smem + 32768),
            [&](f32x4 (&acc)[4][4], int mb, int nb, int ln) { epi_out_resid(p.out, p.out, acc, mb, nb, ln); });
  }
#else
  for (int k_ = 0; k_ * (G >> 3) < 16 * 8; ++k_) {
    int tm, tn;
    if (!gemm_tile_xcd(bid, G, k_, 8, tm, tn)) continue;
    gemm128<false>((const bf16_t*)(ws + L1_H), 1024, 16383, (const bf16_t*)(ws + OFF_WOUT1), 1024, 1023, 1024, tm * 128, tn * 128, sA, sB,
            [&](f32x4 (&acc)[4][4], int mb, int nb, int ln) { epi_out_resid(p.out, p.out, acc, mb, nb, ln); });
  }
#endif
  }
}

extern "C" void kernel_launch(void* const* d_in, const int* in_sizes, int n_in, void* d_out, int out_size, void* d_ws, size_t ws_size,
                              hipStream_t stream) {
  static int grid_blocks = 0;
  if (!grid_blocks) {
    int dev = 0, cus = 0, per_cu = 0;
    (void)hipGetDevice(&dev);
    (void)hipDeviceGetAttribute(&cus, hipDeviceAttributeMultiprocessorCount, dev);
    (void)hipOccupancyMaxActiveBlocksPerMultiprocessor(&per_cu, mega, 256, 0);
    if (per_cu > 2) per_cu = 2;
    if (per_cu < 1) per_cu = 1;
    grid_blocks = cus * per_cu;
  }
  Params p{};
  const float** pf = (const float**)&p;
  for (int i = 0; i < 22; ++i) pf[i] = (const float*)d_in[i];
  p.out = (float*)d_out;
  p.ws = (unsigned char*)d_ws;
  (void)hipMemsetAsync((unsigned char*)d_ws + OFF_BAR, 0, 16384, stream);
  void* args[] = {&p};
  hipError_t e = hipLaunchCooperativeKernel((void*)mega, dim3(grid_blocks), dim3(256), args, 0, stream);
  if (e != hipSuccess) fprintf(stderr, "cooperative launch failed: %s (grid %d)\n", hipGetErrorString(e), grid_blocks);
}
```

```cpp
#include <hip/hip_runtime.h>
#define USE_G256 1
#define USE_WQ 1
#include <hip/hip_cooperative_groups.h>
#include <stdint.h>
#include <cstdio>
namespace cg = cooperative_groups;

typedef unsigned short bf16_t;
typedef __attribute__((ext_vector_type(8))) short bf16x8;
typedef __attribute__((ext_vector_type(4))) float f32x4;
typedef __attribute__((ext_vector_type(4))) unsigned int u32x4;

#define DEVI __device__ __forceinline__
#define EPSF 1e-6f
#define LDT 72
#define SLD 68
#define NEGS (-1e30f)
#define LAUNDER(ptr) asm volatile("" : "+s"(ptr))

struct Params {
  const float* x; const float* norm_w; const float* ev_w_in; const float* ev_b_in; const float* f_bias;
  const float* conv_w; const float* conv_b; const float* m_hn; const float* q_norm; const float* k_norm;
  const float* ck_pos; const float* ck_w1; const float* ck_w2; const float* cv_pos; const float* cv_w1; const float* cv_w2;
  const float* ev_w_out; const float* od_w_in; const float* od_b_in; const float* lb_logits; const float* h_hn; const float* od_w_out;
  float* out; unsigned char* ws;
};

constexpr size_t MiB = 1048576;
constexpr size_t OFF_WIN0 = 0;
constexpr size_t OFF_WOUT0 = OFF_WIN0 + 4480ull * 1024 * 2;
constexpr size_t OFF_WIN1 = OFF_WOUT0 + 2 * MiB;
constexpr size_t OFF_WOUT1 = OFF_WIN1 + 8 * MiB;
constexpr size_t OFF_WCK = OFF_WOUT1 + 2 * MiB;
constexpr size_t OFF_WCV = OFF_WCK + 512 * 1024;
constexpr size_t OFF_ROPE = OFF_WCV + 512 * 1024;
constexpr size_t OFF_PB = OFF_ROPE + 512 * 1024;
constexpr size_t OFF_LB = OFF_PB + 1024;
constexpr size_t OFF_BAR = OFF_LB + 4096;
constexpr size_t OFF_BASE = 24 * MiB;
constexpr size_t L0_H = OFF_BASE;
constexpr size_t L0_QKRAW = L0_H + 32 * MiB;
constexpr size_t L0_QC = L0_QKRAW + 32 * MiB;
constexpr size_t L0_KC = L0_QC + 16 * MiB;
constexpr size_t L0_KCT = L0_KC + 16 * MiB;
constexpr size_t L0_MVT = L0_KCT + 16 * MiB;
constexpr size_t L0_MO = L0_MVT + 16 * MiB;
constexpr size_t L0_MZ = L0_MO + 16 * MiB;
constexpr size_t L0_QN = L0_MZ + 16 * MiB;
constexpr size_t L0_NZ = L0_QN + 16 * MiB;
constexpr size_t L0_KCRAW = L0_NZ + 16 * MiB;
constexpr size_t L0_VCRAW = L0_KCRAW + 4 * MiB;
constexpr size_t L0_KS = L0_VCRAW + 4 * MiB;
constexpr size_t L0_KW = L0_KS + 4 * MiB;
constexpr size_t L0_VST = L0_KW + 4 * MiB;
constexpr size_t L0_VWT = L0_VST + 4 * MiB;
constexpr size_t L0_HID = L0_VWT + 4 * MiB;
constexpr size_t L0_KCMP = L0_HID + 2 * MiB;
constexpr size_t L0_VCMPT = L0_KCMP + 256 * 1024;
constexpr size_t L0_IG = L0_VCMPT + 256 * 1024;
constexpr size_t L0_LOGF = L0_IG + 256 * 1024;
constexpr size_t L0_GATES = L0_LOGF + 256 * 1024;
constexpr size_t L0_DN = L0_GATES + 1536 * 1024;
constexpr size_t L0_BL = L0_DN + 256 * 1024;
constexpr size_t L0_MLOC = L0_BL + 4096;
constexpr size_t L0_MIN = L0_MLOC + 4096;
constexpr size_t L0_HIDP = L0_MIN + 4096;
constexpr size_t L0_END = L0_HIDP + 8 * MiB;
static_assert(L0_END <= 256 * MiB, "ws overflow L0");
constexpr size_t L1_H = OFF_BASE;
constexpr size_t L1_FP = L1_H + 32 * MiB;
constexpr size_t L1_Q = L1_FP + 32 * MiB;
constexpr size_t L1_VT = L1_Q + 32 * MiB;
constexpr size_t L1_Z = L1_VT + 32 * MiB;
constexpr size_t L1_ST = L1_Z + 32 * MiB;
constexpr size_t L1_BL = L1_ST + 64 * MiB;
constexpr size_t L1_END = L1_BL + 1 * MiB;
static_assert(L1_END <= 256 * MiB, "ws overflow L1");

DEVI int opaque_tid() { int t = threadIdx.x; asm volatile("" : "+v"(t)); return t; }
typedef __bf16 bf16v2_t __attribute__((ext_vector_type(2)));
typedef float f32v2_t __attribute__((ext_vector_type(2)));
DEVI bf16_t f2bf(float f) { __bf16 h = (__bf16)f; return __builtin_bit_cast(unsigned short, h); }
DEVI float bf2f(bf16_t b) { return __uint_as_float(((unsigned)b) << 16); }
DEVI unsigned pack2(float a, float b) { f32v2_t f = {a, b}; bf16v2_t h = __builtin_convertvector(f, bf16v2_t); return __builtin_bit_cast(unsigned, h); }
DEVI float lo2f(unsigned u) { return __uint_as_float(u << 16); }
DEVI float hi2f(unsigned u) { return __uint_as_float(u & 0xffff0000u); }
DEVI float sigm(float x) { return __builtin_amdgcn_rcpf(1.f + __expf(-x)); }
DEVI float siluf(float x) { return x * sigm(x); }
DEVI float wave_sum(float v) { for (int o = 32; o > 0; o >>= 1) v += __shfl_xor(v, o); return v; }
DEVI float grp16_sum(float v) { v += __shfl_xor(v, 1); v += __shfl_xor(v, 2); v += __shfl_xor(v, 4); v += __shfl_xor(v, 8); return v; }

DEVI void wave_scan_sum128(float& a, float& b, int lane) {
  float t = a + b;
  float s = t;
#pragma unroll
  for (int o = 1; o < 64; o <<= 1) { float u = __shfl_up(s, o); if (lane >= o) s += u; }
  const float excl = s - t;
  a = excl + a;
  b = a + b;
}
DEVI void wave_scan_max128(float& a, float& b, int lane) {
  float t = fmaxf(a, b);
  float s = t;
#pragma unroll
  for (int o = 1; o < 64; o <<= 1) { float u = __shfl_up(s, o); if (lane >= o) s = fmaxf(s, u); }
  float prev = __shfl_up(s, 1);
  if (lane == 0) prev = -3.0e38f;
  a = fmaxf(prev, a);
  b = fmaxf(a, b);
}
DEVI float wave_max(float v) { for (int o = 32; o > 0; o >>= 1) v = fmaxf(v, __shfl_xor(v, o)); return v; }
DEVI int oldcol(int n) {
  return n < 2560 ? n : (n < 3840 ? n + 8 : (n < 4352 ? n + 32 : (n < 4360 ? n - 4352 + 2560 : n - 4360 + 3848)));
}

template <int MT, int NTL, int KS>
DEVI void mma_lds(const bf16_t* sA, const bf16_t* sB, f32x4 (&acc)[MT][NTL], int lane, bool neg = false) {
  const int r = lane & 15, q = lane >> 4;
#pragma unroll
  for (int ks = 0; ks < KS; ++ks) {
    bf16x8 a[MT], b[NTL];
#pragma unroll
    for (int mt = 0; mt < MT; ++mt) a[mt] = *(const bf16x8*)(sA + (mt * 16 + r) * LDT + ks * 32 + q * 8);
    if (neg) {
#pragma unroll
      for (int mt = 0; mt < MT; ++mt) a[mt] ^= (short)0x8000;
    }
#pragma unroll
    for (int nt = 0; nt < NTL; ++nt) b[nt] = *(const bf16x8*)(sB + (nt * 16 + r) * LDT + ks * 32 + q * 8);
#pragma unroll
    for (int mt = 0; mt < MT; ++mt)
#pragma unroll
      for (int nt = 0; nt < NTL; ++nt) acc[mt][nt] = __builtin_amdgcn_mfma_f32_16x16x32_bf16(a[mt], b[nt], acc[mt][nt], 0, 0, 0);
  }
}
template <int MT, int NTL, int KS>
DEVI void mma_lds_sw(const bf16_t* sA, const bf16_t* sB, f32x4 (&acc)[MT][NTL], int lane, bool neg = false) {
  const int r = lane & 15, q = lane >> 4;
#pragma unroll
  for (int ks = 0; ks < KS; ++ks) {
    bf16x8 a[MT], b[NTL];
#pragma unroll
    for (int mt = 0; mt < MT; ++mt) a[mt] = *(const bf16x8*)(sA + (mt * 16 + r) * LDT + ks * 32 + q * 8);
    if (neg) {
#pragma unroll
      for (int mt = 0; mt < MT; ++mt) a[mt] ^= (short)0x8000;
    }
#pragma unroll
    for (int nt = 0; nt < NTL; ++nt) b[nt] = *(const bf16x8*)(sB + (nt * 16 + r) * LDT + ks * 32 + q * 8);
#pragma unroll
    for (int mt = 0; mt < MT; ++mt)
#pragma unroll
      for (int nt = 0; nt < NTL; ++nt) acc[mt][nt] = __builtin_amdgcn_mfma_f32_16x16x32_bf16(b[nt], a[mt], acc[mt][nt], 0, 0, 0);
  }
}


template <int MT, int NTL, bool SWAP>
DEVI void mma_swz(const bf16_t* sA, const bf16_t* sB, f32x4 (&acc)[MT][NTL], int lane, bool neg) {
  const int r = lane & 15, q = lane >> 4, r7 = r & 7;
#pragma unroll
  for (int ks = 0; ks < 2; ++ks) {
    bf16x8 a[MT], b[NTL];
    const int co = ((ks * 4 + q) ^ r7) * 8;
#pragma unroll
    for (int mt = 0; mt < MT; ++mt) a[mt] = *(const bf16x8*)(sA + (mt * 16 + r) * 64 + co);
#pragma unroll
    for (int nt = 0; nt < NTL; ++nt) b[nt] = *(const bf16x8*)(sB + (nt * 16 + r) * 64 + co);
    if (neg) {
#pragma unroll
      for (int mt = 0; mt < MT; ++mt) a[mt] ^= (short)0x8000;
    }
#pragma unroll
    for (int mt = 0; mt < MT; ++mt)
#pragma unroll
      for (int nt = 0; nt < NTL; ++nt) {
        if (SWAP) acc[mt][nt] = __builtin_amdgcn_mfma_f32_16x16x32_bf16(b[nt], a[mt], acc[mt][nt], 0, 0, 0);
        else acc[mt][nt] = __builtin_amdgcn_mfma_f32_16x16x32_bf16(a[mt], b[nt], acc[mt][nt], 0, 0, 0);
      }
  }
}

DEVI void load_tile128(bf16_t* s, const bf16_t* g, long ld) {
  const int tid = opaque_tid(), lr = tid >> 3, lk = (tid & 7) * 8;
#pragma unroll
  for (int j = 0; j < 4; ++j) *(uint4*)(s + (lr + 32 * j) * LDT + lk) = *(const uint4*)(g + (long)(lr + 32 * j) * ld + lk);
}
DEVI void load_tile64(bf16_t* s, const bf16_t* g, long ld) {
  const int tid = opaque_tid(), lr = tid >> 3, lk = (tid & 7) * 8;
#pragma unroll
  for (int j = 0; j < 2; ++j) *(uint4*)(s + (lr + 32 * j) * LDT + lk) = *(const uint4*)(g + (long)(lr + 32 * j) * ld + lk);
}

template <bool SWAP, class Epi>
DEVI void gemm128(const bf16_t* A, long lda, int amax, const bf16_t* B, long ldb, int bmax, int K, int m0, int n0,
                  bf16_t* sA, bf16_t* sB, Epi&& epi) {
  const int tid = opaque_tid(), lane = tid & 63, w = tid >> 6, wr = w >> 1, wc = w & 1;
  const int lr = tid >> 3, lk = (tid & 7) * 8;
  const int lsw = (((tid & 7) ^ (lr & 7)) * 8);
  f32x4 acc[4][4];
#pragma unroll
  for (int mt = 0; mt < 4; ++mt)
#pragma unroll
    for (int nt = 0; nt < 4; ++nt) acc[mt][nt] = f32x4{0.f, 0.f, 0.f, 0.f};
  const bf16_t* ap[4];
  const bf16_t* bp[4];
#pragma unroll
  for (int j = 0; j < 4; ++j) {
    int ra = min(m0 + lr + 32 * j, amax);
    ap[j] = A + (long)ra * lda + lk;
    int rb = min(n0 + lr + 32 * j, bmax);
    bp[j] = B + (long)rb * ldb + lk;
  }
#ifndef GEMM_PASSES
#define GEMM_PASSES 1
#endif
  for (int pass_ = 0; pass_ < GEMM_PASSES; ++pass_) {
  u32x4 va0, va1, va2, va3, vb0, vb1, vb2, vb3;
  va0 = *(const u32x4*)(ap[0]); va1 = *(const u32x4*)(ap[1]); va2 = *(const u32x4*)(ap[2]); va3 = *(const u32x4*)(ap[3]);
  vb0 = *(const u32x4*)(bp[0]); vb1 = *(const u32x4*)(bp[1]); vb2 = *(const u32x4*)(bp[2]); vb3 = *(const u32x4*)(bp[3]);
  const int KT = K >> 6;
  *(u32x4*)(sA + (lr + 0) * 64 + lsw) = va0; *(u32x4*)(sA + (lr + 32) * 64 + lsw) = va1;
  *(u32x4*)(sA + (lr + 64) * 64 + lsw) = va2; *(u32x4*)(sA + (lr + 96) * 64 + lsw) = va3;
  *(u32x4*)(sB + (lr + 0) * 64 + lsw) = vb0; *(u32x4*)(sB + (lr + 32) * 64 + lsw) = vb1;
  *(u32x4*)(sB + (lr + 64) * 64 + lsw) = vb2; *(u32x4*)(sB + (lr + 96) * 64 + lsw) = vb3;
  if (KT > 1) {
    va0 = *(const u32x4*)(ap[0] + 64); va1 = *(const u32x4*)(ap[1] + 64); va2 = *(const u32x4*)(ap[2] + 64); va3 = *(const u32x4*)(ap[3] + 64);
    vb0 = *(const u32x4*)(bp[0] + 64); vb1 = *(const u32x4*)(bp[1] + 64); vb2 = *(const u32x4*)(bp[2] + 64); vb3 = *(const u32x4*)(bp[3] + 64);
  }
  __syncthreads();
  for (int kt = 0; kt < KT; ++kt) {
    const int st = (kt & 1) * 16384;
    const int sn = ((kt + 1) & 1) * 16384;
    if (kt + 1 < KT) {
      *(u32x4*)(sA + sn + (lr + 0) * 64 + lsw) = va0; *(u32x4*)(sA + sn + (lr + 32) * 64 + lsw) = va1;
      *(u32x4*)(sA + sn + (lr + 64) * 64 + lsw) = va2; *(u32x4*)(sA + sn + (lr + 96) * 64 + lsw) = va3;
      *(u32x4*)(sB + sn + (lr + 0) * 64 + lsw) = vb0; *(u32x4*)(sB + sn + (lr + 32) * 64 + lsw) = vb1;
      *(u32x4*)(sB + sn + (lr + 64) * 64 + lsw) = vb2; *(u32x4*)(sB + sn + (lr + 96) * 64 + lsw) = vb3;
    }
    if (kt + 2 < KT) {
      const int ko = (kt + 2) * 64;
      va0 = *(const u32x4*)(ap[0] + ko); va1 = *(const u32x4*)(ap[1] + ko); va2 = *(const u32x4*)(ap[2] + ko); va3 = *(const u32x4*)(ap[3] + ko);
      vb0 = *(const u32x4*)(bp[0] + ko); vb1 = *(const u32x4*)(bp[1] + ko); vb2 = *(const u32x4*)(bp[2] + ko); vb3 = *(const u32x4*)(bp[3] + ko);
    }
    __builtin_amdgcn_sched_barrier(0);
    __builtin_amdgcn_s_setprio(2);
    mma_swz<4, 4, SWAP>(sA + st + wr * 64 * 64, sB + st + wc * 64 * 64, acc, lane, (pass_ & 1) != 0);
    __builtin_amdgcn_s_setprio(0);
    __syncthreads();
  }
  }
  epi(acc, m0 + wr * 64, n0 + wc * 64, lane);
}


DEVI bool gemm_tile_xcd(int bid, int G, int k, int NTN, int& tm, int& tn) {
  const int x = bid & 7, per = G >> 3;
  const int u = (bid >> 3) + per * k;
  const int full_groups = NTN >> 3, rem = NTN & 7;
  const int n_full = full_groups * 2 * 64;
  if (u < n_full) {
    const int sb = u >> 6, wi = u & 63;
    const int tg = sb >> 1, th = sb & 1;
    tm = x * 16 + th * 8 + (wi >> 3);
    tn = tg * 8 + (wi & 7);
    return true;
  }
  const int v = u - n_full;
  if (v >= 16 * rem) return false;
  tm = x * 16 + v / rem;
  tn = full_groups * 8 + v % rem;
  return true;
}


template <class Epi>
DEVI void gemm256(const bf16_t* A, long lda, const bf16_t* B, long ldb, int K, int m0, int n0, bf16_t* sA, bf16_t* sB, Epi&& epi) {
  const int tid = opaque_tid(), lane = tid & 63, w = tid >> 6, wr = w >> 1, wc = w & 1;
  const int lr = tid >> 3, lk = (tid & 7) * 8;
  const int lsw = (((tid & 7) ^ (lr & 7)) * 8);
  const int r = lane & 15, q = lane >> 4, r7 = r & 7;
  f32x4 acc[2][4][4];
#pragma unroll
  for (int hh = 0; hh < 2; ++hh)
#pragma unroll
    for (int mt = 0; mt < 4; ++mt)
#pragma unroll
      for (int nt = 0; nt < 4; ++nt) acc[hh][mt][nt] = f32x4{0.f, 0.f, 0.f, 0.f};
  const bf16_t* abase = A + (long)(m0 + lr) * lda + lk;
  const bf16_t* bbase = B + (long)(n0 + lr) * ldb + lk;
  u32x4 va[8], vb[4];
#pragma unroll
  for (int j = 0; j < 8; ++j) va[j] = *(const u32x4*)(abase + (long)(32 * j) * lda);
#pragma unroll
  for (int j = 0; j < 4; ++j) vb[j] = *(const u32x4*)(bbase + (long)(32 * j) * ldb);
  const int KT = K >> 6;
  for (int kt = 0; kt < KT; ++kt) {
#pragma unroll
    for (int j = 0; j < 8; ++j) *(u32x4*)(sA + (lr + 32 * j) * 64 + lsw) = va[j];
#pragma unroll
    for (int j = 0; j < 4; ++j) *(u32x4*)(sB + (lr + 32 * j) * 64 + lsw) = vb[j];
    __syncthreads();
    if (kt + 1 < KT) {
      const int ko = (kt + 1) * 64;
#pragma unroll
      for (int j = 0; j < 8; ++j) va[j] = *(const u32x4*)(abase + (long)(32 * j) * lda + ko);
#pragma unroll
      for (int j = 0; j < 4; ++j) vb[j] = *(const u32x4*)(bbase + (long)(32 * j) * ldb + ko);
    }
    __builtin_amdgcn_sched_barrier(0);
    __builtin_amdgcn_s_setprio(2);
#pragma unroll
    for (int ks = 0; ks < 2; ++ks) {
      const int co = ((ks * 4 + q) ^ r7) * 8;
      bf16x8 b[4];
#pragma unroll
      for (int nt = 0; nt < 4; ++nt) b[nt] = *(const bf16x8*)(sB + (wc * 64 + nt * 16 + r) * 64 + co);
#pragma unroll
      for (int hh = 0; hh < 2; ++hh) {
        bf16x8 a[4];
#pragma unroll
        for (int mt = 0; mt < 4; ++mt) a[mt] = *(const bf16x8*)(sA + (wr * 128 + hh * 64 + mt * 16 + r) * 64 + co);
#pragma unroll
        for (int mt = 0; mt < 4; ++mt)
#pragma unroll
          for (int nt = 0; nt < 4; ++nt) acc[hh][mt][nt] = __builtin_amdgcn_mfma_f32_16x16x32_bf16(a[mt], b[nt], acc[hh][mt][nt], 0, 0, 0);
      }
    }
    __builtin_amdgcn_s_setprio(0);
    __syncthreads();
  }
  epi(acc[0], m0 + wr * 128, n0 + wc * 64, lane);
  epi(acc[1], m0 + wr * 128 + 64, n0 + wc * 64, lane);
}

DEVI bool gemm_tile_xcd256(int bid, int G, int k, int NTN, int& tm, int& tn) {
  const int x = bid & 7, per = G >> 3;
  const int u = (bid >> 3) + per * k;
  if (u >= 8 * NTN) return false;
  const int tg = u >> 6, wi = u & 63;
  tm = x * 8 + (wi >> 3);
  tn = tg * 8 + (wi & 7);
  return true;
}

DEVI void transpose_tile(const float* src, int N, int ldsrc, bf16_t* dst, int K, int ktile, int ntile, bool perm, float* sT) {
  const int tid = opaque_tid();
  const int k0 = ktile * 64, n0 = ntile * 64;
#pragma unroll
  for (int j = 0; j < 4; ++j) {
    int idx = tid + 256 * j;
    int kk = idx >> 4, n4 = (idx & 15) * 4;
    int n = n0 + n4;
    float4 v = make_float4(0.f, 0.f, 0.f, 0.f);
    if (n < N) { int oc = perm ? oldcol(n) : n; v = *(const float4*)(src + (long)(k0 + kk) * ldsrc + oc); }
    sT[kk * 65 + n4 + 0] = v.x; sT[kk * 65 + n4 + 1] = v.y; sT[kk * 65 + n4 + 2] = v.z; sT[kk * 65 + n4 + 3] = v.w;
  }
  __syncthreads();
#pragma unroll
  for (int j = 0; j < 2; ++j) {
    int idx = tid + 256 * j;
    int nn = idx >> 3, kc = (idx & 7) * 8;
    if (n0 + nn < N) {
      uint4 o;
      o.x = pack2(sT[(kc + 0) * 65 + nn], sT[(kc + 1) * 65 + nn]);
      o.y = pack2(sT[(kc + 2) * 65 + nn], sT[(kc + 3) * 65 + nn]);
      o.z = pack2(sT[(kc + 4) * 65 + nn], sT[(kc + 5) * 65 + nn]);
      o.w = pack2(sT[(kc + 6) * 65 + nn], sT[(kc + 7) * 65 + nn]);
      *(uint4*)(dst + (long)(n0 + nn) * K + k0 + kc) = o;
    }
  }
  __syncthreads();
}

DEVI void rmsnorm_row2(const float* X, const float* w, bf16_t* H, int row0, int row1, int lane) {
  const float4* xa = (const float4*)(X + (long)row0 * 1024);
  const float4* xb = (const float4*)(X + (long)row1 * 1024);
  float4 va[4], vb[4], ww[4];
#pragma unroll
  for (int j = 0; j < 4; ++j) { va[j] = xa[lane + 64 * j]; vb[j] = xb[lane + 64 * j]; ww[j] = ((const float4*)w)[lane + 64 * j]; }
  float sa = 0.f, sb = 0.f;
#pragma unroll
  for (int j = 0; j < 4; ++j) {
    sa += va[j].x * va[j].x + va[j].y * va[j].y + va[j].z * va[j].z + va[j].w * va[j].w;
    sb += vb[j].x * vb[j].x + vb[j].y * vb[j].y + vb[j].z * vb[j].z + vb[j].w * vb[j].w;
  }
  sa = wave_sum(sa); sb = wave_sum(sb);
  const float ra = rsqrtf(sa * (1.f / 1024.f) + EPSF), rb = rsqrtf(sb * (1.f / 1024.f) + EPSF);
#pragma unroll
  for (int j = 0; j < 4; ++j) {
    uint2 o;
    o.x = pack2(va[j].x * ra * ww[j].x, va[j].y * ra * ww[j].y);
    o.y = pack2(va[j].z * ra * ww[j].z, va[j].w * ra * ww[j].w);
    *(uint2*)(H + (long)row0 * 1024 + (lane + 64 * j) * 4) = o;
    o.x = pack2(vb[j].x * rb * ww[j].x, vb[j].y * rb * ww[j].y);
    o.y = pack2(vb[j].z * rb * ww[j].z, vb[j].w * rb * ww[j].w);
    *(uint2*)(H + (long)row1 * 1024 + (lane + 64 * j) * 4) = o;
  }
}

DEVI void phase0(const Params& p, unsigned char* smem) {
  const int G = gridDim.x, bid = blockIdx.x, tid = threadIdx.x, lane = tid & 63, w = tid >> 6;
  unsigned char* ws = p.ws;
  float* sT = (float*)smem;
  for (int it = bid; it < 69 * 16; it += G) transpose_tile(p.ev_w_in, 4384, 4384, (bf16_t*)(ws + OFF_WIN0), 1024, it / 69, it % 69, true, sT);
  for (int it = bid; it < 16 * 16; it += G) transpose_tile(p.ev_w_out, 1024, 1024, (bf16_t*)(ws + OFF_WOUT0), 1024, it / 16, it % 16, false, sT);
  for (int it = bid; it < 64 * 16; it += G) transpose_tile(p.od_w_in, 4096, 4096, (bf16_t*)(ws + OFF_WIN1), 1024, it / 64, it % 64, false, sT);
  for (int it = bid; it < 16 * 16; it += G) transpose_tile(p.od_w_out, 1024, 1024, (bf16_t*)(ws + OFF_WOUT1), 1024, it / 16, it % 16, false, sT);
  for (int it = bid; it < 2 * 32; it += G) transpose_tile(p.ck_w1, 128, 128, (bf16_t*)(ws + OFF_WCK), 2048, it / 2, it % 2, false, sT);
  for (int it = bid; it < 2 * 32; it += G) transpose_tile(p.cv_w1, 128, 128, (bf16_t*)(ws + OFF_WCV), 2048, it / 2, it % 2, false, sT);
  for (int row = (bid * 4 + w) * 2; row < 16384; row += G * 8) rmsnorm_row2(p.x, p.norm_w, (bf16_t*)(ws + L0_H), row, row + 1, lane);
  for (int idx = bid * 256 + tid; idx < 8192 * 8; idx += G * 256) {
    int t = idx >> 3, i = idx & 7;
    float invf = powf(500000.0f, -(float)i / 8.0f);
    float ang = (float)t * invf;
    double a = (double)ang;
    float2 cs;
    cs.x = (float)cos(a);
    cs.y = (float)sin(a);
    ((float2*)(ws + OFF_ROPE))[idx] = cs;
  }
  for (int o = bid * 4 + w; o < 256; o += G * 4) {
    int kv = o >> 7, j = o & 127;
    const float* pos = kv ? p.cv_pos : p.ck_pos;
    const float* w1 = kv ? p.cv_w1 : p.ck_w1;
    float sacc_ = 0.f;
#pragma unroll 8
    for (int i = lane; i < 2048; i += 64) sacc_ += pos[i] * w1[i * 128 + j];
    sacc_ = wave_sum(sacc_);
    if (lane == 0) ((float*)(ws + OFF_PB))[o] = sacc_;
  }
  if (bid == G - 2 || G < 2) {
    for (int c = tid; c < 1024; c += 256) {
      float l0 = p.lb_logits[c], l1 = p.lb_logits[1024 + c];
      ((float*)(ws + OFF_LB))[c] = 1.f / (1.f + expf(l1 - l0));
    }
  }
}

template <int MODE>
DEVI void store_rm(bf16_t* dst, int ld, int colbase, f32x4 (&acc)[4][4], const float* bias, int mb, int lane) {
  const int r = lane & 15, q = lane >> 4;
#pragma unroll
  for (int mt = 0; mt < 4; ++mt)
#pragma unroll
    for (int i = 0; i < 4; ++i) {
      long row = mb + mt * 16 + q * 4 + i;
#pragma unroll
      for (int nt = 0; nt < 4; ++nt) {
        float v = acc[mt][nt][i] + bias[nt];
        if (MODE == 1) v = sigm(v);
        if (MODE == 2) v = siluf(v);
        dst[row * ld + colbase + nt * 16 + r] = f2bf(v);
      }
    }
}
template <int MODE>
DEVI void store_T(bf16_t* dst, int bgrp, int F, int featoff, f32x4 (&acc)[4][4], const float* bias, int tl0, int lane) {
  const int r = lane & 15, q = lane >> 4;
#pragma unroll
  for (int mt = 0; mt < 4; ++mt)
#pragma unroll
    for (int nt = 0; nt < 4; ++nt) {
      int t = tl0 + mt * 16 + q * 4;
      float b = bias[nt];
      uint2 o;
      o.x = pack2(acc[mt][nt][0] + b, acc[mt][nt][1] + b);
      o.y = pack2(acc[mt][nt][2] + b, acc[mt][nt][3] + b);
      *(uint2*)(dst + (((long)bgrp * 128 + (t >> 6)) * F + featoff + nt * 16 + r) * 64 + (t & 63)) = o;
    }
}
DEVI void norm_rope_store(bf16_t* dst, long rowbase, int ld, int colbase, f32x4 (&acc)[4][4], const float* bias, const float* nw,
                          float scale, const float2* rope, int mb, int lane) {
  const int r = lane & 15, q = lane >> 4;
  float wv[4];
#pragma unroll
  for (int nt = 0; nt < 4; ++nt) wv[nt] = nw[nt * 16 + r];
  float2 csv[4][4];
#pragma unroll
  for (int mt = 0; mt < 4; ++mt)
#pragma unroll
    for (int i = 0; i < 4; ++i) csv[mt][i] = rope[((mb + mt * 16 + q * 4 + i) & 8191) * 8 + (r & 7)];
#pragma unroll
  for (int mt = 0; mt < 4; ++mt)
#pragma unroll
    for (int i = 0; i < 4; ++i) {
      int row = mb + mt * 16 + q * 4 + i;
      int t = row & 8191;
      float v[4];
      float ss = 0.f;
#pragma unroll
      for (int nt = 0; nt < 4; ++nt) { v[nt] = acc[mt][nt][i] + bias[nt]; ss += v[nt] * v[nt]; }
      ss = grp16_sum(ss);
      float rinv = rsqrtf(ss * (1.f / 64.f) + EPSF);
#pragma unroll
      for (int nt = 0; nt < 4; ++nt) v[nt] = v[nt] * rinv * wv[nt];
      float partner = __shfl_xor(v[0], 8);
      float2 cs = csv[mt][i];
      float x1 = (r < 8) ? v[0] : partner, x2 = (r < 8) ? partner : v[0];
      v[0] = (r < 8) ? (x1 * cs.x - x2 * cs.y) : (x1 * cs.y + x2 * cs.x);
#pragma unroll
      for (int nt = 0; nt < 4; ++nt) dst[(rowbase + t) * ld + colbase + nt * 16 + r] = f2bf(v[nt] * scale);
    }
}

DEVI void epi_proj0(const Params& p, f32x4 (&acc)[4][4], int mb, int nb, int lane) {
  if (nb >= 4384) return;
  unsigned char* ws = p.ws;
  const int r = lane & 15, q = lane >> 4;
  float bias[4];
#pragma unroll
  for (int nt = 0; nt < 4; ++nt) { int n = nb + nt * 16 + r; bias[nt] = (n < 4384) ? p.ev_b_in[oldcol(n)] : 0.f; }
  const int b = mb >> 13;
  const int tl0 = mb & 8191;
  const float2* rope = (const float2*)(ws + OFF_ROPE);
  if (nb < 1024) {
    store_rm<0>((bf16_t*)(ws + L0_QKRAW), 1024, nb, acc, bias, mb, lane);
  } else if (nb < 1536) {
    store_T<0>((bf16_t*)(ws + L0_MVT), b * 4 + ((nb - 1024) >> 7), 128, (nb - 1024) & 127, acc, bias, tl0, lane);
  } else if (nb < 2048) {
    store_rm<1>((bf16_t*)(ws + L0_MO), 512, nb - 1536, acc, bias, mb, lane);
  } else if (nb < 2560) {
    store_rm<2>((bf16_t*)(ws + L0_MZ), 512, nb - 2048, acc, bias, mb, lane);
  } else if (nb < 3072) {
    int head = (nb - 2560) >> 6, g = head >> 2, rr = head & 3;
    norm_rope_store((bf16_t*)(ws + L0_QN), (long)(b * 2 + g) * 8192, 256, rr * 64, acc, bias, p.q_norm, 0.125f * 1.4426950408889634f, rope, mb, lane);
  } else if (nb < 3328) {
    int g = ((nb - 3072) >> 6) & 1;
    bf16_t* dst = (bf16_t*)(ws + (nb < 3200 ? L0_KCRAW : L0_VCRAW));
    const long rowbase = (long)(b * 2 + g) * 8192;
#pragma unroll
    for (int mt = 0; mt < 4; ++mt)
#pragma unroll
      for (int i = 0; i < 4; ++i) {
        int t = (mb + mt * 16 + q * 4 + i) & 8191;
#pragma unroll
        for (int nt = 0; nt < 4; ++nt) dst[(rowbase + t) * 64 + nt * 16 + r] = f2bf(acc[mt][nt][i] + bias[nt]);
      }
  } else if (nb < 3456) {
    int g = (nb - 3328) >> 6;
    norm_rope_store((bf16_t*)(ws + L0_KS), (long)(b * 2 + g) * 8192, 64, 0, acc, bias, p.k_norm + 64, 1.f, rope, mb, lane);
  } else if (nb < 3584) {
    store_T<0>((bf16_t*)(ws + L0_VST), b * 2 + ((nb - 3456) >> 6), 64, 0, acc, bias, tl0, lane);
  } else if (nb < 3712) {
    int g = (nb - 3584) >> 6;
    norm_rope_store((bf16_t*)(ws + L0_KW), (long)(b * 2 + g) * 8192, 64, 0, acc, bias, p.k_norm + 128, 1.f, rope, mb, lane);
  } else if (nb < 3840) {
    store_T<0>((bf16_t*)(ws + L0_VWT), b * 2 + ((nb - 3712) >> 6), 64, 0, acc, bias, tl0, lane);
  } else if (nb < 4352) {
    store_rm<2>((bf16_t*)(ws + L0_NZ), 512, nb - 3840, acc, bias, mb, lane);
  } else {
    float* IG = (float*)(ws + L0_IG);
    float* LF = (float*)(ws + L0_LOGF);
    float* GT = (float*)(ws + L0_GATES);
#pragma unroll
    for (int mt = 0; mt < 4; ++mt)
#pragma unroll
      for (int i = 0; i < 4; ++i) {
        long row = mb + mt * 16 + q * 4 + i;
#pragma unroll
        for (int nt = 0; nt < 2; ++nt) {
          int c = nt * 16 + r;
          float v = acc[mt][nt][i] + bias[nt];
          if (c < 4) IG[row * 4 + c] = v;
          else if (c < 8) { float xx = v + p.f_bias[c - 4]; LF[row * 4 + c - 4] = fminf(xx, 0.f) - log1pf(__expf(-fabsf(xx))); }
          else GT[row * 24 + c - 8] = sigm(v);
        }
      }
  }
}

DEVI void epi_cmp_hidden(const Params& p, f32x4 (&acc)[4][4], int mb, int nb, int lane, int kv, int bg, int ksp) {
  const int r = lane & 15, q = lane >> 4;
  float* hid = (float*)(p.ws + L0_HIDP) + ((long)((ksp * 2 + kv) * 4 + bg) * 512) * 128;
#pragma unroll
  for (int mt = 0; mt < 4; ++mt)
#pragma unroll
    for (int i = 0; i < 4; ++i) {
      int row = mb + mt * 16 + q * 4 + i;
#pragma unroll
      for (int nt = 0; nt < 4; ++nt) hid[(long)row * 128 + nb + nt * 16 + r] = acc[mt][nt][i];
    }
}

DEVI void epi_out_resid(const float* resid, float* out, f32x4 (&acc)[4][4], int mb, int nb, int lane) {
  const int r = lane & 15, q = lane >> 4;
#pragma unroll
  for (int mt = 0; mt < 4; ++mt) {
    float rv[4][4];
#pragma unroll
    for (int i = 0; i < 4; ++i)
#pragma unroll
      for (int nt = 0; nt < 4; ++nt) rv[i][nt] = resid[(long)(mb + mt * 16 + q * 4 + i) * 1024 + nb + nt * 16 + r];
#pragma unroll
    for (int i = 0; i < 4; ++i)
#pragma unroll
      for (int nt = 0; nt < 4; ++nt) out[(long)(mb + mt * 16 + q * 4 + i) * 1024 + nb + nt * 16 + r] = rv[i][nt] + acc[mt][nt][i];
  }
}

DEVI void epi_proj1(const Params& p, f32x4 (&acc)[4][4], int mb, int nb, int lane) {
  unsigned char* ws = p.ws;
  const int r = lane & 15;
  float bias[4];
#pragma unroll
  for (int nt = 0; nt < 4; ++nt) bias[nt] = p.od_b_in[nb + nt * 16 + r];
  const int b = mb >> 13, tl0 = mb & 8191;
  if (nb < 1024) store_rm<0>((bf16_t*)(ws + L1_FP), 1024, nb, acc, bias, mb, lane);
  else if (nb < 2048) store_T<0>((bf16_t*)(ws + L1_VT), b * 8 + ((nb - 1024) >> 7), 128, (nb - 1024) & 127, acc, bias, tl0, lane);
  else if (nb < 3072) store_rm<2>((bf16_t*)(ws + L1_Q), 1024, nb - 2048, acc, bias, mb, lane);
  else store_rm<2>((bf16_t*)(ws + L1_Z), 1024, nb - 3072, acc, bias, mb, lane);
}

DEVI void conv_tile(const Params& p, int item, unsigned char* smem) {
  const int tid = opaque_tid();
  const int ctile = item & 7, ttile = item >> 3;
  const int t0g = ttile * 64;
  const int b = t0g >> 13, tl0 = t0g & 8191;
  unsigned char* ws = p.ws;
  float* sRaw = (float*)smem;
  bf16_t* sOutT = (bf16_t*)(smem + 67 * 128 * 4);
  const bf16_t* raw = (const bf16_t*)(ws + L0_QKRAW);
  for (int idx = tid; idx < 67 * 16; idx += 256) {
    int rr = idx >> 4, ch = (idx & 15) * 8;
    int tl = tl0 + rr - 3;
    uint4 v = make_uint4(0, 0, 0, 0);
    if (tl >= 0) v = *(const uint4*)(raw + (long)(b * 8192 + tl) * 1024 + ctile * 128 + ch);
    float* d = sRaw + rr * 128 + ch;
    d[0] = lo2f(v.x); d[1] = hi2f(v.x); d[2] = lo2f(v.y); d[3] = hi2f(v.y);
    d[4] = lo2f(v.z); d[5] = hi2f(v.z); d[6] = lo2f(v.w); d[7] = hi2f(v.w);
  }
  __syncthreads();
  const int c = tid & 127, th = tid >> 7;
  const int cg_ = ctile * 128 + c;
  const float w0 = p.conv_w[cg_], w1 = p.conv_w[1024 + cg_], w2 = p.conv_w[2048 + cg_], w3 = p.conv_w[3072 + cg_];
  const float cb = p.conv_b[cg_];
  const bool isk = ctile >= 4;
  bf16_t* dst = (bf16_t*)(ws + (isk ? L0_KC : L0_QC));
  const int cc = isk ? cg_ - 512 : cg_;
  const float sc = isk ? 0.08838834764831845f : 1.f;
  for (int t = th * 32; t < th * 32 + 32; ++t) {
    float a = cb + w0 * sRaw[t * 128 + c] + w1 * sRaw[(t + 1) * 128 + c] + w2 * sRaw[(t + 2) * 128 + c] + w3 * sRaw[(t + 3) * 128 + c];
    bf16_t o = f2bf(siluf(a) * sc);
    dst[(long)(t0g + t) * 512 + cc] = o;
    sOutT[c * LDT + t] = o;
  }
  __syncthreads();
  if (isk) {
    bf16_t* kct = (bf16_t*)(ws + L0_KCT);
#pragma unroll
    for (int j = 0; j < 4; ++j) {
      int idx = tid + 256 * j;
      int cr = idx >> 3, tc = (idx & 7) * 8;
      *(uint4*)(kct + ((((long)(b * 4 + (ctile - 4)) * 128 + (tl0 >> 6)) * 128 + cr) * 64) + tc) = *(const uint4*)(sOutT + cr * LDT + tc);
    }
  }
  __syncthreads();
}

DEVI void cmp_finalize(const Params& p, int task, int lane) {
  const int n = task & 511, bg = (task >> 9) & 3, kv = task >> 11;
  unsigned char* ws = p.ws;
  bf16_t* KCMP = (bf16_t*)(ws + L0_KCMP);
  bf16_t* VCMPT = (bf16_t*)(ws + L0_VCMPT);
  if (n == 511) {
    if (kv == 0) KCMP[((long)bg * 512 + 511) * 64 + lane] = 0;
    else VCMPT[((long)bg * 64 + lane) * 512 + 511] = 0;
    return;
  }
  const float* hid = (const float*)(ws + L0_HIDP) + ((long)(kv * 4 + bg) * 512 + n) * 128;
  const float* pbv = (const float*)(ws + OFF_PB) + kv * 128;
  const float* w2 = kv ? p.cv_w2 : p.ck_w2;
  float g0, g1;
  {
    float x0 = ((hid[lane] + hid[lane + 524288]) + (hid[lane + 2 * 524288] + hid[lane + 3 * 524288])) + pbv[lane];
    float x1 = ((hid[lane + 64] + hid[lane + 64 + 524288]) + (hid[lane + 64 + 2 * 524288] + hid[lane + 64 + 3 * 524288])) + pbv[lane + 64];
    g0 = 0.5f * x0 * (1.f + tanhf(0.7978845608028654f * (x0 + 0.044715f * x0 * x0 * x0)));
    g1 = 0.5f * x1 * (1.f + tanhf(0.7978845608028654f * (x1 + 0.044715f * x1 * x1 * x1)));
  }
  float a = 0.f;
  for (int j0 = 0; j0 < 64; j0 += 16) {
    float wv[16], wu[16];
#pragma unroll
    for (int k = 0; k < 16; ++k) { wv[k] = w2[(j0 + k) * 64 + lane]; wu[k] = w2[(64 + j0 + k) * 64 + lane]; }
#pragma unroll
    for (int k = 0; k < 16; ++k) a += __shfl(g0, j0 + k) * wv[k] + __shfl(g1, j0 + k) * wu[k];
  }
  if (kv == 0) {
    float ss = wave_sum(a * a);
    float rinv = rsqrtf(ss * (1.f / 64.f) + EPSF);
    float v = a * rinv * p.k_norm[lane];
    float partner = __shfl_xor(v, 8);
    int pos = 16 * n + 31;
    float2 cs = ((const float2*)(ws + OFF_ROPE))[pos * 8 + (lane & 7)];
    float o = v;
    if (lane < 8) o = v * cs.x - partner * cs.y;
    else if (lane < 16) o = partner * cs.y + v * cs.x;
    KCMP[((long)bg * 512 + n) * 64 + lane] = f2bf(o);
  } else {
    VCMPT[((long)bg * 64 + lane) * 512 + n] = f2bf(a);
  }
}

DEVI void mlstm_local(const Params& p, int unit, unsigned char* smem) {
  const int tid = opaque_tid(), lane = tid & 63, w = tid >> 6, wr = w >> 1, wc = w & 1;
  const int bh = unit >> 6, c = unit & 63, b = bh >> 2, h = bh & 3, t0 = c * 128;
  const long R0 = (long)b * 8192 + t0;
  unsigned char* ws = p.ws;
  bf16_t* sA = (bf16_t*)smem;
  bf16_t* sB = (bf16_t*)(smem + 18432);
  float* sIg = (float*)(smem + 36864);
  float* sLf = sIg + 128;
  float* sW = sLf + 128;
  const float* IG = (const float*)(ws + L0_IG);
  const float* LF = (const float*)(ws + L0_LOGF);
  if (tid < 128) { sIg[tid] = IG[(R0 + tid) * 4 + h]; sLf[tid] = LF[(R0 + tid) * 4 + h]; }
  __syncthreads();
  if (tid < 64) {
    float c0 = sLf[2 * tid], c1 = sLf[2 * tid + 1];
    wave_scan_sum128(c0, c1, tid);
    const float bL = __shfl(c1, 63);
    float d0 = bL - c0 + sIg[2 * tid], d1 = bL - c1 + sIg[2 * tid + 1];
    const float ml = wave_max(fmaxf(d0, d1));
    sW[2 * tid] = __expf(d0 - ml); sW[2 * tid + 1] = __expf(d1 - ml);
    if (tid == 0) { ((float*)(ws + L0_BL))[unit] = bL; ((float*)(ws + L0_MLOC))[unit] = ml; }
  }
  __syncthreads();
  f32x4 acc[4][4];
#pragma unroll
  for (int mt = 0; mt < 4; ++mt)
#pragma unroll
    for (int nt = 0; nt < 4; ++nt) acc[mt][nt] = f32x4{0.f, 0.f, 0.f, 0.f};
  float dn = 0.f;
  const bf16_t* vt = (const bf16_t*)(ws + L0_MVT) + (((long)(b * 4 + h) * 128 + (t0 >> 6)) * 128) * 64;
  const bf16_t* kt_ = (const bf16_t*)(ws + L0_KCT) + (((long)(b * 4 + h) * 128 + (t0 >> 6)) * 128) * 64;
  const int lr = tid >> 3, lk = (tid & 7) * 8;
  for (int kt = 0; kt < 2; ++kt) {
    load_tile128(sA, vt + kt * 8192, 64);
#pragma unroll
    for (int j = 0; j < 4; ++j) {
      uint4 v = *(const uint4*)(kt_ + (long)kt * 8192 + (lr + 32 * j) * 64 + lk);
      const float* ww = sW + kt * 64 + lk;
      uint4 o;
      o.x = pack2(lo2f(v.x) * ww[0], hi2f(v.x) * ww[1]);
      o.y = pack2(lo2f(v.y) * ww[2], hi2f(v.y) * ww[3]);
      o.z = pack2(lo2f(v.z) * ww[4], hi2f(v.z) * ww[5]);
      o.w = pack2(lo2f(v.w) * ww[6], hi2f(v.w) * ww[7]);
      *(uint4*)(sB + (lr + 32 * j) * LDT + lk) = o;
    }
    __syncthreads();
    if (tid < 128) {
#pragma unroll 8
      for (int s = 0; s < 64; ++s) dn += bf2f(sB[tid * LDT + s]);
    }
    mma_lds<4, 4, 2>(sA + wr * 64 * LDT, sB + wc * 64 * LDT, acc, lane);
    __syncthreads();
  }
  float* dct = (float*)(ws + L0_H) + (long)unit * 16384;
  const int r = lane & 15, q = lane >> 4;
#pragma unroll
  for (int mt = 0; mt < 4; ++mt)
#pragma unroll
    for (int i = 0; i < 4; ++i) {
      int e = wr * 64 + mt * 16 + q * 4 + i;
#pragma unroll
      for (int nt = 0; nt < 4; ++nt) dct[e * 128 + wc * 64 + nt * 16 + r] = acc[mt][nt][i];
    }
  if (tid < 128) ((float*)(ws + L0_DN))[unit * 128 + tid] = dn;
}

template <bool DUMMY>
DEVI void mlstm_scan(const Params& p, unsigned char* smem) {
  unsigned char* ws = p.ws;
  const float* BL = (const float*)(ws + L0_BL);
  const float* ML = (const float*)(ws + L0_MLOC);
  float* MIN_ = (float*)(ws + L0_MIN);
  float* sDec = (float*)smem;
  float* sWn = sDec + 128;
  const int tid = opaque_tid();
  const int total = 8 * 16384 + 8 * 128;
  for (int base = blockIdx.x * 256; base < total; base += gridDim.x * 256) {
    const int bh0 = (base < 131072) ? (base >> 14) : ((base - 131072) >> 7);
    __syncthreads();
    if (tid < 2) {
      const int bh = bh0 + tid;
      if (bh < 8) {
        float m = 0.f;
        for (int c = 0; c < 64; ++c) {
          const int unit = bh * 64 + c;
          const float bL = BL[unit], ml = ML[unit];
          if (!DUMMY && base < 131072 && (base & 16383) == 0 && tid == 0) MIN_[unit] = m;
          const float mn = fmaxf(bL + m, ml);
          sDec[tid * 64 + c] = __expf(bL + m - mn);
          sWn[tid * 64 + c] = __expf(ml - mn);
          m = mn;
        }
      }
    }
    __syncthreads();
    const int idx = base + tid;
    if (idx < total) {
      float* ptr; long stride; int sel;
      if (idx < 131072) { const int bh = idx >> 14; ptr = (float*)(ws + L0_H) + (long)bh * 64 * 16384 + (idx & 16383); stride = 16384; sel = bh - bh0; }
      else { const int j = idx - 131072; const int bh = j >> 7; ptr = (float*)(ws + L0_DN) + (long)bh * 64 * 128 + (j & 127); stride = 128; sel = bh - bh0; }
      const float* dec = sDec + sel * 64;
      const float* wn = sWn + sel * 64;
      float C = 0.f;
      for (int c0 = 0; c0 < 64; c0 += 8) {
        float dv[8];
#pragma unroll
        for (int k = 0; k < 8; ++k) dv[k] = ptr[(long)(c0 + k) * stride];
#pragma unroll
        for (int k = 0; k < 8; ++k) {
          if (!DUMMY) ptr[(long)(c0 + k) * stride] = C;
          C = dec[c0 + k] * C + wn[c0 + k] * dv[k];
        }
      }
      if (DUMMY && C == 123.456f) MIN_[0] = C;
    }
  }
}

DEVI void mlstm_out(const Params& p, int item, unsigned char* smem) {
  const int tid = opaque_tid(), lane = tid & 63, w = tid >> 6, wr = w >> 1, wc = w & 1;
  const int r = lane & 15, q = lane >> 4;
  const int unit = item >> 1, u = item & 1;
  const int bh = unit >> 6, c = unit & 63, b = bh >> 2, h = bh & 3, t0 = c * 128;
  const long R0 = (long)b * 8192 + t0;
  const int J0 = u * 64;
  unsigned char* ws = p.ws;
  bf16_t* sA = (bf16_t*)smem;
  bf16_t* sB = (bf16_t*)(smem + 9216);
  bf16_t* sS0 = (bf16_t*)(smem + 27648);
  bf16_t* sS1 = (bf16_t*)(smem + 36864);
  float* fl = (float*)(smem + 46080);
  float* sIg = fl; float* sLf = fl + 128; float* sRj = fl + 256; float* sCs = fl + 384; float* sWi = fl + 512;
  float* sEm = fl + 640; float* sQn = fl + 768; float* sNin = fl + 896; float* sDen = fl + 1024; float* sSs = fl + 1280;
  const float* IG = (const float*)(ws + L0_IG);
  const float* LF = (const float*)(ws + L0_LOGF);
  const bf16_t* QC = (const bf16_t*)(ws + L0_QC) + (R0 + J0) * 512 + h * 128;
  const bf16_t* KC = (const bf16_t*)(ws + L0_KC) + R0 * 512 + h * 128;
  if (tid < 128) { sIg[tid] = IG[(R0 + tid) * 4 + h]; sLf[tid] = LF[(R0 + tid) * 4 + h]; sNin[tid] = ((const float*)(ws + L0_DN))[unit * 128 + tid]; }
  const float m_in = ((const float*)(ws + L0_MIN))[unit];
  __syncthreads();
  if (tid < 64) {
    float c0 = sLf[2 * tid], c1 = sLf[2 * tid + 1];
    wave_scan_sum128(c0, c1, tid);
    const float a0 = sIg[2 * tid] - c0, a1 = sIg[2 * tid + 1] - c1;
    float x0 = a0, x1 = a1;
    wave_scan_max128(x0, x1, tid);
    const float mx0 = fmaxf(x0, m_in), mx1 = fmaxf(x1, m_in);
    sCs[2 * tid] = a0; sCs[2 * tid + 1] = a1;
    sRj[2 * tid] = -mx0; sRj[2 * tid + 1] = -mx1;
    sWi[2 * tid] = __expf(m_in - mx0); sWi[2 * tid + 1] = __expf(m_in - mx1);
    sEm[2 * tid] = __expf(-(c0 + mx0)); sEm[2 * tid + 1] = __expf(-(c1 + mx1));
  }
  if (tid >= 128 && tid < 192) {
    int jl = tid - 128;
    const bf16_t* qr = QC + (long)jl * 512;
    float s = 0.f;
#pragma unroll 2
    for (int ch = 0; ch < 16; ++ch) {
      uint4 v = *(const uint4*)(qr + ch * 8);
      const float* nn = sNin + ch * 8;
      s += lo2f(v.x) * nn[0] + hi2f(v.x) * nn[1] + lo2f(v.y) * nn[2] + hi2f(v.y) * nn[3] + lo2f(v.z) * nn[4] + hi2f(v.z) * nn[5] + lo2f(v.w) * nn[6] + hi2f(v.w) * nn[7];
    }
    sQn[jl] = s;
  }
  __syncthreads();
  f32x4 acc[2][4];
#pragma unroll
  for (int mt = 0; mt < 2; ++mt)
#pragma unroll
    for (int nt = 0; nt < 4; ++nt) acc[mt][nt] = f32x4{0.f, 0.f, 0.f, 0.f};
  const bool skipS = (wc > u);
  const int lr = tid >> 3, lk = (tid & 7) * 8;
  {
    u32x4 qa0, qa1, kb0, kb1, kb2, kb3;
    qa0 = *(const u32x4*)(QC + (long)lr * 512 + lk); qa1 = *(const u32x4*)(QC + (long)(lr + 32) * 512 + lk);
    kb0 = *(const u32x4*)(KC + (long)lr * 512 + lk); kb1 = *(const u32x4*)(KC + (long)(lr + 32) * 512 + lk);
    kb2 = *(const u32x4*)(KC + (long)(lr + 64) * 512 + lk); kb3 = *(const u32x4*)(KC + (long)(lr + 96) * 512 + lk);
#pragma unroll 1
    for (int kt = 0; kt < 2; ++kt) {
      *(u32x4*)(sA + lr * LDT + lk) = qa0; *(u32x4*)(sA + (lr + 32) * LDT + lk) = qa1;
      *(u32x4*)(sB + lr * LDT + lk) = kb0; *(u32x4*)(sB + (lr + 32) * LDT + lk) = kb1;
      *(u32x4*)(sB + (lr + 64) * LDT + lk) = kb2; *(u32x4*)(sB + (lr + 96) * LDT + lk) = kb3;
      __syncthreads();
      if (kt == 0) {
        qa0 = *(const u32x4*)(QC + (long)lr * 512 + 64 + lk); qa1 = *(const u32x4*)(QC + (long)(lr + 32) * 512 + 64 + lk);
        kb0 = *(const u32x4*)(KC + (long)lr * 512 + 64 + lk); kb1 = *(const u32x4*)(KC + (long)(lr + 32) * 512 + 64 + lk);
        kb2 = *(const u32x4*)(KC + (long)(lr + 64) * 512 + 64 + lk); kb3 = *(const u32x4*)(KC + (long)(lr + 96) * 512 + 64 + lk);
      }
      if (!skipS) mma_lds<2, 4, 2>(sA + wr * 32 * LDT, sB + wc * 64 * LDT, acc, lane);
      __syncthreads();
    }
  }
  {
    bf16_t* sS = wc ? sS1 : sS0;
#pragma unroll
    for (int mt = 0; mt < 2; ++mt)
#pragma unroll
      for (int i = 0; i < 4; ++i) {
        int jl = wr * 32 + mt * 16 + q * 4 + i;
        int j = J0 + jl;
        float rj = sRj[j], rs = 0.f;
#pragma unroll
        for (int nt = 0; nt < 4; ++nt) {
          int sl = nt * 16 + r, s = wc * 64 + sl;
          float val = (s <= j) ? acc[mt][nt][i] * __expf(rj + sCs[s]) : 0.f;
          rs += val;
          sS[jl * LDT + sl] = f2bf(val);
        }
        rs = grp16_sum(rs);
        if (r == 0) sDen[wc * 64 + jl] = rs;
      }
  }
#pragma unroll
  for (int mt = 0; mt < 2; ++mt)
#pragma unroll
    for (int nt = 0; nt < 4; ++nt) acc[mt][nt] = f32x4{0.f, 0.f, 0.f, 0.f};
  const bf16_t* vt = (const bf16_t*)(ws + L0_MVT) + (((long)(b * 4 + h) * 128 + (t0 >> 6)) * 128) * 64;
  const float* ct = (const float*)(ws + L0_H) + (long)unit * 16384;
  {
    u32x4 vb0, vb1, vb2, vb3;
    u32x4 qa0, qa1;
    float4 cv[8];
    const int nsteps = u ? 4 : 3;
    auto kind_of = [&](int sidx) { return u ? sidx : (sidx == 0 ? 0 : sidx + 1); };
    auto fetch = [&](int kind) {
      if (kind < 2) {
        const bf16_t* vp = vt + (long)kind * 8192 + lr * 64 + lk;
        vb0 = *(const u32x4*)vp; vb1 = *(const u32x4*)(vp + 32 * 64); vb2 = *(const u32x4*)(vp + 64 * 64); vb3 = *(const u32x4*)(vp + 96 * 64);
      } else {
        const int k2 = kind - 2;
        qa0 = *(const u32x4*)(QC + (long)lr * 512 + k2 * 64 + lk); qa1 = *(const u32x4*)(QC + (long)(lr + 32) * 512 + k2 * 64 + lk);
#pragma unroll
        for (int j = 0; j < 8; ++j) cv[j] = *(const float4*)(ct + (long)((tid >> 4) + 16 * j) * 128 + k2 * 64 + (tid & 15) * 4);
      }
    };
    fetch(0);
#pragma unroll 1
    for (int sidx = 0; sidx < nsteps; ++sidx) {
      const int kind = kind_of(sidx);
      const bf16_t* aS;
      if (kind < 2) {
        *(u32x4*)(sB + lr * LDT + lk) = vb0; *(u32x4*)(sB + (lr + 32) * LDT + lk) = vb1;
        *(u32x4*)(sB + (lr + 64) * LDT + lk) = vb2; *(u32x4*)(sB + (lr + 96) * LDT + lk) = vb3;
        aS = kind ? sS1 : sS0;
      } else {
        const float w0 = sWi[J0 + lr], w1 = sWi[J0 + lr + 32];
        u32x4 o0, o1;
        o0[0] = pack2(lo2f(qa0[0]) * w0, hi2f(qa0[0]) * w0); o0[1] = pack2(lo2f(qa0[1]) * w0, hi2f(qa0[1]) * w0);
        o0[2] = pack2(lo2f(qa0[2]) * w0, hi2f(qa0[2]) * w0); o0[3] = pack2(lo2f(qa0[3]) * w0, hi2f(qa0[3]) * w0);
        o1[0] = pack2(lo2f(qa1[0]) * w1, hi2f(qa1[0]) * w1); o1[1] = pack2(lo2f(qa1[1]) * w1, hi2f(qa1[1]) * w1);
        o1[2] = pack2(lo2f(qa1[2]) * w1, hi2f(qa1[2]) * w1); o1[3] = pack2(lo2f(qa1[3]) * w1, hi2f(qa1[3]) * w1);
        *(u32x4*)(sA + lr * LDT + lk) = o0; *(u32x4*)(sA + (lr + 32) * LDT + lk) = o1;
#pragma unroll
        for (int j = 0; j < 8; ++j) {
          uint2 o;
          o.x = pack2(cv[j].x, cv[j].y);
          o.y = pack2(cv[j].z, cv[j].w);
          *(uint2*)(sB + ((tid >> 4) + 16 * j) * LDT + (tid & 15) * 4) = o;
        }
        aS = sA;
      }
      __syncthreads();
      if (sidx + 1 < nsteps) fetch(kind_of(sidx + 1));
      mma_lds<2, 4, 2>(aS + wr * 32 * LDT, sB + wc * 64 * LDT, acc, lane);
      __syncthreads();
    }
  }
#pragma unroll
  for (int mt = 0; mt < 2; ++mt)
#pragma unroll
    for (int i = 0; i < 4; ++i) {
      int jl = wr * 32 + mt * 16 + q * 4 + i;
      int j = J0 + jl;
      float den = sDen[jl] + sDen[64 + jl] + sWi[j] * sQn[jl];
      float dinv = 1.f / fmaxf(fabsf(den), sEm[j]);
      float ss = 0.f;
#pragma unroll
      for (int nt = 0; nt < 4; ++nt) { float v = acc[mt][nt][i] * dinv; acc[mt][nt][i] = v; ss += v * v; }
      ss = grp16_sum(ss);
      if (r == 0) sSs[wc * 64 + jl] = ss;
    }
  __syncthreads();
  const bf16_t* MO = (const bf16_t*)(ws + L0_MO);
  const bf16_t* MZ = (const bf16_t*)(ws + L0_MZ);
  bf16_t* Y = (bf16_t*)(ws + L0_QKRAW);
  float hn[4];
#pragma unroll
  for (int nt = 0; nt < 4; ++nt) hn[nt] = p.m_hn[h * 128 + wc * 64 + nt * 16 + r];
#pragma unroll
  for (int mt = 0; mt < 2; ++mt) {
    float gv[4][4];
#pragma unroll
    for (int i = 0; i < 4; ++i) {
      long row = R0 + J0 + wr * 32 + mt * 16 + q * 4 + i;
#pragma unroll
      for (int nt = 0; nt < 4; ++nt) {
        int col = h * 128 + wc * 64 + nt * 16 + r;
        gv[i][nt] = bf2f(MO[row * 512 + col]) * bf2f(MZ[row * 512 + col]);
      }
    }
#pragma unroll
    for (int i = 0; i < 4; ++i) {
      int jl = wr * 32 + mt * 16 + q * 4 + i;
      float rinv = rsqrtf((sSs[jl] + sSs[64 + jl]) * (1.f / 128.f) + EPSF);
      long row = R0 + J0 + jl;
#pragma unroll
      for (int nt = 0; nt < 4; ++nt) {
        int col = h * 128 + wc * 64 + nt * 16 + r;
        Y[row * 1024 + col] = f2bf(acc[mt][nt][i] * rinv * hn[nt] * gv[i][nt]);
      }
    }
  }
  __syncthreads();
}

struct NsaSm {
  bf16_t* sK; bf16_t* sV;
  float* sImpA; float* sImpB;
  unsigned* sSel; unsigned* sGrp; unsigned* sUn;
};

DEVI int next_bit(unsigned long long lo, unsigned long long hi, int from) {
  if (from < 64) {
    unsigned long long v = lo & (~0ull << from);
    if (v) return __builtin_ctzll(v);
    if (hi) return 64 + __builtin_ctzll(hi);
    return -1;
  }
  if (from >= 128) return -1;
  unsigned long long v = hi & (~0ull << (from - 64));
  if (v) return 64 + __builtin_ctzll(v);
  return -1;
}

template <int MODE, bool DUMMY = false, class MaskF, class ActF>
DEVI void nsa_branch(const NsaSm& sm, unsigned long long tmlo, unsigned long long tmhi,
                     const bf16_t* Kg, const bf16_t* Vg, long vstep, long ldv,
                     const bf16x8 (&qf)[2][2], f32x4 (&O)[4][2], float (&mrow)[2], float (&lrow)[2], const float (&invl)[2],
                     MaskF mask, ActF actf, int tokbase, int tid) {
  const int lane = tid & 63, r = lane & 15, q = lane >> 4;
  const int lr = tid >> 3, lk = (tid & 7) * 8;
  int j = next_bit(tmlo, tmhi, 0);
  if (j < 0) return;
  u32x4 k0, k1, v0, v1;
  u32x4 k2, k3, v2, v3;
  if (!DUMMY) {
    const bf16_t* kp = Kg + (long)j * 4096 + lr * 64 + lk;
    k0 = *(const u32x4*)kp; k1 = *(const u32x4*)(kp + 32 * 64);
    if (MODE != 1) {
      const bf16_t* vp = Vg + (long)j * vstep + (long)lr * ldv + lk;
      v0 = *(const u32x4*)vp; v1 = *(const u32x4*)(vp + 32 * ldv);
    }
    *(u32x4*)(sm.sK + lr * LDT + lk) = k0; *(u32x4*)(sm.sK + (lr + 32) * LDT + lk) = k1;
    if (MODE != 1) { *(u32x4*)(sm.sV + lr * LDT + lk) = v0; *(u32x4*)(sm.sV + (lr + 32) * LDT + lk) = v1; }
  }
  int j1 = next_bit(tmlo, tmhi, j + 1);
  if (!DUMMY && j1 >= 0) {
    const bf16_t* kp = Kg + (long)j1 * 4096 + lr * 64 + lk;
    k0 = *(const u32x4*)kp; k1 = *(const u32x4*)(kp + 32 * 64);
    if (MODE != 1) {
      const bf16_t* vp = Vg + (long)j1 * vstep + (long)lr * ldv + lk;
      v0 = *(const u32x4*)vp; v1 = *(const u32x4*)(vp + 32 * ldv);
    }
  }
  if (!DUMMY) __syncthreads();
  int buf = 0;
  while (true) {
    const int jn = j1;
    const int j2 = (j1 >= 0) ? next_bit(tmlo, tmhi, j1 + 1) : -1;
    if (!DUMMY && j2 >= 0) {
      const bf16_t* kp = Kg + (long)j2 * 4096 + lr * 64 + lk;
      k2 = *(const u32x4*)kp; k3 = *(const u32x4*)(kp + 32 * 64);
      if (MODE != 1) {
        const bf16_t* vp = Vg + (long)j2 * vstep + (long)lr * ldv + lk;
        v2 = *(const u32x4*)vp; v3 = *(const u32x4*)(vp + 32 * ldv);
      }
    }
    const bf16_t* sK = sm.sK + buf * (64 * LDT);
    const bf16_t* sV = sm.sV + buf * (64 * LDT);
    const bool a0 = actf(0, j), a1 = actf(1, j);
    __builtin_amdgcn_sched_barrier(0);
    if (a0 || a1) {
      const bool full = mask.full(j);
      f32x4 sacc[4][2];
#pragma unroll
      for (int mt = 0; mt < 4; ++mt) { sacc[mt][0] = f32x4{0.f, 0.f, 0.f, 0.f}; sacc[mt][1] = f32x4{0.f, 0.f, 0.f, 0.f}; }
      __builtin_amdgcn_s_setprio(2);
#pragma unroll
      for (int ks = 0; ks < 2; ++ks)
#pragma unroll
        for (int mt = 0; mt < 4; ++mt) {
          bf16x8 a = *(const bf16x8*)(sK + (mt * 16 + r) * LDT + ks * 32 + q * 8);
          if (a0) sacc[mt][0] = __builtin_amdgcn_mfma_f32_16x16x32_bf16(a, qf[0][ks], sacc[mt][0], 0, 0, 0);
          if (a1) sacc[mt][1] = __builtin_amdgcn_mfma_f32_16x16x32_bf16(a, qf[1][ks], sacc[mt][1], 0, 0, 0);
        }
      __builtin_amdgcn_s_setprio(0);
      __builtin_amdgcn_sched_barrier(0);
#pragma unroll
      for (int nt = 0; nt < 2; ++nt) {
        const bool act = nt ? a1 : a0;
        if (act) {
          const bool lb = mask.bit(nt, j);
          if (!full) {
#pragma unroll
            for (int mt = 0; mt < 4; ++mt)
#pragma unroll
              for (int i = 0; i < 4; ++i) sacc[mt][nt][i] = mask.elem(mt * 16 + q * 4 + i, nt, j) ? sacc[mt][nt][i] : NEGS;
          }
          if (MODE != 2) {
            float tmx = fmaxf(fmaxf(sacc[0][nt][0], sacc[0][nt][1]), fmaxf(sacc[0][nt][2], sacc[0][nt][3]));
#pragma unroll
            for (int mt = 1; mt < 4; ++mt)
              tmx = fmaxf(tmx, fmaxf(fmaxf(sacc[mt][nt][0], sacc[mt][nt][1]), fmaxf(sacc[mt][nt][2], sacc[mt][nt][3])));
            if (MaskF::HASBIT) tmx = lb ? tmx : NEGS;
            tmx = fmaxf(tmx, __shfl_xor(tmx, 16));
            tmx = fmaxf(tmx, __shfl_xor(tmx, 32));
            const float mo = mrow[nt];
            const float mn = fmaxf(mo, tmx);
            float mnc = fmaxf(mn, -1e20f);
            if (MaskF::HASBIT) mnc = lb ? mnc : 1e30f;
            mrow[nt] = mn;
            f32x4 psv = f32x4{0.f, 0.f, 0.f, 0.f};
#pragma unroll
            for (int mt = 0; mt < 4; ++mt) {
              f32x4 dd = sacc[mt][nt] - mnc;
              f32x4 pp;
              pp[0] = __builtin_amdgcn_exp2f(dd[0]); pp[1] = __builtin_amdgcn_exp2f(dd[1]);
              pp[2] = __builtin_amdgcn_exp2f(dd[2]); pp[3] = __builtin_amdgcn_exp2f(dd[3]);
              sacc[mt][nt] = pp;
              psv += pp;
            }
            const float ps = (psv[0] + psv[1]) + (psv[2] + psv[3]);
            const float al = __builtin_amdgcn_exp2f(mo - mn);
            lrow[nt] = lrow[nt] * al + ps;
            if (MODE == 0) {
              if (__any(al != 1.f)) {
#pragma unroll
                for (int dt = 0; dt < 4; ++dt) O[dt][nt] *= al;
              }
            }
          } else {
            const float mmc = fmaxf(mrow[nt], -1e20f), il = invl[nt];
            const int tok = tokbase + nt * 4 + (r >> 2);
#pragma unroll
            for (int mt = 0; mt < 4; ++mt) {
              float pp[4];
#pragma unroll
              for (int i = 0; i < 4; ++i) {
                pp[i] = __builtin_amdgcn_exp2f(sacc[mt][nt][i] - mmc) * il;
                sacc[mt][nt][i] = pp[i];
              }
              float mainv = 32.f * (pp[0] + pp[1] + pp[2]) + 16.f * pp[3];
              float carry = 16.f * pp[3];
              mainv += __shfl_xor(mainv, 1); mainv += __shfl_xor(mainv, 2);
              carry += __shfl_xor(carry, 1); carry += __shfl_xor(carry, 2);
              if ((r & 3) == 0) {
                const int mp = j * 16 + mt * 4 + q;
                sm.sImpA[tok * 128 + mp] = mainv;
                if (mp + 1 < 128) sm.sImpB[tok * 128 + mp + 1] = carry;
              }
            }
          }
        }
      }
      __builtin_amdgcn_sched_barrier(0);
      if (MODE != 1) {
        __builtin_amdgcn_s_setprio(2);
#pragma unroll
        for (int ks = 0; ks < 2; ++ks) {
          bf16x8 pb[2];
#pragma unroll
          for (int nt = 0; nt < 2; ++nt) {
            union { u32x4 u; bf16x8 h; } cv;
            cv.u[0] = pack2(sacc[2 * ks][nt][0], sacc[2 * ks][nt][1]);
            cv.u[1] = pack2(sacc[2 * ks][nt][2], sacc[2 * ks][nt][3]);
            cv.u[2] = pack2(sacc[2 * ks + 1][nt][0], sacc[2 * ks + 1][nt][1]);
            cv.u[3] = pack2(sacc[2 * ks + 1][nt][2], sacc[2 * ks + 1][nt][3]);
            pb[nt] = cv.h;
          }
#pragma unroll
          for (int dt = 0; dt < 4; ++dt) {
            union { u32x4 u; bf16x8 h; } av;
            const uint2 lo = *(const uint2*)(sV + (dt * 16 + r) * LDT + (2 * ks) * 16 + q * 4);
            const uint2 hi = *(const uint2*)(sV + (dt * 16 + r) * LDT + (2 * ks + 1) * 16 + q * 4);
            av.u[0] = lo.x; av.u[1] = lo.y; av.u[2] = hi.x; av.u[3] = hi.y;
            if (a0) O[dt][0] = __builtin_amdgcn_mfma_f32_16x16x32_bf16(av.h, pb[0], O[dt][0], 0, 0, 0);
            if (a1) O[dt][1] = __builtin_amdgcn_mfma_f32_16x16x32_bf16(av.h, pb[1], O[dt][1], 0, 0, 0);
          }
        }
        __builtin_amdgcn_s_setprio(0);
      }
    }
    __builtin_amdgcn_sched_barrier(0);
    if (!DUMMY && jn >= 0) {
      bf16_t* dK = sm.sK + (buf ^ 1) * (64 * LDT);
      bf16_t* dV = sm.sV + (buf ^ 1) * (64 * LDT);
      *(u32x4*)(dK + lr * LDT + lk) = k0; *(u32x4*)(dK + (lr + 32) * LDT + lk) = k1;
      if (MODE != 1) { *(u32x4*)(dV + lr * LDT + lk) = v0; *(u32x4*)(dV + (lr + 32) * LDT + lk) = v1; }
    }
    if (!DUMMY) __syncthreads();
    if (jn < 0) break;
    j = jn;
    j1 = j2;
    k0 = k2; k1 = k3; v0 = v2; v1 = v3;
    buf ^= 1;
  }
}

struct MaskC {
      static constexpr bool HASBIT = false;
      int t0_, t1_, tmin_;
      DEVI bool full(int jt) const { return 16 * (jt * 64 + 63) + 31 <= tmin_; }
      DEVI bool bit(int nt, int jt) const { return true; }
      DEVI bool elem(int key, int nt, int jt) const { return 16 * (jt * 64 + key) + 31 <= (nt ? t1_ : t0_); }
};

struct MaskS {
      static constexpr bool HASBIT = true;
      unsigned long long a_lo, a_hi, b_lo, b_hi; int t0_, t1_, cur_;
      DEVI bool full(int jt) const { return jt < cur_; }
      DEVI bool bit(int nt, int jt) const {
        const unsigned long long lo = nt ? b_lo : a_lo, hi = nt ? b_hi : a_hi;
        const unsigned long long wd = (jt < 64) ? (lo >> jt) : (hi >> (jt - 64));
        return (wd & 1ull) != 0ull;
      }
      DEVI bool elem(int key, int nt, int jt) const { return jt * 64 + key <= (nt ? t1_ : t0_); }
};

struct MaskW {
      static constexpr bool HASBIT = false;
      int t0_, t1_, tmin_, tmax_;
      DEVI bool full(int jt) const { return (jt * 64 + 63 <= tmin_) && (tmax_ - jt * 64 < 512); }
      DEVI bool bit(int nt, int jt) const { return true; }
      DEVI bool elem(int key, int nt, int jt) const { const int s_ = jt * 64 + key, t_ = nt ? t1_ : t0_; return (s_ <= t_) && (t_ - s_ < 512); }
};

DEVI void nsa_tile(const Params& p, int tileidx, unsigned char* smem) {
  const int tid = opaque_tid(), lane = tid & 63, w = tid >> 6, r = lane & 15, q = lane >> 4;
  const int bg = tileidx & 3, tt = tileidx >> 2, b = bg >> 1, g = bg & 1, t0 = tt * 32;
  unsigned char* ws = p.ws;
  NsaSm sm;
  sm.sK = (bf16_t*)smem; sm.sV = (bf16_t*)(smem + 18432);
  sm.sImpA = (float*)(smem + 36864); sm.sImpB = (float*)(smem + 53248);
  sm.sSel = (unsigned*)(smem + 69632); sm.sGrp = sm.sSel + 128; sm.sUn = sm.sGrp + 32;
  const int tokbase = 8 * w;
  bf16x8 qf[2][2];
  {
    const bf16_t* qn = (const bf16_t*)(ws + L0_QN) + ((long)bg * 8192 + t0) * 256 + (32 * w + r) * 64 + q * 8;
    qf[0][0] = *(const bf16x8*)(qn); qf[0][1] = *(const bf16x8*)(qn + 32);
    qf[1][0] = *(const bf16x8*)(qn + 16 * 64); qf[1][1] = *(const bf16x8*)(qn + 16 * 64 + 32);
  }
  int tq[2];
  const float* GT = (const float*)(ws + L0_GATES);
#pragma unroll
  for (int nt = 0; nt < 2; ++nt) tq[nt] = t0 + tokbase + nt * 4 + (r >> 2);
#define GATE(nt, k) (GT[((long)b * 8192 + tq[nt]) * 24 + (g * 4 + (r & 3)) * 3 + (k)])
  f32x4 O[4][2];
  f32x4* sOut = (f32x4*)(smem + 36864) + (w * 8) * 64 + lane;
  const int cur = t0 >> 6;
  float mrow[2], lrow[2], invl[2];
  for (int i = tid; i < 32 * 128; i += 256) { sm.sImpA[i] = 0.f; sm.sImpB[i] = 0.f; }
  __syncthreads();
  {
    const int nvmax = (t0 + 31 >= 31) ? (((t0 + 31 - 31) >> 4) + 1) : 0;
    int nkt = (nvmax + 63) >> 6;
    if (nkt > 8) nkt = 8;
    const unsigned long long cm0 = (1ull << nkt) - 1ull;
    const bf16_t* KCMP = (const bf16_t*)(ws + L0_KCMP) + (long)bg * 512 * 64;
    const bf16_t* VCMPT = (const bf16_t*)(ws + L0_VCMPT) + (long)bg * 64 * 512;
    MaskC mk{tq[0], tq[1], t0 + tokbase};
    auto act = [&](int nt, int jt) { return true; };
    mrow[0] = mrow[1] = NEGS; lrow[0] = lrow[1] = 0.f; invl[0] = invl[1] = 0.f;
    nsa_branch<1>(sm, cm0, 0ull, KCMP, VCMPT, 64, 512, qf, O, mrow, lrow, invl, mk, act, tokbase, tid);
#pragma unroll
    for (int nt = 0; nt < 2; ++nt) {
      float l = lrow[nt];
      l += __shfl_xor(l, 16); l += __shfl_xor(l, 32);
      invl[nt] = (l > 0.f) ? 1.f / l : 0.f;
    }
#pragma unroll
    for (int dt = 0; dt < 4; ++dt) { O[dt][0] = f32x4{0.f, 0.f, 0.f, 0.f}; O[dt][1] = f32x4{0.f, 0.f, 0.f, 0.f}; }
    nsa_branch<2>(sm, cm0, 0ull, KCMP, VCMPT, 64, 512, qf, O, mrow, lrow, invl, mk, act, tokbase, tid);
  }
  __syncthreads();
  {
    const int ncand = (cur - 2 > 0) ? cur - 2 : 0;
    const int nf = (cur >= 2) ? 3 : cur + 1;
    const int kk = 16 - nf;
    const int m0i = lane, m1i = lane + 64;
    const bool c0 = (m0i >= 1 && m0i <= cur - 2), c1 = (m1i <= cur - 2);
    for (int tqi = 0; tqi < 8; ++tqi) {
      const int tok = tokbase + tqi;
      bool s0, s1;
      if (ncand <= kk) { s0 = c0; s1 = c1; }
      else {
        const float f0 = sm.sImpA[tok * 128 + m0i] + sm.sImpB[tok * 128 + m0i];
        const float f1 = sm.sImpA[tok * 128 + m1i] + sm.sImpB[tok * 128 + m1i];
        const unsigned k0 = c0 ? (__float_as_uint(f0) + 1u) : 0u;
        const unsigned k1 = c1 ? (__float_as_uint(f1) + 1u) : 0u;
        unsigned prefix = 0u;
        for (int bit = 31; bit >= 0; --bit) {
          const unsigned cand = prefix | (1u << bit);
          const int cnt = __popcll(__ballot(k0 >= cand)) + __popcll(__ballot(k1 >= cand));
          if (cnt >= kk) prefix = cand;
        }
        const bool g0 = k0 > prefix, g1 = k1 > prefix;
        const int ng = __popcll(__ballot(g0)) + __popcll(__ballot(g1));
        const bool e0 = (k0 == prefix), e1 = (k1 == prefix);
        const unsigned long long be0 = __ballot(e0), be1 = __ballot(e1);
        const unsigned long long lm = (1ull << lane) - 1ull;
        const int re0 = __popcll(be0 & lm), re1 = __popcll(be0) + __popcll(be1 & lm);
        const int need = kk - ng;
        s0 = g0 || (e0 && re0 < need);
        s1 = g1 || (e1 && re1 < need);
      }
      s0 = s0 || (m0i == 0) || (m0i == cur) || (m0i == cur - 1);
      s1 = s1 || (m1i == cur) || (m1i == cur - 1);
      const unsigned long long lo = __ballot(s0), hi = __ballot(s1);
      if (lane == 0) {
        sm.sSel[tok * 4 + 0] = (unsigned)lo; sm.sSel[tok * 4 + 1] = (unsigned)(lo >> 32);
        sm.sSel[tok * 4 + 2] = (unsigned)hi; sm.sSel[tok * 4 + 3] = (unsigned)(hi >> 32);
      }
    }
  }
  __syncthreads();
  if (tid < 32) { int gi = tid >> 2, wd = tid & 3; unsigned u = 0; for (int k = 0; k < 4; ++k) u |= sm.sSel[(gi * 4 + k) * 4 + wd]; sm.sGrp[tid] = u; }
  __syncthreads();
  if (tid < 4) { unsigned u = 0; for (int gi = 0; gi < 8; ++gi) u |= sm.sGrp[gi * 4 + tid]; sm.sUn[tid] = u; }
  __syncthreads();
#pragma unroll
  for (int nt = 0; nt < 2; ++nt)
#pragma unroll
    for (int dt = 0; dt < 4; ++dt) sOut[(nt * 4 + dt) * 64] = O[dt][nt] * GATE(nt, 0);
  {
    const bf16_t* KS = (const bf16_t*)(ws + L0_KS) + (long)bg * 8192 * 64;
    const bf16_t* VST = (const bf16_t*)(ws + L0_VST) + (long)bg * 128 * 4096;
    const unsigned long long ulo = (unsigned long long)sm.sUn[0] | ((unsigned long long)sm.sUn[1] << 32);
    const unsigned long long uhi = (unsigned long long)sm.sUn[2] | ((unsigned long long)sm.sUn[3] << 32);
    const int tk0 = tokbase + (r >> 2), tk1 = tokbase + 4 + (r >> 2);
    MaskS mk{(unsigned long long)sm.sSel[tk0 * 4 + 0] | ((unsigned long long)sm.sSel[tk0 * 4 + 1] << 32),
             (unsigned long long)sm.sSel[tk0 * 4 + 2] | ((unsigned long long)sm.sSel[tk0 * 4 + 3] << 32),
             (unsigned long long)sm.sSel[tk1 * 4 + 0] | ((unsigned long long)sm.sSel[tk1 * 4 + 1] << 32),
             (unsigned long long)sm.sSel[tk1 * 4 + 2] | ((unsigned long long)sm.sSel[tk1 * 4 + 3] << 32), tq[0], tq[1], cur};
    unsigned long long g0lo, g0hi, g1lo, g1hi;
    {
      const unsigned* gp = sm.sGrp + (2 * w) * 4;
      g0lo = (unsigned long long)__builtin_amdgcn_readfirstlane(gp[0]) | ((unsigned long long)__builtin_amdgcn_readfirstlane(gp[1]) << 32);
      g0hi = (unsigned long long)__builtin_amdgcn_readfirstlane(gp[2]) | ((unsigned long long)__builtin_amdgcn_readfirstlane(gp[3]) << 32);
      g1lo = (unsigned long long)__builtin_amdgcn_readfirstlane(gp[4]) | ((unsigned long long)__builtin_amdgcn_readfirstlane(gp[5]) << 32);
      g1hi = (unsigned long long)__builtin_amdgcn_readfirstlane(gp[6]) | ((unsigned long long)__builtin_amdgcn_readfirstlane(gp[7]) << 32);
    }
    auto act = [&](int nt, int jt) {
      const unsigned long long lo = nt ? g1lo : g0lo, hi = nt ? g1hi : g0hi;
      const unsigned long long wd = (jt < 64) ? (lo >> jt) : (hi >> (jt - 64));
      return (wd & 1ull) != 0ull;
    };
    mrow[0] = mrow[1] = NEGS; lrow[0] = lrow[1] = 0.f;
#pragma unroll
    for (int dt = 0; dt < 4; ++dt) { O[dt][0] = f32x4{0.f, 0.f, 0.f, 0.f}; O[dt][1] = f32x4{0.f, 0.f, 0.f, 0.f}; }
#ifdef NSA_DUMMY_SEL
    {
      nsa_branch<0, true>(sm, ulo, uhi, KS, VST, 4096, 64, qf, O, mrow, lrow, invl, mk, act, tokbase, tid);
      float chk = lrow[0] + lrow[1];
#pragma unroll
      for (int dt = 0; dt < 4; ++dt) chk += O[dt][0][0] + O[dt][0][1] + O[dt][0][2] + O[dt][0][3] + O[dt][1][0] + O[dt][1][1] + O[dt][1][2] + O[dt][1][3];
      if (chk == 123.456f) sm.sUn[0] = 1u;
      mrow[0] = mrow[1] = NEGS; lrow[0] = lrow[1] = 0.f;
#pragma unroll
      for (int dt = 0; dt < 4; ++dt) { O[dt][0] = f32x4{0.f, 0.f, 0.f, 0.f}; O[dt][1] = f32x4{0.f, 0.f, 0.f, 0.f}; }
      __syncthreads();
    }
#endif
    nsa_branch<0>(sm, ulo, uhi, KS, VST, 4096, 64, qf, O, mrow, lrow, invl, mk, act, tokbase, tid);
#pragma unroll
    for (int nt = 0; nt < 2; ++nt) {
      float l = lrow[nt];
      l += __shfl_xor(l, 16); l += __shfl_xor(l, 32);
      const float f = GATE(nt, 1) * ((l > 0.f) ? 1.f / l : 0.f);
#pragma unroll
      for (int dt = 0; dt < 4; ++dt) sOut[(nt * 4 + dt) * 64] += O[dt][nt] * f;
    }
  }
  {
    const bf16_t* KW = (const bf16_t*)(ws + L0_KW) + (long)bg * 8192 * 64;
    const bf16_t* VWT = (const bf16_t*)(ws + L0_VWT) + (long)bg * 128 * 4096;
    const int jlo = ((t0 - 511 > 0) ? (t0 - 511) : 0) >> 6;
    unsigned long long wlo = 0ull, whi = 0ull;
    for (int jj = jlo; jj <= cur; ++jj) { if (jj < 64) wlo |= (1ull << jj); else whi |= (1ull << (jj - 64)); }
    MaskW mk{tq[0], tq[1], t0 + tokbase, t0 + tokbase + 7};
    auto act = [&](int nt, int jt) { return true; };
    mrow[0] = mrow[1] = NEGS; lrow[0] = lrow[1] = 0.f;
#pragma unroll
    for (int dt = 0; dt < 4; ++dt) { O[dt][0] = f32x4{0.f, 0.f, 0.f, 0.f}; O[dt][1] = f32x4{0.f, 0.f, 0.f, 0.f}; }
    nsa_branch<0>(sm, wlo, whi, KW, VWT, 4096, 64, qf, O, mrow, lrow, invl, mk, act, tokbase, tid);
#pragma unroll
    for (int nt = 0; nt < 2; ++nt) {
      float l = lrow[nt];
      l += __shfl_xor(l, 16); l += __shfl_xor(l, 32);
      const float f = GATE(nt, 2) * ((l > 0.f) ? 1.f / l : 0.f);
#pragma unroll
      for (int dt = 0; dt < 4; ++dt) O[dt][nt] = sOut[(nt * 4 + dt) * 64] + O[dt][nt] * f;
    }
  }
  const bf16_t* NZ = (const bf16_t*)(ws + L0_NZ);
  bf16_t* Y = (bf16_t*)(ws + L0_QKRAW);
  uint2 zzv[2][4];
#pragma unroll
  for (int nt = 0; nt < 2; ++nt)
#pragma unroll
    for (int dt = 0; dt < 4; ++dt)
      zzv[nt][dt] = *(const uint2*)(NZ + ((long)b * 8192 + tq[nt]) * 512 + (g * 4 + (r & 3)) * 64 + dt * 16 + q * 4);
#pragma unroll
  for (int nt = 0; nt < 2; ++nt) {
    const long tok = (long)b * 8192 + tq[nt];
    const int head = g * 4 + (r & 3);
#pragma unroll
    for (int dt = 0; dt < 4; ++dt) {
      const int d = dt * 16 + q * 4;
      const uint2 zz = zzv[nt][dt];
      uint2 o;
      o.x = pack2(O[dt][nt][0] * lo2f(zz.x), O[dt][nt][1] * hi2f(zz.x));
      o.y = pack2(O[dt][nt][2] * lo2f(zz.y), O[dt][nt][3] * hi2f(zz.y));
      *(uint2*)(Y + tok * 1024 + 512 + head * 64 + d) = o;
    }
  }
  __syncthreads();
}

DEVI void hgrn_local(const Params& p, int unit, unsigned char* smem) {
  const int tid = opaque_tid(), lane = tid & 63, w = tid >> 6, wr = w >> 1, wc = w & 1;
  const int bh = unit >> 7, c = unit & 127, b = bh >> 3, h = bh & 7, t0 = c * 64;
  const long R0 = (long)b * 8192 + t0;
  unsigned char* ws = p.ws;
  bf16_t* sA = (bf16_t*)smem;
  bf16_t* sB = (bf16_t*)(smem + 18432);
  float* psum = (float*)(smem + 36864);
  const int cch = tid & 127, half = tid >> 7;
  const float lb = ((const float*)(ws + OFF_LB))[h * 128 + cch];
  const bf16_t* FP = (const bf16_t*)(ws + L1_FP) + R0 * 1024 + h * 128 + cch;
  float sgv[32], lgv[32];
  {
    const bf16_t* vtp = (const bf16_t*)(ws + L1_VT) + (((long)(b * 8 + h) * 128 + c) * 128) * 64 + (tid >> 3) * 64 + (tid & 7) * 8;
    u32x4 t0_ = *(const u32x4*)vtp, t1_ = *(const u32x4*)(vtp + 32 * 64), t2_ = *(const u32x4*)(vtp + 64 * 64), t3_ = *(const u32x4*)(vtp + 96 * 64);
    bf16_t fpr[32];
#pragma unroll
    for (int k = 0; k < 32; ++k) fpr[k] = FP[(long)(half * 32 + k) * 1024];
    {
      bf16_t* sp = sA + (tid >> 3) * LDT + (tid & 7) * 8;
      *(u32x4*)sp = t0_; *(u32x4*)(sp + 32 * LDT) = t1_; *(u32x4*)(sp + 64 * LDT) = t2_; *(u32x4*)(sp + 96 * LDT) = t3_;
    }
#pragma unroll
    for (int k = 0; k < 32; ++k) { sgv[k] = sigm(bf2f(fpr[k])); lgv[k] = __logf(lb + (1.f - lb) * sgv[k]); }
  }
  float sum = 0.f;
#pragma unroll
  for (int k = 0; k < 32; ++k) sum += lgv[k];
  psum[half * 128 + cch] = sum;
  __syncthreads();
  const float bL = psum[cch] + psum[128 + cch];
  float run = half ? psum[cch] : 0.f;
#pragma unroll
  for (int k = 0; k < 32; ++k) {
    run += lgv[k];
    float kk_ = (1.f - lb) * (1.f - sgv[k]);
    sB[cch * LDT + half * 32 + k] = f2bf(kk_ * __expf(bL - run));
  }
  if (half == 0) ((float*)(ws + L1_BL))[(long)unit * 128 + cch] = bL;
  __syncthreads();
  f32x4 acc[4][4];
#pragma unroll
  for (int mt = 0; mt < 4; ++mt)
#pragma unroll
    for (int nt = 0; nt < 4; ++nt) acc[mt][nt] = f32x4{0.f, 0.f, 0.f, 0.f};
  mma_lds_sw<4, 4, 2>(sA + wr * 64 * LDT, sB + wc * 64 * LDT, acc, lane);
#ifndef R9B
#define R9B 1
#endif
  for (int r9_ = 0; r9_ < R9B; ++r9_) {
  bf16_t* st = (bf16_t*)(ws + L1_ST) + (long)unit * 16384;
  const int r = lane & 15, q = lane >> 4;
#pragma unroll
  for (int mt = 0; mt < 4; ++mt) {
    const int v = wr * 64 + mt * 16 + r;
#pragma unroll
    for (int nt = 0; nt < 4; ++nt) {
      uint2 o;
      o.x = pack2(acc[mt][nt][0], acc[mt][nt][1]);
      o.y = pack2(acc[mt][nt][2], acc[mt][nt][3]);
      *(uint2*)(st + v * 128 + wc * 64 + nt * 16 + q * 4) = o;
    }
  }
  }
  __syncthreads();
}

template <bool DUMMY>
DEVI void hgrn_scan(const Params& p) {
  unsigned char* ws = p.ws;
  const float* BL = (const float*)(ws + L1_BL);
  for (int idx = blockIdx.x * 256 + opaque_tid(); idx < 16 * 8192; idx += gridDim.x * 256) {
    const int bh = idx >> 13, pr = idx & 8191;
    const int c2 = (pr & 63) * 2;
    unsigned* ptr = (unsigned*)(ws + L1_ST) + (long)bh * 128 * 8192 + pr;
    const float* blp = BL + (long)bh * 128 * 128 + c2;
    float s0 = 0.f, s1 = 0.f;
    for (int c0 = 0; c0 < 128; c0 += 8) {
      unsigned dv[8]; float2 bl[8];
#pragma unroll
      for (int k = 0; k < 8; ++k) { dv[k] = ptr[(long)(c0 + k) * 8192]; bl[k] = *(const float2*)(blp + (long)(c0 + k) * 128); }
#pragma unroll
      for (int k = 0; k < 8; ++k) {
        if (!DUMMY) ptr[(long)(c0 + k) * 8192] = pack2(s0, s1);
        s0 = __expf(bl[k].x) * s0 + lo2f(dv[k]);
        s1 = __expf(bl[k].y) * s1 + hi2f(dv[k]);
      }
    }
    if (DUMMY && s0 == 123.456f) ptr[0] = pack2(s0, s1);
  }
}

DEVI void hgrn_out(const Params& p, int unit, unsigned char* smem) {
  const int tid = opaque_tid(), lane = tid & 63, w = tid >> 6, wr = w >> 1, wc = w & 1;
  const int r = lane & 15, q = lane >> 4;
  const int bh = unit >> 7, c = unit & 127, b = bh >> 3, h = bh & 7, t0 = c * 64;
  const long R0 = (long)b * 8192 + t0;
  unsigned char* ws = p.ws;
  bf16_t* sQ0 = (bf16_t*)smem; bf16_t* sQ1 = (bf16_t*)(smem + 9216);
  bf16_t* sK0 = (bf16_t*)(smem + 18432); bf16_t* sK1 = (bf16_t*)(smem + 27648);
  bf16_t* sAm = (bf16_t*)(smem + 36864);
  bf16_t* sB = (bf16_t*)(smem + 46080);
  float* psum = (float*)(smem + 64512);
  float* sSs = psum + 256;
  const int cch = tid & 127, half = tid >> 7, cc = cch & 63;
  const float lb = ((const float*)(ws + OFF_LB))[h * 128 + cch];
  const bf16_t* FP = (const bf16_t*)(ws + L1_FP) + R0 * 1024 + h * 128 + cch;
  const bf16_t* Q1 = (const bf16_t*)(ws + L1_Q) + R0 * 1024 + h * 128 + cch;
  const bf16_t* vt = (const bf16_t*)(ws + L1_VT) + (((long)(b * 8 + h) * 128 + c) * 128) * 64;
  const bf16_t* st = (const bf16_t*)(ws + L1_ST) + (long)unit * 16384;
  const int tl_r = tid >> 3, tl_k = (tid & 7) * 8;
  u32x4 vv0, vv1, vv2, vv3, sa0, sa1, sa2, sa3, sb0, sb1, sb2, sb3;
  {
    const bf16_t* vp = vt + tl_r * 64 + tl_k;
    vv0 = *(const u32x4*)vp; vv1 = *(const u32x4*)(vp + 32 * 64); vv2 = *(const u32x4*)(vp + 64 * 64); vv3 = *(const u32x4*)(vp + 96 * 64);
    const bf16_t* sp = st + tl_r * 128 + tl_k;
    sa0 = *(const u32x4*)sp; sa1 = *(const u32x4*)(sp + 32 * 128); sa2 = *(const u32x4*)(sp + 64 * 128); sa3 = *(const u32x4*)(sp + 96 * 128);
    sb0 = *(const u32x4*)(sp + 64); sb1 = *(const u32x4*)(sp + 32 * 128 + 64); sb2 = *(const u32x4*)(sp + 64 * 128 + 64); sb3 = *(const u32x4*)(sp + 96 * 128 + 64);
  }
  float sgv[32], lgv[32];
  bf16_t qr[32];
  {
    bf16_t fpr[32];
#pragma unroll
    for (int k = 0; k < 32; ++k) { fpr[k] = FP[(long)(half * 32 + k) * 1024]; qr[k] = Q1[(long)(half * 32 + k) * 1024]; }
    { bf16_t* dp = sB + tl_r * LDT + tl_k; *(u32x4*)dp = vv0; *(u32x4*)(dp + 32 * LDT) = vv1; *(u32x4*)(dp + 64 * LDT) = vv2; *(u32x4*)(dp + 96 * LDT) = vv3; }
#pragma unroll
    for (int k = 0; k < 32; ++k) { sgv[k] = sigm(bf2f(fpr[k])); lgv[k] = __logf(lb + (1.f - lb) * sgv[k]); }
  }
  float sum = 0.f;
#pragma unroll
  for (int k = 0; k < 32; ++k) sum += lgv[k];
  psum[half * 128 + cch] = sum;
  __syncthreads();
  float run = half ? psum[cch] : 0.f;
  bf16_t* sQ = (cch < 64) ? sQ0 : sQ1;
  bf16_t* sK = (cch < 64) ? sK0 : sK1;
#pragma unroll
  for (int k = 0; k < 32; ++k) {
    const int s_ = half * 32 + k;
    run += lgv[k];
    float kk_ = (1.f - lb) * (1.f - sgv[k]);
    sQ[s_ * LDT + cc] = f2bf(bf2f(qr[k]) * __expf(run));
    sK[s_ * LDT + cc] = f2bf(kk_ * __expf(fminf(-run, 80.f)));
  }
  __syncthreads();
  {
    f32x4 a1[2][2];
#pragma unroll
    for (int mt = 0; mt < 2; ++mt)
#pragma unroll
      for (int nt = 0; nt < 2; ++nt) a1[mt][nt] = f32x4{0.f, 0.f, 0.f, 0.f};
    if (!(wr == 0 && wc == 1)) {
      mma_lds<2, 2, 2>(sQ0 + wr * 32 * LDT, sK0 + wc * 32 * LDT, a1, lane);
      mma_lds<2, 2, 2>(sQ1 + wr * 32 * LDT, sK1 + wc * 32 * LDT, a1, lane);
    }
#pragma unroll
    for (int mt = 0; mt < 2; ++mt)
#pragma unroll
      for (int i = 0; i < 4; ++i) {
        int j = wr * 32 + mt * 16 + q * 4 + i;
#pragma unroll
        for (int nt = 0; nt < 2; ++nt) {
          int s = wc * 32 + nt * 16 + r;
          sAm[j * LDT + s] = f2bf((s <= j) ? a1[mt][nt][i] : 0.f);
        }
      }
  }
  __syncthreads();
  f32x4 o[2][4];
#pragma unroll
  for (int mt = 0; mt < 2; ++mt)
#pragma unroll
    for (int nt = 0; nt < 4; ++nt) o[mt][nt] = f32x4{0.f, 0.f, 0.f, 0.f};
  mma_lds<2, 4, 2>(sAm + wr * 32 * LDT, sB + wc * 64 * LDT, o, lane);
  __syncthreads();
  { bf16_t* dp = sB + tl_r * LDT + tl_k; *(u32x4*)dp = sa0; *(u32x4*)(dp + 32 * LDT) = sa1; *(u32x4*)(dp + 64 * LDT) = sa2; *(u32x4*)(dp + 96 * LDT) = sa3; }
  __syncthreads();
  mma_lds<2, 4, 2>(sQ0 + wr * 32 * LDT, sB + wc * 64 * LDT, o, lane);
  __syncthreads();
  { bf16_t* dp = sB + tl_r * LDT + tl_k; *(u32x4*)dp = sb0; *(u32x4*)(dp + 32 * LDT) = sb1; *(u32x4*)(dp + 64 * LDT) = sb2; *(u32x4*)(dp + 96 * LDT) = sb3; }
  __syncthreads();
  mma_lds<2, 4, 2>(sQ1 + wr * 32 * LDT, sB + wc * 64 * LDT, o, lane);
#pragma unroll
  for (int mt = 0; mt < 2; ++mt)
#pragma unroll
    for (int i = 0; i < 4; ++i) {
      int j = wr * 32 + mt * 16 + q * 4 + i;
      float ss = 0.f;
#pragma unroll
      for (int nt = 0; nt < 4; ++nt) ss += o[mt][nt][i] * o[mt][nt][i];
      ss = grp16_sum(ss);
      if (r == 0) sSs[wc * 64 + j] = ss;
    }
  __syncthreads();
  const bf16_t* Z1 = (const bf16_t*)(ws + L1_Z);
  bf16_t* Y1 = (bf16_t*)(ws + L1_H);
  float hn[4];
#pragma unroll
  for (int nt = 0; nt < 4; ++nt) hn[nt] = p.h_hn[h * 128 + wc * 64 + nt * 16 + r];
#pragma unroll
  for (int mt = 0; mt < 2; ++mt) {
    float zv[4][4];
#pragma unroll
    for (int i = 0; i < 4; ++i) {
      long row = R0 + wr * 32 + mt * 16 + q * 4 + i;
#pragma unroll
      for (int nt = 0; nt < 4; ++nt) zv[i][nt] = bf2f(Z1[row * 1024 + h * 128 + wc * 64 + nt * 16 + r]);
    }
#pragma unroll
    for (int i = 0; i < 4; ++i) {
      int j = wr * 32 + mt * 16 + q * 4 + i;
      float rinv = rsqrtf((sSs[j] + sSs[64 + j]) * (1.f / 128.f) + EPSF);
      long row = R0 + j;
#pragma unroll
      for (int nt = 0; nt < 4; ++nt) {
        int col = h * 128 + wc * 64 + nt * 16 + r;
        Y1[row * 1024 + col] = f2bf(o[mt][nt][i] * rinv * hn[nt] * zv[i][nt]);
      }
    }
  }
  __syncthreads();
}

#define XB_TMO      128
#define XB_XCNT(j)  (256  + 64 * (j))
#define XB_XSUB(j)  (1280 + 64 * (j))
#define XB_XGEN(j)  (2304 + 64 * (j))
#define XB_TOP      3328
#define XB_TOPGEN   3392
#define XCD_BAR_WORDS 3456
#define XB_SPIN_CAP (1u << 22)
DEVI unsigned xb_ld(unsigned* p) { return __hip_atomic_load(p, __ATOMIC_RELAXED, __HIP_MEMORY_SCOPE_AGENT); }
DEVI unsigned xb_add(unsigned* p, unsigned v) { return __hip_atomic_fetch_add(p, v, __ATOMIC_RELAXED, __HIP_MEMORY_SCOPE_AGENT); }
DEVI unsigned xb_xcc_id() { return (unsigned)__builtin_amdgcn_s_getreg((3 << 11) | 20) & 0xFu; }
#define XB_SPIN(cond, bar) do { unsigned _sp = 0; while (cond) { __builtin_amdgcn_s_sleep(1); \
    if ((++_sp & 255u) == 0u) { if (xb_ld(&(bar)[XB_TMO])) break; if (_sp > XB_SPIN_CAP) { atomicAdd(&(bar)[XB_TMO], 1u); break; } } } } while (0)

DEVI void xcd_barrier_complete(unsigned* bar, unsigned x, unsigned& nloc, unsigned& nx) {
  const unsigned G = gridDim.x;
  unsigned sum, cnt, mine, sp = 0u;
  for (;;) {
    sum = 0u; cnt = 0u; mine = 0u;
#pragma unroll
    for (unsigned j = 0; j < 16; ++j) { const unsigned c = xb_ld(&bar[XB_XCNT(j)]); sum += c; cnt += (c > 0u) ? 1u : 0u; mine = (j == x) ? c : mine; }
    if (sum == G) break;
    __builtin_amdgcn_s_sleep(1);
    if ((++sp & 255u) == 0u) { if (xb_ld(&bar[XB_TMO])) break; if (sp > XB_SPIN_CAP) { atomicAdd(&bar[XB_TMO], 1u); break; } }
  }
  nloc = mine > 0u ? mine : 1u; nx = cnt > 0u ? cnt : 1u;
}

DEVI void grid_barrier(unsigned* bar, unsigned xcc, volatile unsigned* st) {
  asm volatile("s_waitcnt vmcnt(0)" ::: "memory");
  __syncthreads();
  if (threadIdx.x == 0) {
    __builtin_amdgcn_s_waitcnt(0);
    unsigned nloc = st[0], nx = st[1];
    if (nloc == 0u) { xcd_barrier_complete(bar, xcc, nloc, nx); st[0] = nloc; st[1] = nx; }
    const unsigned old = xb_add(&bar[XB_XSUB(xcc)], 1u);
    const unsigned gen = old / nloc;
    if (old + 1u == (gen + 1u) * nloc) {
      __builtin_amdgcn_fence(__ATOMIC_RELEASE, "agent");
      asm volatile("s_waitcnt vmcnt(0)" ::: "memory");
      const unsigned og = xb_add(&bar[XB_TOP], 1u);
      const unsigned tg = og / nx;
      if (og + 1u == (tg + 1u) * nx) xb_add(&bar[XB_TOPGEN], 1u);
      else XB_SPIN(xb_ld(&bar[XB_TOPGEN]) == tg, bar);
      __builtin_amdgcn_fence(__ATOMIC_ACQUIRE, "agent");
      xb_add(&bar[XB_XGEN(xcc)], 1u);
      asm volatile("s_waitcnt vmcnt(0)" ::: "memory");
    } else {
      XB_SPIN(xb_ld(&bar[XB_XGEN(xcc)]) == gen, bar);
      __builtin_amdgcn_fence(__ATOMIC_ACQUIRE, "agent");
      asm volatile("s_waitcnt vmcnt(0)" ::: "memory");
    }
  }
  __syncthreads();
}

#ifndef REP_NSA
#define REP_NSA 1
#endif
#ifndef REP_P0
#define REP_P0 1
#endif
#ifndef REP_P1
#define REP_P1 1
#endif
#ifndef REP_P2
#define REP_P2 1
#endif
#ifndef REP_P3
#define REP_P3 1
#endif
#ifndef REP_P4
#define REP_P4 1
#endif
#ifndef REP_P5
#define REP_P5 1
#endif
#ifndef REP_P6
#define REP_P6 1
#endif
#ifndef REP_P7
#define REP_P7 1
#endif
#ifndef REP_P8
#define REP_P8 1
#endif
#ifndef REP_P9
#define REP_P9 1
#endif
#ifndef REP_P10
#define REP_P10 1
#endif
#ifndef REP_P11
#define REP_P11 1
#endif
#ifndef REP_P12
#define REP_P12 1
#endif
#ifndef DBG_STOP
#define DBG_STOP 99
#endif
DEVI void dbg_probe_bf16(const Params& p, size_t off, long n) {
  const bf16_t* b = (const bf16_t*)(p.ws + off);
  for (long i = (long)blockIdx.x * 256 + threadIdx.x; i < 16384L * 1024; i += (long)gridDim.x * 256) {
    float v = bf2f(b[i % n]);
    if (!(v == v) || fabsf(v) > 1e30f) v = 777.f;
    p.out[i] = v;
  }
}
DEVI void dbg_probe_f32(const Params& p, size_t off, long n) {
  const float* b = (const float*)(p.ws + off);
  for (long i = (long)blockIdx.x * 256 + threadIdx.x; i < 16384L * 1024; i += (long)gridDim.x * 256) {
    float v = b[i % n];
    if (!(v == v) || fabsf(v) > 1e30f) v = 777.f;
    p.out[i] = v;
  }
}
DEVI void dbg_probe_combo(const Params& p) {
  const bf16_t* qn = (const bf16_t*)(p.ws + L0_QN);
  const bf16_t* ks = (const bf16_t*)(p.ws + L0_KS);
  const bf16_t* nz = (const bf16_t*)(p.ws + L0_NZ);
  const float* ig = (const float*)(p.ws + L0_IG);
  for (long i = (long)blockIdx.x * 256 + threadIdx.x; i < 16384L * 1024; i += (long)gridDim.x * 256) {
    float v = bf2f(qn[i % (16384L * 512)]) + bf2f(ks[i % (4L * 8192 * 64 * 4)]) + bf2f(nz[i % (16384L * 512)]) + ig[i % (16384L * 32)];
    if (!(v == v) || fabsf(v) > 1e30f) v = 777.f;
    p.out[i] = v;
  }
}
#define DBG_AT(k, stmt) if (DBG_STOP == k) { stmt; return; }

#define GSYNC() grid_barrier(bar_ctr, bar_xcc, bar_st)

__global__ void __launch_bounds__(256, 2) mega(Params p) {
  __shared__ __attribute__((aligned(16))) unsigned char smem[79872];
  cg::grid_group grid = cg::this_grid();
  const int G = gridDim.x, bid = blockIdx.x, tid = threadIdx.x, lane = tid & 63, w = tid >> 6;
  unsigned char* ws = p.ws;
  bf16_t* sA = (bf16_t*)smem;
  bf16_t* sB = (bf16_t*)(smem + 16384);
  unsigned* bar_ctr = (unsigned*)(ws + OFF_BAR);
  __shared__ uint4 xb_words;
  if (tid == 0) xb_words = make_uint4(0u, 0u, 0u, 0u);
  __syncthreads();
  volatile unsigned* bar_st = (volatile unsigned*)&xb_words;
  const unsigned bar_xcc = xb_xcc_id();
  if (tid == 0) (void)xb_add(&bar_ctr[XB_XCNT(bar_xcc)], 1u);
  if (p.ws == nullptr) grid.sync();

#ifdef EXTRA_SYNCS
  for (int e_ = 0; e_ < EXTRA_SYNCS; ++e_) GSYNC();
#endif
  for (int rep_ = 0; rep_ < REP_P0; ++rep_) {
  phase0(p, smem);
  GSYNC();
  }
  DBG_AT(0, dbg_probe_bf16(p, L0_H, 16384L*1024))
  for (int rep_ = 0; rep_ < REP_P1; ++rep_) {
#ifdef USE_G256
  for (int k_ = 0; k_ * (G >> 3) < 8 * 32; ++k_) {
    int tm, tn;
    if (!gemm_tile_xcd256(bid, G, k_, 32, tm, tn)) continue;
    gemm256((const bf16_t*)(ws + L0_H), 1024, (const bf16_t*)(ws + OFF_WIN0), 1024, 1024, tm * 256, tn * 128, sA, (bf16_t*)(smem + 32768),
            [&](f32x4 (&acc)[4][4], int mb, int nb, int ln) { epi_proj0(p, acc, mb, nb, ln); });
  }
  for (int v_ = (bid >> 3); v_ < 48; v_ += (G >> 3)) {
    const int tm = (bid & 7) * 16 + v_ / 3, tn = 32 + v_ % 3;
    gemm128<false>((const bf16_t*)(ws + L0_H), 1024, 16383, (const bf16_t*)(ws + OFF_WIN0), 1024, 4383, 1024, tm * 128, tn * 128, sA, sB,
            [&](f32x4 (&acc)[4][4], int mb, int nb, int ln) { epi_proj0(p, acc, mb, nb, ln); });
  }
#else
  for (int k_ = 0; k_ * (G >> 3) < 16 * 35; ++k_) {
    int tm, tn;
    if (!gemm_tile_xcd(bid, G, k_, 35, tm, tn)) continue;
    gemm128<false>((const bf16_t*)(ws + L0_H), 1024, 16383, (const bf16_t*)(ws + OFF_WIN0), 1024, 4383, 1024, tm * 128, tn * 128, sA, sB,
            [&](f32x4 (&acc)[4][4], int mb, int nb, int ln) { epi_proj0(p, acc, mb, nb, ln); });
  }
#endif
  GSYNC();
  }
  DBG_AT(1, dbg_probe_bf16(p, L0_QKRAW, 16384L*1024)) DBG_AT(101, dbg_probe_combo(p)) DBG_AT(102, dbg_probe_bf16(p, L0_KS, 4L*8192*64*4)) DBG_AT(103, dbg_probe_f32(p, L0_IG, 16384L*4*2+16384L*24)) DBG_AT(104, dbg_probe_bf16(p, L0_MVT, 16384L*512*3))
  for (int rep_ = 0; rep_ < REP_P2; ++rep_) {
  for (int it = bid; it < 128 + 2048; it += G) {
    if (it < 128) {
      int ksp = it >> 5, kv = (it >> 4) & 1, bg = (it >> 2) & 3, tm = it & 3;
      const bf16_t* A = (const bf16_t*)(ws + (kv ? L0_VCRAW : L0_KCRAW)) + (long)bg * 8192 * 64 + ksp * 512;
      const bf16_t* B = (const bf16_t*)(ws + (kv ? OFF_WCV : OFF_WCK)) + ksp * 512;
      gemm128<false>(A, 1024, 510, B, 2048, 127, 512, tm * 128, 0, sA, sB,
              [&](f32x4 (&acc)[4][4], int mb, int nb, int ln) { epi_cmp_hidden(p, acc, mb, nb, ln, kv, bg, ksp); });
    } else {
      conv_tile(p, it - 128, smem);
    }
  }
  GSYNC();
  }
  DBG_AT(2, dbg_probe_bf16(p, L0_QC, 16384L*512*3)) DBG_AT(201, dbg_probe_f32(p, L0_HID, 2L*4*512*128))
  for (int rep_ = 0; rep_ < REP_P3; ++rep_) {
  for (int it = bid; it < 512 + 1024; it += G) {
    if (it < 512) mlstm_local(p, it, smem);
    else { const int t_ = opaque_tid(); cmp_finalize(p, (it - 512) * 4 + (t_ >> 6), t_ & 63); }
  }
  GSYNC();
  }
  DBG_AT(3, dbg_probe_f32(p, L0_H, 512L*16384)) DBG_AT(301, dbg_probe_bf16(p, L0_KCMP, 4L*512*64*2)) DBG_AT(302, dbg_probe_f32(p, L0_DN, 512L*128 + 2048))
  for (int rep_ = 0; rep_ < REP_P4; ++rep_) {
#ifdef DUMMY_P4
  mlstm_scan<true>(p, smem);
  GSYNC();
#endif
  mlstm_scan<false>(p, smem);
  GSYNC();
  }
  DBG_AT(4, dbg_probe_f32(p, L0_H, 512L*16384)) DBG_AT(401, dbg_probe_f32(p, L0_DN, 512L*128 + 3072))
  for (int rep_ = 0; rep_ < REP_P5; ++rep_) {
#ifdef USE_WQ
  {
    unsigned* wq = bar_ctr + 3600;
    volatile unsigned* slot = (volatile unsigned*)&xb_words;
    for (int s_ = 0; s_ < 5; ++s_) {
      const int qi = (s_ < 4) ? (int)((bar_xcc + (unsigned)s_) & 3u) : 4;
      const int qn_ = (s_ < 4) ? 256 : 1024;
      for (;;) {
        if (tid == 0) slot[3] = xb_add(&wq[qi * 64], 1u);
        __syncthreads();
        const int it = (int)slot[3];
        __syncthreads();
        if (it >= qn_) break;
        if (s_ < 4) nsa_tile(p, (255 - it) * 4 + qi, smem);
        else mlstm_out(p, it, smem);
      }
    }
  }
#else
  for (int it = bid; it < 1024 + 1024; it += G) {
    if (it < 1024) {
      int k = it >> 9, i = it & 511;
      int idx = (k & 1) ? (k * 512 + 511 - i) : it;
#ifndef DBG_SKIP_NSA
      for (int r2_ = 0; r2_ < REP_NSA; ++r2_) nsa_tile(p, idx, smem);
#endif
    } else {
#ifndef DBG_SKIP_MOUT
      mlstm_out(p, it - 1024, smem);
#endif
    }
  }
#endif
  GSYNC();
  }
  DBG_AT(5, dbg_probe_bf16(p, L0_QKRAW, 16384L*1024))
  for (int rep_ = 0; rep_ < REP_P6; ++rep_) {
#ifdef USE_G256
  for (int k_ = 0; k_ * (G >> 3) < 8 * 8; ++k_) {
    int tm, tn;
    if (!gemm_tile_xcd256(bid, G, k_, 8, tm, tn)) continue;
    gemm256((const bf16_t*)(ws + L0_QKRAW), 1024, (const bf16_t*)(ws + OFF_WOUT0), 1024, 1024, tm * 256, tn * 128, sA, (bf16_t*)(smem + 32768),
            [&](f32x4 (&acc)[4][4], int mb, int nb, int ln) { epi_out_resid(p.x, p.out, acc, mb, nb, ln); });
  }
#else
  for (int k_ = 0; k_ * (G >> 3) < 16 * 8; ++k_) {
    int tm, tn;
    if (!gemm_tile_xcd(bid, G, k_, 8, tm, tn)) continue;
    gemm128<false>((const bf16_t*)(ws + L0_QKRAW), 1024, 16383, (const bf16_t*)(ws + OFF_WOUT0), 1024, 1023, 1024, tm * 128, tn * 128, sA, sB,
            [&](f32x4 (&acc)[4][4], int mb, int nb, int ln) { epi_out_resid(p.x, p.out, acc, mb, nb, ln); });
  }
#endif
  GSYNC();
  }
  DBG_AT(6, (void)0)
  for (int rep_ = 0; rep_ < REP_P7; ++rep_) {
  { const int t_ = opaque_tid(); for (int row = (bid * 4 + (t_ >> 6)) * 2; row < 16384; row += G * 8) rmsnorm_row2(p.out, p.norm_w + 1024, (bf16_t*)(ws + L1_H), row, row + 1, t_ & 63); }
  GSYNC();
  }
  DBG_AT(7, dbg_probe_bf16(p, L1_H, 16384L*1024))
  for (int rep_ = 0; rep_ < REP_P8; ++rep_) {
#ifdef USE_G256
  for (int k_ = 0; k_ * (G >> 3) < 8 * 32; ++k_) {
    int tm, tn;
    if (!gemm_tile_xcd256(bid, G, k_, 32, tm, tn)) continue;
    gemm256((const bf16_t*)(ws + L1_H), 1024, (const bf16_t*)(ws + OFF_WIN1), 1024, 1024, tm * 256, tn * 128, sA, (bf16_t*)(smem + 32768),
            [&](f32x4 (&acc)[4][4], int mb, int nb, int ln) { epi_proj1(p, acc, mb, nb, ln); });
  }
#else
  for (int k_ = 0; k_ * (G >> 3) < 16 * 32; ++k_) {
    int tm, tn;
    if (!gemm_tile_xcd(bid, G, k_, 32, tm, tn)) continue;
    gemm128<false>((const bf16_t*)(ws + L1_H), 1024, 16383, (const bf16_t*)(ws + OFF_WIN1), 1024, 4095, 1024, tm * 128, tn * 128, sA, sB,
            [&](f32x4 (&acc)[4][4], int mb, int nb, int ln) { epi_proj1(p, acc, mb, nb, ln); });
  }
#endif
  GSYNC();
  }
  DBG_AT(8, dbg_probe_bf16(p, L1_FP, 16384L*1024*4))
  for (int rep_ = 0; rep_ < REP_P9; ++rep_) {
  for (int it = bid; it < 2048; it += G) hgrn_local(p, it, smem);
  GSYNC();
  }
  DBG_AT(9, dbg_probe_bf16(p, L1_ST, 2048L*16384))
  for (int rep_ = 0; rep_ < REP_P10; ++rep_) {
#ifdef DUMMY_P10
  hgrn_scan<true>(p);
  GSYNC();
#endif
  hgrn_scan<false>(p);
  GSYNC();
  }
  DBG_AT(10, dbg_probe_bf16(p, L1_ST, 2048L*16384))
  for (int rep_ = 0; rep_ < REP_P11; ++rep_) {
  for (int it = bid; it < 2048; it += G) hgrn_out(p, it, smem);
  GSYNC();
  }
  DBG_AT(11, dbg_probe_bf16(p, L1_H, 16384L*1024))
  for (int rep_ = 0; rep_ < REP_P12; ++rep_) {
#ifdef USE_G256
  for (int k_ = 0; k_ * (G >> 3) < 8 * 8; ++k_) {
    int tm, tn;
    if (!gemm_tile_xcd256(bid, G, k_, 8, tm, tn)) continue;
    gemm256((const bf16_t*)(ws + L1_H), 1024, (const bf16_t*)(ws + OFF_WOUT1), 1024, 1024, tm * 256, tn * 128, sA, (bf16_t*)(smem + 32768),
            [&](f32x4 (&acc)[4][4], int mb, int nb, int ln) { epi_out_resid(p.out, p.out, acc, mb, nb, ln); });
  }
#else
  for (int k_ = 0; k_ * (G >> 3) < 16 * 8; ++k_) {
    int tm, tn;
    if (!gemm_tile_xcd(bid, G, k_, 8, tm, tn)) continue;
    gemm128<false>((const bf16_t*)(ws + L1_H), 1024, 16383, (const bf16_t*)(ws + OFF_WOUT1), 1024, 1023, 1024, tm * 128, tn * 128, sA, sB,
            [&](f32x4 (&acc)[4][4], int mb, int nb, int ln) { epi_out_resid(p.out, p.out, acc, mb, nb, ln); });
  }
#endif
  }
}

extern "C" void kernel_launch(void* const* d_in, const int* in_sizes, int n_in, void* d_out, int out_size, void* d_ws, size_t ws_size,
                              hipStream_t stream) {
  static int grid_blocks = 0;
  if (!grid_blocks) {
    int dev = 0, cus = 0, per_cu = 0;
    (void)hipGetDevice(&dev);
    (void)hipDeviceGetAttribute(&cus, hipDeviceAttributeMultiprocessorCount, dev);
    (void)hipOccupancyMaxActiveBlocksPerMultiprocessor(&per_cu, mega, 256, 0);
    if (per_cu > 2) per_cu = 2;
    if (per_cu < 1) per_cu = 1;
    grid_blocks = cus * per_cu;
  }
  Params p{};
  const float** pf = (const float**)&p;
  for (int i = 0; i < 22; ++i) pf[i] = (const float*)d_in[i];
  p.out = (float*)d_out;
  p.ws = (unsigned char*)d_ws;
  (void)hipMemsetAsync((unsigned char*)d_ws + OFF_BAR, 0, 16384, stream);
  void* args[] = {&p};
  hipError_t e = hipLaunchCooperativeKernel((void*)mega, dim3(grid_blocks), dim3(256), args, 0, stream);
  if (e != hipSuccess) fprintf(stderr, "cooperative launch failed: %s (grid %d)\n", hipGetErrorString(e), grid_blocks);
}
```

```cpp
#include <hip/hip_runtime.h>
#define USE_G256 1
#define USE_WQ 1
#include <hip/hip_cooperative_groups.h>
#include <stdint.h>
#include <cstdio>
namespace cg = cooperative_groups;

typedef unsigned short bf16_t;
typedef __attribute__((ext_vector_type(8))) short bf16x8;
typedef __attribute__((ext_vector_type(4))) float f32x4;
typedef __attribute__((ext_vector_type(4))) unsigned int u32x4;

#define DEVI __device__ __forceinline__
#define EPSF 1e-6f
#define LDT 72
#define SLD 68
#define NEGS (-1e30f)
#define LAUNDER(ptr) asm volatile("" : "+s"(ptr))

struct Params {
  const float* x; const float* norm_w; const float* ev_w_in; const float* ev_b_in; const float* f_bias;
  const float* conv_w; const float* conv_b; const float* m_hn; const float* q_norm; const float* k_norm;
  const float* ck_pos; const float* ck_w1; const float* ck_w2; const float* cv_pos; const float* cv_w1; const float* cv_w2;
  const float* ev_w_out; const float* od_w_in; const float* od_b_in; const float* lb_logits; const float* h_hn; const float* od_w_out;
  float* out; unsigned char* ws;
};

constexpr size_t MiB = 1048576;
constexpr size_t OFF_WIN0 = 0;
constexpr size_t OFF_WOUT0 = OFF_WIN0 + 4480ull * 1024 * 2;
constexpr size_t OFF_WIN1 = OFF_WOUT0 + 2 * MiB;
constexpr size_t OFF_WOUT1 = OFF_WIN1 + 8 * MiB;
constexpr size_t OFF_WCK = OFF_WOUT1 + 2 * MiB;
constexpr size_t OFF_WCV = OFF_WCK + 512 * 1024;
constexpr size_t OFF_ROPE = OFF_WCV + 512 * 1024;
constexpr size_t OFF_PB = OFF_ROPE + 512 * 1024;
constexpr size_t OFF_LB = OFF_PB + 1024;
constexpr size_t OFF_BAR = OFF_LB + 4096;
constexpr size_t OFF_BASE = 24 * MiB;
constexpr size_t L0_H = OFF_BASE;
constexpr size_t L0_QKRAW = L0_H + 32 * MiB;
constexpr size_t L0_QC = L0_QKRAW + 32 * MiB;
constexpr size_t L0_KC = L0_QC + 16 * MiB;
constexpr size_t L0_KCT = L0_KC + 16 * MiB;
constexpr size_t L0_MVT = L0_KCT + 16 * MiB;
constexpr size_t L0_MO = L0_MVT + 16 * MiB;
constexpr size_t L0_MZ = L0_MO + 16 * MiB;
constexpr size_t L0_QN = L0_MZ + 16 * MiB;
constexpr size_t L0_NZ = L0_QN + 16 * MiB;
constexpr size_t L0_KCRAW = L0_NZ + 16 * MiB;
constexpr size_t L0_VCRAW = L0_KCRAW + 4 * MiB;
constexpr size_t L0_KS = L0_VCRAW + 4 * MiB;
constexpr size_t L0_KW = L0_KS + 4 * MiB;
constexpr size_t L0_VST = L0_KW + 4 * MiB;
constexpr size_t L0_VWT = L0_VST + 4 * MiB;
constexpr size_t L0_HID = L0_VWT + 4 * MiB;
constexpr size_t L0_KCMP = L0_HID + 2 * MiB;
constexpr size_t L0_VCMPT = L0_KCMP + 256 * 1024;
constexpr size_t L0_IG = L0_VCMPT + 256 * 1024;
constexpr size_t L0_LOGF = L0_IG + 256 * 1024;
constexpr size_t L0_GATES = L0_LOGF + 256 * 1024;
constexpr size_t L0_DN = L0_GATES + 1536 * 1024;
constexpr size_t L0_BL = L0_DN + 256 * 1024;
constexpr size_t L0_MLOC = L0_BL + 4096;
constexpr size_t L0_MIN = L0_MLOC + 4096;
constexpr size_t L0_HIDP = L0_MIN + 4096;
constexpr size_t L0_END = L0_HIDP + 8 * MiB;
static_assert(L0_END <= 256 * MiB, "ws overflow L0");
constexpr size_t L1_H = OFF_BASE;
constexpr size_t L1_FP = L1_H + 32 * MiB;
constexpr size_t L1_Q = L1_FP + 32 * MiB;
constexpr size_t L1_VT = L1_Q + 32 * MiB;
constexpr size_t L1_Z = L1_VT + 32 * MiB;
constexpr size_t L1_ST = L1_Z + 32 * MiB;
constexpr size_t L1_BL = L1_ST + 64 * MiB;
constexpr size_t L1_END = L1_BL + 1 * MiB;
static_assert(L1_END <= 256 * MiB, "ws overflow L1");

DEVI int opaque_tid() { int t = threadIdx.x; asm volatile("" : "+v"(t)); return t; }
typedef __bf16 bf16v2_t __attribute__((ext_vector_type(2)));
typedef float f32v2_t __attribute__((ext_vector_type(2)));
DEVI bf16_t f2bf(float f) { __bf16 h = (__bf16)f; return __builtin_bit_cast(unsigned short, h); }
DEVI float bf2f(bf16_t b) { return __uint_as_float(((unsigned)b) << 16); }
DEVI unsigned pack2(float a, float b) { f32v2_t f = {a, b}; bf16v2_t h = __builtin_convertvector(f, bf16v2_t); return __builtin_bit_cast(unsigned, h); }
DEVI float lo2f(unsigned u) { return __uint_as_float(u << 16); }
DEVI float hi2f(unsigned u) { return __uint_as_float(u & 0xffff0000u); }
DEVI float sigm(float x) { return __builtin_amdgcn_rcpf(1.f + __expf(-x)); }
DEVI float siluf(float x) { return x * sigm(x); }
DEVI float wave_sum(float v) { for (int o = 32; o > 0; o >>= 1) v += __shfl_xor(v, o); return v; }
DEVI float grp16_sum(float v) { v += __shfl_xor(v, 1); v += __shfl_xor(v, 2); v += __shfl_xor(v, 4); v += __shfl_xor(v, 8); return v; }

DEVI void wave_scan_sum128(float& a, float& b, int lane) {
  float t = a + b;
  float s = t;
#pragma unroll
  for (int o = 1; o < 64; o <<= 1) { float u = __shfl_up(s, o); if (lane >= o) s += u; }
  const float excl = s - t;
  a = excl + a;
  b = a + b;
}
DEVI void wave_scan_max128(float& a, float& b, int lane) {
  float t = fmaxf(a, b);
  float s = t;
#pragma unroll
  for (int o = 1; o < 64; o <<= 1) { float u = __shfl_up(s, o); if (lane >= o) s = fmaxf(s, u); }
  float prev = __shfl_up(s, 1);
  if (lane == 0) prev = -3.0e38f;
  a = fmaxf(prev, a);
  b = fmaxf(a, b);
}
DEVI float wave_max(float v) { for (int o = 32; o > 0; o >>= 1) v = fmaxf(v, __shfl_xor(v, o)); return v; }
DEVI int oldcol(int n) {
  return n < 2560 ? n : (n < 3840 ? n + 8 : (n < 4352 ? n + 32 : (n < 4360 ? n - 4352 + 2560 : n - 4360 + 3848)));
}

template <int MT, int NTL, int KS>
DEVI void mma_lds(const bf16_t* sA, const bf16_t* sB, f32x4 (&acc)[MT][NTL], int lane, bool neg = false) {
  const int r = lane & 15, q = lane >> 4;
#pragma unroll
  for (int ks = 0; ks < KS; ++ks) {
    bf16x8 a[MT], b[NTL];
#pragma unroll
    for (int mt = 0; mt < MT; ++mt) a[mt] = *(const bf16x8*)(sA + (mt * 16 + r) * LDT + ks * 32 + q * 8);
    if (neg) {
#pragma unroll
      for (int mt = 0; mt < MT; ++mt) a[mt] ^= (short)0x8000;
    }
#pragma unroll
    for (int nt = 0; nt < NTL; ++nt) b[nt] = *(const bf16x8*)(sB + (nt * 16 + r) * LDT + ks * 32 + q * 8);
#pragma unroll
    for (int mt = 0; mt < MT; ++mt)
#pragma unroll
      for (int nt = 0; nt < NTL; ++nt) acc[mt][nt] = __builtin_amdgcn_mfma_f32_16x16x32_bf16(a[mt], b[nt], acc[mt][nt], 0, 0, 0);
  }
}
template <int MT, int NTL, int KS>
DEVI void mma_lds_sw(const bf16_t* sA, const bf16_t* sB, f32x4 (&acc)[MT][NTL], int lane, bool neg = false) {
  const int r = lane & 15, q = lane >> 4;
#pragma unroll
  for (int ks = 0; ks < KS; ++ks) {
    bf16x8 a[MT], b[NTL];
#pragma unroll
    for (int mt = 0; mt < MT; ++mt) a[mt] = *(const bf16x8*)(sA + (mt * 16 + r) * LDT + ks * 32 + q * 8);
    if (neg) {
#pragma unroll
      for (int mt = 0; mt < MT; ++mt) a[mt] ^= (short)0x8000;
    }
#pragma unroll
    for (int nt = 0; nt < NTL; ++nt) b[nt] = *(const bf16x8*)(sB + (nt * 16 + r) * LDT + ks * 32 + q * 8);
#pragma unroll
    for (int mt = 0; mt < MT; ++mt)
#pragma unroll
      for (int nt = 0; nt < NTL; ++nt) acc[mt][nt] = __builtin_amdgcn_mfma_f32_16x16x32_bf16(b[nt], a[mt], acc[mt][nt], 0, 0, 0);
  }
}


template <int MT, int NTL, bool SWAP>
DEVI void mma_swz(const bf16_t* sA, const bf16_t* sB, f32x4 (&acc)[MT][NTL], int lane, bool neg) {
  const int r = lane & 15, q = lane >> 4, r7 = r & 7;
#pragma unroll
  for (int ks = 0; ks < 2; ++ks) {
    bf16x8 a[MT], b[NTL];
    const int co = ((ks * 4 + q) ^ r7) * 8;
#pragma unroll
    for (int mt = 0; mt < MT; ++mt) a[mt] = *(const bf16x8*)(sA + (mt * 16 + r) * 64 + co);
#pragma unroll
    for (int nt = 0; nt < NTL; ++nt) b[nt] = *(const bf16x8*)(sB + (nt * 16 + r) * 64 + co);
    if (neg) {
#pragma unroll
      for (int mt = 0; mt < MT; ++mt) a[mt] ^= (short)0x8000;
    }
#pragma unroll
    for (int mt = 0; mt < MT; ++mt)
#pragma unroll
      for (int nt = 0; nt < NTL; ++nt) {
        if (SWAP) acc[mt][nt] = __builtin_amdgcn_mfma_f32_16x16x32_bf16(b[nt], a[mt], acc[mt][nt], 0, 0, 0);
        else acc[mt][nt] = __builtin_amdgcn_mfma_f32_16x16x32_bf16(a[mt], b[nt], acc[mt][nt], 0, 0, 0);
      }
  }
}

DEVI void load_tile128(bf16_t* s, const bf16_t* g, long ld) {
  const int tid = opaque_tid(), lr = tid >> 3, lk = (tid & 7) * 8;
#pragma unroll
  for (int j = 0; j < 4; ++j) *(uint4*)(s + (lr + 32 * j) * LDT + lk) = *(const uint4*)(g + (long)(lr + 32 * j) * ld + lk);
}
DEVI void load_tile64(bf16_t* s, const bf16_t* g, long ld) {
  const int tid = opaque_tid(), lr = tid >> 3, lk = (tid & 7) * 8;
#pragma unroll
  for (int j = 0; j < 2; ++j) *(uint4*)(s + (lr + 32 * j) * LDT + lk) = *(const uint4*)(g + (long)(lr + 32 * j) * ld + lk);
}

template <bool SWAP, class Epi>
DEVI void gemm128(const bf16_t* A, long lda, int amax, const bf16_t* B, long ldb, int bmax, int K, int m0, int n0,
                  bf16_t* sA, bf16_t* sB, Epi&& epi) {
  const int tid = opaque_tid(), lane = tid & 63, w = tid >> 6, wr = w >> 1, wc = w & 1;
  const int lr = tid >> 3, lk = (tid & 7) * 8;
  const int lsw = (((tid & 7) ^ (lr & 7)) * 8);
  f32x4 acc[4][4];
#pragma unroll
  for (int mt = 0; mt < 4; ++mt)
#pragma unroll
    for (int nt = 0; nt < 4; ++nt) acc[mt][nt] = f32x4{0.f, 0.f, 0.f, 0.f};
  const bf16_t* ap[4];
  const bf16_t* bp[4];
#pragma unroll
  for (int j = 0; j < 4; ++j) {
    int ra = min(m0 + lr + 32 * j, amax);
    ap[j] = A + (long)ra * lda + lk;
    int rb = min(n0 + lr + 32 * j, bmax);
    bp[j] = B + (long)rb * ldb + lk;
  }
#ifndef GEMM_PASSES
#define GEMM_PASSES 1
#endif
  for (int pass_ = 0; pass_ < GEMM_PASSES; ++pass_) {
  u32x4 va0, va1, va2, va3, vb0, vb1, vb2, vb3;
  va0 = *(const u32x4*)(ap[0]); va1 = *(const u32x4*)(ap[1]); va2 = *(const u32x4*)(ap[2]); va3 = *(const u32x4*)(ap[3]);
  vb0 = *(const u32x4*)(bp[0]); vb1 = *(const u32x4*)(bp[1]); vb2 = *(const u32x4*)(bp[2]); vb3 = *(const u32x4*)(bp[3]);
  const int KT = K >> 6;
  *(u32x4*)(sA + (lr + 0) * 64 + lsw) = va0; *(u32x4*)(sA + (lr + 32) * 64 + lsw) = va1;
  *(u32x4*)(sA + (lr + 64) * 64 + lsw) = va2; *(u32x4*)(sA + (lr + 96) * 64 + lsw) = va3;
  *(u32x4*)(sB + (lr + 0) * 64 + lsw) = vb0; *(u32x4*)(sB + (lr + 32) * 64 + lsw) = vb1;
  *(u32x4*)(sB + (lr + 64) * 64 + lsw) = vb2; *(u32x4*)(sB + (lr + 96) * 64 + lsw) = vb3;
  if (KT > 1) {
    va0 = *(const u32x4*)(ap[0] + 64); va1 = *(const u32x4*)(ap[1] + 64); va2 = *(const u32x4*)(ap[2] + 64); va3 = *(const u32x4*)(ap[3] + 64);
    vb0 = *(const u32x4*)(bp[0] + 64); vb1 = *(const u32x4*)(bp[1] + 64); vb2 = *(const u32x4*)(bp[2] + 64); vb3 = *(const u32x4*)(bp[3] + 64);
  }
  __syncthreads();
  for (int kt = 0; kt < KT; ++kt) {
    const int st = (kt & 1) * 16384;
    const int sn = ((kt + 1) & 1) * 16384;
    if (kt + 1 < KT) {
      *(u32x4*)(sA + sn + (lr + 0) * 64 + lsw) = va0; *(u32x4*)(sA + sn + (lr + 32) * 64 + lsw) = va1;
      *(u32x4*)(sA + sn + (lr + 64) * 64 + lsw) = va2; *(u32x4*)(sA + sn + (lr + 96) * 64 + lsw) = va3;
      *(u32x4*)(sB + sn + (lr + 0) * 64 + lsw) = vb0; *(u32x4*)(sB + sn + (lr + 32) * 64 + lsw) = vb1;
      *(u32x4*)(sB + sn + (lr + 64) * 64 + lsw) = vb2; *(u32x4*)(sB + sn + (lr + 96) * 64 + lsw) = vb3;
    }
    if (kt + 2 < KT) {
      const int ko = (kt + 2) * 64;
      va0 = *(const u32x4*)(ap[0] + ko); va1 = *(const u32x4*)(ap[1] + ko); va2 = *(const u32x4*)(ap[2] + ko); va3 = *(const u32x4*)(ap[3] + ko);
      vb0 = *(const u32x4*)(bp[0] + ko); vb1 = *(const u32x4*)(bp[1] + ko); vb2 = *(const u32x4*)(bp[2] + ko); vb3 = *(const u32x4*)(bp[3] + ko);
    }
    __builtin_amdgcn_sched_barrier(0);
    __builtin_amdgcn_s_setprio(2);
    mma_swz<4, 4, SWAP>(sA + st + wr * 64 * 64, sB + st + wc * 64 * 64, acc, lane, (pass_ & 1) != 0);
    __builtin_amdgcn_s_setprio(0);
    __syncthreads();
  }
  }
  epi(acc, m0 + wr * 64, n0 + wc * 64, lane);
}


DEVI bool gemm_tile_xcd(int bid, int G, int k, int NTN, int& tm, int& tn) {
  const int x = bid & 7, per = G >> 3;
  const int u = (bid >> 3) + per * k;
  const int full_groups = NTN >> 3, rem = NTN & 7;
  const int n_full = full_groups * 2 * 64;
  if (u < n_full) {
    const int sb = u >> 6, wi = u & 63;
    const int tg = sb >> 1, th = sb & 1;
    tm = x * 16 + th * 8 + (wi >> 3);
    tn = tg * 8 + (wi & 7);
    return true;
  }
  const int v = u - n_full;
  if (v >= 16 * rem) return false;
  tm = x * 16 + v / rem;
  tn = full_groups * 8 + v % rem;
  return true;
}


template <class Epi>
DEVI void gemm256(const bf16_t* A, long lda, const bf16_t* B, long ldb, int K, int m0, int n0, bf16_t* sA, bf16_t* sB, Epi&& epi) {
  const int tid = opaque_tid(), lane = tid & 63, w = tid >> 6, wr = w >> 1, wc = w & 1;
  const int lr = tid >> 3, lk = (tid & 7) * 8;
  const int lsw = (((tid & 7) ^ (lr & 7)) * 8);
  const int r = lane & 15, q = lane >> 4, r7 = r & 7;
  f32x4 acc[2][4][4];
#pragma unroll
  for (int hh = 0; hh < 2; ++hh)
#pragma unroll
    for (int mt = 0; mt < 4; ++mt)
#pragma unroll
      for (int nt = 0; nt < 4; ++nt) acc[hh][mt][nt] = f32x4{0.f, 0.f, 0.f, 0.f};
  const bf16_t* abase = A + (long)(m0 + lr) * lda + lk;
  const bf16_t* bbase = B + (long)(n0 + lr) * ldb + lk;
  u32x4 va[8], vb[4];
#pragma unroll
  for (int j = 0; j < 8; ++j) va[j] = *(const u32x4*)(abase + (long)(32 * j) * lda);
#pragma unroll
  for (int j = 0; j < 4; ++j) vb[j] = *(const u32x4*)(bbase + (long)(32 * j) * ldb);
  const int KT = K >> 6;
  for (int kt = 0; kt < KT; ++kt) {
#pragma unroll
    for (int j = 0; j < 8; ++j) *(u32x4*)(sA + (lr + 32 * j) * 64 + lsw) = va[j];
#pragma unroll
    for (int j = 0; j < 4; ++j) *(u32x4*)(sB + (lr + 32 * j) * 64 + lsw) = vb[j];
    __syncthreads();
    if (kt + 1 < KT) {
      const int ko = (kt + 1) * 64;
#pragma unroll
      for (int j = 0; j < 8; ++j) va[j] = *(const u32x4*)(abase + (long)(32 * j) * lda + ko);
#pragma unroll
      for (int j = 0; j < 4; ++j) vb[j] = *(const u32x4*)(bbase + (long)(32 * j) * ldb + ko);
    }
    __builtin_amdgcn_sched_barrier(0);
    __builtin_amdgcn_s_setprio(2);
#pragma unroll
    for (int ks = 0; ks < 2; ++ks) {
      const int co = ((ks * 4 + q) ^ r7) * 8;
      bf16x8 b[4];
#pragma unroll
      for (int nt = 0; nt < 4; ++nt) b[nt] = *(const bf16x8*)(sB + (wc * 64 + nt * 16 + r) * 64 + co);
#pragma unroll
      for (int hh = 0; hh < 2; ++hh) {
        bf16x8 a[4];
#pragma unroll
        for (int mt = 0; mt < 4; ++mt) a[mt] = *(const bf16x8*)(sA + (wr * 128 + hh * 64 + mt * 16 + r) * 64 + co);
#pragma unroll
        for (int mt = 0; mt < 4; ++mt)
#pragma unroll
          for (int nt = 0; nt < 4; ++nt) acc[hh][mt][nt] = __builtin_amdgcn_mfma_f32_16x16x32_bf16(a[mt], b[nt], acc[hh][mt][nt], 0, 0, 0);
      }
    }
    __builtin_amdgcn_s_setprio(0);
    __syncthreads();
  }
  epi(acc[0], m0 + wr * 128, n0 + wc * 64, lane);
  epi(acc[1], m0 + wr * 128 + 64, n0 + wc * 64, lane);
}

DEVI bool gemm_tile_xcd256(int bid, int G, int k, int NTN, int& tm, int& tn) {
  const int x = bid & 7, per = G >> 3;
  const int u = (bid >> 3) + per * k;
  if (u >= 8 * NTN) return false;
  const int tg = u >> 6, wi = u & 63;
  tm = x * 8 + (wi >> 3);
  tn = tg * 8 + (wi & 7);
  return true;
}

DEVI void transpose_tile(const float* src, int N, int ldsrc, bf16_t* dst, int K, int ktile, int ntile, bool perm, float* sT) {
  const int tid = opaque_tid();
  const int k0 = ktile * 64, n0 = ntile * 64;
#pragma unroll
  for (int j = 0; j < 4; ++j) {
    int idx = tid + 256 * j;
    int kk = idx >> 4, n4 = (idx & 15) * 4;
    int n = n0 + n4;
    float4 v = make_float4(0.f, 0.f, 0.f, 0.f);
    if (n < N) { int oc = perm ? oldcol(n) : n; const f32x4 t_ = __builtin_nontemporal_load((const f32x4*)(src + (long)(k0 + kk) * ldsrc + oc)); v = make_float4(t_[0], t_[1], t_[2], t_[3]); }
    sT[kk * 65 + n4 + 0] = v.x; sT[kk * 65 + n4 + 1] = v.y; sT[kk * 65 + n4 + 2] = v.z; sT[kk * 65 + n4 + 3] = v.w;
  }
  __syncthreads();
#pragma unroll
  for (int j = 0; j < 2; ++j) {
    int idx = tid + 256 * j;
    int nn = idx >> 3, kc = (idx & 7) * 8;
    if (n0 + nn < N) {
      uint4 o;
      o.x = pack2(sT[(kc + 0) * 65 + nn], sT[(kc + 1) * 65 + nn]);
      o.y = pack2(sT[(kc + 2) * 65 + nn], sT[(kc + 3) * 65 + nn]);
      o.z = pack2(sT[(kc + 4) * 65 + nn], sT[(kc + 5) * 65 + nn]);
      o.w = pack2(sT[(kc + 6) * 65 + nn], sT[(kc + 7) * 65 + nn]);
      *(uint4*)(dst + (long)(n0 + nn) * K + k0 + kc) = o;
    }
  }
  __syncthreads();
}

DEVI void rmsnorm_row2(const float* X, const float* w, bf16_t* H, int row0, int row1, int lane) {
  const float4* xa = (const float4*)(X + (long)row0 * 1024);
  const float4* xb = (const float4*)(X + (long)row1 * 1024);
  float4 va[4], vb[4], ww[4];
#pragma unroll
  for (int j = 0; j < 4; ++j) {
    const f32x4 ta_ = __builtin_nontemporal_load((const f32x4*)(xa + lane + 64 * j));
    const f32x4 tb_ = __builtin_nontemporal_load((const f32x4*)(xb + lane + 64 * j));
    va[j] = make_float4(ta_[0], ta_[1], ta_[2], ta_[3]); vb[j] = make_float4(tb_[0], tb_[1], tb_[2], tb_[3]);
    ww[j] = ((const float4*)w)[lane + 64 * j];
  }
  float sa = 0.f, sb = 0.f;
#pragma unroll
  for (int j = 0; j < 4; ++j) {
    sa += va[j].x * va[j].x + va[j].y * va[j].y + va[j].z * va[j].z + va[j].w * va[j].w;
    sb += vb[j].x * vb[j].x + vb[j].y * vb[j].y + vb[j].z * vb[j].z + vb[j].w * vb[j].w;
  }
  sa = wave_sum(sa); sb = wave_sum(sb);
  const float ra = rsqrtf(sa * (1.f / 1024.f) + EPSF), rb = rsqrtf(sb * (1.f / 1024.f) + EPSF);
#pragma unroll
  for (int j = 0; j < 4; ++j) {
    uint2 o;
    o.x = pack2(va[j].x * ra * ww[j].x, va[j].y * ra * ww[j].y);
    o.y = pack2(va[j].z * ra * ww[j].z, va[j].w * ra * ww[j].w);
    *(uint2*)(H + (long)row0 * 1024 + (lane + 64 * j) * 4) = o;
    o.x = pack2(vb[j].x * rb * ww[j].x, vb[j].y * rb * ww[j].y);
    o.y = pack2(vb[j].z * rb * ww[j].z, vb[j].w * rb * ww[j].w);
    *(uint2*)(H + (long)row1 * 1024 + (lane + 64 * j) * 4) = o;
  }
}

DEVI void phase0(const Params& p, unsigned char* smem) {
  const int G = gridDim.x, bid = blockIdx.x, tid = threadIdx.x, lane = tid & 63, w = tid >> 6;
  unsigned char* ws = p.ws;
  float* sT = (float*)smem;
  for (int it = bid; it < 69 * 16; it += G) transpose_tile(p.ev_w_in, 4384, 4384, (bf16_t*)(ws + OFF_WIN0), 1024, it / 69, it % 69, true, sT);
  for (int it = bid; it < 16 * 16; it += G) transpose_tile(p.ev_w_out, 1024, 1024, (bf16_t*)(ws + OFF_WOUT0), 1024, it / 16, it % 16, false, sT);
  for (int it = bid; it < 64 * 16; it += G) transpose_tile(p.od_w_in, 4096, 4096, (bf16_t*)(ws + OFF_WIN1), 1024, it / 64, it % 64, false, sT);
  for (int it = bid; it < 16 * 16; it += G) transpose_tile(p.od_w_out, 1024, 1024, (bf16_t*)(ws + OFF_WOUT1), 1024, it / 16, it % 16, false, sT);
  for (int it = bid; it < 2 * 32; it += G) transpose_tile(p.ck_w1, 128, 128, (bf16_t*)(ws + OFF_WCK), 2048, it / 2, it % 2, false, sT);
  for (int it = bid; it < 2 * 32; it += G) transpose_tile(p.cv_w1, 128, 128, (bf16_t*)(ws + OFF_WCV), 2048, it / 2, it % 2, false, sT);
  for (int row = (bid * 4 + w) * 2; row < 16384; row += G * 8) rmsnorm_row2(p.x, p.norm_w, (bf16_t*)(ws + L0_H), row, row + 1, lane);
  for (int idx = bid * 256 + tid; idx < 8192 * 8; idx += G * 256) {
    int t = idx >> 3, i = idx & 7;
    float invf = powf(500000.0f, -(float)i / 8.0f);
    float ang = (float)t * invf;
    double a = (double)ang;
    float2 cs;
    cs.x = (float)cos(a);
    cs.y = (float)sin(a);
    ((float2*)(ws + OFF_ROPE))[idx] = cs;
  }
  for (int o = bid * 4 + w; o < 256; o += G * 4) {
    int kv = o >> 7, j = o & 127;
    const float* pos = kv ? p.cv_pos : p.ck_pos;
    const float* w1 = kv ? p.cv_w1 : p.ck_w1;
    float sacc_ = 0.f;
#pragma unroll 8
    for (int i = lane; i < 2048; i += 64) sacc_ += pos[i] * w1[i * 128 + j];
    sacc_ = wave_sum(sacc_);
    if (lane == 0) ((float*)(ws + OFF_PB))[o] = sacc_;
  }
  if (bid == G - 2 || G < 2) {
    for (int c = tid; c < 1024; c += 256) {
      float l0 = p.lb_logits[c], l1 = p.lb_logits[1024 + c];
      ((float*)(ws + OFF_LB))[c] = 1.f / (1.f + expf(l1 - l0));
    }
  }
}

template <int MODE>
DEVI void store_rm(bf16_t* dst, int ld, int colbase, f32x4 (&acc)[4][4], const float* bias, int mb, int lane) {
  const int r = lane & 15, q = lane >> 4;
#pragma unroll
  for (int mt = 0; mt < 4; ++mt)
#pragma unroll
    for (int i = 0; i < 4; ++i) {
      long row = mb + mt * 16 + q * 4 + i;
#pragma unroll
      for (int nt = 0; nt < 4; ++nt) {
        float v = acc[mt][nt][i] + bias[nt];
        if (MODE == 1) v = sigm(v);
        if (MODE == 2) v = siluf(v);
        dst[row * ld + colbase + nt * 16 + r] = f2bf(v);
      }
    }
}
template <int MODE>
DEVI void store_T(bf16_t* dst, int bgrp, int F, int featoff, f32x4 (&acc)[4][4], const float* bias, int tl0, int lane) {
  const int r = lane & 15, q = lane >> 4;
#pragma unroll
  for (int mt = 0; mt < 4; ++mt)
#pragma unroll
    for (int nt = 0; nt < 4; ++nt) {
      int t = tl0 + mt * 16 + q * 4;
      float b = bias[nt];
      uint2 o;
      o.x = pack2(acc[mt][nt][0] + b, acc[mt][nt][1] + b);
      o.y = pack2(acc[mt][nt][2] + b, acc[mt][nt][3] + b);
      *(uint2*)(dst + (((long)bgrp * 128 + (t >> 6)) * F + featoff + nt * 16 + r) * 64 + (t & 63)) = o;
    }
}
DEVI void norm_rope_store(bf16_t* dst, long rowbase, int ld, int colbase, f32x4 (&acc)[4][4], const float* bias, const float* nw,
                          float scale, const float2* rope, int mb, int lane) {
  const int r = lane & 15, q = lane >> 4;
  float wv[4];
#pragma unroll
  for (int nt = 0; nt < 4; ++nt) wv[nt] = nw[nt * 16 + r];
  float2 csv[4][4];
#pragma unroll
  for (int mt = 0; mt < 4; ++mt)
#pragma unroll
    for (int i = 0; i < 4; ++i) csv[mt][i] = rope[((mb + mt * 16 + q * 4 + i) & 8191) * 8 + (r & 7)];
#pragma unroll
  for (int mt = 0; mt < 4; ++mt)
#pragma unroll
    for (int i = 0; i < 4; ++i) {
      int row = mb + mt * 16 + q * 4 + i;
      int t = row & 8191;
      float v[4];
      float ss = 0.f;
#pragma unroll
      for (int nt = 0; nt < 4; ++nt) { v[nt] = acc[mt][nt][i] + bias[nt]; ss += v[nt] * v[nt]; }
      ss = grp16_sum(ss);
      float rinv = rsqrtf(ss * (1.f / 64.f) + EPSF);
#pragma unroll
      for (int nt = 0; nt < 4; ++nt) v[nt] = v[nt] * rinv * wv[nt];
      float partner = __shfl_xor(v[0], 8);
      float2 cs = csv[mt][i];
      float x1 = (r < 8) ? v[0] : partner, x2 = (r < 8) ? partner : v[0];
      v[0] = (r < 8) ? (x1 * cs.x - x2 * cs.y) : (x1 * cs.y + x2 * cs.x);
#pragma unroll
      for (int nt = 0; nt < 4; ++nt) dst[(rowbase + t) * ld + colbase + nt * 16 + r] = f2bf(v[nt] * scale);
    }
}

DEVI void epi_proj0(const Params& p, f32x4 (&acc)[4][4], int mb, int nb, int lane) {
  if (nb >= 4384) return;
  unsigned char* ws = p.ws;
  const int r = lane & 15, q = lane >> 4;
  float bias[4];
#pragma unroll
  for (int nt = 0; nt < 4; ++nt) { int n = nb + nt * 16 + r; bias[nt] = (n < 4384) ? p.ev_b_in[oldcol(n)] : 0.f; }
  const int b = mb >> 13;
  const int tl0 = mb & 8191;
  const float2* rope = (const float2*)(ws + OFF_ROPE);
  if (nb < 1024) {
    store_rm<0>((bf16_t*)(ws + L0_QKRAW), 1024, nb, acc, bias, mb, lane);
  } else if (nb < 1536) {
    store_T<0>((bf16_t*)(ws + L0_MVT), b * 4 + ((nb - 1024) >> 7), 128, (nb - 1024) & 127, acc, bias, tl0, lane);
  } else if (nb < 2048) {
    store_rm<1>((bf16_t*)(ws + L0_MO), 512, nb - 1536, acc, bias, mb, lane);
  } else if (nb < 2560) {
    store_rm<2>((bf16_t*)(ws + L0_MZ), 512, nb - 2048, acc, bias, mb, lane);
  } else if (nb < 3072) {
    int head = (nb - 2560) >> 6, g = head >> 2, rr = head & 3;
    norm_rope_store((bf16_t*)(ws + L0_QN), (long)(b * 2 + g) * 8192, 256, rr * 64, acc, bias, p.q_norm, 0.125f * 1.4426950408889634f, rope, mb, lane);
  } else if (nb < 3328) {
    int g = ((nb - 3072) >> 6) & 1;
    bf16_t* dst = (bf16_t*)(ws + (nb < 3200 ? L0_KCRAW : L0_VCRAW));
    const long rowbase = (long)(b * 2 + g) * 8192;
#pragma unroll
    for (int mt = 0; mt < 4; ++mt)
#pragma unroll
      for (int i = 0; i < 4; ++i) {
        int t = (mb + mt * 16 + q * 4 + i) & 8191;
#pragma unroll
        for (int nt = 0; nt < 4; ++nt) dst[(rowbase + t) * 64 + nt * 16 + r] = f2bf(acc[mt][nt][i] + bias[nt]);
      }
  } else if (nb < 3456) {
    int g = (nb - 3328) >> 6;
    norm_rope_store((bf16_t*)(ws + L0_KS), (long)(b * 2 + g) * 8192, 64, 0, acc, bias, p.k_norm + 64, 1.f, rope, mb, lane);
  } else if (nb < 3584) {
    store_T<0>((bf16_t*)(ws + L0_VST), b * 2 + ((nb - 3456) >> 6), 64, 0, acc, bias, tl0, lane);
  } else if (nb < 3712) {
    int g = (nb - 3584) >> 6;
    norm_rope_store((bf16_t*)(ws + L0_KW), (long)(b * 2 + g) * 8192, 64, 0, acc, bias, p.k_norm + 128, 1.f, rope, mb, lane);
  } else if (nb < 3840) {
    store_T<0>((bf16_t*)(ws + L0_VWT), b * 2 + ((nb - 3712) >> 6), 64, 0, acc, bias, tl0, lane);
  } else if (nb < 4352) {
    store_rm<2>((bf16_t*)(ws + L0_NZ), 512, nb - 3840, acc, bias, mb, lane);
  } else {
    float* IG = (float*)(ws + L0_IG);
    float* LF = (float*)(ws + L0_LOGF);
    float* GT = (float*)(ws + L0_GATES);
#pragma unroll
    for (int mt = 0; mt < 4; ++mt)
#pragma unroll
      for (int i = 0; i < 4; ++i) {
        long row = mb + mt * 16 + q * 4 + i;
#pragma unroll
        for (int nt = 0; nt < 2; ++nt) {
          int c = nt * 16 + r;
          float v = acc[mt][nt][i] + bias[nt];
          if (c < 4) IG[row * 4 + c] = v;
          else if (c < 8) { float xx = v + p.f_bias[c - 4]; LF[row * 4 + c - 4] = fminf(xx, 0.f) - log1pf(__expf(-fabsf(xx))); }
          else GT[row * 24 + c - 8] = sigm(v);
        }
      }
  }
}

DEVI void epi_cmp_hidden(const Params& p, f32x4 (&acc)[4][4], int mb, int nb, int lane, int kv, int bg, int ksp) {
  const int r = lane & 15, q = lane >> 4;
  float* hid = (float*)(p.ws + L0_HIDP) + ((long)((ksp * 2 + kv) * 4 + bg) * 512) * 128;
#pragma unroll
  for (int mt = 0; mt < 4; ++mt)
#pragma unroll
    for (int i = 0; i < 4; ++i) {
      int row = mb + mt * 16 + q * 4 + i;
#pragma unroll
      for (int nt = 0; nt < 4; ++nt) hid[(long)row * 128 + nb + nt * 16 + r] = acc[mt][nt][i];
    }
}

DEVI void epi_out_resid(const float* resid, float* out, f32x4 (&acc)[4][4], int mb, int nb, int lane) {
  const int r = lane & 15, q = lane >> 4;
#pragma unroll
  for (int mt = 0; mt < 4; ++mt) {
    float rv[4][4];
#pragma unroll
    for (int i = 0; i < 4; ++i)
#pragma unroll
      for (int nt = 0; nt < 4; ++nt) rv[i][nt] = resid[(long)(mb + mt * 16 + q * 4 + i) * 1024 + nb + nt * 16 + r];
#pragma unroll
    for (int i = 0; i < 4; ++i)
#pragma unroll
      for (int nt = 0; nt < 4; ++nt) out[(long)(mb + mt * 16 + q * 4 + i) * 1024 + nb + nt * 16 + r] = rv[i][nt] + acc[mt][nt][i];
  }
}

DEVI void epi_proj1(const Params& p, f32x4 (&acc)[4][4], int mb, int nb, int lane) {
  unsigned char* ws = p.ws;
  const int r = lane & 15;
  float bias[4];
#pragma unroll
  for (int nt = 0; nt < 4; ++nt) bias[nt] = p.od_b_in[nb + nt * 16 + r];
  const int b = mb >> 13, tl0 = mb & 8191;
  if (nb < 1024) store_rm<0>((bf16_t*)(ws + L1_FP), 1024, nb, acc, bias, mb, lane);
  else if (nb < 2048) store_T<0>((bf16_t*)(ws + L1_VT), b * 8 + ((nb - 1024) >> 7), 128, (nb - 1024) & 127, acc, bias, tl0, lane);
  else if (nb < 3072) store_rm<2>((bf16_t*)(ws + L1_Q), 1024, nb - 2048, acc, bias, mb, lane);
  else store_rm<2>((bf16_t*)(ws + L1_Z), 1024, nb - 3072, acc, bias, mb, lane);
}

DEVI void conv_tile(const Params& p, int item, unsigned char* smem) {
  const int tid = opaque_tid();
  const int ctile = item & 7, ttile = item >> 3;
  const int t0g = ttile * 64;
  const int b = t0g >> 13, tl0 = t0g & 8191;
  unsigned char* ws = p.ws;
  float* sRaw = (float*)smem;
  bf16_t* sOutT = (bf16_t*)(smem + 67 * 128 * 4);
  const bf16_t* raw = (const bf16_t*)(ws + L0_QKRAW);
  for (int idx = tid; idx < 67 * 16; idx += 256) {
    int rr = idx >> 4, ch = (idx & 15) * 8;
    int tl = tl0 + rr - 3;
    uint4 v = make_uint4(0, 0, 0, 0);
    if (tl >= 0) v = *(const uint4*)(raw + (long)(b * 8192 + tl) * 1024 + ctile * 128 + ch);
    float* d = sRaw + rr * 128 + ch;
    d[0] = lo2f(v.x); d[1] = hi2f(v.x); d[2] = lo2f(v.y); d[3] = hi2f(v.y);
    d[4] = lo2f(v.z); d[5] = hi2f(v.z); d[6] = lo2f(v.w); d[7] = hi2f(v.w);
  }
  __syncthreads();
  const int c = tid & 127, th = tid >> 7;
  const int cg_ = ctile * 128 + c;
  const float w0 = p.conv_w[cg_], w1 = p.conv_w[1024 + cg_], w2 = p.conv_w[2048 + cg_], w3 = p.conv_w[3072 + cg_];
  const float cb = p.conv_b[cg_];
  const bool isk = ctile >= 4;
  bf16_t* dst = (bf16_t*)(ws + (isk ? L0_KC : L0_QC));
  const int cc = isk ? cg_ - 512 : cg_;
  const float sc = isk ? 0.08838834764831845f : 1.f;
  for (int t = th * 32; t < th * 32 + 32; ++t) {
    float a = cb + w0 * sRaw[t * 128 + c] + w1 * sRaw[(t + 1) * 128 + c] + w2 * sRaw[(t + 2) * 128 + c] + w3 * sRaw[(t + 3) * 128 + c];
    bf16_t o = f2bf(siluf(a) * sc);
    dst[(long)(t0g + t) * 512 + cc] = o;
    sOutT[c * LDT + t] = o;
  }
  __syncthreads();
  if (isk) {
    bf16_t* kct = (bf16_t*)(ws + L0_KCT);
#pragma unroll
    for (int j = 0; j < 4; ++j) {
      int idx = tid + 256 * j;
      int cr = idx >> 3, tc = (idx & 7) * 8;
      *(uint4*)(kct + ((((long)(b * 4 + (ctile - 4)) * 128 + (tl0 >> 6)) * 128 + cr) * 64) + tc) = *(const uint4*)(sOutT + cr * LDT + tc);
    }
  }
  __syncthreads();
}

DEVI void cmp_finalize(const Params& p, int task, int lane) {
  const int n = task & 511, bg = (task >> 9) & 3, kv = task >> 11;
  unsigned char* ws = p.ws;
  bf16_t* KCMP = (bf16_t*)(ws + L0_KCMP);
  bf16_t* VCMPT = (bf16_t*)(ws + L0_VCMPT);
  if (n == 511) {
    if (kv == 0) KCMP[((long)bg * 512 + 511) * 64 + lane] = 0;
    else VCMPT[((long)bg * 64 + lane) * 512 + 511] = 0;
    return;
  }
  const float* hid = (const float*)(ws + L0_HIDP) + ((long)(kv * 4 + bg) * 512 + n) * 128;
  const float* pbv = (const float*)(ws + OFF_PB) + kv * 128;
  const float* w2 = kv ? p.cv_w2 : p.ck_w2;
  float g0, g1;
  {
    float x0 = ((hid[lane] + hid[lane + 524288]) + (hid[lane + 2 * 524288] + hid[lane + 3 * 524288])) + pbv[lane];
    float x1 = ((hid[lane + 64] + hid[lane + 64 + 524288]) + (hid[lane + 64 + 2 * 524288] + hid[lane + 64 + 3 * 524288])) + pbv[lane + 64];
    g0 = 0.5f * x0 * (1.f + tanhf(0.7978845608028654f * (x0 + 0.044715f * x0 * x0 * x0)));
    g1 = 0.5f * x1 * (1.f + tanhf(0.7978845608028654f * (x1 + 0.044715f * x1 * x1 * x1)));
  }
  float a = 0.f;
  for (int j0 = 0; j0 < 64; j0 += 16) {
    float wv[16], wu[16];
#pragma unroll
    for (int k = 0; k < 16; ++k) { wv[k] = w2[(j0 + k) * 64 + lane]; wu[k] = w2[(64 + j0 + k) * 64 + lane]; }
#pragma unroll
    for (int k = 0; k < 16; ++k) a += __shfl(g0, j0 + k) * wv[k] + __shfl(g1, j0 + k) * wu[k];
  }
  if (kv == 0) {
    float ss = wave_sum(a * a);
    float rinv = rsqrtf(ss * (1.f / 64.f) + EPSF);
    float v = a * rinv * p.k_norm[lane];
    float partner = __shfl_xor(v, 8);
    int pos = 16 * n + 31;
    float2 cs = ((const float2*)(ws + OFF_ROPE))[pos * 8 + (lane & 7)];
    float o = v;
    if (lane < 8) o = v * cs.x - partner * cs.y;
    else if (lane < 16) o = partner * cs.y + v * cs.x;
    KCMP[((long)bg * 512 + n) * 64 + lane] = f2bf(o);
  } else {
    VCMPT[((long)bg * 64 + lane) * 512 + n] = f2bf(a);
  }
}

DEVI void mlstm_local(const Params& p, int unit, unsigned char* smem) {
  const int tid = opaque_tid(), lane = tid & 63, w = tid >> 6, wr = w >> 1, wc = w & 1;
  const int bh = unit >> 6, c = unit & 63, b = bh >> 2, h = bh & 3, t0 = c * 128;
  const long R0 = (long)b * 8192 + t0;
  unsigned char* ws = p.ws;
  bf16_t* sA = (bf16_t*)smem;
  bf16_t* sB = (bf16_t*)(smem + 18432);
  float* sIg = (float*)(smem + 36864);
  float* sLf = sIg + 128;
  float* sW = sLf + 128;
  const float* IG = (const float*)(ws + L0_IG);
  const float* LF = (const float*)(ws + L0_LOGF);
  if (tid < 128) { sIg[tid] = IG[(R0 + tid) * 4 + h]; sLf[tid] = LF[(R0 + tid) * 4 + h]; }
  __syncthreads();
  if (tid < 64) {
    float c0 = sLf[2 * tid], c1 = sLf[2 * tid + 1];
    wave_scan_sum128(c0, c1, tid);
    const float bL = __shfl(c1, 63);
    float d0 = bL - c0 + sIg[2 * tid], d1 = bL - c1 + sIg[2 * tid + 1];
    const float ml = wave_max(fmaxf(d0, d1));
    sW[2 * tid] = __expf(d0 - ml); sW[2 * tid + 1] = __expf(d1 - ml);
    if (tid == 0) { ((float*)(ws + L0_BL))[unit] = bL; ((float*)(ws + L0_MLOC))[unit] = ml; }
  }
  __syncthreads();
  f32x4 acc[4][4];
#pragma unroll
  for (int mt = 0; mt < 4; ++mt)
#pragma unroll
    for (int nt = 0; nt < 4; ++nt) acc[mt][nt] = f32x4{0.f, 0.f, 0.f, 0.f};
  float dn = 0.f;
  const bf16_t* vt = (const bf16_t*)(ws + L0_MVT) + (((long)(b * 4 + h) * 128 + (t0 >> 6)) * 128) * 64;
  const bf16_t* kt_ = (const bf16_t*)(ws + L0_KCT) + (((long)(b * 4 + h) * 128 + (t0 >> 6)) * 128) * 64;
  const int lr = tid >> 3, lk = (tid & 7) * 8;
  for (int kt = 0; kt < 2; ++kt) {
    load_tile128(sA, vt + kt * 8192, 64);
#pragma unroll
    for (int j = 0; j < 4; ++j) {
      uint4 v = *(const uint4*)(kt_ + (long)kt * 8192 + (lr + 32 * j) * 64 + lk);
      const float* ww = sW + kt * 64 + lk;
      uint4 o;
      o.x = pack2(lo2f(v.x) * ww[0], hi2f(v.x) * ww[1]);
      o.y = pack2(lo2f(v.y) * ww[2], hi2f(v.y) * ww[3]);
      o.z = pack2(lo2f(v.z) * ww[4], hi2f(v.z) * ww[5]);
      o.w = pack2(lo2f(v.w) * ww[6], hi2f(v.w) * ww[7]);
      *(uint4*)(sB + (lr + 32 * j) * LDT + lk) = o;
    }
    __syncthreads();
    if (tid < 128) {
#pragma unroll 8
      for (int s = 0; s < 64; ++s) dn += bf2f(sB[tid * LDT + s]);
    }
    mma_lds<4, 4, 2>(sA + wr * 64 * LDT, sB + wc * 64 * LDT, acc, lane);
    __syncthreads();
  }
  float* dct = (float*)(ws + L0_H) + (long)unit * 16384;
  const int r = lane & 15, q = lane >> 4;
#pragma unroll
  for (int mt = 0; mt < 4; ++mt)
#pragma unroll
    for (int i = 0; i < 4; ++i) {
      int e = wr * 64 + mt * 16 + q * 4 + i;
#pragma unroll
      for (int nt = 0; nt < 4; ++nt) dct[e * 128 + wc * 64 + nt * 16 + r] = acc[mt][nt][i];
    }
  if (tid < 128) ((float*)(ws + L0_DN))[unit * 128 + tid] = dn;
}

template <bool DUMMY>
DEVI void mlstm_scan(const Params& p, unsigned char* smem) {
  unsigned char* ws = p.ws;
  const float* BL = (const float*)(ws + L0_BL);
  const float* ML = (const float*)(ws + L0_MLOC);
  float* MIN_ = (float*)(ws + L0_MIN);
  float* sDec = (float*)smem;
  float* sWn = sDec + 128;
  const int tid = opaque_tid();
  const int total = 8 * 16384 + 8 * 128;
  for (int base = blockIdx.x * 256; base < total; base += gridDim.x * 256) {
    const int bh0 = (base < 131072) ? (base >> 14) : ((base - 131072) >> 7);
    __syncthreads();
    if (tid < 2) {
      const int bh = bh0 + tid;
      if (bh < 8) {
        float m = 0.f;
        for (int c = 0; c < 64; ++c) {
          const int unit = bh * 64 + c;
          const float bL = BL[unit], ml = ML[unit];
          if (!DUMMY && base < 131072 && (base & 16383) == 0 && tid == 0) MIN_[unit] = m;
          const float mn = fmaxf(bL + m, ml);
          sDec[tid * 64 + c] = __expf(bL + m - mn);
          sWn[tid * 64 + c] = __expf(ml - mn);
          m = mn;
        }
      }
    }
    __syncthreads();
    const int idx = base + tid;
    if (idx < total) {
      float* ptr; long stride; int sel;
      if (idx < 131072) { const int bh = idx >> 14; ptr = (float*)(ws + L0_H) + (long)bh * 64 * 16384 + (idx & 16383); stride = 16384; sel = bh - bh0; }
      else { const int j = idx - 131072; const int bh = j >> 7; ptr = (float*)(ws + L0_DN) + (long)bh * 64 * 128 + (j & 127); stride = 128; sel = bh - bh0; }
      const float* dec = sDec + sel * 64;
      const float* wn = sWn + sel * 64;
      float C = 0.f;
      for (int c0 = 0; c0 < 64; c0 += 8) {
        float dv[8];
#pragma unroll
        for (int k = 0; k < 8; ++k) dv[k] = __builtin_nontemporal_load(ptr + (long)(c0 + k) * stride);
#pragma unroll
        for (int k = 0; k < 8; ++k) {
          if (!DUMMY) ptr[(long)(c0 + k) * stride] = C;
          C = dec[c0 + k] * C + wn[c0 + k] * dv[k];
        }
      }
      if (DUMMY && C == 123.456f) MIN_[0] = C;
    }
  }
}

DEVI void mlstm_out(const Params& p, int item, unsigned char* smem) {
  const int tid = opaque_tid(), lane = tid & 63, w = tid >> 6, wr = w >> 1, wc = w & 1;
  const int r = lane & 15, q = lane >> 4;
  const int unit = item >> 1, u = item & 1;
  const int bh = unit >> 6, c = unit & 63, b = bh >> 2, h = bh & 3, t0 = c * 128;
  const long R0 = (long)b * 8192 + t0;
  const int J0 = u * 64;
  unsigned char* ws = p.ws;
  bf16_t* sA = (bf16_t*)smem;
  bf16_t* sB = (bf16_t*)(smem + 9216);
  bf16_t* sS0 = (bf16_t*)(smem + 27648);
  bf16_t* sS1 = (bf16_t*)(smem + 36864);
  float* fl = (float*)(smem + 46080);
  float* sIg = fl; float* sLf = fl + 128; float* sRj = fl + 256; float* sCs = fl + 384; float* sWi = fl + 512;
  float* sEm = fl + 640; float* sQn = fl + 768; float* sNin = fl + 896; float* sDen = fl + 1024; float* sSs = fl + 1280;
  const float* IG = (const float*)(ws + L0_IG);
  const float* LF = (const float*)(ws + L0_LOGF);
  const bf16_t* QC = (const bf16_t*)(ws + L0_QC) + (R0 + J0) * 512 + h * 128;
  const bf16_t* KC = (const bf16_t*)(ws + L0_KC) + R0 * 512 + h * 128;
  if (tid < 128) { sIg[tid] = IG[(R0 + tid) * 4 + h]; sLf[tid] = LF[(R0 + tid) * 4 + h]; sNin[tid] = ((const float*)(ws + L0_DN))[unit * 128 + tid]; }
  const float m_in = ((const float*)(ws + L0_MIN))[unit];
  __syncthreads();
  if (tid < 64) {
    float c0 = sLf[2 * tid], c1 = sLf[2 * tid + 1];
    wave_scan_sum128(c0, c1, tid);
    const float a0 = sIg[2 * tid] - c0, a1 = sIg[2 * tid + 1] - c1;
    float x0 = a0, x1 = a1;
    wave_scan_max128(x0, x1, tid);
    const float mx0 = fmaxf(x0, m_in), mx1 = fmaxf(x1, m_in);
    sCs[2 * tid] = a0; sCs[2 * tid + 1] = a1;
    sRj[2 * tid] = -mx0; sRj[2 * tid + 1] = -mx1;
    sWi[2 * tid] = __expf(m_in - mx0); sWi[2 * tid + 1] = __expf(m_in - mx1);
    sEm[2 * tid] = __expf(-(c0 + mx0)); sEm[2 * tid + 1] = __expf(-(c1 + mx1));
  }
  if (tid >= 128 && tid < 192) {
    int jl = tid - 128;
    const bf16_t* qr = QC + (long)jl * 512;
    float s = 0.f;
#pragma unroll 2
    for (int ch = 0; ch < 16; ++ch) {
      uint4 v = *(const uint4*)(qr + ch * 8);
      const float* nn = sNin + ch * 8;
      s += lo2f(v.x) * nn[0] + hi2f(v.x) * nn[1] + lo2f(v.y) * nn[2] + hi2f(v.y) * nn[3] + lo2f(v.z) * nn[4] + hi2f(v.z) * nn[5] + lo2f(v.w) * nn[6] + hi2f(v.w) * nn[7];
    }
    sQn[jl] = s;
  }
  __syncthreads();
  f32x4 acc[2][4];
#pragma unroll
  for (int mt = 0; mt < 2; ++mt)
#pragma unroll
    for (int nt = 0; nt < 4; ++nt) acc[mt][nt] = f32x4{0.f, 0.f, 0.f, 0.f};
  const bool skipS = (wc > u);
  const int lr = tid >> 3, lk = (tid & 7) * 8;
  {
    u32x4 qa0, qa1, kb0, kb1, kb2, kb3;
    qa0 = *(const u32x4*)(QC + (long)lr * 512 + lk); qa1 = *(const u32x4*)(QC + (long)(lr + 32) * 512 + lk);
    kb0 = *(const u32x4*)(KC + (long)lr * 512 + lk); kb1 = *(const u32x4*)(KC + (long)(lr + 32) * 512 + lk);
    kb2 = *(const u32x4*)(KC + (long)(lr + 64) * 512 + lk); kb3 = *(const u32x4*)(KC + (long)(lr + 96) * 512 + lk);
#pragma unroll 1
    for (int kt = 0; kt < 2; ++kt) {
      *(u32x4*)(sA + lr * LDT + lk) = qa0; *(u32x4*)(sA + (lr + 32) * LDT + lk) = qa1;
      *(u32x4*)(sB + lr * LDT + lk) = kb0; *(u32x4*)(sB + (lr + 32) * LDT + lk) = kb1;
      *(u32x4*)(sB + (lr + 64) * LDT + lk) = kb2; *(u32x4*)(sB + (lr + 96) * LDT + lk) = kb3;
      __syncthreads();
      if (kt == 0) {
        qa0 = *(const u32x4*)(QC + (long)lr * 512 + 64 + lk); qa1 = *(const u32x4*)(QC + (long)(lr + 32) * 512 + 64 + lk);
        kb0 = *(const u32x4*)(KC + (long)lr * 512 + 64 + lk); kb1 = *(const u32x4*)(KC + (long)(lr + 32) * 512 + 64 + lk);
        kb2 = *(const u32x4*)(KC + (long)(lr + 64) * 512 + 64 + lk); kb3 = *(const u32x4*)(KC + (long)(lr + 96) * 512 + 64 + lk);
      }
      if (!skipS) mma_lds<2, 4, 2>(sA + wr * 32 * LDT, sB + wc * 64 * LDT, acc, lane);
      __syncthreads();
    }
  }
  {
    bf16_t* sS = wc ? sS1 : sS0;
#pragma unroll
    for (int mt = 0; mt < 2; ++mt)
#pragma unroll
      for (int i = 0; i < 4; ++i) {
        int jl = wr * 32 + mt * 16 + q * 4 + i;
        int j = J0 + jl;
        float rj = sRj[j], rs = 0.f;
#pragma unroll
        for (int nt = 0; nt < 4; ++nt) {
          int sl = nt * 16 + r, s = wc * 64 + sl;
          float val = (s <= j) ? acc[mt][nt][i] * __expf(rj + sCs[s]) : 0.f;
          rs += val;
          sS[jl * LDT + sl] = f2bf(val);
        }
        rs = grp16_sum(rs);
        if (r == 0) sDen[wc * 64 + jl] = rs;
      }
  }
#pragma unroll
  for (int mt = 0; mt < 2; ++mt)
#pragma unroll
    for (int nt = 0; nt < 4; ++nt) acc[mt][nt] = f32x4{0.f, 0.f, 0.f, 0.f};
  const bf16_t* vt = (const bf16_t*)(ws + L0_MVT) + (((long)(b * 4 + h) * 128 + (t0 >> 6)) * 128) * 64;
  const float* ct = (const float*)(ws + L0_H) + (long)unit * 16384;
  {
    u32x4 vb0, vb1, vb2, vb3;
    u32x4 qa0, qa1;
    float4 cv[8];
    const int nsteps = u ? 4 : 3;
    auto kind_of = [&](int sidx) { return u ? sidx : (sidx == 0 ? 0 : sidx + 1); };
    auto fetch = [&](int kind) {
      if (kind < 2) {
        const bf16_t* vp = vt + (long)kind * 8192 + lr * 64 + lk;
        vb0 = *(const u32x4*)vp; vb1 = *(const u32x4*)(vp + 32 * 64); vb2 = *(const u32x4*)(vp + 64 * 64); vb3 = *(const u32x4*)(vp + 96 * 64);
      } else {
        const int k2 = kind - 2;
        qa0 = *(const u32x4*)(QC + (long)lr * 512 + k2 * 64 + lk); qa1 = *(const u32x4*)(QC + (long)(lr + 32) * 512 + k2 * 64 + lk);
#pragma unroll
        for (int j = 0; j < 8; ++j) cv[j] = *(const float4*)(ct + (long)((tid >> 4) + 16 * j) * 128 + k2 * 64 + (tid & 15) * 4);
      }
    };
    fetch(0);
#pragma unroll 1
    for (int sidx = 0; sidx < nsteps; ++sidx) {
      const int kind = kind_of(sidx);
      const bf16_t* aS;
      if (kind < 2) {
        *(u32x4*)(sB + lr * LDT + lk) = vb0; *(u32x4*)(sB + (lr + 32) * LDT + lk) = vb1;
        *(u32x4*)(sB + (lr + 64) * LDT + lk) = vb2; *(u32x4*)(sB + (lr + 96) * LDT + lk) = vb3;
        aS = kind ? sS1 : sS0;
      } else {
        const float w0 = sWi[J0 + lr], w1 = sWi[J0 + lr + 32];
        u32x4 o0, o1;
        o0[0] = pack2(lo2f(qa0[0]) * w0, hi2f(qa0[0]) * w0); o0[1] = pack2(lo2f(qa0[1]) * w0, hi2f(qa0[1]) * w0);
        o0[2] = pack2(lo2f(qa0[2]) * w0, hi2f(qa0[2]) * w0); o0[3] = pack2(lo2f(qa0[3]) * w0, hi2f(qa0[3]) * w0);
        o1[0] = pack2(lo2f(qa1[0]) * w1, hi2f(qa1[0]) * w1); o1[1] = pack2(lo2f(qa1[1]) * w1, hi2f(qa1[1]) * w1);
        o1[2] = pack2(lo2f(qa1[2]) * w1, hi2f(qa1[2]) * w1); o1[3] = pack2(lo2f(qa1[3]) * w1, hi2f(qa1[3]) * w1);
        *(u32x4*)(sA + lr * LDT + lk) = o0; *(u32x4*)(sA + (lr + 32) * LDT + lk) = o1;
#pragma unroll
        for (int j = 0; j < 8; ++j) {
          uint2 o;
          o.x = pack2(cv[j].x, cv[j].y);
          o.y = pack2(cv[j].z, cv[j].w);
          *(uint2*)(sB + ((tid >> 4) + 16 * j) * LDT + (tid & 15) * 4) = o;
        }
        aS = sA;
      }
      __syncthreads();
      if (sidx + 1 < nsteps) fetch(kind_of(sidx + 1));
      mma_lds<2, 4, 2>(aS + wr * 32 * LDT, sB + wc * 64 * LDT, acc, lane);
      __syncthreads();
    }
  }
#pragma unroll
  for (int mt = 0; mt < 2; ++mt)
#pragma unroll
    for (int i = 0; i < 4; ++i) {
      int jl = wr * 32 + mt * 16 + q * 4 + i;
      int j = J0 + jl;
      float den = sDen[jl] + sDen[64 + jl] + sWi[j] * sQn[jl];
      float dinv = 1.f / fmaxf(fabsf(den), sEm[j]);
      float ss = 0.f;
#pragma unroll
      for (int nt = 0; nt < 4; ++nt) { float v = acc[mt][nt][i] * dinv; acc[mt][nt][i] = v; ss += v * v; }
      ss = grp16_sum(ss);
      if (r == 0) sSs[wc * 64 + jl] = ss;
    }
  __syncthreads();
  const bf16_t* MO = (const bf16_t*)(ws + L0_MO);
  const bf16_t* MZ = (const bf16_t*)(ws + L0_MZ);
  bf16_t* Y = (bf16_t*)(ws + L0_QKRAW);
  float hn[4];
#pragma unroll
  for (int nt = 0; nt < 4; ++nt) hn[nt] = p.m_hn[h * 128 + wc * 64 + nt * 16 + r];
#pragma unroll
  for (int mt = 0; mt < 2; ++mt) {
    float gv[4][4];
#pragma unroll
    for (int i = 0; i < 4; ++i) {
      long row = R0 + J0 + wr * 32 + mt * 16 + q * 4 + i;
#pragma unroll
      for (int nt = 0; nt < 4; ++nt) {
        int col = h * 128 + wc * 64 + nt * 16 + r;
        gv[i][nt] = bf2f(MO[row * 512 + col]) * bf2f(MZ[row * 512 + col]);
      }
    }
#pragma unroll
    for (int i = 0; i < 4; ++i) {
      int jl = wr * 32 + mt * 16 + q * 4 + i;
      float rinv = rsqrtf((sSs[jl] + sSs[64 + jl]) * (1.f / 128.f) + EPSF);
      long row = R0 + J0 + jl;
#pragma unroll
      for (int nt = 0; nt < 4; ++nt) {
        int col = h * 128 + wc * 64 + nt * 16 + r;
        Y[row * 1024 + col] = f2bf(acc[mt][nt][i] * rinv * hn[nt] * gv[i][nt]);
      }
    }
  }
  __syncthreads();
}

struct NsaSm {
  bf16_t* sK; bf16_t* sV;
  float* sImpA; float* sImpB;
  unsigned* sSel; unsigned* sGrp; unsigned* sUn;
};

DEVI int next_bit(unsigned long long lo, unsigned long long hi, int from) {
  if (from < 64) {
    unsigned long long v = lo & (~0ull << from);
    if (v) return __builtin_ctzll(v);
    if (hi) return 64 + __builtin_ctzll(hi);
    return -1;
  }
  if (from >= 128) return -1;
  unsigned long long v = hi & (~0ull << (from - 64));
  if (v) return 64 + __builtin_ctzll(v);
  return -1;
}

template <int MODE, bool DUMMY = false, class MaskF, class ActF>
DEVI void nsa_branch(const NsaSm& sm, unsigned long long tmlo, unsigned long long tmhi,
                     const bf16_t* Kg, const bf16_t* Vg, long vstep, long ldv,
                     const bf16x8 (&qf)[2][2], f32x4 (&O)[4][2], float (&mrow)[2], float (&lrow)[2], const float (&invl)[2],
                     MaskF mask, ActF actf, int tokbase, int tid) {
  const int lane = tid & 63, r = lane & 15, q = lane >> 4;
  const int lr = tid >> 3, lk = (tid & 7) * 8;
  int j = next_bit(tmlo, tmhi, 0);
  if (j < 0) return;
  u32x4 k0, k1, v0, v1;
  u32x4 k2, k3, v2, v3;
  if (!DUMMY) {
    const bf16_t* kp = Kg + (long)j * 4096 + lr * 64 + lk;
    k0 = *(const u32x4*)kp; k1 = *(const u32x4*)(kp + 32 * 64);
    if (MODE != 1) {
      const bf16_t* vp = Vg + (long)j * vstep + (long)lr * ldv + lk;
      v0 = *(const u32x4*)vp; v1 = *(const u32x4*)(vp + 32 * ldv);
    }
    *(u32x4*)(sm.sK + lr * LDT + lk) = k0; *(u32x4*)(sm.sK + (lr + 32) * LDT + lk) = k1;
    if (MODE != 1) { *(u32x4*)(sm.sV + lr * LDT + lk) = v0; *(u32x4*)(sm.sV + (lr + 32) * LDT + lk) = v1; }
  }
  int j1 = next_bit(tmlo, tmhi, j + 1);
  if (!DUMMY && j1 >= 0) {
    const bf16_t* kp = Kg + (long)j1 * 4096 + lr * 64 + lk;
    k0 = *(const u32x4*)kp; k1 = *(const u32x4*)(kp + 32 * 64);
    if (MODE != 1) {
      const bf16_t* vp = Vg + (long)j1 * vstep + (long)lr * ldv + lk;
      v0 = *(const u32x4*)vp; v1 = *(const u32x4*)(vp + 32 * ldv);
    }
  }
  if (!DUMMY) __syncthreads();
  int buf = 0;
  while (true) {
    const int jn = j1;
    const int j2 = (j1 >= 0) ? next_bit(tmlo, tmhi, j1 + 1) : -1;
    if (!DUMMY && j2 >= 0) {
      const bf16_t* kp = Kg + (long)j2 * 4096 + lr * 64 + lk;
      k2 = *(const u32x4*)kp; k3 = *(const u32x4*)(kp + 32 * 64);
      if (MODE != 1) {
        const bf16_t* vp = Vg + (long)j2 * vstep + (long)lr * ldv + lk;
        v2 = *(const u32x4*)vp; v3 = *(const u32x4*)(vp + 32 * ldv);
      }
    }
    const bf16_t* sK = sm.sK + buf * (64 * LDT);
    const bf16_t* sV = sm.sV + buf * (64 * LDT);
    const bool a0 = actf(0, j), a1 = actf(1, j);
    __builtin_amdgcn_sched_barrier(0);
    if (a0 || a1) {
      const bool full = mask.full(j);
      f32x4 sacc[4][2];
#pragma unroll
      for (int mt = 0; mt < 4; ++mt) { sacc[mt][0] = f32x4{0.f, 0.f, 0.f, 0.f}; sacc[mt][1] = f32x4{0.f, 0.f, 0.f, 0.f}; }
      __builtin_amdgcn_s_setprio(2);
#pragma unroll
      for (int ks = 0; ks < 2; ++ks)
#pragma unroll
        for (int mt = 0; mt < 4; ++mt) {
          bf16x8 a = *(const bf16x8*)(sK + (mt * 16 + r) * LDT + ks * 32 + q * 8);
          if (a0) sacc[mt][0] = __builtin_amdgcn_mfma_f32_16x16x32_bf16(a, qf[0][ks], sacc[mt][0], 0, 0, 0);
          if (a1) sacc[mt][1] = __builtin_amdgcn_mfma_f32_16x16x32_bf16(a, qf[1][ks], sacc[mt][1], 0, 0, 0);
        }
      __builtin_amdgcn_s_setprio(0);
      __builtin_amdgcn_sched_barrier(0);
#pragma unroll
      for (int nt = 0; nt < 2; ++nt) {
        const bool act = nt ? a1 : a0;
        if (act) {
          const bool lb = mask.bit(nt, j);
          if (!full) {
#pragma unroll
            for (int mt = 0; mt < 4; ++mt)
#pragma unroll
              for (int i = 0; i < 4; ++i) sacc[mt][nt][i] = mask.elem(mt * 16 + q * 4 + i, nt, j) ? sacc[mt][nt][i] : NEGS;
          }
          if (MODE != 2) {
            float tmx = fmaxf(fmaxf(sacc[0][nt][0], sacc[0][nt][1]), fmaxf(sacc[0][nt][2], sacc[0][nt][3]));
#pragma unroll
            for (int mt = 1; mt < 4; ++mt)
              tmx = fmaxf(tmx, fmaxf(fmaxf(sacc[mt][nt][0], sacc[mt][nt][1]), fmaxf(sacc[mt][nt][2], sacc[mt][nt][3])));
            if (MaskF::HASBIT) tmx = lb ? tmx : NEGS;
            tmx = fmaxf(tmx, __shfl_xor(tmx, 16));
            tmx = fmaxf(tmx, __shfl_xor(tmx, 32));
            const float mo = mrow[nt];
            const float mn = fmaxf(mo, tmx);
            float mnc = fmaxf(mn, -1e20f);
            if (MaskF::HASBIT) mnc = lb ? mnc : 1e30f;
            mrow[nt] = mn;
            f32x4 psv = f32x4{0.f, 0.f, 0.f, 0.f};
#pragma unroll
            for (int mt = 0; mt < 4; ++mt) {
              f32x4 dd = sacc[mt][nt] - mnc;
              f32x4 pp;
              pp[0] = __builtin_amdgcn_exp2f(dd[0]); pp[1] = __builtin_amdgcn_exp2f(dd[1]);
              pp[2] = __builtin_amdgcn_exp2f(dd[2]); pp[3] = __builtin_amdgcn_exp2f(dd[3]);
              sacc[mt][nt] = pp;
              psv += pp;
            }
            const float ps = (psv[0] + psv[1]) + (psv[2] + psv[3]);
            const float al = __builtin_amdgcn_exp2f(mo - mn);
            lrow[nt] = lrow[nt] * al + ps;
            if (MODE == 0) {
              if (__any(al != 1.f)) {
#pragma unroll
                for (int dt = 0; dt < 4; ++dt) O[dt][nt] *= al;
              }
            }
          } else {
            const float mmc = fmaxf(mrow[nt], -1e20f), il = invl[nt];
            const int tok = tokbase + nt * 4 + (r >> 2);
#pragma unroll
            for (int mt = 0; mt < 4; ++mt) {
              float pp[4];
#pragma unroll
              for (int i = 0; i < 4; ++i) {
                pp[i] = __builtin_amdgcn_exp2f(sacc[mt][nt][i] - mmc) * il;
                sacc[mt][nt][i] = pp[i];
              }
              float mainv = 32.f * (pp[0] + pp[1] + pp[2]) + 16.f * pp[3];
              float carry = 16.f * pp[3];
              mainv += __shfl_xor(mainv, 1); mainv += __shfl_xor(mainv, 2);
              carry += __shfl_xor(carry, 1); carry += __shfl_xor(carry, 2);
              if ((r & 3) == 0) {
                const int mp = j * 16 + mt * 4 + q;
                sm.sImpA[tok * 128 + mp] = mainv;
                if (mp + 1 < 128) sm.sImpB[tok * 128 + mp + 1] = carry;
              }
            }
          }
        }
      }
      __builtin_amdgcn_sched_barrier(0);
      if (MODE != 1) {
        __builtin_amdgcn_s_setprio(2);
#pragma unroll
        for (int ks = 0; ks < 2; ++ks) {
          bf16x8 pb[2];
#pragma unroll
          for (int nt = 0; nt < 2; ++nt) {
            union { u32x4 u; bf16x8 h; } cv;
            cv.u[0] = pack2(sacc[2 * ks][nt][0], sacc[2 * ks][nt][1]);
            cv.u[1] = pack2(sacc[2 * ks][nt][2], sacc[2 * ks][nt][3]);
            cv.u[2] = pack2(sacc[2 * ks + 1][nt][0], sacc[2 * ks + 1][nt][1]);
            cv.u[3] = pack2(sacc[2 * ks + 1][nt][2], sacc[2 * ks + 1][nt][3]);
            pb[nt] = cv.h;
          }
#pragma unroll
          for (int dt = 0; dt < 4; ++dt) {
            union { u32x4 u; bf16x8 h; } av;
            const uint2 lo = *(const uint2*)(sV + (dt * 16 + r) * LDT + (2 * ks) * 16 + q * 4);
            const uint2 hi = *(const uint2*)(sV + (dt * 16 + r) * LDT + (2 * ks + 1) * 16 + q * 4);
            av.u[0] = lo.x; av.u[1] = lo.y; av.u[2] = hi.x; av.u[3] = hi.y;
            if (a0) O[dt][0] = __builtin_amdgcn_mfma_f32_16x16x32_bf16(av.h, pb[0], O[dt][0], 0, 0, 0);
            if (a1) O[dt][1] = __builtin_amdgcn_mfma_f32_16x16x32_bf16(av.h, pb[1], O[dt][1], 0, 0, 0);
          }
        }
        __builtin_amdgcn_s_setprio(0);
      }
    }
    __builtin_amdgcn_sched_barrier(0);
    if (!DUMMY && jn >= 0) {
      bf16_t* dK = sm.sK + (buf ^ 1) * (64 * LDT);
      bf16_t* dV = sm.sV + (buf ^ 1) * (64 * LDT);
      *(u32x4*)(dK + lr * LDT + lk) = k0; *(u32x4*)(dK + (lr + 32) * LDT + lk) = k1;
      if (MODE != 1) { *(u32x4*)(dV + lr * LDT + lk) = v0; *(u32x4*)(dV + (lr + 32) * LDT + lk) = v1; }
    }
    if (!DUMMY) __syncthreads();
    if (jn < 0) break;
    j = jn;
    j1 = j2;
    k0 = k2; k1 = k3; v0 = v2; v1 = v3;
    buf ^= 1;
  }
}

struct MaskC {
      static constexpr bool HASBIT = false;
      int t0_, t1_, tmin_;
      DEVI bool full(int jt) const { return 16 * (jt * 64 + 63) + 31 <= tmin_; }
      DEVI bool bit(int nt, int jt) const { return true; }
      DEVI bool elem(int key, int nt, int jt) const { return 16 * (jt * 64 + key) + 31 <= (nt ? t1_ : t0_); }
};

struct MaskS {
      static constexpr bool HASBIT = true;
      unsigned long long a_lo, a_hi, b_lo, b_hi; int t0_, t1_, cur_;
      DEVI bool full(int jt) const { return jt < cur_; }
      DEVI bool bit(int nt, int jt) const {
        const unsigned long long lo = nt ? b_lo : a_lo, hi = nt ? b_hi : a_hi;
        const unsigned long long wd = (jt < 64) ? (lo >> jt) : (hi >> (jt - 64));
        return (wd & 1ull) != 0ull;
      }
      DEVI bool elem(int key, int nt, int jt) const { return jt * 64 + key <= (nt ? t1_ : t0_); }
};

struct MaskW {
      static constexpr bool HASBIT = false;
      int t0_, t1_, tmin_, tmax_;
      DEVI bool full(int jt) const { return (jt * 64 + 63 <= tmin_) && (tmax_ - jt * 64 < 512); }
      DEVI bool bit(int nt, int jt) const { return true; }
      DEVI bool elem(int key, int nt, int jt) const { const int s_ = jt * 64 + key, t_ = nt ? t1_ : t0_; return (s_ <= t_) && (t_ - s_ < 512); }
};

DEVI void nsa_tile(const Params& p, int tileidx, unsigned char* smem) {
  const int tid = opaque_tid(), lane = tid & 63, w = tid >> 6, r = lane & 15, q = lane >> 4;
  const int bg = tileidx & 3, tt = tileidx >> 2, b = bg >> 1, g = bg & 1, t0 = tt * 32;
  unsigned char* ws = p.ws;
  NsaSm sm;
  sm.sK = (bf16_t*)smem; sm.sV = (bf16_t*)(smem + 18432);
  sm.sImpA = (float*)(smem + 36864); sm.sImpB = (float*)(smem + 53248);
  sm.sSel = (unsigned*)(smem + 69632); sm.sGrp = sm.sSel + 128; sm.sUn = sm.sGrp + 32;
  const int tokbase = 8 * w;
  bf16x8 qf[2][2];
  {
    const bf16_t* qn = (const bf16_t*)(ws + L0_QN) + ((long)bg * 8192 + t0) * 256 + (32 * w + r) * 64 + q * 8;
    qf[0][0] = *(const bf16x8*)(qn); qf[0][1] = *(const bf16x8*)(qn + 32);
    qf[1][0] = *(const bf16x8*)(qn + 16 * 64); qf[1][1] = *(const bf16x8*)(qn + 16 * 64 + 32);
  }
  int tq[2];
  const float* GT = (const float*)(ws + L0_GATES);
#pragma unroll
  for (int nt = 0; nt < 2; ++nt) tq[nt] = t0 + tokbase + nt * 4 + (r >> 2);
#define GATE(nt, k) (GT[((long)b * 8192 + tq[nt]) * 24 + (g * 4 + (r & 3)) * 3 + (k)])
  f32x4 O[4][2];
  f32x4* sOut = (f32x4*)(smem + 36864) + (w * 8) * 64 + lane;
  const int cur = t0 >> 6;
  float mrow[2], lrow[2], invl[2];
  for (int i = tid; i < 32 * 128; i += 256) { sm.sImpA[i] = 0.f; sm.sImpB[i] = 0.f; }
  __syncthreads();
  {
    const int nvmax = (t0 + 31 >= 31) ? (((t0 + 31 - 31) >> 4) + 1) : 0;
    int nkt = (nvmax + 63) >> 6;
    if (nkt > 8) nkt = 8;
    const unsigned long long cm0 = (1ull << nkt) - 1ull;
    const bf16_t* KCMP = (const bf16_t*)(ws + L0_KCMP) + (long)bg * 512 * 64;
    const bf16_t* VCMPT = (const bf16_t*)(ws + L0_VCMPT) + (long)bg * 64 * 512;
    MaskC mk{tq[0], tq[1], t0 + tokbase};
    auto act = [&](int nt, int jt) { return true; };
    mrow[0] = mrow[1] = NEGS; lrow[0] = lrow[1] = 0.f; invl[0] = invl[1] = 0.f;
    nsa_branch<1>(sm, cm0, 0ull, KCMP, VCMPT, 64, 512, qf, O, mrow, lrow, invl, mk, act, tokbase, tid);
#pragma unroll
    for (int nt = 0; nt < 2; ++nt) {
      float l = lrow[nt];
      l += __shfl_xor(l, 16); l += __shfl_xor(l, 32);
      invl[nt] = (l > 0.f) ? 1.f / l : 0.f;
    }
#pragma unroll
    for (int dt = 0; dt < 4; ++dt) { O[dt][0] = f32x4{0.f, 0.f, 0.f, 0.f}; O[dt][1] = f32x4{0.f, 0.f, 0.f, 0.f}; }
    nsa_branch<2>(sm, cm0, 0ull, KCMP, VCMPT, 64, 512, qf, O, mrow, lrow, invl, mk, act, tokbase, tid);
  }
  __syncthreads();
  {
    const int ncand = (cur - 2 > 0) ? cur - 2 : 0;
    const int nf = (cur >= 2) ? 3 : cur + 1;
    const int kk = 16 - nf;
    const int m0i = lane, m1i = lane + 64;
    const bool c0 = (m0i >= 1 && m0i <= cur - 2), c1 = (m1i <= cur - 2);
    for (int tqi = 0; tqi < 8; ++tqi) {
      const int tok = tokbase + tqi;
      bool s0, s1;
      if (ncand <= kk) { s0 = c0; s1 = c1; }
      else {
        const float f0 = sm.sImpA[tok * 128 + m0i] + sm.sImpB[tok * 128 + m0i];
        const float f1 = sm.sImpA[tok * 128 + m1i] + sm.sImpB[tok * 128 + m1i];
        const unsigned k0 = c0 ? (__float_as_uint(f0) + 1u) : 0u;
        const unsigned k1 = c1 ? (__float_as_uint(f1) + 1u) : 0u;
        unsigned prefix = 0u;
        for (int bit = 31; bit >= 0; --bit) {
          const unsigned cand = prefix | (1u << bit);
          const int cnt = __popcll(__ballot(k0 >= cand)) + __popcll(__ballot(k1 >= cand));
          if (cnt >= kk) prefix = cand;
        }
        const bool g0 = k0 > prefix, g1 = k1 > prefix;
        const int ng = __popcll(__ballot(g0)) + __popcll(__ballot(g1));
        const bool e0 = (k0 == prefix), e1 = (k1 == prefix);
        const unsigned long long be0 = __ballot(e0), be1 = __ballot(e1);
        const unsigned long long lm = (1ull << lane) - 1ull;
        const int re0 = __popcll(be0 & lm), re1 = __popcll(be0) + __popcll(be1 & lm);
        const int need = kk - ng;
        s0 = g0 || (e0 && re0 < need);
        s1 = g1 || (e1 && re1 < need);
      }
      s0 = s0 || (m0i == 0) || (m0i == cur) || (m0i == cur - 1);
      s1 = s1 || (m1i == cur) || (m1i == cur - 1);
      const unsigned long long lo = __ballot(s0), hi = __ballot(s1);
      if (lane == 0) {
        sm.sSel[tok * 4 + 0] = (unsigned)lo; sm.sSel[tok * 4 + 1] = (unsigned)(lo >> 32);
        sm.sSel[tok * 4 + 2] = (unsigned)hi; sm.sSel[tok * 4 + 3] = (unsigned)(hi >> 32);
      }
    }
  }
  __syncthreads();
  if (tid < 32) { int gi = tid >> 2, wd = tid & 3; unsigned u = 0; for (int k = 0; k < 4; ++k) u |= sm.sSel[(gi * 4 + k) * 4 + wd]; sm.sGrp[tid] = u; }
  __syncthreads();
  if (tid < 4) { unsigned u = 0; for (int gi = 0; gi < 8; ++gi) u |= sm.sGrp[gi * 4 + tid]; sm.sUn[tid] = u; }
  __syncthreads();
#pragma unroll
  for (int nt = 0; nt < 2; ++nt)
#pragma unroll
    for (int dt = 0; dt < 4; ++dt) sOut[(nt * 4 + dt) * 64] = O[dt][nt] * GATE(nt, 0);
  {
    const bf16_t* KS = (const bf16_t*)(ws + L0_KS) + (long)bg * 8192 * 64;
    const bf16_t* VST = (const bf16_t*)(ws + L0_VST) + (long)bg * 128 * 4096;
    const unsigned long long ulo = (unsigned long long)sm.sUn[0] | ((unsigned long long)sm.sUn[1] << 32);
    const unsigned long long uhi = (unsigned long long)sm.sUn[2] | ((unsigned long long)sm.sUn[3] << 32);
    const int tk0 = tokbase + (r >> 2), tk1 = tokbase + 4 + (r >> 2);
    MaskS mk{(unsigned long long)sm.sSel[tk0 * 4 + 0] | ((unsigned long long)sm.sSel[tk0 * 4 + 1] << 32),
             (unsigned long long)sm.sSel[tk0 * 4 + 2] | ((unsigned long long)sm.sSel[tk0 * 4 + 3] << 32),
             (unsigned long long)sm.sSel[tk1 * 4 + 0] | ((unsigned long long)sm.sSel[tk1 * 4 + 1] << 32),
             (unsigned long long)sm.sSel[tk1 * 4 + 2] | ((unsigned long long)sm.sSel[tk1 * 4 + 3] << 32), tq[0], tq[1], cur};
    unsigned long long g0lo, g0hi, g1lo, g1hi;
    {
      const unsigned* gp = sm.sGrp + (2 * w) * 4;
      g0lo = (unsigned long long)__builtin_amdgcn_readfirstlane(gp[0]) | ((unsigned long long)__builtin_amdgcn_readfirstlane(gp[1]) << 32);
      g0hi = (unsigned long long)__builtin_amdgcn_readfirstlane(gp[2]) | ((unsigned long long)__builtin_amdgcn_readfirstlane(gp[3]) << 32);
      g1lo = (unsigned long long)__builtin_amdgcn_readfirstlane(gp[4]) | ((unsigned long long)__builtin_amdgcn_readfirstlane(gp[5]) << 32);
      g1hi = (unsigned long long)__builtin_amdgcn_readfirstlane(gp[6]) | ((unsigned long long)__builtin_amdgcn_readfirstlane(gp[7]) << 32);
    }
    auto act = [&](int nt, int jt) {
      const unsigned long long lo = nt ? g1lo : g0lo, hi = nt ? g1hi : g0hi;
      const unsigned long long wd = (jt < 64) ? (lo >> jt) : (hi >> (jt - 64));
      return (wd & 1ull) != 0ull;
    };
    mrow[0] = mrow[1] = NEGS; lrow[0] = lrow[1] = 0.f;
#pragma unroll
    for (int dt = 0; dt < 4; ++dt) { O[dt][0] = f32x4{0.f, 0.f, 0.f, 0.f}; O[dt][1] = f32x4{0.f, 0.f, 0.f, 0.f}; }
#ifdef NSA_DUMMY_SEL
    {
      nsa_branch<0, true>(sm, ulo, uhi, KS, VST, 4096, 64, qf, O, mrow, lrow, invl, mk, act, tokbase, tid);
      float chk = lrow[0] + lrow[1];
#pragma unroll
      for (int dt = 0; dt < 4; ++dt) chk += O[dt][0][0] + O[dt][0][1] + O[dt][0][2] + O[dt][0][3] + O[dt][1][0] + O[dt][1][1] + O[dt][1][2] + O[dt][1][3];
      if (chk == 123.456f) sm.sUn[0] = 1u;
      mrow[0] = mrow[1] = NEGS; lrow[0] = lrow[1] = 0.f;
#pragma unroll
      for (int dt = 0; dt < 4; ++dt) { O[dt][0] = f32x4{0.f, 0.f, 0.f, 0.f}; O[dt][1] = f32x4{0.f, 0.f, 0.f, 0.f}; }
      __syncthreads();
    }
#endif
    nsa_branch<0>(sm, ulo, uhi, KS, VST, 4096, 64, qf, O, mrow, lrow, invl, mk, act, tokbase, tid);
#pragma unroll
    for (int nt = 0; nt < 2; ++nt) {
      float l = lrow[nt];
      l += __shfl_xor(l, 16); l += __shfl_xor(l, 32);
      const float f = GATE(nt, 1) * ((l > 0.f) ? 1.f / l : 0.f);
#pragma unroll
      for (int dt = 0; dt < 4; ++dt) sOut[(nt * 4 + dt) * 64] += O[dt][nt] * f;
    }
  }
  {
    const bf16_t* KW = (const bf16_t*)(ws + L0_KW) + (long)bg * 8192 * 64;
    const bf16_t* VWT = (const bf16_t*)(ws + L0_VWT) + (long)bg * 128 * 4096;
    const int jlo = ((t0 - 511 > 0) ? (t0 - 511) : 0) >> 6;
    unsigned long long wlo = 0ull, whi = 0ull;
    for (int jj = jlo; jj <= cur; ++jj) { if (jj < 64) wlo |= (1ull << jj); else whi |= (1ull << (jj - 64)); }
    MaskW mk{tq[0], tq[1], t0 + tokbase, t0 + tokbase + 7};
    auto act = [&](int nt, int jt) { return true; };
    mrow[0] = mrow[1] = NEGS; lrow[0] = lrow[1] = 0.f;
#pragma unroll
    for (int dt = 0; dt < 4; ++dt) { O[dt][0] = f32x4{0.f, 0.f, 0.f, 0.f}; O[dt][1] = f32x4{0.f, 0.f, 0.f, 0.f}; }
    nsa_branch<0>(sm, wlo, whi, KW, VWT, 4096, 64, qf, O, mrow, lrow, invl, mk, act, tokbase, tid);
#pragma unroll
    for (int nt = 0; nt < 2; ++nt) {
      float l = lrow[nt];
      l += __shfl_xor(l, 16); l += __shfl_xor(l, 32);
      const float f = GATE(nt, 2) * ((l > 0.f) ? 1.f / l : 0.f);
#pragma unroll
      for (int dt = 0; dt < 4; ++dt) O[dt][nt] = sOut[(nt * 4 + dt) * 64] + O[dt][nt] * f;
    }
  }
  const bf16_t* NZ = (const bf16_t*)(ws + L0_NZ);
  bf16_t* Y = (bf16_t*)(ws + L0_QKRAW);
  uint2 zzv[2][4];
#pragma unroll
  for (int nt = 0; nt < 2; ++nt)
#pragma unroll
    for (int dt = 0; dt < 4; ++dt)
      zzv[nt][dt] = *(const uint2*)(NZ + ((long)b * 8192 + tq[nt]) * 512 + (g * 4 + (r & 3)) * 64 + dt * 16 + q * 4);
#pragma unroll
  for (int nt = 0; nt < 2; ++nt) {
    const long tok = (long)b * 8192 + tq[nt];
    const int head = g * 4 + (r & 3);
#pragma unroll
    for (int dt = 0; dt < 4; ++dt) {
      const int d = dt * 16 + q * 4;
      const uint2 zz = zzv[nt][dt];
      uint2 o;
      o.x = pack2(O[dt][nt][0] * lo2f(zz.x), O[dt][nt][1] * hi2f(zz.x));
      o.y = pack2(O[dt][nt][2] * lo2f(zz.y), O[dt][nt][3] * hi2f(zz.y));
      *(uint2*)(Y + tok * 1024 + 512 + head * 64 + d) = o;
    }
  }
  __syncthreads();
}

DEVI void hgrn_local(const Params& p, int unit, unsigned char* smem) {
  const int tid = opaque_tid(), lane = tid & 63, w = tid >> 6, wr = w >> 1, wc = w & 1;
  const int bh = unit >> 7, c = unit & 127, b = bh >> 3, h = bh & 7, t0 = c * 64;
  const long R0 = (long)b * 8192 + t0;
  unsigned char* ws = p.ws;
  bf16_t* sA = (bf16_t*)smem;
  bf16_t* sB = (bf16_t*)(smem + 18432);
  float* psum = (float*)(smem + 36864);
  const int cch = tid & 127, half = tid >> 7;
  const float lb = ((const float*)(ws + OFF_LB))[h * 128 + cch];
  const bf16_t* FP = (const bf16_t*)(ws + L1_FP) + R0 * 1024 + h * 128 + cch;
  float sgv[32], lgv[32];
  {
    const bf16_t* vtp = (const bf16_t*)(ws + L1_VT) + (((long)(b * 8 + h) * 128 + c) * 128) * 64 + (tid >> 3) * 64 + (tid & 7) * 8;
    u32x4 t0_ = *(const u32x4*)vtp, t1_ = *(const u32x4*)(vtp + 32 * 64), t2_ = *(const u32x4*)(vtp + 64 * 64), t3_ = *(const u32x4*)(vtp + 96 * 64);
    bf16_t fpr[32];
#pragma unroll
    for (int k = 0; k < 32; ++k) fpr[k] = FP[(long)(half * 32 + k) * 1024];
    {
      bf16_t* sp = sA + (tid >> 3) * LDT + (tid & 7) * 8;
      *(u32x4*)sp = t0_; *(u32x4*)(sp + 32 * LDT) = t1_; *(u32x4*)(sp + 64 * LDT) = t2_; *(u32x4*)(sp + 96 * LDT) = t3_;
    }
#pragma unroll
    for (int k = 0; k < 32; ++k) { sgv[k] = sigm(bf2f(fpr[k])); lgv[k] = __logf(lb + (1.f - lb) * sgv[k]); }
  }
  float sum = 0.f;
#pragma unroll
  for (int k = 0; k < 32; ++k) sum += lgv[k];
  psum[half * 128 + cch] = sum;
  __syncthreads();
  const float bL = psum[cch] + psum[128 + cch];
  float run = half ? psum[cch] : 0.f;
#pragma unroll
  for (int k = 0; k < 32; ++k) {
    run += lgv[k];
    float kk_ = (1.f - lb) * (1.f - sgv[k]);
    sB[cch * LDT + half * 32 + k] = f2bf(kk_ * __expf(bL - run));
  }
  if (half == 0) ((float*)(ws + L1_BL))[(long)unit * 128 + cch] = bL;
  __syncthreads();
  f32x4 acc[4][4];
#pragma unroll
  for (int mt = 0; mt < 4; ++mt)
#pragma unroll
    for (int nt = 0; nt < 4; ++nt) acc[mt][nt] = f32x4{0.f, 0.f, 0.f, 0.f};
  mma_lds_sw<4, 4, 2>(sA + wr * 64 * LDT, sB + wc * 64 * LDT, acc, lane);
#ifndef R9B
#define R9B 1
#endif
  for (int r9_ = 0; r9_ < R9B; ++r9_) {
  bf16_t* st = (bf16_t*)(ws + L1_ST) + (long)unit * 16384;
  const int r = lane & 15, q = lane >> 4;
#pragma unroll
  for (int mt = 0; mt < 4; ++mt) {
    const int v = wr * 64 + mt * 16 + r;
#pragma unroll
    for (int nt = 0; nt < 4; ++nt) {
      uint2 o;
      o.x = pack2(acc[mt][nt][0], acc[mt][nt][1]);
      o.y = pack2(acc[mt][nt][2], acc[mt][nt][3]);
      *(uint2*)(st + v * 128 + wc * 64 + nt * 16 + q * 4) = o;
    }
  }
  }
  __syncthreads();
}

template <bool DUMMY>
DEVI void hgrn_scan(const Params& p) {
  unsigned char* ws = p.ws;
  const float* BL = (const float*)(ws + L1_BL);
  for (int idx = blockIdx.x * 256 + opaque_tid(); idx < 16 * 8192; idx += gridDim.x * 256) {
    const int bh = idx >> 13, pr = idx & 8191;
    const int c2 = (pr & 63) * 2;
    unsigned* ptr = (unsigned*)(ws + L1_ST) + (long)bh * 128 * 8192 + pr;
    const float* blp = BL + (long)bh * 128 * 128 + c2;
    float s0 = 0.f, s1 = 0.f;
    for (int c0 = 0; c0 < 128; c0 += 8) {
      unsigned dv[8]; float2 bl[8];
#pragma unroll
      for (int k = 0; k < 8; ++k) { dv[k] = __builtin_nontemporal_load(ptr + (long)(c0 + k) * 8192); bl[k] = *(const float2*)(blp + (long)(c0 + k) * 128); }
#pragma unroll
      for (int k = 0; k < 8; ++k) {
        if (!DUMMY) ptr[(long)(c0 + k) * 8192] = pack2(s0, s1);
        s0 = __expf(bl[k].x) * s0 + lo2f(dv[k]);
        s1 = __expf(bl[k].y) * s1 + hi2f(dv[k]);
      }
    }
    if (DUMMY && s0 == 123.456f) ptr[0] = pack2(s0, s1);
  }
}

DEVI void hgrn_out(const Params& p, int unit, unsigned char* smem) {
  const int tid = opaque_tid(), lane = tid & 63, w = tid >> 6, wr = w >> 1, wc = w & 1;
  const int r = lane & 15, q = lane >> 4;
  const int bh = unit >> 7, c = unit & 127, b = bh >> 3, h = bh & 7, t0 = c * 64;
  const long R0 = (long)b * 8192 + t0;
  unsigned char* ws = p.ws;
  bf16_t* sQ0 = (bf16_t*)smem; bf16_t* sQ1 = (bf16_t*)(smem + 9216);
  bf16_t* sK0 = (bf16_t*)(smem + 18432); bf16_t* sK1 = (bf16_t*)(smem + 27648);
  bf16_t* sAm = (bf16_t*)(smem + 36864);
  bf16_t* sB = (bf16_t*)(smem + 46080);
  float* psum = (float*)(smem + 64512);
  float* sSs = psum + 256;
  const int cch = tid & 127, half = tid >> 7, cc = cch & 63;
  const float lb = ((const float*)(ws + OFF_LB))[h * 128 + cch];
  const bf16_t* FP = (const bf16_t*)(ws + L1_FP) + R0 * 1024 + h * 128 + cch;
  const bf16_t* Q1 = (const bf16_t*)(ws + L1_Q) + R0 * 1024 + h * 128 + cch;
  const bf16_t* vt = (const bf16_t*)(ws + L1_VT) + (((long)(b * 8 + h) * 128 + c) * 128) * 64;
  const bf16_t* st = (const bf16_t*)(ws + L1_ST) + (long)unit * 16384;
  const int tl_r = tid >> 3, tl_k = (tid & 7) * 8;
  u32x4 vv0, vv1, vv2, vv3, sa0, sa1, sa2, sa3, sb0, sb1, sb2, sb3;
  {
    const bf16_t* vp = vt + tl_r * 64 + tl_k;
    vv0 = *(const u32x4*)vp; vv1 = *(const u32x4*)(vp + 32 * 64); vv2 = *(const u32x4*)(vp + 64 * 64); vv3 = *(const u32x4*)(vp + 96 * 64);
    const bf16_t* sp = st + tl_r * 128 + tl_k;
    sa0 = *(const u32x4*)sp; sa1 = *(const u32x4*)(sp + 32 * 128); sa2 = *(const u32x4*)(sp + 64 * 128); sa3 = *(const u32x4*)(sp + 96 * 128);
    sb0 = *(const u32x4*)(sp + 64); sb1 = *(const u32x4*)(sp + 32 * 128 + 64); sb2 = *(const u32x4*)(sp + 64 * 128 + 64); sb3 = *(const u32x4*)(sp + 96 * 128 + 64);
  }
  float sgv[32], lgv[32];
  bf16_t qr[32];
  {
    bf16_t fpr[32];
#pragma unroll
    for (int k = 0; k < 32; ++k) { fpr[k] = FP[(long)(half * 32 + k) * 1024]; qr[k] = Q1[(long)(half * 32 + k) * 1024]; }
    { bf16_t* dp = sB + tl_r * LDT + tl_k; *(u32x4*)dp = vv0; *(u32x4*)(dp + 32 * LDT) = vv1; *(u32x4*)(dp + 64 * LDT) = vv2; *(u32x4*)(dp + 96 * LDT) = vv3; }
#pragma unroll
    for (int k = 0; k < 32; ++k) { sgv[k] = sigm(bf2f(fpr[k])); lgv[k] = __logf(lb + (1.f - lb) * sgv[k]); }
  }
  float sum = 0.f;
#pragma unroll
  for (int k = 0; k < 32; ++k) sum += lgv[k];
  psum[half * 128 + cch] = sum;
  __syncthreads();
  float run = half ? psum[cch] : 0.f;
  bf16_t* sQ = (cch < 64) ? sQ0 : sQ1;
  bf16_t* sK = (cch < 64) ? sK0 : sK1;
#pragma unroll
  for (int k = 0; k < 32; ++k) {
    const int s_ = half * 32 + k;
    run += lgv[k];
    float kk_ = (1.f - lb) * (1.f - sgv[k]);
    sQ[s_ * LDT + cc] = f2bf(bf2f(qr[k]) * __expf(run));
    sK[s_ * LDT + cc] = f2bf(kk_ * __expf(fminf(-run, 80.f)));
  }
  __syncthreads();
  {
    f32x4 a1[2][2];
#pragma unroll
    for (int mt = 0; mt < 2; ++mt)
#pragma unroll
      for (int nt = 0; nt < 2; ++nt) a1[mt][nt] = f32x4{0.f, 0.f, 0.f, 0.f};
    if (!(wr == 0 && wc == 1)) {
      mma_lds<2, 2, 2>(sQ0 + wr * 32 * LDT, sK0 + wc * 32 * LDT, a1, lane);
      mma_lds<2, 2, 2>(sQ1 + wr * 32 * LDT, sK1 + wc * 32 * LDT, a1, lane);
    }
#pragma unroll
    for (int mt = 0; mt < 2; ++mt)
#pragma unroll
      for (int i = 0; i < 4; ++i) {
        int j = wr * 32 + mt * 16 + q * 4 + i;
#pragma unroll
        for (int nt = 0; nt < 2; ++nt) {
          int s = wc * 32 + nt * 16 + r;
          sAm[j * LDT + s] = f2bf((s <= j) ? a1[mt][nt][i] : 0.f);
        }
      }
  }
  __syncthreads();
  f32x4 o[2][4];
#pragma unroll
  for (int mt = 0; mt < 2; ++mt)
#pragma unroll
    for (int nt = 0; nt < 4; ++nt) o[mt][nt] = f32x4{0.f, 0.f, 0.f, 0.f};
  mma_lds<2, 4, 2>(sAm + wr * 32 * LDT, sB + wc * 64 * LDT, o, lane);
  __syncthreads();
  { bf16_t* dp = sB + tl_r * LDT + tl_k; *(u32x4*)dp = sa0; *(u32x4*)(dp + 32 * LDT) = sa1; *(u32x4*)(dp + 64 * LDT) = sa2; *(u32x4*)(dp + 96 * LDT) = sa3; }
  __syncthreads();
  mma_lds<2, 4, 2>(sQ0 + wr * 32 * LDT, sB + wc * 64 * LDT, o, lane);
  __syncthreads();
  { bf16_t* dp = sB + tl_r * LDT + tl_k; *(u32x4*)dp = sb0; *(u32x4*)(dp + 32 * LDT) = sb1; *(u32x4*)(dp + 64 * LDT) = sb2; *(u32x4*)(dp + 96 * LDT) = sb3; }
  __syncthreads();
  mma_lds<2, 4, 2>(sQ1 + wr * 32 * LDT, sB + wc * 64 * LDT, o, lane);
#pragma unroll
  for (int mt = 0; mt < 2; ++mt)
#pragma unroll
    for (int i = 0; i < 4; ++i) {
      int j = wr * 32 + mt * 16 + q * 4 + i;
      float ss = 0.f;
#pragma unroll
      for (int nt = 0; nt < 4; ++nt) ss += o[mt][nt][i] * o[mt][nt][i];
      ss = grp16_sum(ss);
      if (r == 0) sSs[wc * 64 + j] = ss;
    }
  __syncthreads();
  const bf16_t* Z1 = (const bf16_t*)(ws + L1_Z);
  bf16_t* Y1 = (bf16_t*)(ws + L1_H);
  float hn[4];
#pragma unroll
  for (int nt = 0; nt < 4; ++nt) hn[nt] = p.h_hn[h * 128 + wc * 64 + nt * 16 + r];
#pragma unroll
  for (int mt = 0; mt < 2; ++mt) {
    float zv[4][4];
#pragma unroll
    for (int i = 0; i < 4; ++i) {
      long row = R0 + wr * 32 + mt * 16 + q * 4 + i;
#pragma unroll
      for (int nt = 0; nt < 4; ++nt) zv[i][nt] = bf2f(Z1[row * 1024 + h * 128 + wc * 64 + nt * 16 + r]);
    }
#pragma unroll
    for (int i = 0; i < 4; ++i) {
      int j = wr * 32 + mt * 16 + q * 4 + i;
      float rinv = rsqrtf((sSs[j] + sSs[64 + j]) * (1.f / 128.f) + EPSF);
      long row = R0 + j;
#pragma unroll
      for (int nt = 0; nt < 4; ++nt) {
        int col = h * 128 + wc * 64 + nt * 16 + r;
        Y1[row * 1024 + col] = f2bf(o[mt][nt][i] * rinv * hn[nt] * zv[i][nt]);
      }
    }
  }
  __syncthreads();
}

#define XB_TMO      128
#define XB_XCNT(j)  (256  + 64 * (j))
#define XB_XSUB(j)  (1280 + 64 * (j))
#define XB_XGEN(j)  (2304 + 64 * (j))
#define XB_TOP      3328
#define XB_TOPGEN   3392
#define XCD_BAR_WORDS 3456
#define XB_SPIN_CAP (1u << 22)
DEVI unsigned xb_ld(unsigned* p) { return __hip_atomic_load(p, __ATOMIC_RELAXED, __HIP_MEMORY_SCOPE_AGENT); }
DEVI unsigned xb_add(unsigned* p, unsigned v) { return __hip_atomic_fetch_add(p, v, __ATOMIC_RELAXED, __HIP_MEMORY_SCOPE_AGENT); }
DEVI unsigned xb_xcc_id() { return (unsigned)__builtin_amdgcn_s_getreg((3 << 11) | 20) & 0xFu; }
#define XB_SPIN(cond, bar) do { unsigned _sp = 0; while (cond) { __builtin_amdgcn_s_sleep(1); \
    if ((++_sp & 255u) == 0u) { if (xb_ld(&(bar)[XB_TMO])) break; if (_sp > XB_SPIN_CAP) { atomicAdd(&(bar)[XB_TMO], 1u); break; } } } } while (0)

DEVI void xcd_barrier_complete(unsigned* bar, unsigned x, unsigned& nloc, unsigned& nx) {
  const unsigned G = gridDim.x;
  unsigned sum, cnt, mine, sp = 0u;
  for (;;) {
    sum = 0u; cnt = 0u; mine = 0u;
#pragma unroll
    for (unsigned j = 0; j < 16; ++j) { const unsigned c = xb_ld(&bar[XB_XCNT(j)]); sum += c; cnt += (c > 0u) ? 1u : 0u; mine = (j == x) ? c : mine; }
    if (sum == G) break;
    __builtin_amdgcn_s_sleep(1);
    if ((++sp & 255u) == 0u) { if (xb_ld(&bar[XB_TMO])) break; if (sp > XB_SPIN_CAP) { atomicAdd(&bar[XB_TMO], 1u); break; } }
  }
  nloc = mine > 0u ? mine : 1u; nx = cnt > 0u ? cnt : 1u;
}

DEVI void grid_barrier(unsigned* bar, unsigned xcc, volatile unsigned* st) {
  asm volatile("s_waitcnt vmcnt(0)" ::: "memory");
  __syncthreads();
  if (threadIdx.x == 0) {
    __builtin_amdgcn_s_waitcnt(0);
    unsigned nloc = st[0], nx = st[1];
    if (nloc == 0u) { xcd_barrier_complete(bar, xcc, nloc, nx); st[0] = nloc; st[1] = nx; }
    const unsigned old = xb_add(&bar[XB_XSUB(xcc)], 1u);
    const unsigned gen = old / nloc;
    if (old + 1u == (gen + 1u) * nloc) {
      __builtin_amdgcn_fence(__ATOMIC_RELEASE, "agent");
      asm volatile("s_waitcnt vmcnt(0)" ::: "memory");
      const unsigned og = xb_add(&bar[XB_TOP], 1u);
      const unsigned tg = og / nx;
      if (og + 1u == (tg + 1u) * nx) xb_add(&bar[XB_TOPGEN], 1u);
      else XB_SPIN(xb_ld(&bar[XB_TOPGEN]) == tg, bar);
      __builtin_amdgcn_fence(__ATOMIC_ACQUIRE, "agent");
      xb_add(&bar[XB_XGEN(xcc)], 1u);
      asm volatile("s_waitcnt vmcnt(0)" ::: "memory");
    } else {
      XB_SPIN(xb_ld(&bar[XB_XGEN(xcc)]) == gen, bar);
      __builtin_amdgcn_fence(__ATOMIC_ACQUIRE, "agent");
      asm volatile("s_waitcnt vmcnt(0)" ::: "memory");
    }
  }
  __syncthreads();
}

#ifndef REP_NSA
#define REP_NSA 1
#endif
#ifndef REP_P0
#define REP_P0 1
#endif
#ifndef REP_P1
#define REP_P1 1
#endif
#ifndef REP_P2
#define REP_P2 1
#endif
#ifndef REP_P3
#define REP_P3 1
#endif
#ifndef REP_P4
#define REP_P4 1
#endif
#ifndef REP_P5
#define REP_P5 1
#endif
#ifndef REP_P6
#define REP_P6 1
#endif
#ifndef REP_P7
#define REP_P7 1
#endif
#ifndef REP_P8
#define REP_P8 1
#endif
#ifndef REP_P9
#define REP_P9 1
#endif
#ifndef REP_P10
#define REP_P10 1
#endif
#ifndef REP_P11
#define REP_P11 1
#endif
#ifndef REP_P12
#define REP_P12 1
#endif
#ifndef DBG_STOP
#define DBG_STOP 99
#endif
DEVI void dbg_probe_bf16(const Params& p, size_t off, long n) {
  const bf16_t* b = (const bf16_t*)(p.ws + off);
  for (long i = (long)blockIdx.x * 256 + threadIdx.x; i < 16384L * 1024; i += (long)gridDim.x * 256) {
    float v = bf2f(b[i % n]);
    if (!(v == v) || fabsf(v) > 1e30f) v = 777.f;
    p.out[i] = v;
  }
}
DEVI void dbg_probe_f32(const Params& p, size_t off, long n) {
  const float* b = (const float*)(p.ws + off);
  for (long i = (long)blockIdx.x * 256 + threadIdx.x; i < 16384L * 1024; i += (long)gridDim.x * 256) {
    float v = b[i % n];
    if (!(v == v) || fabsf(v) > 1e30f) v = 777.f;
    p.out[i] = v;
  }
}
DEVI void dbg_probe_combo(const Params& p) {
  const bf16_t* qn = (const bf16_t*)(p.ws + L0_QN);
  const bf16_t* ks = (const bf16_t*)(p.ws + L0_KS);
  const bf16_t* nz = (const bf16_t*)(p.ws + L0_NZ);
  const float* ig = (const float*)(p.ws + L0_IG);
  for (long i = (long)blockIdx.x * 256 + threadIdx.x; i < 16384L * 1024; i += (long)gridDim.x * 256) {
    float v = bf2f(qn[i % (16384L * 512)]) + bf2f(ks[i % (4L * 8192 * 64 * 4)]) + bf2f(nz[i % (16384L * 512)]) + ig[i % (16384L * 32)];
    if (!(v == v) || fabsf(v) > 1e30f) v = 777.f;
    p.out[i] = v;
  }
}
#define DBG_AT(k, stmt) if (DBG_STOP == k) { stmt; return; }

#define GSYNC() grid_barrier(bar_ctr, bar_xcc, bar_st)

__global__ void __launch_bounds__(256, 2) mega(Params p) {
  __shared__ __attribute__((aligned(16))) unsigned char smem[79872];
  cg::grid_group grid = cg::this_grid();
  const int G = gridDim.x, bid = blockIdx.x, tid = threadIdx.x, lane = tid & 63, w = tid >> 6;
  unsigned char* ws = p.ws;
  bf16_t* sA = (bf16_t*)smem;
  bf16_t* sB = (bf16_t*)(smem + 16384);
  unsigned* bar_ctr = (unsigned*)(ws + OFF_BAR);
  __shared__ uint4 xb_words;
  if (tid == 0) xb_words = make_uint4(0u, 0u, 0u, 0u);
  __syncthreads();
  volatile unsigned* bar_st = (volatile unsigned*)&xb_words;
  const unsigned bar_xcc = xb_xcc_id();
  if (tid == 0) (void)xb_add(&bar_ctr[XB_XCNT(bar_xcc)], 1u);
  if (p.ws == nullptr) grid.sync();

#ifdef EXTRA_SYNCS
  for (int e_ = 0; e_ < EXTRA_SYNCS; ++e_) GSYNC();
#endif
  for (int rep_ = 0; rep_ < REP_P0; ++rep_) {
  phase0(p, smem);
  GSYNC();
  }
  DBG_AT(0, dbg_probe_bf16(p, L0_H, 16384L*1024))
  for (int rep_ = 0; rep_ < REP_P1; ++rep_) {
#ifdef USE_G256
  for (int k_ = 0; k_ * (G >> 3) < 8 * 32; ++k_) {
    int tm, tn;
    if (!gemm_tile_xcd256(bid, G, k_, 32, tm, tn)) continue;
    gemm256((const bf16_t*)(ws + L0_H), 1024, (const bf16_t*)(ws + OFF_WIN0), 1024, 1024, tm * 256, tn * 128, sA, (bf16_t*)(smem + 32768),
            [&](f32x4 (&acc)[4][4], int mb, int nb, int ln) { epi_proj0(p, acc, mb, nb, ln); });
  }
  for (int v_ = (bid >> 3); v_ < 48; v_ += (G >> 3)) {
    const int tm = (bid & 7) * 16 + v_ / 3, tn = 32 + v_ % 3;
    gemm128<false>((const bf16_t*)(ws + L0_H), 1024, 16383, (const bf16_t*)(ws + OFF_WIN0), 1024, 4383, 1024, tm * 128, tn * 128, sA, sB,
            [&](f32x4 (&acc)[4][4], int mb, int nb, int ln) { epi_proj0(p, acc, mb, nb, ln); });
  }
#else
  for (int k_ = 0; k_ * (G >> 3) < 16 * 35; ++k_) {
    int tm, tn;
    if (!gemm_tile_xcd(bid, G, k_, 35, tm, tn)) continue;
    gemm128<false>((const bf16_t*)(ws + L0_H), 1024, 16383, (const bf16_t*)(ws + OFF_WIN0), 1024, 4383, 1024, tm * 128, tn * 128, sA, sB,
            [&](f32x4 (&acc)[4][4], int mb, int nb, int ln) { epi_proj0(p, acc, mb, nb, ln); });
  }
#endif
  GSYNC();
  }
  DBG_AT(1, dbg_probe_bf16(p, L0_QKRAW, 16384L*1024)) DBG_AT(101, dbg_probe_combo(p)) DBG_AT(102, dbg_probe_bf16(p, L0_KS, 4L*8192*64*4)) DBG_AT(103, dbg_probe_f32(p, L0_IG, 16384L*4*2+16384L*24)) DBG_AT(104, dbg_probe_bf16(p, L0_MVT, 16384L*512*3))
  for (int rep_ = 0; rep_ < REP_P2; ++rep_) {
  for (int it = bid; it < 128 + 2048; it += G) {
    if (it < 128) {
      int ksp = it >> 5, kv = (it >> 4) & 1, bg = (it >> 2) & 3, tm = it & 3;
      const bf16_t* A = (const bf16_t*)(ws + (kv ? L0_VCRAW : L0_KCRAW)) + (long)bg * 8192 * 64 + ksp * 512;
      const bf16_t* B = (const bf16_t*)(ws + (kv ? OFF_WCV : OFF_WCK)) + ksp * 512;
      gemm128<false>(A, 1024, 510, B, 2048, 127, 512, tm * 128, 0, sA, sB,
              [&](f32x4 (&acc)[4][4], int mb, int nb, int ln) { epi_cmp_hidden(p, acc, mb, nb, ln, kv, bg, ksp); });
    } else {
      conv_tile(p, it - 128, smem);
    }
  }
  GSYNC();
  }
  DBG_AT(2, dbg_probe_bf16(p, L0_QC, 16384L*512*3)) DBG_AT(201, dbg_probe_f32(p, L0_HID, 2L*4*512*128))
  for (int rep_ = 0; rep_ < REP_P3; ++rep_) {
  for (int it = bid; it < 512 + 1024; it += G) {
    if (it < 512) mlstm_local(p, it, smem);
    else { const int t_ = opaque_tid(); cmp_finalize(p, (it - 512) * 4 + (t_ >> 6), t_ & 63); }
  }
  GSYNC();
  }
  DBG_AT(3, dbg_probe_f32(p, L0_H, 512L*16384)) DBG_AT(301, dbg_probe_bf16(p, L0_KCMP, 4L*512*64*2)) DBG_AT(302, dbg_probe_f32(p, L0_DN, 512L*128 + 2048))
  for (int rep_ = 0; rep_ < REP_P4; ++rep_) {
#ifdef DUMMY_P4
  mlstm_scan<true>(p, smem);
  GSYNC();
#endif
  mlstm_scan<false>(p, smem);
  GSYNC();
  }
  DBG_AT(4, dbg_probe_f32(p, L0_H, 512L*16384)) DBG_AT(401, dbg_probe_f32(p, L0_DN, 512L*128 + 3072))
  for (int rep_ = 0; rep_ < REP_P5; ++rep_) {
#ifdef USE_WQ
  {
    unsigned* wq = bar_ctr + 3600;
    volatile unsigned* slot = (volatile unsigned*)&xb_words;
    for (int s_ = 0; s_ < 5; ++s_) {
      const int qi = (s_ < 4) ? (int)((bar_xcc + (unsigned)s_) & 3u) : 4;
      const int qn_ = (s_ < 4) ? 256 : 1024;
      for (;;) {
        if (tid == 0) slot[3] = xb_add(&wq[qi * 64], 1u);
        __syncthreads();
        const int it = (int)slot[3];
        __syncthreads();
        if (it >= qn_) break;
        if (s_ < 4) nsa_tile(p, (255 - it) * 4 + qi, smem);
        else mlstm_out(p, it, smem);
      }
    }
  }
#else
  for (int it = bid; it < 1024 + 1024; it += G) {
    if (it < 1024) {
      int k = it >> 9, i = it & 511;
      int idx = (k & 1) ? (k * 512 + 511 - i) : it;
#ifndef DBG_SKIP_NSA
      for (int r2_ = 0; r2_ < REP_NSA; ++r2_) nsa_tile(p, idx, smem);
#endif
    } else {
#ifndef DBG_SKIP_MOUT
      mlstm_out(p, it - 1024, smem);
#endif
    }
  }
#endif
  GSYNC();
  }
  DBG_AT(5, dbg_probe_bf16(p, L0_QKRAW, 16384L*1024))
  for (int rep_ = 0; rep_ < REP_P6; ++rep_) {
#ifdef USE_G256
  for (int k_ = 0; k_ * (G >> 3) < 8 * 8; ++k_) {
    int tm, tn;
    if (!gemm_tile_xcd256(bid, G, k_, 8, tm, tn)) continue;
    gemm256((const bf16_t*)(ws + L0_QKRAW), 1024, (const bf16_t*)(ws + OFF_WOUT0), 1024, 1024, tm * 256, tn * 128, sA, (bf16_t*)(smem + 32768),
            [&](f32x4 (&acc)[4][4], int mb, int nb, int ln) { epi_out_resid(p.x, p.out, acc, mb, nb, ln); });
  }
#else
  for (int k_ = 0; k_ * (G >> 3) < 16 * 8; ++k_) {
    int tm, tn;
    if (!gemm_tile_xcd(bid, G, k_, 8, tm, tn)) continue;
    gemm128<false>((const bf16_t*)(ws + L0_QKRAW), 1024, 16383, (const bf16_t*)(ws + OFF_WOUT0), 1024, 1023, 1024, tm * 128, tn * 128, sA, sB,
            [&](f32x4 (&acc)[4][4], int mb, int nb, int ln) { epi_out_resid(p.x, p.out, acc, mb, nb, ln); });
  }
#endif
  GSYNC();
  }
  DBG_AT(6, (void)0)
  for (int rep_ = 0; rep_ < REP_P7; ++rep_) {
  { const int t_ = opaque_tid(); for (int row = (bid * 4 + (t_ >> 6)) * 2; row < 16384; row += G * 8) rmsnorm_row2(p.out, p.norm_w + 1024, (bf16_t*)(ws + L1_H), row, row + 1, t_ & 63); }
  GSYNC();
  }
  DBG_AT(7, dbg_probe_bf16(p, L1_H, 16384L*1024))
  for (int rep_ = 0; rep_ < REP_P8; ++rep_) {
#ifdef USE_G256
  for (int k_ = 0; k_ * (G >> 3) < 8 * 32; ++k_) {
    int tm, tn;
    if (!gemm_tile_xcd256(bid, G, k_, 32, tm, tn)) continue;
    gemm256((const bf16_t*)(ws + L1_H), 1024, (const bf16_t*)(ws + OFF_WIN1), 1024, 1024, tm * 256, tn * 128, sA, (bf16_t*)(smem + 32768),
            [&](f32x4 (&acc)[4][4], int mb, int nb, int ln) { epi_proj1(p, acc, mb, nb, ln); });
  }
#else
  for (int k_ = 0; k_ * (G >> 3) < 16 * 32; ++k_) {
    int tm, tn;
    if (!gemm_tile_xcd(bid, G, k_, 32, tm, tn)) continue;
    gemm128<false>((const bf16_t*)(ws + L1_H), 1024, 16383, (const bf16_t*)(ws + OFF_WIN1), 1024, 4095, 1024, tm * 128, tn * 128, sA, sB,
            [&](f32x4 (&acc)[4][4], int mb, int nb, int ln) { epi_proj1(p, acc, mb, nb, ln); });
  }
#endif
  GSYNC();
  }
  DBG_AT(8, dbg_probe_bf16(p, L1_FP, 16384L*1024*4))
  for (int rep_ = 0; rep_ < REP_P9; ++rep_) {
  for (int it = bid; it < 2048; it += G) hgrn_local(p, it, smem);
  GSYNC();
  }
  DBG_AT(9, dbg_probe_bf16(p, L1_ST, 2048L*16384))
  for (int rep_ = 0; rep_ < REP_P10; ++rep_) {
#ifdef DUMMY_P10
  hgrn_scan<true>(p);
  GSYNC();
#endif
  hgrn_scan<false>(p);
  GSYNC();
  }
  DBG_AT(10, dbg_probe_bf16(p, L1_ST, 2048L*16384))
  for (int rep_ = 0; rep_ < REP_P11; ++rep_) {
  for (int it = bid; it < 2048; it += G) hgrn_out(p, it, smem);
  GSYNC();
  }
  DBG_AT(11, dbg_probe_bf16(p, L1_H, 16384L*1024))
  for (int rep_ = 0; rep_ < REP_P12; ++rep_) {
#ifdef USE_G256
  for (int k_ = 0; k_ * (G >> 3) < 8 * 8; ++k_) {
    int tm, tn;
    if (!gemm_tile_xcd256(bid, G, k_, 8, tm, tn)) continue;
    gemm256((const bf16_t*)(ws + L1_H), 1024, (const bf16_t*)(ws + OFF_WOUT1), 1024, 1024, tm * 256, tn * 128, sA, (bf16_t*)(smem + 32768),
            [&](f32x4 (&acc)[4][4], int mb, int nb, int ln) { epi_out_resid(p.out, p.out, acc, mb, nb, ln); });
  }
#else
  for (int k_ = 0; k_ * (G >> 3) < 16 * 8; ++k_) {
    int tm, tn;
    if (!gemm_tile_xcd(bid, G, k_, 8, tm, tn)) continue;
    gemm128<false>((const bf16_t*)(ws + L1_H), 1024, 16383, (const bf16_t*)(ws + OFF_WOUT1), 1024, 1023, 1024, tm * 128, tn * 128, sA, sB,
            [&](f32x4 (&acc)[4][4], int mb, int nb, int ln) { epi_out_resid(p.out, p.out, acc, mb, nb, ln); });
  }
#endif
  }
}

extern "C" void kernel_launch(void* const* d_in, const int* in_sizes, int n_in, void* d_out, int out_size, void* d_ws, size_t ws_size,
                              hipStream_t stream) {
  static int grid_blocks = 0;
  if (!grid_blocks) {
    int dev = 0, cus = 0, per_cu = 0;
    (void)hipGetDevice(&dev);
    (void)hipDeviceGetAttribute(&cus, hipDeviceAttributeMultiprocessorCount, dev);
    (void)hipOccupancyMaxActiveBlocksPerMultiprocessor(&per_cu, mega, 256, 0);
    if (per_cu > 2) per_cu = 2;
    if (per_cu < 1) per_cu = 1;
    grid_blocks = cus * per_cu;
  }
  Params p{};
  const float** pf = (const float**)&p;
  for (int i = 0; i < 22; ++i) pf[i] = (const float*)d_in[i];
  p.out = (float*)d_out;
  p.ws = (unsigned char*)d_ws;
  (void)hipMemsetAsync((unsigned char*)d_ws + OFF_BAR, 0, 16384, stream);
  void* args[] = {&p};
  hipError_t e = hipLaunchCooperativeKernel((void*)mega, dim3(grid_blocks), dim3(256), args, 0, stream);
  if (e != hipSuccess) fprintf(stderr, "cooperative launch failed: %s (grid %d)\n", hipGetErrorString(e), grid_blocks);
}
```

```cpp
#include <hip/hip_runtime.h>
#define USE_G256 1
#define USE_WQ 1
#include <hip/hip_cooperative_groups.h>
#include <stdint.h>
#include <cstdio>
namespace cg = cooperative_groups;

typedef unsigned short bf16_t;
typedef __attribute__((ext_vector_type(8))) short bf16x8;
typedef __attribute__((ext_vector_type(4))) float f32x4;
typedef __attribute__((ext_vector_type(4))) unsigned int u32x4;

#define DEVI __device__ __forceinline__
#define EPSF 1e-6f
#define LDT 72
#define SLD 68
#define NEGS (-1e30f)
#define LAUNDER(ptr) asm volatile("" : "+s"(ptr))

struct Params {
  const float* x; const float* norm_w; const float* ev_w_in; const float* ev_b_in; const float* f_bias;
  const float* conv_w; const float* conv_b; const float* m_hn; const float* q_norm; const float* k_norm;
  const float* ck_pos; const float* ck_w1; const float* ck_w2; const float* cv_pos; const float* cv_w1; const float* cv_w2;
  const float* ev_w_out; const float* od_w_in; const float* od_b_in; const float* lb_logits; const float* h_hn; const float* od_w_out;
  float* out; unsigned char* ws;
};

constexpr size_t MiB = 1048576;
constexpr size_t OFF_WIN0 = 0;
constexpr size_t OFF_WOUT0 = OFF_WIN0 + 4480ull * 1024 * 2;
constexpr size_t OFF_WIN1 = OFF_WOUT0 + 2 * MiB;
constexpr size_t OFF_WOUT1 = OFF_WIN1 + 8 * MiB;
constexpr size_t OFF_WCK = OFF_WOUT1 + 2 * MiB;
constexpr size_t OFF_WCV = OFF_WCK + 512 * 1024;
constexpr size_t OFF_ROPE = OFF_WCV + 512 * 1024;
constexpr size_t OFF_PB = OFF_ROPE + 512 * 1024;
constexpr size_t OFF_LB = OFF_PB + 1024;
constexpr size_t OFF_BAR = OFF_LB + 4096;
constexpr size_t OFF_BASE = 24 * MiB;
constexpr size_t L0_H = OFF_BASE;
constexpr size_t L0_QKRAW = L0_H + 32 * MiB;
constexpr size_t L0_QC = L0_QKRAW + 32 * MiB;
constexpr size_t L0_KC = L0_QC + 16 * MiB;
constexpr size_t L0_KCT = L0_KC + 16 * MiB;
constexpr size_t L0_MVT = L0_KCT + 16 * MiB;
constexpr size_t L0_MO = L0_MVT + 16 * MiB;
constexpr size_t L0_MZ = L0_MO + 16 * MiB;
constexpr size_t L0_QN = L0_MZ + 16 * MiB;
constexpr size_t L0_NZ = L0_QN + 16 * MiB;
constexpr size_t L0_KCRAW = L0_NZ + 16 * MiB;
constexpr size_t L0_VCRAW = L0_KCRAW + 4 * MiB;
constexpr size_t L0_KS = L0_VCRAW + 4 * MiB;
constexpr size_t L0_KW = L0_KS + 4 * MiB;
constexpr size_t L0_VST = L0_KW + 4 * MiB;
constexpr size_t L0_VWT = L0_VST + 4 * MiB;
constexpr size_t L0_HID = L0_VWT + 4 * MiB;
constexpr size_t L0_KCMP = L0_HID + 2 * MiB;
constexpr size_t L0_VCMPT = L0_KCMP + 256 * 1024;
constexpr size_t L0_IG = L0_VCMPT + 256 * 1024;
constexpr size_t L0_LOGF = L0_IG + 256 * 1024;
constexpr size_t L0_GATES = L0_LOGF + 256 * 1024;
constexpr size_t L0_DN = L0_GATES + 1536 * 1024;
constexpr size_t L0_BL = L0_DN + 256 * 1024;
constexpr size_t L0_MLOC = L0_BL + 4096;
constexpr size_t L0_MIN = L0_MLOC + 4096;
constexpr size_t L0_HIDP = L0_MIN + 4096;
constexpr size_t L0_END = L0_HIDP + 8 * MiB;
static_assert(L0_END <= 256 * MiB, "ws overflow L0");
constexpr size_t L1_H = OFF_BASE;
constexpr size_t L1_FP = L1_H + 32 * MiB;
constexpr size_t L1_Q = L1_FP + 32 * MiB;
constexpr size_t L1_VT = L1_Q + 32 * MiB;
constexpr size_t L1_Z = L1_VT + 32 * MiB;
constexpr size_t L1_ST = L1_Z + 32 * MiB;
constexpr size_t L1_BL = L1_ST + 64 * MiB;
constexpr size_t L1_END = L1_BL + 1 * MiB;
static_assert(L1_END <= 256 * MiB, "ws overflow L1");

DEVI int opaque_tid() { int t = threadIdx.x; asm volatile("" : "+v"(t)); return t; }
typedef __bf16 bf16v2_t __attribute__((ext_vector_type(2)));
typedef float f32v2_t __attribute__((ext_vector_type(2)));
DEVI bf16_t f2bf(float f) { __bf16 h = (__bf16)f; return __builtin_bit_cast(unsigned short, h); }
DEVI float bf2f(bf16_t b) { return __uint_as_float(((unsigned)b) << 16); }
DEVI unsigned pack2(float a, float b) { f32v2_t f = {a, b}; bf16v2_t h = __builtin_convertvector(f, bf16v2_t); return __builtin_bit_cast(unsigned, h); }
DEVI float lo2f(unsigned u) { return __uint_as_float(u << 16); }
DEVI float hi2f(unsigned u) { return __uint_as_float(u & 0xffff0000u); }
DEVI float sigm(float x) { return __builtin_amdgcn_rcpf(1.f + __expf(-x)); }
DEVI float siluf(float x) { return x * sigm(x); }
DEVI float wave_sum(float v) { for (int o = 32; o > 0; o >>= 1) v += __shfl_xor(v, o); return v; }
DEVI float grp16_sum(float v) { v += __shfl_xor(v, 1); v += __shfl_xor(v, 2); v += __shfl_xor(v, 4); v += __shfl_xor(v, 8); return v; }

DEVI void wave_scan_sum128(float& a, float& b, int lane) {
  float t = a + b;
  float s = t;
#pragma unroll
  for (int o = 1; o < 64; o <<= 1) { float u = __shfl_up(s, o); if (lane >= o) s += u; }
  const float excl = s - t;
  a = excl + a;
  b = a + b;
}
DEVI void wave_scan_max128(float& a, float& b, int lane) {
  float t = fmaxf(a, b);
  float s = t;
#pragma unroll
  for (int o = 1; o < 64; o <<= 1) { float u = __shfl_up(s, o); if (lane >= o) s = fmaxf(s, u); }
  float prev = __shfl_up(s, 1);
  if (lane == 0) prev = -3.0e38f;
  a = fmaxf(prev, a);
  b = fmaxf(a, b);
}
DEVI float wave_max(float v) { for (int o = 32; o > 0; o >>= 1) v = fmaxf(v, __shfl_xor(v, o)); return v; }
DEVI int oldcol(int n) {
  return n < 2560 ? n : (n < 3840 ? n + 8 : (n < 4352 ? n + 32 : (n < 4360 ? n - 4352 + 2560 : n - 4360 + 3848)));
}

template <int MT, int NTL, int KS>
DEVI void mma_lds(const bf16_t* sA, const bf16_t* sB, f32x4 (&acc)[MT][NTL], int lane, bool neg = false) {
  const int r = lane & 15, q = lane >> 4;
#pragma unroll
  for (int ks = 0; ks < KS; ++ks) {
    bf16x8 a[MT], b[NTL];
#pragma unroll
    for (int mt = 0; mt < MT; ++mt) a[mt] = *(const bf16x8*)(sA + (mt * 16 + r) * LDT + ks * 32 + q * 8);
    if (neg) {
#pragma unroll
      for (int mt = 0; mt < MT; ++mt) a[mt] ^= (short)0x8000;
    }
#pragma unroll
    for (int nt = 0; nt < NTL; ++nt) b[nt] = *(const bf16x8*)(sB + (nt * 16 + r) * LDT + ks * 32 + q * 8);
#pragma unroll
    for (int mt = 0; mt < MT; ++mt)
#pragma unroll
      for (int nt = 0; nt < NTL; ++nt) acc[mt][nt] = __builtin_amdgcn_mfma_f32_16x16x32_bf16(a[mt], b[nt], acc[mt][nt], 0, 0, 0);
  }
}
template <int MT, int NTL, int KS>
DEVI void mma_lds_sw(const bf16_t* sA, const bf16_t* sB, f32x4 (&acc)[MT][NTL], int lane, bool neg = false) {
  const int r = lane & 15, q = lane >> 4;
#pragma unroll
  for (int ks = 0; ks < KS; ++ks) {
    bf16x8 a[MT], b[NTL];
#pragma unroll
    for (int mt = 0; mt < MT; ++mt) a[mt] = *(const bf16x8*)(sA + (mt * 16 + r) * LDT + ks * 32 + q * 8);
    if (neg) {
#pragma unroll
      for (int mt = 0; mt < MT; ++mt) a[mt] ^= (short)0x8000;
    }
#pragma unroll
    for (int nt = 0; nt < NTL; ++nt) b[nt] = *(const bf16x8*)(sB + (nt * 16 + r) * LDT + ks * 32 + q * 8);
#pragma unroll
    for (int mt = 0; mt < MT; ++mt)
#pragma unroll
      for (int nt = 0; nt < NTL; ++nt) acc[mt][nt] = __builtin_amdgcn_mfma_f32_16x16x32_bf16(b[nt], a[mt], acc[mt][nt], 0, 0, 0);
  }
}


template <int MT, int NTL, bool SWAP>
DEVI void mma_swz(const bf16_t* sA, const bf16_t* sB, f32x4 (&acc)[MT][NTL], int lane, bool neg) {
  const int r = lane & 15, q = lane >> 4, r7 = r & 7;
#pragma unroll
  for (int ks = 0; ks < 2; ++ks) {
    bf16x8 a[MT], b[NTL];
    const int co = ((ks * 4 + q) ^ r7) * 8;
#pragma unroll
    for (int mt = 0; mt < MT; ++mt) a[mt] = *(const bf16x8*)(sA + (mt * 16 + r) * 64 + co);
#pragma unroll
    for (int nt = 0; nt < NTL; ++nt) b[nt] = *(const bf16x8*)(sB + (nt * 16 + r) * 64 + co);
    if (neg) {
#pragma unroll
      for (int mt = 0; mt < MT; ++mt) a[mt] ^= (short)0x8000;
    }
#pragma unroll
    for (int mt = 0; mt < MT; ++mt)
#pragma unroll
      for (int nt = 0; nt < NTL; ++nt) {
        if (SWAP) acc[mt][nt] = __builtin_amdgcn_mfma_f32_16x16x32_bf16(b[nt], a[mt], acc[mt][nt], 0, 0, 0);
        else acc[mt][nt] = __builtin_amdgcn_mfma_f32_16x16x32_bf16(a[mt], b[nt], acc[mt][nt], 0, 0, 0);
      }
  }
}

DEVI void load_tile128(bf16_t* s, const bf16_t* g, long ld) {
  const int tid = opaque_tid(), lr = tid >> 3, lk = (tid & 7) * 8;
#pragma unroll
  for (int j = 0; j < 4; ++j) *(uint4*)(s + (lr + 32 * j) * LDT + lk) = *(const uint4*)(g + (long)(lr + 32 * j) * ld + lk);
}
DEVI void load_tile64(bf16_t* s, const bf16_t* g, long ld) {
  const int tid = opaque_tid(), lr = tid >> 3, lk = (tid & 7) * 8;
#pragma unroll
  for (int j = 0; j < 2; ++j) *(uint4*)(s + (lr + 32 * j) * LDT + lk) = *(const uint4*)(g + (long)(lr + 32 * j) * ld + lk);
}

template <bool SWAP, class Epi>
DEVI void gemm128(const bf16_t* A, long lda, int amax, const bf16_t* B, long ldb, int bmax, int K, int m0, int n0,
                  bf16_t* sA, bf16_t* sB, Epi&& epi) {
  const int tid = opaque_tid(), lane = tid & 63, w = tid >> 6, wr = w >> 1, wc = w & 1;
  const int lr = tid >> 3, lk = (tid & 7) * 8;
  const int lsw = (((tid & 7) ^ (lr & 7)) * 8);
  f32x4 acc[4][4];
#pragma unroll
  for (int mt = 0; mt < 4; ++mt)
#pragma unroll
    for (int nt = 0; nt < 4; ++nt) acc[mt][nt] = f32x4{0.f, 0.f, 0.f, 0.f};
  const bf16_t* ap[4];
  const bf16_t* bp[4];
#pragma unroll
  for (int j = 0; j < 4; ++j) {
    int ra = min(m0 + lr + 32 * j, amax);
    ap[j] = A + (long)ra * lda + lk;
    int rb = min(n0 + lr + 32 * j, bmax);
    bp[j] = B + (long)rb * ldb + lk;
  }
#ifndef GEMM_PASSES
#define GEMM_PASSES 1
#endif
  for (int pass_ = 0; pass_ < GEMM_PASSES; ++pass_) {
  u32x4 va0, va1, va2, va3, vb0, vb1, vb2, vb3;
  va0 = *(const u32x4*)(ap[0]); va1 = *(const u32x4*)(ap[1]); va2 = *(const u32x4*)(ap[2]); va3 = *(const u32x4*)(ap[3]);
  vb0 = *(const u32x4*)(bp[0]); vb1 = *(const u32x4*)(bp[1]); vb2 = *(const u32x4*)(bp[2]); vb3 = *(const u32x4*)(bp[3]);
  const int KT = K >> 6;
  *(u32x4*)(sA + (lr + 0) * 64 + lsw) = va0; *(u32x4*)(sA + (lr + 32) * 64 + lsw) = va1;
  *(u32x4*)(sA + (lr + 64) * 64 + lsw) = va2; *(u32x4*)(sA + (lr + 96) * 64 + lsw) = va3;
  *(u32x4*)(sB + (lr + 0) * 64 + lsw) = vb0; *(u32x4*)(sB + (lr + 32) * 64 + lsw) = vb1;
  *(u32x4*)(sB + (lr + 64) * 64 + lsw) = vb2; *(u32x4*)(sB + (lr + 96) * 64 + lsw) = vb3;
  if (KT > 1) {
    va0 = *(const u32x4*)(ap[0] + 64); va1 = *(const u32x4*)(ap[1] + 64); va2 = *(const u32x4*)(ap[2] + 64); va3 = *(const u32x4*)(ap[3] + 64);
    vb0 = *(const u32x4*)(bp[0] + 64); vb1 = *(const u32x4*)(bp[1] + 64); vb2 = *(const u32x4*)(bp[2] + 64); vb3 = *(const u32x4*)(bp[3] + 64);
  }
  __syncthreads();
  for (int kt = 0; kt < KT; ++kt) {
    const int st = (kt & 1) * 16384;
    const int sn = ((kt + 1) & 1) * 16384;
    if (kt + 1 < KT) {
      *(u32x4*)(sA + sn + (lr + 0) * 64 + lsw) = va0; *(u32x4*)(sA + sn + (lr + 32) * 64 + lsw) = va1;
      *(u32x4*)(sA + sn + (lr + 64) * 64 + lsw) = va2; *(u32x4*)(sA + sn + (lr + 96) * 64 + lsw) = va3;
      *(u32x4*)(sB + sn + (lr + 0) * 64 + lsw) = vb0; *(u32x4*)(sB + sn + (lr + 32) * 64 + lsw) = vb1;
      *(u32x4*)(sB + sn + (lr + 64) * 64 + lsw) = vb2; *(u32x4*)(sB + sn + (lr + 96) * 64 + lsw) = vb3;
    }
    if (kt + 2 < KT) {
      const int ko = (kt + 2) * 64;
      va0 = *(const u32x4*)(ap[0] + ko); va1 = *(const u32x4*)(ap[1] + ko); va2 = *(const u32x4*)(ap[2] + ko); va3 = *(const u32x4*)(ap[3] + ko);
      vb0 = *(const u32x4*)(bp[0] + ko); vb1 = *(const u32x4*)(bp[1] + ko); vb2 = *(const u32x4*)(bp[2] + ko); vb3 = *(const u32x4*)(bp[3] + ko);
    }
    __builtin_amdgcn_sched_barrier(0);
    __builtin_amdgcn_s_setprio(2);
    mma_swz<4, 4, SWAP>(sA + st + wr * 64 * 64, sB + st + wc * 64 * 64, acc, lane, (pass_ & 1) != 0);
    __builtin_amdgcn_s_setprio(0);
    __syncthreads();
  }
  }
  epi(acc, m0 + wr * 64, n0 + wc * 64, lane);
}


DEVI bool gemm_tile_xcd(int bid, int G, int k, int NTN, int& tm, int& tn) {
  const int x = bid & 7, per = G >> 3;
  const int u = (bid >> 3) + per * k;
  const int full_groups = NTN >> 3, rem = NTN & 7;
  const int n_full = full_groups * 2 * 64;
  if (u < n_full) {
    const int sb = u >> 6, wi = u & 63;
    const int tg = sb >> 1, th = sb & 1;
    tm = x * 16 + th * 8 + (wi >> 3);
    tn = tg * 8 + (wi & 7);
    return true;
  }
  const int v = u - n_full;
  if (v >= 16 * rem) return false;
  tm = x * 16 + v / rem;
  tn = full_groups * 8 + v % rem;
  return true;
}


template <class Epi>
DEVI void gemm256(const bf16_t* A, long lda, const bf16_t* B, long ldb, int K, int m0, int n0, bf16_t* sA, bf16_t* sB, Epi&& epi) {
  const int tid = opaque_tid(), lane = tid & 63, w = tid >> 6, wr = w >> 1, wc = w & 1;
  const int lr = tid >> 3, lk = (tid & 7) * 8;
  const int lsw = (((tid & 7) ^ (lr & 7)) * 8);
  const int r = lane & 15, q = lane >> 4, r7 = r & 7;
  f32x4 acc[2][4][4];
#pragma unroll
  for (int hh = 0; hh < 2; ++hh)
#pragma unroll
    for (int mt = 0; mt < 4; ++mt)
#pragma unroll
      for (int nt = 0; nt < 4; ++nt) acc[hh][mt][nt] = f32x4{0.f, 0.f, 0.f, 0.f};
  const bf16_t* abase = A + (long)(m0 + lr) * lda + lk;
  const bf16_t* bbase = B + (long)(n0 + lr) * ldb + lk;
  u32x4 va[8], vb[4];
#pragma unroll
  for (int j = 0; j < 8; ++j) va[j] = *(const u32x4*)(abase + (long)(32 * j) * lda);
#pragma unroll
  for (int j = 0; j < 4; ++j) vb[j] = *(const u32x4*)(bbase + (long)(32 * j) * ldb);
  const int KT = K >> 6;
  for (int kt = 0; kt < KT; ++kt) {
#pragma unroll
    for (int j = 0; j < 8; ++j) *(u32x4*)(sA + (lr + 32 * j) * 64 + lsw) = va[j];
#pragma unroll
    for (int j = 0; j < 4; ++j) *(u32x4*)(sB + (lr + 32 * j) * 64 + lsw) = vb[j];
    __syncthreads();
    if (kt + 1 < KT) {
      const int ko = (kt + 1) * 64;
#pragma unroll
      for (int j = 0; j < 8; ++j) va[j] = *(const u32x4*)(abase + (long)(32 * j) * lda + ko);
#pragma unroll
      for (int j = 0; j < 4; ++j) vb[j] = *(const u32x4*)(bbase + (long)(32 * j) * ldb + ko);
    }
    __builtin_amdgcn_sched_barrier(0);
    __builtin_amdgcn_s_setprio(2);
#pragma unroll
    for (int ks = 0; ks < 2; ++ks) {
      const int co = ((ks * 4 + q) ^ r7) * 8;
      bf16x8 b[4];
#pragma unroll
      for (int nt = 0; nt < 4; ++nt) b[nt] = *(const bf16x8*)(sB + (wc * 64 + nt * 16 + r) * 64 + co);
#pragma unroll
      for (int hh = 0; hh < 2; ++hh) {
        bf16x8 a[4];
#pragma unroll
        for (int mt = 0; mt < 4; ++mt) a[mt] = *(const bf16x8*)(sA + (wr * 128 + hh * 64 + mt * 16 + r) * 64 + co);
#pragma unroll
        for (int mt = 0; mt < 4; ++mt)
#pragma unroll
          for (int nt = 0; nt < 4; ++nt) acc[hh][mt][nt] = __builtin_amdgcn_mfma_f32_16x16x32_bf16(a[mt], b[nt], acc[hh][mt][nt], 0, 0, 0);
      }
    }
    __builtin_amdgcn_s_setprio(0);
    __syncthreads();
  }
  epi(acc[0], m0 + wr * 128, n0 + wc * 64, lane);
  epi(acc[1], m0 + wr * 128 + 64, n0 + wc * 64, lane);
}

DEVI bool gemm_tile_xcd256(int bid, int G, int k, int NTN, int& tm, int& tn) {
  const int x = bid & 7, per = G >> 3;
  const int u = (bid >> 3) + per * k;
  if (u >= 8 * NTN) return false;
  const int tg = u >> 6, wi = u & 63;
  tm = x * 8 + (wi >> 3);
  tn = tg * 8 + (wi & 7);
  return true;
}

DEVI void transpose_tile(const float* src, int N, int ldsrc, bf16_t* dst, int K, int ktile, int ntile, bool perm, float* sT) {
  const int tid = opaque_tid();
  const int k0 = ktile * 64, n0 = ntile * 64;
#pragma unroll
  for (int j = 0; j < 4; ++j) {
    int idx = tid + 256 * j;
    int kk = idx >> 4, n4 = (idx & 15) * 4;
    int n = n0 + n4;
    float4 v = make_float4(0.f, 0.f, 0.f, 0.f);
    if (n < N) { int oc = perm ? oldcol(n) : n; const f32x4 t_ = __builtin_nontemporal_load((const f32x4*)(src + (long)(k0 + kk) * ldsrc + oc)); v = make_float4(t_[0], t_[1], t_[2], t_[3]); }
    sT[kk * 65 + n4 + 0] = v.x; sT[kk * 65 + n4 + 1] = v.y; sT[kk * 65 + n4 + 2] = v.z; sT[kk * 65 + n4 + 3] = v.w;
  }
  __syncthreads();
#pragma unroll
  for (int j = 0; j < 2; ++j) {
    int idx = tid + 256 * j;
    int nn = idx >> 3, kc = (idx & 7) * 8;
    if (n0 + nn < N) {
      uint4 o;
      o.x = pack2(sT[(kc + 0) * 65 + nn], sT[(kc + 1) * 65 + nn]);
      o.y = pack2(sT[(kc + 2) * 65 + nn], sT[(kc + 3) * 65 + nn]);
      o.z = pack2(sT[(kc + 4) * 65 + nn], sT[(kc + 5) * 65 + nn]);
      o.w = pack2(sT[(kc + 6) * 65 + nn], sT[(kc + 7) * 65 + nn]);
      *(uint4*)(dst + (long)(n0 + nn) * K + k0 + kc) = o;
    }
  }
  __syncthreads();
}

DEVI void rmsnorm_row2(const float* X, const float* w, bf16_t* H, int row0, int row1, int lane) {
  const float4* xa = (const float4*)(X + (long)row0 * 1024);
  const float4* xb = (const float4*)(X + (long)row1 * 1024);
  float4 va[4], vb[4], ww[4];
#pragma unroll
  for (int j = 0; j < 4; ++j) {
    const f32x4 ta_ = __builtin_nontemporal_load((const f32x4*)(xa + lane + 64 * j));
    const f32x4 tb_ = __builtin_nontemporal_load((const f32x4*)(xb + lane + 64 * j));
    va[j] = make_float4(ta_[0], ta_[1], ta_[2], ta_[3]); vb[j] = make_float4(tb_[0], tb_[1], tb_[2], tb_[3]);
    ww[j] = ((const float4*)w)[lane + 64 * j];
  }
  float sa = 0.f, sb = 0.f;
#pragma unroll
  for (int j = 0; j < 4; ++j) {
    sa += va[j].x * va[j].x + va[j].y * va[j].y + va[j].z * va[j].z + va[j].w * va[j].w;
    sb += vb[j].x * vb[j].x + vb[j].y * vb[j].y + vb[j].z * vb[j].z + vb[j].w * vb[j].w;
  }
  sa = wave_sum(sa); sb = wave_sum(sb);
  const float ra = rsqrtf(sa * (1.f / 1024.f) + EPSF), rb = rsqrtf(sb * (1.f / 1024.f) + EPSF);
#pragma unroll
  for (int j = 0; j < 4; ++j) {
    uint2 o;
    o.x = pack2(va[j].x * ra * ww[j].x, va[j].y * ra * ww[j].y);
    o.y = pack2(va[j].z * ra * ww[j].z, va[j].w * ra * ww[j].w);
    *(uint2*)(H + (long)row0 * 1024 + (lane + 64 * j) * 4) = o;
    o.x = pack2(vb[j].x * rb * ww[j].x, vb[j].y * rb * ww[j].y);
    o.y = pack2(vb[j].z * rb * ww[j].z, vb[j].w * rb * ww[j].w);
    *(uint2*)(H + (long)row1 * 1024 + (lane + 64 * j) * 4) = o;
  }
}

DEVI void phase0(const Params& p, unsigned char* smem) {
  const int G = gridDim.x, bid = blockIdx.x, tid = threadIdx.x, lane = tid & 63, w = tid >> 6;
  unsigned char* ws = p.ws;
  float* sT = (float*)smem;
  for (int it = bid; it < 69 * 16; it += G) transpose_tile(p.ev_w_in, 4384, 4384, (bf16_t*)(ws + OFF_WIN0), 1024, it / 69, it % 69, true, sT);
  for (int it = bid; it < 16 * 16; it += G) transpose_tile(p.ev_w_out, 1024, 1024, (bf16_t*)(ws + OFF_WOUT0), 1024, it / 16, it % 16, false, sT);
  for (int it = bid; it < 64 * 16; it += G) transpose_tile(p.od_w_in, 4096, 4096, (bf16_t*)(ws + OFF_WIN1), 1024, it / 64, it % 64, false, sT);
  for (int it = bid; it < 16 * 16; it += G) transpose_tile(p.od_w_out, 1024, 1024, (bf16_t*)(ws + OFF_WOUT1), 1024, it / 16, it % 16, false, sT);
  for (int it = bid; it < 2 * 32; it += G) transpose_tile(p.ck_w1, 128, 128, (bf16_t*)(ws + OFF_WCK), 2048, it / 2, it % 2, false, sT);
  for (int it = bid; it < 2 * 32; it += G) transpose_tile(p.cv_w1, 128, 128, (bf16_t*)(ws + OFF_WCV), 2048, it / 2, it % 2, false, sT);
  for (int row = (bid * 4 + w) * 2; row < 16384; row += G * 8) rmsnorm_row2(p.x, p.norm_w, (bf16_t*)(ws + L0_H), row, row + 1, lane);
  for (int idx = bid * 256 + tid; idx < 8192 * 8; idx += G * 256) {
    int t = idx >> 3, i = idx & 7;
    float invf = powf(500000.0f, -(float)i / 8.0f);
    float ang = (float)t * invf;
    double a = (double)ang;
    float2 cs;
    cs.x = (float)cos(a);
    cs.y = (float)sin(a);
    ((float2*)(ws + OFF_ROPE))[idx] = cs;
  }
  for (int o = bid * 4 + w; o < 256; o += G * 4) {
    int kv = o >> 7, j = o & 127;
    const float* pos = kv ? p.cv_pos : p.ck_pos;
    const float* w1 = kv ? p.cv_w1 : p.ck_w1;
    float sacc_ = 0.f;
#pragma unroll 8
    for (int i = lane; i < 2048; i += 64) sacc_ += pos[i] * w1[i * 128 + j];
    sacc_ = wave_sum(sacc_);
    if (lane == 0) ((float*)(ws + OFF_PB))[o] = sacc_;
  }
  if (bid == G - 2 || G < 2) {
    for (int c = tid; c < 1024; c += 256) {
      float l0 = p.lb_logits[c], l1 = p.lb_logits[1024 + c];
      ((float*)(ws + OFF_LB))[c] = 1.f / (1.f + expf(l1 - l0));
    }
  }
}

template <int MODE>
DEVI void store_rm(bf16_t* dst, int ld, int colbase, f32x4 (&acc)[4][4], const float* bias, int mb, int lane) {
  const int r = lane & 15, q = lane >> 4;
#pragma unroll
  for (int mt = 0; mt < 4; ++mt)
#pragma unroll
    for (int i = 0; i < 4; ++i) {
      long row = mb + mt * 16 + q * 4 + i;
#pragma unroll
      for (int nt = 0; nt < 4; ++nt) {
        float v = acc[mt][nt][i] + bias[nt];
        if (MODE == 1) v = sigm(v);
        if (MODE == 2) v = siluf(v);
        dst[row * ld + colbase + nt * 16 + r] = f2bf(v);
      }
    }
}
template <int MODE>
DEVI void store_T(bf16_t* dst, int bgrp, int F, int featoff, f32x4 (&acc)[4][4], const float* bias, int tl0, int lane) {
  const int r = lane & 15, q = lane >> 4;
#pragma unroll
  for (int mt = 0; mt < 4; ++mt)
#pragma unroll
    for (int nt = 0; nt < 4; ++nt) {
      int t = tl0 + mt * 16 + q * 4;
      float b = bias[nt];
      uint2 o;
      o.x = pack2(acc[mt][nt][0] + b, acc[mt][nt][1] + b);
      o.y = pack2(acc[mt][nt][2] + b, acc[mt][nt][3] + b);
      *(uint2*)(dst + (((long)bgrp * 128 + (t >> 6)) * F + featoff + nt * 16 + r) * 64 + (t & 63)) = o;
    }
}
DEVI void norm_rope_store(bf16_t* dst, long rowbase, int ld, int colbase, f32x4 (&acc)[4][4], const float* bias, const float* nw,
                          float scale, const float2* rope, int mb, int lane) {
  const int r = lane & 15, q = lane >> 4;
  float wv[4];
#pragma unroll
  for (int nt = 0; nt < 4; ++nt) wv[nt] = nw[nt * 16 + r];
  float2 csv[4][4];
#pragma unroll
  for (int mt = 0; mt < 4; ++mt)
#pragma unroll
    for (int i = 0; i < 4; ++i) csv[mt][i] = rope[((mb + mt * 16 + q * 4 + i) & 8191) * 8 + (r & 7)];
#pragma unroll
  for (int mt = 0; mt < 4; ++mt)
#pragma unroll
    for (int i = 0; i < 4; ++i) {
      int row = mb + mt * 16 + q * 4 + i;
      int t = row & 8191;
      float v[4];
      float ss = 0.f;
#pragma unroll
      for (int nt = 0; nt < 4; ++nt) { v[nt] = acc[mt][nt][i] + bias[nt]; ss += v[nt] * v[nt]; }
      ss = grp16_sum(ss);
      float rinv = rsqrtf(ss * (1.f / 64.f) + EPSF);
#pragma unroll
      for (int nt = 0; nt < 4; ++nt) v[nt] = v[nt] * rinv * wv[nt];
      float partner = __shfl_xor(v[0], 8);
      float2 cs = csv[mt][i];
      float x1 = (r < 8) ? v[0] : partner, x2 = (r < 8) ? partner : v[0];
      v[0] = (r < 8) ? (x1 * cs.x - x2 * cs.y) : (x1 * cs.y + x2 * cs.x);
#pragma unroll
      for (int nt = 0; nt < 4; ++nt) dst[(rowbase + t) * ld + colbase + nt * 16 + r] = f2bf(v[nt] * scale);
    }
}

DEVI void epi_proj0(const Params& p, f32x4 (&acc)[4][4], int mb, int nb, int lane) {
  if (nb >= 4384) return;
  unsigned char* ws = p.ws;
  const int r = lane & 15, q = lane >> 4;
  float bias[4];
#pragma unroll
  for (int nt = 0; nt < 4; ++nt) { int n = nb + nt * 16 + r; bias[nt] = (n < 4384) ? p.ev_b_in[oldcol(n)] : 0.f; }
  const int b = mb >> 13;
  const int tl0 = mb & 8191;
  const float2* rope = (const float2*)(ws + OFF_ROPE);
  if (nb < 1024) {
    store_rm<0>((bf16_t*)(ws + L0_QKRAW), 1024, nb, acc, bias, mb, lane);
  } else if (nb < 1536) {
    store_T<0>((bf16_t*)(ws + L0_MVT), b * 4 + ((nb - 1024) >> 7), 128, (nb - 1024) & 127, acc, bias, tl0, lane);
  } else if (nb < 2048) {
    store_rm<1>((bf16_t*)(ws + L0_MO), 512, nb - 1536, acc, bias, mb, lane);
  } else if (nb < 2560) {
    store_rm<2>((bf16_t*)(ws + L0_MZ), 512, nb - 2048, acc, bias, mb, lane);
  } else if (nb < 3072) {
    int head = (nb - 2560) >> 6, g = head >> 2, rr = head & 3;
    norm_rope_store((bf16_t*)(ws + L0_QN), (long)(b * 2 + g) * 8192, 256, rr * 64, acc, bias, p.q_norm, 0.125f * 1.4426950408889634f, rope, mb, lane);
  } else if (nb < 3328) {
    int g = ((nb - 3072) >> 6) & 1;
    bf16_t* dst = (bf16_t*)(ws + (nb < 3200 ? L0_KCRAW : L0_VCRAW));
    const long rowbase = (long)(b * 2 + g) * 8192;
#pragma unroll
    for (int mt = 0; mt < 4; ++mt)
#pragma unroll
      for (int i = 0; i < 4; ++i) {
        int t = (mb + mt * 16 + q * 4 + i) & 8191;
#pragma unroll
        for (int nt = 0; nt < 4; ++nt) dst[(rowbase + t) * 64 + nt * 16 + r] = f2bf(acc[mt][nt][i] + bias[nt]);
      }
  } else if (nb < 3456) {
    int g = (nb - 3328) >> 6;
    norm_rope_store((bf16_t*)(ws + L0_KS), (long)(b * 2 + g) * 8192, 64, 0, acc, bias, p.k_norm + 64, 1.f, rope, mb, lane);
  } else if (nb < 3584) {
    store_T<0>((bf16_t*)(ws + L0_VST), b * 2 + ((nb - 3456) >> 6), 64, 0, acc, bias, tl0, lane);
  } else if (nb < 3712) {
    int g = (nb - 3584) >> 6;
    norm_rope_store((bf16_t*)(ws + L0_KW), (long)(b * 2 + g) * 8192, 64, 0, acc, bias, p.k_norm + 128, 1.f, rope, mb, lane);
  } else if (nb < 3840) {
    store_T<0>((bf16_t*)(ws + L0_VWT), b * 2 + ((nb - 3712) >> 6), 64, 0, acc, bias, tl0, lane);
  } else if (nb < 4352) {
    store_rm<2>((bf16_t*)(ws + L0_NZ), 512, nb - 3840, acc, bias, mb, lane);
  } else {
    float* IG = (float*)(ws + L0_IG);
    float* LF = (float*)(ws + L0_LOGF);
    float* GT = (float*)(ws + L0_GATES);
#pragma unroll
    for (int mt = 0; mt < 4; ++mt)
#pragma unroll
      for (int i = 0; i < 4; ++i) {
        long row = mb + mt * 16 + q * 4 + i;
#pragma unroll
        for (int nt = 0; nt < 2; ++nt) {
          int c = nt * 16 + r;
          float v = acc[mt][nt][i] + bias[nt];
          if (c < 4) IG[row * 4 + c] = v;
          else if (c < 8) { float xx = v + p.f_bias[c - 4]; LF[row * 4 + c - 4] = fminf(xx, 0.f) - log1pf(__expf(-fabsf(xx))); }
          else GT[row * 24 + c - 8] = sigm(v);
        }
      }
  }
}

DEVI void epi_cmp_hidden(const Params& p, f32x4 (&acc)[4][4], int mb, int nb, int lane, int kv, int bg, int ksp) {
  const int r = lane & 15, q = lane >> 4;
  float* hid = (float*)(p.ws + L0_HIDP) + ((long)((ksp * 2 + kv) * 4 + bg) * 512) * 128;
#pragma unroll
  for (int mt = 0; mt < 4; ++mt)
#pragma unroll
    for (int i = 0; i < 4; ++i) {
      int row = mb + mt * 16 + q * 4 + i;
#pragma unroll
      for (int nt = 0; nt < 4; ++nt) hid[(long)row * 128 + nb + nt * 16 + r] = acc[mt][nt][i];
    }
}

DEVI void epi_out_resid(const float* resid, float* out, f32x4 (&acc)[4][4], int mb, int nb, int lane) {
  const int r = lane & 15, q = lane >> 4;
#pragma unroll
  for (int mt = 0; mt < 4; ++mt) {
    float rv[4][4];
#pragma unroll
    for (int i = 0; i < 4; ++i)
#pragma unroll
      for (int nt = 0; nt < 4; ++nt) rv[i][nt] = resid[(long)(mb + mt * 16 + q * 4 + i) * 1024 + nb + nt * 16 + r];
#pragma unroll
    for (int i = 0; i < 4; ++i)
#pragma unroll
      for (int nt = 0; nt < 4; ++nt) out[(long)(mb + mt * 16 + q * 4 + i) * 1024 + nb + nt * 16 + r] = rv[i][nt] + acc[mt][nt][i];
  }
}

DEVI void epi_proj1(const Params& p, f32x4 (&acc)[4][4], int mb, int nb, int lane) {
  unsigned char* ws = p.ws;
  const int r = lane & 15;
  float bias[4];
#pragma unroll
  for (int nt = 0; nt < 4; ++nt) bias[nt] = p.od_b_in[nb + nt * 16 + r];
  const int b = mb >> 13, tl0 = mb & 8191;
  if (nb < 1024) store_rm<0>((bf16_t*)(ws + L1_FP), 1024, nb, acc, bias, mb, lane);
  else if (nb < 2048) store_T<0>((bf16_t*)(ws + L1_VT), b * 8 + ((nb - 1024) >> 7), 128, (nb - 1024) & 127, acc, bias, tl0, lane);
  else if (nb < 3072) store_rm<2>((bf16_t*)(ws + L1_Q), 1024, nb - 2048, acc, bias, mb, lane);
  else store_rm<2>((bf16_t*)(ws + L1_Z), 1024, nb - 3072, acc, bias, mb, lane);
}

DEVI void conv_tile(const Params& p, int item, unsigned char* smem) {
  const int tid = opaque_tid();
  const int ctile = item & 7, ttile = item >> 3;
  const int t0g = ttile * 64;
  const int b = t0g >> 13, tl0 = t0g & 8191;
  unsigned char* ws = p.ws;
  float* sRaw = (float*)smem;
  bf16_t* sOutT = (bf16_t*)(smem + 67 * 128 * 4);
  const bf16_t* raw = (const bf16_t*)(ws + L0_QKRAW);
  for (int idx = tid; idx < 67 * 16; idx += 256) {
    int rr = idx >> 4, ch = (idx & 15) * 8;
    int tl = tl0 + rr - 3;
    uint4 v = make_uint4(0, 0, 0, 0);
    if (tl >= 0) v = *(const uint4*)(raw + (long)(b * 8192 + tl) * 1024 + ctile * 128 + ch);
    float* d = sRaw + rr * 128 + ch;
    d[0] = lo2f(v.x); d[1] = hi2f(v.x); d[2] = lo2f(v.y); d[3] = hi2f(v.y);
    d[4] = lo2f(v.z); d[5] = hi2f(v.z); d[6] = lo2f(v.w); d[7] = hi2f(v.w);
  }
  __syncthreads();
  const int c = tid & 127, th = tid >> 7;
  const int cg_ = ctile * 128 + c;
  const float w0 = p.conv_w[cg_], w1 = p.conv_w[1024 + cg_], w2 = p.conv_w[2048 + cg_], w3 = p.conv_w[3072 + cg_];
  const float cb = p.conv_b[cg_];
  const bool isk = ctile >= 4;
  bf16_t* dst = (bf16_t*)(ws + (isk ? L0_KC : L0_QC));
  const int cc = isk ? cg_ - 512 : cg_;
  const float sc = isk ? 0.08838834764831845f : 1.f;
  for (int t = th * 32; t < th * 32 + 32; ++t) {
    float a = cb + w0 * sRaw[t * 128 + c] + w1 * sRaw[(t + 1) * 128 + c] + w2 * sRaw[(t + 2) * 128 + c] + w3 * sRaw[(t + 3) * 128 + c];
    bf16_t o = f2bf(siluf(a) * sc);
    dst[(long)(t0g + t) * 512 + cc] = o;
    sOutT[c * LDT + t] = o;
  }
  __syncthreads();
  if (isk) {
    bf16_t* kct = (bf16_t*)(ws + L0_KCT);
#pragma unroll
    for (int j = 0; j < 4; ++j) {
      int idx = tid + 256 * j;
      int cr = idx >> 3, tc = (idx & 7) * 8;
      *(uint4*)(kct + ((((long)(b * 4 + (ctile - 4)) * 128 + (tl0 >> 6)) * 128 + cr) * 64) + tc) = *(const uint4*)(sOutT + cr * LDT + tc);
    }
  }
  __syncthreads();
}

DEVI void cmp_finalize(const Params& p, int task, int lane) {
  const int n = task & 511, bg = (task >> 9) & 3, kv = task >> 11;
  unsigned char* ws = p.ws;
  bf16_t* KCMP = (bf16_t*)(ws + L0_KCMP);
  bf16_t* VCMPT = (bf16_t*)(ws + L0_VCMPT);
  if (n == 511) {
    if (kv == 0) KCMP[((long)bg * 512 + 511) * 64 + lane] = 0;
    else VCMPT[((long)bg * 64 + lane) * 512 + 511] = 0;
    return;
  }
  const float* hid = (const float*)(ws + L0_HIDP) + ((long)(kv * 4 + bg) * 512 + n) * 128;
  const float* pbv = (const float*)(ws + OFF_PB) + kv * 128;
  const float* w2 = kv ? p.cv_w2 : p.ck_w2;
  float g0, g1;
  {
    float x0 = ((hid[lane] + hid[lane + 524288]) + (hid[lane + 2 * 524288] + hid[lane + 3 * 524288])) + pbv[lane];
    float x1 = ((hid[lane + 64] + hid[lane + 64 + 524288]) + (hid[lane + 64 + 2 * 524288] + hid[lane + 64 + 3 * 524288])) + pbv[lane + 64];
    g0 = 0.5f * x0 * (1.f + tanhf(0.7978845608028654f * (x0 + 0.044715f * x0 * x0 * x0)));
    g1 = 0.5f * x1 * (1.f + tanhf(0.7978845608028654f * (x1 + 0.044715f * x1 * x1 * x1)));
  }
  float a = 0.f;
  for (int j0 = 0; j0 < 64; j0 += 16) {
    float wv[16], wu[16];
#pragma unroll
    for (int k = 0; k < 16; ++k) { wv[k] = w2[(j0 + k) * 64 + lane]; wu[k] = w2[(64 + j0 + k) * 64 + lane]; }
#pragma unroll
    for (int k = 0; k < 16; ++k) a += __shfl(g0, j0 + k) * wv[k] + __shfl(g1, j0 + k) * wu[k];
  }
  if (kv == 0) {
    float ss = wave_sum(a * a);
    float rinv = rsqrtf(ss * (1.f / 64.f) + EPSF);
    float v = a * rinv * p.k_norm[lane];
    float partner = __shfl_xor(v, 8);
    int pos = 16 * n + 31;
    float2 cs = ((const float2*)(ws + OFF_ROPE))[pos * 8 + (lane & 7)];
    float o = v;
    if (lane < 8) o = v * cs.x - partner * cs.y;
    else if (lane < 16) o = partner * cs.y + v * cs.x;
    KCMP[((long)bg * 512 + n) * 64 + lane] = f2bf(o);
  } else {
    VCMPT[((long)bg * 64 + lane) * 512 + n] = f2bf(a);
  }
}

DEVI void mlstm_local(const Params& p, int unit, unsigned char* smem) {
  const int tid = opaque_tid(), lane = tid & 63, w = tid >> 6, wr = w >> 1, wc = w & 1;
  const int bh = unit >> 6, c = unit & 63, b = bh >> 2, h = bh & 3, t0 = c * 128;
  const long R0 = (long)b * 8192 + t0;
  unsigned char* ws = p.ws;
  bf16_t* sA = (bf16_t*)smem;
  bf16_t* sB = (bf16_t*)(smem + 18432);
  float* sIg = (float*)(smem + 36864);
  float* sLf = sIg + 128;
  float* sW = sLf + 128;
  const float* IG = (const float*)(ws + L0_IG);
  const float* LF = (const float*)(ws + L0_LOGF);
  if (tid < 128) { sIg[tid] = IG[(R0 + tid) * 4 + h]; sLf[tid] = LF[(R0 + tid) * 4 + h]; }
  __syncthreads();
  if (tid < 64) {
    float c0 = sLf[2 * tid], c1 = sLf[2 * tid + 1];
    wave_scan_sum128(c0, c1, tid);
    const float bL = __shfl(c1, 63);
    float d0 = bL - c0 + sIg[2 * tid], d1 = bL - c1 + sIg[2 * tid + 1];
    const float ml = wave_max(fmaxf(d0, d1));
    sW[2 * tid] = __expf(d0 - ml); sW[2 * tid + 1] = __expf(d1 - ml);
    if (tid == 0) { ((float*)(ws + L0_BL))[unit] = bL; ((float*)(ws + L0_MLOC))[unit] = ml; }
  }
  __syncthreads();
  f32x4 acc[4][4];
#pragma unroll
  for (int mt = 0; mt < 4; ++mt)
#pragma unroll
    for (int nt = 0; nt < 4; ++nt) acc[mt][nt] = f32x4{0.f, 0.f, 0.f, 0.f};
  float dn = 0.f;
  const bf16_t* vt = (const bf16_t*)(ws + L0_MVT) + (((long)(b * 4 + h) * 128 + (t0 >> 6)) * 128) * 64;
  const bf16_t* kt_ = (const bf16_t*)(ws + L0_KCT) + (((long)(b * 4 + h) * 128 + (t0 >> 6)) * 128) * 64;
  const int lr = tid >> 3, lk = (tid & 7) * 8;
  for (int kt = 0; kt < 2; ++kt) {
    load_tile128(sA, vt + kt * 8192, 64);
#pragma unroll
    for (int j = 0; j < 4; ++j) {
      uint4 v = *(const uint4*)(kt_ + (long)kt * 8192 + (lr + 32 * j) * 64 + lk);
      const float* ww = sW + kt * 64 + lk;
      uint4 o;
      o.x = pack2(lo2f(v.x) * ww[0], hi2f(v.x) * ww[1]);
      o.y = pack2(lo2f(v.y) * ww[2], hi2f(v.y) * ww[3]);
      o.z = pack2(lo2f(v.z) * ww[4], hi2f(v.z) * ww[5]);
      o.w = pack2(lo2f(v.w) * ww[6], hi2f(v.w) * ww[7]);
      *(uint4*)(sB + (lr + 32 * j) * LDT + lk) = o;
    }
    __syncthreads();
    if (tid < 128) {
#pragma unroll 8
      for (int s = 0; s < 64; ++s) dn += bf2f(sB[tid * LDT + s]);
    }
    mma_lds<4, 4, 2>(sA + wr * 64 * LDT, sB + wc * 64 * LDT, acc, lane);
    __syncthreads();
  }
  float* dct = (float*)(ws + L0_H) + (long)unit * 16384;
  const int r = lane & 15, q = lane >> 4;
#pragma unroll
  for (int mt = 0; mt < 4; ++mt)
#pragma unroll
    for (int i = 0; i < 4; ++i) {
      int e = wr * 64 + mt * 16 + q * 4 + i;
#pragma unroll
      for (int nt = 0; nt < 4; ++nt) dct[e * 128 + wc * 64 + nt * 16 + r] = acc[mt][nt][i];
    }
  if (tid < 128) ((float*)(ws + L0_DN))[unit * 128 + tid] = dn;
}

template <bool DUMMY>
DEVI void mlstm_scan(const Params& p, unsigned char* smem) {
  unsigned char* ws = p.ws;
  const float* BL = (const float*)(ws + L0_BL);
  const float* ML = (const float*)(ws + L0_MLOC);
  float* MIN_ = (float*)(ws + L0_MIN);
  float* sDec = (float*)smem;
  float* sWn = sDec + 128;
  const int tid = opaque_tid();
  const int total = 8 * 16384 + 8 * 128;
  for (int base = blockIdx.x * 256; base < total; base += gridDim.x * 256) {
    const int bh0 = (base < 131072) ? (base >> 14) : ((base - 131072) >> 7);
    __syncthreads();
    if (tid < 2) {
      const int bh = bh0 + tid;
      if (bh < 8) {
        float m = 0.f;
        for (int c = 0; c < 64; ++c) {
          const int unit = bh * 64 + c;
          const float bL = BL[unit], ml = ML[unit];
          if (!DUMMY && base < 131072 && (base & 16383) == 0 && tid == 0) MIN_[unit] = m;
          const float mn = fmaxf(bL + m, ml);
          sDec[tid * 64 + c] = __expf(bL + m - mn);
          sWn[tid * 64 + c] = __expf(ml - mn);
          m = mn;
        }
      }
    }
    __syncthreads();
    const int idx = base + tid;
    if (idx < total) {
      float* ptr; long stride; int sel;
      if (idx < 131072) { const int bh = idx >> 14; ptr = (float*)(ws + L0_H) + (long)bh * 64 * 16384 + (idx & 16383); stride = 16384; sel = bh - bh0; }
      else { const int j = idx - 131072; const int bh = j >> 7; ptr = (float*)(ws + L0_DN) + (long)bh * 64 * 128 + (j & 127); stride = 128; sel = bh - bh0; }
      const float* dec = sDec + sel * 64;
      const float* wn = sWn + sel * 64;
      float C = 0.f;
      for (int c0 = 0; c0 < 64; c0 += 8) {
        float dv[8];
#pragma unroll
        for (int k = 0; k < 8; ++k) dv[k] = __builtin_nontemporal_load(ptr + (long)(c0 + k) * stride);
#pragma unroll
        for (int k = 0; k < 8; ++k) {
          if (!DUMMY) __builtin_nontemporal_store(C, ptr + (long)(c0 + k) * stride);
          C = dec[c0 + k] * C + wn[c0 + k] * dv[k];
        }
      }
      if (DUMMY && C == 123.456f) MIN_[0] = C;
    }
  }
}

DEVI void mlstm_out(const Params& p, int item, unsigned char* smem) {
  const int tid = opaque_tid(), lane = tid & 63, w = tid >> 6, wr = w >> 1, wc = w & 1;
  const int r = lane & 15, q = lane >> 4;
  const int unit = item >> 1, u = item & 1;
  const int bh = unit >> 6, c = unit & 63, b = bh >> 2, h = bh & 3, t0 = c * 128;
  const long R0 = (long)b * 8192 + t0;
  const int J0 = u * 64;
  unsigned char* ws = p.ws;
  bf16_t* sA = (bf16_t*)smem;
  bf16_t* sB = (bf16_t*)(smem + 9216);
  bf16_t* sS0 = (bf16_t*)(smem + 27648);
  bf16_t* sS1 = (bf16_t*)(smem + 36864);
  float* fl = (float*)(smem + 46080);
  float* sIg = fl; float* sLf = fl + 128; float* sRj = fl + 256; float* sCs = fl + 384; float* sWi = fl + 512;
  float* sEm = fl + 640; float* sQn = fl + 768; float* sNin = fl + 896; float* sDen = fl + 1024; float* sSs = fl + 1280;
  const float* IG = (const float*)(ws + L0_IG);
  const float* LF = (const float*)(ws + L0_LOGF);
  const bf16_t* QC = (const bf16_t*)(ws + L0_QC) + (R0 + J0) * 512 + h * 128;
  const bf16_t* KC = (const bf16_t*)(ws + L0_KC) + R0 * 512 + h * 128;
  if (tid < 128) { sIg[tid] = IG[(R0 + tid) * 4 + h]; sLf[tid] = LF[(R0 + tid) * 4 + h]; sNin[tid] = ((const float*)(ws + L0_DN))[unit * 128 + tid]; }
  const float m_in = ((const float*)(ws + L0_MIN))[unit];
  __syncthreads();
  if (tid < 64) {
    float c0 = sLf[2 * tid], c1 = sLf[2 * tid + 1];
    wave_scan_sum128(c0, c1, tid);
    const float a0 = sIg[2 * tid] - c0, a1 = sIg[2 * tid + 1] - c1;
    float x0 = a0, x1 = a1;
    wave_scan_max128(x0, x1, tid);
    const float mx0 = fmaxf(x0, m_in), mx1 = fmaxf(x1, m_in);
    sCs[2 * tid] = a0; sCs[2 * tid + 1] = a1;
    sRj[2 * tid] = -mx0; sRj[2 * tid + 1] = -mx1;
    sWi[2 * tid] = __expf(m_in - mx0); sWi[2 * tid + 1] = __expf(m_in - mx1);
    sEm[2 * tid] = __expf(-(c0 + mx0)); sEm[2 * tid + 1] = __expf(-(c1 + mx1));
  }
  if (tid >= 128 && tid < 192) {
    int jl = tid - 128;
    const bf16_t* qr = QC + (long)jl * 512;
    float s = 0.f;
#pragma unroll 2
    for (int ch = 0; ch < 16; ++ch) {
      uint4 v = *(const uint4*)(qr + ch * 8);
      const float* nn = sNin + ch * 8;
      s += lo2f(v.x) * nn[0] + hi2f(v.x) * nn[1] + lo2f(v.y) * nn[2] + hi2f(v.y) * nn[3] + lo2f(v.z) * nn[4] + hi2f(v.z) * nn[5] + lo2f(v.w) * nn[6] + hi2f(v.w) * nn[7];
    }
    sQn[jl] = s;
  }
  __syncthreads();
  f32x4 acc[2][4];
#pragma unroll
  for (int mt = 0; mt < 2; ++mt)
#pragma unroll
    for (int nt = 0; nt < 4; ++nt) acc[mt][nt] = f32x4{0.f, 0.f, 0.f, 0.f};
  const bool skipS = (wc > u);
  const int lr = tid >> 3, lk = (tid & 7) * 8;
  {
    u32x4 qa0, qa1, kb0, kb1, kb2, kb3;
    qa0 = *(const u32x4*)(QC + (long)lr * 512 + lk); qa1 = *(const u32x4*)(QC + (long)(lr + 32) * 512 + lk);
    kb0 = *(const u32x4*)(KC + (long)lr * 512 + lk); kb1 = *(const u32x4*)(KC + (long)(lr + 32) * 512 + lk);
    kb2 = *(const u32x4*)(KC + (long)(lr + 64) * 512 + lk); kb3 = *(const u32x4*)(KC + (long)(lr + 96) * 512 + lk);
#pragma unroll 1
    for (int kt = 0; kt < 2; ++kt) {
      *(u32x4*)(sA + lr * LDT + lk) = qa0; *(u32x4*)(sA + (lr + 32) * LDT + lk) = qa1;
      *(u32x4*)(sB + lr * LDT + lk) = kb0; *(u32x4*)(sB + (lr + 32) * LDT + lk) = kb1;
      *(u32x4*)(sB + (lr + 64) * LDT + lk) = kb2; *(u32x4*)(sB + (lr + 96) * LDT + lk) = kb3;
      __syncthreads();
      if (kt == 0) {
        qa0 = *(const u32x4*)(QC + (long)lr * 512 + 64 + lk); qa1 = *(const u32x4*)(QC + (long)(lr + 32) * 512 + 64 + lk);
        kb0 = *(const u32x4*)(KC + (long)lr * 512 + 64 + lk); kb1 = *(const u32x4*)(KC + (long)(lr + 32) * 512 + 64 + lk);
        kb2 = *(const u32x4*)(KC + (long)(lr + 64) * 512 + 64 + lk); kb3 = *(const u32x4*)(KC + (long)(lr + 96) * 512 + 64 + lk);
      }
      if (!skipS) mma_lds<2, 4, 2>(sA + wr * 32 * LDT, sB + wc * 64 * LDT, acc, lane);
      __syncthreads();
    }
  }
  {
    bf16_t* sS = wc ? sS1 : sS0;
#pragma unroll
    for (int mt = 0; mt < 2; ++mt)
#pragma unroll
      for (int i = 0; i < 4; ++i) {
        int jl = wr * 32 + mt * 16 + q * 4 + i;
        int j = J0 + jl;
        float rj = sRj[j], rs = 0.f;
#pragma unroll
        for (int nt = 0; nt < 4; ++nt) {
          int sl = nt * 16 + r, s = wc * 64 + sl;
          float val = (s <= j) ? acc[mt][nt][i] * __expf(rj + sCs[s]) : 0.f;
          rs += val;
          sS[jl * LDT + sl] = f2bf(val);
        }
        rs = grp16_sum(rs);
        if (r == 0) sDen[wc * 64 + jl] = rs;
      }
  }
#pragma unroll
  for (int mt = 0; mt < 2; ++mt)
#pragma unroll
    for (int nt = 0; nt < 4; ++nt) acc[mt][nt] = f32x4{0.f, 0.f, 0.f, 0.f};
  const bf16_t* vt = (const bf16_t*)(ws + L0_MVT) + (((long)(b * 4 + h) * 128 + (t0 >> 6)) * 128) * 64;
  const float* ct = (const float*)(ws + L0_H) + (long)unit * 16384;
  {
    u32x4 vb0, vb1, vb2, vb3;
    u32x4 qa0, qa1;
    float4 cv[8];
    const int nsteps = u ? 4 : 3;
    auto kind_of = [&](int sidx) { return u ? sidx : (sidx == 0 ? 0 : sidx + 1); };
    auto fetch = [&](int kind) {
      if (kind < 2) {
        const bf16_t* vp = vt + (long)kind * 8192 + lr * 64 + lk;
        vb0 = *(const u32x4*)vp; vb1 = *(const u32x4*)(vp + 32 * 64); vb2 = *(const u32x4*)(vp + 64 * 64); vb3 = *(const u32x4*)(vp + 96 * 64);
      } else {
        const int k2 = kind - 2;
        qa0 = *(const u32x4*)(QC + (long)lr * 512 + k2 * 64 + lk); qa1 = *(const u32x4*)(QC + (long)(lr + 32) * 512 + k2 * 64 + lk);
#pragma unroll
        for (int j = 0; j < 8; ++j) cv[j] = *(const float4*)(ct + (long)((tid >> 4) + 16 * j) * 128 + k2 * 64 + (tid & 15) * 4);
      }
    };
    fetch(0);
#pragma unroll 1
    for (int sidx = 0; sidx < nsteps; ++sidx) {
      const int kind = kind_of(sidx);
      const bf16_t* aS;
      if (kind < 2) {
        *(u32x4*)(sB + lr * LDT + lk) = vb0; *(u32x4*)(sB + (lr + 32) * LDT + lk) = vb1;
        *(u32x4*)(sB + (lr + 64) * LDT + lk) = vb2; *(u32x4*)(sB + (lr + 96) * LDT + lk) = vb3;
        aS = kind ? sS1 : sS0;
      } else {
        const float w0 = sWi[J0 + lr], w1 = sWi[J0 + lr + 32];
        u32x4 o0, o1;
        o0[0] = pack2(lo2f(qa0[0]) * w0, hi2f(qa0[0]) * w0); o0[1] = pack2(lo2f(qa0[1]) * w0, hi2f(qa0[1]) * w0);
        o0[2] = pack2(lo2f(qa0[2]) * w0, hi2f(qa0[2]) * w0); o0[3] = pack2(lo2f(qa0[3]) * w0, hi2f(qa0[3]) * w0);
        o1[0] = pack2(lo2f(qa1[0]) * w1, hi2f(qa1[0]) * w1); o1[1] = pack2(lo2f(qa1[1]) * w1, hi2f(qa1[1]) * w1);
        o1[2] = pack2(lo2f(qa1[2]) * w1, hi2f(qa1[2]) * w1); o1[3] = pack2(lo2f(qa1[3]) * w1, hi2f(qa1[3]) * w1);
        *(u32x4*)(sA + lr * LDT + lk) = o0; *(u32x4*)(sA + (lr + 32) * LDT + lk) = o1;
#pragma unroll
        for (int j = 0; j < 8; ++j) {
          uint2 o;
          o.x = pack2(cv[j].x, cv[j].y);
          o.y = pack2(cv[j].z, cv[j].w);
          *(uint2*)(sB + ((tid >> 4) + 16 * j) * LDT + (tid & 15) * 4) = o;
        }
        aS = sA;
      }
      __syncthreads();
      if (sidx + 1 < nsteps) fetch(kind_of(sidx + 1));
      mma_lds<2, 4, 2>(aS + wr * 32 * LDT, sB + wc * 64 * LDT, acc, lane);
      __syncthreads();
    }
  }
#pragma unroll
  for (int mt = 0; mt < 2; ++mt)
#pragma unroll
    for (int i = 0; i < 4; ++i) {
      int jl = wr * 32 + mt * 16 + q * 4 + i;
      int j = J0 + jl;
      float den = sDen[jl] + sDen[64 + jl] + sWi[j] * sQn[jl];
      float dinv = 1.f / fmaxf(fabsf(den), sEm[j]);
      float ss = 0.f;
#pragma unroll
      for (int nt = 0; nt < 4; ++nt) { float v = acc[mt][nt][i] * dinv; acc[mt][nt][i] = v; ss += v * v; }
      ss = grp16_sum(ss);
      if (r == 0) sSs[wc * 64 + jl] = ss;
    }
  __syncthreads();
  const bf16_t* MO = (const bf16_t*)(ws + L0_MO);
  const bf16_t* MZ = (const bf16_t*)(ws + L0_MZ);
  bf16_t* Y = (bf16_t*)(ws + L0_QKRAW);
  float hn[4];
#pragma unroll
  for (int nt = 0; nt < 4; ++nt) hn[nt] = p.m_hn[h * 128 + wc * 64 + nt * 16 + r];
#pragma unroll
  for (int mt = 0; mt < 2; ++mt) {
    float gv[4][4];
#pragma unroll
    for (int i = 0; i < 4; ++i) {
      long row = R0 + J0 + wr * 32 + mt * 16 + q * 4 + i;
#pragma unroll
      for (int nt = 0; nt < 4; ++nt) {
        int col = h * 128 + wc * 64 + nt * 16 + r;
        gv[i][nt] = bf2f(MO[row * 512 + col]) * bf2f(MZ[row * 512 + col]);
      }
    }
#pragma unroll
    for (int i = 0; i < 4; ++i) {
      int jl = wr * 32 + mt * 16 + q * 4 + i;
      float rinv = rsqrtf((sSs[jl] + sSs[64 + jl]) * (1.f / 128.f) + EPSF);
      long row = R0 + J0 + jl;
#pragma unroll
      for (int nt = 0; nt < 4; ++nt) {
        int col = h * 128 + wc * 64 + nt * 16 + r;
        Y[row * 1024 + col] = f2bf(acc[mt][nt][i] * rinv * hn[nt] * gv[i][nt]);
      }
    }
  }
  __syncthreads();
}

struct NsaSm {
  bf16_t* sK; bf16_t* sV;
  float* sImpA; float* sImpB;
  unsigned* sSel; unsigned* sGrp; unsigned* sUn;
};

DEVI int next_bit(unsigned long long lo, unsigned long long hi, int from) {
  if (from < 64) {
    unsigned long long v = lo & (~0ull << from);
    if (v) return __builtin_ctzll(v);
    if (hi) return 64 + __builtin_ctzll(hi);
    return -1;
  }
  if (from >= 128) return -1;
  unsigned long long v = hi & (~0ull << (from - 64));
  if (v) return 64 + __builtin_ctzll(v);
  return -1;
}

template <int MODE, bool DUMMY = false, class MaskF, class ActF>
DEVI void nsa_branch(const NsaSm& sm, unsigned long long tmlo, unsigned long long tmhi,
                     const bf16_t* Kg, const bf16_t* Vg, long vstep, long ldv,
                     const bf16x8 (&qf)[2][2], f32x4 (&O)[4][2], float (&mrow)[2], float (&lrow)[2], const float (&invl)[2],
                     MaskF mask, ActF actf, int tokbase, int tid) {
  const int lane = tid & 63, r = lane & 15, q = lane >> 4;
  const int lr = tid >> 3, lk = (tid & 7) * 8;
  int j = next_bit(tmlo, tmhi, 0);
  if (j < 0) return;
  u32x4 k0, k1, v0, v1;
  u32x4 k2, k3, v2, v3;
  if (!DUMMY) {
    const bf16_t* kp = Kg + (long)j * 4096 + lr * 64 + lk;
    k0 = *(const u32x4*)kp; k1 = *(const u32x4*)(kp + 32 * 64);
    if (MODE != 1) {
      const bf16_t* vp = Vg + (long)j * vstep + (long)lr * ldv + lk;
      v0 = *(const u32x4*)vp; v1 = *(const u32x4*)(vp + 32 * ldv);
    }
    *(u32x4*)(sm.sK + lr * LDT + lk) = k0; *(u32x4*)(sm.sK + (lr + 32) * LDT + lk) = k1;
    if (MODE != 1) { *(u32x4*)(sm.sV + lr * LDT + lk) = v0; *(u32x4*)(sm.sV + (lr + 32) * LDT + lk) = v1; }
  }
  int j1 = next_bit(tmlo, tmhi, j + 1);
  if (!DUMMY && j1 >= 0) {
    const bf16_t* kp = Kg + (long)j1 * 4096 + lr * 64 + lk;
    k0 = *(const u32x4*)kp; k1 = *(const u32x4*)(kp + 32 * 64);
    if (MODE != 1) {
      const bf16_t* vp = Vg + (long)j1 * vstep + (long)lr * ldv + lk;
      v0 = *(const u32x4*)vp; v1 = *(const u32x4*)(vp + 32 * ldv);
    }
  }
  if (!DUMMY) __syncthreads();
  int buf = 0;
  while (true) {
    const int jn = j1;
    const int j2 = (j1 >= 0) ? next_bit(tmlo, tmhi, j1 + 1) : -1;
    if (!DUMMY && j2 >= 0) {
      const bf16_t* kp = Kg + (long)j2 * 4096 + lr * 64 + lk;
      k2 = *(const u32x4*)kp; k3 = *(const u32x4*)(kp + 32 * 64);
      if (MODE != 1) {
        const bf16_t* vp = Vg + (long)j2 * vstep + (long)lr * ldv + lk;
        v2 = *(const u32x4*)vp; v3 = *(const u32x4*)(vp + 32 * ldv);
      }
    }
    const bf16_t* sK = sm.sK + buf * (64 * LDT);
    const bf16_t* sV = sm.sV + buf * (64 * LDT);
    const bool a0 = actf(0, j), a1 = actf(1, j);
    __builtin_amdgcn_sched_barrier(0);
    if (a0 || a1) {
      const bool full = mask.full(j);
      f32x4 sacc[4][2];
#pragma unroll
      for (int mt = 0; mt < 4; ++mt) { sacc[mt][0] = f32x4{0.f, 0.f, 0.f, 0.f}; sacc[mt][1] = f32x4{0.f, 0.f, 0.f, 0.f}; }
      __builtin_amdgcn_s_setprio(2);
#pragma unroll
      for (int ks = 0; ks < 2; ++ks)
#pragma unroll
        for (int mt = 0; mt < 4; ++mt) {
          bf16x8 a = *(const bf16x8*)(sK + (mt * 16 + r) * LDT + ks * 32 + q * 8);
          if (a0) sacc[mt][0] = __builtin_amdgcn_mfma_f32_16x16x32_bf16(a, qf[0][ks], sacc[mt][0], 0, 0, 0);
          if (a1) sacc[mt][1] = __builtin_amdgcn_mfma_f32_16x16x32_bf16(a, qf[1][ks], sacc[mt][1], 0, 0, 0);
        }
      __builtin_amdgcn_s_setprio(0);
      __builtin_amdgcn_sched_barrier(0);
#pragma unroll
      for (int nt = 0; nt < 2; ++nt) {
        const bool act = nt ? a1 : a0;
        if (act) {
          const bool lb = mask.bit(nt, j);
          if (!full) {
#pragma unroll
            for (int mt = 0; mt < 4; ++mt)
#pragma unroll
              for (int i = 0; i < 4; ++i) sacc[mt][nt][i] = mask.elem(mt * 16 + q * 4 + i, nt, j) ? sacc[mt][nt][i] : NEGS;
          }
          if (MODE != 2) {
            float tmx = fmaxf(fmaxf(sacc[0][nt][0], sacc[0][nt][1]), fmaxf(sacc[0][nt][2], sacc[0][nt][3]));
#pragma unroll
            for (int mt = 1; mt < 4; ++mt)
              tmx = fmaxf(tmx, fmaxf(fmaxf(sacc[mt][nt][0], sacc[mt][nt][1]), fmaxf(sacc[mt][nt][2], sacc[mt][nt][3])));
            if (MaskF::HASBIT) tmx = lb ? tmx : NEGS;
            tmx = fmaxf(tmx, __shfl_xor(tmx, 16));
            tmx = fmaxf(tmx, __shfl_xor(tmx, 32));
            const float mo = mrow[nt];
            const float mn = fmaxf(mo, tmx);
            float mnc = fmaxf(mn, -1e20f);
            if (MaskF::HASBIT) mnc = lb ? mnc : 1e30f;
            mrow[nt] = mn;
            f32x4 psv = f32x4{0.f, 0.f, 0.f, 0.f};
#pragma unroll
            for (int mt = 0; mt < 4; ++mt) {
              f32x4 dd = sacc[mt][nt] - mnc;
              f32x4 pp;
              pp[0] = __builtin_amdgcn_exp2f(dd[0]); pp[1] = __builtin_amdgcn_exp2f(dd[1]);
              pp[2] = __builtin_amdgcn_exp2f(dd[2]); pp[3] = __builtin_amdgcn_exp2f(dd[3]);
              sacc[mt][nt] = pp;
              psv += pp;
            }
            const float ps = (psv[0] + psv[1]) + (psv[2] + psv[3]);
            const float al = __builtin_amdgcn_exp2f(mo - mn);
            lrow[nt] = lrow[nt] * al + ps;
            if (MODE == 0) {
              if (__any(al != 1.f)) {
#pragma unroll
                for (int dt = 0; dt < 4; ++dt) O[dt][nt] *= al;
              }
            }
          } else {
            const float mmc = fmaxf(mrow[nt], -1e20f), il = invl[nt];
            const int tok = tokbase + nt * 4 + (r >> 2);
#pragma unroll
            for (int mt = 0; mt < 4; ++mt) {
              float pp[4];
#pragma unroll
              for (int i = 0; i < 4; ++i) {
                pp[i] = __builtin_amdgcn_exp2f(sacc[mt][nt][i] - mmc) * il;
                sacc[mt][nt][i] = pp[i];
              }
              float mainv = 32.f * (pp[0] + pp[1] + pp[2]) + 16.f * pp[3];
              float carry = 16.f * pp[3];
              mainv += __shfl_xor(mainv, 1); mainv += __shfl_xor(mainv, 2);
              carry += __shfl_xor(carry, 1); carry += __shfl_xor(carry, 2);
              if ((r & 3) == 0) {
                const int mp = j * 16 + mt * 4 + q;
                sm.sImpA[tok * 128 + mp] = mainv;
                if (mp + 1 < 128) sm.sImpB[tok * 128 + mp + 1] = carry;
              }
            }
          }
        }
      }
      __builtin_amdgcn_sched_barrier(0);
      if (MODE != 1) {
        __builtin_amdgcn_s_setprio(2);
#pragma unroll
        for (int ks = 0; ks < 2; ++ks) {
          bf16x8 pb[2];
#pragma unroll
          for (int nt = 0; nt < 2; ++nt) {
            union { u32x4 u; bf16x8 h; } cv;
            cv.u[0] = pack2(sacc[2 * ks][nt][0], sacc[2 * ks][nt][1]);
            cv.u[1] = pack2(sacc[2 * ks][nt][2], sacc[2 * ks][nt][3]);
            cv.u[2] = pack2(sacc[2 * ks + 1][nt][0], sacc[2 * ks + 1][nt][1]);
            cv.u[3] = pack2(sacc[2 * ks + 1][nt][2], sacc[2 * ks + 1][nt][3]);
            pb[nt] = cv.h;
          }
#pragma unroll
          for (int dt = 0; dt < 4; ++dt) {
            union { u32x4 u; bf16x8 h; } av;
            const uint2 lo = *(const uint2*)(sV + (dt * 16 + r) * LDT + (2 * ks) * 16 + q * 4);
            const uint2 hi = *(const uint2*)(sV + (dt * 16 + r) * LDT + (2 * ks + 1) * 16 + q * 4);
            av.u[0] = lo.x; av.u[1] = lo.y; av.u[2] = hi.x; av.u[3] = hi.y;
            if (a0) O[dt][0] = __builtin_amdgcn_mfma_f32_16x16x32_bf16(av.h, pb[0], O[dt][0], 0, 0, 0);
            if (a1) O[dt][1] = __builtin_amdgcn_mfma_f32_16x16x32_bf16(av.h, pb[1], O[dt][1], 0, 0, 0);
          }
        }
        __builtin_amdgcn_s_setprio(0);
      }
    }
    __builtin_amdgcn_sched_barrier(0);
    if (!DUMMY && jn >= 0) {
      bf16_t* dK = sm.sK + (buf ^ 1) * (64 * LDT);
      bf16_t* dV = sm.sV + (buf ^ 1) * (64 * LDT);
      *(u32x4*)(dK + lr * LDT + lk) = k0; *(u32x4*)(dK + (lr + 32) * LDT + lk) = k1;
      if (MODE != 1) { *(u32x4*)(dV + lr * LDT + lk) = v0; *(u32x4*)(dV + (lr + 32) * LDT + lk) = v1; }
    }
    if (!DUMMY) __syncthreads();
    if (jn < 0) break;
    j = jn;
    j1 = j2;
    k0 = k2; k1 = k3; v0 = v2; v1 = v3;
    buf ^= 1;
  }
}

struct MaskC {
      static constexpr bool HASBIT = false;
      int t0_, t1_, tmin_;
      DEVI bool full(int jt) const { return 16 * (jt * 64 + 63) + 31 <= tmin_; }
      DEVI bool bit(int nt, int jt) const { return true; }
      DEVI bool elem(int key, int nt, int jt) const { return 16 * (jt * 64 + key) + 31 <= (nt ? t1_ : t0_); }
};

struct MaskS {
      static constexpr bool HASBIT = true;
      unsigned long long a_lo, a_hi, b_lo, b_hi; int t0_, t1_, cur_;
      DEVI bool full(int jt) const { return jt < cur_; }
      DEVI bool bit(int nt, int jt) const {
        const unsigned long long lo = nt ? b_lo : a_lo, hi = nt ? b_hi : a_hi;
        const unsigned long long wd = (jt < 64) ? (lo >> jt) : (hi >> (jt - 64));
        return (wd & 1ull) != 0ull;
      }
      DEVI bool elem(int key, int nt, int jt) const { return jt * 64 + key <= (nt ? t1_ : t0_); }
};

struct MaskW {
      static constexpr bool HASBIT = false;
      int t0_, t1_, tmin_, tmax_;
      DEVI bool full(int jt) const { return (jt * 64 + 63 <= tmin_) && (tmax_ - jt * 64 < 512); }
      DEVI bool bit(int nt, int jt) const { return true; }
      DEVI bool elem(int key, int nt, int jt) const { const int s_ = jt * 64 + key, t_ = nt ? t1_ : t0_; return (s_ <= t_) && (t_ - s_ < 512); }
};

DEVI void nsa_tile(const Params& p, int tileidx, unsigned char* smem) {
  const int tid = opaque_tid(), lane = tid & 63, w = tid >> 6, r = lane & 15, q = lane >> 4;
  const int bg = tileidx & 3, tt = tileidx >> 2, b = bg >> 1, g = bg & 1, t0 = tt * 32;
  unsigned char* ws = p.ws;
  NsaSm sm;
  sm.sK = (bf16_t*)smem; sm.sV = (bf16_t*)(smem + 18432);
  sm.sImpA = (float*)(smem + 36864); sm.sImpB = (float*)(smem + 53248);
  sm.sSel = (unsigned*)(smem + 69632); sm.sGrp = sm.sSel + 128; sm.sUn = sm.sGrp + 32;
  const int tokbase = 8 * w;
  bf16x8 qf[2][2];
  {
    const bf16_t* qn = (const bf16_t*)(ws + L0_QN) + ((long)bg * 8192 + t0) * 256 + (32 * w + r) * 64 + q * 8;
    qf[0][0] = *(const bf16x8*)(qn); qf[0][1] = *(const bf16x8*)(qn + 32);
    qf[1][0] = *(const bf16x8*)(qn + 16 * 64); qf[1][1] = *(const bf16x8*)(qn + 16 * 64 + 32);
  }
  int tq[2];
  const float* GT = (const float*)(ws + L0_GATES);
#pragma unroll
  for (int nt = 0; nt < 2; ++nt) tq[nt] = t0 + tokbase + nt * 4 + (r >> 2);
#define GATE(nt, k) (GT[((long)b * 8192 + tq[nt]) * 24 + (g * 4 + (r & 3)) * 3 + (k)])
  f32x4 O[4][2];
  f32x4* sOut = (f32x4*)(smem + 36864) + (w * 8) * 64 + lane;
  const int cur = t0 >> 6;
  float mrow[2], lrow[2], invl[2];
  for (int i = tid; i < 32 * 128; i += 256) { sm.sImpA[i] = 0.f; sm.sImpB[i] = 0.f; }
  __syncthreads();
  {
    const int nvmax = (t0 + 31 >= 31) ? (((t0 + 31 - 31) >> 4) + 1) : 0;
    int nkt = (nvmax + 63) >> 6;
    if (nkt > 8) nkt = 8;
    const unsigned long long cm0 = (1ull << nkt) - 1ull;
    const bf16_t* KCMP = (const bf16_t*)(ws + L0_KCMP) + (long)bg * 512 * 64;
    const bf16_t* VCMPT = (const bf16_t*)(ws + L0_VCMPT) + (long)bg * 64 * 512;
    MaskC mk{tq[0], tq[1], t0 + tokbase};
    auto act = [&](int nt, int jt) { return true; };
    mrow[0] = mrow[1] = NEGS; lrow[0] = lrow[1] = 0.f; invl[0] = invl[1] = 0.f;
    nsa_branch<1>(sm, cm0, 0ull, KCMP, VCMPT, 64, 512, qf, O, mrow, lrow, invl, mk, act, tokbase, tid);
#pragma unroll
    for (int nt = 0; nt < 2; ++nt) {
      float l = lrow[nt];
      l += __shfl_xor(l, 16); l += __shfl_xor(l, 32);
      invl[nt] = (l > 0.f) ? 1.f / l : 0.f;
    }
#pragma unroll
    for (int dt = 0; dt < 4; ++dt) { O[dt][0] = f32x4{0.f, 0.f, 0.f, 0.f}; O[dt][1] = f32x4{0.f, 0.f, 0.f, 0.f}; }
    nsa_branch<2>(sm, cm0, 0ull, KCMP, VCMPT, 64, 512, qf, O, mrow, lrow, invl, mk, act, tokbase, tid);
  }
  __syncthreads();
  {
    const int ncand = (cur - 2 > 0) ? cur - 2 : 0;
    const int nf = (cur >= 2) ? 3 : cur + 1;
    const int kk = 16 - nf;
    const int m0i = lane, m1i = lane + 64;
    const bool c0 = (m0i >= 1 && m0i <= cur - 2), c1 = (m1i <= cur - 2);
    for (int tqi = 0; tqi < 8; ++tqi) {
      const int tok = tokbase + tqi;
      bool s0, s1;
      if (ncand <= kk) { s0 = c0; s1 = c1; }
      else {
        const float f0 = sm.sImpA[tok * 128 + m0i] + sm.sImpB[tok * 128 + m0i];
        const float f1 = sm.sImpA[tok * 128 + m1i] + sm.sImpB[tok * 128 + m1i];
        const unsigned k0 = c0 ? (__float_as_uint(f0) + 1u) : 0u;
        const unsigned k1 = c1 ? (__float_as_uint(f1) + 1u) : 0u;
        unsigned prefix = 0u;
        for (int bit = 31; bit >= 0; --bit) {
          const unsigned cand = prefix | (1u << bit);
          const int cnt = __popcll(__ballot(k0 >= cand)) + __popcll(__ballot(k1 >= cand));
          if (cnt >= kk) prefix = cand;
        }
        const bool g0 = k0 > prefix, g1 = k1 > prefix;
        const int ng = __popcll(__ballot(g0)) + __popcll(__ballot(g1));
        const bool e0 = (k0 == prefix), e1 = (k1 == prefix);
        const unsigned long long be0 = __ballot(e0), be1 = __ballot(e1);
        const unsigned long long lm = (1ull << lane) - 1ull;
        const int re0 = __popcll(be0 & lm), re1 = __popcll(be0) + __popcll(be1 & lm);
        const int need = kk - ng;
        s0 = g0 || (e0 && re0 < need);
        s1 = g1 || (e1 && re1 < need);
      }
      s0 = s0 || (m0i == 0) || (m0i == cur) || (m0i == cur - 1);
      s1 = s1 || (m1i == cur) || (m1i == cur - 1);
      const unsigned long long lo = __ballot(s0), hi = __ballot(s1);
      if (lane == 0) {
        sm.sSel[tok * 4 + 0] = (unsigned)lo; sm.sSel[tok * 4 + 1] = (unsigned)(lo >> 32);
        sm.sSel[tok * 4 + 2] = (unsigned)hi; sm.sSel[tok * 4 + 3] = (unsigned)(hi >> 32);
      }
    }
  }
  __syncthreads();
  if (tid < 32) { int gi = tid >> 2, wd = tid & 3; unsigned u = 0; for (int k = 0; k < 4; ++k) u |= sm.sSel[(gi * 4 + k) * 4 + wd]; sm.sGrp[tid] = u; }
  __syncthreads();
  if (tid < 4) { unsigned u = 0; for (int gi = 0; gi < 8; ++gi) u |= sm.sGrp[gi * 4 + tid]; sm.sUn[tid] = u; }
  __syncthreads();
#pragma unroll
  for (int nt = 0; nt < 2; ++nt)
#pragma unroll
    for (int dt = 0; dt < 4; ++dt) sOut[(nt * 4 + dt) * 64] = O[dt][nt] * GATE(nt, 0);
  {
    const bf16_t* KS = (const bf16_t*)(ws + L0_KS) + (long)bg * 8192 * 64;
    const bf16_t* VST = (const bf16_t*)(ws + L0_VST) + (long)bg * 128 * 4096;
    const unsigned long long ulo = (unsigned long long)sm.sUn[0] | ((unsigned long long)sm.sUn[1] << 32);
    const unsigned long long uhi = (unsigned long long)sm.sUn[2] | ((unsigned long long)sm.sUn[3] << 32);
    const int tk0 = tokbase + (r >> 2), tk1 = tokbase + 4 + (r >> 2);
    MaskS mk{(unsigned long long)sm.sSel[tk0 * 4 + 0] | ((unsigned long long)sm.sSel[tk0 * 4 + 1] << 32),
             (unsigned long long)sm.sSel[tk0 * 4 + 2] | ((unsigned long long)sm.sSel[tk0 * 4 + 3] << 32),
             (unsigned long long)sm.sSel[tk1 * 4 + 0] | ((unsigned long long)sm.sSel[tk1 * 4 + 1] << 32),
             (unsigned long long)sm.sSel[tk1 * 4 + 2] | ((unsigned long long)sm.sSel[tk1 * 4 + 3] << 32), tq[0], tq[1], cur};
    unsigned long long g0lo, g0hi, g1lo, g1hi;
    {
      const unsigned* gp = sm.sGrp + (2 * w) * 4;
      g0lo = (unsigned long long)__builtin_amdgcn_readfirstlane(gp[0]) | ((unsigned long long)__builtin_amdgcn_readfirstlane(gp[1]) << 32);
      g0hi = (unsigned long long)__builtin_amdgcn_readfirstlane(gp[2]) | ((unsigned long long)__builtin_amdgcn_readfirstlane(gp[3]) << 32);
      g1lo = (unsigned long long)__builtin_amdgcn_readfirstlane(gp[4]) | ((unsigned long long)__builtin_amdgcn_readfirstlane(gp[5]) << 32);
      g1hi = (unsigned long long)__builtin_amdgcn_readfirstlane(gp[6]) | ((unsigned long long)__builtin_amdgcn_readfirstlane(gp[7]) << 32);
    }
    auto act = [&](int nt, int jt) {
      const unsigned long long lo = nt ? g1lo : g0lo, hi = nt ? g1hi : g0hi;
      const unsigned long long wd = (jt < 64) ? (lo >> jt) : (hi >> (jt - 64));
      return (wd & 1ull) != 0ull;
    };
    mrow[0] = mrow[1] = NEGS; lrow[0] = lrow[1] = 0.f;
#pragma unroll
    for (int dt = 0; dt < 4; ++dt) { O[dt][0] = f32x4{0.f, 0.f, 0.f, 0.f}; O[dt][1] = f32x4{0.f, 0.f, 0.f, 0.f}; }
#ifdef NSA_DUMMY_SEL
    {
      nsa_branch<0, true>(sm, ulo, uhi, KS, VST, 4096, 64, qf, O, mrow, lrow, invl, mk, act, tokbase, tid);
      float chk = lrow[0] + lrow[1];
#pragma unroll
      for (int dt = 0; dt < 4; ++dt) chk += O[dt][0][0] + O[dt][0][1] + O[dt][0][2] + O[dt][0][3] + O[dt][1][0] + O[dt][1][1] + O[dt][1][2] + O[dt][1][3];
      if (chk == 123.456f) sm.sUn[0] = 1u;
      mrow[0] = mrow[1] = NEGS; lrow[0] = lrow[1] = 0.f;
#pragma unroll
      for (int dt = 0; dt < 4; ++dt) { O[dt][0] = f32x4{0.f, 0.f, 0.f, 0.f}; O[dt][1] = f32x4{0.f, 0.f, 0.f, 0.f}; }
      __syncthreads();
    }
#endif
    nsa_branch<0>(sm, ulo, uhi, KS, VST, 4096, 64, qf, O, mrow, lrow, invl, mk, act, tokbase, tid);
#pragma unroll
    for (int nt = 0; nt < 2; ++nt) {
      float l = lrow[nt];
      l += __shfl_xor(l, 16); l += __shfl_xor(l, 32);
      const float f = GATE(nt, 1) * ((l > 0.f) ? 1.f / l : 0.f);
#pragma unroll
      for (int dt = 0; dt < 4; ++dt) sOut[(nt * 4 + dt) * 64] += O[dt][nt] * f;
    }
  }
  {
    const bf16_t* KW = (const bf16_t*)(ws + L0_KW) + (long)bg * 8192 * 64;
    const bf16_t* VWT = (const bf16_t*)(ws + L0_VWT) + (long)bg * 128 * 4096;
    const int jlo = ((t0 - 511 > 0) ? (t0 - 511) : 0) >> 6;
    unsigned long long wlo = 0ull, whi = 0ull;
    for (int jj = jlo; jj <= cur; ++jj) { if (jj < 64) wlo |= (1ull << jj); else whi |= (1ull << (jj - 64)); }
    MaskW mk{tq[0], tq[1], t0 + tokbase, t0 + tokbase + 7};
    auto act = [&](int nt, int jt) { return true; };
    mrow[0] = mrow[1] = NEGS; lrow[0] = lrow[1] = 0.f;
#pragma unroll
    for (int dt = 0; dt < 4; ++dt) { O[dt][0] = f32x4{0.f, 0.f, 0.f, 0.f}; O[dt][1] = f32x4{0.f, 0.f, 0.f, 0.f}; }
    nsa_branch<0>(sm, wlo, whi, KW, VWT, 4096, 64, qf, O, mrow, lrow, invl, mk, act, tokbase, tid);
#pragma unroll
    for (int nt = 0; nt < 2; ++nt) {
      float l = lrow[nt];
      l += __shfl_xor(l, 16); l += __shfl_xor(l, 32);
      const float f = GATE(nt, 2) * ((l > 0.f) ? 1.f / l : 0.f);
#pragma unroll
      for (int dt = 0; dt < 4; ++dt) O[dt][nt] = sOut[(nt * 4 + dt) * 64] + O[dt][nt] * f;
    }
  }
  const bf16_t* NZ = (const bf16_t*)(ws + L0_NZ);
  bf16_t* Y = (bf16_t*)(ws + L0_QKRAW);
  uint2 zzv[2][4];
#pragma unroll
  for (int nt = 0; nt < 2; ++nt)
#pragma unroll
    for (int dt = 0; dt < 4; ++dt)
      zzv[nt][dt] = *(const uint2*)(NZ + ((long)b * 8192 + tq[nt]) * 512 + (g * 4 + (r & 3)) * 64 + dt * 16 + q * 4);
#pragma unroll
  for (int nt = 0; nt < 2; ++nt) {
    const long tok = (long)b * 8192 + tq[nt];
    const int head = g * 4 + (r & 3);
#pragma unroll
    for (int dt = 0; dt < 4; ++dt) {
      const int d = dt * 16 + q * 4;
      const uint2 zz = zzv[nt][dt];
      uint2 o;
      o.x = pack2(O[dt][nt][0] * lo2f(zz.x), O[dt][nt][1] * hi2f(zz.x));
      o.y = pack2(O[dt][nt][2] * lo2f(zz.y), O[dt][nt][3] * hi2f(zz.y));
      *(uint2*)(Y + tok * 1024 + 512 + head * 64 + d) = o;
    }
  }
  __syncthreads();
}

DEVI void hgrn_local(const Params& p, int unit, unsigned char* smem) {
  const int tid = opaque_tid(), lane = tid & 63, w = tid >> 6, wr = w >> 1, wc = w & 1;
  const int bh = unit >> 7, c = unit & 127, b = bh >> 3, h = bh & 7, t0 = c * 64;
  const long R0 = (long)b * 8192 + t0;
  unsigned char* ws = p.ws;
  bf16_t* sA = (bf16_t*)smem;
  bf16_t* sB = (bf16_t*)(smem + 18432);
  float* psum = (float*)(smem + 36864);
  const int cch = tid & 127, half = tid >> 7;
  const float lb = ((const float*)(ws + OFF_LB))[h * 128 + cch];
  const bf16_t* FP = (const bf16_t*)(ws + L1_FP) + R0 * 1024 + h * 128 + cch;
  float sgv[32], lgv[32];
  {
    const bf16_t* vtp = (const bf16_t*)(ws + L1_VT) + (((long)(b * 8 + h) * 128 + c) * 128) * 64 + (tid >> 3) * 64 + (tid & 7) * 8;
    u32x4 t0_ = *(const u32x4*)vtp, t1_ = *(const u32x4*)(vtp + 32 * 64), t2_ = *(const u32x4*)(vtp + 64 * 64), t3_ = *(const u32x4*)(vtp + 96 * 64);
    bf16_t fpr[32];
#pragma unroll
    for (int k = 0; k < 32; ++k) fpr[k] = FP[(long)(half * 32 + k) * 1024];
    {
      bf16_t* sp = sA + (tid >> 3) * LDT + (tid & 7) * 8;
      *(u32x4*)sp = t0_; *(u32x4*)(sp + 32 * LDT) = t1_; *(u32x4*)(sp + 64 * LDT) = t2_; *(u32x4*)(sp + 96 * LDT) = t3_;
    }
#pragma unroll
    for (int k = 0; k < 32; ++k) { sgv[k] = sigm(bf2f(fpr[k])); lgv[k] = __logf(lb + (1.f - lb) * sgv[k]); }
  }
  float sum = 0.f;
#pragma unroll
  for (int k = 0; k < 32; ++k) sum += lgv[k];
  psum[half * 128 + cch] = sum;
  __syncthreads();
  const float bL = psum[cch] + psum[128 + cch];
  float run = half ? psum[cch] : 0.f;
#pragma unroll
  for (int k = 0; k < 32; ++k) {
    run += lgv[k];
    float kk_ = (1.f - lb) * (1.f - sgv[k]);
    sB[cch * LDT + half * 32 + k] = f2bf(kk_ * __expf(bL - run));
  }
  if (half == 0) ((float*)(ws + L1_BL))[(long)unit * 128 + cch] = bL;
  __syncthreads();
  f32x4 acc[4][4];
#pragma unroll
  for (int mt = 0; mt < 4; ++mt)
#pragma unroll
    for (int nt = 0; nt < 4; ++nt) acc[mt][nt] = f32x4{0.f, 0.f, 0.f, 0.f};
  mma_lds_sw<4, 4, 2>(sA + wr * 64 * LDT, sB + wc * 64 * LDT, acc, lane);
#ifndef R9B
#define R9B 1
#endif
  for (int r9_ = 0; r9_ < R9B; ++r9_) {
  bf16_t* st = (bf16_t*)(ws + L1_ST) + (long)unit * 16384;
  const int r = lane & 15, q = lane >> 4;
#pragma unroll
  for (int mt = 0; mt < 4; ++mt) {
    const int v = wr * 64 + mt * 16 + r;
#pragma unroll
    for (int nt = 0; nt < 4; ++nt) {
      uint2 o;
      o.x = pack2(acc[mt][nt][0], acc[mt][nt][1]);
      o.y = pack2(acc[mt][nt][2], acc[mt][nt][3]);
      *(uint2*)(st + v * 128 + wc * 64 + nt * 16 + q * 4) = o;
    }
  }
  }
  __syncthreads();
}

template <bool DUMMY>
DEVI void hgrn_scan(const Params& p) {
  unsigned char* ws = p.ws;
  const float* BL = (const float*)(ws + L1_BL);
  for (int idx = blockIdx.x * 256 + opaque_tid(); idx < 16 * 8192; idx += gridDim.x * 256) {
    const int bh = idx >> 13, pr = idx & 8191;
    const int c2 = (pr & 63) * 2;
    unsigned* ptr = (unsigned*)(ws + L1_ST) + (long)bh * 128 * 8192 + pr;
    const float* blp = BL + (long)bh * 128 * 128 + c2;
    float s0 = 0.f, s1 = 0.f;
    for (int c0 = 0; c0 < 128; c0 += 8) {
      unsigned dv[8]; float2 bl[8];
#pragma unroll
      for (int k = 0; k < 8; ++k) { dv[k] = __builtin_nontemporal_load(ptr + (long)(c0 + k) * 8192); bl[k] = *(const float2*)(blp + (long)(c0 + k) * 128); }
#pragma unroll
      for (int k = 0; k < 8; ++k) {
        if (!DUMMY) __builtin_nontemporal_store(pack2(s0, s1), ptr + (long)(c0 + k) * 8192);
        s0 = __expf(bl[k].x) * s0 + lo2f(dv[k]);
        s1 = __expf(bl[k].y) * s1 + hi2f(dv[k]);
      }
    }
    if (DUMMY && s0 == 123.456f) ptr[0] = pack2(s0, s1);
  }
}

DEVI void hgrn_out(const Params& p, int unit, unsigned char* smem) {
  const int tid = opaque_tid(), lane = tid & 63, w = tid >> 6, wr = w >> 1, wc = w & 1;
  const int r = lane & 15, q = lane >> 4;
  const int bh = unit >> 7, c = unit & 127, b = bh >> 3, h = bh & 7, t0 = c * 64;
  const long R0 = (long)b * 8192 + t0;
  unsigned char* ws = p.ws;
  bf16_t* sQ0 = (bf16_t*)smem; bf16_t* sQ1 = (bf16_t*)(smem + 9216);
  bf16_t* sK0 = (bf16_t*)(smem + 18432); bf16_t* sK1 = (bf16_t*)(smem + 27648);
  bf16_t* sAm = (bf16_t*)(smem + 36864);
  bf16_t* sB = (bf16_t*)(smem + 46080);
  float* psum = (float*)(smem + 64512);
  float* sSs = psum + 256;
  const int cch = tid & 127, half = tid >> 7, cc = cch & 63;
  const float lb = ((const float*)(ws + OFF_LB))[h * 128 + cch];
  const bf16_t* FP = (const bf16_t*)(ws + L1_FP) + R0 * 1024 + h * 128 + cch;
  const bf16_t* Q1 = (const bf16_t*)(ws + L1_Q) + R0 * 1024 + h * 128 + cch;
  const bf16_t* vt = (const bf16_t*)(ws + L1_VT) + (((long)(b * 8 + h) * 128 + c) * 128) * 64;
  const bf16_t* st = (const bf16_t*)(ws + L1_ST) + (long)unit * 16384;
  const int tl_r = tid >> 3, tl_k = (tid & 7) * 8;
  u32x4 vv0, vv1, vv2, vv3, sa0, sa1, sa2, sa3, sb0, sb1, sb2, sb3;
  {
    const bf16_t* vp = vt + tl_r * 64 + tl_k;
    vv0 = *(const u32x4*)vp; vv1 = *(const u32x4*)(vp + 32 * 64); vv2 = *(const u32x4*)(vp + 64 * 64); vv3 = *(const u32x4*)(vp + 96 * 64);
    const bf16_t* sp = st + tl_r * 128 + tl_k;
    sa0 = *(const u32x4*)sp; sa1 = *(const u32x4*)(sp + 32 * 128); sa2 = *(const u32x4*)(sp + 64 * 128); sa3 = *(const u32x4*)(sp + 96 * 128);
    sb0 = *(const u32x4*)(sp + 64); sb1 = *(const u32x4*)(sp + 32 * 128 + 64); sb2 = *(const u32x4*)(sp + 64 * 128 + 64); sb3 = *(const u32x4*)(sp + 96 * 128 + 64);
  }
  float sgv[32], lgv[32];
  bf16_t qr[32];
  {
    bf16_t fpr[32];
#pragma unroll
    for (int k = 0; k < 32; ++k) { fpr[k] = FP[(long)(half * 32 + k) * 1024]; qr[k] = Q1[(long)(half * 32 + k) * 1024]; }
    { bf16_t* dp = sB + tl_r * LDT + tl_k; *(u32x4*)dp = vv0; *(u32x4*)(dp + 32 * LDT) = vv1; *(u32x4*)(dp + 64 * LDT) = vv2; *(u32x4*)(dp + 96 * LDT) = vv3; }
#pragma unroll
    for (int k = 0; k < 32; ++k) { sgv[k] = sigm(bf2f(fpr[k])); lgv[k] = __logf(lb + (1.f - lb) * sgv[k]); }
  }
  float sum = 0.f;
#pragma unroll
  for (int k = 0; k < 32; ++k) sum += lgv[k];
  psum[half * 128 + cch] = sum;
  __syncthreads();
  float run = half ? psum[cch] : 0.f;
  bf16_t* sQ = (cch < 64) ? sQ0 : sQ1;
  bf16_t* sK = (cch < 64) ? sK0 : sK1;
#pragma unroll
  for (int k = 0; k < 32; ++k) {
    const int s_ = half * 32 + k;
    run += lgv[k];
    float kk_ = (1.f - lb) * (1.f - sgv[k]);
    sQ[s_ * LDT + cc] = f2bf(bf2f(qr[k]) * __expf(run));
    sK[s_ * LDT + cc] = f2bf(kk_ * __expf(fminf(-run, 80.f)));
  }
  __syncthreads();
  {
    f32x4 a1[2][2];
#pragma unroll
    for (int mt = 0; mt < 2; ++mt)
#pragma unroll
      for (int nt = 0; nt < 2; ++nt) a1[mt][nt] = f32x4{0.f, 0.f, 0.f, 0.f};
    if (!(wr == 0 && wc == 1)) {
      mma_lds<2, 2, 2>(sQ0 + wr * 32 * LDT, sK0 + wc * 32 * LDT, a1, lane);
      mma_lds<2, 2, 2>(sQ1 + wr * 32 * LDT, sK1 + wc * 32 * LDT, a1, lane);
    }
#pragma unroll
    for (int mt = 0; mt < 2; ++mt)
#pragma unroll
      for (int i = 0; i < 4; ++i) {
        int j = wr * 32 + mt * 16 + q * 4 + i;
#pragma unroll
        for (int nt = 0; nt < 2; ++nt) {
          int s = wc * 32 + nt * 16 + r;
          sAm[j * LDT + s] = f2bf((s <= j) ? a1[mt][nt][i] : 0.f);
        }
      }
  }
  __syncthreads();
  f32x4 o[2][4];
#pragma unroll
  for (int mt = 0; mt < 2; ++mt)
#pragma unroll
    for (int nt = 0; nt < 4; ++nt) o[mt][nt] = f32x4{0.f, 0.f, 0.f, 0.f};
  mma_lds<2, 4, 2>(sAm + wr * 32 * LDT, sB + wc * 64 * LDT, o, lane);
  __syncthreads();
  { bf16_t* dp = sB + tl_r * LDT + tl_k; *(u32x4*)dp = sa0; *(u32x4*)(dp + 32 * LDT) = sa1; *(u32x4*)(dp + 64 * LDT) = sa2; *(u32x4*)(dp + 96 * LDT) = sa3; }
  __syncthreads();
  mma_lds<2, 4, 2>(sQ0 + wr * 32 * LDT, sB + wc * 64 * LDT, o, lane);
  __syncthreads();
  { bf16_t* dp = sB + tl_r * LDT + tl_k; *(u32x4*)dp = sb0; *(u32x4*)(dp + 32 * LDT) = sb1; *(u32x4*)(dp + 64 * LDT) = sb2; *(u32x4*)(dp + 96 * LDT) = sb3; }
  __syncthreads();
  mma_lds<2, 4, 2>(sQ1 + wr * 32 * LDT, sB + wc * 64 * LDT, o, lane);
#pragma unroll
  for (int mt = 0; mt < 2; ++mt)
#pragma unroll
    for (int i = 0; i < 4; ++i) {
      int j = wr * 32 + mt * 16 + q * 4 + i;
      float ss = 0.f;
#pragma unroll
      for (int nt = 0; nt < 4; ++nt) ss += o[mt][nt][i] * o[mt][nt][i];
      ss = grp16_sum(ss);
      if (r == 0) sSs[wc * 64 + j] = ss;
    }
  __syncthreads();
  const bf16_t* Z1 = (const bf16_t*)(ws + L1_Z);
  bf16_t* Y1 = (bf16_t*)(ws + L1_H);
  float hn[4];
#pragma unroll
  for (int nt = 0; nt < 4; ++nt) hn[nt] = p.h_hn[h * 128 + wc * 64 + nt * 16 + r];
#pragma unroll
  for (int mt = 0; mt < 2; ++mt) {
    float zv[4][4];
#pragma unroll
    for (int i = 0; i < 4; ++i) {
      long row = R0 + wr * 32 + mt * 16 + q * 4 + i;
#pragma unroll
      for (int nt = 0; nt < 4; ++nt) zv[i][nt] = bf2f(Z1[row * 1024 + h * 128 + wc * 64 + nt * 16 + r]);
    }
#pragma unroll
    for (int i = 0; i < 4; ++i) {
      int j = wr * 32 + mt * 16 + q * 4 + i;
      float rinv = rsqrtf((sSs[j] + sSs[64 + j]) * (1.f / 128.f) + EPSF);
      long row = R0 + j;
#pragma unroll
      for (int nt = 0; nt < 4; ++nt) {
        int col = h * 128 + wc * 64 + nt * 16 + r;
        Y1[row * 1024 + col] = f2bf(o[mt][nt][i] * rinv * hn[nt] * zv[i][nt]);
      }
    }
  }
  __syncthreads();
}

#define XB_TMO      128
#define XB_XCNT(j)  (256  + 64 * (j))
#define XB_XSUB(j)  (1280 + 64 * (j))
#define XB_XGEN(j)  (2304 + 64 * (j))
#define XB_TOP      3328
#define XB_TOPGEN   3392
#define XCD_BAR_WORDS 3456
#define XB_SPIN_CAP (1u << 22)
DEVI unsigned xb_ld(unsigned* p) { return __hip_atomic_load(p, __ATOMIC_RELAXED, __HIP_MEMORY_SCOPE_AGENT); }
DEVI unsigned xb_add(unsigned* p, unsigned v) { return __hip_atomic_fetch_add(p, v, __ATOMIC_RELAXED, __HIP_MEMORY_SCOPE_AGENT); }
DEVI unsigned xb_xcc_id() { return (unsigned)__builtin_amdgcn_s_getreg((3 << 11) | 20) & 0xFu; }
#define XB_SPIN(cond, bar) do { unsigned _sp = 0; while (cond) { __builtin_amdgcn_s_sleep(1); \
    if ((++_sp & 255u) == 0u) { if (xb_ld(&(bar)[XB_TMO])) break; if (_sp > XB_SPIN_CAP) { atomicAdd(&(bar)[XB_TMO], 1u); break; } } } } while (0)

DEVI void xcd_barrier_complete(unsigned* bar, unsigned x, unsigned& nloc, unsigned& nx) {
  const unsigned G = gridDim.x;
  unsigned sum, cnt, mine, sp = 0u;
  for (;;) {
    sum = 0u; cnt = 0u; mine = 0u;
#pragma unroll
    for (unsigned j = 0; j < 16; ++j) { const unsigned c = xb_ld(&bar[XB_XCNT(j)]); sum += c; cnt += (c > 0u) ? 1u : 0u; mine = (j == x) ? c : mine; }
    if (sum == G) break;
    __builtin_amdgcn_s_sleep(1);
    if ((++sp & 255u) == 0u) { if (xb_ld(&bar[XB_TMO])) break; if (sp > XB_SPIN_CAP) { atomicAdd(&bar[XB_TMO], 1u); break; } }
  }
  nloc = mine > 0u ? mine : 1u; nx = cnt > 0u ? cnt : 1u;
}

DEVI void grid_barrier(unsigned* bar, unsigned xcc, volatile unsigned* st) {
  asm volatile("s_waitcnt vmcnt(0)" ::: "memory");
  __syncthreads();
  if (threadIdx.x == 0) {
    __builtin_amdgcn_s_waitcnt(0);
    unsigned nloc = st[0], nx = st[1];
    if (nloc == 0u) { xcd_barrier_complete(bar, xcc, nloc, nx); st[0] = nloc; st[1] = nx; }
    const unsigned old = xb_add(&bar[XB_XSUB(xcc)], 1u);
    const unsigned gen = old / nloc;
    if (old + 1u == (gen + 1u) * nloc) {
      __builtin_amdgcn_fence(__ATOMIC_RELEASE, "agent");
      asm volatile("s_waitcnt vmcnt(0)" ::: "memory");
      const unsigned og = xb_add(&bar[XB_TOP], 1u);
      const unsigned tg = og / nx;
      if (og + 1u == (tg + 1u) * nx) xb_add(&bar[XB_TOPGEN], 1u);
      else XB_SPIN(xb_ld(&bar[XB_TOPGEN]) == tg, bar);
      __builtin_amdgcn_fence(__ATOMIC_ACQUIRE, "agent");
      xb_add(&bar[XB_XGEN(xcc)], 1u);
      asm volatile("s_waitcnt vmcnt(0)" ::: "memory");
    } else {
      XB_SPIN(xb_ld(&bar[XB_XGEN(xcc)]) == gen, bar);
      __builtin_amdgcn_fence(__ATOMIC_ACQUIRE, "agent");
      asm volatile("s_waitcnt vmcnt(0)" ::: "memory");
    }
  }
  __syncthreads();
}

#ifndef REP_NSA
#define REP_NSA 1
#endif
#ifndef REP_P0
#define REP_P0 1
#endif
#ifndef REP_P1
#define REP_P1 1
#endif
#ifndef REP_P2
#define REP_P2 1
#endif
#ifndef REP_P3
#define REP_P3 1
#endif
#ifndef REP_P4
#define REP_P4 1
#endif
#ifndef REP_P5
#define REP_P5 1
#endif
#ifndef REP_P6
#define REP_P6 1
#endif
#ifndef REP_P7
#define REP_P7 1
#endif
#ifndef REP_P8
#define REP_P8 1
#endif
#ifndef REP_P9
#define REP_P9 1
#endif
#ifndef REP_P10
#define REP_P10 1
#endif
#ifndef REP_P11
#define REP_P11 1
#endif
#ifndef REP_P12
#define REP_P12 1
#endif
#ifndef DBG_STOP
#define DBG_STOP 99
#endif
DEVI void dbg_probe_bf16(const Params& p, size_t off, long n) {
  const bf16_t* b = (const bf16_t*)(p.ws + off);
  for (long i = (long)blockIdx.x * 256 + threadIdx.x; i < 16384L * 1024; i += (long)gridDim.x * 256) {
    float v = bf2f(b[i % n]);
    if (!(v == v) || fabsf(v) > 1e30f) v = 777.f;
    p.out[i] = v;
  }
}
DEVI void dbg_probe_f32(const Params& p, size_t off, long n) {
  const float* b = (const float*)(p.ws + off);
  for (long i = (long)blockIdx.x * 256 + threadIdx.x; i < 16384L * 1024; i += (long)gridDim.x * 256) {
    float v = b[i % n];
    if (!(v == v) || fabsf(v) > 1e30f) v = 777.f;
    p.out[i] = v;
  }
}
DEVI void dbg_probe_combo(const Params& p) {
  const bf16_t* qn = (const bf16_t*)(p.ws + L0_QN);
  const bf16_t* ks = (const bf16_t*)(p.ws + L0_KS);
  const bf16_t* nz = (const bf16_t*)(p.ws + L0_NZ);
  const float* ig = (const float*)(p.ws + L0_IG);
  for (long i = (long)blockIdx.x * 256 + threadIdx.x; i < 16384L * 1024; i += (long)gridDim.x * 256) {
    float v = bf2f(qn[i % (16384L * 512)]) + bf2f(ks[i % (4L * 8192 * 64 * 4)]) + bf2f(nz[i % (16384L * 512)]) + ig[i % (16384L * 32)];
    if (!(v == v) || fabsf(v) > 1e30f) v = 777.f;
    p.out[i] = v;
  }
}
#define DBG_AT(k, stmt) if (DBG_STOP == k) { stmt; return; }

#define GSYNC() grid_barrier(bar_ctr, bar_xcc, bar_st)

__global__ void __launch_bounds__(256, 2) mega(Params p) {
  __shared__ __attribute__((aligned(16))) unsigned char smem[79872];
  cg::grid_group grid = cg::this_grid();
  const int G = gridDim.x, bid = blockIdx.x, tid = threadIdx.x, lane = tid & 63, w = tid >> 6;
  unsigned char* ws = p.ws;
  bf16_t* sA = (bf16_t*)smem;
  bf16_t* sB = (bf16_t*)(smem + 16384);
  unsigned* bar_ctr = (unsigned*)(ws + OFF_BAR);
  __shared__ uint4 xb_words;
  if (tid == 0) xb_words = make_uint4(0u, 0u, 0u, 0u);
  __syncthreads();
  volatile unsigned* bar_st = (volatile unsigned*)&xb_words;
  const unsigned bar_xcc = xb_xcc_id();
  if (tid == 0) (void)xb_add(&bar_ctr[XB_XCNT(bar_xcc)], 1u);
  if (p.ws == nullptr) grid.sync();

#ifdef EXTRA_SYNCS
  for (int e_ = 0; e_ < EXTRA_SYNCS; ++e_) GSYNC();
#endif
  for (int rep_ = 0; rep_ < REP_P0; ++rep_) {
  phase0(p, smem);
  GSYNC();
  }
  DBG_AT(0, dbg_probe_bf16(p, L0_H, 16384L*1024))
  for (int rep_ = 0; rep_ < REP_P1; ++rep_) {
#ifdef USE_G256
  for (int k_ = 0; k_ * (G >> 3) < 8 * 32; ++k_) {
    int tm, tn;
    if (!gemm_tile_xcd256(bid, G, k_, 32, tm, tn)) continue;
    gemm256((const bf16_t*)(ws + L0_H), 1024, (const bf16_t*)(ws + OFF_WIN0), 1024, 1024, tm * 256, tn * 128, sA, (bf16_t*)(smem + 32768),
            [&](f32x4 (&acc)[4][4], int mb, int nb, int ln) { epi_proj0(p, acc, mb, nb, ln); });
  }
  for (int v_ = (bid >> 3); v_ < 48; v_ += (G >> 3)) {
    const int tm = (bid & 7) * 16 + v_ / 3, tn = 32 + v_ % 3;
    gemm128<false>((const bf16_t*)(ws + L0_H), 1024, 16383, (const bf16_t*)(ws + OFF_WIN0), 1024, 4383, 1024, tm * 128, tn * 128, sA, sB,
            [&](f32x4 (&acc)[4][4], int mb, int nb, int ln) { epi_proj0(p, acc, mb, nb, ln); });
  }
#else
  for (int k_ = 0; k_ * (G >> 3) < 16 * 35; ++k_) {
    int tm, tn;
    if (!gemm_tile_xcd(bid, G, k_, 35, tm, tn)) continue;
    gemm128<false>((const bf16_t*)(ws + L0_H), 1024, 16383, (const bf16_t*)(ws + OFF_WIN0), 1024, 4383, 1024, tm * 128, tn * 128, sA, sB,
            [&](f32x4 (&acc)[4][4], int mb, int nb, int ln) { epi_proj0(p, acc, mb, nb, ln); });
  }
#endif
  GSYNC();
  }
  DBG_AT(1, dbg_probe_bf16(p, L0_QKRAW, 16384L*1024)) DBG_AT(101, dbg_probe_combo(p)) DBG_AT(102, dbg_probe_bf16(p, L0_KS, 4L*8192*64*4)) DBG_AT(103, dbg_probe_f32(p, L0_IG, 16384L*4*2+16384L*24)) DBG_AT(104, dbg_probe_bf16(p, L0_MVT, 16384L*512*3))
  for (int rep_ = 0; rep_ < REP_P2; ++rep_) {
  for (int it = bid; it < 128 + 2048; it += G) {
    if (it < 128) {
      int ksp = it >> 5, kv = (it >> 4) & 1, bg = (it >> 2) & 3, tm = it & 3;
      const bf16_t* A = (const bf16_t*)(ws + (kv ? L0_VCRAW : L0_KCRAW)) + (long)bg * 8192 * 64 + ksp * 512;
      const bf16_t* B = (const bf16_t*)(ws + (kv ? OFF_WCV : OFF_WCK)) + ksp * 512;
      gemm128<false>(A, 1024, 510, B, 2048, 127, 512, tm * 128, 0, sA, sB,
              [&](f32x4 (&acc)[4][4], int mb, int nb, int ln) { epi_cmp_hidden(p, acc, mb, nb, ln, kv, bg, ksp); });
    } else {
      conv_tile(p, it - 128, smem);
    }
  }
  GSYNC();
  }
  DBG_AT(2, dbg_probe_bf16(p, L0_QC, 16384L*512*3)) DBG_AT(201, dbg_probe_f32(p, L0_HID, 2L*4*512*128))
  for (int rep_ = 0; rep_ < REP_P3; ++rep_) {
  for (int it = bid; it < 512 + 1024; it += G) {
    if (it < 512) mlstm_local(p, it, smem);
    else { const int t_ = opaque_tid(); cmp_finalize(p, (it - 512) * 4 + (t_ >> 6), t_ & 63); }
  }
  GSYNC();
  }
  DBG_AT(3, dbg_probe_f32(p, L0_H, 512L*16384)) DBG_AT(301, dbg_probe_bf16(p, L0_KCMP, 4L*512*64*2)) DBG_AT(302, dbg_probe_f32(p, L0_DN, 512L*128 + 2048))
  for (int rep_ = 0; rep_ < REP_P4; ++rep_) {
#ifdef DUMMY_P4
  mlstm_scan<true>(p, smem);
  GSYNC();
#endif
  mlstm_scan<false>(p, smem);
  GSYNC();
  }
  DBG_AT(4, dbg_probe_f32(p, L0_H, 512L*16384)) DBG_AT(401, dbg_probe_f32(p, L0_DN, 512L*128 + 3072))
  for (int rep_ = 0; rep_ < REP_P5; ++rep_) {
#ifdef USE_WQ
  {
    unsigned* wq = bar_ctr + 3600;
    volatile unsigned* slot = (volatile unsigned*)&xb_words;
    for (int s_ = 0; s_ < 5; ++s_) {
      const int qi = (s_ < 4) ? (int)((bar_xcc + (unsigned)s_) & 3u) : 4;
      const int qn_ = (s_ < 4) ? 256 : 1024;
      for (;;) {
        if (tid == 0) slot[3] = xb_add(&wq[qi * 64], 1u);
        __syncthreads();
        const int it = (int)slot[3];
        __syncthreads();
        if (it >= qn_) break;
        if (s_ < 4) nsa_tile(p, (255 - it) * 4 + qi, smem);
        else mlstm_out(p, it, smem);
      }
    }
  }
#else
  for (int it = bid; it < 1024 + 1024; it += G) {
    if (it < 1024) {
      int k = it >> 9, i = it & 511;
      int idx = (k & 1) ? (k * 512 + 511 - i) : it;
#ifndef DBG_SKIP_NSA
      for (int r2_ = 0; r2_ < REP_NSA; ++r2_) nsa_tile(p, idx, smem);
#endif
    } else {
#ifndef DBG_SKIP_MOUT
      mlstm_out(p, it - 1024, smem);
#endif
    }
  }
#endif
  GSYNC();
  }
  DBG_AT(5, dbg_probe_bf16(p, L0_QKRAW, 16384L*1024))
  for (int rep_ = 0; rep_ < REP_P6; ++rep_) {
#ifdef USE_G256
  for (int k_ = 0; k_ * (G >> 3) < 8 * 8; ++k_) {
    int tm, tn;
    if (!gemm_tile_xcd256(bid, G, k_, 8, tm, tn)) continue;
    gemm256((const bf16_t*)(ws + L0_QKRAW), 1024, (const bf16_t*)(ws + OFF_WOUT0), 1024, 1024, tm * 256, tn * 128, sA, (bf16_t*)(smem + 32768),
            [&](f32x4 (&acc)[4][4], int mb, int nb, int ln) { epi_out_resid(p.x, p.out, acc, mb, nb, ln); });
  }
#else
  for (int k_ = 0; k_ * (G >> 3) < 16 * 8; ++k_) {
    int tm, tn;
    if (!gemm_tile_xcd(bid, G, k_, 8, tm, tn)) continue;
    gemm128<false>((const bf16_t*)(ws + L0_QKRAW), 1024, 16383, (const bf16_t*)(ws + OFF_WOUT0), 1024, 1023, 1024, tm * 128, tn * 128, sA, sB,
            [&](f32x4 (&acc)[4][4], int mb, int nb, int ln) { epi_out_resid(p.x, p.out, acc, mb, nb, ln); });
  }
#endif
  GSYNC();
  }
  DBG_AT(6, (void)0)
  for (int rep_ = 0; rep_ < REP_P7; ++rep_) {
  { const int t_ = opaque_tid(); for (int row = (bid * 4 + (t_ >> 6)) * 2; row < 16384; row += G * 8) rmsnorm_row2(p.out, p.norm_w + 1024, (bf16_t*)(ws + L1_H), row, row + 1, t_ & 63); }
  GSYNC();
  }
  DBG_AT(7, dbg_probe_bf16(p, L1_H, 16384L*1024))
  for (int rep_ = 0; rep_ < REP_P8; ++rep_) {
#ifdef USE_G256
  for (int k_ = 0; k_ * (G >> 3) < 8 * 32; ++k_) {
    int tm, tn;
    if (!gemm_tile_xcd256(bid, G, k_, 32, tm, tn)) continue;
    gemm256((const bf16_t*)(ws + L1_H), 1024, (const bf16_t*)(ws + OFF_WIN1), 1024, 1024, tm * 256, tn * 128, sA, (bf16_t*)(smem + 32768),
            [&](f32x4 (&acc)[4][4], int mb, int nb, int ln) { epi_proj1(p, acc, mb, nb, ln); });
  }
#else
  for (int k_ = 0; k_ * (G >> 3) < 16 * 32; ++k_) {
    int tm, tn;
    if (!gemm_tile_xcd(bid, G, k_, 32, tm, tn)) continue;
    gemm128<false>((const bf16_t*)(ws + L1_H), 1024, 16383, (const bf16_t*)(ws + OFF_WIN1), 1024, 4095, 1024, tm * 128, tn * 128, sA, sB,
            [&](f32x4 (&acc)[4][4], int mb, int nb, int ln) { epi_proj1(p, acc, mb, nb, ln); });
  }
#endif
  GSYNC();
  }
  DBG_AT(8, dbg_probe_bf16(p, L1_FP, 16384L*1024*4))
  for (int rep_ = 0; rep_ < REP_P9; ++rep_) {
  for (int it = bid; it < 2048; it += G) hgrn_local(p, it, smem);
  GSYNC();
  }
  DBG_AT(9, dbg_probe_bf16(p, L1_ST, 2048L*16384))
  for (int rep_ = 0; rep_ < REP_P10; ++rep_) {
#ifdef DUMMY_P10
  hgrn_scan<true>(p);
  GSYNC();
#endif
  hgrn_scan<false>(p);
  GSYNC();
  }
  DBG_AT(10, dbg_probe_bf16(p, L1_ST, 2048L*16384))
  for (int rep_ = 0; rep_ < REP_P11; ++rep_) {
  for (int it = bid; it < 2048; it += G) hgrn_out(p, it, smem);
  GSYNC();
  }
  DBG_AT(11, dbg_probe_bf16(p, L1_H, 16384L*1024))
  for (int rep_ = 0; rep_ < REP_P12; ++rep_) {
#ifdef USE_G256
  for (int k_ = 0; k_ * (G >> 3) < 8 * 8; ++k_) {
    int tm, tn;
    if (!gemm_tile_xcd256(bid, G, k_, 8, tm, tn)) continue;
    gemm256((const bf16_t*)(ws + L1_H), 1024, (const bf16_t*)(ws + OFF_WOUT1), 1024, 1024, tm * 256, tn * 128, sA, (bf16_t*)(smem + 32768),
            [&](f32x4 (&acc)[4][4], int mb, int nb, int ln) { epi_out_resid(p.out, p.out, acc, mb, nb, ln); });
  }
#else
  for (int k_ = 0; k_ * (G >> 3) < 16 * 8; ++k_) {
    int tm, tn;
    if (!gemm_tile_xcd(bid, G, k_, 8, tm, tn)) continue;
    gemm128<false>((const bf16_t*)(ws + L1_H), 1024, 16383, (const bf16_t*)(ws + OFF_WOUT1), 1024, 1023, 1024, tm * 128, tn * 128, sA, sB,
            [&](f32x4 (&acc)[4][4], int mb, int nb, int ln) { epi_out_resid(p.out, p.out, acc, mb, nb, ln); });
  }
#endif
  }
}

extern "C" void kernel_launch(void* const* d_in, const int* in_sizes, int n_in, void* d_out, int out_size, void* d_ws, size_t ws_size,
                              hipStream_t stream) {
  static int grid_blocks = 0;
  if (!grid_blocks) {
    int dev = 0, cus = 0, per_cu = 0;
    (void)hipGetDevice(&dev);
    (void)hipDeviceGetAttribute(&cus, hipDeviceAttributeMultiprocessorCount, dev);
    (void)hipOccupancyMaxActiveBlocksPerMultiprocessor(&per_cu, mega, 256, 0);
    if (per_cu > 2) per_cu = 2;
    if (per_cu < 1) per_cu = 1;
    grid_blocks = cus * per_cu;
  }
  Params p{};
  const float** pf = (const float**)&p;
  for (int i = 0; i < 22; ++i) pf[i] = (const float*)d_in[i];
  p.out = (float*)d_out;
  p.ws = (unsigned char*)d_ws;
  (void)hipMemsetAsync((unsigned char*)d_ws + OFF_BAR, 0, 16384, stream);
  void* args[] = {&p};
  hipError_t e = hipLaunchCooperativeKernel((void*)mega, dim3(grid_blocks), dim3(256), args, 0, stream);
  if (e != hipSuccess) fprintf(stderr, "cooperative launch failed: %s (grid %d)\n", hipGetErrorString(e), grid_blocks);
}
```

```cpp
#include <hip/hip_runtime.h>
#define USE_G256 1
#define USE_WQ 1
#define USE_WQ1 1
#include <hip/hip_cooperative_groups.h>
#include <stdint.h>
#include <cstdio>
namespace cg = cooperative_groups;

typedef unsigned short bf16_t;
typedef __attribute__((ext_vector_type(8))) short bf16x8;
typedef __attribute__((ext_vector_type(4))) float f32x4;
typedef __attribute__((ext_vector_type(4))) unsigned int u32x4;

#define DEVI __device__ __forceinline__
#define EPSF 1e-6f
#define LDT 72
#define SLD 68
#define NEGS (-1e30f)
#define LAUNDER(ptr) asm volatile("" : "+s"(ptr))

struct Params {
  const float* x; const float* norm_w; const float* ev_w_in; const float* ev_b_in; const float* f_bias;
  const float* conv_w; const float* conv_b; const float* m_hn; const float* q_norm; const float* k_norm;
  const float* ck_pos; const float* ck_w1; const float* ck_w2; const float* cv_pos; const float* cv_w1; const float* cv_w2;
  const float* ev_w_out; const float* od_w_in; const float* od_b_in; const float* lb_logits; const float* h_hn; const float* od_w_out;
  float* out; unsigned char* ws;
};

constexpr size_t MiB = 1048576;
constexpr size_t OFF_WIN0 = 0;
constexpr size_t OFF_WOUT0 = OFF_WIN0 + 4480ull * 1024 * 2;
constexpr size_t OFF_WIN1 = OFF_WOUT0 + 2 * MiB;
constexpr size_t OFF_WOUT1 = OFF_WIN1 + 8 * MiB;
constexpr size_t OFF_WCK = OFF_WOUT1 + 2 * MiB;
constexpr size_t OFF_WCV = OFF_WCK + 512 * 1024;
constexpr size_t OFF_ROPE = OFF_WCV + 512 * 1024;
constexpr size_t OFF_PB = OFF_ROPE + 512 * 1024;
constexpr size_t OFF_LB = OFF_PB + 1024;
constexpr size_t OFF_BAR = OFF_LB + 4096;
constexpr size_t OFF_BASE = 24 * MiB;
constexpr size_t L0_H = OFF_BASE;
constexpr size_t L0_QKRAW = L0_H + 32 * MiB;
constexpr size_t L0_QC = L0_QKRAW + 32 * MiB;
constexpr size_t L0_KC = L0_QC + 16 * MiB;
constexpr size_t L0_KCT = L0_KC + 16 * MiB;
constexpr size_t L0_MVT = L0_KCT + 16 * MiB;
constexpr size_t L0_MO = L0_MVT + 16 * MiB;
constexpr size_t L0_MZ = L0_MO + 16 * MiB;
constexpr size_t L0_QN = L0_MZ + 16 * MiB;
constexpr size_t L0_NZ = L0_QN + 16 * MiB;
constexpr size_t L0_KCRAW = L0_NZ + 16 * MiB;
constexpr size_t L0_VCRAW = L0_KCRAW + 4 * MiB;
constexpr size_t L0_KS = L0_VCRAW + 4 * MiB;
constexpr size_t L0_KW = L0_KS + 4 * MiB;
constexpr size_t L0_VST = L0_KW + 4 * MiB;
constexpr size_t L0_VWT = L0_VST + 4 * MiB;
constexpr size_t L0_HID = L0_VWT + 4 * MiB;
constexpr size_t L0_KCMP = L0_HID + 2 * MiB;
constexpr size_t L0_VCMPT = L0_KCMP + 256 * 1024;
constexpr size_t L0_IG = L0_VCMPT + 256 * 1024;
constexpr size_t L0_LOGF = L0_IG + 256 * 1024;
constexpr size_t L0_GATES = L0_LOGF + 256 * 1024;
constexpr size_t L0_DN = L0_GATES + 1536 * 1024;
constexpr size_t L0_BL = L0_DN + 256 * 1024;
constexpr size_t L0_MLOC = L0_BL + 4096;
constexpr size_t L0_MIN = L0_MLOC + 4096;
constexpr size_t L0_HIDP = L0_MIN + 4096;
constexpr size_t L0_END = L0_HIDP + 8 * MiB;
static_assert(L0_END <= 256 * MiB, "ws overflow L0");
constexpr size_t L1_H = OFF_BASE;
constexpr size_t L1_FP = L1_H + 32 * MiB;
constexpr size_t L1_Q = L1_FP + 32 * MiB;
constexpr size_t L1_VT = L1_Q + 32 * MiB;
constexpr size_t L1_Z = L1_VT + 32 * MiB;
constexpr size_t L1_ST = L1_Z + 32 * MiB;
constexpr size_t L1_BL = L1_ST + 64 * MiB;
constexpr size_t L1_END = L1_BL + 1 * MiB;
static_assert(L1_END <= 256 * MiB, "ws overflow L1");

DEVI int opaque_tid() { int t = threadIdx.x; asm volatile("" : "+v"(t)); return t; }
typedef __bf16 bf16v2_t __attribute__((ext_vector_type(2)));
typedef float f32v2_t __attribute__((ext_vector_type(2)));
DEVI bf16_t f2bf(float f) { __bf16 h = (__bf16)f; return __builtin_bit_cast(unsigned short, h); }
DEVI float bf2f(bf16_t b) { return __uint_as_float(((unsigned)b) << 16); }
DEVI unsigned pack2(float a, float b) { f32v2_t f = {a, b}; bf16v2_t h = __builtin_convertvector(f, bf16v2_t); return __builtin_bit_cast(unsigned, h); }
DEVI float lo2f(unsigned u) { return __uint_as_float(u << 16); }
DEVI float hi2f(unsigned u) { return __uint_as_float(u & 0xffff0000u); }
DEVI float sigm(float x) { return __builtin_amdgcn_rcpf(1.f + __expf(-x)); }
DEVI float siluf(float x) { return x * sigm(x); }
DEVI float wave_sum(float v) { for (int o = 32; o > 0; o >>= 1) v += __shfl_xor(v, o); return v; }
DEVI float grp16_sum(float v) { v += __shfl_xor(v, 1); v += __shfl_xor(v, 2); v += __shfl_xor(v, 4); v += __shfl_xor(v, 8); return v; }

DEVI void wave_scan_sum128(float& a, float& b, int lane) {
  float t = a + b;
  float s = t;
#pragma unroll
  for (int o = 1; o < 64; o <<= 1) { float u = __shfl_up(s, o); if (lane >= o) s += u; }
  const float excl = s - t;
  a = excl + a;
  b = a + b;
}
DEVI void wave_scan_max128(float& a, float& b, int lane) {
  float t = fmaxf(a, b);
  float s = t;
#pragma unroll
  for (int o = 1; o < 64; o <<= 1) { float u = __shfl_up(s, o); if (lane >= o) s = fmaxf(s, u); }
  float prev = __shfl_up(s, 1);
  if (lane == 0) prev = -3.0e38f;
  a = fmaxf(prev, a);
  b = fmaxf(a, b);
}
DEVI float wave_max(float v) { for (int o = 32; o > 0; o >>= 1) v = fmaxf(v, __shfl_xor(v, o)); return v; }
DEVI int oldcol(int n) {
  return n < 2560 ? n : (n < 3840 ? n + 8 : (n < 4352 ? n + 32 : (n < 4360 ? n - 4352 + 2560 : n - 4360 + 3848)));
}

template <int MT, int NTL, int KS>
DEVI void mma_lds(const bf16_t* sA, const bf16_t* sB, f32x4 (&acc)[MT][NTL], int lane, bool neg = false) {
  const int r = lane & 15, q = lane >> 4;
#pragma unroll
  for (int ks = 0; ks < KS; ++ks) {
    bf16x8 a[MT], b[NTL];
#pragma unroll
    for (int mt = 0; mt < MT; ++mt) a[mt] = *(const bf16x8*)(sA + (mt * 16 + r) * LDT + ks * 32 + q * 8);
    if (neg) {
#pragma unroll
      for (int mt = 0; mt < MT; ++mt) a[mt] ^= (short)0x8000;
    }
#pragma unroll
    for (int nt = 0; nt < NTL; ++nt) b[nt] = *(const bf16x8*)(sB + (nt * 16 + r) * LDT + ks * 32 + q * 8);
#pragma unroll
    for (int mt = 0; mt < MT; ++mt)
#pragma unroll
      for (int nt = 0; nt < NTL; ++nt) acc[mt][nt] = __builtin_amdgcn_mfma_f32_16x16x32_bf16(a[mt], b[nt], acc[mt][nt], 0, 0, 0);
  }
}
template <int MT, int NTL, int KS>
DEVI void mma_lds_sw(const bf16_t* sA, const bf16_t* sB, f32x4 (&acc)[MT][NTL], int lane, bool neg = false) {
  const int r = lane & 15, q = lane >> 4;
#pragma unroll
  for (int ks = 0; ks < KS; ++ks) {
    bf16x8 a[MT], b[NTL];
#pragma unroll
    for (int mt = 0; mt < MT; ++mt) a[mt] = *(const bf16x8*)(sA + (mt * 16 + r) * LDT + ks * 32 + q * 8);
    if (neg) {
#pragma unroll
      for (int mt = 0; mt < MT; ++mt) a[mt] ^= (short)0x8000;
    }
#pragma unroll
    for (int nt = 0; nt < NTL; ++nt) b[nt] = *(const bf16x8*)(sB + (nt * 16 + r) * LDT + ks * 32 + q * 8);
#pragma unroll
    for (int mt = 0; mt < MT; ++mt)
#pragma unroll
      for (int nt = 0; nt < NTL; ++nt) acc[mt][nt] = __builtin_amdgcn_mfma_f32_16x16x32_bf16(b[nt], a[mt], acc[mt][nt], 0, 0, 0);
  }
}


template <int MT, int NTL, bool SWAP>
DEVI void mma_swz(const bf16_t* sA, const bf16_t* sB, f32x4 (&acc)[MT][NTL], int lane, bool neg) {
  const int r = lane & 15, q = lane >> 4, r7 = r & 7;
#pragma unroll
  for (int ks = 0; ks < 2; ++ks) {
    bf16x8 a[MT], b[NTL];
    const int co = ((ks * 4 + q) ^ r7) * 8;
#pragma unroll
    for (int mt = 0; mt < MT; ++mt) a[mt] = *(const bf16x8*)(sA + (mt * 16 + r) * 64 + co);
#pragma unroll
    for (int nt = 0; nt < NTL; ++nt) b[nt] = *(const bf16x8*)(sB + (nt * 16 + r) * 64 + co);
    if (neg) {
#pragma unroll
      for (int mt = 0; mt < MT; ++mt) a[mt] ^= (short)0x8000;
    }
#pragma unroll
    for (int mt = 0; mt < MT; ++mt)
#pragma unroll
      for (int nt = 0; nt < NTL; ++nt) {
        if (SWAP) acc[mt][nt] = __builtin_amdgcn_mfma_f32_16x16x32_bf16(b[nt], a[mt], acc[mt][nt], 0, 0, 0);
        else acc[mt][nt] = __builtin_amdgcn_mfma_f32_16x16x32_bf16(a[mt], b[nt], acc[mt][nt], 0, 0, 0);
      }
  }
}

DEVI void load_tile128(bf16_t* s, const bf16_t* g, long ld) {
  const int tid = opaque_tid(), lr = tid >> 3, lk = (tid & 7) * 8;
#pragma unroll
  for (int j = 0; j < 4; ++j) *(uint4*)(s + (lr + 32 * j) * LDT + lk) = *(const uint4*)(g + (long)(lr + 32 * j) * ld + lk);
}
DEVI void load_tile64(bf16_t* s, const bf16_t* g, long ld) {
  const int tid = opaque_tid(), lr = tid >> 3, lk = (tid & 7) * 8;
#pragma unroll
  for (int j = 0; j < 2; ++j) *(uint4*)(s + (lr + 32 * j) * LDT + lk) = *(const uint4*)(g + (long)(lr + 32 * j) * ld + lk);
}

template <bool SWAP, class Epi>
DEVI void gemm128(const bf16_t* A, long lda, int amax, const bf16_t* B, long ldb, int bmax, int K, int m0, int n0,
                  bf16_t* sA, bf16_t* sB, Epi&& epi) {
  const int tid = opaque_tid(), lane = tid & 63, w = tid >> 6, wr = w >> 1, wc = w & 1;
  const int lr = tid >> 3, lk = (tid & 7) * 8;
  const int lsw = (((tid & 7) ^ (lr & 7)) * 8);
  f32x4 acc[4][4];
#pragma unroll
  for (int mt = 0; mt < 4; ++mt)
#pragma unroll
    for (int nt = 0; nt < 4; ++nt) acc[mt][nt] = f32x4{0.f, 0.f, 0.f, 0.f};
  const bf16_t* ap[4];
  const bf16_t* bp[4];
#pragma unroll
  for (int j = 0; j < 4; ++j) {
    int ra = min(m0 + lr + 32 * j, amax);
    ap[j] = A + (long)ra * lda + lk;
    int rb = min(n0 + lr + 32 * j, bmax);
    bp[j] = B + (long)rb * ldb + lk;
  }
#ifndef GEMM_PASSES
#define GEMM_PASSES 1
#endif
  for (int pass_ = 0; pass_ < GEMM_PASSES; ++pass_) {
  u32x4 va0, va1, va2, va3, vb0, vb1, vb2, vb3;
  va0 = *(const u32x4*)(ap[0]); va1 = *(const u32x4*)(ap[1]); va2 = *(const u32x4*)(ap[2]); va3 = *(const u32x4*)(ap[3]);
  vb0 = *(const u32x4*)(bp[0]); vb1 = *(const u32x4*)(bp[1]); vb2 = *(const u32x4*)(bp[2]); vb3 = *(const u32x4*)(bp[3]);
  const int KT = K >> 6;
  *(u32x4*)(sA + (lr + 0) * 64 + lsw) = va0; *(u32x4*)(sA + (lr + 32) * 64 + lsw) = va1;
  *(u32x4*)(sA + (lr + 64) * 64 + lsw) = va2; *(u32x4*)(sA + (lr + 96) * 64 + lsw) = va3;
  *(u32x4*)(sB + (lr + 0) * 64 + lsw) = vb0; *(u32x4*)(sB + (lr + 32) * 64 + lsw) = vb1;
  *(u32x4*)(sB + (lr + 64) * 64 + lsw) = vb2; *(u32x4*)(sB + (lr + 96) * 64 + lsw) = vb3;
  if (KT > 1) {
    va0 = *(const u32x4*)(ap[0] + 64); va1 = *(const u32x4*)(ap[1] + 64); va2 = *(const u32x4*)(ap[2] + 64); va3 = *(const u32x4*)(ap[3] + 64);
    vb0 = *(const u32x4*)(bp[0] + 64); vb1 = *(const u32x4*)(bp[1] + 64); vb2 = *(const u32x4*)(bp[2] + 64); vb3 = *(const u32x4*)(bp[3] + 64);
  }
  __syncthreads();
  for (int kt = 0; kt < KT; ++kt) {
    const int st = (kt & 1) * 16384;
    const int sn = ((kt + 1) & 1) * 16384;
    if (kt + 1 < KT) {
      *(u32x4*)(sA + sn + (lr + 0) * 64 + lsw) = va0; *(u32x4*)(sA + sn + (lr + 32) * 64 + lsw) = va1;
      *(u32x4*)(sA + sn + (lr + 64) * 64 + lsw) = va2; *(u32x4*)(sA + sn + (lr + 96) * 64 + lsw) = va3;
      *(u32x4*)(sB + sn + (lr + 0) * 64 + lsw) = vb0; *(u32x4*)(sB + sn + (lr + 32) * 64 + lsw) = vb1;
      *(u32x4*)(sB + sn + (lr + 64) * 64 + lsw) = vb2; *(u32x4*)(sB + sn + (lr + 96) * 64 + lsw) = vb3;
    }
    if (kt + 2 < KT) {
      const int ko = (kt + 2) * 64;
      va0 = *(const u32x4*)(ap[0] + ko); va1 = *(const u32x4*)(ap[1] + ko); va2 = *(const u32x4*)(ap[2] + ko); va3 = *(const u32x4*)(ap[3] + ko);
      vb0 = *(const u32x4*)(bp[0] + ko); vb1 = *(const u32x4*)(bp[1] + ko); vb2 = *(const u32x4*)(bp[2] + ko); vb3 = *(const u32x4*)(bp[3] + ko);
    }
    __builtin_amdgcn_sched_barrier(0);
    __builtin_amdgcn_s_setprio(2);
    mma_swz<4, 4, SWAP>(sA + st + wr * 64 * 64, sB + st + wc * 64 * 64, acc, lane, (pass_ & 1) != 0);
    __builtin_amdgcn_s_setprio(0);
    __syncthreads();
  }
  }
  epi(acc, m0 + wr * 64, n0 + wc * 64, lane);
}


DEVI bool gemm_tile_xcd(int bid, int G, int k, int NTN, int& tm, int& tn) {
  const int x = bid & 7, per = G >> 3;
  const int u = (bid >> 3) + per * k;
  const int full_groups = NTN >> 3, rem = NTN & 7;
  const int n_full = full_groups * 2 * 64;
  if (u < n_full) {
    const int sb = u >> 6, wi = u & 63;
    const int tg = sb >> 1, th = sb & 1;
    tm = x * 16 + th * 8 + (wi >> 3);
    tn = tg * 8 + (wi & 7);
    return true;
  }
  const int v = u - n_full;
  if (v >= 16 * rem) return false;
  tm = x * 16 + v / rem;
  tn = full_groups * 8 + v % rem;
  return true;
}


template <class Epi>
DEVI void gemm256(const bf16_t* A, long lda, const bf16_t* B, long ldb, int K, int m0, int n0, bf16_t* sA, bf16_t* sB, Epi&& epi) {
  const int tid = opaque_tid(), lane = tid & 63, w = tid >> 6, wr = w >> 1, wc = w & 1;
  const int lr = tid >> 3, lk = (tid & 7) * 8;
  const int lsw = (((tid & 7) ^ (lr & 7)) * 8);
  const int r = lane & 15, q = lane >> 4, r7 = r & 7;
  f32x4 acc[2][4][4];
#pragma unroll
  for (int hh = 0; hh < 2; ++hh)
#pragma unroll
    for (int mt = 0; mt < 4; ++mt)
#pragma unroll
      for (int nt = 0; nt < 4; ++nt) acc[hh][mt][nt] = f32x4{0.f, 0.f, 0.f, 0.f};
  const bf16_t* abase = A + (long)(m0 + lr) * lda + lk;
  const bf16_t* bbase = B + (long)(n0 + lr) * ldb + lk;
  u32x4 va[8], vb[4];
#pragma unroll
  for (int j = 0; j < 8; ++j) va[j] = *(const u32x4*)(abase + (long)(32 * j) * lda);
#pragma unroll
  for (int j = 0; j < 4; ++j) vb[j] = *(const u32x4*)(bbase + (long)(32 * j) * ldb);
  const int KT = K >> 6;
  for (int kt = 0; kt < KT; ++kt) {
#pragma unroll
    for (int j = 0; j < 8; ++j) *(u32x4*)(sA + (lr + 32 * j) * 64 + lsw) = va[j];
#pragma unroll
    for (int j = 0; j < 4; ++j) *(u32x4*)(sB + (lr + 32 * j) * 64 + lsw) = vb[j];
    __syncthreads();
    if (kt + 1 < KT) {
      const int ko = (kt + 1) * 64;
#pragma unroll
      for (int j = 0; j < 8; ++j) va[j] = *(const u32x4*)(abase + (long)(32 * j) * lda + ko);
#pragma unroll
      for (int j = 0; j < 4; ++j) vb[j] = *(const u32x4*)(bbase + (long)(32 * j) * ldb + ko);
    }
    __builtin_amdgcn_sched_barrier(0);
    __builtin_amdgcn_s_setprio(2);
#pragma unroll
    for (int ks = 0; ks < 2; ++ks) {
      const int co = ((ks * 4 + q) ^ r7) * 8;
      bf16x8 b[4];
#pragma unroll
      for (int nt = 0; nt < 4; ++nt) b[nt] = *(const bf16x8*)(sB + (wc * 64 + nt * 16 + r) * 64 + co);
#pragma unroll
      for (int hh = 0; hh < 2; ++hh) {
        bf16x8 a[4];
#pragma unroll
        for (int mt = 0; mt < 4; ++mt) a[mt] = *(const bf16x8*)(sA + (wr * 128 + hh * 64 + mt * 16 + r) * 64 + co);
#pragma unroll
        for (int mt = 0; mt < 4; ++mt)
#pragma unroll
          for (int nt = 0; nt < 4; ++nt) acc[hh][mt][nt] = __builtin_amdgcn_mfma_f32_16x16x32_bf16(a[mt], b[nt], acc[hh][mt][nt], 0, 0, 0);
      }
    }
    __builtin_amdgcn_s_setprio(0);
    __syncthreads();
  }
  epi(acc[0], m0 + wr * 128, n0 + wc * 64, lane);
  epi(acc[1], m0 + wr * 128 + 64, n0 + wc * 64, lane);
}

DEVI bool gemm_tile_xcd256(int bid, int G, int k, int NTN, int& tm, int& tn) {
  const int x = bid & 7, per = G >> 3;
  const int u = (bid >> 3) + per * k;
  if (u >= 8 * NTN) return false;
  const int tg = u >> 6, wi = u & 63;
  tm = x * 8 + (wi >> 3);
  tn = tg * 8 + (wi & 7);
  return true;
}

DEVI void transpose_tile(const float* src, int N, int ldsrc, bf16_t* dst, int K, int ktile, int ntile, bool perm, float* sT) {
  const int tid = opaque_tid();
  const int k0 = ktile * 64, n0 = ntile * 64;
#pragma unroll
  for (int j = 0; j < 4; ++j) {
    int idx = tid + 256 * j;
    int kk = idx >> 4, n4 = (idx & 15) * 4;
    int n = n0 + n4;
    float4 v = make_float4(0.f, 0.f, 0.f, 0.f);
    if (n < N) { int oc = perm ? oldcol(n) : n; const f32x4 t_ = __builtin_nontemporal_load((const f32x4*)(src + (long)(k0 + kk) * ldsrc + oc)); v = make_float4(t_[0], t_[1], t_[2], t_[3]); }
    sT[kk * 65 + n4 + 0] = v.x; sT[kk * 65 + n4 + 1] = v.y; sT[kk * 65 + n4 + 2] = v.z; sT[kk * 65 + n4 + 3] = v.w;
  }
  __syncthreads();
#pragma unroll
  for (int j = 0; j < 2; ++j) {
    int idx = tid + 256 * j;
    int nn = idx >> 3, kc = (idx & 7) * 8;
    if (n0 + nn < N) {
      uint4 o;
      o.x = pack2(sT[(kc + 0) * 65 + nn], sT[(kc + 1) * 65 + nn]);
      o.y = pack2(sT[(kc + 2) * 65 + nn], sT[(kc + 3) * 65 + nn]);
      o.z = pack2(sT[(kc + 4) * 65 + nn], sT[(kc + 5) * 65 + nn]);
      o.w = pack2(sT[(kc + 6) * 65 + nn], sT[(kc + 7) * 65 + nn]);
      *(uint4*)(dst + (long)(n0 + nn) * K + k0 + kc) = o;
    }
  }
  __syncthreads();
}

DEVI void rmsnorm_row2(const float* X, const float* w, bf16_t* H, int row0, int row1, int lane) {
  const float4* xa = (const float4*)(X + (long)row0 * 1024);
  const float4* xb = (const float4*)(X + (long)row1 * 1024);
  float4 va[4], vb[4], ww[4];
#pragma unroll
  for (int j = 0; j < 4; ++j) {
    const f32x4 ta_ = __builtin_nontemporal_load((const f32x4*)(xa + lane + 64 * j));
    const f32x4 tb_ = __builtin_nontemporal_load((const f32x4*)(xb + lane + 64 * j));
    va[j] = make_float4(ta_[0], ta_[1], ta_[2], ta_[3]); vb[j] = make_float4(tb_[0], tb_[1], tb_[2], tb_[3]);
    ww[j] = ((const float4*)w)[lane + 64 * j];
  }
  float sa = 0.f, sb = 0.f;
#pragma unroll
  for (int j = 0; j < 4; ++j) {
    sa += va[j].x * va[j].x + va[j].y * va[j].y + va[j].z * va[j].z + va[j].w * va[j].w;
    sb += vb[j].x * vb[j].x + vb[j].y * vb[j].y + vb[j].z * vb[j].z + vb[j].w * vb[j].w;
  }
  sa = wave_sum(sa); sb = wave_sum(sb);
  const float ra = rsqrtf(sa * (1.f / 1024.f) + EPSF), rb = rsqrtf(sb * (1.f / 1024.f) + EPSF);
#pragma unroll
  for (int j = 0; j < 4; ++j) {
    uint2 o;
    o.x = pack2(va[j].x * ra * ww[j].x, va[j].y * ra * ww[j].y);
    o.y = pack2(va[j].z * ra * ww[j].z, va[j].w * ra * ww[j].w);
    *(uint2*)(H + (long)row0 * 1024 + (lane + 64 * j) * 4) = o;
    o.x = pack2(vb[j].x * rb * ww[j].x, vb[j].y * rb * ww[j].y);
    o.y = pack2(vb[j].z * rb * ww[j].z, vb[j].w * rb * ww[j].w);
    *(uint2*)(H + (long)row1 * 1024 + (lane + 64 * j) * 4) = o;
  }
}

DEVI void phase0(const Params& p, unsigned char* smem) {
  const int G = gridDim.x, bid = blockIdx.x, tid = threadIdx.x, lane = tid & 63, w = tid >> 6;
  unsigned char* ws = p.ws;
  float* sT = (float*)smem;
  for (int it = bid; it < 69 * 16; it += G) transpose_tile(p.ev_w_in, 4384, 4384, (bf16_t*)(ws + OFF_WIN0), 1024, it / 69, it % 69, true, sT);
  for (int it = bid; it < 16 * 16; it += G) transpose_tile(p.ev_w_out, 1024, 1024, (bf16_t*)(ws + OFF_WOUT0), 1024, it / 16, it % 16, false, sT);
  for (int it = bid; it < 64 * 16; it += G) transpose_tile(p.od_w_in, 4096, 4096, (bf16_t*)(ws + OFF_WIN1), 1024, it / 64, it % 64, false, sT);
  for (int it = bid; it < 16 * 16; it += G) transpose_tile(p.od_w_out, 1024, 1024, (bf16_t*)(ws + OFF_WOUT1), 1024, it / 16, it % 16, false, sT);
  for (int it = bid; it < 2 * 32; it += G) transpose_tile(p.ck_w1, 128, 128, (bf16_t*)(ws + OFF_WCK), 2048, it / 2, it % 2, false, sT);
  for (int it = bid; it < 2 * 32; it += G) transpose_tile(p.cv_w1, 128, 128, (bf16_t*)(ws + OFF_WCV), 2048, it / 2, it % 2, false, sT);
  for (int row = (bid * 4 + w) * 2; row < 16384; row += G * 8) rmsnorm_row2(p.x, p.norm_w, (bf16_t*)(ws + L0_H), row, row + 1, lane);
  for (int idx = bid * 256 + tid; idx < 8192 * 8; idx += G * 256) {
    int t = idx >> 3, i = idx & 7;
    float invf = powf(500000.0f, -(float)i / 8.0f);
    float ang = (float)t * invf;
    double a = (double)ang;
    float2 cs;
    cs.x = (float)cos(a);
    cs.y = (float)sin(a);
    ((float2*)(ws + OFF_ROPE))[idx] = cs;
  }
  for (int o = bid * 4 + w; o < 256; o += G * 4) {
    int kv = o >> 7, j = o & 127;
    const float* pos = kv ? p.cv_pos : p.ck_pos;
    const float* w1 = kv ? p.cv_w1 : p.ck_w1;
    float sacc_ = 0.f;
#pragma unroll 8
    for (int i = lane; i < 2048; i += 64) sacc_ += pos[i] * w1[i * 128 + j];
    sacc_ = wave_sum(sacc_);
    if (lane == 0) ((float*)(ws + OFF_PB))[o] = sacc_;
  }
  if (bid == G - 2 || G < 2) {
    for (int c = tid; c < 1024; c += 256) {
      float l0 = p.lb_logits[c], l1 = p.lb_logits[1024 + c];
      ((float*)(ws + OFF_LB))[c] = 1.f / (1.f + expf(l1 - l0));
    }
  }
}

template <int MODE>
DEVI void store_rm(bf16_t* dst, int ld, int colbase, f32x4 (&acc)[4][4], const float* bias, int mb, int lane) {
  const int r = lane & 15, q = lane >> 4;
#pragma unroll
  for (int mt = 0; mt < 4; ++mt)
#pragma unroll
    for (int i = 0; i < 4; ++i) {
      long row = mb + mt * 16 + q * 4 + i;
#pragma unroll
      for (int nt = 0; nt < 4; ++nt) {
        float v = acc[mt][nt][i] + bias[nt];
        if (MODE == 1) v = sigm(v);
        if (MODE == 2) v = siluf(v);
        dst[row * ld + colbase + nt * 16 + r] = f2bf(v);
      }
    }
}
template <int MODE>
DEVI void store_T(bf16_t* dst, int bgrp, int F, int featoff, f32x4 (&acc)[4][4], const float* bias, int tl0, int lane) {
  const int r = lane & 15, q = lane >> 4;
#pragma unroll
  for (int mt = 0; mt < 4; ++mt)
#pragma unroll
    for (int nt = 0; nt < 4; ++nt) {
      int t = tl0 + mt * 16 + q * 4;
      float b = bias[nt];
      uint2 o;
      o.x = pack2(acc[mt][nt][0] + b, acc[mt][nt][1] + b);
      o.y = pack2(acc[mt][nt][2] + b, acc[mt][nt][3] + b);
      *(uint2*)(dst + (((long)bgrp * 128 + (t >> 6)) * F + featoff + nt * 16 + r) * 64 + (t & 63)) = o;
    }
}
DEVI void norm_rope_store(bf16_t* dst, long rowbase, int ld, int colbase, f32x4 (&acc)[4][4], const float* bias, const float* nw,
                          float scale, const float2* rope, int mb, int lane) {
  const int r = lane & 15, q = lane >> 4;
  float wv[4];
#pragma unroll
  for (int nt = 0; nt < 4; ++nt) wv[nt] = nw[nt * 16 + r];
  float2 csv[4][4];
#pragma unroll
  for (int mt = 0; mt < 4; ++mt)
#pragma unroll
    for (int i = 0; i < 4; ++i) csv[mt][i] = rope[((mb + mt * 16 + q * 4 + i) & 8191) * 8 + (r & 7)];
#pragma unroll
  for (int mt = 0; mt < 4; ++mt)
#pragma unroll
    for (int i = 0; i < 4; ++i) {
      int row = mb + mt * 16 + q * 4 + i;
      int t = row & 8191;
      float v[4];
      float ss = 0.f;
#pragma unroll
      for (int nt = 0; nt < 4; ++nt) { v[nt] = acc[mt][nt][i] + bias[nt]; ss += v[nt] * v[nt]; }
      ss = grp16_sum(ss);
      float rinv = rsqrtf(ss * (1.f / 64.f) + EPSF);
#pragma unroll
      for (int nt = 0; nt < 4; ++nt) v[nt] = v[nt] * rinv * wv[nt];
      float partner = __shfl_xor(v[0], 8);
      float2 cs = csv[mt][i];
      float x1 = (r < 8) ? v[0] : partner, x2 = (r < 8) ? partner : v[0];
      v[0] = (r < 8) ? (x1 * cs.x - x2 * cs.y) : (x1 * cs.y + x2 * cs.x);
#pragma unroll
      for (int nt = 0; nt < 4; ++nt) dst[(rowbase + t) * ld + colbase + nt * 16 + r] = f2bf(v[nt] * scale);
    }
}

DEVI void epi_proj0(const Params& p, f32x4 (&acc)[4][4], int mb, int nb, int lane) {
  if (nb >= 4384) return;
  unsigned char* ws = p.ws;
  const int r = lane & 15, q = lane >> 4;
  float bias[4];
#pragma unroll
  for (int nt = 0; nt < 4; ++nt) { int n = nb + nt * 16 + r; bias[nt] = (n < 4384) ? p.ev_b_in[oldcol(n)] : 0.f; }
  const int b = mb >> 13;
  const int tl0 = mb & 8191;
  const float2* rope = (const float2*)(ws + OFF_ROPE);
  if (nb < 1024) {
    store_rm<0>((bf16_t*)(ws + L0_QKRAW), 1024, nb, acc, bias, mb, lane);
  } else if (nb < 1536) {
    store_T<0>((bf16_t*)(ws + L0_MVT), b * 4 + ((nb - 1024) >> 7), 128, (nb - 1024) & 127, acc, bias, tl0, lane);
  } else if (nb < 2048) {
    store_rm<1>((bf16_t*)(ws + L0_MO), 512, nb - 1536, acc, bias, mb, lane);
  } else if (nb < 2560) {
    store_rm<2>((bf16_t*)(ws + L0_MZ), 512, nb - 2048, acc, bias, mb, lane);
  } else if (nb < 3072) {
    int head = (nb - 2560) >> 6, g = head >> 2, rr = head & 3;
    norm_rope_store((bf16_t*)(ws + L0_QN), (long)(b * 2 + g) * 8192, 256, rr * 64, acc, bias, p.q_norm, 0.125f * 1.4426950408889634f, rope, mb, lane);
  } else if (nb < 3328) {
    int g = ((nb - 3072) >> 6) & 1;
    bf16_t* dst = (bf16_t*)(ws + (nb < 3200 ? L0_KCRAW : L0_VCRAW));
    const long rowbase = (long)(b * 2 + g) * 8192;
#pragma unroll
    for (int mt = 0; mt < 4; ++mt)
#pragma unroll
      for (int i = 0; i < 4; ++i) {
        int t = (mb + mt * 16 + q * 4 + i) & 8191;
#pragma unroll
        for (int nt = 0; nt < 4; ++nt) dst[(rowbase + t) * 64 + nt * 16 + r] = f2bf(acc[mt][nt][i] + bias[nt]);
      }
  } else if (nb < 3456) {
    int g = (nb - 3328) >> 6;
    norm_rope_store((bf16_t*)(ws + L0_KS), (long)(b * 2 + g) * 8192, 64, 0, acc, bias, p.k_norm + 64, 1.f, rope, mb, lane);
  } else if (nb < 3584) {
    store_T<0>((bf16_t*)(ws + L0_VST), b * 2 + ((nb - 3456) >> 6), 64, 0, acc, bias, tl0, lane);
  } else if (nb < 3712) {
    int g = (nb - 3584) >> 6;
    norm_rope_store((bf16_t*)(ws + L0_KW), (long)(b * 2 + g) * 8192, 64, 0, acc, bias, p.k_norm + 128, 1.f, rope, mb, lane);
  } else if (nb < 3840) {
    store_T<0>((bf16_t*)(ws + L0_VWT), b * 2 + ((nb - 3712) >> 6), 64, 0, acc, bias, tl0, lane);
  } else if (nb < 4352) {
    store_rm<2>((bf16_t*)(ws + L0_NZ), 512, nb - 3840, acc, bias, mb, lane);
  } else {
    float* IG = (float*)(ws + L0_IG);
    float* LF = (float*)(ws + L0_LOGF);
    float* GT = (float*)(ws + L0_GATES);
#pragma unroll
    for (int mt = 0; mt < 4; ++mt)
#pragma unroll
      for (int i = 0; i < 4; ++i) {
        long row = mb + mt * 16 + q * 4 + i;
#pragma unroll
        for (int nt = 0; nt < 2; ++nt) {
          int c = nt * 16 + r;
          float v = acc[mt][nt][i] + bias[nt];
          if (c < 4) IG[row * 4 + c] = v;
          else if (c < 8) { float xx = v + p.f_bias[c - 4]; LF[row * 4 + c - 4] = fminf(xx, 0.f) - log1pf(__expf(-fabsf(xx))); }
          else GT[row * 24 + c - 8] = sigm(v);
        }
      }
  }
}

DEVI void epi_cmp_hidden(const Params& p, f32x4 (&acc)[4][4], int mb, int nb, int lane, int kv, int bg, int ksp) {
  const int r = lane & 15, q = lane >> 4;
  float* hid = (float*)(p.ws + L0_HIDP) + ((long)((ksp * 2 + kv) * 4 + bg) * 512) * 128;
#pragma unroll
  for (int mt = 0; mt < 4; ++mt)
#pragma unroll
    for (int i = 0; i < 4; ++i) {
      int row = mb + mt * 16 + q * 4 + i;
#pragma unroll
      for (int nt = 0; nt < 4; ++nt) hid[(long)row * 128 + nb + nt * 16 + r] = acc[mt][nt][i];
    }
}

DEVI void epi_out_resid(const float* resid, float* out, f32x4 (&acc)[4][4], int mb, int nb, int lane) {
  const int r = lane & 15, q = lane >> 4;
#pragma unroll
  for (int mt = 0; mt < 4; ++mt) {
    float rv[4][4];
#pragma unroll
    for (int i = 0; i < 4; ++i)
#pragma unroll
      for (int nt = 0; nt < 4; ++nt) rv[i][nt] = resid[(long)(mb + mt * 16 + q * 4 + i) * 1024 + nb + nt * 16 + r];
#pragma unroll
    for (int i = 0; i < 4; ++i)
#pragma unroll
      for (int nt = 0; nt < 4; ++nt) out[(long)(mb + mt * 16 + q * 4 + i) * 1024 + nb + nt * 16 + r] = rv[i][nt] + acc[mt][nt][i];
  }
}

DEVI void epi_proj1(const Params& p, f32x4 (&acc)[4][4], int mb, int nb, int lane) {
  unsigned char* ws = p.ws;
  const int r = lane & 15;
  float bias[4];
#pragma unroll
  for (int nt = 0; nt < 4; ++nt) bias[nt] = p.od_b_in[nb + nt * 16 + r];
  const int b = mb >> 13, tl0 = mb & 8191;
  if (nb < 1024) store_rm<0>((bf16_t*)(ws + L1_FP), 1024, nb, acc, bias, mb, lane);
  else if (nb < 2048) store_T<0>((bf16_t*)(ws + L1_VT), b * 8 + ((nb - 1024) >> 7), 128, (nb - 1024) & 127, acc, bias, tl0, lane);
  else if (nb < 3072) store_rm<2>((bf16_t*)(ws + L1_Q), 1024, nb - 2048, acc, bias, mb, lane);
  else store_rm<2>((bf16_t*)(ws + L1_Z), 1024, nb - 3072, acc, bias, mb, lane);
}

DEVI void conv_tile(const Params& p, int item, unsigned char* smem) {
  const int tid = opaque_tid();
  const int ctile = item & 7, ttile = item >> 3;
  const int t0g = ttile * 64;
  const int b = t0g >> 13, tl0 = t0g & 8191;
  unsigned char* ws = p.ws;
  float* sRaw = (float*)smem;
  bf16_t* sOutT = (bf16_t*)(smem + 67 * 128 * 4);
  const bf16_t* raw = (const bf16_t*)(ws + L0_QKRAW);
  for (int idx = tid; idx < 67 * 16; idx += 256) {
    int rr = idx >> 4, ch = (idx & 15) * 8;
    int tl = tl0 + rr - 3;
    uint4 v = make_uint4(0, 0, 0, 0);
    if (tl >= 0) v = *(const uint4*)(raw + (long)(b * 8192 + tl) * 1024 + ctile * 128 + ch);
    float* d = sRaw + rr * 128 + ch;
    d[0] = lo2f(v.x); d[1] = hi2f(v.x); d[2] = lo2f(v.y); d[3] = hi2f(v.y);
    d[4] = lo2f(v.z); d[5] = hi2f(v.z); d[6] = lo2f(v.w); d[7] = hi2f(v.w);
  }
  __syncthreads();
  const int c = tid & 127, th = tid >> 7;
  const int cg_ = ctile * 128 + c;
  const float w0 = p.conv_w[cg_], w1 = p.conv_w[1024 + cg_], w2 = p.conv_w[2048 + cg_], w3 = p.conv_w[3072 + cg_];
  const float cb = p.conv_b[cg_];
  const bool isk = ctile >= 4;
  bf16_t* dst = (bf16_t*)(ws + (isk ? L0_KC : L0_QC));
  const int cc = isk ? cg_ - 512 : cg_;
  const float sc = isk ? 0.08838834764831845f : 1.f;
  for (int t = th * 32; t < th * 32 + 32; ++t) {
    float a = cb + w0 * sRaw[t * 128 + c] + w1 * sRaw[(t + 1) * 128 + c] + w2 * sRaw[(t + 2) * 128 + c] + w3 * sRaw[(t + 3) * 128 + c];
    bf16_t o = f2bf(siluf(a) * sc);
    dst[(long)(t0g + t) * 512 + cc] = o;
    sOutT[c * LDT + t] = o;
  }
  __syncthreads();
  if (isk) {
    bf16_t* kct = (bf16_t*)(ws + L0_KCT);
#pragma unroll
    for (int j = 0; j < 4; ++j) {
      int idx = tid + 256 * j;
      int cr = idx >> 3, tc = (idx & 7) * 8;
      *(uint4*)(kct + ((((long)(b * 4 + (ctile - 4)) * 128 + (tl0 >> 6)) * 128 + cr) * 64) + tc) = *(const uint4*)(sOutT + cr * LDT + tc);
    }
  }
  __syncthreads();
}

DEVI void cmp_finalize(const Params& p, int task, int lane) {
  const int n = task & 511, bg = (task >> 9) & 3, kv = task >> 11;
  unsigned char* ws = p.ws;
  bf16_t* KCMP = (bf16_t*)(ws + L0_KCMP);
  bf16_t* VCMPT = (bf16_t*)(ws + L0_VCMPT);
  if (n == 511) {
    if (kv == 0) KCMP[((long)bg * 512 + 511) * 64 + lane] = 0;
    else VCMPT[((long)bg * 64 + lane) * 512 + 511] = 0;
    return;
  }
  const float* hid = (const float*)(ws + L0_HIDP) + ((long)(kv * 4 + bg) * 512 + n) * 128;
  const float* pbv = (const float*)(ws + OFF_PB) + kv * 128;
  const float* w2 = kv ? p.cv_w2 : p.ck_w2;
  float g0, g1;
  {
    float x0 = ((hid[lane] + hid[lane + 524288]) + (hid[lane + 2 * 524288] + hid[lane + 3 * 524288])) + pbv[lane];
    float x1 = ((hid[lane + 64] + hid[lane + 64 + 524288]) + (hid[lane + 64 + 2 * 524288] + hid[lane + 64 + 3 * 524288])) + pbv[lane + 64];
    g0 = 0.5f * x0 * (1.f + tanhf(0.7978845608028654f * (x0 + 0.044715f * x0 * x0 * x0)));
    g1 = 0.5f * x1 * (1.f + tanhf(0.7978845608028654f * (x1 + 0.044715f * x1 * x1 * x1)));
  }
  float a = 0.f;
  for (int j0 = 0; j0 < 64; j0 += 16) {
    float wv[16], wu[16];
#pragma unroll
    for (int k = 0; k < 16; ++k) { wv[k] = w2[(j0 + k) * 64 + lane]; wu[k] = w2[(64 + j0 + k) * 64 + lane]; }
#pragma unroll
    for (int k = 0; k < 16; ++k) a += __shfl(g0, j0 + k) * wv[k] + __shfl(g1, j0 + k) * wu[k];
  }
  if (kv == 0) {
    float ss = wave_sum(a * a);
    float rinv = rsqrtf(ss * (1.f / 64.f) + EPSF);
    float v = a * rinv * p.k_norm[lane];
    float partner = __shfl_xor(v, 8);
    int pos = 16 * n + 31;
    float2 cs = ((const float2*)(ws + OFF_ROPE))[pos * 8 + (lane & 7)];
    float o = v;
    if (lane < 8) o = v * cs.x - partner * cs.y;
    else if (lane < 16) o = partner * cs.y + v * cs.x;
    KCMP[((long)bg * 512 + n) * 64 + lane] = f2bf(o);
  } else {
    VCMPT[((long)bg * 64 + lane) * 512 + n] = f2bf(a);
  }
}

DEVI void mlstm_local(const Params& p, int unit, unsigned char* smem) {
  const int tid = opaque_tid(), lane = tid & 63, w = tid >> 6, wr = w >> 1, wc = w & 1;
  const int bh = unit >> 6, c = unit & 63, b = bh >> 2, h = bh & 3, t0 = c * 128;
  const long R0 = (long)b * 8192 + t0;
  unsigned char* ws = p.ws;
  bf16_t* sA = (bf16_t*)smem;
  bf16_t* sB = (bf16_t*)(smem + 18432);
  float* sIg = (float*)(smem + 36864);
  float* sLf = sIg + 128;
  float* sW = sLf + 128;
  const float* IG = (const float*)(ws + L0_IG);
  const float* LF = (const float*)(ws + L0_LOGF);
  if (tid < 128) { sIg[tid] = IG[(R0 + tid) * 4 + h]; sLf[tid] = LF[(R0 + tid) * 4 + h]; }
  __syncthreads();
  if (tid < 64) {
    float c0 = sLf[2 * tid], c1 = sLf[2 * tid + 1];
    wave_scan_sum128(c0, c1, tid);
    const float bL = __shfl(c1, 63);
    float d0 = bL - c0 + sIg[2 * tid], d1 = bL - c1 + sIg[2 * tid + 1];
    const float ml = wave_max(fmaxf(d0, d1));
    sW[2 * tid] = __expf(d0 - ml); sW[2 * tid + 1] = __expf(d1 - ml);
    if (tid == 0) { ((float*)(ws + L0_BL))[unit] = bL; ((float*)(ws + L0_MLOC))[unit] = ml; }
  }
  __syncthreads();
  f32x4 acc[4][4];
#pragma unroll
  for (int mt = 0; mt < 4; ++mt)
#pragma unroll
    for (int nt = 0; nt < 4; ++nt) acc[mt][nt] = f32x4{0.f, 0.f, 0.f, 0.f};
  float dn = 0.f;
  const bf16_t* vt = (const bf16_t*)(ws + L0_MVT) + (((long)(b * 4 + h) * 128 + (t0 >> 6)) * 128) * 64;
  const bf16_t* kt_ = (const bf16_t*)(ws + L0_KCT) + (((long)(b * 4 + h) * 128 + (t0 >> 6)) * 128) * 64;
  const int lr = tid >> 3, lk = (tid & 7) * 8;
  for (int kt = 0; kt < 2; ++kt) {
    load_tile128(sA, vt + kt * 8192, 64);
#pragma unroll
    for (int j = 0; j < 4; ++j) {
      uint4 v = *(const uint4*)(kt_ + (long)kt * 8192 + (lr + 32 * j) * 64 + lk);
      const float* ww = sW + kt * 64 + lk;
      uint4 o;
      o.x = pack2(lo2f(v.x) * ww[0], hi2f(v.x) * ww[1]);
      o.y = pack2(lo2f(v.y) * ww[2], hi2f(v.y) * ww[3]);
      o.z = pack2(lo2f(v.z) * ww[4], hi2f(v.z) * ww[5]);
      o.w = pack2(lo2f(v.w) * ww[6], hi2f(v.w) * ww[7]);
      *(uint4*)(sB + (lr + 32 * j) * LDT + lk) = o;
    }
    __syncthreads();
    if (tid < 128) {
#pragma unroll 8
      for (int s = 0; s < 64; ++s) dn += bf2f(sB[tid * LDT + s]);
    }
    mma_lds<4, 4, 2>(sA + wr * 64 * LDT, sB + wc * 64 * LDT, acc, lane);
    __syncthreads();
  }
  float* dct = (float*)(ws + L0_H) + (long)unit * 16384;
  const int r = lane & 15, q = lane >> 4;
#pragma unroll
  for (int mt = 0; mt < 4; ++mt)
#pragma unroll
    for (int i = 0; i < 4; ++i) {
      int e = wr * 64 + mt * 16 + q * 4 + i;
#pragma unroll
      for (int nt = 0; nt < 4; ++nt) dct[e * 128 + wc * 64 + nt * 16 + r] = acc[mt][nt][i];
    }
  if (tid < 128) ((float*)(ws + L0_DN))[unit * 128 + tid] = dn;
}

template <bool DUMMY>
DEVI void mlstm_scan(const Params& p, unsigned char* smem) {
  unsigned char* ws = p.ws;
  const float* BL = (const float*)(ws + L0_BL);
  const float* ML = (const float*)(ws + L0_MLOC);
  float* MIN_ = (float*)(ws + L0_MIN);
  float* sDec = (float*)smem;
  float* sWn = sDec + 128;
  const int tid = opaque_tid();
  const int total = 8 * 16384 + 8 * 128;
  for (int base = blockIdx.x * 256; base < total; base += gridDim.x * 256) {
    const int bh0 = (base < 131072) ? (base >> 14) : ((base - 131072) >> 7);
    __syncthreads();
    if (tid < 2) {
      const int bh = bh0 + tid;
      if (bh < 8) {
        float m = 0.f;
        for (int c = 0; c < 64; ++c) {
          const int unit = bh * 64 + c;
          const float bL = BL[unit], ml = ML[unit];
          if (!DUMMY && base < 131072 && (base & 16383) == 0 && tid == 0) MIN_[unit] = m;
          const float mn = fmaxf(bL + m, ml);
          sDec[tid * 64 + c] = __expf(bL + m - mn);
          sWn[tid * 64 + c] = __expf(ml - mn);
          m = mn;
        }
      }
    }
    __syncthreads();
    const int idx = base + tid;
    if (idx < total) {
      float* ptr; long stride; int sel;
      if (idx < 131072) { const int bh = idx >> 14; ptr = (float*)(ws + L0_H) + (long)bh * 64 * 16384 + (idx & 16383); stride = 16384; sel = bh - bh0; }
      else { const int j = idx - 131072; const int bh = j >> 7; ptr = (float*)(ws + L0_DN) + (long)bh * 64 * 128 + (j & 127); stride = 128; sel = bh - bh0; }
      const float* dec = sDec + sel * 64;
      const float* wn = sWn + sel * 64;
      float C = 0.f;
      for (int c0 = 0; c0 < 64; c0 += 8) {
        float dv[8];
#pragma unroll
        for (int k = 0; k < 8; ++k) dv[k] = __builtin_nontemporal_load(ptr + (long)(c0 + k) * stride);
#pragma unroll
        for (int k = 0; k < 8; ++k) {
          if (!DUMMY) __builtin_nontemporal_store(C, ptr + (long)(c0 + k) * stride);
          C = dec[c0 + k] * C + wn[c0 + k] * dv[k];
        }
      }
      if (DUMMY && C == 123.456f) MIN_[0] = C;
    }
  }
}

DEVI void mlstm_out(const Params& p, int item, unsigned char* smem) {
  const int tid = opaque_tid(), lane = tid & 63, w = tid >> 6, wr = w >> 1, wc = w & 1;
  const int r = lane & 15, q = lane >> 4;
  const int unit = item >> 1, u = item & 1;
  const int bh = unit >> 6, c = unit & 63, b = bh >> 2, h = bh & 3, t0 = c * 128;
  const long R0 = (long)b * 8192 + t0;
  const int J0 = u * 64;
  unsigned char* ws = p.ws;
  bf16_t* sA = (bf16_t*)smem;
  bf16_t* sB = (bf16_t*)(smem + 9216);
  bf16_t* sS0 = (bf16_t*)(smem + 27648);
  bf16_t* sS1 = (bf16_t*)(smem + 36864);
  float* fl = (float*)(smem + 46080);
  float* sIg = fl; float* sLf = fl + 128; float* sRj = fl + 256; float* sCs = fl + 384; float* sWi = fl + 512;
  float* sEm = fl + 640; float* sQn = fl + 768; float* sNin = fl + 896; float* sDen = fl + 1024; float* sSs = fl + 1280;
  const float* IG = (const float*)(ws + L0_IG);
  const float* LF = (const float*)(ws + L0_LOGF);
  const bf16_t* QC = (const bf16_t*)(ws + L0_QC) + (R0 + J0) * 512 + h * 128;
  const bf16_t* KC = (const bf16_t*)(ws + L0_KC) + R0 * 512 + h * 128;
  if (tid < 128) { sIg[tid] = IG[(R0 + tid) * 4 + h]; sLf[tid] = LF[(R0 + tid) * 4 + h]; sNin[tid] = ((const float*)(ws + L0_DN))[unit * 128 + tid]; }
  const float m_in = ((const float*)(ws + L0_MIN))[unit];
  __syncthreads();
  if (tid < 64) {
    float c0 = sLf[2 * tid], c1 = sLf[2 * tid + 1];
    wave_scan_sum128(c0, c1, tid);
    const float a0 = sIg[2 * tid] - c0, a1 = sIg[2 * tid + 1] - c1;
    float x0 = a0, x1 = a1;
    wave_scan_max128(x0, x1, tid);
    const float mx0 = fmaxf(x0, m_in), mx1 = fmaxf(x1, m_in);
    sCs[2 * tid] = a0; sCs[2 * tid + 1] = a1;
    sRj[2 * tid] = -mx0; sRj[2 * tid + 1] = -mx1;
    sWi[2 * tid] = __expf(m_in - mx0); sWi[2 * tid + 1] = __expf(m_in - mx1);
    sEm[2 * tid] = __expf(-(c0 + mx0)); sEm[2 * tid + 1] = __expf(-(c1 + mx1));
  }
  if (tid >= 128 && tid < 192) {
    int jl = tid - 128;
    const bf16_t* qr = QC + (long)jl * 512;
    float s = 0.f;
#pragma unroll 2
    for (int ch = 0; ch < 16; ++ch) {
      uint4 v = *(const uint4*)(qr + ch * 8);
      const float* nn = sNin + ch * 8;
      s += lo2f(v.x) * nn[0] + hi2f(v.x) * nn[1] + lo2f(v.y) * nn[2] + hi2f(v.y) * nn[3] + lo2f(v.z) * nn[4] + hi2f(v.z) * nn[5] + lo2f(v.w) * nn[6] + hi2f(v.w) * nn[7];
    }
    sQn[jl] = s;
  }
  __syncthreads();
  f32x4 acc[2][4];
#pragma unroll
  for (int mt = 0; mt < 2; ++mt)
#pragma unroll
    for (int nt = 0; nt < 4; ++nt) acc[mt][nt] = f32x4{0.f, 0.f, 0.f, 0.f};
  const bool skipS = (wc > u);
  const int lr = tid >> 3, lk = (tid & 7) * 8;
  {
    u32x4 qa0, qa1, kb0, kb1, kb2, kb3;
    qa0 = *(const u32x4*)(QC + (long)lr * 512 + lk); qa1 = *(const u32x4*)(QC + (long)(lr + 32) * 512 + lk);
    kb0 = *(const u32x4*)(KC + (long)lr * 512 + lk); kb1 = *(const u32x4*)(KC + (long)(lr + 32) * 512 + lk);
    kb2 = *(const u32x4*)(KC + (long)(lr + 64) * 512 + lk); kb3 = *(const u32x4*)(KC + (long)(lr + 96) * 512 + lk);
#pragma unroll 1
    for (int kt = 0; kt < 2; ++kt) {
      *(u32x4*)(sA + lr * LDT + lk) = qa0; *(u32x4*)(sA + (lr + 32) * LDT + lk) = qa1;
      *(u32x4*)(sB + lr * LDT + lk) = kb0; *(u32x4*)(sB + (lr + 32) * LDT + lk) = kb1;
      *(u32x4*)(sB + (lr + 64) * LDT + lk) = kb2; *(u32x4*)(sB + (lr + 96) * LDT + lk) = kb3;
      __syncthreads();
      if (kt == 0) {
        qa0 = *(const u32x4*)(QC + (long)lr * 512 + 64 + lk); qa1 = *(const u32x4*)(QC + (long)(lr + 32) * 512 + 64 + lk);
        kb0 = *(const u32x4*)(KC + (long)lr * 512 + 64 + lk); kb1 = *(const u32x4*)(KC + (long)(lr + 32) * 512 + 64 + lk);
        kb2 = *(const u32x4*)(KC + (long)(lr + 64) * 512 + 64 + lk); kb3 = *(const u32x4*)(KC + (long)(lr + 96) * 512 + 64 + lk);
      }
      if (!skipS) mma_lds<2, 4, 2>(sA + wr * 32 * LDT, sB + wc * 64 * LDT, acc, lane);
      __syncthreads();
    }
  }
  {
    bf16_t* sS = wc ? sS1 : sS0;
#pragma unroll
    for (int mt = 0; mt < 2; ++mt)
#pragma unroll
      for (int i = 0; i < 4; ++i) {
        int jl = wr * 32 + mt * 16 + q * 4 + i;
        int j = J0 + jl;
        float rj = sRj[j], rs = 0.f;
#pragma unroll
        for (int nt = 0; nt < 4; ++nt) {
          int sl = nt * 16 + r, s = wc * 64 + sl;
          float val = (s <= j) ? acc[mt][nt][i] * __expf(rj + sCs[s]) : 0.f;
          rs += val;
          sS[jl * LDT + sl] = f2bf(val);
        }
        rs = grp16_sum(rs);
        if (r == 0) sDen[wc * 64 + jl] = rs;
      }
  }
#pragma unroll
  for (int mt = 0; mt < 2; ++mt)
#pragma unroll
    for (int nt = 0; nt < 4; ++nt) acc[mt][nt] = f32x4{0.f, 0.f, 0.f, 0.f};
  const bf16_t* vt = (const bf16_t*)(ws + L0_MVT) + (((long)(b * 4 + h) * 128 + (t0 >> 6)) * 128) * 64;
  const float* ct = (const float*)(ws + L0_H) + (long)unit * 16384;
  {
    u32x4 vb0, vb1, vb2, vb3;
    u32x4 qa0, qa1;
    float4 cv[8];
    const int nsteps = u ? 4 : 3;
    auto kind_of = [&](int sidx) { return u ? sidx : (sidx == 0 ? 0 : sidx + 1); };
    auto fetch = [&](int kind) {
      if (kind < 2) {
        const bf16_t* vp = vt + (long)kind * 8192 + lr * 64 + lk;
        vb0 = *(const u32x4*)vp; vb1 = *(const u32x4*)(vp + 32 * 64); vb2 = *(const u32x4*)(vp + 64 * 64); vb3 = *(const u32x4*)(vp + 96 * 64);
      } else {
        const int k2 = kind - 2;
        qa0 = *(const u32x4*)(QC + (long)lr * 512 + k2 * 64 + lk); qa1 = *(const u32x4*)(QC + (long)(lr + 32) * 512 + k2 * 64 + lk);
#pragma unroll
        for (int j = 0; j < 8; ++j) cv[j] = *(const float4*)(ct + (long)((tid >> 4) + 16 * j) * 128 + k2 * 64 + (tid & 15) * 4);
      }
    };
    fetch(0);
#pragma unroll 1
    for (int sidx = 0; sidx < nsteps; ++sidx) {
      const int kind = kind_of(sidx);
      const bf16_t* aS;
      if (kind < 2) {
        *(u32x4*)(sB + lr * LDT + lk) = vb0; *(u32x4*)(sB + (lr + 32) * LDT + lk) = vb1;
        *(u32x4*)(sB + (lr + 64) * LDT + lk) = vb2; *(u32x4*)(sB + (lr + 96) * LDT + lk) = vb3;
        aS = kind ? sS1 : sS0;
      } else {
        const float w0 = sWi[J0 + lr], w1 = sWi[J0 + lr + 32];
        u32x4 o0, o1;
        o0[0] = pack2(lo2f(qa0[0]) * w0, hi2f(qa0[0]) * w0); o0[1] = pack2(lo2f(qa0[1]) * w0, hi2f(qa0[1]) * w0);
        o0[2] = pack2(lo2f(qa0[2]) * w0, hi2f(qa0[2]) * w0); o0[3] = pack2(lo2f(qa0[3]) * w0, hi2f(qa0[3]) * w0);
        o1[0] = pack2(lo2f(qa1[0]) * w1, hi2f(qa1[0]) * w1); o1[1] = pack2(lo2f(qa1[1]) * w1, hi2f(qa1[1]) * w1);
        o1[2] = pack2(lo2f(qa1[2]) * w1, hi2f(qa1[2]) * w1); o1[3] = pack2(lo2f(qa1[3]) * w1, hi2f(qa1[3]) * w1);
        *(u32x4*)(sA + lr * LDT + lk) = o0; *(u32x4*)(sA + (lr + 32) * LDT + lk) = o1;
#pragma unroll
        for (int j = 0; j < 8; ++j) {
          uint2 o;
          o.x = pack2(cv[j].x, cv[j].y);
          o.y = pack2(cv[j].z, cv[j].w);
          *(uint2*)(sB + ((tid >> 4) + 16 * j) * LDT + (tid & 15) * 4) = o;
        }
        aS = sA;
      }
      __syncthreads();
      if (sidx + 1 < nsteps) fetch(kind_of(sidx + 1));
      mma_lds<2, 4, 2>(aS + wr * 32 * LDT, sB + wc * 64 * LDT, acc, lane);
      __syncthreads();
    }
  }
#pragma unroll
  for (int mt = 0; mt < 2; ++mt)
#pragma unroll
    for (int i = 0; i < 4; ++i) {
      int jl = wr * 32 + mt * 16 + q * 4 + i;
      int j = J0 + jl;
      float den = sDen[jl] + sDen[64 + jl] + sWi[j] * sQn[jl];
      float dinv = 1.f / fmaxf(fabsf(den), sEm[j]);
      float ss = 0.f;
#pragma unroll
      for (int nt = 0; nt < 4; ++nt) { float v = acc[mt][nt][i] * dinv; acc[mt][nt][i] = v; ss += v * v; }
      ss = grp16_sum(ss);
      if (r == 0) sSs[wc * 64 + jl] = ss;
    }
  __syncthreads();
  const bf16_t* MO = (const bf16_t*)(ws + L0_MO);
  const bf16_t* MZ = (const bf16_t*)(ws + L0_MZ);
  bf16_t* Y = (bf16_t*)(ws + L0_QKRAW);
  float hn[4];
#pragma unroll
  for (int nt = 0; nt < 4; ++nt) hn[nt] = p.m_hn[h * 128 + wc * 64 + nt * 16 + r];
#pragma unroll
  for (int mt = 0; mt < 2; ++mt) {
    float gv[4][4];
#pragma unroll
    for (int i = 0; i < 4; ++i) {
      long row = R0 + J0 + wr * 32 + mt * 16 + q * 4 + i;
#pragma unroll
      for (int nt = 0; nt < 4; ++nt) {
        int col = h * 128 + wc * 64 + nt * 16 + r;
        gv[i][nt] = bf2f(MO[row * 512 + col]) * bf2f(MZ[row * 512 + col]);
      }
    }
#pragma unroll
    for (int i = 0; i < 4; ++i) {
      int jl = wr * 32 + mt * 16 + q * 4 + i;
      float rinv = rsqrtf((sSs[jl] + sSs[64 + jl]) * (1.f / 128.f) + EPSF);
      long row = R0 + J0 + jl;
#pragma unroll
      for (int nt = 0; nt < 4; ++nt) {
        int col = h * 128 + wc * 64 + nt * 16 + r;
        Y[row * 1024 + col] = f2bf(acc[mt][nt][i] * rinv * hn[nt] * gv[i][nt]);
      }
    }
  }
  __syncthreads();
}

struct NsaSm {
  bf16_t* sK; bf16_t* sV;
  float* sImpA; float* sImpB;
  unsigned* sSel; unsigned* sGrp; unsigned* sUn;
};

DEVI int next_bit(unsigned long long lo, unsigned long long hi, int from) {
  if (from < 64) {
    unsigned long long v = lo & (~0ull << from);
    if (v) return __builtin_ctzll(v);
    if (hi) return 64 + __builtin_ctzll(hi);
    return -1;
  }
  if (from >= 128) return -1;
  unsigned long long v = hi & (~0ull << (from - 64));
  if (v) return 64 + __builtin_ctzll(v);
  return -1;
}

template <int MODE, bool DUMMY = false, class MaskF, class ActF>
DEVI void nsa_branch(const NsaSm& sm, unsigned long long tmlo, unsigned long long tmhi,
                     const bf16_t* Kg, const bf16_t* Vg, long vstep, long ldv,
                     const bf16x8 (&qf)[2][2], f32x4 (&O)[4][2], float (&mrow)[2], float (&lrow)[2], const float (&invl)[2],
                     MaskF mask, ActF actf, int tokbase, int tid) {
  const int lane = tid & 63, r = lane & 15, q = lane >> 4;
  const int lr = tid >> 3, lk = (tid & 7) * 8;
  int j = next_bit(tmlo, tmhi, 0);
  if (j < 0) return;
  u32x4 k0, k1, v0, v1;
  u32x4 k2, k3, v2, v3;
  if (!DUMMY) {
    const bf16_t* kp = Kg + (long)j * 4096 + lr * 64 + lk;
    k0 = *(const u32x4*)kp; k1 = *(const u32x4*)(kp + 32 * 64);
    if (MODE != 1) {
      const bf16_t* vp = Vg + (long)j * vstep + (long)lr * ldv + lk;
      v0 = *(const u32x4*)vp; v1 = *(const u32x4*)(vp + 32 * ldv);
    }
    *(u32x4*)(sm.sK + lr * LDT + lk) = k0; *(u32x4*)(sm.sK + (lr + 32) * LDT + lk) = k1;
    if (MODE != 1) { *(u32x4*)(sm.sV + lr * LDT + lk) = v0; *(u32x4*)(sm.sV + (lr + 32) * LDT + lk) = v1; }
  }
  int j1 = next_bit(tmlo, tmhi, j + 1);
  if (!DUMMY && j1 >= 0) {
    const bf16_t* kp = Kg + (long)j1 * 4096 + lr * 64 + lk;
    k0 = *(const u32x4*)kp; k1 = *(const u32x4*)(kp + 32 * 64);
    if (MODE != 1) {
      const bf16_t* vp = Vg + (long)j1 * vstep + (long)lr * ldv + lk;
      v0 = *(const u32x4*)vp; v1 = *(const u32x4*)(vp + 32 * ldv);
    }
  }
  if (!DUMMY) __syncthreads();
  int buf = 0;
  while (true) {
    const int jn = j1;
    const int j2 = (j1 >= 0) ? next_bit(tmlo, tmhi, j1 + 1) : -1;
    if (!DUMMY && j2 >= 0) {
      const bf16_t* kp = Kg + (long)j2 * 4096 + lr * 64 + lk;
      k2 = *(const u32x4*)kp; k3 = *(const u32x4*)(kp + 32 * 64);
      if (MODE != 1) {
        const bf16_t* vp = Vg + (long)j2 * vstep + (long)lr * ldv + lk;
        v2 = *(const u32x4*)vp; v3 = *(const u32x4*)(vp + 32 * ldv);
      }
    }
    const bf16_t* sK = sm.sK + buf * (64 * LDT);
    const bf16_t* sV = sm.sV + buf * (64 * LDT);
    const bool a0 = actf(0, j), a1 = actf(1, j);
    __builtin_amdgcn_sched_barrier(0);
    if (a0 || a1) {
      const bool full = mask.full(j);
      f32x4 sacc[4][2];
#pragma unroll
      for (int mt = 0; mt < 4; ++mt) { sacc[mt][0] = f32x4{0.f, 0.f, 0.f, 0.f}; sacc[mt][1] = f32x4{0.f, 0.f, 0.f, 0.f}; }
      __builtin_amdgcn_s_setprio(2);
#pragma unroll
      for (int ks = 0; ks < 2; ++ks)
#pragma unroll
        for (int mt = 0; mt < 4; ++mt) {
          bf16x8 a = *(const bf16x8*)(sK + (mt * 16 + r) * LDT + ks * 32 + q * 8);
          if (a0) sacc[mt][0] = __builtin_amdgcn_mfma_f32_16x16x32_bf16(a, qf[0][ks], sacc[mt][0], 0, 0, 0);
          if (a1) sacc[mt][1] = __builtin_amdgcn_mfma_f32_16x16x32_bf16(a, qf[1][ks], sacc[mt][1], 0, 0, 0);
        }
      __builtin_amdgcn_s_setprio(0);
      __builtin_amdgcn_sched_barrier(0);
#pragma unroll
      for (int nt = 0; nt < 2; ++nt) {
        const bool act = nt ? a1 : a0;
        if (act) {
          const bool lb = mask.bit(nt, j);
          if (!full) {
#pragma unroll
            for (int mt = 0; mt < 4; ++mt)
#pragma unroll
              for (int i = 0; i < 4; ++i) sacc[mt][nt][i] = mask.elem(mt * 16 + q * 4 + i, nt, j) ? sacc[mt][nt][i] : NEGS;
          }
          if (MODE != 2) {
            float tmx = fmaxf(fmaxf(sacc[0][nt][0], sacc[0][nt][1]), fmaxf(sacc[0][nt][2], sacc[0][nt][3]));
#pragma unroll
            for (int mt = 1; mt < 4; ++mt)
              tmx = fmaxf(tmx, fmaxf(fmaxf(sacc[mt][nt][0], sacc[mt][nt][1]), fmaxf(sacc[mt][nt][2], sacc[mt][nt][3])));
            if (MaskF::HASBIT) tmx = lb ? tmx : NEGS;
            tmx = fmaxf(tmx, __shfl_xor(tmx, 16));
            tmx = fmaxf(tmx, __shfl_xor(tmx, 32));
            const float mo = mrow[nt];
            const float mn = fmaxf(mo, tmx);
            float mnc = fmaxf(mn, -1e20f);
            if (MaskF::HASBIT) mnc = lb ? mnc : 1e30f;
            mrow[nt] = mn;
            f32x4 psv = f32x4{0.f, 0.f, 0.f, 0.f};
#pragma unroll
            for (int mt = 0; mt < 4; ++mt) {
              f32x4 dd = sacc[mt][nt] - mnc;
              f32x4 pp;
              pp[0] = __builtin_amdgcn_exp2f(dd[0]); pp[1] = __builtin_amdgcn_exp2f(dd[1]);
              pp[2] = __builtin_amdgcn_exp2f(dd[2]); pp[3] = __builtin_amdgcn_exp2f(dd[3]);
              sacc[mt][nt] = pp;
              psv += pp;
            }
            const float ps = (psv[0] + psv[1]) + (psv[2] + psv[3]);
            const float al = __builtin_amdgcn_exp2f(mo - mn);
            lrow[nt] = lrow[nt] * al + ps;
            if (MODE == 0) {
              if (__any(al != 1.f)) {
#pragma unroll
                for (int dt = 0; dt < 4; ++dt) O[dt][nt] *= al;
              }
            }
          } else {
            const float mmc = fmaxf(mrow[nt], -1e20f), il = invl[nt];
            const int tok = tokbase + nt * 4 + (r >> 2);
#pragma unroll
            for (int mt = 0; mt < 4; ++mt) {
              float pp[4];
#pragma unroll
              for (int i = 0; i < 4; ++i) {
                pp[i] = __builtin_amdgcn_exp2f(sacc[mt][nt][i] - mmc) * il;
                sacc[mt][nt][i] = pp[i];
              }
              float mainv = 32.f * (pp[0] + pp[1] + pp[2]) + 16.f * pp[3];
              float carry = 16.f * pp[3];
              mainv += __shfl_xor(mainv, 1); mainv += __shfl_xor(mainv, 2);
              carry += __shfl_xor(carry, 1); carry += __shfl_xor(carry, 2);
              if ((r & 3) == 0) {
                const int mp = j * 16 + mt * 4 + q;
                sm.sImpA[tok * 128 + mp] = mainv;
                if (mp + 1 < 128) sm.sImpB[tok * 128 + mp + 1] = carry;
              }
            }
          }
        }
      }
      __builtin_amdgcn_sched_barrier(0);
      if (MODE != 1) {
        __builtin_amdgcn_s_setprio(2);
#pragma unroll
        for (int ks = 0; ks < 2; ++ks) {
          bf16x8 pb[2];
#pragma unroll
          for (int nt = 0; nt < 2; ++nt) {
            union { u32x4 u; bf16x8 h; } cv;
            cv.u[0] = pack2(sacc[2 * ks][nt][0], sacc[2 * ks][nt][1]);
            cv.u[1] = pack2(sacc[2 * ks][nt][2], sacc[2 * ks][nt][3]);
            cv.u[2] = pack2(sacc[2 * ks + 1][nt][0], sacc[2 * ks + 1][nt][1]);
            cv.u[3] = pack2(sacc[2 * ks + 1][nt][2], sacc[2 * ks + 1][nt][3]);
            pb[nt] = cv.h;
          }
#pragma unroll
          for (int dt = 0; dt < 4; ++dt) {
            union { u32x4 u; bf16x8 h; } av;
            const uint2 lo = *(const uint2*)(sV + (dt * 16 + r) * LDT + (2 * ks) * 16 + q * 4);
            const uint2 hi = *(const uint2*)(sV + (dt * 16 + r) * LDT + (2 * ks + 1) * 16 + q * 4);
            av.u[0] = lo.x; av.u[1] = lo.y; av.u[2] = hi.x; av.u[3] = hi.y;
            if (a0) O[dt][0] = __builtin_amdgcn_mfma_f32_16x16x32_bf16(av.h, pb[0], O[dt][0], 0, 0, 0);
            if (a1) O[dt][1] = __builtin_amdgcn_mfma_f32_16x16x32_bf16(av.h, pb[1], O[dt][1], 0, 0, 0);
          }
        }
        __builtin_amdgcn_s_setprio(0);
      }
    }
    __builtin_amdgcn_sched_barrier(0);
    if (!DUMMY && jn >= 0) {
      bf16_t* dK = sm.sK + (buf ^ 1) * (64 * LDT);
      bf16_t* dV = sm.sV + (buf ^ 1) * (64 * LDT);
      *(u32x4*)(dK + lr * LDT + lk) = k0; *(u32x4*)(dK + (lr + 32) * LDT + lk) = k1;
      if (MODE != 1) { *(u32x4*)(dV + lr * LDT + lk) = v0; *(u32x4*)(dV + (lr + 32) * LDT + lk) = v1; }
    }
    if (!DUMMY) __syncthreads();
    if (jn < 0) break;
    j = jn;
    j1 = j2;
    k0 = k2; k1 = k3; v0 = v2; v1 = v3;
    buf ^= 1;
  }
}

struct MaskC {
      static constexpr bool HASBIT = false;
      int t0_, t1_, tmin_;
      DEVI bool full(int jt) const { return 16 * (jt * 64 + 63) + 31 <= tmin_; }
      DEVI bool bit(int nt, int jt) const { return true; }
      DEVI bool elem(int key, int nt, int jt) const { return 16 * (jt * 64 + key) + 31 <= (nt ? t1_ : t0_); }
};

struct MaskS {
      static constexpr bool HASBIT = true;
      unsigned long long a_lo, a_hi, b_lo, b_hi; int t0_, t1_, cur_;
      DEVI bool full(int jt) const { return jt < cur_; }
      DEVI bool bit(int nt, int jt) const {
        const unsigned long long lo = nt ? b_lo : a_lo, hi = nt ? b_hi : a_hi;
        const unsigned long long wd = (jt < 64) ? (lo >> jt) : (hi >> (jt - 64));
        return (wd & 1ull) != 0ull;
      }
      DEVI bool elem(int key, int nt, int jt) const { return jt * 64 + key <= (nt ? t1_ : t0_); }
};

struct MaskW {
      static constexpr bool HASBIT = false;
      int t0_, t1_, tmin_, tmax_;
      DEVI bool full(int jt) const { return (jt * 64 + 63 <= tmin_) && (tmax_ - jt * 64 < 512); }
      DEVI bool bit(int nt, int jt) const { return true; }
      DEVI bool elem(int key, int nt, int jt) const { const int s_ = jt * 64 + key, t_ = nt ? t1_ : t0_; return (s_ <= t_) && (t_ - s_ < 512); }
};

DEVI void nsa_tile(const Params& p, int tileidx, unsigned char* smem) {
  const int tid = opaque_tid(), lane = tid & 63, w = tid >> 6, r = lane & 15, q = lane >> 4;
  const int bg = tileidx & 3, tt = tileidx >> 2, b = bg >> 1, g = bg & 1, t0 = tt * 32;
  unsigned char* ws = p.ws;
  NsaSm sm;
  sm.sK = (bf16_t*)smem; sm.sV = (bf16_t*)(smem + 18432);
  sm.sImpA = (float*)(smem + 36864); sm.sImpB = (float*)(smem + 53248);
  sm.sSel = (unsigned*)(smem + 69632); sm.sGrp = sm.sSel + 128; sm.sUn = sm.sGrp + 32;
  const int tokbase = 8 * w;
  bf16x8 qf[2][2];
  {
    const bf16_t* qn = (const bf16_t*)(ws + L0_QN) + ((long)bg * 8192 + t0) * 256 + (32 * w + r) * 64 + q * 8;
    qf[0][0] = *(const bf16x8*)(qn); qf[0][1] = *(const bf16x8*)(qn + 32);
    qf[1][0] = *(const bf16x8*)(qn + 16 * 64); qf[1][1] = *(const bf16x8*)(qn + 16 * 64 + 32);
  }
  int tq[2];
  const float* GT = (const float*)(ws + L0_GATES);
#pragma unroll
  for (int nt = 0; nt < 2; ++nt) tq[nt] = t0 + tokbase + nt * 4 + (r >> 2);
#define GATE(nt, k) (GT[((long)b * 8192 + tq[nt]) * 24 + (g * 4 + (r & 3)) * 3 + (k)])
  f32x4 O[4][2];
  f32x4* sOut = (f32x4*)(smem + 36864) + (w * 8) * 64 + lane;
  const int cur = t0 >> 6;
  float mrow[2], lrow[2], invl[2];
  for (int i = tid; i < 32 * 128; i += 256) { sm.sImpA[i] = 0.f; sm.sImpB[i] = 0.f; }
  __syncthreads();
  {
    const int nvmax = (t0 + 31 >= 31) ? (((t0 + 31 - 31) >> 4) + 1) : 0;
    int nkt = (nvmax + 63) >> 6;
    if (nkt > 8) nkt = 8;
    const unsigned long long cm0 = (1ull << nkt) - 1ull;
    const bf16_t* KCMP = (const bf16_t*)(ws + L0_KCMP) + (long)bg * 512 * 64;
    const bf16_t* VCMPT = (const bf16_t*)(ws + L0_VCMPT) + (long)bg * 64 * 512;
    MaskC mk{tq[0], tq[1], t0 + tokbase};
    auto act = [&](int nt, int jt) { return true; };
    mrow[0] = mrow[1] = NEGS; lrow[0] = lrow[1] = 0.f; invl[0] = invl[1] = 0.f;
    nsa_branch<1>(sm, cm0, 0ull, KCMP, VCMPT, 64, 512, qf, O, mrow, lrow, invl, mk, act, tokbase, tid);
#pragma unroll
    for (int nt = 0; nt < 2; ++nt) {
      float l = lrow[nt];
      l += __shfl_xor(l, 16); l += __shfl_xor(l, 32);
      invl[nt] = (l > 0.f) ? 1.f / l : 0.f;
    }
#pragma unroll
    for (int dt = 0; dt < 4; ++dt) { O[dt][0] = f32x4{0.f, 0.f, 0.f, 0.f}; O[dt][1] = f32x4{0.f, 0.f, 0.f, 0.f}; }
    nsa_branch<2>(sm, cm0, 0ull, KCMP, VCMPT, 64, 512, qf, O, mrow, lrow, invl, mk, act, tokbase, tid);
  }
  __syncthreads();
  {
    const int ncand = (cur - 2 > 0) ? cur - 2 : 0;
    const int nf = (cur >= 2) ? 3 : cur + 1;
    const int kk = 16 - nf;
    const int m0i = lane, m1i = lane + 64;
    const bool c0 = (m0i >= 1 && m0i <= cur - 2), c1 = (m1i <= cur - 2);
    for (int tqi = 0; tqi < 8; ++tqi) {
      const int tok = tokbase + tqi;
      bool s0, s1;
      if (ncand <= kk) { s0 = c0; s1 = c1; }
      else {
        const float f0 = sm.sImpA[tok * 128 + m0i] + sm.sImpB[tok * 128 + m0i];
        const float f1 = sm.sImpA[tok * 128 + m1i] + sm.sImpB[tok * 128 + m1i];
        const unsigned k0 = c0 ? (__float_as_uint(f0) + 1u) : 0u;
        const unsigned k1 = c1 ? (__float_as_uint(f1) + 1u) : 0u;
        unsigned prefix = 0u;
        for (int bit = 31; bit >= 0; --bit) {
          const unsigned cand = prefix | (1u << bit);
          const int cnt = __popcll(__ballot(k0 >= cand)) + __popcll(__ballot(k1 >= cand));
          if (cnt >= kk) prefix = cand;
        }
        const bool g0 = k0 > prefix, g1 = k1 > prefix;
        const int ng = __popcll(__ballot(g0)) + __popcll(__ballot(g1));
        const bool e0 = (k0 == prefix), e1 = (k1 == prefix);
        const unsigned long long be0 = __ballot(e0), be1 = __ballot(e1);
        const unsigned long long lm = (1ull << lane) - 1ull;
        const int re0 = __popcll(be0 & lm), re1 = __popcll(be0) + __popcll(be1 & lm);
        const int need = kk - ng;
        s0 = g0 || (e0 && re0 < need);
        s1 = g1 || (e1 && re1 < need);
      }
      s0 = s0 || (m0i == 0) || (m0i == cur) || (m0i == cur - 1);
      s1 = s1 || (m1i == cur) || (m1i == cur - 1);
      const unsigned long long lo = __ballot(s0), hi = __ballot(s1);
      if (lane == 0) {
        sm.sSel[tok * 4 + 0] = (unsigned)lo; sm.sSel[tok * 4 + 1] = (unsigned)(lo >> 32);
        sm.sSel[tok * 4 + 2] = (unsigned)hi; sm.sSel[tok * 4 + 3] = (unsigned)(hi >> 32);
      }
    }
  }
  __syncthreads();
  if (tid < 32) { int gi = tid >> 2, wd = tid & 3; unsigned u = 0; for (int k = 0; k < 4; ++k) u |= sm.sSel[(gi * 4 + k) * 4 + wd]; sm.sGrp[tid] = u; }
  __syncthreads();
  if (tid < 4) { unsigned u = 0; for (int gi = 0; gi < 8; ++gi) u |= sm.sGrp[gi * 4 + tid]; sm.sUn[tid] = u; }
  __syncthreads();
#pragma unroll
  for (int nt = 0; nt < 2; ++nt)
#pragma unroll
    for (int dt = 0; dt < 4; ++dt) sOut[(nt * 4 + dt) * 64] = O[dt][nt] * GATE(nt, 0);
  {
    const bf16_t* KS = (const bf16_t*)(ws + L0_KS) + (long)bg * 8192 * 64;
    const bf16_t* VST = (const bf16_t*)(ws + L0_VST) + (long)bg * 128 * 4096;
    const unsigned long long ulo = (unsigned long long)sm.sUn[0] | ((unsigned long long)sm.sUn[1] << 32);
    const unsigned long long uhi = (unsigned long long)sm.sUn[2] | ((unsigned long long)sm.sUn[3] << 32);
    const int tk0 = tokbase + (r >> 2), tk1 = tokbase + 4 + (r >> 2);
    MaskS mk{(unsigned long long)sm.sSel[tk0 * 4 + 0] | ((unsigned long long)sm.sSel[tk0 * 4 + 1] << 32),
             (unsigned long long)sm.sSel[tk0 * 4 + 2] | ((unsigned long long)sm.sSel[tk0 * 4 + 3] << 32),
             (unsigned long long)sm.sSel[tk1 * 4 + 0] | ((unsigned long long)sm.sSel[tk1 * 4 + 1] << 32),
             (unsigned long long)sm.sSel[tk1 * 4 + 2] | ((unsigned long long)sm.sSel[tk1 * 4 + 3] << 32), tq[0], tq[1], cur};
    unsigned long long g0lo, g0hi, g1lo, g1hi;
    {
      const unsigned* gp = sm.sGrp + (2 * w) * 4;
      g0lo = (unsigned long long)__builtin_amdgcn_readfirstlane(gp[0]) | ((unsigned long long)__builtin_amdgcn_readfirstlane(gp[1]) << 32);
      g0hi = (unsigned long long)__builtin_amdgcn_readfirstlane(gp[2]) | ((unsigned long long)__builtin_amdgcn_readfirstlane(gp[3]) << 32);
      g1lo = (unsigned long long)__builtin_amdgcn_readfirstlane(gp[4]) | ((unsigned long long)__builtin_amdgcn_readfirstlane(gp[5]) << 32);
      g1hi = (unsigned long long)__builtin_amdgcn_readfirstlane(gp[6]) | ((unsigned long long)__builtin_amdgcn_readfirstlane(gp[7]) << 32);
    }
    auto act = [&](int nt, int jt) {
      const unsigned long long lo = nt ? g1lo : g0lo, hi = nt ? g1hi : g0hi;
      const unsigned long long wd = (jt < 64) ? (lo >> jt) : (hi >> (jt - 64));
      return (wd & 1ull) != 0ull;
    };
    mrow[0] = mrow[1] = NEGS; lrow[0] = lrow[1] = 0.f;
#pragma unroll
    for (int dt = 0; dt < 4; ++dt) { O[dt][0] = f32x4{0.f, 0.f, 0.f, 0.f}; O[dt][1] = f32x4{0.f, 0.f, 0.f, 0.f}; }
#ifdef NSA_DUMMY_SEL
    {
      nsa_branch<0, true>(sm, ulo, uhi, KS, VST, 4096, 64, qf, O, mrow, lrow, invl, mk, act, tokbase, tid);
      float chk = lrow[0] + lrow[1];
#pragma unroll
      for (int dt = 0; dt < 4; ++dt) chk += O[dt][0][0] + O[dt][0][1] + O[dt][0][2] + O[dt][0][3] + O[dt][1][0] + O[dt][1][1] + O[dt][1][2] + O[dt][1][3];
      if (chk == 123.456f) sm.sUn[0] = 1u;
      mrow[0] = mrow[1] = NEGS; lrow[0] = lrow[1] = 0.f;
#pragma unroll
      for (int dt = 0; dt < 4; ++dt) { O[dt][0] = f32x4{0.f, 0.f, 0.f, 0.f}; O[dt][1] = f32x4{0.f, 0.f, 0.f, 0.f}; }
      __syncthreads();
    }
#endif
    nsa_branch<0>(sm, ulo, uhi, KS, VST, 4096, 64, qf, O, mrow, lrow, invl, mk, act, tokbase, tid);
#pragma unroll
    for (int nt = 0; nt < 2; ++nt) {
      float l = lrow[nt];
      l += __shfl_xor(l, 16); l += __shfl_xor(l, 32);
      const float f = GATE(nt, 1) * ((l > 0.f) ? 1.f / l : 0.f);
#pragma unroll
      for (int dt = 0; dt < 4; ++dt) sOut[(nt * 4 + dt) * 64] += O[dt][nt] * f;
    }
  }
  {
    const bf16_t* KW = (const bf16_t*)(ws + L0_KW) + (long)bg * 8192 * 64;
    const bf16_t* VWT = (const bf16_t*)(ws + L0_VWT) + (long)bg * 128 * 4096;
    const int jlo = ((t0 - 511 > 0) ? (t0 - 511) : 0) >> 6;
    unsigned long long wlo = 0ull, whi = 0ull;
    for (int jj = jlo; jj <= cur; ++jj) { if (jj < 64) wlo |= (1ull << jj); else whi |= (1ull << (jj - 64)); }
    MaskW mk{tq[0], tq[1], t0 + tokbase, t0 + tokbase + 7};
    auto act = [&](int nt, int jt) { return true; };
    mrow[0] = mrow[1] = NEGS; lrow[0] = lrow[1] = 0.f;
#pragma unroll
    for (int dt = 0; dt < 4; ++dt) { O[dt][0] = f32x4{0.f, 0.f, 0.f, 0.f}; O[dt][1] = f32x4{0.f, 0.f, 0.f, 0.f}; }
    nsa_branch<0>(sm, wlo, whi, KW, VWT, 4096, 64, qf, O, mrow, lrow, invl, mk, act, tokbase, tid);
#pragma unroll
    for (int nt = 0; nt < 2; ++nt) {
      float l = lrow[nt];
      l += __shfl_xor(l, 16); l += __shfl_xor(l, 32);
      const float f = GATE(nt, 2) * ((l > 0.f) ? 1.f / l : 0.f);
#pragma unroll
      for (int dt = 0; dt < 4; ++dt) O[dt][nt] = sOut[(nt * 4 + dt) * 64] + O[dt][nt] * f;
    }
  }
  const bf16_t* NZ = (const bf16_t*)(ws + L0_NZ);
  bf16_t* Y = (bf16_t*)(ws + L0_QKRAW);
  uint2 zzv[2][4];
#pragma unroll
  for (int nt = 0; nt < 2; ++nt)
#pragma unroll
    for (int dt = 0; dt < 4; ++dt)
      zzv[nt][dt] = *(const uint2*)(NZ + ((long)b * 8192 + tq[nt]) * 512 + (g * 4 + (r & 3)) * 64 + dt * 16 + q * 4);
#pragma unroll
  for (int nt = 0; nt < 2; ++nt) {
    const long tok = (long)b * 8192 + tq[nt];
    const int head = g * 4 + (r & 3);
#pragma unroll
    for (int dt = 0; dt < 4; ++dt) {
      const int d = dt * 16 + q * 4;
      const uint2 zz = zzv[nt][dt];
      uint2 o;
      o.x = pack2(O[dt][nt][0] * lo2f(zz.x), O[dt][nt][1] * hi2f(zz.x));
      o.y = pack2(O[dt][nt][2] * lo2f(zz.y), O[dt][nt][3] * hi2f(zz.y));
      *(uint2*)(Y + tok * 1024 + 512 + head * 64 + d) = o;
    }
  }
  __syncthreads();
}

DEVI void hgrn_local(const Params& p, int unit, unsigned char* smem) {
  const int tid = opaque_tid(), lane = tid & 63, w = tid >> 6, wr = w >> 1, wc = w & 1;
  const int bh = unit >> 7, c = unit & 127, b = bh >> 3, h = bh & 7, t0 = c * 64;
  const long R0 = (long)b * 8192 + t0;
  unsigned char* ws = p.ws;
  bf16_t* sA = (bf16_t*)smem;
  bf16_t* sB = (bf16_t*)(smem + 18432);
  float* psum = (float*)(smem + 36864);
  const int cch = tid & 127, half = tid >> 7;
  const float lb = ((const float*)(ws + OFF_LB))[h * 128 + cch];
  const bf16_t* FP = (const bf16_t*)(ws + L1_FP) + R0 * 1024 + h * 128 + cch;
  float sgv[32], lgv[32];
  {
    const bf16_t* vtp = (const bf16_t*)(ws + L1_VT) + (((long)(b * 8 + h) * 128 + c) * 128) * 64 + (tid >> 3) * 64 + (tid & 7) * 8;
    u32x4 t0_ = *(const u32x4*)vtp, t1_ = *(const u32x4*)(vtp + 32 * 64), t2_ = *(const u32x4*)(vtp + 64 * 64), t3_ = *(const u32x4*)(vtp + 96 * 64);
    bf16_t fpr[32];
#pragma unroll
    for (int k = 0; k < 32; ++k) fpr[k] = FP[(long)(half * 32 + k) * 1024];
    {
      bf16_t* sp = sA + (tid >> 3) * LDT + (tid & 7) * 8;
      *(u32x4*)sp = t0_; *(u32x4*)(sp + 32 * LDT) = t1_; *(u32x4*)(sp + 64 * LDT) = t2_; *(u32x4*)(sp + 96 * LDT) = t3_;
    }
#pragma unroll
    for (int k = 0; k < 32; ++k) { sgv[k] = sigm(bf2f(fpr[k])); lgv[k] = __logf(lb + (1.f - lb) * sgv[k]); }
  }
  float sum = 0.f;
#pragma unroll
  for (int k = 0; k < 32; ++k) sum += lgv[k];
  psum[half * 128 + cch] = sum;
  __syncthreads();
  const float bL = psum[cch] + psum[128 + cch];
  float run = half ? psum[cch] : 0.f;
#pragma unroll
  for (int k = 0; k < 32; ++k) {
    run += lgv[k];
    float kk_ = (1.f - lb) * (1.f - sgv[k]);
    sB[cch * LDT + half * 32 + k] = f2bf(kk_ * __expf(bL - run));
  }
  if (half == 0) ((float*)(ws + L1_BL))[(long)unit * 128 + cch] = bL;
  __syncthreads();
  f32x4 acc[4][4];
#pragma unroll
  for (int mt = 0; mt < 4; ++mt)
#pragma unroll
    for (int nt = 0; nt < 4; ++nt) acc[mt][nt] = f32x4{0.f, 0.f, 0.f, 0.f};
  mma_lds_sw<4, 4, 2>(sA + wr * 64 * LDT, sB + wc * 64 * LDT, acc, lane);
#ifndef R9B
#define R9B 1
#endif
  for (int r9_ = 0; r9_ < R9B; ++r9_) {
  bf16_t* st = (bf16_t*)(ws + L1_ST) + (long)unit * 16384;
  const int r = lane & 15, q = lane >> 4;
#pragma unroll
  for (int mt = 0; mt < 4; ++mt) {
    const int v = wr * 64 + mt * 16 + r;
#pragma unroll
    for (int nt = 0; nt < 4; ++nt) {
      uint2 o;
      o.x = pack2(acc[mt][nt][0], acc[mt][nt][1]);
      o.y = pack2(acc[mt][nt][2], acc[mt][nt][3]);
      *(uint2*)(st + v * 128 + wc * 64 + nt * 16 + q * 4) = o;
    }
  }
  }
  __syncthreads();
}

template <bool DUMMY>
DEVI void hgrn_scan(const Params& p) {
  unsigned char* ws = p.ws;
  const float* BL = (const float*)(ws + L1_BL);
  for (int idx = blockIdx.x * 256 + opaque_tid(); idx < 16 * 8192; idx += gridDim.x * 256) {
    const int bh = idx >> 13, pr = idx & 8191;
    const int c2 = (pr & 63) * 2;
    unsigned* ptr = (unsigned*)(ws + L1_ST) + (long)bh * 128 * 8192 + pr;
    const float* blp = BL + (long)bh * 128 * 128 + c2;
    float s0 = 0.f, s1 = 0.f;
    for (int c0 = 0; c0 < 128; c0 += 8) {
      unsigned dv[8]; float2 bl[8];
#pragma unroll
      for (int k = 0; k < 8; ++k) { dv[k] = __builtin_nontemporal_load(ptr + (long)(c0 + k) * 8192); bl[k] = *(const float2*)(blp + (long)(c0 + k) * 128); }
#pragma unroll
      for (int k = 0; k < 8; ++k) {
        if (!DUMMY) __builtin_nontemporal_store(pack2(s0, s1), ptr + (long)(c0 + k) * 8192);
        s0 = __expf(bl[k].x) * s0 + lo2f(dv[k]);
        s1 = __expf(bl[k].y) * s1 + hi2f(dv[k]);
      }
    }
    if (DUMMY && s0 == 123.456f) ptr[0] = pack2(s0, s1);
  }
}

DEVI void hgrn_out(const Params& p, int unit, unsigned char* smem) {
  const int tid = opaque_tid(), lane = tid & 63, w = tid >> 6, wr = w >> 1, wc = w & 1;
  const int r = lane & 15, q = lane >> 4;
  const int bh = unit >> 7, c = unit & 127, b = bh >> 3, h = bh & 7, t0 = c * 64;
  const long R0 = (long)b * 8192 + t0;
  unsigned char* ws = p.ws;
  bf16_t* sQ0 = (bf16_t*)smem; bf16_t* sQ1 = (bf16_t*)(smem + 9216);
  bf16_t* sK0 = (bf16_t*)(smem + 18432); bf16_t* sK1 = (bf16_t*)(smem + 27648);
  bf16_t* sAm = (bf16_t*)(smem + 36864);
  bf16_t* sB = (bf16_t*)(smem + 46080);
  float* psum = (float*)(smem + 64512);
  float* sSs = psum + 256;
  const int cch = tid & 127, half = tid >> 7, cc = cch & 63;
  const float lb = ((const float*)(ws + OFF_LB))[h * 128 + cch];
  const bf16_t* FP = (const bf16_t*)(ws + L1_FP) + R0 * 1024 + h * 128 + cch;
  const bf16_t* Q1 = (const bf16_t*)(ws + L1_Q) + R0 * 1024 + h * 128 + cch;
  const bf16_t* vt = (const bf16_t*)(ws + L1_VT) + (((long)(b * 8 + h) * 128 + c) * 128) * 64;
  const bf16_t* st = (const bf16_t*)(ws + L1_ST) + (long)unit * 16384;
  const int tl_r = tid >> 3, tl_k = (tid & 7) * 8;
  u32x4 vv0, vv1, vv2, vv3, sa0, sa1, sa2, sa3, sb0, sb1, sb2, sb3;
  {
    const bf16_t* vp = vt + tl_r * 64 + tl_k;
    vv0 = *(const u32x4*)vp; vv1 = *(const u32x4*)(vp + 32 * 64); vv2 = *(const u32x4*)(vp + 64 * 64); vv3 = *(const u32x4*)(vp + 96 * 64);
    const bf16_t* sp = st + tl_r * 128 + tl_k;
    sa0 = *(const u32x4*)sp; sa1 = *(const u32x4*)(sp + 32 * 128); sa2 = *(const u32x4*)(sp + 64 * 128); sa3 = *(const u32x4*)(sp + 96 * 128);
    sb0 = *(const u32x4*)(sp + 64); sb1 = *(const u32x4*)(sp + 32 * 128 + 64); sb2 = *(const u32x4*)(sp + 64 * 128 + 64); sb3 = *(const u32x4*)(sp + 96 * 128 + 64);
  }
  float sgv[32], lgv[32];
  bf16_t qr[32];
  {
    bf16_t fpr[32];
#pragma unroll
    for (int k = 0; k < 32; ++k) { fpr[k] = FP[(long)(half * 32 + k) * 1024]; qr[k] = Q1[(long)(half * 32 + k) * 1024]; }
    { bf16_t* dp = sB + tl_r * LDT + tl_k; *(u32x4*)dp = vv0; *(u32x4*)(dp + 32 * LDT) = vv1; *(u32x4*)(dp + 64 * LDT) = vv2; *(u32x4*)(dp + 96 * LDT) = vv3; }
#pragma unroll
    for (int k = 0; k < 32; ++k) { sgv[k] = sigm(bf2f(fpr[k])); lgv[k] = __logf(lb + (1.f - lb) * sgv[k]); }
  }
  float sum = 0.f;
#pragma unroll
  for (int k = 0; k < 32; ++k) sum += lgv[k];
  psum[half * 128 + cch] = sum;
  __syncthreads();
  float run = half ? psum[cch] : 0.f;
  bf16_t* sQ = (cch < 64) ? sQ0 : sQ1;
  bf16_t* sK = (cch < 64) ? sK0 : sK1;
#pragma unroll
  for (int k = 0; k < 32; ++k) {
    const int s_ = half * 32 + k;
    run += lgv[k];
    float kk_ = (1.f - lb) * (1.f - sgv[k]);
    sQ[s_ * LDT + cc] = f2bf(bf2f(qr[k]) * __expf(run));
    sK[s_ * LDT + cc] = f2bf(kk_ * __expf(fminf(-run, 80.f)));
  }
  __syncthreads();
  {
    f32x4 a1[2][2];
#pragma unroll
    for (int mt = 0; mt < 2; ++mt)
#pragma unroll
      for (int nt = 0; nt < 2; ++nt) a1[mt][nt] = f32x4{0.f, 0.f, 0.f, 0.f};
    if (!(wr == 0 && wc == 1)) {
      mma_lds<2, 2, 2>(sQ0 + wr * 32 * LDT, sK0 + wc * 32 * LDT, a1, lane);
      mma_lds<2, 2, 2>(sQ1 + wr * 32 * LDT, sK1 + wc * 32 * LDT, a1, lane);
    }
#pragma unroll
    for (int mt = 0; mt < 2; ++mt)
#pragma unroll
      for (int i = 0; i < 4; ++i) {
        int j = wr * 32 + mt * 16 + q * 4 + i;
#pragma unroll
        for (int nt = 0; nt < 2; ++nt) {
          int s = wc * 32 + nt * 16 + r;
          sAm[j * LDT + s] = f2bf((s <= j) ? a1[mt][nt][i] : 0.f);
        }
      }
  }
  __syncthreads();
  f32x4 o[2][4];
#pragma unroll
  for (int mt = 0; mt < 2; ++mt)
#pragma unroll
    for (int nt = 0; nt < 4; ++nt) o[mt][nt] = f32x4{0.f, 0.f, 0.f, 0.f};
  mma_lds<2, 4, 2>(sAm + wr * 32 * LDT, sB + wc * 64 * LDT, o, lane);
  __syncthreads();
  { bf16_t* dp = sB + tl_r * LDT + tl_k; *(u32x4*)dp = sa0; *(u32x4*)(dp + 32 * LDT) = sa1; *(u32x4*)(dp + 64 * LDT) = sa2; *(u32x4*)(dp + 96 * LDT) = sa3; }
  __syncthreads();
  mma_lds<2, 4, 2>(sQ0 + wr * 32 * LDT, sB + wc * 64 * LDT, o, lane);
  __syncthreads();
  { bf16_t* dp = sB + tl_r * LDT + tl_k; *(u32x4*)dp = sb0; *(u32x4*)(dp + 32 * LDT) = sb1; *(u32x4*)(dp + 64 * LDT) = sb2; *(u32x4*)(dp + 96 * LDT) = sb3; }
  __syncthreads();
  mma_lds<2, 4, 2>(sQ1 + wr * 32 * LDT, sB + wc * 64 * LDT, o, lane);
#pragma unroll
  for (int mt = 0; mt < 2; ++mt)
#pragma unroll
    for (int i = 0; i < 4; ++i) {
      int j = wr * 32 + mt * 16 + q * 4 + i;
      float ss = 0.f;
#pragma unroll
      for (int nt = 0; nt < 4; ++nt) ss += o[mt][nt][i] * o[mt][nt][i];
      ss = grp16_sum(ss);
      if (r == 0) sSs[wc * 64 + j] = ss;
    }
  __syncthreads();
  const bf16_t* Z1 = (const bf16_t*)(ws + L1_Z);
  bf16_t* Y1 = (bf16_t*)(ws + L1_H);
  float hn[4];
#pragma unroll
  for (int nt = 0; nt < 4; ++nt) hn[nt] = p.h_hn[h * 128 + wc * 64 + nt * 16 + r];
#pragma unroll
  for (int mt = 0; mt < 2; ++mt) {
    float zv[4][4];
#pragma unroll
    for (int i = 0; i < 4; ++i) {
      long row = R0 + wr * 32 + mt * 16 + q * 4 + i;
#pragma unroll
      for (int nt = 0; nt < 4; ++nt) zv[i][nt] = bf2f(Z1[row * 1024 + h * 128 + wc * 64 + nt * 16 + r]);
    }
#pragma unroll
    for (int i = 0; i < 4; ++i) {
      int j = wr * 32 + mt * 16 + q * 4 + i;
      float rinv = rsqrtf((sSs[j] + sSs[64 + j]) * (1.f / 128.f) + EPSF);
      long row = R0 + j;
#pragma unroll
      for (int nt = 0; nt < 4; ++nt) {
        int col = h * 128 + wc * 64 + nt * 16 + r;
        Y1[row * 1024 + col] = f2bf(o[mt][nt][i] * rinv * hn[nt] * zv[i][nt]);
      }
    }
  }
  __syncthreads();
}

#define XB_TMO      128
#define XB_XCNT(j)  (256  + 64 * (j))
#define XB_XSUB(j)  (1280 + 64 * (j))
#define XB_XGEN(j)  (2304 + 64 * (j))
#define XB_TOP      3328
#define XB_TOPGEN   3392
#define XCD_BAR_WORDS 3456
#define XB_SPIN_CAP (1u << 22)
DEVI unsigned xb_ld(unsigned* p) { return __hip_atomic_load(p, __ATOMIC_RELAXED, __HIP_MEMORY_SCOPE_AGENT); }
DEVI unsigned xb_add(unsigned* p, unsigned v) { return __hip_atomic_fetch_add(p, v, __ATOMIC_RELAXED, __HIP_MEMORY_SCOPE_AGENT); }
DEVI unsigned xb_xcc_id() { return (unsigned)__builtin_amdgcn_s_getreg((3 << 11) | 20) & 0xFu; }
#define XB_SPIN(cond, bar) do { unsigned _sp = 0; while (cond) { __builtin_amdgcn_s_sleep(1); \
    if ((++_sp & 255u) == 0u) { if (xb_ld(&(bar)[XB_TMO])) break; if (_sp > XB_SPIN_CAP) { atomicAdd(&(bar)[XB_TMO], 1u); break; } } } } while (0)

DEVI void xcd_barrier_complete(unsigned* bar, unsigned x, unsigned& nloc, unsigned& nx) {
  const unsigned G = gridDim.x;
  unsigned sum, cnt, mine, sp = 0u;
  for (;;) {
    sum = 0u; cnt = 0u; mine = 0u;
#pragma unroll
    for (unsigned j = 0; j < 16; ++j) { const unsigned c = xb_ld(&bar[XB_XCNT(j)]); sum += c; cnt += (c > 0u) ? 1u : 0u; mine = (j == x) ? c : mine; }
    if (sum == G) break;
    __builtin_amdgcn_s_sleep(1);
    if ((++sp & 255u) == 0u) { if (xb_ld(&bar[XB_TMO])) break; if (sp > XB_SPIN_CAP) { atomicAdd(&bar[XB_TMO], 1u); break; } }
  }
  nloc = mine > 0u ? mine : 1u; nx = cnt > 0u ? cnt : 1u;
}

DEVI void grid_barrier(unsigned* bar, unsigned xcc, volatile unsigned* st) {
  asm volatile("s_waitcnt vmcnt(0)" ::: "memory");
  __syncthreads();
  if (threadIdx.x == 0) {
    __builtin_amdgcn_s_waitcnt(0);
    unsigned nloc = st[0], nx = st[1];
    if (nloc == 0u) { xcd_barrier_complete(bar, xcc, nloc, nx); st[0] = nloc; st[1] = nx; }
    const unsigned old = xb_add(&bar[XB_XSUB(xcc)], 1u);
    const unsigned gen = old / nloc;
    if (old + 1u == (gen + 1u) * nloc) {
      __builtin_amdgcn_fence(__ATOMIC_RELEASE, "agent");
      asm volatile("s_waitcnt vmcnt(0)" ::: "memory");
      const unsigned og = xb_add(&bar[XB_TOP], 1u);
      const unsigned tg = og / nx;
      if (og + 1u == (tg + 1u) * nx) xb_add(&bar[XB_TOPGEN], 1u);
      else XB_SPIN(xb_ld(&bar[XB_TOPGEN]) == tg, bar);
      __builtin_amdgcn_fence(__ATOMIC_ACQUIRE, "agent");
      xb_add(&bar[XB_XGEN(xcc)], 1u);
      asm volatile("s_waitcnt vmcnt(0)" ::: "memory");
    } else {
      XB_SPIN(xb_ld(&bar[XB_XGEN(xcc)]) == gen, bar);
      __builtin_amdgcn_fence(__ATOMIC_ACQUIRE, "agent");
      asm volatile("s_waitcnt vmcnt(0)" ::: "memory");
    }
  }
  __syncthreads();
}

#ifndef REP_NSA
#define REP_NSA 1
#endif
#ifndef REP_P0
#define REP_P0 1
#endif
#ifndef REP_P1
#define REP_P1 1
#endif
#ifndef REP_P2
#define REP_P2 1
#endif
#ifndef REP_P3
#define REP_P3 1
#endif
#ifndef REP_P4
#define REP_P4 1
#endif
#ifndef REP_P5
#define REP_P5 1
#endif
#ifndef REP_P6
#define REP_P6 1
#endif
#ifndef REP_P7
#define REP_P7 1
#endif
#ifndef REP_P8
#define REP_P8 1
#endif
#ifndef REP_P9
#define REP_P9 1
#endif
#ifndef REP_P10
#define REP_P10 1
#endif
#ifndef REP_P11
#define REP_P11 1
#endif
#ifndef REP_P12
#define REP_P12 1
#endif
#ifndef DBG_STOP
#define DBG_STOP 99
#endif
DEVI void dbg_probe_bf16(const Params& p, size_t off, long n) {
  const bf16_t* b = (const bf16_t*)(p.ws + off);
  for (long i = (long)blockIdx.x * 256 + threadIdx.x; i < 16384L * 1024; i += (long)gridDim.x * 256) {
    float v = bf2f(b[i % n]);
    if (!(v == v) || fabsf(v) > 1e30f) v = 777.f;
    p.out[i] = v;
  }
}
DEVI void dbg_probe_f32(const Params& p, size_t off, long n) {
  const float* b = (const float*)(p.ws + off);
  for (long i = (long)blockIdx.x * 256 + threadIdx.x; i < 16384L * 1024; i += (long)gridDim.x * 256) {
    float v = b[i % n];
    if (!(v == v) || fabsf(v) > 1e30f) v = 777.f;
    p.out[i] = v;
  }
}
DEVI void dbg_probe_combo(const Params& p) {
  const bf16_t* qn = (const bf16_t*)(p.ws + L0_QN);
  const bf16_t* ks = (const bf16_t*)(p.ws + L0_KS);
  const bf16_t* nz = (const bf16_t*)(p.ws + L0_NZ);
  const float* ig = (const float*)(p.ws + L0_IG);
  for (long i = (long)blockIdx.x * 256 + threadIdx.x; i < 16384L * 1024; i += (long)gridDim.x * 256) {
    float v = bf2f(qn[i % (16384L * 512)]) + bf2f(ks[i % (4L * 8192 * 64 * 4)]) + bf2f(nz[i % (16384L * 512)]) + ig[i % (16384L * 32)];
    if (!(v == v) || fabsf(v) > 1e30f) v = 777.f;
    p.out[i] = v;
  }
}
#define DBG_AT(k, stmt) if (DBG_STOP == k) { stmt; return; }

#define GSYNC() grid_barrier(bar_ctr, bar_xcc, bar_st)

__global__ void __launch_bounds__(256, 2) mega(Params p) {
  __shared__ __attribute__((aligned(16))) unsigned char smem[79872];
  cg::grid_group grid = cg::this_grid();
  const int G = gridDim.x, bid = blockIdx.x, tid = threadIdx.x, lane = tid & 63, w = tid >> 6;
  unsigned char* ws = p.ws;
  bf16_t* sA = (bf16_t*)smem;
  bf16_t* sB = (bf16_t*)(smem + 16384);
  unsigned* bar_ctr = (unsigned*)(ws + OFF_BAR);
  __shared__ uint4 xb_words;
  if (tid == 0) xb_words = make_uint4(0u, 0u, 0u, 0u);
  __syncthreads();
  volatile unsigned* bar_st = (volatile unsigned*)&xb_words;
  const unsigned bar_xcc = xb_xcc_id();
  if (tid == 0) (void)xb_add(&bar_ctr[XB_XCNT(bar_xcc)], 1u);
  if (p.ws == nullptr) grid.sync();

#ifdef EXTRA_SYNCS
  for (int e_ = 0; e_ < EXTRA_SYNCS; ++e_) GSYNC();
#endif
  for (int rep_ = 0; rep_ < REP_P0; ++rep_) {
  phase0(p, smem);
  GSYNC();
  }
  DBG_AT(0, dbg_probe_bf16(p, L0_H, 16384L*1024))
  for (int rep_ = 0; rep_ < REP_P1; ++rep_) {
#ifdef USE_G256
#ifdef USE_WQ1
  {
    unsigned* wq = bar_ctr + 3600;
    volatile unsigned* slot = (volatile unsigned*)&xb_words;
    for (int s_ = 0; s_ < 8; ++s_) {
      const int x = (int)((bar_xcc + (unsigned)s_) & 7u);
      for (;;) {
        if (tid == 0) slot[3] = xb_add(&wq[(8 + x) * 64], 1u);
        __syncthreads();
        const int u = (int)slot[3];
        __syncthreads();
        if (u >= 304) break;
        if (u < 256) {
          const int tm = x * 8 + ((u & 63) >> 3), tn = (u >> 6) * 8 + (u & 7);
          gemm256((const bf16_t*)(ws + L0_H), 1024, (const bf16_t*)(ws + OFF_WIN0), 1024, 1024, tm * 256, tn * 128, sA, (bf16_t*)(smem + 32768),
                  [&](f32x4 (&acc)[4][4], int mb, int nb, int ln) { epi_proj0(p, acc, mb, nb, ln); });
        } else {
          const int v_ = u - 256;
          const int tm = x * 16 + v_ / 3, tn = 32 + v_ % 3;
          gemm128<false>((const bf16_t*)(ws + L0_H), 1024, 16383, (const bf16_t*)(ws + OFF_WIN0), 1024, 4383, 1024, tm * 128, tn * 128, sA, sB,
                  [&](f32x4 (&acc)[4][4], int mb, int nb, int ln) { epi_proj0(p, acc, mb, nb, ln); });
        }
      }
    }
  }
#else
  for (int k_ = 0; k_ * (G >> 3) < 8 * 32; ++k_) {
    int tm, tn;
    if (!gemm_tile_xcd256(bid, G, k_, 32, tm, tn)) continue;
    gemm256((const bf16_t*)(ws + L0_H), 1024, (const bf16_t*)(ws + OFF_WIN0), 1024, 1024, tm * 256, tn * 128, sA, (bf16_t*)(smem + 32768),
            [&](f32x4 (&acc)[4][4], int mb, int nb, int ln) { epi_proj0(p, acc, mb, nb, ln); });
  }
  for (int v_ = (bid >> 3); v_ < 48; v_ += (G >> 3)) {
    const int tm = (bid & 7) * 16 + v_ / 3, tn = 32 + v_ % 3;
    gemm128<false>((const bf16_t*)(ws + L0_H), 1024, 16383, (const bf16_t*)(ws + OFF_WIN0), 1024, 4383, 1024, tm * 128, tn * 128, sA, sB,
            [&](f32x4 (&acc)[4][4], int mb, int nb, int ln) { epi_proj0(p, acc, mb, nb, ln); });
  }
#endif
#else
  for (int k_ = 0; k_ * (G >> 3) < 16 * 35; ++k_) {
    int tm, tn;
    if (!gemm_tile_xcd(bid, G, k_, 35, tm, tn)) continue;
    gemm128<false>((const bf16_t*)(ws + L0_H), 1024, 16383, (const bf16_t*)(ws + OFF_WIN0), 1024, 4383, 1024, tm * 128, tn * 128, sA, sB,
            [&](f32x4 (&acc)[4][4], int mb, int nb, int ln) { epi_proj0(p, acc, mb, nb, ln); });
  }
#endif
  GSYNC();
  }
  DBG_AT(1, dbg_probe_bf16(p, L0_QKRAW, 16384L*1024)) DBG_AT(101, dbg_probe_combo(p)) DBG_AT(102, dbg_probe_bf16(p, L0_KS, 4L*8192*64*4)) DBG_AT(103, dbg_probe_f32(p, L0_IG, 16384L*4*2+16384L*24)) DBG_AT(104, dbg_probe_bf16(p, L0_MVT, 16384L*512*3))
  for (int rep_ = 0; rep_ < REP_P2; ++rep_) {
  for (int it = bid; it < 128 + 2048; it += G) {
    if (it < 128) {
      int ksp = it >> 5, kv = (it >> 4) & 1, bg = (it >> 2) & 3, tm = it & 3;
      const bf16_t* A = (const bf16_t*)(ws + (kv ? L0_VCRAW : L0_KCRAW)) + (long)bg * 8192 * 64 + ksp * 512;
      const bf16_t* B = (const bf16_t*)(ws + (kv ? OFF_WCV : OFF_WCK)) + ksp * 512;
      gemm128<false>(A, 1024, 510, B, 2048, 127, 512, tm * 128, 0, sA, sB,
              [&](f32x4 (&acc)[4][4], int mb, int nb, int ln) { epi_cmp_hidden(p, acc, mb, nb, ln, kv, bg, ksp); });
    } else {
      conv_tile(p, it - 128, smem);
    }
  }
  GSYNC();
  }
  DBG_AT(2, dbg_probe_bf16(p, L0_QC, 16384L*512*3)) DBG_AT(201, dbg_probe_f32(p, L0_HID, 2L*4*512*128))
  for (int rep_ = 0; rep_ < REP_P3; ++rep_) {
  for (int it = bid; it < 512 + 1024; it += G) {
    if (it < 512) mlstm_local(p, it, smem);
    else { const int t_ = opaque_tid(); cmp_finalize(p, (it - 512) * 4 + (t_ >> 6), t_ & 63); }
  }
  GSYNC();
  }
  DBG_AT(3, dbg_probe_f32(p, L0_H, 512L*16384)) DBG_AT(301, dbg_probe_bf16(p, L0_KCMP, 4L*512*64*2)) DBG_AT(302, dbg_probe_f32(p, L0_DN, 512L*128 + 2048))
  for (int rep_ = 0; rep_ < REP_P4; ++rep_) {
#ifdef DUMMY_P4
  mlstm_scan<true>(p, smem);
  GSYNC();
#endif
  mlstm_scan<false>(p, smem);
  GSYNC();
  }
  DBG_AT(4, dbg_probe_f32(p, L0_H, 512L*16384)) DBG_AT(401, dbg_probe_f32(p, L0_DN, 512L*128 + 3072))
  for (int rep_ = 0; rep_ < REP_P5; ++rep_) {
#ifdef USE_WQ
  {
    unsigned* wq = bar_ctr + 3600;
    volatile unsigned* slot = (volatile unsigned*)&xb_words;
    for (int s_ = 0; s_ < 5; ++s_) {
      const int qi = (s_ < 4) ? (int)((bar_xcc + (unsigned)s_) & 3u) : 4;
      const int qn_ = (s_ < 4) ? 256 : 1024;
      for (;;) {
        if (tid == 0) slot[3] = xb_add(&wq[qi * 64], 1u);
        __syncthreads();
        const int it = (int)slot[3];
        __syncthreads();
        if (it >= qn_) break;
        if (s_ < 4) nsa_tile(p, (255 - it) * 4 + qi, smem);
        else mlstm_out(p, it, smem);
      }
    }
  }
#else
  for (int it = bid; it < 1024 + 1024; it += G) {
    if (it < 1024) {
      int k = it >> 9, i = it & 511;
      int idx = (k & 1) ? (k * 512 + 511 - i) : it;
#ifndef DBG_SKIP_NSA
      for (int r2_ = 0; r2_ < REP_NSA; ++r2_) nsa_tile(p, idx, smem);
#endif
    } else {
#ifndef DBG_SKIP_MOUT
      mlstm_out(p, it - 1024, smem);
#endif
    }
  }
#endif
  GSYNC();
  }
  DBG_AT(5, dbg_probe_bf16(p, L0_QKRAW, 16384L*1024))
  for (int rep_ = 0; rep_ < REP_P6; ++rep_) {
#ifdef USE_G256
  for (int k_ = 0; k_ * (G >> 3) < 8 * 8; ++k_) {
    int tm, tn;
    if (!gemm_tile_xcd256(bid, G, k_, 8, tm, tn)) continue;
    gemm256((const bf16_t*)(ws + L0_QKRAW), 1024, (const bf16_t*)(ws + OFF_WOUT0), 1024, 1024, tm * 256, tn * 128, sA, (bf16_t*)(smem + 32768),
            [&](f32x4 (&acc)[4][4], int mb, int nb, int ln) { epi_out_resid(p.x, p.out, acc, mb, nb, ln); });
  }
#else
  for (int k_ = 0; k_ * (G >> 3) < 16 * 8; ++k_) {
    int tm, tn;
    if (!gemm_tile_xcd(bid, G, k_, 8, tm, tn)) continue;
    gemm128<false>((const bf16_t*)(ws + L0_QKRAW), 1024, 16383, (const bf16_t*)(ws + OFF_WOUT0), 1024, 1023, 1024, tm * 128, tn * 128, sA, sB,
            [&](f32x4 (&acc)[4][4], int mb, int nb, int ln) { epi_out_resid(p.x, p.out, acc, mb, nb, ln); });
  }
#endif
  GSYNC();
  }
  DBG_AT(6, (void)0)
  for (int rep_ = 0; rep_ < REP_P7; ++rep_) {
  { const int t_ = opaque_tid(); for (int row = (bid * 4 + (t_ >> 6)) * 2; row < 16384; row += G * 8) rmsnorm_row2(p.out, p.norm_w + 1024, (bf16_t*)(ws + L1_H), row, row + 1, t_ & 63); }
  GSYNC();
  }
  DBG_AT(7, dbg_probe_bf16(p, L1_H, 16384L*1024))
  for (int rep_ = 0; rep_ < REP_P8; ++rep_) {
#ifdef USE_G256
  for (int k_ = 0; k_ * (G >> 3) < 8 * 32; ++k_) {
    int tm, tn;
    if (!gemm_tile_xcd256(bid, G, k_, 32, tm, tn)) continue;
    gemm256((const bf16_t*)(ws + L1_H), 1024, (const bf16_t*)(ws + OFF_WIN1), 1024, 1024, tm * 256, tn * 128, sA, (bf16_t*)(smem + 32768),
            [&](f32x4 (&acc)[4][4], int mb, int nb, int ln) { epi_proj1(p, acc, mb, nb, ln); });
  }
#else
  for (int k_ = 0; k_ * (G >> 3) < 16 * 32; ++k_) {
    int tm, tn;
    if (!gemm_tile_xcd(bid, G, k_, 32, tm, tn)) continue;
    gemm128<false>((const bf16_t*)(ws + L1_H), 1024, 16383, (const bf16_t*)(ws + OFF_WIN1), 1024, 4095, 1024, tm * 128, tn * 128, sA, sB,
            [&](f32x4 (&acc)[4][4], int mb, int nb, int ln) { epi_proj1(p, acc, mb, nb, ln); });
  }
#endif
  GSYNC();
  }
  DBG_AT(8, dbg_probe_bf16(p, L1_FP, 16384L*1024*4))
  for (int rep_ = 0; rep_ < REP_P9; ++rep_) {
  for (int it = bid; it < 2048; it += G) hgrn_local(p, it, smem);
  GSYNC();
  }
  DBG_AT(9, dbg_probe_bf16(p, L1_ST, 2048L*16384))
  for (int rep_ = 0; rep_ < REP_P10; ++rep_) {
#ifdef DUMMY_P10
  hgrn_scan<true>(p);
  GSYNC();
#endif
  hgrn_scan<false>(p);
  GSYNC();
  }
  DBG_AT(10, dbg_probe_bf16(p, L1_ST, 2048L*16384))
  for (int rep_ = 0; rep_ < REP_P11; ++rep_) {
  for (int it = bid; it < 2048; it += G) hgrn_out(p, it, smem);
  GSYNC();
  }
  DBG_AT(11, dbg_probe_bf16(p, L1_H, 16384L*1024))
  for (int rep_ = 0; rep_ < REP_P12; ++rep_) {
#ifdef USE_G256
  for (int k_ = 0; k_ * (G >> 3) < 8 * 8; ++k_) {
    int tm, tn;
    if (!gemm_tile_xcd256(bid, G, k_, 8, tm, tn)) continue;
    gemm256((const bf16_t*)(ws + L1_H), 1024, (const bf16_t*)(ws + OFF_WOUT1), 1024, 1024, tm * 256, tn * 128, sA, (bf16_t*)(smem + 32768),
            [&](f32x4 (&acc)[4][4], int mb, int nb, int ln) { epi_out_resid(p.out, p.out, acc, mb, nb, ln); });
  }
#else
  for (int k_ = 0; k_ * (G >> 3) < 16 * 8; ++k_) {
    int tm, tn;
    if (!gemm_tile_xcd(bid, G, k_, 8, tm, tn)) continue;
    gemm128<false>((const bf16_t*)(ws + L1_H), 1024, 16383, (const bf16_t*)(ws + OFF_WOUT1), 1024, 1023, 1024, tm * 128, tn * 128, sA, sB,
            [&](f32x4 (&acc)[4][4], int mb, int nb, int ln) { epi_out_resid(p.out, p.out, acc, mb, nb, ln); });
  }
#endif
  }
}

extern "C" void kernel_launch(void* const* d_in, const int* in_sizes, int n_in, void* d_out, int out_size, void* d_ws, size_t ws_size,
                              hipStream_t stream) {
  static int grid_blocks = 0;
  if (!grid_blocks) {
    int dev = 0, cus = 0, per_cu = 0;
    (void)hipGetDevice(&dev);
    (void)hipDeviceGetAttribute(&cus, hipDeviceAttributeMultiprocessorCount, dev);
    (void)hipOccupancyMaxActiveBlocksPerMultiprocessor(&per_cu, mega, 256, 0);
    if (per_cu > 2) per_cu = 2;
    if (per_cu < 1) per_cu = 1;
    grid_blocks = cus * per_cu;
  }
  Params p{};
  const float** pf = (const float**)&p;
  for (int i = 0; i < 22; ++i) pf[i] = (const float*)d_in[i];
  p.out = (float*)d_out;
  p.ws = (unsigned char*)d_ws;
  (void)hipMemsetAsync((unsigned char*)d_ws + OFF_BAR, 0, 32768, stream);
  void* args[] = {&p};
  hipError_t e = hipLaunchCooperativeKernel((void*)mega, dim3(grid_blocks), dim3(256), args, 0, stream);
  if (e != hipSuccess) fprintf(stderr, "cooperative launch failed: %s (grid %d)\n", hipGetErrorString(e), grid_blocks);
}
```

```cpp
#include <hip/hip_runtime.h>
#define USE_G256 1
#define USE_WQ 1
#include <hip/hip_cooperative_groups.h>
#include <stdint.h>
#include <cstdio>
namespace cg = cooperative_groups;

typedef unsigned short bf16_t;
typedef __attribute__((ext_vector_type(8))) short bf16x8;
typedef __attribute__((ext_vector_type(4))) float f32x4;
typedef __attribute__((ext_vector_type(4))) unsigned int u32x4;

#define DEVI __device__ __forceinline__
#define EPSF 1e-6f
#define LDT 72
#define SLD 68
#define NEGS (-1e30f)
#define LAUNDER(ptr) asm volatile("" : "+s"(ptr))

struct Params {
  const float* x; const float* norm_w; const float* ev_w_in; const float* ev_b_in; const float* f_bias;
  const float* conv_w; const float* conv_b; const float* m_hn; const float* q_norm; const float* k_norm;
  const float* ck_pos; const float* ck_w1; const float* ck_w2; const float* cv_pos; const float* cv_w1; const float* cv_w2;
  const float* ev_w_out; const float* od_w_in; const float* od_b_in; const float* lb_logits; const float* h_hn; const float* od_w_out;
  float* out; unsigned char* ws;
};

constexpr size_t MiB = 1048576;
constexpr size_t OFF_WIN0 = 0;
constexpr size_t OFF_WOUT0 = OFF_WIN0 + 4480ull * 1024 * 2;
constexpr size_t OFF_WIN1 = OFF_WOUT0 + 2 * MiB;
constexpr size_t OFF_WOUT1 = OFF_WIN1 + 8 * MiB;
constexpr size_t OFF_WCK = OFF_WOUT1 + 2 * MiB;
constexpr size_t OFF_WCV = OFF_WCK + 512 * 1024;
constexpr size_t OFF_ROPE = OFF_WCV + 512 * 1024;
constexpr size_t OFF_PB = OFF_ROPE + 512 * 1024;
constexpr size_t OFF_LB = OFF_PB + 1024;
constexpr size_t OFF_BAR = OFF_LB + 4096;
constexpr size_t OFF_BASE = 24 * MiB;
constexpr size_t L0_H = OFF_BASE;
constexpr size_t L0_QKRAW = L0_H + 32 * MiB;
constexpr size_t L0_QC = L0_QKRAW + 32 * MiB;
constexpr size_t L0_KC = L0_QC + 16 * MiB;
constexpr size_t L0_KCT = L0_KC + 16 * MiB;
constexpr size_t L0_MVT = L0_KCT + 16 * MiB;
constexpr size_t L0_MO = L0_MVT + 16 * MiB;
constexpr size_t L0_MZ = L0_MO + 16 * MiB;
constexpr size_t L0_QN = L0_MZ + 16 * MiB;
constexpr size_t L0_NZ = L0_QN + 16 * MiB;
constexpr size_t L0_KCRAW = L0_NZ + 16 * MiB;
constexpr size_t L0_VCRAW = L0_KCRAW + 4 * MiB;
constexpr size_t L0_KS = L0_VCRAW + 4 * MiB;
constexpr size_t L0_KW = L0_KS + 4 * MiB;
constexpr size_t L0_VST = L0_KW + 4 * MiB;
constexpr size_t L0_VWT = L0_VST + 4 * MiB;
constexpr size_t L0_HID = L0_VWT + 4 * MiB;
constexpr size_t L0_KCMP = L0_HID + 2 * MiB;
constexpr size_t L0_VCMPT = L0_KCMP + 256 * 1024;
constexpr size_t L0_IG = L0_VCMPT + 256 * 1024;
constexpr size_t L0_LOGF = L0_IG + 256 * 1024;
constexpr size_t L0_GATES = L0_LOGF + 256 * 1024;
constexpr size_t L0_DN = L0_GATES + 1536 * 1024;
constexpr size_t L0_BL = L0_DN + 256 * 1024;
constexpr size_t L0_MLOC = L0_BL + 4096;
constexpr size_t L0_MIN = L0_MLOC + 4096;
constexpr size_t L0_HIDP = L0_MIN + 4096;
constexpr size_t L0_END = L0_HIDP + 8 * MiB;
static_assert(L0_END <= 256 * MiB, "ws overflow L0");
constexpr size_t L1_H = OFF_BASE;
constexpr size_t L1_FP = L1_H + 32 * MiB;
constexpr size_t L1_Q = L1_FP + 32 * MiB;
constexpr size_t L1_VT = L1_Q + 32 * MiB;
constexpr size_t L1_Z = L1_VT + 32 * MiB;
constexpr size_t L1_ST = L1_Z + 32 * MiB;
constexpr size_t L1_BL = L1_ST + 64 * MiB;
constexpr size_t L1_END = L1_BL + 1 * MiB;
static_assert(L1_END <= 256 * MiB, "ws overflow L1");

DEVI int opaque_tid() { int t = threadIdx.x; asm volatile("" : "+v"(t)); return t; }
typedef __bf16 bf16v2_t __attribute__((ext_vector_type(2)));
typedef float f32v2_t __attribute__((ext_vector_type(2)));
DEVI bf16_t f2bf(float f) { __bf16 h = (__bf16)f; return __builtin_bit_cast(unsigned short, h); }
DEVI float bf2f(bf16_t b) { return __uint_as_float(((unsigned)b) << 16); }
DEVI unsigned pack2(float a, float b) { f32v2_t f = {a, b}; bf16v2_t h = __builtin_convertvector(f, bf16v2_t); return __builtin_bit_cast(unsigned, h); }
DEVI float lo2f(unsigned u) { return __uint_as_float(u << 16); }
DEVI float hi2f(unsigned u) { return __uint_as_float(u & 0xffff0000u); }
DEVI float sigm(float x) { return __builtin_amdgcn_rcpf(1.f + __expf(-x)); }
DEVI float siluf(float x) { return x * sigm(x); }
DEVI float wave_sum(float v) { for (int o = 32; o > 0; o >>= 1) v += __shfl_xor(v, o); return v; }
DEVI float grp16_sum(float v) { v += __shfl_xor(v, 1); v += __shfl_xor(v, 2); v += __shfl_xor(v, 4); v += __shfl_xor(v, 8); return v; }

DEVI void wave_scan_sum128(float& a, float& b, int lane) {
  float t = a + b;
  float s = t;
#pragma unroll
  for (int o = 1; o < 64; o <<= 1) { float u = __shfl_up(s, o); if (lane >= o) s += u; }
  const float excl = s - t;
  a = excl + a;
  b = a + b;
}
DEVI void wave_scan_max128(float& a, float& b, int lane) {
  float t = fmaxf(a, b);
  float s = t;
#pragma unroll
  for (int o = 1; o < 64; o <<= 1) { float u = __shfl_up(s, o); if (lane >= o) s = fmaxf(s, u); }
  float prev = __shfl_up(s, 1);
  if (lane == 0) prev = -3.0e38f;
  a = fmaxf(prev, a);
  b = fmaxf(a, b);
}
DEVI float wave_max(float v) { for (int o = 32; o > 0; o >>= 1) v = fmaxf(v, __shfl_xor(v, o)); return v; }
DEVI int oldcol(int n) {
  return n < 2560 ? n : (n < 3840 ? n + 8 : (n < 4352 ? n + 32 : (n < 4360 ? n - 4352 + 2560 : n - 4360 + 3848)));
}

template <int MT, int NTL, int KS>
DEVI void mma_lds(const bf16_t* sA, const bf16_t* sB, f32x4 (&acc)[MT][NTL], int lane, bool neg = false) {
  const int r = lane & 15, q = lane >> 4;
#pragma unroll
  for (int ks = 0; ks < KS; ++ks) {
    bf16x8 a[MT], b[NTL];
#pragma unroll
    for (int mt = 0; mt < MT; ++mt) a[mt] = *(const bf16x8*)(sA + (mt * 16 + r) * LDT + ks * 32 + q * 8);
    if (neg) {
#pragma unroll
      for (int mt = 0; mt < MT; ++mt) a[mt] ^= (short)0x8000;
    }
#pragma unroll
    for (int nt = 0; nt < NTL; ++nt) b[nt] = *(const bf16x8*)(sB + (nt * 16 + r) * LDT + ks * 32 + q * 8);
#pragma unroll
    for (int mt = 0; mt < MT; ++mt)
#pragma unroll
      for (int nt = 0; nt < NTL; ++nt) acc[mt][nt] = __builtin_amdgcn_mfma_f32_16x16x32_bf16(a[mt], b[nt], acc[mt][nt], 0, 0, 0);
  }
}
template <int MT, int NTL, int KS>
DEVI void mma_lds_sw(const bf16_t* sA, const bf16_t* sB, f32x4 (&acc)[MT][NTL], int lane, bool neg = false) {
  const int r = lane & 15, q = lane >> 4;
#pragma unroll
  for (int ks = 0; ks < KS; ++ks) {
    bf16x8 a[MT], b[NTL];
#pragma unroll
    for (int mt = 0; mt < MT; ++mt) a[mt] = *(const bf16x8*)(sA + (mt * 16 + r) * LDT + ks * 32 + q * 8);
    if (neg) {
#pragma unroll
      for (int mt = 0; mt < MT; ++mt) a[mt] ^= (short)0x8000;
    }
#pragma unroll
    for (int nt = 0; nt < NTL; ++nt) b[nt] = *(const bf16x8*)(sB + (nt * 16 + r) * LDT + ks * 32 + q * 8);
#pragma unroll
    for (int mt = 0; mt < MT; ++mt)
#pragma unroll
      for (int nt = 0; nt < NTL; ++nt) acc[mt][nt] = __builtin_amdgcn_mfma_f32_16x16x32_bf16(b[nt], a[mt], acc[mt][nt], 0, 0, 0);
  }
}


template <int MT, int NTL, bool SWAP>
DEVI void mma_swz(const bf16_t* sA, const bf16_t* sB, f32x4 (&acc)[MT][NTL], int lane, bool neg) {
  const int r = lane & 15, q = lane >> 4, r7 = r & 7;
#pragma unroll
  for (int ks = 0; ks < 2; ++ks) {
    bf16x8 a[MT], b[NTL];
    const int co = ((ks * 4 + q) ^ r7) * 8;
#pragma unroll
    for (int mt = 0; mt < MT; ++mt) a[mt] = *(const bf16x8*)(sA + (mt * 16 + r) * 64 + co);
#pragma unroll
    for (int nt = 0; nt < NTL; ++nt) b[nt] = *(const bf16x8*)(sB + (nt * 16 + r) * 64 + co);
    if (neg) {
#pragma unroll
      for (int mt = 0; mt < MT; ++mt) a[mt] ^= (short)0x8000;
    }
#pragma unroll
    for (int mt = 0; mt < MT; ++mt)
#pragma unroll
      for (int nt = 0; nt < NTL; ++nt) {
        if (SWAP) acc[mt][nt] = __builtin_amdgcn_mfma_f32_16x16x32_bf16(b[nt], a[mt], acc[mt][nt], 0, 0, 0);
        else acc[mt][nt] = __builtin_amdgcn_mfma_f32_16x16x32_bf16(a[mt], b[nt], acc[mt][nt], 0, 0, 0);
      }
  }
}

DEVI void load_tile128(bf16_t* s, const bf16_t* g, long ld) {
  const int tid = opaque_tid(), lr = tid >> 3, lk = (tid & 7) * 8;
#pragma unroll
  for (int j = 0; j < 4; ++j) *(uint4*)(s + (lr + 32 * j) * LDT + lk) = *(const uint4*)(g + (long)(lr + 32 * j) * ld + lk);
}
DEVI void load_tile64(bf16_t* s, const bf16_t* g, long ld) {
  const int tid = opaque_tid(), lr = tid >> 3, lk = (tid & 7) * 8;
#pragma unroll
  for (int j = 0; j < 2; ++j) *(uint4*)(s + (lr + 32 * j) * LDT + lk) = *(const uint4*)(g + (long)(lr + 32 * j) * ld + lk);
}

template <bool SWAP, class Epi>
DEVI void gemm128(const bf16_t* A, long lda, int amax, const bf16_t* B, long ldb, int bmax, int K, int m0, int n0,
                  bf16_t* sA, bf16_t* sB, Epi&& epi) {
  const int tid = opaque_tid(), lane = tid & 63, w = tid >> 6, wr = w >> 1, wc = w & 1;
  const int lr = tid >> 3, lk = (tid & 7) * 8;
  const int lsw = (((tid & 7) ^ (lr & 7)) * 8);
  f32x4 acc[4][4];
#pragma unroll
  for (int mt = 0; mt < 4; ++mt)
#pragma unroll
    for (int nt = 0; nt < 4; ++nt) acc[mt][nt] = f32x4{0.f, 0.f, 0.f, 0.f};
  const bf16_t* ap[4];
  const bf16_t* bp[4];
#pragma unroll
  for (int j = 0; j < 4; ++j) {
    int ra = min(m0 + lr + 32 * j, amax);
    ap[j] = A + (long)ra * lda + lk;
    int rb = min(n0 + lr + 32 * j, bmax);
    bp[j] = B + (long)rb * ldb + lk;
  }
#ifndef GEMM_PASSES
#define GEMM_PASSES 1
#endif
  for (int pass_ = 0; pass_ < GEMM_PASSES; ++pass_) {
  u32x4 va0, va1, va2, va3, vb0, vb1, vb2, vb3;
  va0 = *(const u32x4*)(ap[0]); va1 = *(const u32x4*)(ap[1]); va2 = *(const u32x4*)(ap[2]); va3 = *(const u32x4*)(ap[3]);
  vb0 = *(const u32x4*)(bp[0]); vb1 = *(const u32x4*)(bp[1]); vb2 = *(const u32x4*)(bp[2]); vb3 = *(const u32x4*)(bp[3]);
  const int KT = K >> 6;
  *(u32x4*)(sA + (lr + 0) * 64 + lsw) = va0; *(u32x4*)(sA + (lr + 32) * 64 + lsw) = va1;
  *(u32x4*)(sA + (lr + 64) * 64 + lsw) = va2; *(u32x4*)(sA + (lr + 96) * 64 + lsw) = va3;
  *(u32x4*)(sB + (lr + 0) * 64 + lsw) = vb0; *(u32x4*)(sB + (lr + 32) * 64 + lsw) = vb1;
  *(u32x4*)(sB + (lr + 64) * 64 + lsw) = vb2; *(u32x4*)(sB + (lr + 96) * 64 + lsw) = vb3;
  if (KT > 1) {
    va0 = *(const u32x4*)(ap[0] + 64); va1 = *(const u32x4*)(ap[1] + 64); va2 = *(const u32x4*)(ap[2] + 64); va3 = *(const u32x4*)(ap[3] + 64);
    vb0 = *(const u32x4*)(bp[0] + 64); vb1 = *(const u32x4*)(bp[1] + 64); vb2 = *(const u32x4*)(bp[2] + 64); vb3 = *(const u32x4*)(bp[3] + 64);
  }
  __syncthreads();
  for (int kt = 0; kt < KT; ++kt) {
    const int st = (kt & 1) * 16384;
    const int sn = ((kt + 1) & 1) * 16384;
    if (kt + 1 < KT) {
      *(u32x4*)(sA + sn + (lr + 0) * 64 + lsw) = va0; *(u32x4*)(sA + sn + (lr + 32) * 64 + lsw) = va1;
      *(u32x4*)(sA + sn + (lr + 64) * 64 + lsw) = va2; *(u32x4*)(sA + sn + (lr + 96) * 64 + lsw) = va3;
      *(u32x4*)(sB + sn + (lr + 0) * 64 + lsw) = vb0; *(u32x4*)(sB + sn + (lr + 32) * 64 + lsw) = vb1;
      *(u32x4*)(sB + sn + (lr + 64) * 64 + lsw) = vb2; *(u32x4*)(sB + sn + (lr + 96) * 64 + lsw) = vb3;
    }
    if (kt + 2 < KT) {
      const int ko = (kt + 2) * 64;
      va0 = *(const u32x4*)(ap[0] + ko); va1 = *(const u32x4*)(ap[1] + ko); va2 = *(const u32x4*)(ap[2] + ko); va3 = *(const u32x4*)(ap[3] + ko);
      vb0 = *(const u32x4*)(bp[0] + ko); vb1 = *(const u32x4*)(bp[1] + ko); vb2 = *(const u32x4*)(bp[2] + ko); vb3 = *(const u32x4*)(bp[3] + ko);
    }
    __builtin_amdgcn_sched_barrier(0);
    __builtin_amdgcn_s_setprio(2);
    mma_swz<4, 4, SWAP>(sA + st + wr * 64 * 64, sB + st + wc * 64 * 64, acc, lane, (pass_ & 1) != 0);
    __builtin_amdgcn_s_setprio(0);
    __syncthreads();
  }
  }
  epi(acc, m0 + wr * 64, n0 + wc * 64, lane);
}


DEVI bool gemm_tile_xcd(int bid, int G, int k, int NTN, int& tm, int& tn) {
  const int x = bid & 7, per = G >> 3;
  const int u = (bid >> 3) + per * k;
  const int full_groups = NTN >> 3, rem = NTN & 7;
  const int n_full = full_groups * 2 * 64;
  if (u < n_full) {
    const int sb = u >> 6, wi = u & 63;
    const int tg = sb >> 1, th = sb & 1;
    tm = x * 16 + th * 8 + (wi >> 3);
    tn = tg * 8 + (wi & 7);
    return true;
  }
  const int v = u - n_full;
  if (v >= 16 * rem) return false;
  tm = x * 16 + v / rem;
  tn = full_groups * 8 + v % rem;
  return true;
}


template <class Epi>
DEVI void gemm256(const bf16_t* A, long lda, const bf16_t* B, long ldb, int K, int m0, int n0, bf16_t* sA, bf16_t* sB, Epi&& epi) {
  const int tid = opaque_tid(), lane = tid & 63, w = tid >> 6, wr = w >> 1, wc = w & 1;
  const int lr = tid >> 3, lk = (tid & 7) * 8;
  const int lsw = (((tid & 7) ^ (lr & 7)) * 8);
  const int r = lane & 15, q = lane >> 4, r7 = r & 7;
  f32x4 acc[2][4][4];
#pragma unroll
  for (int hh = 0; hh < 2; ++hh)
#pragma unroll
    for (int mt = 0; mt < 4; ++mt)
#pragma unroll
      for (int nt = 0; nt < 4; ++nt) acc[hh][mt][nt] = f32x4{0.f, 0.f, 0.f, 0.f};
  const bf16_t* abase = A + (long)(m0 + lr) * lda + lk;
  const bf16_t* bbase = B + (long)(n0 + lr) * ldb + lk;
  u32x4 va[8], vb[4];
#pragma unroll
  for (int j = 0; j < 8; ++j) va[j] = *(const u32x4*)(abase + (long)(32 * j) * lda);
#pragma unroll
  for (int j = 0; j < 4; ++j) vb[j] = *(const u32x4*)(bbase + (long)(32 * j) * ldb);
  const int KT = K >> 6;
  for (int kt = 0; kt < KT; ++kt) {
#pragma unroll
    for (int j = 0; j < 8; ++j) *(u32x4*)(sA + (lr + 32 * j) * 64 + lsw) = va[j];
#pragma unroll
    for (int j = 0; j < 4; ++j) *(u32x4*)(sB + (lr + 32 * j) * 64 + lsw) = vb[j];
    __syncthreads();
    if (kt + 1 < KT) {
      const int ko = (kt + 1) * 64;
#pragma unroll
      for (int j = 0; j < 8; ++j) va[j] = *(const u32x4*)(abase + (long)(32 * j) * lda + ko);
#pragma unroll
      for (int j = 0; j < 4; ++j) vb[j] = *(const u32x4*)(bbase + (long)(32 * j) * ldb + ko);
    }
    __builtin_amdgcn_sched_barrier(0);
    __builtin_amdgcn_s_setprio(2);
#pragma unroll
    for (int ks = 0; ks < 2; ++ks) {
      const int co = ((ks * 4 + q) ^ r7) * 8;
      bf16x8 b[4];
#pragma unroll
      for (int nt = 0; nt < 4; ++nt) b[nt] = *(const bf16x8*)(sB + (wc * 64 + nt * 16 + r) * 64 + co);
#pragma unroll
      for (int hh = 0; hh < 2; ++hh) {
        bf16x8 a[4];
#pragma unroll
        for (int mt = 0; mt < 4; ++mt) a[mt] = *(const bf16x8*)(sA + (wr * 128 + hh * 64 + mt * 16 + r) * 64 + co);
#pragma unroll
        for (int mt = 0; mt < 4; ++mt)
#pragma unroll
          for (int nt = 0; nt < 4; ++nt) acc[hh][mt][nt] = __builtin_amdgcn_mfma_f32_16x16x32_bf16(a[mt], b[nt], acc[hh][mt][nt], 0, 0, 0);
      }
    }
    __builtin_amdgcn_s_setprio(0);
    __syncthreads();
  }
  epi(acc[0], m0 + wr * 128, n0 + wc * 64, lane);
  epi(acc[1], m0 + wr * 128 + 64, n0 + wc * 64, lane);
}

DEVI bool gemm_tile_xcd256(int bid, int G, int k, int NTN, int& tm, int& tn) {
  const int x = bid & 7, per = G >> 3;
  const int u = (bid >> 3) + per * k;
  if (u >= 8 * NTN) return false;
  const int tg = u >> 6, wi = u & 63;
  tm = x * 8 + (wi >> 3);
  tn = tg * 8 + (wi & 7);
  return true;
}

DEVI void transpose_tile(const float* src, int N, int ldsrc, bf16_t* dst, int K, int ktile, int ntile, bool perm, float* sT) {
  const int tid = opaque_tid();
  const int k0 = ktile * 64, n0 = ntile * 64;
#pragma unroll
  for (int j = 0; j < 4; ++j) {
    int idx = tid + 256 * j;
    int kk = idx >> 4, n4 = (idx & 15) * 4;
    int n = n0 + n4;
    float4 v = make_float4(0.f, 0.f, 0.f, 0.f);
    if (n < N) { int oc = perm ? oldcol(n) : n; const f32x4 t_ = __builtin_nontemporal_load((const f32x4*)(src + (long)(k0 + kk) * ldsrc + oc)); v = make_float4(t_[0], t_[1], t_[2], t_[3]); }
    sT[kk * 65 + n4 + 0] = v.x; sT[kk * 65 + n4 + 1] = v.y; sT[kk * 65 + n4 + 2] = v.z; sT[kk * 65 + n4 + 3] = v.w;
  }
  __syncthreads();
#pragma unroll
  for (int j = 0; j < 2; ++j) {
    int idx = tid + 256 * j;
    int nn = idx >> 3, kc = (idx & 7) * 8;
    if (n0 + nn < N) {
      uint4 o;
      o.x = pack2(sT[(kc + 0) * 65 + nn], sT[(kc + 1) * 65 + nn]);
      o.y = pack2(sT[(kc + 2) * 65 + nn], sT[(kc + 3) * 65 + nn]);
      o.z = pack2(sT[(kc + 4) * 65 + nn], sT[(kc + 5) * 65 + nn]);
      o.w = pack2(sT[(kc + 6) * 65 + nn], sT[(kc + 7) * 65 + nn]);
      *(uint4*)(dst + (long)(n0 + nn) * K + k0 + kc) = o;
    }
  }
  __syncthreads();
}

DEVI void rmsnorm_row2(const float* X, const float* w, bf16_t* H, int row0, int row1, int lane) {
  const float4* xa = (const float4*)(X + (long)row0 * 1024);
  const float4* xb = (const float4*)(X + (long)row1 * 1024);
  float4 va[4], vb[4], ww[4];
#pragma unroll
  for (int j = 0; j < 4; ++j) {
    const f32x4 ta_ = __builtin_nontemporal_load((const f32x4*)(xa + lane + 64 * j));
    const f32x4 tb_ = __builtin_nontemporal_load((const f32x4*)(xb + lane + 64 * j));
    va[j] = make_float4(ta_[0], ta_[1], ta_[2], ta_[3]); vb[j] = make_float4(tb_[0], tb_[1], tb_[2], tb_[3]);
    ww[j] = ((const float4*)w)[lane + 64 * j];
  }
  float sa = 0.f, sb = 0.f;
#pragma unroll
  for (int j = 0; j < 4; ++j) {
    sa += va[j].x * va[j].x + va[j].y * va[j].y + va[j].z * va[j].z + va[j].w * va[j].w;
    sb += vb[j].x * vb[j].x + vb[j].y * vb[j].y + vb[j].z * vb[j].z + vb[j].w * vb[j].w;
  }
  sa = wave_sum(sa); sb = wave_sum(sb);
  const float ra = rsqrtf(sa * (1.f / 1024.f) + EPSF), rb = rsqrtf(sb * (1.f / 1024.f) + EPSF);
#pragma unroll
  for (int j = 0; j < 4; ++j) {
    uint2 o;
    o.x = pack2(va[j].x * ra * ww[j].x, va[j].y * ra * ww[j].y);
    o.y = pack2(va[j].z * ra * ww[j].z, va[j].w * ra * ww[j].w);
    *(uint2*)(H + (long)row0 * 1024 + (lane + 64 * j) * 4) = o;
    o.x = pack2(vb[j].x * rb * ww[j].x, vb[j].y * rb * ww[j].y);
    o.y = pack2(vb[j].z * rb * ww[j].z, vb[j].w * rb * ww[j].w);
    *(uint2*)(H + (long)row1 * 1024 + (lane + 64 * j) * 4) = o;
  }
}

DEVI void phase0(const Params& p, unsigned char* smem) {
  const int G = gridDim.x, bid = blockIdx.x, tid = threadIdx.x, lane = tid & 63, w = tid >> 6;
  unsigned char* ws = p.ws;
  float* sT = (float*)smem;
  for (int it = bid; it < 69 * 16; it += G) transpose_tile(p.ev_w_in, 4384, 4384, (bf16_t*)(ws + OFF_WIN0), 1024, it / 69, it % 69, true, sT);
  for (int it = bid; it < 16 * 16; it += G) transpose_tile(p.ev_w_out, 1024, 1024, (bf16_t*)(ws + OFF_WOUT0), 1024, it / 16, it % 16, false, sT);
  for (int it = bid; it < 64 * 16; it += G) transpose_tile(p.od_w_in, 4096, 4096, (bf16_t*)(ws + OFF_WIN1), 1024, it / 64, it % 64, false, sT);
  for (int it = bid; it < 16 * 16; it += G) transpose_tile(p.od_w_out, 1024, 1024, (bf16_t*)(ws + OFF_WOUT1), 1024, it / 16, it % 16, false, sT);
  for (int it = bid; it < 2 * 32; it += G) transpose_tile(p.ck_w1, 128, 128, (bf16_t*)(ws + OFF_WCK), 2048, it / 2, it % 2, false, sT);
  for (int it = bid; it < 2 * 32; it += G) transpose_tile(p.cv_w1, 128, 128, (bf16_t*)(ws + OFF_WCV), 2048, it / 2, it % 2, false, sT);
  for (int row = (bid * 4 + w) * 2; row < 16384; row += G * 8) rmsnorm_row2(p.x, p.norm_w, (bf16_t*)(ws + L0_H), row, row + 1, lane);
  for (int idx = bid * 256 + tid; idx < 8192 * 8; idx += G * 256) {
    int t = idx >> 3, i = idx & 7;
    float invf = powf(500000.0f, -(float)i / 8.0f);
    float ang = (float)t * invf;
    double a = (double)ang;
    float2 cs;
    cs.x = (float)cos(a);
    cs.y = (float)sin(a);
    ((float2*)(ws + OFF_ROPE))[idx] = cs;
  }
  for (int o = bid * 4 + w; o < 256; o += G * 4) {
    int kv = o >> 7, j = o & 127;
    const float* pos = kv ? p.cv_pos : p.ck_pos;
    const float* w1 = kv ? p.cv_w1 : p.ck_w1;
    float sacc_ = 0.f;
#pragma unroll 8
    for (int i = lane; i < 2048; i += 64) sacc_ += pos[i] * w1[i * 128 + j];
    sacc_ = wave_sum(sacc_);
    if (lane == 0) ((float*)(ws + OFF_PB))[o] = sacc_;
  }
  if (bid == G - 2 || G < 2) {
    for (int c = tid; c < 1024; c += 256) {
      float l0 = p.lb_logits[c], l1 = p.lb_logits[1024 + c];
      ((float*)(ws + OFF_LB))[c] = 1.f / (1.f + expf(l1 - l0));
    }
  }
}

template <int MODE>
DEVI void store_rm(bf16_t* dst, int ld, int colbase, f32x4 (&acc)[4][4], const float* bias, int mb, int lane) {
  const int r = lane & 15, q = lane >> 4;
#pragma unroll
  for (int mt = 0; mt < 4; ++mt)
#pragma unroll
    for (int i = 0; i < 4; ++i) {
      long row = mb + mt * 16 + q * 4 + i;
#pragma unroll
      for (int nt = 0; nt < 4; ++nt) {
        float v = acc[mt][nt][i] + bias[nt];
        if (MODE == 1) v = sigm(v);
        if (MODE == 2) v = siluf(v);
        dst[row * ld + colbase + nt * 16 + r] = f2bf(v);
      }
    }
}
template <int MODE>
DEVI void store_T(bf16_t* dst, int bgrp, int F, int featoff, f32x4 (&acc)[4][4], const float* bias, int tl0, int lane) {
  const int r = lane & 15, q = lane >> 4;
#pragma unroll
  for (int mt = 0; mt < 4; ++mt)
#pragma unroll
    for (int nt = 0; nt < 4; ++nt) {
      int t = tl0 + mt * 16 + q * 4;
      float b = bias[nt];
      uint2 o;
      o.x = pack2(acc[mt][nt][0] + b, acc[mt][nt][1] + b);
      o.y = pack2(acc[mt][nt][2] + b, acc[mt][nt][3] + b);
      *(uint2*)(dst + (((long)bgrp * 128 + (t >> 6)) * F + featoff + nt * 16 + r) * 64 + (t & 63)) = o;
    }
}
DEVI void norm_rope_store(bf16_t* dst, long rowbase, int ld, int colbase, f32x4 (&acc)[4][4], const float* bias, const float* nw,
                          float scale, const float2* rope, int mb, int lane) {
  const int r = lane & 15, q = lane >> 4;
  float wv[4];
#pragma unroll
  for (int nt = 0; nt < 4; ++nt) wv[nt] = nw[nt * 16 + r];
  float2 csv[4][4];
#pragma unroll
  for (int mt = 0; mt < 4; ++mt)
#pragma unroll
    for (int i = 0; i < 4; ++i) csv[mt][i] = rope[((mb + mt * 16 + q * 4 + i) & 8191) * 8 + (r & 7)];
#pragma unroll
  for (int mt = 0; mt < 4; ++mt)
#pragma unroll
    for (int i = 0; i < 4; ++i) {
      int row = mb + mt * 16 + q * 4 + i;
      int t = row & 8191;
      float v[4];
      float ss = 0.f;
#pragma unroll
      for (int nt = 0; nt < 4; ++nt) { v[nt] = acc[mt][nt][i] + bias[nt]; ss += v[nt] * v[nt]; }
      ss = grp16_sum(ss);
      float rinv = rsqrtf(ss * (1.f / 64.f) + EPSF);
#pragma unroll
      for (int nt = 0; nt < 4; ++nt) v[nt] = v[nt] * rinv * wv[nt];
      float partner = __shfl_xor(v[0], 8);
      float2 cs = csv[mt][i];
      float x1 = (r < 8) ? v[0] : partner, x2 = (r < 8) ? partner : v[0];
      v[0] = (r < 8) ? (x1 * cs.x - x2 * cs.y) : (x1 * cs.y + x2 * cs.x);
#pragma unroll
      for (int nt = 0; nt < 4; ++nt) dst[(rowbase + t) * ld + colbase + nt * 16 + r] = f2bf(v[nt] * scale);
    }
}

DEVI void epi_proj0(const Params& p, f32x4 (&acc)[4][4], int mb, int nb, int lane) {
  if (nb >= 4384) return;
  unsigned char* ws = p.ws;
  const int r = lane & 15, q = lane >> 4;
  float bias[4];
#pragma unroll
  for (int nt = 0; nt < 4; ++nt) { int n = nb + nt * 16 + r; bias[nt] = (n < 4384) ? p.ev_b_in[oldcol(n)] : 0.f; }
  const int b = mb >> 13;
  const int tl0 = mb & 8191;
  const float2* rope = (const float2*)(ws + OFF_ROPE);
  if (nb < 1024) {
    store_rm<0>((bf16_t*)(ws + L0_QKRAW), 1024, nb, acc, bias, mb, lane);
  } else if (nb < 1536) {
    store_T<0>((bf16_t*)(ws + L0_MVT), b * 4 + ((nb - 1024) >> 7), 128, (nb - 1024) & 127, acc, bias, tl0, lane);
  } else if (nb < 2048) {
    store_rm<1>((bf16_t*)(ws + L0_MO), 512, nb - 1536, acc, bias, mb, lane);
  } else if (nb < 2560) {
    store_rm<2>((bf16_t*)(ws + L0_MZ), 512, nb - 2048, acc, bias, mb, lane);
  } else if (nb < 3072) {
    int head = (nb - 2560) >> 6, g = head >> 2, rr = head & 3;
    norm_rope_store((bf16_t*)(ws + L0_QN), (long)(b * 2 + g) * 8192, 256, rr * 64, acc, bias, p.q_norm, 0.125f * 1.4426950408889634f, rope, mb, lane);
  } else if (nb < 3328) {
    int g = ((nb - 3072) >> 6) & 1;
    bf16_t* dst = (bf16_t*)(ws + (nb < 3200 ? L0_KCRAW : L0_VCRAW));
    const long rowbase = (long)(b * 2 + g) * 8192;
#pragma unroll
    for (int mt = 0; mt < 4; ++mt)
#pragma unroll
      for (int i = 0; i < 4; ++i) {
        int t = (mb + mt * 16 + q * 4 + i) & 8191;
#pragma unroll
        for (int nt = 0; nt < 4; ++nt) dst[(rowbase + t) * 64 + nt * 16 + r] = f2bf(acc[mt][nt][i] + bias[nt]);
      }
  } else if (nb < 3456) {
    int g = (nb - 3328) >> 6;
    norm_rope_store((bf16_t*)(ws + L0_KS), (long)(b * 2 + g) * 8192, 64, 0, acc, bias, p.k_norm + 64, 1.f, rope, mb, lane);
  } else if (nb < 3584) {
    store_T<0>((bf16_t*)(ws + L0_VST), b * 2 + ((nb - 3456) >> 6), 64, 0, acc, bias, tl0, lane);
  } else if (nb < 3712) {
    int g = (nb - 3584) >> 6;
    norm_rope_store((bf16_t*)(ws + L0_KW), (long)(b * 2 + g) * 8192, 64, 0, acc, bias, p.k_norm + 128, 1.f, rope, mb, lane);
  } else if (nb < 3840) {
    store_T<0>((bf16_t*)(ws + L0_VWT), b * 2 + ((nb - 3712) >> 6), 64, 0, acc, bias, tl0, lane);
  } else if (nb < 4352) {
    store_rm<2>((bf16_t*)(ws + L0_NZ), 512, nb - 3840, acc, bias, mb, lane);
  } else {
    float* IG = (float*)(ws + L0_IG);
    float* LF = (float*)(ws + L0_LOGF);
    float* GT = (float*)(ws + L0_GATES);
#pragma unroll
    for (int mt = 0; mt < 4; ++mt)
#pragma unroll
      for (int i = 0; i < 4; ++i) {
        long row = mb + mt * 16 + q * 4 + i;
#pragma unroll
        for (int nt = 0; nt < 2; ++nt) {
          int c = nt * 16 + r;
          float v = acc[mt][nt][i] + bias[nt];
          if (c < 4) IG[row * 4 + c] = v;
          else if (c < 8) { float xx = v + p.f_bias[c - 4]; LF[row * 4 + c - 4] = fminf(xx, 0.f) - log1pf(__expf(-fabsf(xx))); }
          else GT[row * 24 + c - 8] = sigm(v);
        }
      }
  }
}

DEVI void epi_cmp_hidden(const Params& p, f32x4 (&acc)[4][4], int mb, int nb, int lane, int kv, int bg, int ksp) {
  const int r = lane & 15, q = lane >> 4;
  float* hid = (float*)(p.ws + L0_HIDP) + ((long)((ksp * 2 + kv) * 4 + bg) * 512) * 128;
#pragma unroll
  for (int mt = 0; mt < 4; ++mt)
#pragma unroll
    for (int i = 0; i < 4; ++i) {
      int row = mb + mt * 16 + q * 4 + i;
#pragma unroll
      for (int nt = 0; nt < 4; ++nt) hid[(long)row * 128 + nb + nt * 16 + r] = acc[mt][nt][i];
    }
}

DEVI void epi_out_resid(const float* resid, float* out, f32x4 (&acc)[4][4], int mb, int nb, int lane) {
  const int r = lane & 15, q = lane >> 4;
#pragma unroll
  for (int mt = 0; mt < 4; ++mt) {
    float rv[4][4];
#pragma unroll
    for (int i = 0; i < 4; ++i)
#pragma unroll
      for (int nt = 0; nt < 4; ++nt) rv[i][nt] = resid[(long)(mb + mt * 16 + q * 4 + i) * 1024 + nb + nt * 16 + r];
#pragma unroll
    for (int i = 0; i < 4; ++i)
#pragma unroll
      for (int nt = 0; nt < 4; ++nt) out[(long)(mb + mt * 16 + q * 4 + i) * 1024 + nb + nt * 16 + r] = rv[i][nt] + acc[mt][nt][i];
  }
}

DEVI void epi_proj1(const Params& p, f32x4 (&acc)[4][4], int mb, int nb, int lane) {
  unsigned char* ws = p.ws;
  const int r = lane & 15;
  float bias[4];
#pragma unroll
  for (int nt = 0; nt < 4; ++nt) bias[nt] = p.od_b_in[nb + nt * 16 + r];
  const int b = mb >> 13, tl0 = mb & 8191;
  if (nb < 1024) store_rm<0>((bf16_t*)(ws + L1_FP), 1024, nb, acc, bias, mb, lane);
  else if (nb < 2048) store_T<0>((bf16_t*)(ws + L1_VT), b * 8 + ((nb - 1024) >> 7), 128, (nb - 1024) & 127, acc, bias, tl0, lane);
  else if (nb < 3072) store_rm<2>((bf16_t*)(ws + L1_Q), 1024, nb - 2048, acc, bias, mb, lane);
  else store_rm<2>((bf16_t*)(ws + L1_Z), 1024, nb - 3072, acc, bias, mb, lane);
}

DEVI void conv_tile(const Params& p, int item, unsigned char* smem) {
  const int tid = opaque_tid();
  const int ctile = item & 7, ttile = item >> 3;
  const int t0g = ttile * 64;
  const int b = t0g >> 13, tl0 = t0g & 8191;
  unsigned char* ws = p.ws;
  float* sRaw = (float*)smem;
  bf16_t* sOutT = (bf16_t*)(smem + 67 * 128 * 4);
  const bf16_t* raw = (const bf16_t*)(ws + L0_QKRAW);
  for (int idx = tid; idx < 67 * 16; idx += 256) {
    int rr = idx >> 4, ch = (idx & 15) * 8;
    int tl = tl0 + rr - 3;
    uint4 v = make_uint4(0, 0, 0, 0);
    if (tl >= 0) v = *(const uint4*)(raw + (long)(b * 8192 + tl) * 1024 + ctile * 128 + ch);
    float* d = sRaw + rr * 128 + ch;
    d[0] = lo2f(v.x); d[1] = hi2f(v.x); d[2] = lo2f(v.y); d[3] = hi2f(v.y);
    d[4] = lo2f(v.z); d[5] = hi2f(v.z); d[6] = lo2f(v.w); d[7] = hi2f(v.w);
  }
  __syncthreads();
  const int c = tid & 127, th = tid >> 7;
  const int cg_ = ctile * 128 + c;
  const float w0 = p.conv_w[cg_], w1 = p.conv_w[1024 + cg_], w2 = p.conv_w[2048 + cg_], w3 = p.conv_w[3072 + cg_];
  const float cb = p.conv_b[cg_];
  const bool isk = ctile >= 4;
  bf16_t* dst = (bf16_t*)(ws + (isk ? L0_KC : L0_QC));
  const int cc = isk ? cg_ - 512 : cg_;
  const float sc = isk ? 0.08838834764831845f : 1.f;
  for (int t = th * 32; t < th * 32 + 32; ++t) {
    float a = cb + w0 * sRaw[t * 128 + c] + w1 * sRaw[(t + 1) * 128 + c] + w2 * sRaw[(t + 2) * 128 + c] + w3 * sRaw[(t + 3) * 128 + c];
    bf16_t o = f2bf(siluf(a) * sc);
    dst[(long)(t0g + t) * 512 + cc] = o;
    sOutT[c * LDT + t] = o;
  }
  __syncthreads();
  if (isk) {
    bf16_t* kct = (bf16_t*)(ws + L0_KCT);
#pragma unroll
    for (int j = 0; j < 4; ++j) {
      int idx = tid + 256 * j;
      int cr = idx >> 3, tc = (idx & 7) * 8;
      *(uint4*)(kct + ((((long)(b * 4 + (ctile - 4)) * 128 + (tl0 >> 6)) * 128 + cr) * 64) + tc) = *(const uint4*)(sOutT + cr * LDT + tc);
    }
  }
  __syncthreads();
}

DEVI void cmp_finalize(const Params& p, int task, int lane) {
  const int n = task & 511, bg = (task >> 9) & 3, kv = task >> 11;
  unsigned char* ws = p.ws;
  bf16_t* KCMP = (bf16_t*)(ws + L0_KCMP);
  bf16_t* VCMPT = (bf16_t*)(ws + L0_VCMPT);
  if (n == 511) {
    if (kv == 0) KCMP[((long)bg * 512 + 511) * 64 + lane] = 0;
    else VCMPT[((long)bg * 64 + lane) * 512 + 511] = 0;
    return;
  }
  const float* hid = (const float*)(ws + L0_HIDP) + ((long)(kv * 4 + bg) * 512 + n) * 128;
  const float* pbv = (const float*)(ws + OFF_PB) + kv * 128;
  const float* w2 = kv ? p.cv_w2 : p.ck_w2;
  float g0, g1;
  {
    float x0 = ((hid[lane] + hid[lane + 524288]) + (hid[lane + 2 * 524288] + hid[lane + 3 * 524288])) + pbv[lane];
    float x1 = ((hid[lane + 64] + hid[lane + 64 + 524288]) + (hid[lane + 64 + 2 * 524288] + hid[lane + 64 + 3 * 524288])) + pbv[lane + 64];
    g0 = 0.5f * x0 * (1.f + tanhf(0.7978845608028654f * (x0 + 0.044715f * x0 * x0 * x0)));
    g1 = 0.5f * x1 * (1.f + tanhf(0.7978845608028654f * (x1 + 0.044715f * x1 * x1 * x1)));
  }
  float a = 0.f;
  for (int j0 = 0; j0 < 64; j0 += 16) {
    float wv[16], wu[16];
#pragma unroll
    for (int k = 0; k < 16; ++k) { wv[k] = w2[(j0 + k) * 64 + lane]; wu[k] = w2[(64 + j0 + k) * 64 + lane]; }
#pragma unroll
    for (int k = 0; k < 16; ++k) a += __shfl(g0, j0 + k) * wv[k] + __shfl(g1, j0 + k) * wu[k];
  }
  if (kv == 0) {
    float ss = wave_sum(a * a);
    float rinv = rsqrtf(ss * (1.f / 64.f) + EPSF);
    float v = a * rinv * p.k_norm[lane];
    float partner = __shfl_xor(v, 8);
    int pos = 16 * n + 31;
    float2 cs = ((const float2*)(ws + OFF_ROPE))[pos * 8 + (lane & 7)];
    float o = v;
    if (lane < 8) o = v * cs.x - partner * cs.y;
    else if (lane < 16) o = partner * cs.y + v * cs.x;
    KCMP[((long)bg * 512 + n) * 64 + lane] = f2bf(o);
  } else {
    VCMPT[((long)bg * 64 + lane) * 512 + n] = f2bf(a);
  }
}

DEVI void mlstm_local(const Params& p, int unit, unsigned char* smem) {
  const int tid = opaque_tid(), lane = tid & 63, w = tid >> 6, wr = w >> 1, wc = w & 1;
  const int bh = unit >> 6, c = unit & 63, b = bh >> 2, h = bh & 3, t0 = c * 128;
  const long R0 = (long)b * 8192 + t0;
  unsigned char* ws = p.ws;
  bf16_t* sA = (bf16_t*)smem;
  bf16_t* sB = (bf16_t*)(smem + 18432);
  float* sIg = (float*)(smem + 36864);
  float* sLf = sIg + 128;
  float* sW = sLf + 128;
  const float* IG = (const float*)(ws + L0_IG);
  const float* LF = (const float*)(ws + L0_LOGF);
  if (tid < 128) { sIg[tid] = IG[(R0 + tid) * 4 + h]; sLf[tid] = LF[(R0 + tid) * 4 + h]; }
  __syncthreads();
  if (tid < 64) {
    float c0 = sLf[2 * tid], c1 = sLf[2 * tid + 1];
    wave_scan_sum128(c0, c1, tid);
    const float bL = __shfl(c1, 63);
    float d0 = bL - c0 + sIg[2 * tid], d1 = bL - c1 + sIg[2 * tid + 1];
    const float ml = wave_max(fmaxf(d0, d1));
    sW[2 * tid] = __expf(d0 - ml); sW[2 * tid + 1] = __expf(d1 - ml);
    if (tid == 0) { ((float*)(ws + L0_BL))[unit] = bL; ((float*)(ws + L0_MLOC))[unit] = ml; }
  }
  __syncthreads();
  f32x4 acc[4][4];
#pragma unroll
  for (int mt = 0; mt < 4; ++mt)
#pragma unroll
    for (int nt = 0; nt < 4; ++nt) acc[mt][nt] = f32x4{0.f, 0.f, 0.f, 0.f};
  float dn = 0.f;
  const bf16_t* vt = (const bf16_t*)(ws + L0_MVT) + (((long)(b * 4 + h) * 128 + (t0 >> 6)) * 128) * 64;
  const bf16_t* kt_ = (const bf16_t*)(ws + L0_KCT) + (((long)(b * 4 + h) * 128 + (t0 >> 6)) * 128) * 64;
  const int lr = tid >> 3, lk = (tid & 7) * 8;
  for (int kt = 0; kt < 2; ++kt) {
    load_tile128(sA, vt + kt * 8192, 64);
#pragma unroll
    for (int j = 0; j < 4; ++j) {
      uint4 v = *(const uint4*)(kt_ + (long)kt * 8192 + (lr + 32 * j) * 64 + lk);
      const float* ww = sW + kt * 64 + lk;
      uint4 o;
      o.x = pack2(lo2f(v.x) * ww[0], hi2f(v.x) * ww[1]);
      o.y = pack2(lo2f(v.y) * ww[2], hi2f(v.y) * ww[3]);
      o.z = pack2(lo2f(v.z) * ww[4], hi2f(v.z) * ww[5]);
      o.w = pack2(lo2f(v.w) * ww[6], hi2f(v.w) * ww[7]);
      *(uint4*)(sB + (lr + 32 * j) * LDT + lk) = o;
    }
    __syncthreads();
    if (tid < 128) {
#pragma unroll 8
      for (int s = 0; s < 64; ++s) dn += bf2f(sB[tid * LDT + s]);
    }
    mma_lds<4, 4, 2>(sA + wr * 64 * LDT, sB + wc * 64 * LDT, acc, lane);
    __syncthreads();
  }
  float* dct = (float*)(ws + L0_H) + (long)unit * 16384;
  const int r = lane & 15, q = lane >> 4;
#pragma unroll
  for (int mt = 0; mt < 4; ++mt)
#pragma unroll
    for (int i = 0; i < 4; ++i) {
      int e = wr * 64 + mt * 16 + q * 4 + i;
#pragma unroll
      for (int nt = 0; nt < 4; ++nt) dct[e * 128 + wc * 64 + nt * 16 + r] = acc[mt][nt][i];
    }
  if (tid < 128) ((float*)(ws + L0_DN))[unit * 128 + tid] = dn;
}

template <bool DUMMY>
DEVI void mlstm_scan(const Params& p, unsigned char* smem) {
  unsigned char* ws = p.ws;
  const float* BL = (const float*)(ws + L0_BL);
  const float* ML = (const float*)(ws + L0_MLOC);
  float* MIN_ = (float*)(ws + L0_MIN);
  float* sDec = (float*)smem;
  float* sWn = sDec + 128;
  const int tid = opaque_tid();
  const int total = 8 * 16384 + 8 * 128;
  for (int base = blockIdx.x * 256; base < total; base += gridDim.x * 256) {
    const int bh0 = (base < 131072) ? (base >> 14) : ((base - 131072) >> 7);
    __syncthreads();
    if (tid < 2) {
      const int bh = bh0 + tid;
      if (bh < 8) {
        float m = 0.f;
        for (int c = 0; c < 64; ++c) {
          const int unit = bh * 64 + c;
          const float bL = BL[unit], ml = ML[unit];
          if (!DUMMY && base < 131072 && (base & 16383) == 0 && tid == 0) MIN_[unit] = m;
          const float mn = fmaxf(bL + m, ml);
          sDec[tid * 64 + c] = __expf(bL + m - mn);
          sWn[tid * 64 + c] = __expf(ml - mn);
          m = mn;
        }
      }
    }
    __syncthreads();
    const int idx = base + tid;
    if (idx < total) {
      float* ptr; long stride; int sel;
      if (idx < 131072) { const int bh = idx >> 14; ptr = (float*)(ws + L0_H) + (long)bh * 64 * 16384 + (idx & 16383); stride = 16384; sel = bh - bh0; }
      else { const int j = idx - 131072; const int bh = j >> 7; ptr = (float*)(ws + L0_DN) + (long)bh * 64 * 128 + (j & 127); stride = 128; sel = bh - bh0; }
      const float* dec = sDec + sel * 64;
      const float* wn = sWn + sel * 64;
      float C = 0.f;
      for (int c0 = 0; c0 < 64; c0 += 8) {
        float dv[8];
#pragma unroll
        for (int k = 0; k < 8; ++k) dv[k] = __builtin_nontemporal_load(ptr + (long)(c0 + k) * stride);
#pragma unroll
        for (int k = 0; k < 8; ++k) {
          if (!DUMMY) __builtin_nontemporal_store(C, ptr + (long)(c0 + k) * stride);
          C = dec[c0 + k] * C + wn[c0 + k] * dv[k];
        }
      }
      if (DUMMY && C == 123.456f) MIN_[0] = C;
    }
  }
}

DEVI void mlstm_out(const Params& p, int item, unsigned char* smem) {
  const int tid = opaque_tid(), lane = tid & 63, w = tid >> 6, wr = w >> 1, wc = w & 1;
  const int r = lane & 15, q = lane >> 4;
  const int unit = item >> 1, u = item & 1;
  const int bh = unit >> 6, c = unit & 63, b = bh >> 2, h = bh & 3, t0 = c * 128;
  const long R0 = (long)b * 8192 + t0;
  const int J0 = u * 64;
  unsigned char* ws = p.ws;
  bf16_t* sA = (bf16_t*)smem;
  bf16_t* sB = (bf16_t*)(smem + 9216);
  bf16_t* sS0 = (bf16_t*)(smem + 27648);
  bf16_t* sS1 = (bf16_t*)(smem + 36864);
  float* fl = (float*)(smem + 46080);
  float* sIg = fl; float* sLf = fl + 128; float* sRj = fl + 256; float* sCs = fl + 384; float* sWi = fl + 512;
  float* sEm = fl + 640; float* sQn = fl + 768; float* sNin = fl + 896; float* sDen = fl + 1024; float* sSs = fl + 1280;
  const float* IG = (const float*)(ws + L0_IG);
  const float* LF = (const float*)(ws + L0_LOGF);
  const bf16_t* QC = (const bf16_t*)(ws + L0_QC) + (R0 + J0) * 512 + h * 128;
  const bf16_t* KC = (const bf16_t*)(ws + L0_KC) + R0 * 512 + h * 128;
  if (tid < 128) { sIg[tid] = IG[(R0 + tid) * 4 + h]; sLf[tid] = LF[(R0 + tid) * 4 + h]; sNin[tid] = ((const float*)(ws + L0_DN))[unit * 128 + tid]; }
  const float m_in = ((const float*)(ws + L0_MIN))[unit];
  __syncthreads();
  if (tid < 64) {
    float c0 = sLf[2 * tid], c1 = sLf[2 * tid + 1];
    wave_scan_sum128(c0, c1, tid);
    const float a0 = sIg[2 * tid] - c0, a1 = sIg[2 * tid + 1] - c1;
    float x0 = a0, x1 = a1;
    wave_scan_max128(x0, x1, tid);
    const float mx0 = fmaxf(x0, m_in), mx1 = fmaxf(x1, m_in);
    sCs[2 * tid] = a0; sCs[2 * tid + 1] = a1;
    sRj[2 * tid] = -mx0; sRj[2 * tid + 1] = -mx1;
    sWi[2 * tid] = __expf(m_in - mx0); sWi[2 * tid + 1] = __expf(m_in - mx1);
    sEm[2 * tid] = __expf(-(c0 + mx0)); sEm[2 * tid + 1] = __expf(-(c1 + mx1));
  }
  if (tid >= 128 && tid < 192) {
    int jl = tid - 128;
    const bf16_t* qr = QC + (long)jl * 512;
    float s = 0.f;
#pragma unroll 2
    for (int ch = 0; ch < 16; ++ch) {
      uint4 v = *(const uint4*)(qr + ch * 8);
      const float* nn = sNin + ch * 8;
      s += lo2f(v.x) * nn[0] + hi2f(v.x) * nn[1] + lo2f(v.y) * nn[2] + hi2f(v.y) * nn[3] + lo2f(v.z) * nn[4] + hi2f(v.z) * nn[5] + lo2f(v.w) * nn[6] + hi2f(v.w) * nn[7];
    }
    sQn[jl] = s;
  }
  __syncthreads();
  f32x4 acc[2][4];
#pragma unroll
  for (int mt = 0; mt < 2; ++mt)
#pragma unroll
    for (int nt = 0; nt < 4; ++nt) acc[mt][nt] = f32x4{0.f, 0.f, 0.f, 0.f};
  const bool skipS = (wc > u);
  const int lr = tid >> 3, lk = (tid & 7) * 8;
  {
    u32x4 qa0, qa1, kb0, kb1, kb2, kb3;
    qa0 = *(const u32x4*)(QC + (long)lr * 512 + lk); qa1 = *(const u32x4*)(QC + (long)(lr + 32) * 512 + lk);
    kb0 = *(const u32x4*)(KC + (long)lr * 512 + lk); kb1 = *(const u32x4*)(KC + (long)(lr + 32) * 512 + lk);
    kb2 = *(const u32x4*)(KC + (long)(lr + 64) * 512 + lk); kb3 = *(const u32x4*)(KC + (long)(lr + 96) * 512 + lk);
#pragma unroll 1
    for (int kt = 0; kt < 2; ++kt) {
      *(u32x4*)(sA + lr * LDT + lk) = qa0; *(u32x4*)(sA + (lr + 32) * LDT + lk) = qa1;
      *(u32x4*)(sB + lr * LDT + lk) = kb0; *(u32x4*)(sB + (lr + 32) * LDT + lk) = kb1;
      *(u32x4*)(sB + (lr + 64) * LDT + lk) = kb2; *(u32x4*)(sB + (lr + 96) * LDT + lk) = kb3;
      __syncthreads();
      if (kt == 0) {
        qa0 = *(const u32x4*)(QC + (long)lr * 512 + 64 + lk); qa1 = *(const u32x4*)(QC + (long)(lr + 32) * 512 + 64 + lk);
        kb0 = *(const u32x4*)(KC + (long)lr * 512 + 64 + lk); kb1 = *(const u32x4*)(KC + (long)(lr + 32) * 512 + 64 + lk);
        kb2 = *(const u32x4*)(KC + (long)(lr + 64) * 512 + 64 + lk); kb3 = *(const u32x4*)(KC + (long)(lr + 96) * 512 + 64 + lk);
      }
      if (!skipS) mma_lds<2, 4, 2>(sA + wr * 32 * LDT, sB + wc * 64 * LDT, acc, lane);
      __syncthreads();
    }
  }
  {
    bf16_t* sS = wc ? sS1 : sS0;
#pragma unroll
    for (int mt = 0; mt < 2; ++mt)
#pragma unroll
      for (int i = 0; i < 4; ++i) {
        int jl = wr * 32 + mt * 16 + q * 4 + i;
        int j = J0 + jl;
        float rj = sRj[j], rs = 0.f;
#pragma unroll
        for (int nt = 0; nt < 4; ++nt) {
          int sl = nt * 16 + r, s = wc * 64 + sl;
          float val = (s <= j) ? acc[mt][nt][i] * __expf(rj + sCs[s]) : 0.f;
          rs += val;
          sS[jl * LDT + sl] = f2bf(val);
        }
        rs = grp16_sum(rs);
        if (r == 0) sDen[wc * 64 + jl] = rs;
      }
  }
#pragma unroll
  for (int mt = 0; mt < 2; ++mt)
#pragma unroll
    for (int nt = 0; nt < 4; ++nt) acc[mt][nt] = f32x4{0.f, 0.f, 0.f, 0.f};
  const bf16_t* vt = (const bf16_t*)(ws + L0_MVT) + (((long)(b * 4 + h) * 128 + (t0 >> 6)) * 128) * 64;
  const float* ct = (const float*)(ws + L0_H) + (long)unit * 16384;
  {
    u32x4 vb0, vb1, vb2, vb3;
    u32x4 qa0, qa1;
    float4 cv[8];
    const int nsteps = u ? 4 : 3;
    auto kind_of = [&](int sidx) { return u ? sidx : (sidx == 0 ? 0 : sidx + 1); };
    auto fetch = [&](int kind) {
      if (kind < 2) {
        const bf16_t* vp = vt + (long)kind * 8192 + lr * 64 + lk;
        vb0 = *(const u32x4*)vp; vb1 = *(const u32x4*)(vp + 32 * 64); vb2 = *(const u32x4*)(vp + 64 * 64); vb3 = *(const u32x4*)(vp + 96 * 64);
      } else {
        const int k2 = kind - 2;
        qa0 = *(const u32x4*)(QC + (long)lr * 512 + k2 * 64 + lk); qa1 = *(const u32x4*)(QC + (long)(lr + 32) * 512 + k2 * 64 + lk);
#pragma unroll
        for (int j = 0; j < 8; ++j) cv[j] = *(const float4*)(ct + (long)((tid >> 4) + 16 * j) * 128 + k2 * 64 + (tid & 15) * 4);
      }
    };
    fetch(0);
#pragma unroll 1
    for (int sidx = 0; sidx < nsteps; ++sidx) {
      const int kind = kind_of(sidx);
      const bf16_t* aS;
      if (kind < 2) {
        *(u32x4*)(sB + lr * LDT + lk) = vb0; *(u32x4*)(sB + (lr + 32) * LDT + lk) = vb1;
        *(u32x4*)(sB + (lr + 64) * LDT + lk) = vb2; *(u32x4*)(sB + (lr + 96) * LDT + lk) = vb3;
        aS = kind ? sS1 : sS0;
      } else {
        const float w0 = sWi[J0 + lr], w1 = sWi[J0 + lr + 32];
        u32x4 o0, o1;
        o0[0] = pack2(lo2f(qa0[0]) * w0, hi2f(qa0[0]) * w0); o0[1] = pack2(lo2f(qa0[1]) * w0, hi2f(qa0[1]) * w0);
        o0[2] = pack2(lo2f(qa0[2]) * w0, hi2f(qa0[2]) * w0); o0[3] = pack2(lo2f(qa0[3]) * w0, hi2f(qa0[3]) * w0);
        o1[0] = pack2(lo2f(qa1[0]) * w1, hi2f(qa1[0]) * w1); o1[1] = pack2(lo2f(qa1[1]) * w1, hi2f(qa1[1]) * w1);
        o1[2] = pack2(lo2f(qa1[2]) * w1, hi2f(qa1[2]) * w1); o1[3] = pack2(lo2f(qa1[3]) * w1, hi2f(qa1[3]) * w1);
        *(u32x4*)(sA + lr * LDT + lk) = o0; *(u32x4*)(sA + (lr + 32) * LDT + lk) = o1;
#pragma unroll
        for (int j = 0; j < 8; ++j) {
          uint2 o;
          o.x = pack2(cv[j].x, cv[j].y);
          o.y = pack2(cv[j].z, cv[j].w);
          *(uint2*)(sB + ((tid >> 4) + 16 * j) * LDT + (tid & 15) * 4) = o;
        }
        aS = sA;
      }
      __syncthreads();
      if (sidx + 1 < nsteps) fetch(kind_of(sidx + 1));
      mma_lds<2, 4, 2>(aS + wr * 32 * LDT, sB + wc * 64 * LDT, acc, lane);
      __syncthreads();
    }
  }
#pragma unroll
  for (int mt = 0; mt < 2; ++mt)
#pragma unroll
    for (int i = 0; i < 4; ++i) {
      int jl = wr * 32 + mt * 16 + q * 4 + i;
      int j = J0 + jl;
      float den = sDen[jl] + sDen[64 + jl] + sWi[j] * sQn[jl];
      float dinv = 1.f / fmaxf(fabsf(den), sEm[j]);
      float ss = 0.f;
#pragma unroll
      for (int nt = 0; nt < 4; ++nt) { float v = acc[mt][nt][i] * dinv; acc[mt][nt][i] = v; ss += v * v; }
      ss = grp16_sum(ss);
      if (r == 0) sSs[wc * 64 + jl] = ss;
    }
  __syncthreads();
  const bf16_t* MO = (const bf16_t*)(ws + L0_MO);
  const bf16_t* MZ = (const bf16_t*)(ws + L0_MZ);
  bf16_t* Y = (bf16_t*)(ws + L0_QKRAW);
  float hn[4];
#pragma unroll
  for (int nt = 0; nt < 4; ++nt) hn[nt] = p.m_hn[h * 128 + wc * 64 + nt * 16 + r];
#pragma unroll
  for (int mt = 0; mt < 2; ++mt) {
    float gv[4][4];
#pragma unroll
    for (int i = 0; i < 4; ++i) {
      long row = R0 + J0 + wr * 32 + mt * 16 + q * 4 + i;
#pragma unroll
      for (int nt = 0; nt < 4; ++nt) {
        int col = h * 128 + wc * 64 + nt * 16 + r;
        gv[i][nt] = bf2f(MO[row * 512 + col]) * bf2f(MZ[row * 512 + col]);
      }
    }
#pragma unroll
    for (int i = 0; i < 4; ++i) {
      int jl = wr * 32 + mt * 16 + q * 4 + i;
      float rinv = rsqrtf((sSs[jl] + sSs[64 + jl]) * (1.f / 128.f) + EPSF);
      long row = R0 + J0 + jl;
#pragma unroll
      for (int nt = 0; nt < 4; ++nt) {
        int col = h * 128 + wc * 64 + nt * 16 + r;
        Y[row * 1024 + col] = f2bf(acc[mt][nt][i] * rinv * hn[nt] * gv[i][nt]);
      }
    }
  }
  __syncthreads();
}

struct NsaSm {
  bf16_t* sK; bf16_t* sV;
  float* sImpA; float* sImpB;
  unsigned* sSel; unsigned* sGrp; unsigned* sUn;
};

DEVI int next_bit(unsigned long long lo, unsigned long long hi, int from) {
  if (from < 64) {
    unsigned long long v = lo & (~0ull << from);
    if (v) return __builtin_ctzll(v);
    if (hi) return 64 + __builtin_ctzll(hi);
    return -1;
  }
  if (from >= 128) return -1;
  unsigned long long v = hi & (~0ull << (from - 64));
  if (v) return 64 + __builtin_ctzll(v);
  return -1;
}

template <int MODE, bool DUMMY = false, class MaskF, class ActF>
DEVI void nsa_branch(const NsaSm& sm, unsigned long long tmlo, unsigned long long tmhi,
                     const bf16_t* Kg, const bf16_t* Vg, long vstep, long ldv,
                     const bf16x8 (&qf)[2][2], f32x4 (&O)[4][2], float (&mrow)[2], float (&lrow)[2], const float (&invl)[2],
                     MaskF mask, ActF actf, int tokbase, int tid) {
  const int lane = tid & 63, r = lane & 15, q = lane >> 4;
  const int lr = tid >> 3, lk = (tid & 7) * 8;
  int j = next_bit(tmlo, tmhi, 0);
  if (j < 0) return;
  u32x4 k0, k1, v0, v1;
  u32x4 k2, k3, v2, v3;
  if (!DUMMY) {
    const bf16_t* kp = Kg + (long)j * 4096 + lr * 64 + lk;
    k0 = *(const u32x4*)kp; k1 = *(const u32x4*)(kp + 32 * 64);
    if (MODE != 1) {
      const bf16_t* vp = Vg + (long)j * vstep + (long)lr * ldv + lk;
      v0 = *(const u32x4*)vp; v1 = *(const u32x4*)(vp + 32 * ldv);
    }
    *(u32x4*)(sm.sK + lr * LDT + lk) = k0; *(u32x4*)(sm.sK + (lr + 32) * LDT + lk) = k1;
    if (MODE != 1) { *(u32x4*)(sm.sV + lr * LDT + lk) = v0; *(u32x4*)(sm.sV + (lr + 32) * LDT + lk) = v1; }
  }
  int j1 = next_bit(tmlo, tmhi, j + 1);
  if (!DUMMY && j1 >= 0) {
    const bf16_t* kp = Kg + (long)j1 * 4096 + lr * 64 + lk;
    k0 = *(const u32x4*)kp; k1 = *(const u32x4*)(kp + 32 * 64);
    if (MODE != 1) {
      const bf16_t* vp = Vg + (long)j1 * vstep + (long)lr * ldv + lk;
      v0 = *(const u32x4*)vp; v1 = *(const u32x4*)(vp + 32 * ldv);
    }
  }
  if (!DUMMY) __syncthreads();
  int buf = 0;
  while (true) {
    const int jn = j1;
    const int j2 = (j1 >= 0) ? next_bit(tmlo, tmhi, j1 + 1) : -1;
    if (!DUMMY && j2 >= 0) {
      const bf16_t* kp = Kg + (long)j2 * 4096 + lr * 64 + lk;
      k2 = *(const u32x4*)kp; k3 = *(const u32x4*)(kp + 32 * 64);
      if (MODE != 1) {
        const bf16_t* vp = Vg + (long)j2 * vstep + (long)lr * ldv + lk;
        v2 = *(const u32x4*)vp; v3 = *(const u32x4*)(vp + 32 * ldv);
      }
    }
    const bf16_t* sK = sm.sK + buf * (64 * LDT);
    const bf16_t* sV = sm.sV + buf * (64 * LDT);
    const bool a0 = actf(0, j), a1 = actf(1, j);
    __builtin_amdgcn_sched_barrier(0);
    if (a0 || a1) {
      const bool full = mask.full(j);
      f32x4 sacc[4][2];
#pragma unroll
      for (int mt = 0; mt < 4; ++mt) { sacc[mt][0] = f32x4{0.f, 0.f, 0.f, 0.f}; sacc[mt][1] = f32x4{0.f, 0.f, 0.f, 0.f}; }
      __builtin_amdgcn_s_setprio(2);
#pragma unroll
      for (int ks = 0; ks < 2; ++ks)
#pragma unroll
        for (int mt = 0; mt < 4; ++mt) {
          bf16x8 a = *(const bf16x8*)(sK + (mt * 16 + r) * LDT + ks * 32 + q * 8);
          if (a0) sacc[mt][0] = __builtin_amdgcn_mfma_f32_16x16x32_bf16(a, qf[0][ks], sacc[mt][0], 0, 0, 0);
          if (a1) sacc[mt][1] = __builtin_amdgcn_mfma_f32_16x16x32_bf16(a, qf[1][ks], sacc[mt][1], 0, 0, 0);
        }
      __builtin_amdgcn_s_setprio(0);
      __builtin_amdgcn_sched_barrier(0);
#pragma unroll
      for (int nt = 0; nt < 2; ++nt) {
        const bool act = nt ? a1 : a0;
        if (act) {
          const bool lb = mask.bit(nt, j);
          if (!full) {
#pragma unroll
            for (int mt = 0; mt < 4; ++mt)
#pragma unroll
              for (int i = 0; i < 4; ++i) sacc[mt][nt][i] = mask.elem(mt * 16 + q * 4 + i, nt, j) ? sacc[mt][nt][i] : NEGS;
          }
          if (MODE != 2) {
            float tmx = fmaxf(fmaxf(sacc[0][nt][0], sacc[0][nt][1]), fmaxf(sacc[0][nt][2], sacc[0][nt][3]));
#pragma unroll
            for (int mt = 1; mt < 4; ++mt)
              tmx = fmaxf(tmx, fmaxf(fmaxf(sacc[mt][nt][0], sacc[mt][nt][1]), fmaxf(sacc[mt][nt][2], sacc[mt][nt][3])));
            if (MaskF::HASBIT) tmx = lb ? tmx : NEGS;
            tmx = fmaxf(tmx, __shfl_xor(tmx, 16));
            tmx = fmaxf(tmx, __shfl_xor(tmx, 32));
            const float mo = mrow[nt];
            const float mn = fmaxf(mo, tmx);
            float mnc = fmaxf(mn, -1e20f);
            if (MaskF::HASBIT) mnc = lb ? mnc : 1e30f;
            mrow[nt] = mn;
            f32x4 psv = f32x4{0.f, 0.f, 0.f, 0.f};
#pragma unroll
            for (int mt = 0; mt < 4; ++mt) {
              f32x4 dd = sacc[mt][nt] - mnc;
              f32x4 pp;
              pp[0] = __builtin_amdgcn_exp2f(dd[0]); pp[1] = __builtin_amdgcn_exp2f(dd[1]);
              pp[2] = __builtin_amdgcn_exp2f(dd[2]); pp[3] = __builtin_amdgcn_exp2f(dd[3]);
              sacc[mt][nt] = pp;
              psv += pp;
            }
            const float ps = (psv[0] + psv[1]) + (psv[2] + psv[3]);
            const float al = __builtin_amdgcn_exp2f(mo - mn);
            lrow[nt] = lrow[nt] * al + ps;
            if (MODE == 0) {
              if (__any(al != 1.f)) {
#pragma unroll
                for (int dt = 0; dt < 4; ++dt) O[dt][nt] *= al;
              }
            }
          } else {
            const float mmc = fmaxf(mrow[nt], -1e20f), il = invl[nt];
            const int tok = tokbase + nt * 4 + (r >> 2);
#pragma unroll
            for (int mt = 0; mt < 4; ++mt) {
              float pp[4];
#pragma unroll
              for (int i = 0; i < 4; ++i) {
                pp[i] = __builtin_amdgcn_exp2f(sacc[mt][nt][i] - mmc) * il;
                sacc[mt][nt][i] = pp[i];
              }
              float mainv = 32.f * (pp[0] + pp[1] + pp[2]) + 16.f * pp[3];
              float carry = 16.f * pp[3];
              mainv += __shfl_xor(mainv, 1); mainv += __shfl_xor(mainv, 2);
              carry += __shfl_xor(carry, 1); carry += __shfl_xor(carry, 2);
              if ((r & 3) == 0) {
                const int mp = j * 16 + mt * 4 + q;
                sm.sImpA[tok * 128 + mp] = mainv;
                if (mp + 1 < 128) sm.sImpB[tok * 128 + mp + 1] = carry;
              }
            }
          }
        }
      }
      __builtin_amdgcn_sched_barrier(0);
      if (MODE != 1) {
        __builtin_amdgcn_s_setprio(2);
#pragma unroll
        for (int ks = 0; ks < 2; ++ks) {
          bf16x8 pb[2];
#pragma unroll
          for (int nt = 0; nt < 2; ++nt) {
            union { u32x4 u; bf16x8 h; } cv;
            cv.u[0] = pack2(sacc[2 * ks][nt][0], sacc[2 * ks][nt][1]);
            cv.u[1] = pack2(sacc[2 * ks][nt][2], sacc[2 * ks][nt][3]);
            cv.u[2] = pack2(sacc[2 * ks + 1][nt][0], sacc[2 * ks + 1][nt][1]);
            cv.u[3] = pack2(sacc[2 * ks + 1][nt][2], sacc[2 * ks + 1][nt][3]);
            pb[nt] = cv.h;
          }
#pragma unroll
          for (int dt = 0; dt < 4; ++dt) {
            union { u32x4 u; bf16x8 h; } av;
            const uint2 lo = *(const uint2*)(sV + (dt * 16 + r) * LDT + (2 * ks) * 16 + q * 4);
            const uint2 hi = *(const uint2*)(sV + (dt * 16 + r) * LDT + (2 * ks + 1) * 16 + q * 4);
            av.u[0] = lo.x; av.u[1] = lo.y; av.u[2] = hi.x; av.u[3] = hi.y;
            if (a0) O[dt][0] = __builtin_amdgcn_mfma_f32_16x16x32_bf16(av.h, pb[0], O[dt][0], 0, 0, 0);
            if (a1) O[dt][1] = __builtin_amdgcn_mfma_f32_16x16x32_bf16(av.h, pb[1], O[dt][1], 0, 0, 0);
          }
        }
        __builtin_amdgcn_s_setprio(0);
      }
    }
    __builtin_amdgcn_sched_barrier(0);
    if (!DUMMY && jn >= 0) {
      bf16_t* dK = sm.sK + (buf ^ 1) * (64 * LDT);
      bf16_t* dV = sm.sV + (buf ^ 1) * (64 * LDT);
      *(u32x4*)(dK + lr * LDT + lk) = k0; *(u32x4*)(dK + (lr + 32) * LDT + lk) = k1;
      if (MODE != 1) { *(u32x4*)(dV + lr * LDT + lk) = v0; *(u32x4*)(dV + (lr + 32) * LDT + lk) = v1; }
    }
    if (!DUMMY) __syncthreads();
    if (jn < 0) break;
    j = jn;
    j1 = j2;
    k0 = k2; k1 = k3; v0 = v2; v1 = v3;
    buf ^= 1;
  }
}

struct MaskC {
      static constexpr bool HASBIT = false;
      int t0_, t1_, tmin_;
      DEVI bool full(int jt) const { return 16 * (jt * 64 + 63) + 31 <= tmin_; }
      DEVI bool bit(int nt, int jt) const { return true; }
      DEVI bool elem(int key, int nt, int jt) const { return 16 * (jt * 64 + key) + 31 <= (nt ? t1_ : t0_); }
};

struct MaskS {
      static constexpr bool HASBIT = true;
      unsigned long long a_lo, a_hi, b_lo, b_hi; int t0_, t1_, cur_;
      DEVI bool full(int jt) const { return jt < cur_; }
      DEVI bool bit(int nt, int jt) const {
        const unsigned long long lo = nt ? b_lo : a_lo, hi = nt ? b_hi : a_hi;
        const unsigned long long wd = (jt < 64) ? (lo >> jt) : (hi >> (jt - 64));
        return (wd & 1ull) != 0ull;
      }
      DEVI bool elem(int key, int nt, int jt) const { return jt * 64 + key <= (nt ? t1_ : t0_); }
};

struct MaskW {
      static constexpr bool HASBIT = false;
      int t0_, t1_, tmin_, tmax_;
      DEVI bool full(int jt) const { return (jt * 64 + 63 <= tmin_) && (tmax_ - jt * 64 < 512); }
      DEVI bool bit(int nt, int jt) const { return true; }
      DEVI bool elem(int key, int nt, int jt) const { const int s_ = jt * 64 + key, t_ = nt ? t1_ : t0_; return (s_ <= t_) && (t_ - s_ < 512); }
};

DEVI void nsa_tile(const Params& p, int tileidx, unsigned char* smem) {
  const int tid = opaque_tid(), lane = tid & 63, w = tid >> 6, r = lane & 15, q = lane >> 4;
  const int bg = tileidx & 3, tt = tileidx >> 2, b = bg >> 1, g = bg & 1, t0 = tt * 32;
  unsigned char* ws = p.ws;
  NsaSm sm;
  sm.sK = (bf16_t*)smem; sm.sV = (bf16_t*)(smem + 18432);
  sm.sImpA = (float*)(smem + 36864); sm.sImpB = (float*)(smem + 53248);
  sm.sSel = (unsigned*)(smem + 69632); sm.sGrp = sm.sSel + 128; sm.sUn = sm.sGrp + 32;
  const int tokbase = 8 * w;
  bf16x8 qf[2][2];
  {
    const bf16_t* qn = (const bf16_t*)(ws + L0_QN) + ((long)bg * 8192 + t0) * 256 + (32 * w + r) * 64 + q * 8;
    qf[0][0] = *(const bf16x8*)(qn); qf[0][1] = *(const bf16x8*)(qn + 32);
    qf[1][0] = *(const bf16x8*)(qn + 16 * 64); qf[1][1] = *(const bf16x8*)(qn + 16 * 64 + 32);
  }
  int tq[2];
  const float* GT = (const float*)(ws + L0_GATES);
#pragma unroll
  for (int nt = 0; nt < 2; ++nt) tq[nt] = t0 + tokbase + nt * 4 + (r >> 2);
#define GATE(nt, k) (GT[((long)b * 8192 + tq[nt]) * 24 + (g * 4 + (r & 3)) * 3 + (k)])
  f32x4 O[4][2];
  f32x4* sOut = (f32x4*)(smem + 36864) + (w * 8) * 64 + lane;
  const int cur = t0 >> 6;
  float mrow[2], lrow[2], invl[2];
  for (int i = tid; i < 32 * 128; i += 256) { sm.sImpA[i] = 0.f; sm.sImpB[i] = 0.f; }
  __syncthreads();
  {
    const int nvmax = (t0 + 31 >= 31) ? (((t0 + 31 - 31) >> 4) + 1) : 0;
    int nkt = (nvmax + 63) >> 6;
    if (nkt > 8) nkt = 8;
    const unsigned long long cm0 = (1ull << nkt) - 1ull;
    const bf16_t* KCMP = (const bf16_t*)(ws + L0_KCMP) + (long)bg * 512 * 64;
    const bf16_t* VCMPT = (const bf16_t*)(ws + L0_VCMPT) + (long)bg * 64 * 512;
    MaskC mk{tq[0], tq[1], t0 + tokbase};
    auto act = [&](int nt, int jt) { return true; };
    mrow[0] = mrow[1] = NEGS; lrow[0] = lrow[1] = 0.f; invl[0] = invl[1] = 0.f;
    nsa_branch<1>(sm, cm0, 0ull, KCMP, VCMPT, 64, 512, qf, O, mrow, lrow, invl, mk, act, tokbase, tid);
#pragma unroll
    for (int nt = 0; nt < 2; ++nt) {
      float l = lrow[nt];
      l += __shfl_xor(l, 16); l += __shfl_xor(l, 32);
      invl[nt] = (l > 0.f) ? 1.f / l : 0.f;
    }
#pragma unroll
    for (int dt = 0; dt < 4; ++dt) { O[dt][0] = f32x4{0.f, 0.f, 0.f, 0.f}; O[dt][1] = f32x4{0.f, 0.f, 0.f, 0.f}; }
    nsa_branch<2>(sm, cm0, 0ull, KCMP, VCMPT, 64, 512, qf, O, mrow, lrow, invl, mk, act, tokbase, tid);
  }
  __syncthreads();
  {
    const int ncand = (cur - 2 > 0) ? cur - 2 : 0;
    const int nf = (cur >= 2) ? 3 : cur + 1;
    const int kk = 16 - nf;
    const int m0i = lane, m1i = lane + 64;
    const bool c0 = (m0i >= 1 && m0i <= cur - 2), c1 = (m1i <= cur - 2);
    for (int tqi = 0; tqi < 8; ++tqi) {
      const int tok = tokbase + tqi;
      bool s0, s1;
      if (ncand <= kk) { s0 = c0; s1 = c1; }
      else {
        const float f0 = sm.sImpA[tok * 128 + m0i] + sm.sImpB[tok * 128 + m0i];
        const float f1 = sm.sImpA[tok * 128 + m1i] + sm.sImpB[tok * 128 + m1i];
        const unsigned k0 = c0 ? (__float_as_uint(f0) + 1u) : 0u;
        const unsigned k1 = c1 ? (__float_as_uint(f1) + 1u) : 0u;
        unsigned prefix = 0u;
        for (int bit = 31; bit >= 0; --bit) {
          const unsigned cand = prefix | (1u << bit);
          const int cnt = __popcll(__ballot(k0 >= cand)) + __popcll(__ballot(k1 >= cand));
          if (cnt >= kk) prefix = cand;
        }
        const bool g0 = k0 > prefix, g1 = k1 > prefix;
        const int ng = __popcll(__ballot(g0)) + __popcll(__ballot(g1));
        const bool e0 = (k0 == prefix), e1 = (k1 == prefix);
        const unsigned long long be0 = __ballot(e0), be1 = __ballot(e1);
        const unsigned long long lm = (1ull << lane) - 1ull;
        const int re0 = __popcll(be0 & lm), re1 = __popcll(be0) + __popcll(be1 & lm);
        const int need = kk - ng;
        s0 = g0 || (e0 && re0 < need);
        s1 = g1 || (e1 && re1 < need);
      }
      s0 = s0 || (m0i == 0) || (m0i == cur) || (m0i == cur - 1);
      s1 = s1 || (m1i == cur) || (m1i == cur - 1);
      const unsigned long long lo = __ballot(s0), hi = __ballot(s1);
      if (lane == 0) {
        sm.sSel[tok * 4 + 0] = (unsigned)lo; sm.sSel[tok * 4 + 1] = (unsigned)(lo >> 32);
        sm.sSel[tok * 4 + 2] = (unsigned)hi; sm.sSel[tok * 4 + 3] = (unsigned)(hi >> 32);
      }
    }
  }
  __syncthreads();
  if (tid < 32) { int gi = tid >> 2, wd = tid & 3; unsigned u = 0; for (int k = 0; k < 4; ++k) u |= sm.sSel[(gi * 4 + k) * 4 + wd]; sm.sGrp[tid] = u; }
  __syncthreads();
  if (tid < 4) { unsigned u = 0; for (int gi = 0; gi < 8; ++gi) u |= sm.sGrp[gi * 4 + tid]; sm.sUn[tid] = u; }
  __syncthreads();
#pragma unroll
  for (int nt = 0; nt < 2; ++nt)
#pragma unroll
    for (int dt = 0; dt < 4; ++dt) sOut[(nt * 4 + dt) * 64] = O[dt][nt] * GATE(nt, 0);
  {
    const bf16_t* KS = (const bf16_t*)(ws + L0_KS) + (long)bg * 8192 * 64;
    const bf16_t* VST = (const bf16_t*)(ws + L0_VST) + (long)bg * 128 * 4096;
    const unsigned long long ulo = (unsigned long long)sm.sUn[0] | ((unsigned long long)sm.sUn[1] << 32);
    const unsigned long long uhi = (unsigned long long)sm.sUn[2] | ((unsigned long long)sm.sUn[3] << 32);
    const int tk0 = tokbase + (r >> 2), tk1 = tokbase + 4 + (r >> 2);
    MaskS mk{(unsigned long long)sm.sSel[tk0 * 4 + 0] | ((unsigned long long)sm.sSel[tk0 * 4 + 1] << 32),
             (unsigned long long)sm.sSel[tk0 * 4 + 2] | ((unsigned long long)sm.sSel[tk0 * 4 + 3] << 32),
             (unsigned long long)sm.sSel[tk1 * 4 + 0] | ((unsigned long long)sm.sSel[tk1 * 4 + 1] << 32),
             (unsigned long long)sm.sSel[tk1 * 4 + 2] | ((unsigned long long)sm.sSel[tk1 * 4 + 3] << 32), tq[0], tq[1], cur};
    unsigned long long g0lo, g0hi, g1lo, g1hi;
    {
      const unsigned* gp = sm.sGrp + (2 * w) * 4;
      g0lo = (unsigned long long)__builtin_amdgcn_readfirstlane(gp[0]) | ((unsigned long long)__builtin_amdgcn_readfirstlane(gp[1]) << 32);
      g0hi = (unsigned long long)__builtin_amdgcn_readfirstlane(gp[2]) | ((unsigned long long)__builtin_amdgcn_readfirstlane(gp[3]) << 32);
      g1lo = (unsigned long long)__builtin_amdgcn_readfirstlane(gp[4]) | ((unsigned long long)__builtin_amdgcn_readfirstlane(gp[5]) << 32);
      g1hi = (unsigned long long)__builtin_amdgcn_readfirstlane(gp[6]) | ((unsigned long long)__builtin_amdgcn_readfirstlane(gp[7]) << 32);
    }
    auto act = [&](int nt, int jt) {
      const unsigned long long lo = nt ? g1lo : g0lo, hi = nt ? g1hi : g0hi;
      const unsigned long long wd = (jt < 64) ? (lo >> jt) : (hi >> (jt - 64));
      return (wd & 1ull) != 0ull;
    };
    mrow[0] = mrow[1] = NEGS; lrow[0] = lrow[1] = 0.f;
#pragma unroll
    for (int dt = 0; dt < 4; ++dt) { O[dt][0] = f32x4{0.f, 0.f, 0.f, 0.f}; O[dt][1] = f32x4{0.f, 0.f, 0.f, 0.f}; }
#ifdef NSA_DUMMY_SEL
    {
      nsa_branch<0, true>(sm, ulo, uhi, KS, VST, 4096, 64, qf, O, mrow, lrow, invl, mk, act, tokbase, tid);
      float chk = lrow[0] + lrow[1];
#pragma unroll
      for (int dt = 0; dt < 4; ++dt) chk += O[dt][0][0] + O[dt][0][1] + O[dt][0][2] + O[dt][0][3] + O[dt][1][0] + O[dt][1][1] + O[dt][1][2] + O[dt][1][3];
      if (chk == 123.456f) sm.sUn[0] = 1u;
      mrow[0] = mrow[1] = NEGS; lrow[0] = lrow[1] = 0.f;
#pragma unroll
      for (int dt = 0; dt < 4; ++dt) { O[dt][0] = f32x4{0.f, 0.f, 0.f, 0.f}; O[dt][1] = f32x4{0.f, 0.f, 0.f, 0.f}; }
      __syncthreads();
    }
#endif
    nsa_branch<0>(sm, ulo, uhi, KS, VST, 4096, 64, qf, O, mrow, lrow, invl, mk, act, tokbase, tid);
#pragma unroll
    for (int nt = 0; nt < 2; ++nt) {
      float l = lrow[nt];
      l += __shfl_xor(l, 16); l += __shfl_xor(l, 32);
      const float f = GATE(nt, 1) * ((l > 0.f) ? 1.f / l : 0.f);
#pragma unroll
      for (int dt = 0; dt < 4; ++dt) sOut[(nt * 4 + dt) * 64] += O[dt][nt] * f;
    }
  }
  {
    const bf16_t* KW = (const bf16_t*)(ws + L0_KW) + (long)bg * 8192 * 64;
    const bf16_t* VWT = (const bf16_t*)(ws + L0_VWT) + (long)bg * 128 * 4096;
    const int jlo = ((t0 - 511 > 0) ? (t0 - 511) : 0) >> 6;
    unsigned long long wlo = 0ull, whi = 0ull;
    for (int jj = jlo; jj <= cur; ++jj) { if (jj < 64) wlo |= (1ull << jj); else whi |= (1ull << (jj - 64)); }
    MaskW mk{tq[0], tq[1], t0 + tokbase, t0 + tokbase + 7};
    auto act = [&](int nt, int jt) { return true; };
    mrow[0] = mrow[1] = NEGS; lrow[0] = lrow[1] = 0.f;
#pragma unroll
    for (int dt = 0; dt < 4; ++dt) { O[dt][0] = f32x4{0.f, 0.f, 0.f, 0.f}; O[dt][1] = f32x4{0.f, 0.f, 0.f, 0.f}; }
    nsa_branch<0>(sm, wlo, whi, KW, VWT, 4096, 64, qf, O, mrow, lrow, invl, mk, act, tokbase, tid);
#pragma unroll
    for (int nt = 0; nt < 2; ++nt) {
      float l = lrow[nt];
      l += __shfl_xor(l, 16); l += __shfl_xor(l, 32);
      const float f = GATE(nt, 2) * ((l > 0.f) ? 1.f / l : 0.f);
#pragma unroll
      for (int dt = 0; dt < 4; ++dt) O[dt][nt] = sOut[(nt * 4 + dt) * 64] + O[dt][nt] * f;
    }
  }
  const bf16_t* NZ = (const bf16_t*)(ws + L0_NZ);
  bf16_t* Y = (bf16_t*)(ws + L0_QKRAW);
  uint2 zzv[2][4];
#pragma unroll
  for (int nt = 0; nt < 2; ++nt)
#pragma unroll
    for (int dt = 0; dt < 4; ++dt)
      zzv[nt][dt] = *(const uint2*)(NZ + ((long)b * 8192 + tq[nt]) * 512 + (g * 4 + (r & 3)) * 64 + dt * 16 + q * 4);
#pragma unroll
  for (int nt = 0; nt < 2; ++nt) {
    const long tok = (long)b * 8192 + tq[nt];
    const int head = g * 4 + (r & 3);
#pragma unroll
    for (int dt = 0; dt < 4; ++dt) {
      const int d = dt * 16 + q * 4;
      const uint2 zz = zzv[nt][dt];
      uint2 o;
      o.x = pack2(O[dt][nt][0] * lo2f(zz.x), O[dt][nt][1] * hi2f(zz.x));
      o.y = pack2(O[dt][nt][2] * lo2f(zz.y), O[dt][nt][3] * hi2f(zz.y));
      *(uint2*)(Y + tok * 1024 + 512 + head * 64 + d) = o;
    }
  }
  __syncthreads();
}

DEVI void hgrn_local(const Params& p, int unit, unsigned char* smem) {
  const int tid = opaque_tid(), lane = tid & 63, w = tid >> 6, wr = w >> 1, wc = w & 1;
  const int bh = unit >> 7, c = unit & 127, b = bh >> 3, h = bh & 7, t0 = c * 64;
  const long R0 = (long)b * 8192 + t0;
  unsigned char* ws = p.ws;
  bf16_t* sA = (bf16_t*)smem;
  bf16_t* sB = (bf16_t*)(smem + 18432);
  float* psum = (float*)(smem + 36864);
  const int cch = tid & 127, half = tid >> 7;
  const float lb = ((const float*)(ws + OFF_LB))[h * 128 + cch];
  const bf16_t* FP = (const bf16_t*)(ws + L1_FP) + R0 * 1024 + h * 128 + cch;
  float sgv[32], lgv[32];
  {
    const bf16_t* vtp = (const bf16_t*)(ws + L1_VT) + (((long)(b * 8 + h) * 128 + c) * 128) * 64 + (tid >> 3) * 64 + (tid & 7) * 8;
    u32x4 t0_ = *(const u32x4*)vtp, t1_ = *(const u32x4*)(vtp + 32 * 64), t2_ = *(const u32x4*)(vtp + 64 * 64), t3_ = *(const u32x4*)(vtp + 96 * 64);
    bf16_t fpr[32];
#pragma unroll
    for (int k = 0; k < 32; ++k) fpr[k] = FP[(long)(half * 32 + k) * 1024];
    {
      bf16_t* sp = sA + (tid >> 3) * LDT + (tid & 7) * 8;
      *(u32x4*)sp = t0_; *(u32x4*)(sp + 32 * LDT) = t1_; *(u32x4*)(sp + 64 * LDT) = t2_; *(u32x4*)(sp + 96 * LDT) = t3_;
    }
#pragma unroll
    for (int k = 0; k < 32; ++k) { sgv[k] = sigm(bf2f(fpr[k])); lgv[k] = __logf(lb + (1.f - lb) * sgv[k]); }
  }
  float sum = 0.f;
#pragma unroll
  for (int k = 0; k < 32; ++k) sum += lgv[k];
  psum[half * 128 + cch] = sum;
  __syncthreads();
  const float bL = psum[cch] + psum[128 + cch];
  float run = half ? psum[cch] : 0.f;
#pragma unroll
  for (int k = 0; k < 32; ++k) {
    run += lgv[k];
    float kk_ = (1.f - lb) * (1.f - sgv[k]);
    sB[cch * LDT + half * 32 + k] = f2bf(kk_ * __expf(bL - run));
  }
  if (half == 0) ((float*)(ws + L1_BL))[(long)unit * 128 + cch] = bL;
  __syncthreads();
  f32x4 acc[4][4];
#pragma unroll
  for (int mt = 0; mt < 4; ++mt)
#pragma unroll
    for (int nt = 0; nt < 4; ++nt) acc[mt][nt] = f32x4{0.f, 0.f, 0.f, 0.f};
  mma_lds_sw<4, 4, 2>(sA + wr * 64 * LDT, sB + wc * 64 * LDT, acc, lane);
#ifndef R9B
#define R9B 1
#endif
  for (int r9_ = 0; r9_ < R9B; ++r9_) {
  bf16_t* st = (bf16_t*)(ws + L1_ST) + (long)unit * 16384;
  const int r = lane & 15, q = lane >> 4;
#pragma unroll
  for (int mt = 0; mt < 4; ++mt) {
    const int v = wr * 64 + mt * 16 + r;
#pragma unroll
    for (int nt = 0; nt < 4; ++nt) {
      uint2 o;
      o.x = pack2(acc[mt][nt][0], acc[mt][nt][1]);
      o.y = pack2(acc[mt][nt][2], acc[mt][nt][3]);
      *(uint2*)(st + v * 128 + wc * 64 + nt * 16 + q * 4) = o;
    }
  }
  }
  __syncthreads();
}

template <bool DUMMY>
DEVI void hgrn_scan(const Params& p) {
  unsigned char* ws = p.ws;
  const float* BL = (const float*)(ws + L1_BL);
  for (int idx = blockIdx.x * 256 + opaque_tid(); idx < 16 * 8192; idx += gridDim.x * 256) {
    const int bh = idx >> 13, pr = idx & 8191;
    const int c2 = (pr & 63) * 2;
    unsigned* ptr = (unsigned*)(ws + L1_ST) + (long)bh * 128 * 8192 + pr;
    const float* blp = BL + (long)bh * 128 * 128 + c2;
    float s0 = 0.f, s1 = 0.f;
    for (int c0 = 0; c0 < 128; c0 += 8) {
      unsigned dv[8]; float2 bl[8];
#pragma unroll
      for (int k = 0; k < 8; ++k) { dv[k] = __builtin_nontemporal_load(ptr + (long)(c0 + k) * 8192); bl[k] = *(const float2*)(blp + (long)(c0 + k) * 128); }
#pragma unroll
      for (int k = 0; k < 8; ++k) {
        if (!DUMMY) __builtin_nontemporal_store(pack2(s0, s1), ptr + (long)(c0 + k) * 8192);
        s0 = __expf(bl[k].x) * s0 + lo2f(dv[k]);
        s1 = __expf(bl[k].y) * s1 + hi2f(dv[k]);
      }
    }
    if (DUMMY && s0 == 123.456f) ptr[0] = pack2(s0, s1);
  }
}

DEVI void hgrn_out(const Params& p, int unit, unsigned char* smem) {
  const int tid = opaque_tid(), lane = tid & 63, w = tid >> 6, wr = w >> 1, wc = w & 1;
  const int r = lane & 15, q = lane >> 4;
  const int bh = unit >> 7, c = unit & 127, b = bh >> 3, h = bh & 7, t0 = c * 64;
  const long R0 = (long)b * 8192 + t0;
  unsigned char* ws = p.ws;
  bf16_t* sQ0 = (bf16_t*)smem; bf16_t* sQ1 = (bf16_t*)(smem + 9216);
  bf16_t* sK0 = (bf16_t*)(smem + 18432); bf16_t* sK1 = (bf16_t*)(smem + 27648);
  bf16_t* sAm = (bf16_t*)(smem + 36864);
  bf16_t* sB = (bf16_t*)(smem + 46080);
  float* psum = (float*)(smem + 64512);
  float* sSs = psum + 256;
  const int cch = tid & 127, half = tid >> 7, cc = cch & 63;
  const float lb = ((const float*)(ws + OFF_LB))[h * 128 + cch];
  const bf16_t* FP = (const bf16_t*)(ws + L1_FP) + R0 * 1024 + h * 128 + cch;
  const bf16_t* Q1 = (const bf16_t*)(ws + L1_Q) + R0 * 1024 + h * 128 + cch;
  const bf16_t* vt = (const bf16_t*)(ws + L1_VT) + (((long)(b * 8 + h) * 128 + c) * 128) * 64;
  const bf16_t* st = (const bf16_t*)(ws + L1_ST) + (long)unit * 16384;
  const int tl_r = tid >> 3, tl_k = (tid & 7) * 8;
  u32x4 vv0, vv1, vv2, vv3, sa0, sa1, sa2, sa3, sb0, sb1, sb2, sb3;
  {
    const bf16_t* vp = vt + tl_r * 64 + tl_k;
    vv0 = *(const u32x4*)vp; vv1 = *(const u32x4*)(vp + 32 * 64); vv2 = *(const u32x4*)(vp + 64 * 64); vv3 = *(const u32x4*)(vp + 96 * 64);
    const bf16_t* sp = st + tl_r * 128 + tl_k;
    sa0 = *(const u32x4*)sp; sa1 = *(const u32x4*)(sp + 32 * 128); sa2 = *(const u32x4*)(sp + 64 * 128); sa3 = *(const u32x4*)(sp + 96 * 128);
    sb0 = *(const u32x4*)(sp + 64); sb1 = *(const u32x4*)(sp + 32 * 128 + 64); sb2 = *(const u32x4*)(sp + 64 * 128 + 64); sb3 = *(const u32x4*)(sp + 96 * 128 + 64);
  }
  float sgv[32], lgv[32];
  bf16_t qr[32];
  {
    bf16_t fpr[32];
#pragma unroll
    for (int k = 0; k < 32; ++k) { fpr[k] = FP[(long)(half * 32 + k) * 1024]; qr[k] = Q1[(long)(half * 32 + k) * 1024]; }
    { bf16_t* dp = sB + tl_r * LDT + tl_k; *(u32x4*)dp = vv0; *(u32x4*)(dp + 32 * LDT) = vv1; *(u32x4*)(dp + 64 * LDT) = vv2; *(u32x4*)(dp + 96 * LDT) = vv3; }
#pragma unroll
    for (int k = 0; k < 32; ++k) { sgv[k] = sigm(bf2f(fpr[k])); lgv[k] = __logf(lb + (1.f - lb) * sgv[k]); }
  }
  float sum = 0.f;
#pragma unroll
  for (int k = 0; k < 32; ++k) sum += lgv[k];
  psum[half * 128 + cch] = sum;
  __syncthreads();
  float run = half ? psum[cch] : 0.f;
  bf16_t* sQ = (cch < 64) ? sQ0 : sQ1;
  bf16_t* sK = (cch < 64) ? sK0 : sK1;
#pragma unroll
  for (int k = 0; k < 32; ++k) {
    const int s_ = half * 32 + k;
    run += lgv[k];
    float kk_ = (1.f - lb) * (1.f - sgv[k]);
    sQ[s_ * LDT + cc] = f2bf(bf2f(qr[k]) * __expf(run));
    sK[s_ * LDT + cc] = f2bf(kk_ * __expf(fminf(-run, 80.f)));
  }
  __syncthreads();
  {
    f32x4 a1[2][2];
#pragma unroll
    for (int mt = 0; mt < 2; ++mt)
#pragma unroll
      for (int nt = 0; nt < 2; ++nt) a1[mt][nt] = f32x4{0.f, 0.f, 0.f, 0.f};
    if (!(wr == 0 && wc == 1)) {
      mma_lds<2, 2, 2>(sQ0 + wr * 32 * LDT, sK0 + wc * 32 * LDT, a1, lane);
      mma_lds<2, 2, 2>(sQ1 + wr * 32 * LDT, sK1 + wc * 32 * LDT, a1, lane);
    }
#pragma unroll
    for (int mt = 0; mt < 2; ++mt)
#pragma unroll
      for (int i = 0; i < 4; ++i) {
        int j = wr * 32 + mt * 16 + q * 4 + i;
#pragma unroll
        for (int nt = 0; nt < 2; ++nt) {
          int s = wc * 32 + nt * 16 + r;
          sAm[j * LDT + s] = f2bf((s <= j) ? a1[mt][nt][i] : 0.f);
        }
      }
  }
  __syncthreads();
  f32x4 o[2][4];
#pragma unroll
  for (int mt = 0; mt < 2; ++mt)
#pragma unroll
    for (int nt = 0; nt < 4; ++nt) o[mt][nt] = f32x4{0.f, 0.f, 0.f, 0.f};
  mma_lds<2, 4, 2>(sAm + wr * 32 * LDT, sB + wc * 64 * LDT, o, lane);
  __syncthreads();
  { bf16_t* dp = sB + tl_r * LDT + tl_k; *(u32x4*)dp = sa0; *(u32x4*)(dp + 32 * LDT) = sa1; *(u32x4*)(dp + 64 * LDT) = sa2; *(u32x4*)(dp + 96 * LDT) = sa3; }
  __syncthreads();
  mma_lds<2, 4, 2>(sQ0 + wr * 32 * LDT, sB + wc * 64 * LDT, o, lane);
  __syncthreads();
  { bf16_t* dp = sB + tl_r * LDT + tl_k; *(u32x4*)dp = sb0; *(u32x4*)(dp + 32 * LDT) = sb1; *(u32x4*)(dp + 64 * LDT) = sb2; *(u32x4*)(dp + 96 * LDT) = sb3; }
  __syncthreads();
  mma_lds<2, 4, 2>(sQ1 + wr * 32 * LDT, sB + wc * 64 * LDT, o, lane);
#pragma unroll
  for (int mt = 0; mt < 2; ++mt)
#pragma unroll
    for (int i = 0; i < 4; ++i) {
      int j = wr * 32 + mt * 16 + q * 4 + i;
      float ss = 0.f;
#pragma unroll
      for (int nt = 0; nt < 4; ++nt) ss += o[mt][nt][i] * o[mt][nt][i];
      ss = grp16_sum(ss);
      if (r == 0) sSs[wc * 64 + j] = ss;
    }
  __syncthreads();
  const bf16_t* Z1 = (const bf16_t*)(ws + L1_Z);
  bf16_t* Y1 = (bf16_t*)(ws + L1_H);
  float hn[4];
#pragma unroll
  for (int nt = 0; nt < 4; ++nt) hn[nt] = p.h_hn[h * 128 + wc * 64 + nt * 16 + r];
#pragma unroll
  for (int mt = 0; mt < 2; ++mt) {
    float zv[4][4];
#pragma unroll
    for (int i = 0; i < 4; ++i) {
      long row = R0 + wr * 32 + mt * 16 + q * 4 + i;
#pragma unroll
      for (int nt = 0; nt < 4; ++nt) zv[i][nt] = bf2f(Z1[row * 1024 + h * 128 + wc * 64 + nt * 16 + r]);
    }
#pragma unroll
    for (int i = 0; i < 4; ++i) {
      int j = wr * 32 + mt * 16 + q * 4 + i;
      float rinv = rsqrtf((sSs[j] + sSs[64 + j]) * (1.f / 128.f) + EPSF);
      long row = R0 + j;
#pragma unroll
      for (int nt = 0; nt < 4; ++nt) {
        int col = h * 128 + wc * 64 + nt * 16 + r;
        Y1[row * 1024 + col] = f2bf(o[mt][nt][i] * rinv * hn[nt] * zv[i][nt]);
      }
    }
  }
  __syncthreads();
}

#define XB_TMO      128
#define XB_XCNT(j)  (256  + 64 * (j))
#define XB_XSUB(j)  (1280 + 64 * (j))
#define XB_XGEN(j)  (2304 + 64 * (j))
#define XB_TOP      3328
#define XB_TOPGEN   3392
#define XCD_BAR_WORDS 3456
#define XB_SPIN_CAP (1u << 22)
DEVI unsigned xb_ld(unsigned* p) { return __hip_atomic_load(p, __ATOMIC_RELAXED, __HIP_MEMORY_SCOPE_AGENT); }
DEVI unsigned xb_add(unsigned* p, unsigned v) { return __hip_atomic_fetch_add(p, v, __ATOMIC_RELAXED, __HIP_MEMORY_SCOPE_AGENT); }
DEVI unsigned xb_xcc_id() { return (unsigned)__builtin_amdgcn_s_getreg((3 << 11) | 20) & 0xFu; }
#define XB_SPIN(cond, bar) do { unsigned _sp = 0; while (cond) { __builtin_amdgcn_s_sleep(1); \
    if ((++_sp & 255u) == 0u) { if (xb_ld(&(bar)[XB_TMO])) break; if (_sp > XB_SPIN_CAP) { atomicAdd(&(bar)[XB_TMO], 1u); break; } } } } while (0)

DEVI void xcd_barrier_complete(unsigned* bar, unsigned x, unsigned& nloc, unsigned& nx) {
  const unsigned G = gridDim.x;
  unsigned sum, cnt, mine, sp = 0u;
  for (;;) {
    sum = 0u; cnt = 0u; mine = 0u;
#pragma unroll
    for (unsigned j = 0; j < 16; ++j) { const unsigned c = xb_ld(&bar[XB_XCNT(j)]); sum += c; cnt += (c > 0u) ? 1u : 0u; mine = (j == x) ? c : mine; }
    if (sum == G) break;
    __builtin_amdgcn_s_sleep(1);
    if ((++sp & 255u) == 0u) { if (xb_ld(&bar[XB_TMO])) break; if (sp > XB_SPIN_CAP) { atomicAdd(&bar[XB_TMO], 1u); break; } }
  }
  nloc = mine > 0u ? mine : 1u; nx = cnt > 0u ? cnt : 1u;
}

DEVI void grid_barrier(unsigned* bar, unsigned xcc, volatile unsigned* st) {
  asm volatile("s_waitcnt vmcnt(0)" ::: "memory");
  __syncthreads();
  if (threadIdx.x == 0) {
    __builtin_amdgcn_s_waitcnt(0);
    unsigned nloc = st[0], nx = st[1];
    if (nloc == 0u) { xcd_barrier_complete(bar, xcc, nloc, nx); st[0] = nloc; st[1] = nx; }
    const unsigned old = xb_add(&bar[XB_XSUB(xcc)], 1u);
    const unsigned gen = old / nloc;
    if (old + 1u == (gen + 1u) * nloc) {
      __builtin_amdgcn_fence(__ATOMIC_RELEASE, "agent");
      asm volatile("s_waitcnt vmcnt(0)" ::: "memory");
      const unsigned og = xb_add(&bar[XB_TOP], 1u);
      const unsigned tg = og / nx;
      if (og + 1u == (tg + 1u) * nx) xb_add(&bar[XB_TOPGEN], 1u);
      else XB_SPIN(xb_ld(&bar[XB_TOPGEN]) == tg, bar);
      __builtin_amdgcn_fence(__ATOMIC_ACQUIRE, "agent");
      xb_add(&bar[XB_XGEN(xcc)], 1u);
      asm volatile("s_waitcnt vmcnt(0)" ::: "memory");
    } else {
      XB_SPIN(xb_ld(&bar[XB_XGEN(xcc)]) == gen, bar);
      __builtin_amdgcn_fence(__ATOMIC_ACQUIRE, "agent");
      asm volatile("s_waitcnt vmcnt(0)" ::: "memory");
    }
  }
  __syncthreads();
}

#ifndef REP_NSA
#define REP_NSA 1
#endif
#ifndef REP_P0
#define REP_P0 1
#endif
#ifndef REP_P1
#define REP_P1 1
#endif
#ifndef REP_P2
#define REP_P2 1
#endif
#ifndef REP_P3
#define REP_P3 1
#endif
#ifndef REP_P4
#define REP_P4 1
#endif
#ifndef REP_P5
#define REP_P5 1
#endif
#ifndef REP_P6
#define REP_P6 1
#endif
#ifndef REP_P7
#define REP_P7 1
#endif
#ifndef REP_P8
#define REP_P8 1
#endif
#ifndef REP_P9
#define REP_P9 1
#endif
#ifndef REP_P10
#define REP_P10 1
#endif
#ifndef REP_P11
#define REP_P11 1
#endif
#ifndef REP_P12
#define REP_P12 1
#endif
#ifndef DBG_STOP
#define DBG_STOP 99
#endif
DEVI void dbg_probe_bf16(const Params& p, size_t off, long n) {
  const bf16_t* b = (const bf16_t*)(p.ws + off);
  for (long i = (long)blockIdx.x * 256 + threadIdx.x; i < 16384L * 1024; i += (long)gridDim.x * 256) {
    float v = bf2f(b[i % n]);
    if (!(v == v) || fabsf(v) > 1e30f) v = 777.f;
    p.out[i] = v;
  }
}
DEVI void dbg_probe_f32(const Params& p, size_t off, long n) {
  const float* b = (const float*)(p.ws + off);
  for (long i = (long)blockIdx.x * 256 + threadIdx.x; i < 16384L * 1024; i += (long)gridDim.x * 256) {
    float v = b[i % n];
    if (!(v == v) || fabsf(v) > 1e30f) v = 777.f;
    p.out[i] = v;
  }
}
DEVI void dbg_probe_combo(const Params& p) {
  const bf16_t* qn = (const bf16_t*)(p.ws + L0_QN);
  const bf16_t* ks = (const bf16_t*)(p.ws + L0_KS);
  const bf16_t* nz = (const bf16_t*)(p.ws + L0_NZ);
  const float* ig = (const float*)(p.ws + L0_IG);
  for (long i = (long)blockIdx.x * 256 + threadIdx.x; i < 16384L * 1024; i += (long)gridDim.x * 256) {
    float v = bf2f(qn[i % (16384L * 512)]) + bf2f(ks[i % (4L * 8192 * 64 * 4)]) + bf2f(nz[i % (16384L * 512)]) + ig[i % (16384L * 32)];
    if (!(v == v) || fabsf(v) > 1e30f) v = 777.f;
    p.out[i] = v;
  }
}
#define DBG_AT(k, stmt) if (DBG_STOP == k) { stmt; return; }

__device__ unsigned g_bar_words[8192];

#define GSYNC() grid_barrier(bar_ctr, bar_xcc, bar_st)

__global__ void __launch_bounds__(256, 2) mega(Params p) {
  __shared__ __attribute__((aligned(16))) unsigned char smem[79872];
  cg::grid_group grid = cg::this_grid();
  const int G = gridDim.x, bid = blockIdx.x, tid = threadIdx.x, lane = tid & 63, w = tid >> 6;
  unsigned char* ws = p.ws;
  bf16_t* sA = (bf16_t*)smem;
  bf16_t* sB = (bf16_t*)(smem + 16384);
  unsigned* bar_ctr = g_bar_words;
  __shared__ uint4 xb_words;
  if (tid == 0) xb_words = make_uint4(0u, 0u, 0u, 0u);
  __syncthreads();
  volatile unsigned* bar_st = (volatile unsigned*)&xb_words;
  const unsigned bar_xcc = xb_xcc_id();
  if (tid == 0) (void)xb_add(&bar_ctr[XB_XCNT(bar_xcc)], 1u);
  if (p.ws == nullptr) grid.sync();

#ifdef EXTRA_SYNCS
  for (int e_ = 0; e_ < EXTRA_SYNCS; ++e_) GSYNC();
#endif
  for (int rep_ = 0; rep_ < REP_P0; ++rep_) {
  phase0(p, smem);
  GSYNC();
  }
  DBG_AT(0, dbg_probe_bf16(p, L0_H, 16384L*1024))
  for (int rep_ = 0; rep_ < REP_P1; ++rep_) {
#ifdef USE_G256
  for (int k_ = 0; k_ * (G >> 3) < 8 * 32; ++k_) {
    int tm, tn;
    if (!gemm_tile_xcd256(bid, G, k_, 32, tm, tn)) continue;
    gemm256((const bf16_t*)(ws + L0_H), 1024, (const bf16_t*)(ws + OFF_WIN0), 1024, 1024, tm * 256, tn * 128, sA, (bf16_t*)(smem + 32768),
            [&](f32x4 (&acc)[4][4], int mb, int nb, int ln) { epi_proj0(p, acc, mb, nb, ln); });
  }
  for (int v_ = (bid >> 3); v_ < 48; v_ += (G >> 3)) {
    const int tm = (bid & 7) * 16 + v_ / 3, tn = 32 + v_ % 3;
    gemm128<false>((const bf16_t*)(ws + L0_H), 1024, 16383, (const bf16_t*)(ws + OFF_WIN0), 1024, 4383, 1024, tm * 128, tn * 128, sA, sB,
            [&](f32x4 (&acc)[4][4], int mb, int nb, int ln) { epi_proj0(p, acc, mb, nb, ln); });
  }
#else
  for (int k_ = 0; k_ * (G >> 3) < 16 * 35; ++k_) {
    int tm, tn;
    if (!gemm_tile_xcd(bid, G, k_, 35, tm, tn)) continue;
    gemm128<false>((const bf16_t*)(ws + L0_H), 1024, 16383, (const bf16_t*)(ws + OFF_WIN0), 1024, 4383, 1024, tm * 128, tn * 128, sA, sB,
            [&](f32x4 (&acc)[4][4], int mb, int nb, int ln) { epi_proj0(p, acc, mb, nb, ln); });
  }
#endif
  GSYNC();
  }
  DBG_AT(1, dbg_probe_bf16(p, L0_QKRAW, 16384L*1024)) DBG_AT(101, dbg_probe_combo(p)) DBG_AT(102, dbg_probe_bf16(p, L0_KS, 4L*8192*64*4)) DBG_AT(103, dbg_probe_f32(p, L0_IG, 16384L*4*2+16384L*24)) DBG_AT(104, dbg_probe_bf16(p, L0_MVT, 16384L*512*3))
  for (int rep_ = 0; rep_ < REP_P2; ++rep_) {
  for (int it = bid; it < 128 + 2048; it += G) {
    if (it < 128) {
      int ksp = it >> 5, kv = (it >> 4) & 1, bg = (it >> 2) & 3, tm = it & 3;
      const bf16_t* A = (const bf16_t*)(ws + (kv ? L0_VCRAW : L0_KCRAW)) + (long)bg * 8192 * 64 + ksp * 512;
      const bf16_t* B = (const bf16_t*)(ws + (kv ? OFF_WCV : OFF_WCK)) + ksp * 512;
      gemm128<false>(A, 1024, 510, B, 2048, 127, 512, tm * 128, 0, sA, sB,
              [&](f32x4 (&acc)[4][4], int mb, int nb, int ln) { epi_cmp_hidden(p, acc, mb, nb, ln, kv, bg, ksp); });
    } else {
      conv_tile(p, it - 128, smem);
    }
  }
  GSYNC();
  }
  DBG_AT(2, dbg_probe_bf16(p, L0_QC, 16384L*512*3)) DBG_AT(201, dbg_probe_f32(p, L0_HID, 2L*4*512*128))
  for (int rep_ = 0; rep_ < REP_P3; ++rep_) {
  for (int it = bid; it < 512 + 1024; it += G) {
    if (it < 512) mlstm_local(p, it, smem);
    else { const int t_ = opaque_tid(); cmp_finalize(p, (it - 512) * 4 + (t_ >> 6), t_ & 63); }
  }
  GSYNC();
  }
  DBG_AT(3, dbg_probe_f32(p, L0_H, 512L*16384)) DBG_AT(301, dbg_probe_bf16(p, L0_KCMP, 4L*512*64*2)) DBG_AT(302, dbg_probe_f32(p, L0_DN, 512L*128 + 2048))
  for (int rep_ = 0; rep_ < REP_P4; ++rep_) {
#ifdef DUMMY_P4
  mlstm_scan<true>(p, smem);
  GSYNC();
#endif
  mlstm_scan<false>(p, smem);
  GSYNC();
  }
  DBG_AT(4, dbg_probe_f32(p, L0_H, 512L*16384)) DBG_AT(401, dbg_probe_f32(p, L0_DN, 512L*128 + 3072))
  for (int rep_ = 0; rep_ < REP_P5; ++rep_) {
#ifdef USE_WQ
  {
    unsigned* wq = bar_ctr + 3600;
    volatile unsigned* slot = (volatile unsigned*)&xb_words;
    for (int s_ = 0; s_ < 5; ++s_) {
      const int qi = (s_ < 4) ? (int)((bar_xcc + (unsigned)s_) & 3u) : 4;
      const int qn_ = (s_ < 4) ? 256 : 1024;
      for (;;) {
        if (tid == 0) slot[3] = xb_add(&wq[qi * 64], 1u);
        __syncthreads();
        const int it = (int)slot[3];
        __syncthreads();
        if (it >= qn_) break;
        if (s_ < 4) nsa_tile(p, (255 - it) * 4 + qi, smem);
        else mlstm_out(p, it, smem);
      }
    }
  }
#else
  for (int it = bid; it < 1024 + 1024; it += G) {
    if (it < 1024) {
      int k = it >> 9, i = it & 511;
      int idx = (k & 1) ? (k * 512 + 511 - i) : it;
#ifndef DBG_SKIP_NSA
      for (int r2_ = 0; r2_ < REP_NSA; ++r2_) nsa_tile(p, idx, smem);
#endif
    } else {
#ifndef DBG_SKIP_MOUT
      mlstm_out(p, it - 1024, smem);
#endif
    }
  }
#endif
  GSYNC();
  }
  DBG_AT(5, dbg_probe_bf16(p, L0_QKRAW, 16384L*1024))
  for (int rep_ = 0; rep_ < REP_P6; ++rep_) {
#ifdef USE_G256
  for (int k_ = 0; k_ * (G >> 3) < 8 * 8; ++k_) {
    int tm, tn;
    if (!gemm_tile_xcd256(bid, G, k_, 8, tm, tn)) continue;
    gemm256((const bf16_t*)(ws + L0_QKRAW), 1024, (const bf16_t*)(ws + OFF_WOUT0), 1024, 1024, tm * 256, tn * 128, sA, (bf16_t*)(smem + 32768),
            [&](f32x4 (&acc)[4][4], int mb, int nb, int ln) { epi_out_resid(p.x, p.out, acc, mb, nb, ln); });
  }
#else
  for (int k_ = 0; k_ * (G >> 3) < 16 * 8; ++k_) {
    int tm, tn;
    if (!gemm_tile_xcd(bid, G, k_, 8, tm, tn)) continue;
    gemm128<false>((const bf16_t*)(ws + L0_QKRAW), 1024, 16383, (const bf16_t*)(ws + OFF_WOUT0), 1024, 1023, 1024, tm * 128, tn * 128, sA, sB,
            [&](f32x4 (&acc)[4][4], int mb, int nb, int ln) { epi_out_resid(p.x, p.out, acc, mb, nb, ln); });
  }
#endif
  GSYNC();
  }
  DBG_AT(6, (void)0)
  for (int rep_ = 0; rep_ < REP_P7; ++rep_) {
  { const int t_ = opaque_tid(); for (int row = (bid * 4 + (t_ >> 6)) * 2; row < 16384; row += G * 8) rmsnorm_row2(p.out, p.norm_w + 1024, (bf16_t*)(ws + L1_H), row, row + 1, t_ & 63); }
  GSYNC();
  }
  DBG_AT(7, dbg_probe_bf16(p, L1_H, 16384L*1024))
  for (int rep_ = 0; rep_ < REP_P8; ++rep_) {
#ifdef USE_G256
  for (int k_ = 0; k_ * (G >> 3) < 8 * 32; ++k_) {
    int tm, tn;
    if (!gemm_tile_xcd256(bid, G, k_, 32, tm, tn)) continue;
    gemm256((const bf16_t*)(ws + L1_H), 1024, (const bf16_t*)(ws + OFF_WIN1), 1024, 1024, tm * 256, tn * 128, sA, (bf16_t*)(smem + 32768),
            [&](f32x4 (&acc)[4][4], int mb, int nb, int ln) { epi_proj1(p, acc, mb, nb, ln); });
  }
#else
  for (int k_ = 0; k_ * (G >> 3) < 16 * 32; ++k_) {
    int tm, tn;
    if (!gemm_tile_xcd(bid, G, k_, 32, tm, tn)) continue;
    gemm128<false>((const bf16_t*)(ws + L1_H), 1024, 16383, (const bf16_t*)(ws + OFF_WIN1), 1024, 4095, 1024, tm * 128, tn * 128, sA, sB,
            [&](f32x4 (&acc)[4][4], int mb, int nb, int ln) { epi_proj1(p, acc, mb, nb, ln); });
  }
#endif
  GSYNC();
  }
  DBG_AT(8, dbg_probe_bf16(p, L1_FP, 16384L*1024*4))
  for (int rep_ = 0; rep_ < REP_P9; ++rep_) {
  for (int it = bid; it < 2048; it += G) hgrn_local(p, it, smem);
  GSYNC();
  }
  DBG_AT(9, dbg_probe_bf16(p, L1_ST, 2048L*16384))
  for (int rep_ = 0; rep_ < REP_P10; ++rep_) {
#ifdef DUMMY_P10
  hgrn_scan<true>(p);
  GSYNC();
#endif
  hgrn_scan<false>(p);
  GSYNC();
  }
  DBG_AT(10, dbg_probe_bf16(p, L1_ST, 2048L*16384))
  for (int rep_ = 0; rep_ < REP_P11; ++rep_) {
  for (int it = bid; it < 2048; it += G) hgrn_out(p, it, smem);
  GSYNC();
  }
  DBG_AT(11, dbg_probe_bf16(p, L1_H, 16384L*1024))
  for (int rep_ = 0; rep_ < REP_P12; ++rep_) {
#ifdef USE_G256
  for (int k_ = 0; k_ * (G >> 3) < 8 * 8; ++k_) {
    int tm, tn;
    if (!gemm_tile_xcd256(bid, G, k_, 8, tm, tn)) continue;
    gemm256((const bf16_t*)(ws + L1_H), 1024, (const bf16_t*)(ws + OFF_WOUT1), 1024, 1024, tm * 256, tn * 128, sA, (bf16_t*)(smem + 32768),
            [&](f32x4 (&acc)[4][4], int mb, int nb, int ln) { epi_out_resid(p.out, p.out, acc, mb, nb, ln); });
  }
#else
  for (int k_ = 0; k_ * (G >> 3) < 16 * 8; ++k_) {
    int tm, tn;
    if (!gemm_tile_xcd(bid, G, k_, 8, tm, tn)) continue;
    gemm128<false>((const bf16_t*)(ws + L1_H), 1024, 16383, (const bf16_t*)(ws + OFF_WOUT1), 1024, 1023, 1024, tm * 128, tn * 128, sA, sB,
            [&](f32x4 (&acc)[4][4], int mb, int nb, int ln) { epi_out_resid(p.out, p.out, acc, mb, nb, ln); });
  }
#endif
  }
  __syncthreads();
  if (tid == 0) {
    const unsigned done_ = xb_add(&bar_ctr[8000], 1u);
    if (done_ == (unsigned)G - 1u) {
      for (int j_ = 0; j_ < 16; ++j_) {
        __hip_atomic_store(&bar_ctr[XB_XCNT(j_)], 0u, __ATOMIC_RELAXED, __HIP_MEMORY_SCOPE_AGENT);
        __hip_atomic_store(&bar_ctr[XB_XSUB(j_)], 0u, __ATOMIC_RELAXED, __HIP_MEMORY_SCOPE_AGENT);
        __hip_atomic_store(&bar_ctr[XB_XGEN(j_)], 0u, __ATOMIC_RELAXED, __HIP_MEMORY_SCOPE_AGENT);
        __hip_atomic_store(&bar_ctr[3600 + j_ * 64], 0u, __ATOMIC_RELAXED, __HIP_MEMORY_SCOPE_AGENT);
      }
      __hip_atomic_store(&bar_ctr[XB_TMO], 0u, __ATOMIC_RELAXED, __HIP_MEMORY_SCOPE_AGENT);
      __hip_atomic_store(&bar_ctr[XB_TOP], 0u, __ATOMIC_RELAXED, __HIP_MEMORY_SCOPE_AGENT);
      __hip_atomic_store(&bar_ctr[XB_TOPGEN], 0u, __ATOMIC_RELAXED, __HIP_MEMORY_SCOPE_AGENT);
      __hip_atomic_store(&bar_ctr[8000], 0u, __ATOMIC_RELAXED, __HIP_MEMORY_SCOPE_AGENT);
    }
  }
}

extern "C" void kernel_launch(void* const* d_in, const int* in_sizes, int n_in, void* d_out, int out_size, void* d_ws, size_t ws_size,
                              hipStream_t stream) {
  static int grid_blocks = 0;
  if (!grid_blocks) {
    int dev = 0, cus = 0, per_cu = 0;
    (void)hipGetDevice(&dev);
    (void)hipDeviceGetAttribute(&cus, hipDeviceAttributeMultiprocessorCount, dev);
    (void)hipOccupancyMaxActiveBlocksPerMultiprocessor(&per_cu, mega, 256, 0);
    if (per_cu > 2) per_cu = 2;
    if (per_cu < 1) per_cu = 1;
    grid_blocks = cus * per_cu;
  }
  Params p{};
  const float** pf = (const float**)&p;
  for (int i = 0; i < 22; ++i) pf[i] = (const float*)d_in[i];
  p.out = (float*)d_out;
  p.ws = (unsigned char*)d_ws;
  void* args[] = {&p};
  hipError_t e = hipLaunchCooperativeKernel((void*)mega, dim3(grid_blocks), dim3(256), args, 0, stream);
  if (e != hipSuccess) fprintf(stderr, "cooperative launch failed: %s (grid %d)\n", hipGetErrorString(e), grid_blocks);
}
```

```cpp
#include <hip/hip_runtime.h>
#define USE_G256 1
#define USE_WQ 1
#include <hip/hip_cooperative_groups.h>
#include <stdint.h>
#include <cstdio>
namespace cg = cooperative_groups;

typedef unsigned short bf16_t;
typedef __attribute__((ext_vector_type(8))) short bf16x8;
typedef __attribute__((ext_vector_type(4))) float f32x4;
typedef __attribute__((ext_vector_type(4))) unsigned int u32x4;

#define DEVI __device__ __forceinline__
#define EPSF 1e-6f
#define LDT 72
#define SLD 68
#define NEGS (-1e30f)
#define LAUNDER(ptr) asm volatile("" : "+s"(ptr))

struct Params {
  const float* x; const float* norm_w; const float* ev_w_in; const float* ev_b_in; const float* f_bias;
  const float* conv_w; const float* conv_b; const float* m_hn; const float* q_norm; const float* k_norm;
  const float* ck_pos; const float* ck_w1; const float* ck_w2; const float* cv_pos; const float* cv_w1; const float* cv_w2;
  const float* ev_w_out; const float* od_w_in; const float* od_b_in; const float* lb_logits; const float* h_hn; const float* od_w_out;
  float* out; unsigned char* ws;
};

constexpr size_t MiB = 1048576;
constexpr size_t OFF_WIN0 = 0;
constexpr size_t OFF_WOUT0 = OFF_WIN0 + 4480ull * 1024 * 2;
constexpr size_t OFF_WIN1 = OFF_WOUT0 + 2 * MiB;
constexpr size_t OFF_WOUT1 = OFF_WIN1 + 8 * MiB;
constexpr size_t OFF_WCK = OFF_WOUT1 + 2 * MiB;
constexpr size_t OFF_WCV = OFF_WCK + 512 * 1024;
constexpr size_t OFF_ROPE = OFF_WCV + 512 * 1024;
constexpr size_t OFF_PB = OFF_ROPE + 512 * 1024;
constexpr size_t OFF_LB = OFF_PB + 1024;
constexpr size_t OFF_BAR = OFF_LB + 4096;
constexpr size_t OFF_BASE = 24 * MiB;
constexpr size_t L0_H = OFF_BASE;
constexpr size_t L0_QKRAW = L0_H + 32 * MiB;
constexpr size_t L0_QC = L0_QKRAW + 32 * MiB;
constexpr size_t L0_KC = L0_QC + 16 * MiB;
constexpr size_t L0_KCT = L0_KC + 16 * MiB;
constexpr size_t L0_MVT = L0_KCT + 16 * MiB;
constexpr size_t L0_MO = L0_MVT + 16 * MiB;
constexpr size_t L0_MZ = L0_MO + 16 * MiB;
constexpr size_t L0_QN = L0_MZ + 16 * MiB;
constexpr size_t L0_NZ = L0_QN + 16 * MiB;
constexpr size_t L0_KCRAW = L0_NZ + 16 * MiB;
constexpr size_t L0_VCRAW = L0_KCRAW + 4 * MiB;
constexpr size_t L0_KS = L0_VCRAW + 4 * MiB;
constexpr size_t L0_KW = L0_KS + 4 * MiB;
constexpr size_t L0_VST = L0_KW + 4 * MiB;
constexpr size_t L0_VWT = L0_VST + 4 * MiB;
constexpr size_t L0_HID = L0_VWT + 4 * MiB;
constexpr size_t L0_KCMP = L0_HID + 2 * MiB;
constexpr size_t L0_VCMPT = L0_KCMP + 256 * 1024;
constexpr size_t L0_IG = L0_VCMPT + 256 * 1024;
constexpr size_t L0_LOGF = L0_IG + 256 * 1024;
constexpr size_t L0_GATES = L0_LOGF + 256 * 1024;
constexpr size_t L0_DN = L0_GATES + 1536 * 1024;
constexpr size_t L0_BL = L0_DN + 256 * 1024;
constexpr size_t L0_MLOC = L0_BL + 4096;
constexpr size_t L0_MIN = L0_MLOC + 4096;
constexpr size_t L0_HIDP = L0_MIN + 4096;
constexpr size_t L0_END = L0_HIDP + 8 * MiB;
static_assert(L0_END <= 256 * MiB, "ws overflow L0");
constexpr size_t L1_H = OFF_BASE;
constexpr size_t L1_FP = L1_H + 32 * MiB;
constexpr size_t L1_Q = L1_FP + 32 * MiB;
constexpr size_t L1_VT = L1_Q + 32 * MiB;
constexpr size_t L1_Z = L1_VT + 32 * MiB;
constexpr size_t L1_ST = L1_Z + 32 * MiB;
constexpr size_t L1_BL = L1_ST + 64 * MiB;
constexpr size_t L1_END = L1_BL + 1 * MiB;
static_assert(L1_END <= 256 * MiB, "ws overflow L1");

DEVI int opaque_tid() { int t = threadIdx.x; asm volatile("" : "+v"(t)); return t; }
typedef __bf16 bf16v2_t __attribute__((ext_vector_type(2)));
typedef float f32v2_t __attribute__((ext_vector_type(2)));
DEVI bf16_t f2bf(float f) { __bf16 h = (__bf16)f; return __builtin_bit_cast(unsigned short, h); }
DEVI float bf2f(bf16_t b) { return __uint_as_float(((unsigned)b) << 16); }
DEVI unsigned pack2(float a, float b) { f32v2_t f = {a, b}; bf16v2_t h = __builtin_convertvector(f, bf16v2_t); return __builtin_bit_cast(unsigned, h); }
DEVI float lo2f(unsigned u) { return __uint_as_float(u << 16); }
DEVI float hi2f(unsigned u) { return __uint_as_float(u & 0xffff0000u); }
DEVI float sigm(float x) { return __builtin_amdgcn_rcpf(1.f + __expf(-x)); }
DEVI float siluf(float x) { return x * sigm(x); }
DEVI float wave_sum(float v) { for (int o = 32; o > 0; o >>= 1) v += __shfl_xor(v, o); return v; }
DEVI float grp16_sum(float v) { v += __shfl_xor(v, 1); v += __shfl_xor(v, 2); v += __shfl_xor(v, 4); v += __shfl_xor(v, 8); return v; }

DEVI void wave_scan_sum128(float& a, float& b, int lane) {
  float t = a + b;
  float s = t;
#pragma unroll
  for (int o = 1; o < 64; o <<= 1) { float u = __shfl_up(s, o); if (lane >= o) s += u; }
  const float excl = s - t;
  a = excl + a;
  b = a + b;
}
DEVI void wave_scan_max128(float& a, float& b, int lane) {
  float t = fmaxf(a, b);
  float s = t;
#pragma unroll
  for (int o = 1; o < 64; o <<= 1) { float u = __shfl_up(s, o); if (lane >= o) s = fmaxf(s, u); }
  float prev = __shfl_up(s, 1);
  if (lane == 0) prev = -3.0e38f;
  a = fmaxf(prev, a);
  b = fmaxf(a, b);
}
DEVI float wave_max(float v) { for (int o = 32; o > 0; o >>= 1) v = fmaxf(v, __shfl_xor(v, o)); return v; }
DEVI int oldcol(int n) {
  return n < 2560 ? n : (n < 3840 ? n + 8 : (n < 4352 ? n + 32 : (n < 4360 ? n - 4352 + 2560 : n - 4360 + 3848)));
}

template <int MT, int NTL, int KS>
DEVI void mma_lds(const bf16_t* sA, const bf16_t* sB, f32x4 (&acc)[MT][NTL], int lane, bool neg = false) {
  const int r = lane & 15, q = lane >> 4;
#pragma unroll
  for (int ks = 0; ks < KS; ++ks) {
    bf16x8 a[MT], b[NTL];
#pragma unroll
    for (int mt = 0; mt < MT; ++mt) a[mt] = *(const bf16x8*)(sA + (mt * 16 + r) * LDT + ks * 32 + q * 8);
    if (neg) {
#pragma unroll
      for (int mt = 0; mt < MT; ++mt) a[mt] ^= (short)0x8000;
    }
#pragma unroll
    for (int nt = 0; nt < NTL; ++nt) b[nt] = *(const bf16x8*)(sB + (nt * 16 + r) * LDT + ks * 32 + q * 8);
#pragma unroll
    for (int mt = 0; mt < MT; ++mt)
#pragma unroll
      for (int nt = 0; nt < NTL; ++nt) acc[mt][nt] = __builtin_amdgcn_mfma_f32_16x16x32_bf16(a[mt], b[nt], acc[mt][nt], 0, 0, 0);
  }
}
template <int MT, int NTL, int KS>
DEVI void mma_lds_sw(const bf16_t* sA, const bf16_t* sB, f32x4 (&acc)[MT][NTL], int lane, bool neg = false) {
  const int r = lane & 15, q = lane >> 4;
#pragma unroll
  for (int ks = 0; ks < KS; ++ks) {
    bf16x8 a[MT], b[NTL];
#pragma unroll
    for (int mt = 0; mt < MT; ++mt) a[mt] = *(const bf16x8*)(sA + (mt * 16 + r) * LDT + ks * 32 + q * 8);
    if (neg) {
#pragma unroll
      for (int mt = 0; mt < MT; ++mt) a[mt] ^= (short)0x8000;
    }
#pragma unroll
    for (int nt = 0; nt < NTL; ++nt) b[nt] = *(const bf16x8*)(sB + (nt * 16 + r) * LDT + ks * 32 + q * 8);
#pragma unroll
    for (int mt = 0; mt < MT; ++mt)
#pragma unroll
      for (int nt = 0; nt < NTL; ++nt) acc[mt][nt] = __builtin_amdgcn_mfma_f32_16x16x32_bf16(b[nt], a[mt], acc[mt][nt], 0, 0, 0);
  }
}


template <int MT, int NTL, bool SWAP>
DEVI void mma_swz(const bf16_t* sA, const bf16_t* sB, f32x4 (&acc)[MT][NTL], int lane, bool neg) {
  const int r = lane & 15, q = lane >> 4, r7 = r & 7;
#pragma unroll
  for (int ks = 0; ks < 2; ++ks) {
    bf16x8 a[MT], b[NTL];
    const int co = ((ks * 4 + q) ^ r7) * 8;
#pragma unroll
    for (int mt = 0; mt < MT; ++mt) a[mt] = *(const bf16x8*)(sA + (mt * 16 + r) * 64 + co);
#pragma unroll
    for (int nt = 0; nt < NTL; ++nt) b[nt] = *(const bf16x8*)(sB + (nt * 16 + r) * 64 + co);
    if (neg) {
#pragma unroll
      for (int mt = 0; mt < MT; ++mt) a[mt] ^= (short)0x8000;
    }
#pragma unroll
    for (int mt = 0; mt < MT; ++mt)
#pragma unroll
      for (int nt = 0; nt < NTL; ++nt) {
        if (SWAP) acc[mt][nt] = __builtin_amdgcn_mfma_f32_16x16x32_bf16(b[nt], a[mt], acc[mt][nt], 0, 0, 0);
        else acc[mt][nt] = __builtin_amdgcn_mfma_f32_16x16x32_bf16(a[mt], b[nt], acc[mt][nt], 0, 0, 0);
      }
  }
}

DEVI void load_tile128(bf16_t* s, const bf16_t* g, long ld) {
  const int tid = opaque_tid(), lr = tid >> 3, lk = (tid & 7) * 8;
#pragma unroll
  for (int j = 0; j < 4; ++j) *(uint4*)(s + (lr + 32 * j) * LDT + lk) = *(const uint4*)(g + (long)(lr + 32 * j) * ld + lk);
}
DEVI void load_tile64(bf16_t* s, const bf16_t* g, long ld) {
  const int tid = opaque_tid(), lr = tid >> 3, lk = (tid & 7) * 8;
#pragma unroll
  for (int j = 0; j < 2; ++j) *(uint4*)(s + (lr + 32 * j) * LDT + lk) = *(const uint4*)(g + (long)(lr + 32 * j) * ld + lk);
}

template <bool SWAP, class Epi>
DEVI void gemm128(const bf16_t* A, long lda, int amax, const bf16_t* B, long ldb, int bmax, int K, int m0, int n0,
                  bf16_t* sA, bf16_t* sB, Epi&& epi) {
  const int tid = opaque_tid(), lane = tid & 63, w = tid >> 6, wr = w >> 1, wc = w & 1;
  const int lr = tid >> 3, lk = (tid & 7) * 8;
  const int lsw = (((tid & 7) ^ (lr & 7)) * 8);
  f32x4 acc[4][4];
#pragma unroll
  for (int mt = 0; mt < 4; ++mt)
#pragma unroll
    for (int nt = 0; nt < 4; ++nt) acc[mt][nt] = f32x4{0.f, 0.f, 0.f, 0.f};
  const bf16_t* ap[4];
  const bf16_t* bp[4];
#pragma unroll
  for (int j = 0; j < 4; ++j) {
    int ra = min(m0 + lr + 32 * j, amax);
    ap[j] = A + (long)ra * lda + lk;
    int rb = min(n0 + lr + 32 * j, bmax);
    bp[j] = B + (long)rb * ldb + lk;
  }
#ifndef GEMM_PASSES
#define GEMM_PASSES 1
#endif
  for (int pass_ = 0; pass_ < GEMM_PASSES; ++pass_) {
  u32x4 va0, va1, va2, va3, vb0, vb1, vb2, vb3;
  va0 = *(const u32x4*)(ap[0]); va1 = *(const u32x4*)(ap[1]); va2 = *(const u32x4*)(ap[2]); va3 = *(const u32x4*)(ap[3]);
  vb0 = *(const u32x4*)(bp[0]); vb1 = *(const u32x4*)(bp[1]); vb2 = *(const u32x4*)(bp[2]); vb3 = *(const u32x4*)(bp[3]);
  const int KT = K >> 6;
  *(u32x4*)(sA + (lr + 0) * 64 + lsw) = va0; *(u32x4*)(sA + (lr + 32) * 64 + lsw) = va1;
  *(u32x4*)(sA + (lr + 64) * 64 + lsw) = va2; *(u32x4*)(sA + (lr + 96) * 64 + lsw) = va3;
  *(u32x4*)(sB + (lr + 0) * 64 + lsw) = vb0; *(u32x4*)(sB + (lr + 32) * 64 + lsw) = vb1;
  *(u32x4*)(sB + (lr + 64) * 64 + lsw) = vb2; *(u32x4*)(sB + (lr + 96) * 64 + lsw) = vb3;
  if (KT > 1) {
    va0 = *(const u32x4*)(ap[0] + 64); va1 = *(const u32x4*)(ap[1] + 64); va2 = *(const u32x4*)(ap[2] + 64); va3 = *(const u32x4*)(ap[3] + 64);
    vb0 = *(const u32x4*)(bp[0] + 64); vb1 = *(const u32x4*)(bp[1] + 64); vb2 = *(const u32x4*)(bp[2] + 64); vb3 = *(const u32x4*)(bp[3] + 64);
  }
  __syncthreads();
  for (int kt = 0; kt < KT; ++kt) {
    const int st = (kt & 1) * 16384;
    const int sn = ((kt + 1) & 1) * 16384;
    if (kt + 1 < KT) {
      *(u32x4*)(sA + sn + (lr + 0) * 64 + lsw) = va0; *(u32x4*)(sA + sn + (lr + 32) * 64 + lsw) = va1;
      *(u32x4*)(sA + sn + (lr + 64) * 64 + lsw) = va2; *(u32x4*)(sA + sn + (lr + 96) * 64 + lsw) = va3;
      *(u32x4*)(sB + sn + (lr + 0) * 64 + lsw) = vb0; *(u32x4*)(sB + sn + (lr + 32) * 64 + lsw) = vb1;
      *(u32x4*)(sB + sn + (lr + 64) * 64 + lsw) = vb2; *(u32x4*)(sB + sn + (lr + 96) * 64 + lsw) = vb3;
    }
    if (kt + 2 < KT) {
      const int ko = (kt + 2) * 64;
      va0 = *(const u32x4*)(ap[0] + ko); va1 = *(const u32x4*)(ap[1] + ko); va2 = *(const u32x4*)(ap[2] + ko); va3 = *(const u32x4*)(ap[3] + ko);
      vb0 = *(const u32x4*)(bp[0] + ko); vb1 = *(const u32x4*)(bp[1] + ko); vb2 = *(const u32x4*)(bp[2] + ko); vb3 = *(const u32x4*)(bp[3] + ko);
    }
    __builtin_amdgcn_sched_barrier(0);
    __builtin_amdgcn_s_setprio(2);
    mma_swz<4, 4, SWAP>(sA + st + wr * 64 * 64, sB + st + wc * 64 * 64, acc, lane, (pass_ & 1) != 0);
    __builtin_amdgcn_s_setprio(0);
    __syncthreads();
  }
  }
  epi(acc, m0 + wr * 64, n0 + wc * 64, lane);
}


DEVI bool gemm_tile_xcd(int bid, int G, int k, int NTN, int& tm, int& tn) {
  const int x = bid & 7, per = G >> 3;
  const int u = (bid >> 3) + per * k;
  const int full_groups = NTN >> 3, rem = NTN & 7;
  const int n_full = full_groups * 2 * 64;
  if (u < n_full) {
    const int sb = u >> 6, wi = u & 63;
    const int tg = sb >> 1, th = sb & 1;
    tm = x * 16 + th * 8 + (wi >> 3);
    tn = tg * 8 + (wi & 7);
    return true;
  }
  const int v = u - n_full;
  if (v >= 16 * rem) return false;
  tm = x * 16 + v / rem;
  tn = full_groups * 8 + v % rem;
  return true;
}


template <class Epi>
DEVI void gemm256(const bf16_t* A, long lda, const bf16_t* B, long ldb, int K, int m0, int n0, bf16_t* sA, bf16_t* sB, Epi&& epi) {
  const int tid = opaque_tid(), lane = tid & 63, w = tid >> 6, wr = w >> 1, wc = w & 1;
  const int lr = tid >> 3, lk = (tid & 7) * 8;
  const int lsw = (((tid & 7) ^ (lr & 7)) * 8);
  const int r = lane & 15, q = lane >> 4, r7 = r & 7;
  f32x4 acc[2][4][4];
#pragma unroll
  for (int hh = 0; hh < 2; ++hh)
#pragma unroll
    for (int mt = 0; mt < 4; ++mt)
#pragma unroll
      for (int nt = 0; nt < 4; ++nt) acc[hh][mt][nt] = f32x4{0.f, 0.f, 0.f, 0.f};
  const bf16_t* abase = A + (long)(m0 + lr) * lda + lk;
  const bf16_t* bbase = B + (long)(n0 + lr) * ldb + lk;
  u32x4 va[8], vb[4];
#pragma unroll
  for (int j = 0; j < 8; ++j) va[j] = *(const u32x4*)(abase + (long)(32 * j) * lda);
#pragma unroll
  for (int j = 0; j < 4; ++j) vb[j] = *(const u32x4*)(bbase + (long)(32 * j) * ldb);
  const int KT = K >> 6;
  for (int kt = 0; kt < KT; ++kt) {
#pragma unroll
    for (int j = 0; j < 8; ++j) *(u32x4*)(sA + (lr + 32 * j) * 64 + lsw) = va[j];
#pragma unroll
    for (int j = 0; j < 4; ++j) *(u32x4*)(sB + (lr + 32 * j) * 64 + lsw) = vb[j];
    __syncthreads();
    if (kt + 1 < KT) {
      const int ko = (kt + 1) * 64;
#pragma unroll
      for (int j = 0; j < 8; ++j) va[j] = *(const u32x4*)(abase + (long)(32 * j) * lda + ko);
#pragma unroll
      for (int j = 0; j < 4; ++j) vb[j] = *(const u32x4*)(bbase + (long)(32 * j) * ldb + ko);
    }
    __builtin_amdgcn_sched_barrier(0);
    __builtin_amdgcn_s_setprio(2);
#pragma unroll
    for (int ks = 0; ks < 2; ++ks) {
      const int co = ((ks * 4 + q) ^ r7) * 8;
      bf16x8 b[4];
#pragma unroll
      for (int nt = 0; nt < 4; ++nt) b[nt] = *(const bf16x8*)(sB + (wc * 64 + nt * 16 + r) * 64 + co);
#pragma unroll
      for (int hh = 0; hh < 2; ++hh) {
        bf16x8 a[4];
#pragma unroll
        for (int mt = 0; mt < 4; ++mt) a[mt] = *(const bf16x8*)(sA + (wr * 128 + hh * 64 + mt * 16 + r) * 64 + co);
#pragma unroll
        for (int mt = 0; mt < 4; ++mt)
#pragma unroll
          for (int nt = 0; nt < 4; ++nt) acc[hh][mt][nt] = __builtin_amdgcn_mfma_f32_16x16x32_bf16(a[mt], b[nt], acc[hh][mt][nt], 0, 0, 0);
      }
    }
    __builtin_amdgcn_s_setprio(0);
    __syncthreads();
  }
  epi(acc[0], m0 + wr * 128, n0 + wc * 64, lane);
  epi(acc[1], m0 + wr * 128 + 64, n0 + wc * 64, lane);
}

DEVI bool gemm_tile_xcd256(int bid, int G, int k, int NTN, int& tm, int& tn) {
  const int x = bid & 7, per = G >> 3;
  const int u = (bid >> 3) + per * k;
  if (u >= 8 * NTN) return false;
  const int tg = u >> 6, wi = u & 63;
  tm = x * 8 + (wi >> 3);
  tn = tg * 8 + (wi & 7);
  return true;
}

DEVI void transpose_tile(const float* src, int N, int ldsrc, bf16_t* dst, int K, int ktile, int ntile, bool perm, float* sT) {
  const int tid = opaque_tid();
  const int k0 = ktile * 64, n0 = ntile * 64;
#pragma unroll
  for (int j = 0; j < 4; ++j) {
    int idx = tid + 256 * j;
    int kk = idx >> 4, n4 = (idx & 15) * 4;
    int n = n0 + n4;
    float4 v = make_float4(0.f, 0.f, 0.f, 0.f);
    if (n < N) { int oc = perm ? oldcol(n) : n; const f32x4 t_ = __builtin_nontemporal_load((const f32x4*)(src + (long)(k0 + kk) * ldsrc + oc)); v = make_float4(t_[0], t_[1], t_[2], t_[3]); }
    sT[kk * 65 + n4 + 0] = v.x; sT[kk * 65 + n4 + 1] = v.y; sT[kk * 65 + n4 + 2] = v.z; sT[kk * 65 + n4 + 3] = v.w;
  }
  __syncthreads();
#pragma unroll
  for (int j = 0; j < 2; ++j) {
    int idx = tid + 256 * j;
    int nn = idx >> 3, kc = (idx & 7) * 8;
    if (n0 + nn < N) {
      uint4 o;
      o.x = pack2(sT[(kc + 0) * 65 + nn], sT[(kc + 1) * 65 + nn]);
      o.y = pack2(sT[(kc + 2) * 65 + nn], sT[(kc + 3) * 65 + nn]);
      o.z = pack2(sT[(kc + 4) * 65 + nn], sT[(kc + 5) * 65 + nn]);
      o.w = pack2(sT[(kc + 6) * 65 + nn], sT[(kc + 7) * 65 + nn]);
      *(uint4*)(dst + (long)(n0 + nn) * K + k0 + kc) = o;
    }
  }
  __syncthreads();
}

DEVI void rmsnorm_row2(const float* X, const float* w, bf16_t* H, int row0, int row1, int lane) {
  const float4* xa = (const float4*)(X + (long)row0 * 1024);
  const float4* xb = (const float4*)(X + (long)row1 * 1024);
  float4 va[4], vb[4], ww[4];
#pragma unroll
  for (int j = 0; j < 4; ++j) {
    const f32x4 ta_ = __builtin_nontemporal_load((const f32x4*)(xa + lane + 64 * j));
    const f32x4 tb_ = __builtin_nontemporal_load((const f32x4*)(xb + lane + 64 * j));
    va[j] = make_float4(ta_[0], ta_[1], ta_[2], ta_[3]); vb[j] = make_float4(tb_[0], tb_[1], tb_[2], tb_[3]);
    ww[j] = ((const float4*)w)[lane + 64 * j];
  }
  float sa = 0.f, sb = 0.f;
#pragma unroll
  for (int j = 0; j < 4; ++j) {
    sa += va[j].x * va[j].x + va[j].y * va[j].y + va[j].z * va[j].z + va[j].w * va[j].w;
    sb += vb[j].x * vb[j].x + vb[j].y * vb[j].y + vb[j].z * vb[j].z + vb[j].w * vb[j].w;
  }
  sa = wave_sum(sa); sb = wave_sum(sb);
  const float ra = rsqrtf(sa * (1.f / 1024.f) + EPSF), rb = rsqrtf(sb * (1.f / 1024.f) + EPSF);
#pragma unroll
  for (int j = 0; j < 4; ++j) {
    uint2 o;
    o.x = pack2(va[j].x * ra * ww[j].x, va[j].y * ra * ww[j].y);
    o.y = pack2(va[j].z * ra * ww[j].z, va[j].w * ra * ww[j].w);
    *(uint2*)(H + (long)row0 * 1024 + (lane + 64 * j) * 4) = o;
    o.x = pack2(vb[j].x * rb * ww[j].x, vb[j].y * rb * ww[j].y);
    o.y = pack2(vb[j].z * rb * ww[j].z, vb[j].w * rb * ww[j].w);
    *(uint2*)(H + (long)row1 * 1024 + (lane + 64 * j) * 4) = o;
  }
}

DEVI void phase0(const Params& p, unsigned char* smem) {
  const int G = gridDim.x, bid = blockIdx.x, tid = threadIdx.x, lane = tid & 63, w = tid >> 6;
  unsigned char* ws = p.ws;
  float* sT = (float*)smem;
  for (int it = bid; it < 69 * 16; it += G) transpose_tile(p.ev_w_in, 4384, 4384, (bf16_t*)(ws + OFF_WIN0), 1024, it / 69, it % 69, true, sT);
  for (int it = bid; it < 16 * 16; it += G) transpose_tile(p.ev_w_out, 1024, 1024, (bf16_t*)(ws + OFF_WOUT0), 1024, it / 16, it % 16, false, sT);
  for (int it = bid; it < 64 * 16; it += G) transpose_tile(p.od_w_in, 4096, 4096, (bf16_t*)(ws + OFF_WIN1), 1024, it / 64, it % 64, false, sT);
  for (int it = bid; it < 16 * 16; it += G) transpose_tile(p.od_w_out, 1024, 1024, (bf16_t*)(ws + OFF_WOUT1), 1024, it / 16, it % 16, false, sT);
  for (int it = bid; it < 2 * 32; it += G) transpose_tile(p.ck_w1, 128, 128, (bf16_t*)(ws + OFF_WCK), 2048, it / 2, it % 2, false, sT);
  for (int it = bid; it < 2 * 32; it += G) transpose_tile(p.cv_w1, 128, 128, (bf16_t*)(ws + OFF_WCV), 2048, it / 2, it % 2, false, sT);
  for (int row = (bid * 4 + w) * 2; row < 16384; row += G * 8) rmsnorm_row2(p.x, p.norm_w, (bf16_t*)(ws + L0_H), row, row + 1, lane);
  for (int idx = bid * 256 + tid; idx < 8192 * 8; idx += G * 256) {
    int t = idx >> 3, i = idx & 7;
    float invf = powf(500000.0f, -(float)i / 8.0f);
    float ang = (float)t * invf;
    double a = (double)ang;
    float2 cs;
    cs.x = (float)cos(a);
    cs.y = (float)sin(a);
    ((float2*)(ws + OFF_ROPE))[idx] = cs;
  }
  for (int o = bid * 4 + w; o < 256; o += G * 4) {
    int kv = o >> 7, j = o & 127;
    const float* pos = kv ? p.cv_pos : p.ck_pos;
    const float* w1 = kv ? p.cv_w1 : p.ck_w1;
    float sacc_ = 0.f;
#pragma unroll 8
    for (int i = lane; i < 2048; i += 64) sacc_ += pos[i] * w1[i * 128 + j];
    sacc_ = wave_sum(sacc_);
    if (lane == 0) ((float*)(ws + OFF_PB))[o] = sacc_;
  }
  if (bid == G - 2 || G < 2) {
    for (int c = tid; c < 1024; c += 256) {
      float l0 = p.lb_logits[c], l1 = p.lb_logits[1024 + c];
      ((float*)(ws + OFF_LB))[c] = 1.f / (1.f + expf(l1 - l0));
    }
  }
}

template <int MODE>
DEVI void store_rm(bf16_t* dst, int ld, int colbase, f32x4 (&acc)[4][4], const float* bias, int mb, int lane) {
  const int r = lane & 15, q = lane >> 4;
#pragma unroll
  for (int mt = 0; mt < 4; ++mt)
#pragma unroll
    for (int i = 0; i < 4; ++i) {
      long row = mb + mt * 16 + q * 4 + i;
#pragma unroll
      for (int nt = 0; nt < 4; ++nt) {
        float v = acc[mt][nt][i] + bias[nt];
        if (MODE == 1) v = sigm(v);
        if (MODE == 2) v = siluf(v);
        dst[row * ld + colbase + nt * 16 + r] = f2bf(v);
      }
    }
}
template <int MODE>
DEVI void store_T(bf16_t* dst, int bgrp, int F, int featoff, f32x4 (&acc)[4][4], const float* bias, int tl0, int lane) {
  const int r = lane & 15, q = lane >> 4;
#pragma unroll
  for (int mt = 0; mt < 4; ++mt)
#pragma unroll
    for (int nt = 0; nt < 4; ++nt) {
      int t = tl0 + mt * 16 + q * 4;
      float b = bias[nt];
      uint2 o;
      o.x = pack2(acc[mt][nt][0] + b, acc[mt][nt][1] + b);
      o.y = pack2(acc[mt][nt][2] + b, acc[mt][nt][3] + b);
      *(uint2*)(dst + (((long)bgrp * 128 + (t >> 6)) * F + featoff + nt * 16 + r) * 64 + (t & 63)) = o;
    }
}
DEVI void norm_rope_store(bf16_t* dst, long rowbase, int ld, int colbase, f32x4 (&acc)[4][4], const float* bias, const float* nw,
                          float scale, const float2* rope, int mb, int lane) {
  const int r = lane & 15, q = lane >> 4;
  float wv[4];
#pragma unroll
  for (int nt = 0; nt < 4; ++nt) wv[nt] = nw[nt * 16 + r];
  float2 csv[4][4];
#pragma unroll
  for (int mt = 0; mt < 4; ++mt)
#pragma unroll
    for (int i = 0; i < 4; ++i) csv[mt][i] = rope[((mb + mt * 16 + q * 4 + i) & 8191) * 8 + (r & 7)];
#pragma unroll
  for (int mt = 0; mt < 4; ++mt)
#pragma unroll
    for (int i = 0; i < 4; ++i) {
      int row = mb + mt * 16 + q * 4 + i;
      int t = row & 8191;
      float v[4];
      float ss = 0.f;
#pragma unroll
      for (int nt = 0; nt < 4; ++nt) { v[nt] = acc[mt][nt][i] + bias[nt]; ss += v[nt] * v[nt]; }
      ss = grp16_sum(ss);
      float rinv = rsqrtf(ss * (1.f / 64.f) + EPSF);
#pragma unroll
      for (int nt = 0; nt < 4; ++nt) v[nt] = v[nt] * rinv * wv[nt];
      float partner = __shfl_xor(v[0], 8);
      float2 cs = csv[mt][i];
      float x1 = (r < 8) ? v[0] : partner, x2 = (r < 8) ? partner : v[0];
      v[0] = (r < 8) ? (x1 * cs.x - x2 * cs.y) : (x1 * cs.y + x2 * cs.x);
#pragma unroll
      for (int nt = 0; nt < 4; ++nt) dst[(rowbase + t) * ld + colbase + nt * 16 + r] = f2bf(v[nt] * scale);
    }
}

DEVI void epi_proj0(const Params& p, f32x4 (&acc)[4][4], int mb, int nb, int lane) {
  if (nb >= 4384) return;
  unsigned char* ws = p.ws;
  const int r = lane & 15, q = lane >> 4;
  float bias[4];
#pragma unroll
  for (int nt = 0; nt < 4; ++nt) { int n = nb + nt * 16 + r; bias[nt] = (n < 4384) ? p.ev_b_in[oldcol(n)] : 0.f; }
  const int b = mb >> 13;
  const int tl0 = mb & 8191;
  const float2* rope = (const float2*)(ws + OFF_ROPE);
  if (nb < 1024) {
    store_rm<0>((bf16_t*)(ws + L0_QKRAW), 1024, nb, acc, bias, mb, lane);
  } else if (nb < 1536) {
    store_T<0>((bf16_t*)(ws + L0_MVT), b * 4 + ((nb - 1024) >> 7), 128, (nb - 1024) & 127, acc, bias, tl0, lane);
  } else if (nb < 2048) {
    store_rm<1>((bf16_t*)(ws + L0_MO), 512, nb - 1536, acc, bias, mb, lane);
  } else if (nb < 2560) {
    store_rm<2>((bf16_t*)(ws + L0_MZ), 512, nb - 2048, acc, bias, mb, lane);
  } else if (nb < 3072) {
    int head = (nb - 2560) >> 6, g = head >> 2, rr = head & 3;
    norm_rope_store((bf16_t*)(ws + L0_QN), (long)(b * 2 + g) * 8192, 256, rr * 64, acc, bias, p.q_norm, 0.125f * 1.4426950408889634f, rope, mb, lane);
  } else if (nb < 3328) {
    int g = ((nb - 3072) >> 6) & 1;
    bf16_t* dst = (bf16_t*)(ws + (nb < 3200 ? L0_KCRAW : L0_VCRAW));
    const long rowbase = (long)(b * 2 + g) * 8192;
#pragma unroll
    for (int mt = 0; mt < 4; ++mt)
#pragma unroll
      for (int i = 0; i < 4; ++i) {
        int t = (mb + mt * 16 + q * 4 + i) & 8191;
#pragma unroll
        for (int nt = 0; nt < 4; ++nt) dst[(rowbase + t) * 64 + nt * 16 + r] = f2bf(acc[mt][nt][i] + bias[nt]);
      }
  } else if (nb < 3456) {
    int g = (nb - 3328) >> 6;
    norm_rope_store((bf16_t*)(ws + L0_KS), (long)(b * 2 + g) * 8192, 64, 0, acc, bias, p.k_norm + 64, 1.f, rope, mb, lane);
  } else if (nb < 3584) {
    store_T<0>((bf16_t*)(ws + L0_VST), b * 2 + ((nb - 3456) >> 6), 64, 0, acc, bias, tl0, lane);
  } else if (nb < 3712) {
    int g = (nb - 3584) >> 6;
    norm_rope_store((bf16_t*)(ws + L0_KW), (long)(b * 2 + g) * 8192, 64, 0, acc, bias, p.k_norm + 128, 1.f, rope, mb, lane);
  } else if (nb < 3840) {
    store_T<0>((bf16_t*)(ws + L0_VWT), b * 2 + ((nb - 3712) >> 6), 64, 0, acc, bias, tl0, lane);
  } else if (nb < 4352) {
    store_rm<2>((bf16_t*)(ws + L0_NZ), 512, nb - 3840, acc, bias, mb, lane);
  } else {
    float* IG = (float*)(ws + L0_IG);
    float* LF = (float*)(ws + L0_LOGF);
    float* GT = (float*)(ws + L0_GATES);
#pragma unroll
    for (int mt = 0; mt < 4; ++mt)
#pragma unroll
      for (int i = 0; i < 4; ++i) {
        long row = mb + mt * 16 + q * 4 + i;
#pragma unroll
        for (int nt = 0; nt < 2; ++nt) {
          int c = nt * 16 + r;
          float v = acc[mt][nt][i] + bias[nt];
          if (c < 4) IG[row * 4 + c] = v;
          else if (c < 8) { float xx = v + p.f_bias[c - 4]; LF[row * 4 + c - 4] = fminf(xx, 0.f) - log1pf(__expf(-fabsf(xx))); }
          else GT[row * 24 + c - 8] = sigm(v);
        }
      }
  }
}

DEVI void epi_cmp_hidden(const Params& p, f32x4 (&acc)[4][4], int mb, int nb, int lane, int kv, int bg, int ksp) {
  const int r = lane & 15, q = lane >> 4;
  float* hid = (float*)(p.ws + L0_HIDP) + ((long)((ksp * 2 + kv) * 4 + bg) * 512) * 128;
#pragma unroll
  for (int mt = 0; mt < 4; ++mt)
#pragma unroll
    for (int i = 0; i < 4; ++i) {
      int row = mb + mt * 16 + q * 4 + i;
#pragma unroll
      for (int nt = 0; nt < 4; ++nt) hid[(long)row * 128 + nb + nt * 16 + r] = acc[mt][nt][i];
    }
}

DEVI void epi_out_resid(const float* resid, float* out, f32x4 (&acc)[4][4], int mb, int nb, int lane) {
  const int r = lane & 15, q = lane >> 4;
#pragma unroll
  for (int mt = 0; mt < 4; ++mt) {
    float rv[4][4];
#pragma unroll
    for (int i = 0; i < 4; ++i)
#pragma unroll
      for (int nt = 0; nt < 4; ++nt) rv[i][nt] = resid[(long)(mb + mt * 16 + q * 4 + i) * 1024 + nb + nt * 16 + r];
#pragma unroll
    for (int i = 0; i < 4; ++i)
#pragma unroll
      for (int nt = 0; nt < 4; ++nt) out[(long)(mb + mt * 16 + q * 4 + i) * 1024 + nb + nt * 16 + r] = rv[i][nt] + acc[mt][nt][i];
  }
}

DEVI void epi_proj1(const Params& p, f32x4 (&acc)[4][4], int mb, int nb, int lane) {
  unsigned char* ws = p.ws;
  const int r = lane & 15;
  float bias[4];
#pragma unroll
  for (int nt = 0; nt < 4; ++nt) bias[nt] = p.od_b_in[nb + nt * 16 + r];
  const int b = mb >> 13, tl0 = mb & 8191;
  if (nb < 1024) store_rm<0>((bf16_t*)(ws + L1_FP), 1024, nb, acc, bias, mb, lane);
  else if (nb < 2048) store_T<0>((bf16_t*)(ws + L1_VT), b * 8 + ((nb - 1024) >> 7), 128, (nb - 1024) & 127, acc, bias, tl0, lane);
  else if (nb < 3072) store_rm<2>((bf16_t*)(ws + L1_Q), 1024, nb - 2048, acc, bias, mb, lane);
  else store_rm<2>((bf16_t*)(ws + L1_Z), 1024, nb - 3072, acc, bias, mb, lane);
}

DEVI void conv_tile(const Params& p, int item, unsigned char* smem) {
  const int tid = opaque_tid();
  const int ctile = item & 7, ttile = item >> 3;
  const int t0g = ttile * 64;
  const int b = t0g >> 13, tl0 = t0g & 8191;
  unsigned char* ws = p.ws;
  float* sRaw = (float*)smem;
  bf16_t* sOutT = (bf16_t*)(smem + 67 * 128 * 4);
  const bf16_t* raw = (const bf16_t*)(ws + L0_QKRAW);
  for (int idx = tid; idx < 67 * 16; idx += 256) {
    int rr = idx >> 4, ch = (idx & 15) * 8;
    int tl = tl0 + rr - 3;
    uint4 v = make_uint4(0, 0, 0, 0);
    if (tl >= 0) v = *(const uint4*)(raw + (long)(b * 8192 + tl) * 1024 + ctile * 128 + ch);
    float* d = sRaw + rr * 128 + ch;
    d[0] = lo2f(v.x); d[1] = hi2f(v.x); d[2] = lo2f(v.y); d[3] = hi2f(v.y);
    d[4] = lo2f(v.z); d[5] = hi2f(v.z); d[6] = lo2f(v.w); d[7] = hi2f(v.w);
  }
  __syncthreads();
  const int c = tid & 127, th = tid >> 7;
  const int cg_ = ctile * 128 + c;
  const float w0 = p.conv_w[cg_], w1 = p.conv_w[1024 + cg_], w2 = p.conv_w[2048 + cg_], w3 = p.conv_w[3072 + cg_];
  const float cb = p.conv_b[cg_];
  const bool isk = ctile >= 4;
  bf16_t* dst = (bf16_t*)(ws + (isk ? L0_KC : L0_QC));
  const int cc = isk ? cg_ - 512 : cg_;
  const float sc = isk ? 0.08838834764831845f : 1.f;
  for (int t = th * 32; t < th * 32 + 32; ++t) {
    float a = cb + w0 * sRaw[t * 128 + c] + w1 * sRaw[(t + 1) * 128 + c] + w2 * sRaw[(t + 2) * 128 + c] + w3 * sRaw[(t + 3) * 128 + c];
    bf16_t o = f2bf(siluf(a) * sc);
    dst[(long)(t0g + t) * 512 + cc] = o;
    sOutT[c * LDT + t] = o;
  }
  __syncthreads();
  if (isk) {
    bf16_t* kct = (bf16_t*)(ws + L0_KCT);
#pragma unroll
    for (int j = 0; j < 4; ++j) {
      int idx = tid + 256 * j;
      int cr = idx >> 3, tc = (idx & 7) * 8;
      *(uint4*)(kct + ((((long)(b * 4 + (ctile - 4)) * 128 + (tl0 >> 6)) * 128 + cr) * 64) + tc) = *(const uint4*)(sOutT + cr * LDT + tc);
    }
  }
  __syncthreads();
}

DEVI void cmp_finalize(const Params& p, int task, int lane) {
  const int n = task & 511, bg = (task >> 9) & 3, kv = task >> 11;
  unsigned char* ws = p.ws;
  bf16_t* KCMP = (bf16_t*)(ws + L0_KCMP);
  bf16_t* VCMPT = (bf16_t*)(ws + L0_VCMPT);
  if (n == 511) {
    if (kv == 0) KCMP[((long)bg * 512 + 511) * 64 + lane] = 0;
    else VCMPT[((long)bg * 64 + lane) * 512 + 511] = 0;
    return;
  }
  const float* hid = (const float*)(ws + L0_HIDP) + ((long)(kv * 4 + bg) * 512 + n) * 128;
  const float* pbv = (const float*)(ws + OFF_PB) + kv * 128;
  const float* w2 = kv ? p.cv_w2 : p.ck_w2;
  float g0, g1;
  {
    float x0 = ((hid[lane] + hid[lane + 524288]) + (hid[lane + 2 * 524288] + hid[lane + 3 * 524288])) + pbv[lane];
    float x1 = ((hid[lane + 64] + hid[lane + 64 + 524288]) + (hid[lane + 64 + 2 * 524288] + hid[lane + 64 + 3 * 524288])) + pbv[lane + 64];
    g0 = 0.5f * x0 * (1.f + tanhf(0.7978845608028654f * (x0 + 0.044715f * x0 * x0 * x0)));
    g1 = 0.5f * x1 * (1.f + tanhf(0.7978845608028654f * (x1 + 0.044715f * x1 * x1 * x1)));
  }
  float a = 0.f;
  for (int j0 = 0; j0 < 64; j0 += 16) {
    float wv[16], wu[16];
#pragma unroll
    for (int k = 0; k < 16; ++k) { wv[k] = w2[(j0 + k) * 64 + lane]; wu[k] = w2[(64 + j0 + k) * 64 + lane]; }
#pragma unroll
    for (int k = 0; k < 16; ++k) a += __shfl(g0, j0 + k) * wv[k] + __shfl(g1, j0 + k) * wu[k];
  }
  if (kv == 0) {
    float ss = wave_sum(a * a);
    float rinv = rsqrtf(ss * (1.f / 64.f) + EPSF);
    float v = a * rinv * p.k_norm[lane];
    float partner = __shfl_xor(v, 8);
    int pos = 16 * n + 31;
    float2 cs = ((const float2*)(ws + OFF_ROPE))[pos * 8 + (lane & 7)];
    float o = v;
    if (lane < 8) o = v * cs.x - partner * cs.y;
    else if (lane < 16) o = partner * cs.y + v * cs.x;
    KCMP[((long)bg * 512 + n) * 64 + lane] = f2bf(o);
  } else {
    VCMPT[((long)bg * 64 + lane) * 512 + n] = f2bf(a);
  }
}

DEVI void mlstm_local(const Params& p, int unit, unsigned char* smem) {
  const int tid = opaque_tid(), lane = tid & 63, w = tid >> 6, wr = w >> 1, wc = w & 1;
  const int bh = unit >> 6, c = unit & 63, b = bh >> 2, h = bh & 3, t0 = c * 128;
  const long R0 = (long)b * 8192 + t0;
  unsigned char* ws = p.ws;
  bf16_t* sA = (bf16_t*)smem;
  bf16_t* sB = (bf16_t*)(smem + 18432);
  float* sIg = (float*)(smem + 36864);
  float* sLf = sIg + 128;
  float* sW = sLf + 128;
  const float* IG = (const float*)(ws + L0_IG);
  const float* LF = (const float*)(ws + L0_LOGF);
  if (tid < 128) { sIg[tid] = IG[(R0 + tid) * 4 + h]; sLf[tid] = LF[(R0 + tid) * 4 + h]; }
  __syncthreads();
  if (tid < 64) {
    float c0 = sLf[2 * tid], c1 = sLf[2 * tid + 1];
    wave_scan_sum128(c0, c1, tid);
    const float bL = __shfl(c1, 63);
    float d0 = bL - c0 + sIg[2 * tid], d1 = bL - c1 + sIg[2 * tid + 1];
    const float ml = wave_max(fmaxf(d0, d1));
    sW[2 * tid] = __expf(d0 - ml); sW[2 * tid + 1] = __expf(d1 - ml);
    if (tid == 0) { ((float*)(ws + L0_BL))[unit] = bL; ((float*)(ws + L0_MLOC))[unit] = ml; }
  }
  __syncthreads();
  f32x4 acc[4][4];
#pragma unroll
  for (int mt = 0; mt < 4; ++mt)
#pragma unroll
    for (int nt = 0; nt < 4; ++nt) acc[mt][nt] = f32x4{0.f, 0.f, 0.f, 0.f};
  float dn = 0.f;
  const bf16_t* vt = (const bf16_t*)(ws + L0_MVT) + (((long)(b * 4 + h) * 128 + (t0 >> 6)) * 128) * 64;
  const bf16_t* kt_ = (const bf16_t*)(ws + L0_KCT) + (((long)(b * 4 + h) * 128 + (t0 >> 6)) * 128) * 64;
  const int lr = tid >> 3, lk = (tid & 7) * 8;
  for (int kt = 0; kt < 2; ++kt) {
    load_tile128(sA, vt + kt * 8192, 64);
#pragma unroll
    for (int j = 0; j < 4; ++j) {
      uint4 v = *(const uint4*)(kt_ + (long)kt * 8192 + (lr + 32 * j) * 64 + lk);
      const float* ww = sW + kt * 64 + lk;
      uint4 o;
      o.x = pack2(lo2f(v.x) * ww[0], hi2f(v.x) * ww[1]);
      o.y = pack2(lo2f(v.y) * ww[2], hi2f(v.y) * ww[3]);
      o.z = pack2(lo2f(v.z) * ww[4], hi2f(v.z) * ww[5]);
      o.w = pack2(lo2f(v.w) * ww[6], hi2f(v.w) * ww[7]);
      *(uint4*)(sB + (lr + 32 * j) * LDT + lk) = o;
    }
    __syncthreads();
    if (tid < 128) {
#pragma unroll 8
      for (int s = 0; s < 64; ++s) dn += bf2f(sB[tid * LDT + s]);
    }
    mma_lds<4, 4, 2>(sA + wr * 64 * LDT, sB + wc * 64 * LDT, acc, lane);
    __syncthreads();
  }
  float* dct = (float*)(ws + L0_H) + (long)unit * 16384;
  const int r = lane & 15, q = lane >> 4;
#pragma unroll
  for (int mt = 0; mt < 4; ++mt)
#pragma unroll
    for (int i = 0; i < 4; ++i) {
      int e = wr * 64 + mt * 16 + q * 4 + i;
#pragma unroll
      for (int nt = 0; nt < 4; ++nt) dct[e * 128 + wc * 64 + nt * 16 + r] = acc[mt][nt][i];
    }
  if (tid < 128) ((float*)(ws + L0_DN))[unit * 128 + tid] = dn;
}

template <bool DUMMY>
DEVI void mlstm_scan(const Params& p, unsigned char* smem) {
  unsigned char* ws = p.ws;
  const float* BL = (const float*)(ws + L0_BL);
  const float* ML = (const float*)(ws + L0_MLOC);
  float* MIN_ = (float*)(ws + L0_MIN);
  float* sDec = (float*)smem;
  float* sWn = sDec + 128;
  const int tid = opaque_tid();
  const int total = 8 * 16384 + 8 * 128;
  for (int base = blockIdx.x * 256; base < total; base += gridDim.x * 256) {
    const int bh0 = (base < 131072) ? (base >> 14) : ((base - 131072) >> 7);
    __syncthreads();
    if (tid < 2) {
      const int bh = bh0 + tid;
      if (bh < 8) {
        float m = 0.f;
        for (int c = 0; c < 64; ++c) {
          const int unit = bh * 64 + c;
          const float bL = BL[unit], ml = ML[unit];
          if (!DUMMY && base < 131072 && (base & 16383) == 0 && tid == 0) MIN_[unit] = m;
          const float mn = fmaxf(bL + m, ml);
          sDec[tid * 64 + c] = __expf(bL + m - mn);
          sWn[tid * 64 + c] = __expf(ml - mn);
          m = mn;
        }
      }
    }
    __syncthreads();
    const int idx = base + tid;
    if (idx < total) {
      float* ptr; long stride; int sel;
      if (idx < 131072) { const int bh = idx >> 14; ptr = (float*)(ws + L0_H) + (long)bh * 64 * 16384 + (idx & 16383); stride = 16384; sel = bh - bh0; }
      else { const int j = idx - 131072; const int bh = j >> 7; ptr = (float*)(ws + L0_DN) + (long)bh * 64 * 128 + (j & 127); stride = 128; sel = bh - bh0; }
      const float* dec = sDec + sel * 64;
      const float* wn = sWn + sel * 64;
      float C = 0.f;
      for (int c0 = 0; c0 < 64; c0 += 8) {
        float dv[8];
#pragma unroll
        for (int k = 0; k < 8; ++k) dv[k] = __builtin_nontemporal_load(ptr + (long)(c0 + k) * stride);
#pragma unroll
        for (int k = 0; k < 8; ++k) {
          if (!DUMMY) __builtin_nontemporal_store(C, ptr + (long)(c0 + k) * stride);
          C = dec[c0 + k] * C + wn[c0 + k] * dv[k];
        }
      }
      if (DUMMY && C == 123.456f) MIN_[0] = C;
    }
  }
}

DEVI void mlstm_out(const Params& p, int item, unsigned char* smem) {
  const int tid = opaque_tid(), lane = tid & 63, w = tid >> 6, wr = w >> 1, wc = w & 1;
  const int r = lane & 15, q = lane >> 4;
  const int unit = item >> 1, u = item & 1;
  const int bh = unit >> 6, c = unit & 63, b = bh >> 2, h = bh & 3, t0 = c * 128;
  const long R0 = (long)b * 8192 + t0;
  const int J0 = u * 64;
  unsigned char* ws = p.ws;
  bf16_t* sA = (bf16_t*)smem;
  bf16_t* sB = (bf16_t*)(smem + 9216);
  bf16_t* sS0 = (bf16_t*)(smem + 27648);
  bf16_t* sS1 = (bf16_t*)(smem + 36864);
  float* fl = (float*)(smem + 46080);
  float* sIg = fl; float* sLf = fl + 128; float* sRj = fl + 256; float* sCs = fl + 384; float* sWi = fl + 512;
  float* sEm = fl + 640; float* sQn = fl + 768; float* sNin = fl + 896; float* sDen = fl + 1024; float* sSs = fl + 1280;
  const float* IG = (const float*)(ws + L0_IG);
  const float* LF = (const float*)(ws + L0_LOGF);
  const bf16_t* QC = (const bf16_t*)(ws + L0_QC) + (R0 + J0) * 512 + h * 128;
  const bf16_t* KC = (const bf16_t*)(ws + L0_KC) + R0 * 512 + h * 128;
  if (tid < 128) { sIg[tid] = IG[(R0 + tid) * 4 + h]; sLf[tid] = LF[(R0 + tid) * 4 + h]; sNin[tid] = ((const float*)(ws + L0_DN))[unit * 128 + tid]; }
  const float m_in = ((const float*)(ws + L0_MIN))[unit];
  __syncthreads();
  if (tid < 64) {
    float c0 = sLf[2 * tid], c1 = sLf[2 * tid + 1];
    wave_scan_sum128(c0, c1, tid);
    const float a0 = sIg[2 * tid] - c0, a1 = sIg[2 * tid + 1] - c1;
    float x0 = a0, x1 = a1;
    wave_scan_max128(x0, x1, tid);
    const float mx0 = fmaxf(x0, m_in), mx1 = fmaxf(x1, m_in);
    sCs[2 * tid] = a0; sCs[2 * tid + 1] = a1;
    sRj[2 * tid] = -mx0; sRj[2 * tid + 1] = -mx1;
    sWi[2 * tid] = __expf(m_in - mx0); sWi[2 * tid + 1] = __expf(m_in - mx1);
    sEm[2 * tid] = __expf(-(c0 + mx0)); sEm[2 * tid + 1] = __expf(-(c1 + mx1));
  }
  if (tid >= 128 && tid < 192) {
    int jl = tid - 128;
    const bf16_t* qr = QC + (long)jl * 512;
    float s = 0.f;
#pragma unroll 2
    for (int ch = 0; ch < 16; ++ch) {
      uint4 v = *(const uint4*)(qr + ch * 8);
      const float* nn = sNin + ch * 8;
      s += lo2f(v.x) * nn[0] + hi2f(v.x) * nn[1] + lo2f(v.y) * nn[2] + hi2f(v.y) * nn[3] + lo2f(v.z) * nn[4] + hi2f(v.z) * nn[5] + lo2f(v.w) * nn[6] + hi2f(v.w) * nn[7];
    }
    sQn[jl] = s;
  }
  __syncthreads();
  f32x4 acc[2][4];
#pragma unroll
  for (int mt = 0; mt < 2; ++mt)
#pragma unroll
    for (int nt = 0; nt < 4; ++nt) acc[mt][nt] = f32x4{0.f, 0.f, 0.f, 0.f};
  const bool skipS = (wc > u);
  const int lr = tid >> 3, lk = (tid & 7) * 8;
  {
    u32x4 qa0, qa1, kb0, kb1, kb2, kb3;
    qa0 = *(const u32x4*)(QC + (long)lr * 512 + lk); qa1 = *(const u32x4*)(QC + (long)(lr + 32) * 512 + lk);
    kb0 = *(const u32x4*)(KC + (long)lr * 512 + lk); kb1 = *(const u32x4*)(KC + (long)(lr + 32) * 512 + lk);
    kb2 = *(const u32x4*)(KC + (long)(lr + 64) * 512 + lk); kb3 = *(const u32x4*)(KC + (long)(lr + 96) * 512 + lk);
#pragma unroll 1
    for (int kt = 0; kt < 2; ++kt) {
      *(u32x4*)(sA + lr * LDT + lk) = qa0; *(u32x4*)(sA + (lr + 32) * LDT + lk) = qa1;
      *(u32x4*)(sB + lr * LDT + lk) = kb0; *(u32x4*)(sB + (lr + 32) * LDT + lk) = kb1;
      *(u32x4*)(sB + (lr + 64) * LDT + lk) = kb2; *(u32x4*)(sB + (lr + 96) * LDT + lk) = kb3;
      __syncthreads();
      if (kt == 0) {
        qa0 = *(const u32x4*)(QC + (long)lr * 512 + 64 + lk); qa1 = *(const u32x4*)(QC + (long)(lr + 32) * 512 + 64 + lk);
        kb0 = *(const u32x4*)(KC + (long)lr * 512 + 64 + lk); kb1 = *(const u32x4*)(KC + (long)(lr + 32) * 512 + 64 + lk);
        kb2 = *(const u32x4*)(KC + (long)(lr + 64) * 512 + 64 + lk); kb3 = *(const u32x4*)(KC + (long)(lr + 96) * 512 + 64 + lk);
      }
      if (!skipS) mma_lds<2, 4, 2>(sA + wr * 32 * LDT, sB + wc * 64 * LDT, acc, lane);
      __syncthreads();
    }
  }
  {
    bf16_t* sS = wc ? sS1 : sS0;
#pragma unroll
    for (int mt = 0; mt < 2; ++mt)
#pragma unroll
      for (int i = 0; i < 4; ++i) {
        int jl = wr * 32 + mt * 16 + q * 4 + i;
        int j = J0 + jl;
        float rj = sRj[j], rs = 0.f;
#pragma unroll
        for (int nt = 0; nt < 4; ++nt) {
          int sl = nt * 16 + r, s = wc * 64 + sl;
          float val = (s <= j) ? acc[mt][nt][i] * __expf(rj + sCs[s]) : 0.f;
          rs += val;
          sS[jl * LDT + sl] = f2bf(val);
        }
        rs = grp16_sum(rs);
        if (r == 0) sDen[wc * 64 + jl] = rs;
      }
  }
#pragma unroll
  for (int mt = 0; mt < 2; ++mt)
#pragma unroll
    for (int nt = 0; nt < 4; ++nt) acc[mt][nt] = f32x4{0.f, 0.f, 0.f, 0.f};
  const bf16_t* vt = (const bf16_t*)(ws + L0_MVT) + (((long)(b * 4 + h) * 128 + (t0 >> 6)) * 128) * 64;
  const float* ct = (const float*)(ws + L0_H) + (long)unit * 16384;
  {
    u32x4 vb0, vb1, vb2, vb3;
    u32x4 qa0, qa1;
    float4 cv[8];
    const int nsteps = u ? 4 : 3;
    auto kind_of = [&](int sidx) { return u ? sidx : (sidx == 0 ? 0 : sidx + 1); };
    auto fetch = [&](int kind) {
      if (kind < 2) {
        const bf16_t* vp = vt + (long)kind * 8192 + lr * 64 + lk;
        vb0 = *(const u32x4*)vp; vb1 = *(const u32x4*)(vp + 32 * 64); vb2 = *(const u32x4*)(vp + 64 * 64); vb3 = *(const u32x4*)(vp + 96 * 64);
      } else {
        const int k2 = kind - 2;
        qa0 = *(const u32x4*)(QC + (long)lr * 512 + k2 * 64 + lk); qa1 = *(const u32x4*)(QC + (long)(lr + 32) * 512 + k2 * 64 + lk);
#pragma unroll
        for (int j = 0; j < 8; ++j) cv[j] = *(const float4*)(ct + (long)((tid >> 4) + 16 * j) * 128 + k2 * 64 + (tid & 15) * 4);
      }
    };
    fetch(0);
#pragma unroll 1
    for (int sidx = 0; sidx < nsteps; ++sidx) {
      const int kind = kind_of(sidx);
      const bf16_t* aS;
      if (kind < 2) {
        *(u32x4*)(sB + lr * LDT + lk) = vb0; *(u32x4*)(sB + (lr + 32) * LDT + lk) = vb1;
        *(u32x4*)(sB + (lr + 64) * LDT + lk) = vb2; *(u32x4*)(sB + (lr + 96) * LDT + lk) = vb3;
        aS = kind ? sS1 : sS0;
      } else {
        const float w0 = sWi[J0 + lr], w1 = sWi[J0 + lr + 32];
        u32x4 o0, o1;
        o0[0] = pack2(lo2f(qa0[0]) * w0, hi2f(qa0[0]) * w0); o0[1] = pack2(lo2f(qa0[1]) * w0, hi2f(qa0[1]) * w0);
        o0[2] = pack2(lo2f(qa0[2]) * w0, hi2f(qa0[2]) * w0); o0[3] = pack2(lo2f(qa0[3]) * w0, hi2f(qa0[3]) * w0);
        o1[0] = pack2(lo2f(qa1[0]) * w1, hi2f(qa1[0]) * w1); o1[1] = pack2(lo2f(qa1[1]) * w1, hi2f(qa1[1]) * w1);
        o1[2] = pack2(lo2f(qa1[2]) * w1, hi2f(qa1[2]) * w1); o1[3] = pack2(lo2f(qa1[3]) * w1, hi2f(qa1[3]) * w1);
        *(u32x4*)(sA + lr * LDT + lk) = o0; *(u32x4*)(sA + (lr + 32) * LDT + lk) = o1;
#pragma unroll
        for (int j = 0; j < 8; ++j) {
          uint2 o;
          o.x = pack2(cv[j].x, cv[j].y);
          o.y = pack2(cv[j].z, cv[j].w);
          *(uint2*)(sB + ((tid >> 4) + 16 * j) * LDT + (tid & 15) * 4) = o;
        }
        aS = sA;
      }
      __syncthreads();
      if (sidx + 1 < nsteps) fetch(kind_of(sidx + 1));
      mma_lds<2, 4, 2>(aS + wr * 32 * LDT, sB + wc * 64 * LDT, acc, lane);
      __syncthreads();
    }
  }
#pragma unroll
  for (int mt = 0; mt < 2; ++mt)
#pragma unroll
    for (int i = 0; i < 4; ++i) {
      int jl = wr * 32 + mt * 16 + q * 4 + i;
      int j = J0 + jl;
      float den = sDen[jl] + sDen[64 + jl] + sWi[j] * sQn[jl];
      float dinv = 1.f / fmaxf(fabsf(den), sEm[j]);
      float ss = 0.f;
#pragma unroll
      for (int nt = 0; nt < 4; ++nt) { float v = acc[mt][nt][i] * dinv; acc[mt][nt][i] = v; ss += v * v; }
      ss = grp16_sum(ss);
      if (r == 0) sSs[wc * 64 + jl] = ss;
    }
  __syncthreads();
  const bf16_t* MO = (const bf16_t*)(ws + L0_MO);
  const bf16_t* MZ = (const bf16_t*)(ws + L0_MZ);
  bf16_t* Y = (bf16_t*)(ws + L0_QKRAW);
  float hn[4];
#pragma unroll
  for (int nt = 0; nt < 4; ++nt) hn[nt] = p.m_hn[h * 128 + wc * 64 + nt * 16 + r];
#pragma unroll
  for (int mt = 0; mt < 2; ++mt) {
    float gv[4][4];
#pragma unroll
    for (int i = 0; i < 4; ++i) {
      long row = R0 + J0 + wr * 32 + mt * 16 + q * 4 + i;
#pragma unroll
      for (int nt = 0; nt < 4; ++nt) {
        int col = h * 128 + wc * 64 + nt * 16 + r;
        gv[i][nt] = bf2f(MO[row * 512 + col]) * bf2f(MZ[row * 512 + col]);
      }
    }
#pragma unroll
    for (int i = 0; i < 4; ++i) {
      int jl = wr * 32 + mt * 16 + q * 4 + i;
      float rinv = rsqrtf((sSs[jl] + sSs[64 + jl]) * (1.f / 128.f) + EPSF);
      long row = R0 + J0 + jl;
#pragma unroll
      for (int nt = 0; nt < 4; ++nt) {
        int col = h * 128 + wc * 64 + nt * 16 + r;
        Y[row * 1024 + col] = f2bf(acc[mt][nt][i] * rinv * hn[nt] * gv[i][nt]);
      }
    }
  }
  __syncthreads();
}

struct NsaSm {
  bf16_t* sK; bf16_t* sV;
  float* sImpA; float* sImpB;
  unsigned* sSel; unsigned* sGrp; unsigned* sUn;
};

DEVI int next_bit(unsigned long long lo, unsigned long long hi, int from) {
  if (from < 64) {
    unsigned long long v = lo & (~0ull << from);
    if (v) return __builtin_ctzll(v);
    if (hi) return 64 + __builtin_ctzll(hi);
    return -1;
  }
  if (from >= 128) return -1;
  unsigned long long v = hi & (~0ull << (from - 64));
  if (v) return 64 + __builtin_ctzll(v);
  return -1;
}

template <int MODE, bool DUMMY = false, class MaskF, class ActF>
DEVI void nsa_branch(const NsaSm& sm, unsigned long long tmlo, unsigned long long tmhi,
                     const bf16_t* Kg, const bf16_t* Vg, long vstep, long ldv,
                     const bf16x8 (&qf)[2][2], f32x4 (&O)[4][2], float (&mrow)[2], float (&lrow)[2], const float (&invl)[2],
                     MaskF mask, ActF actf, int tokbase, int tid) {
  const int lane = tid & 63, r = lane & 15, q = lane >> 4;
  const int lr = tid >> 3, lk = (tid & 7) * 8;
  int j = next_bit(tmlo, tmhi, 0);
  if (j < 0) return;
  u32x4 k0, k1, v0, v1;
  u32x4 k2, k3, v2, v3;
  if (!DUMMY) {
    const bf16_t* kp = Kg + (long)j * 4096 + lr * 64 + lk;
    k0 = *(const u32x4*)kp; k1 = *(const u32x4*)(kp + 32 * 64);
    if (MODE != 1) {
      const bf16_t* vp = Vg + (long)j * vstep + (long)lr * ldv + lk;
      v0 = *(const u32x4*)vp; v1 = *(const u32x4*)(vp + 32 * ldv);
    }
    *(u32x4*)(sm.sK + lr * LDT + lk) = k0; *(u32x4*)(sm.sK + (lr + 32) * LDT + lk) = k1;
    if (MODE != 1) { *(u32x4*)(sm.sV + lr * LDT + lk) = v0; *(u32x4*)(sm.sV + (lr + 32) * LDT + lk) = v1; }
  }
  int j1 = next_bit(tmlo, tmhi, j + 1);
  if (!DUMMY && j1 >= 0) {
    const bf16_t* kp = Kg + (long)j1 * 4096 + lr * 64 + lk;
    k0 = *(const u32x4*)kp; k1 = *(const u32x4*)(kp + 32 * 64);
    if (MODE != 1) {
      const bf16_t* vp = Vg + (long)j1 * vstep + (long)lr * ldv + lk;
      v0 = *(const u32x4*)vp; v1 = *(const u32x4*)(vp + 32 * ldv);
    }
  }
  if (!DUMMY) __syncthreads();
  int buf = 0;
  while (true) {
    const int jn = j1;
    const int j2 = (j1 >= 0) ? next_bit(tmlo, tmhi, j1 + 1) : -1;
    if (!DUMMY && j2 >= 0) {
      const bf16_t* kp = Kg + (long)j2 * 4096 + lr * 64 + lk;
      k2 = *(const u32x4*)kp; k3 = *(const u32x4*)(kp + 32 * 64);
      if (MODE != 1) {
        const bf16_t* vp = Vg + (long)j2 * vstep + (long)lr * ldv + lk;
        v2 = *(const u32x4*)vp; v3 = *(const u32x4*)(vp + 32 * ldv);
      }
    }
    const bf16_t* sK = sm.sK + buf * (64 * LDT);
    const bf16_t* sV = sm.sV + buf * (64 * LDT);
    const bool a0 = actf(0, j), a1 = actf(1, j);
    __builtin_amdgcn_sched_barrier(0);
    if (a0 || a1) {
      const bool full = mask.full(j);
      f32x4 sacc[4][2];
#pragma unroll
      for (int mt = 0; mt < 4; ++mt) { sacc[mt][0] = f32x4{0.f, 0.f, 0.f, 0.f}; sacc[mt][1] = f32x4{0.f, 0.f, 0.f, 0.f}; }
      __builtin_amdgcn_s_setprio(2);
#pragma unroll
      for (int ks = 0; ks < 2; ++ks)
#pragma unroll
        for (int mt = 0; mt < 4; ++mt) {
          bf16x8 a = *(const bf16x8*)(sK + (mt * 16 + r) * LDT + ks * 32 + q * 8);
          if (a0) sacc[mt][0] = __builtin_amdgcn_mfma_f32_16x16x32_bf16(a, qf[0][ks], sacc[mt][0], 0, 0, 0);
          if (a1) sacc[mt][1] = __builtin_amdgcn_mfma_f32_16x16x32_bf16(a, qf[1][ks], sacc[mt][1], 0, 0, 0);
        }
      __builtin_amdgcn_s_setprio(0);
      __builtin_amdgcn_sched_barrier(0);
#pragma unroll
      for (int nt = 0; nt < 2; ++nt) {
        const bool act = nt ? a1 : a0;
        if (act) {
          const bool lb = mask.bit(nt, j);
          if (!full) {
#pragma unroll
            for (int mt = 0; mt < 4; ++mt)
#pragma unroll
              for (int i = 0; i < 4; ++i) sacc[mt][nt][i] = mask.elem(mt * 16 + q * 4 + i, nt, j) ? sacc[mt][nt][i] : NEGS;
          }
          if (MODE != 2) {
            float tmx = fmaxf(fmaxf(sacc[0][nt][0], sacc[0][nt][1]), fmaxf(sacc[0][nt][2], sacc[0][nt][3]));
#pragma unroll
            for (int mt = 1; mt < 4; ++mt)
              tmx = fmaxf(tmx, fmaxf(fmaxf(sacc[mt][nt][0], sacc[mt][nt][1]), fmaxf(sacc[mt][nt][2], sacc[mt][nt][3])));
            if (MaskF::HASBIT) tmx = lb ? tmx : NEGS;
            tmx = fmaxf(tmx, __shfl_xor(tmx, 16));
            tmx = fmaxf(tmx, __shfl_xor(tmx, 32));
            const float mo = mrow[nt];
            const float mn = fmaxf(mo, tmx);
            float mnc = fmaxf(mn, -1e20f);
            if (MaskF::HASBIT) mnc = lb ? mnc : 1e30f;
            mrow[nt] = mn;
            f32x4 psv = f32x4{0.f, 0.f, 0.f, 0.f};
#pragma unroll
            for (int mt = 0; mt < 4; ++mt) {
              f32x4 dd = sacc[mt][nt] - mnc;
              f32x4 pp;
              pp[0] = __builtin_amdgcn_exp2f(dd[0]); pp[1] = __builtin_amdgcn_exp2f(dd[1]);
              pp[2] = __builtin_amdgcn_exp2f(dd[2]); pp[3] = __builtin_amdgcn_exp2f(dd[3]);
              sacc[mt][nt] = pp;
              psv += pp;
            }
            const float ps = (psv[0] + psv[1]) + (psv[2] + psv[3]);
            const float al = __builtin_amdgcn_exp2f(mo - mn);
            lrow[nt] = lrow[nt] * al + ps;
            if (MODE == 0) {
              if (__any(al != 1.f)) {
#pragma unroll
                for (int dt = 0; dt < 4; ++dt) O[dt][nt] *= al;
              }
            }
          } else {
            const float mmc = fmaxf(mrow[nt], -1e20f), il = invl[nt];
            const int tok = tokbase + nt * 4 + (r >> 2);
#pragma unroll
            for (int mt = 0; mt < 4; ++mt) {
              float pp[4];
#pragma unroll
              for (int i = 0; i < 4; ++i) {
                pp[i] = __builtin_amdgcn_exp2f(sacc[mt][nt][i] - mmc) * il;
                sacc[mt][nt][i] = pp[i];
              }
              float mainv = 32.f * (pp[0] + pp[1] + pp[2]) + 16.f * pp[3];
              float carry = 16.f * pp[3];
              mainv += __shfl_xor(mainv, 1); mainv += __shfl_xor(mainv, 2);
              carry += __shfl_xor(carry, 1); carry += __shfl_xor(carry, 2);
              if ((r & 3) == 0) {
                const int mp = j * 16 + mt * 4 + q;
                sm.sImpA[tok * 128 + mp] = mainv;
                if (mp + 1 < 128) sm.sImpB[tok * 128 + mp + 1] = carry;
              }
            }
          }
        }
      }
      __builtin_amdgcn_sched_barrier(0);
      if (MODE != 1) {
        __builtin_amdgcn_s_setprio(2);
#pragma unroll
        for (int ks = 0; ks < 2; ++ks) {
          bf16x8 pb[2];
#pragma unroll
          for (int nt = 0; nt < 2; ++nt) {
            union { u32x4 u; bf16x8 h; } cv;
            cv.u[0] = pack2(sacc[2 * ks][nt][0], sacc[2 * ks][nt][1]);
            cv.u[1] = pack2(sacc[2 * ks][nt][2], sacc[2 * ks][nt][3]);
            cv.u[2] = pack2(sacc[2 * ks + 1][nt][0], sacc[2 * ks + 1][nt][1]);
            cv.u[3] = pack2(sacc[2 * ks + 1][nt][2], sacc[2 * ks + 1][nt][3]);
            pb[nt] = cv.h;
          }
#pragma unroll
          for (int dt = 0; dt < 4; ++dt) {
            union { u32x4 u; bf16x8 h; } av;
            const uint2 lo = *(const uint2*)(sV + (dt * 16 + r) * LDT + (2 * ks) * 16 + q * 4);
            const uint2 hi = *(const uint2*)(sV + (dt * 16 + r) * LDT + (2 * ks + 1) * 16 + q * 4);
            av.u[0] = lo.x; av.u[1] = lo.y; av.u[2] = hi.x; av.u[3] = hi.y;
            if (a0) O[dt][0] = __builtin_amdgcn_mfma_f32_16x16x32_bf16(av.h, pb[0], O[dt][0], 0, 0, 0);
            if (a1) O[dt][1] = __builtin_amdgcn_mfma_f32_16x16x32_bf16(av.h, pb[1], O[dt][1], 0, 0, 0);
          }
        }
        __builtin_amdgcn_s_setprio(0);
      }
    }
    __builtin_amdgcn_sched_barrier(0);
    if (!DUMMY && jn >= 0) {
      bf16_t* dK = sm.sK + (buf ^ 1) * (64 * LDT);
      bf16_t* dV = sm.sV + (buf ^ 1) * (64 * LDT);
      *(u32x4*)(dK + lr * LDT + lk) = k0; *(u32x4*)(dK + (lr + 32) * LDT + lk) = k1;
      if (MODE != 1) { *(u32x4*)(dV + lr * LDT + lk) = v0; *(u32x4*)(dV + (lr + 32) * LDT + lk) = v1; }
    }
    if (!DUMMY) __syncthreads();
    if (jn < 0) break;
    j = jn;
    j1 = j2;
    k0 = k2; k1 = k3; v0 = v2; v1 = v3;
    buf ^= 1;
  }
}

struct MaskC {
      static constexpr bool HASBIT = false;
      int t0_, t1_, tmin_;
      DEVI bool full(int jt) const { return 16 * (jt * 64 + 63) + 31 <= tmin_; }
      DEVI bool bit(int nt, int jt) const { return true; }
      DEVI bool elem(int key, int nt, int jt) const { return 16 * (jt * 64 + key) + 31 <= (nt ? t1_ : t0_); }
};

struct MaskS {
      static constexpr bool HASBIT = true;
      unsigned long long a_lo, a_hi, b_lo, b_hi; int t0_, t1_, cur_;
      DEVI bool full(int jt) const { return jt < cur_; }
      DEVI bool bit(int nt, int jt) const {
        const unsigned long long lo = nt ? b_lo : a_lo, hi = nt ? b_hi : a_hi;
        const unsigned long long wd = (jt < 64) ? (lo >> jt) : (hi >> (jt - 64));
        return (wd & 1ull) != 0ull;
      }
      DEVI bool elem(int key, int nt, int jt) const { return jt * 64 + key <= (nt ? t1_ : t0_); }
};

struct MaskW {
      static constexpr bool HASBIT = false;
      int t0_, t1_, tmin_, tmax_;
      DEVI bool full(int jt) const { return (jt * 64 + 63 <= tmin_) && (tmax_ - jt * 64 < 512); }
      DEVI bool bit(int nt, int jt) const { return true; }
      DEVI bool elem(int key, int nt, int jt) const { const int s_ = jt * 64 + key, t_ = nt ? t1_ : t0_; return (s_ <= t_) && (t_ - s_ < 512); }
};

DEVI void nsa_tile(const Params& p, int tileidx, unsigned char* smem) {
  const int tid = opaque_tid(), lane = tid & 63, w = tid >> 6, r = lane & 15, q = lane >> 4;
  const int bg = tileidx & 3, tt = tileidx >> 2, b = bg >> 1, g = bg & 1, t0 = tt * 32;
  unsigned char* ws = p.ws;
  NsaSm sm;
  sm.sK = (bf16_t*)smem; sm.sV = (bf16_t*)(smem + 18432);
  sm.sImpA = (float*)(smem + 36864); sm.sImpB = (float*)(smem + 53248);
  sm.sSel = (unsigned*)(smem + 69632); sm.sGrp = sm.sSel + 128; sm.sUn = sm.sGrp + 32;
  const int tokbase = 8 * w;
  bf16x8 qf[2][2];
  {
    const bf16_t* qn = (const bf16_t*)(ws + L0_QN) + ((long)bg * 8192 + t0) * 256 + (32 * w + r) * 64 + q * 8;
    qf[0][0] = *(const bf16x8*)(qn); qf[0][1] = *(const bf16x8*)(qn + 32);
    qf[1][0] = *(const bf16x8*)(qn + 16 * 64); qf[1][1] = *(const bf16x8*)(qn + 16 * 64 + 32);
  }
  int tq[2];
  const float* GT = (const float*)(ws + L0_GATES);
#pragma unroll
  for (int nt = 0; nt < 2; ++nt) tq[nt] = t0 + tokbase + nt * 4 + (r >> 2);
#define GATE(nt, k) (GT[((long)b * 8192 + tq[nt]) * 24 + (g * 4 + (r & 3)) * 3 + (k)])
  f32x4 O[4][2];
  f32x4* sOut = (f32x4*)(smem + 36864) + (w * 8) * 64 + lane;
  const int cur = t0 >> 6;
  float mrow[2], lrow[2], invl[2];
  for (int i = tid; i < 32 * 128; i += 256) { sm.sImpA[i] = 0.f; sm.sImpB[i] = 0.f; }
  __syncthreads();
  {
    const int nvmax = (t0 + 31 >= 31) ? (((t0 + 31 - 31) >> 4) + 1) : 0;
    int nkt = (nvmax + 63) >> 6;
    if (nkt > 8) nkt = 8;
    const unsigned long long cm0 = (1ull << nkt) - 1ull;
    const bf16_t* KCMP = (const bf16_t*)(ws + L0_KCMP) + (long)bg * 512 * 64;
    const bf16_t* VCMPT = (const bf16_t*)(ws + L0_VCMPT) + (long)bg * 64 * 512;
    MaskC mk{tq[0], tq[1], t0 + tokbase};
    auto act = [&](int nt, int jt) { return true; };
    mrow[0] = mrow[1] = NEGS; lrow[0] = lrow[1] = 0.f; invl[0] = invl[1] = 0.f;
    nsa_branch<1>(sm, cm0, 0ull, KCMP, VCMPT, 64, 512, qf, O, mrow, lrow, invl, mk, act, tokbase, tid);
#pragma unroll
    for (int nt = 0; nt < 2; ++nt) {
      float l = lrow[nt];
      l += __shfl_xor(l, 16); l += __shfl_xor(l, 32);
      invl[nt] = (l > 0.f) ? 1.f / l : 0.f;
    }
#pragma unroll
    for (int dt = 0; dt < 4; ++dt) { O[dt][0] = f32x4{0.f, 0.f, 0.f, 0.f}; O[dt][1] = f32x4{0.f, 0.f, 0.f, 0.f}; }
    nsa_branch<2>(sm, cm0, 0ull, KCMP, VCMPT, 64, 512, qf, O, mrow, lrow, invl, mk, act, tokbase, tid);
  }
  __syncthreads();
  {
    const int ncand = (cur - 2 > 0) ? cur - 2 : 0;
    const int nf = (cur >= 2) ? 3 : cur + 1;
    const int kk = 16 - nf;
    const int m0i = lane, m1i = lane + 64;
    const bool c0 = (m0i >= 1 && m0i <= cur - 2), c1 = (m1i <= cur - 2);
    for (int tqi = 0; tqi < 8; ++tqi) {
      const int tok = tokbase + tqi;
      bool s0, s1;
      if (ncand <= kk) { s0 = c0; s1 = c1; }
      else {
        const float f0 = sm.sImpA[tok * 128 + m0i] + sm.sImpB[tok * 128 + m0i];
        const float f1 = sm.sImpA[tok * 128 + m1i] + sm.sImpB[tok * 128 + m1i];
        const unsigned k0 = c0 ? (__float_as_uint(f0) + 1u) : 0u;
        const unsigned k1 = c1 ? (__float_as_uint(f1) + 1u) : 0u;
        unsigned prefix = 0u;
        for (int bit = 31; bit >= 0; --bit) {
          const unsigned cand = prefix | (1u << bit);
          const int cnt = __popcll(__ballot(k0 >= cand)) + __popcll(__ballot(k1 >= cand));
          if (cnt >= kk) prefix = cand;
        }
        const bool g0 = k0 > prefix, g1 = k1 > prefix;
        const int ng = __popcll(__ballot(g0)) + __popcll(__ballot(g1));
        const bool e0 = (k0 == prefix), e1 = (k1 == prefix);
        const unsigned long long be0 = __ballot(e0), be1 = __ballot(e1);
        const unsigned long long lm = (1ull << lane) - 1ull;
        const int re0 = __popcll(be0 & lm), re1 = __popcll(be0) + __popcll(be1 & lm);
        const int need = kk - ng;
        s0 = g0 || (e0 && re0 < need);
        s1 = g1 || (e1 && re1 < need);
      }
      s0 = s0 || (m0i == 0) || (m0i == cur) || (m0i == cur - 1);
      s1 = s1 || (m1i == cur) || (m1i == cur - 1);
      const unsigned long long lo = __ballot(s0), hi = __ballot(s1);
      if (lane == 0) {
        sm.sSel[tok * 4 + 0] = (unsigned)lo; sm.sSel[tok * 4 + 1] = (unsigned)(lo >> 32);
        sm.sSel[tok * 4 + 2] = (unsigned)hi; sm.sSel[tok * 4 + 3] = (unsigned)(hi >> 32);
      }
    }
  }
  __syncthreads();
  if (tid < 32) { int gi = tid >> 2, wd = tid & 3; unsigned u = 0; for (int k = 0; k < 4; ++k) u |= sm.sSel[(gi * 4 + k) * 4 + wd]; sm.sGrp[tid] = u; }
  __syncthreads();
  if (tid < 4) { unsigned u = 0; for (int gi = 0; gi < 8; ++gi) u |= sm.sGrp[gi * 4 + tid]; sm.sUn[tid] = u; }
  __syncthreads();
#pragma unroll
  for (int nt = 0; nt < 2; ++nt)
#pragma unroll
    for (int dt = 0; dt < 4; ++dt) sOut[(nt * 4 + dt) * 64] = O[dt][nt] * GATE(nt, 0);
  {
    const bf16_t* KS = (const bf16_t*)(ws + L0_KS) + (long)bg * 8192 * 64;
    const bf16_t* VST = (const bf16_t*)(ws + L0_VST) + (long)bg * 128 * 4096;
    const unsigned long long ulo = (unsigned long long)sm.sUn[0] | ((unsigned long long)sm.sUn[1] << 32);
    const unsigned long long uhi = (unsigned long long)sm.sUn[2] | ((unsigned long long)sm.sUn[3] << 32);
    const int tk0 = tokbase + (r >> 2), tk1 = tokbase + 4 + (r >> 2);
    MaskS mk{(unsigned long long)sm.sSel[tk0 * 4 + 0] | ((unsigned long long)sm.sSel[tk0 * 4 + 1] << 32),
             (unsigned long long)sm.sSel[tk0 * 4 + 2] | ((unsigned long long)sm.sSel[tk0 * 4 + 3] << 32),
             (unsigned long long)sm.sSel[tk1 * 4 + 0] | ((unsigned long long)sm.sSel[tk1 * 4 + 1] << 32),
             (unsigned long long)sm.sSel[tk1 * 4 + 2] | ((unsigned long long)sm.sSel[tk1 * 4 + 3] << 32), tq[0], tq[1], cur};
    unsigned long long g0lo, g0hi, g1lo, g1hi;
    {
      const unsigned* gp = sm.sGrp + (2 * w) * 4;
      g0lo = (unsigned long long)__builtin_amdgcn_readfirstlane(gp[0]) | ((unsigned long long)__builtin_amdgcn_readfirstlane(gp[1]) << 32);
      g0hi = (unsigned long long)__builtin_amdgcn_readfirstlane(gp[2]) | ((unsigned long long)__builtin_amdgcn_readfirstlane(gp[3]) << 32);
      g1lo = (unsigned long long)__builtin_amdgcn_readfirstlane(gp[4]) | ((unsigned long long)__builtin_amdgcn_readfirstlane(gp[5]) << 32);
      g1hi = (unsigned long long)__builtin_amdgcn_readfirstlane(gp[6]) | ((unsigned long long)__builtin_amdgcn_readfirstlane(gp[7]) << 32);
    }
    auto act = [&](int nt, int jt) {
      const unsigned long long lo = nt ? g1lo : g0lo, hi = nt ? g1hi : g0hi;
      const unsigned long long wd = (jt < 64) ? (lo >> jt) : (hi >> (jt - 64));
      return (wd & 1ull) != 0ull;
    };
    mrow[0] = mrow[1] = NEGS; lrow[0] = lrow[1] = 0.f;
#pragma unroll
    for (int dt = 0; dt < 4; ++dt) { O[dt][0] = f32x4{0.f, 0.f, 0.f, 0.f}; O[dt][1] = f32x4{0.f, 0.f, 0.f, 0.f}; }
#ifdef NSA_DUMMY_SEL
    {
      nsa_branch<0, true>(sm, ulo, uhi, KS, VST, 4096, 64, qf, O, mrow, lrow, invl, mk, act, tokbase, tid);
      float chk = lrow[0] + lrow[1];
#pragma unroll
      for (int dt = 0; dt < 4; ++dt) chk += O[dt][0][0] + O[dt][0][1] + O[dt][0][2] + O[dt][0][3] + O[dt][1][0] + O[dt][1][1] + O[dt][1][2] + O[dt][1][3];
      if (chk == 123.456f) sm.sUn[0] = 1u;
      mrow[0] = mrow[1] = NEGS; lrow[0] = lrow[1] = 0.f;
#pragma unroll
      for (int dt = 0; dt < 4; ++dt) { O[dt][0] = f32x4{0.f, 0.f, 0.f, 0.f}; O[dt][1] = f32x4{0.f, 0.f, 0.f, 0.f}; }
      __syncthreads();
    }
#endif
    nsa_branch<0>(sm, ulo, uhi, KS, VST, 4096, 64, qf, O, mrow, lrow, invl, mk, act, tokbase, tid);
#pragma unroll
    for (int nt = 0; nt < 2; ++nt) {
      float l = lrow[nt];
      l += __shfl_xor(l, 16); l += __shfl_xor(l, 32);
      const float f = GATE(nt, 1) * ((l > 0.f) ? 1.f / l : 0.f);
#pragma unroll
      for (int dt = 0; dt < 4; ++dt) sOut[(nt * 4 + dt) * 64] += O[dt][nt] * f;
    }
  }
  {
    const bf16_t* KW = (const bf16_t*)(ws + L0_KW) + (long)bg * 8192 * 64;
    const bf16_t* VWT = (const bf16_t*)(ws + L0_VWT) + (long)bg * 128 * 4096;
    const int jlo = ((t0 - 511 > 0) ? (t0 - 511) : 0) >> 6;
    unsigned long long wlo = 0ull, whi = 0ull;
    for (int jj = jlo; jj <= cur; ++jj) { if (jj < 64) wlo |= (1ull << jj); else whi |= (1ull << (jj - 64)); }
    MaskW mk{tq[0], tq[1], t0 + tokbase, t0 + tokbase + 7};
    auto act = [&](int nt, int jt) { return true; };
    mrow[0] = mrow[1] = NEGS; lrow[0] = lrow[1] = 0.f;
#pragma unroll
    for (int dt = 0; dt < 4; ++dt) { O[dt][0] = f32x4{0.f, 0.f, 0.f, 0.f}; O[dt][1] = f32x4{0.f, 0.f, 0.f, 0.f}; }
    nsa_branch<0>(sm, wlo, whi, KW, VWT, 4096, 64, qf, O, mrow, lrow, invl, mk, act, tokbase, tid);
#pragma unroll
    for (int nt = 0; nt < 2; ++nt) {
      float l = lrow[nt];
      l += __shfl_xor(l, 16); l += __shfl_xor(l, 32);
      const float f = GATE(nt, 2) * ((l > 0.f) ? 1.f / l : 0.f);
#pragma unroll
      for (int dt = 0; dt < 4; ++dt) O[dt][nt] = sOut[(nt * 4 + dt) * 64] + O[dt][nt] * f;
    }
  }
  const bf16_t* NZ = (const bf16_t*)(ws + L0_NZ);
  bf16_t* Y = (bf16_t*)(ws + L0_QKRAW);
  uint2 zzv[2][4];
#pragma unroll
  for (int nt = 0; nt < 2; ++nt)
#pragma unroll
    for (int dt = 0; dt < 4; ++dt)
      zzv[nt][dt] = *(const uint2*)(NZ + ((long)b * 8192 + tq[nt]) * 512 + (g * 4 + (r & 3)) * 64 + dt * 16 + q * 4);
#pragma unroll
  for (int nt = 0; nt < 2; ++nt) {
    const long tok = (long)b * 8192 + tq[nt];
    const int head = g * 4 + (r & 3);
#pragma unroll
    for (int dt = 0; dt < 4; ++dt) {
      const int d = dt * 16 + q * 4;
      const uint2 zz = zzv[nt][dt];
      uint2 o;
      o.x = pack2(O[dt][nt][0] * lo2f(zz.x), O[dt][nt][1] * hi2f(zz.x));
      o.y = pack2(O[dt][nt][2] * lo2f(zz.y), O[dt][nt][3] * hi2f(zz.y));
      *(uint2*)(Y + tok * 1024 + 512 + head * 64 + d) = o;
    }
  }
  __syncthreads();
}

DEVI void hgrn_local(const Params& p, int unit, unsigned char* smem) {
  const int tid = opaque_tid(), lane = tid & 63, w = tid >> 6, wr = w >> 1, wc = w & 1;
  const int bh = unit >> 7, c = unit & 127, b = bh >> 3, h = bh & 7, t0 = c * 64;
  const long R0 = (long)b * 8192 + t0;
  unsigned char* ws = p.ws;
  bf16_t* sA = (bf16_t*)smem;
  bf16_t* sB = (bf16_t*)(smem + 18432);
  float* psum = (float*)(smem + 36864);
  const int cch = tid & 127, half = tid >> 7;
  const float lb = ((const float*)(ws + OFF_LB))[h * 128 + cch];
  const bf16_t* FP = (const bf16_t*)(ws + L1_FP) + R0 * 1024 + h * 128 + cch;
  float sgv[32], lgv[32];
  {
    const bf16_t* vtp = (const bf16_t*)(ws + L1_VT) + (((long)(b * 8 + h) * 128 + c) * 128) * 64 + (tid >> 3) * 64 + (tid & 7) * 8;
    u32x4 t0_ = *(const u32x4*)vtp, t1_ = *(const u32x4*)(vtp + 32 * 64), t2_ = *(const u32x4*)(vtp + 64 * 64), t3_ = *(const u32x4*)(vtp + 96 * 64);
    bf16_t fpr[32];
#pragma unroll
    for (int k = 0; k < 32; ++k) fpr[k] = FP[(long)(half * 32 + k) * 1024];
    {
      bf16_t* sp = sA + (tid >> 3) * LDT + (tid & 7) * 8;
      *(u32x4*)sp = t0_; *(u32x4*)(sp + 32 * LDT) = t1_; *(u32x4*)(sp + 64 * LDT) = t2_; *(u32x4*)(sp + 96 * LDT) = t3_;
    }
#pragma unroll
    for (int k = 0; k < 32; ++k) { sgv[k] = sigm(bf2f(fpr[k])); lgv[k] = __logf(lb + (1.f - lb) * sgv[k]); }
  }
  float sum = 0.f;
#pragma unroll
  for (int k = 0; k < 32; ++k) sum += lgv[k];
  psum[half * 128 + cch] = sum;
  __syncthreads();
  const float bL = psum[cch] + psum[128 + cch];
  float run = half ? psum[cch] : 0.f;
#pragma unroll
  for (int k = 0; k < 32; ++k) {
    run += lgv[k];
    float kk_ = (1.f - lb) * (1.f - sgv[k]);
    sB[cch * LDT + half * 32 + k] = f2bf(kk_ * __expf(bL - run));
  }
  if (half == 0) ((float*)(ws + L1_BL))[(long)unit * 128 + cch] = bL;
  __syncthreads();
  f32x4 acc[4][4];
#pragma unroll
  for (int mt = 0; mt < 4; ++mt)
#pragma unroll
    for (int nt = 0; nt < 4; ++nt) acc[mt][nt] = f32x4{0.f, 0.f, 0.f, 0.f};
  mma_lds_sw<4, 4, 2>(sA + wr * 64 * LDT, sB + wc * 64 * LDT, acc, lane);
#ifndef R9B
#define R9B 1
#endif
  for (int r9_ = 0; r9_ < R9B; ++r9_) {
  bf16_t* st = (bf16_t*)(ws + L1_ST) + (long)unit * 16384;
  const int r = lane & 15, q = lane >> 4;
#pragma unroll
  for (int mt = 0; mt < 4; ++mt) {
    const int v = wr * 64 + mt * 16 + r;
#pragma unroll
    for (int nt = 0; nt < 4; ++nt) {
      uint2 o;
      o.x = pack2(acc[mt][nt][0], acc[mt][nt][1]);
      o.y = pack2(acc[mt][nt][2], acc[mt][nt][3]);
      *(uint2*)(st + v * 128 + wc * 64 + nt * 16 + q * 4) = o;
    }
  }
  }
  __syncthreads();
}

template <bool DUMMY>
DEVI void hgrn_scan(const Params& p) {
  unsigned char* ws = p.ws;
  const float* BL = (const float*)(ws + L1_BL);
  for (int idx = blockIdx.x * 256 + opaque_tid(); idx < 16 * 8192; idx += gridDim.x * 256) {
    const int bh = idx >> 13, pr = idx & 8191;
    const int c2 = (pr & 63) * 2;
    unsigned* ptr = (unsigned*)(ws + L1_ST) + (long)bh * 128 * 8192 + pr;
    const float* blp = BL + (long)bh * 128 * 128 + c2;
    float s0 = 0.f, s1 = 0.f;
    for (int c0 = 0; c0 < 128; c0 += 8) {
      unsigned dv[8]; float2 bl[8];
#pragma unroll
      for (int k = 0; k < 8; ++k) { dv[k] = __builtin_nontemporal_load(ptr + (long)(c0 + k) * 8192); bl[k] = *(const float2*)(blp + (long)(c0 + k) * 128); }
#pragma unroll
      for (int k = 0; k < 8; ++k) {
        if (!DUMMY) __builtin_nontemporal_store(pack2(s0, s1), ptr + (long)(c0 + k) * 8192);
        s0 = __expf(bl[k].x) * s0 + lo2f(dv[k]);
        s1 = __expf(bl[k].y) * s1 + hi2f(dv[k]);
      }
    }
    if (DUMMY && s0 == 123.456f) ptr[0] = pack2(s0, s1);
  }
}

DEVI void hgrn_out(const Params& p, int unit, unsigned char* smem) {
  const int tid = opaque_tid(), lane = tid & 63, w = tid >> 6, wr = w >> 1, wc = w & 1;
  const int r = lane & 15, q = lane >> 4;
  const int bh = unit >> 7, c = unit & 127, b = bh >> 3, h = bh & 7, t0 = c * 64;
  const long R0 = (long)b * 8192 + t0;
  unsigned char* ws = p.ws;
  bf16_t* sQ0 = (bf16_t*)smem; bf16_t* sQ1 = (bf16_t*)(smem + 9216);
  bf16_t* sK0 = (bf16_t*)(smem + 18432); bf16_t* sK1 = (bf16_t*)(smem + 27648);
  bf16_t* sAm = (bf16_t*)(smem + 36864);
  bf16_t* sB = (bf16_t*)(smem + 46080);
  float* psum = (float*)(smem + 64512);
  float* sSs = psum + 256;
  const int cch = tid & 127, half = tid >> 7, cc = cch & 63;
  const float lb = ((const float*)(ws + OFF_LB))[h * 128 + cch];
  const bf16_t* FP = (const bf16_t*)(ws + L1_FP) + R0 * 1024 + h * 128 + cch;
  const bf16_t* Q1 = (const bf16_t*)(ws + L1_Q) + R0 * 1024 + h * 128 + cch;
  const bf16_t* vt = (const bf16_t*)(ws + L1_VT) + (((long)(b * 8 + h) * 128 + c) * 128) * 64;
  const bf16_t* st = (const bf16_t*)(ws + L1_ST) + (long)unit * 16384;
  const int tl_r = tid >> 3, tl_k = (tid & 7) * 8;
  u32x4 vv0, vv1, vv2, vv3, sa0, sa1, sa2, sa3, sb0, sb1, sb2, sb3;
  {
    const bf16_t* vp = vt + tl_r * 64 + tl_k;
    vv0 = *(const u32x4*)vp; vv1 = *(const u32x4*)(vp + 32 * 64); vv2 = *(const u32x4*)(vp + 64 * 64); vv3 = *(const u32x4*)(vp + 96 * 64);
    const bf16_t* sp = st + tl_r * 128 + tl_k;
    sa0 = *(const u32x4*)sp; sa1 = *(const u32x4*)(sp + 32 * 128); sa2 = *(const u32x4*)(sp + 64 * 128); sa3 = *(const u32x4*)(sp + 96 * 128);
    sb0 = *(const u32x4*)(sp + 64); sb1 = *(const u32x4*)(sp + 32 * 128 + 64); sb2 = *(const u32x4*)(sp + 64 * 128 + 64); sb3 = *(const u32x4*)(sp + 96 * 128 + 64);
  }
  float sgv[32], lgv[32];
  bf16_t qr[32];
  {
    bf16_t fpr[32];
#pragma unroll
    for (int k = 0; k < 32; ++k) { fpr[k] = FP[(long)(half * 32 + k) * 1024]; qr[k] = Q1[(long)(half * 32 + k) * 1024]; }
    { bf16_t* dp = sB + tl_r * LDT + tl_k; *(u32x4*)dp = vv0; *(u32x4*)(dp + 32 * LDT) = vv1; *(u32x4*)(dp + 64 * LDT) = vv2; *(u32x4*)(dp + 96 * LDT) = vv3; }
#pragma unroll
    for (int k = 0; k < 32; ++k) { sgv[k] = sigm(bf2f(fpr[k])); lgv[k] = __logf(lb + (1.f - lb) * sgv[k]); }
  }
  float sum = 0.f;
#pragma unroll
  for (int k = 0; k < 32; ++k) sum += lgv[k];
  psum[half * 128 + cch] = sum;
  __syncthreads();
  float run = half ? psum[cch] : 0.f;
  bf16_t* sQ = (cch < 64) ? sQ0 : sQ1;
  bf16_t* sK = (cch < 64) ? sK0 : sK1;
#pragma unroll
  for (int k = 0; k < 32; ++k) {
    const int s_ = half * 32 + k;
    run += lgv[k];
    float kk_ = (1.f - lb) * (1.f - sgv[k]);
    sQ[s_ * LDT + cc] = f2bf(bf2f(qr[k]) * __expf(run));
    sK[s_ * LDT + cc] = f2bf(kk_ * __expf(fminf(-run, 80.f)));
  }
  __syncthreads();
  {
    f32x4 a1[2][2];
#pragma unroll
    for (int mt = 0; mt < 2; ++mt)
#pragma unroll
      for (int nt = 0; nt < 2; ++nt) a1[mt][nt] = f32x4{0.f, 0.f, 0.f, 0.f};
    if (!(wr == 0 && wc == 1)) {
      mma_lds<2, 2, 2>(sQ0 + wr * 32 * LDT, sK0 + wc * 32 * LDT, a1, lane);
      mma_lds<2, 2, 2>(sQ1 + wr * 32 * LDT, sK1 + wc * 32 * LDT, a1, lane);
    }
#pragma unroll
    for (int mt = 0; mt < 2; ++mt)
#pragma unroll
      for (int i = 0; i < 4; ++i) {
        int j = wr * 32 + mt * 16 + q * 4 + i;
#pragma unroll
        for (int nt = 0; nt < 2; ++nt) {
          int s = wc * 32 + nt * 16 + r;
          sAm[j * LDT + s] = f2bf((s <= j) ? a1[mt][nt][i] : 0.f);
        }
      }
  }
  __syncthreads();
  f32x4 o[2][4];
#pragma unroll
  for (int mt = 0; mt < 2; ++mt)
#pragma unroll
    for (int nt = 0; nt < 4; ++nt) o[mt][nt] = f32x4{0.f, 0.f, 0.f, 0.f};
  mma_lds<2, 4, 2>(sAm + wr * 32 * LDT, sB + wc * 64 * LDT, o, lane);
  __syncthreads();
  { bf16_t* dp = sB + tl_r * LDT + tl_k; *(u32x4*)dp = sa0; *(u32x4*)(dp + 32 * LDT) = sa1; *(u32x4*)(dp + 64 * LDT) = sa2; *(u32x4*)(dp + 96 * LDT) = sa3; }
  __syncthreads();
  mma_lds<2, 4, 2>(sQ0 + wr * 32 * LDT, sB + wc * 64 * LDT, o, lane);
  __syncthreads();
  { bf16_t* dp = sB + tl_r * LDT + tl_k; *(u32x4*)dp = sb0; *(u32x4*)(dp + 32 * LDT) = sb1; *(u32x4*)(dp + 64 * LDT) = sb2; *(u32x4*)(dp + 96 * LDT) = sb3; }
  __syncthreads();
  mma_lds<2, 4, 2>(sQ1 + wr * 32 * LDT, sB + wc * 64 * LDT, o, lane);
#pragma unroll
  for (int mt = 0; mt < 2; ++mt)
#pragma unroll
    for (int i = 0; i < 4; ++i) {
      int j = wr * 32 + mt * 16 + q * 4 + i;
      float ss = 0.f;
#pragma unroll
      for (int nt = 0; nt < 4; ++nt) ss += o[mt][nt][i] * o[mt][nt][i];
      ss = grp16_sum(ss);
      if (r == 0) sSs[wc * 64 + j] = ss;
    }
  __syncthreads();
  const bf16_t* Z1 = (const bf16_t*)(ws + L1_Z);
  bf16_t* Y1 = (bf16_t*)(ws + L1_H);
  float hn[4];
#pragma unroll
  for (int nt = 0; nt < 4; ++nt) hn[nt] = p.h_hn[h * 128 + wc * 64 + nt * 16 + r];
#pragma unroll
  for (int mt = 0; mt < 2; ++mt) {
    float zv[4][4];
#pragma unroll
    for (int i = 0; i < 4; ++i) {
      long row = R0 + wr * 32 + mt * 16 + q * 4 + i;
#pragma unroll
      for (int nt = 0; nt < 4; ++nt) zv[i][nt] = bf2f(Z1[row * 1024 + h * 128 + wc * 64 + nt * 16 + r]);
    }
#pragma unroll
    for (int i = 0; i < 4; ++i) {
      int j = wr * 32 + mt * 16 + q * 4 + i;
      float rinv = rsqrtf((sSs[j] + sSs[64 + j]) * (1.f / 128.f) + EPSF);
      long row = R0 + j;
#pragma unroll
      for (int nt = 0; nt < 4; ++nt) {
        int col = h * 128 + wc * 64 + nt * 16 + r;
        Y1[row * 1024 + col] = f2bf(o[mt][nt][i] * rinv * hn[nt] * zv[i][nt]);
      }
    }
  }
  __syncthreads();
}

#define XB_TMO      128
#define XB_XCNT(j)  (256  + 64 * (j))
#define XB_XSUB(j)  (1280 + 64 * (j))
#define XB_XGEN(j)  (2304 + 64 * (j))
#define XB_TOP      3328
#define XB_TOPGEN   3392
#define XCD_BAR_WORDS 3456
#define XB_SPIN_CAP (1u << 22)
DEVI unsigned xb_ld(unsigned* p) { return __hip_atomic_load(p, __ATOMIC_RELAXED, __HIP_MEMORY_SCOPE_AGENT); }
DEVI unsigned xb_add(unsigned* p, unsigned v) { return __hip_atomic_fetch_add(p, v, __ATOMIC_RELAXED, __HIP_MEMORY_SCOPE_AGENT); }
DEVI unsigned xb_xcc_id() { return (unsigned)__builtin_amdgcn_s_getreg((3 << 11) | 20) & 0xFu; }
#define XB_SPIN(cond, bar) do { unsigned _sp = 0; while (cond) { __builtin_amdgcn_s_sleep(1); \
    if ((++_sp & 255u) == 0u) { if (xb_ld(&(bar)[XB_TMO])) break; if (_sp > XB_SPIN_CAP) { atomicAdd(&(bar)[XB_TMO], 1u); break; } } } } while (0)

DEVI void xcd_barrier_complete(unsigned* bar, unsigned x, unsigned& nloc, unsigned& nx) {
  const unsigned G = gridDim.x;
  unsigned sum, cnt, mine, sp = 0u;
  for (;;) {
    sum = 0u; cnt = 0u; mine = 0u;
#pragma unroll
    for (unsigned j = 0; j < 16; ++j) { const unsigned c = xb_ld(&bar[XB_XCNT(j)]); sum += c; cnt += (c > 0u) ? 1u : 0u; mine = (j == x) ? c : mine; }
    if (sum == G) break;
    __builtin_amdgcn_s_sleep(1);
    if ((++sp & 255u) == 0u) { if (xb_ld(&bar[XB_TMO])) break; if (sp > XB_SPIN_CAP) { atomicAdd(&bar[XB_TMO], 1u); break; } }
  }
  nloc = mine > 0u ? mine : 1u; nx = cnt > 0u ? cnt : 1u;
}

DEVI void grid_barrier(unsigned* bar, unsigned xcc, volatile unsigned* st) {
  asm volatile("s_waitcnt vmcnt(0)" ::: "memory");
  __syncthreads();
  if (threadIdx.x == 0) {
    __builtin_amdgcn_s_waitcnt(0);
    unsigned nloc = st[0], nx = st[1];
    if (nloc == 0u) { xcd_barrier_complete(bar, xcc, nloc, nx); st[0] = nloc; st[1] = nx; }
    const unsigned old = xb_add(&bar[XB_XSUB(xcc)], 1u);
    const unsigned gen = old / nloc;
    if (old + 1u == (gen + 1u) * nloc) {
      __builtin_amdgcn_fence(__ATOMIC_RELEASE, "agent");
      asm volatile("s_waitcnt vmcnt(0)" ::: "memory");
      const unsigned og = xb_add(&bar[XB_TOP], 1u);
      const unsigned tg = og / nx;
      if (og + 1u == (tg + 1u) * nx) xb_add(&bar[XB_TOPGEN], 1u);
      else XB_SPIN(xb_ld(&bar[XB_TOPGEN]) == tg, bar);
      __builtin_amdgcn_fence(__ATOMIC_ACQUIRE, "agent");
      xb_add(&bar[XB_XGEN(xcc)], 1u);
      asm volatile("s_waitcnt vmcnt(0)" ::: "memory");
    } else {
      XB_SPIN(xb_ld(&bar[XB_XGEN(xcc)]) == gen, bar);
      __builtin_amdgcn_fence(__ATOMIC_ACQUIRE, "agent");
      asm volatile("s_waitcnt vmcnt(0)" ::: "memory");
    }
  }
  __syncthreads();
}

#ifndef REP_NSA
#define REP_NSA 1
#endif
#ifndef REP_P0
#define REP_P0 1
#endif
#ifndef REP_P1
#define REP_P1 1
#endif
#ifndef REP_P2
#define REP_P2 1
#endif
#ifndef REP_P3
#define REP_P3 1
#endif
#ifndef REP_P4
#define REP_P4 1
#endif
#ifndef REP_P5
#define REP_P5 1
#endif
#ifndef REP_P6
#define REP_P6 1
#endif
#ifndef REP_P7
#define REP_P7 1
#endif
#ifndef REP_P8
#define REP_P8 1
#endif
#ifndef REP_P9
#define REP_P9 1
#endif
#ifndef REP_P10
#define REP_P10 1
#endif
#ifndef REP_P11
#define REP_P11 1
#endif
#ifndef REP_P12
#define REP_P12 1
#endif
#ifndef DBG_STOP
#define DBG_STOP 99
#endif
DEVI void dbg_probe_bf16(const Params& p, size_t off, long n) {
  const bf16_t* b = (const bf16_t*)(p.ws + off);
  for (long i = (long)blockIdx.x * 256 + threadIdx.x; i < 16384L * 1024; i += (long)gridDim.x * 256) {
    float v = bf2f(b[i % n]);
    if (!(v == v) || fabsf(v) > 1e30f) v = 777.f;
    p.out[i] = v;
  }
}
DEVI void dbg_probe_f32(const Params& p, size_t off, long n) {
  const float* b = (const float*)(p.ws + off);
  for (long i = (long)blockIdx.x * 256 + threadIdx.x; i < 16384L * 1024; i += (long)gridDim.x * 256) {
    float v = b[i % n];
    if (!(v == v) || fabsf(v) > 1e30f) v = 777.f;
    p.out[i] = v;
  }
}
DEVI void dbg_probe_combo(const Params& p) {
  const bf16_t* qn = (const bf16_t*)(p.ws + L0_QN);
  const bf16_t* ks = (const bf16_t*)(p.ws + L0_KS);
  const bf16_t* nz = (const bf16_t*)(p.ws + L0_NZ);
  const float* ig = (const float*)(p.ws + L0_IG);
  for (long i = (long)blockIdx.x * 256 + threadIdx.x; i < 16384L * 1024; i += (long)gridDim.x * 256) {
    float v = bf2f(qn[i % (16384L * 512)]) + bf2f(ks[i % (4L * 8192 * 64 * 4)]) + bf2f(nz[i % (16384L * 512)]) + ig[i % (16384L * 32)];
    if (!(v == v) || fabsf(v) > 1e30f) v = 777.f;
    p.out[i] = v;
  }
}
#define DBG_AT(k, stmt) if (DBG_STOP == k) { stmt; return; }

__device__ unsigned g_bar_words[8192];

#define GSYNC() grid_barrier(bar_ctr, bar_xcc, bar_st)

__global__ void __launch_bounds__(256, 2) mega(Params p) {
  __shared__ __attribute__((aligned(16))) unsigned char smem[79872];
  cg::grid_group grid = cg::this_grid();
  const int G = gridDim.x, bid = blockIdx.x, tid = threadIdx.x, lane = tid & 63, w = tid >> 6;
  unsigned char* ws = p.ws;
  bf16_t* sA = (bf16_t*)smem;
  bf16_t* sB = (bf16_t*)(smem + 16384);
  unsigned* bar_ctr = g_bar_words;
  __shared__ uint4 xb_words;
  if (tid == 0) xb_words = make_uint4(0u, 0u, 0u, 0u);
  __syncthreads();
  volatile unsigned* bar_st = (volatile unsigned*)&xb_words;
  const unsigned bar_xcc = xb_xcc_id();
  if (tid == 0) (void)xb_add(&bar_ctr[XB_XCNT(bar_xcc)], 1u);
  if (p.ws == nullptr) grid.sync();

#ifdef EXTRA_SYNCS
  for (int e_ = 0; e_ < EXTRA_SYNCS; ++e_) GSYNC();
#endif
  for (int rep_ = 0; rep_ < REP_P0; ++rep_) {
  phase0(p, smem);
  GSYNC();
  }
  DBG_AT(0, dbg_probe_bf16(p, L0_H, 16384L*1024))
  for (int rep_ = 0; rep_ < REP_P1; ++rep_) {
#ifdef USE_G256
  {
    unsigned* wq = bar_ctr + 3600;
    volatile unsigned* slot = (volatile unsigned*)&xb_words;
    for (int s_ = 0; s_ < 8; ++s_) {
      const int x = (int)((bar_xcc + (unsigned)s_) & 7u);
      for (;;) {
        if (tid == 0) slot[3] = xb_add(&wq[(8 + x) * 64], 1u);
        __syncthreads();
        const int u = (int)slot[3];
        __syncthreads();
        if (u >= 304) break;
        if (u < 256) {
          const int tm = x * 8 + ((u & 63) >> 3), tn = (u >> 6) * 8 + (u & 7);
          gemm256((const bf16_t*)(ws + L0_H), 1024, (const bf16_t*)(ws + OFF_WIN0), 1024, 1024, tm * 256, tn * 128, sA, (bf16_t*)(smem + 32768),
                  [&](f32x4 (&acc)[4][4], int mb, int nb, int ln) { epi_proj0(p, acc, mb, nb, ln); });
        } else {
          const int v_ = u - 256;
          const int tm = x * 16 + v_ / 3, tn = 32 + v_ % 3;
          gemm128<false>((const bf16_t*)(ws + L0_H), 1024, 16383, (const bf16_t*)(ws + OFF_WIN0), 1024, 4383, 1024, tm * 128, tn * 128, sA, sB,
                  [&](f32x4 (&acc)[4][4], int mb, int nb, int ln) { epi_proj0(p, acc, mb, nb, ln); });
        }
      }
    }
  }
#else
  for (int k_ = 0; k_ * (G >> 3) < 16 * 35; ++k_) {
    int tm, tn;
    if (!gemm_tile_xcd(bid, G, k_, 35, tm, tn)) continue;
    gemm128<false>((const bf16_t*)(ws + L0_H), 1024, 16383, (const bf16_t*)(ws + OFF_WIN0), 1024, 4383, 1024, tm * 128, tn * 128, sA, sB,
            [&](f32x4 (&acc)[4][4], int mb, int nb, int ln) { epi_proj0(p, acc, mb, nb, ln); });
  }
#endif
  GSYNC();
  }
  DBG_AT(1, dbg_probe_bf16(p, L0_QKRAW, 16384L*1024)) DBG_AT(101, dbg_probe_combo(p)) DBG_AT(102, dbg_probe_bf16(p, L0_KS, 4L*8192*64*4)) DBG_AT(103, dbg_probe_f32(p, L0_IG, 16384L*4*2+16384L*24)) DBG_AT(104, dbg_probe_bf16(p, L0_MVT, 16384L*512*3))
  for (int rep_ = 0; rep_ < REP_P2; ++rep_) {
  for (int it = bid; it < 128 + 2048; it += G) {
    if (it < 128) {
      int ksp = it >> 5, kv = (it >> 4) & 1, bg = (it >> 2) & 3, tm = it & 3;
      const bf16_t* A = (const bf16_t*)(ws + (kv ? L0_VCRAW : L0_KCRAW)) + (long)bg * 8192 * 64 + ksp * 512;
      const bf16_t* B = (const bf16_t*)(ws + (kv ? OFF_WCV : OFF_WCK)) + ksp * 512;
      gemm128<false>(A, 1024, 510, B, 2048, 127, 512, tm * 128, 0, sA, sB,
              [&](f32x4 (&acc)[4][4], int mb, int nb, int ln) { epi_cmp_hidden(p, acc, mb, nb, ln, kv, bg, ksp); });
    } else {
      conv_tile(p, it - 128, smem);
    }
  }
  GSYNC();
  }
  DBG_AT(2, dbg_probe_bf16(p, L0_QC, 16384L*512*3)) DBG_AT(201, dbg_probe_f32(p, L0_HID, 2L*4*512*128))
  for (int rep_ = 0; rep_ < REP_P3; ++rep_) {
  for (int it = bid; it < 512 + 1024; it += G) {
    if (it < 512) mlstm_local(p, it, smem);
    else { const int t_ = opaque_tid(); cmp_finalize(p, (it - 512) * 4 + (t_ >> 6), t_ & 63); }
  }
  GSYNC();
  }
  DBG_AT(3, dbg_probe_f32(p, L0_H, 512L*16384)) DBG_AT(301, dbg_probe_bf16(p, L0_KCMP, 4L*512*64*2)) DBG_AT(302, dbg_probe_f32(p, L0_DN, 512L*128 + 2048))
  for (int rep_ = 0; rep_ < REP_P4; ++rep_) {
#ifdef DUMMY_P4
  mlstm_scan<true>(p, smem);
  GSYNC();
#endif
  mlstm_scan<false>(p, smem);
  GSYNC();
  }
  DBG_AT(4, dbg_probe_f32(p, L0_H, 512L*16384)) DBG_AT(401, dbg_probe_f32(p, L0_DN, 512L*128 + 3072))
  for (int rep_ = 0; rep_ < REP_P5; ++rep_) {
#ifdef USE_WQ
  {
    unsigned* wq = bar_ctr + 3600;
    volatile unsigned* slot = (volatile unsigned*)&xb_words;
    for (int s_ = 0; s_ < 5; ++s_) {
      const int qi = (s_ < 4) ? (int)((bar_xcc + (unsigned)s_) & 3u) : 4;
      const int qn_ = (s_ < 4) ? 256 : 1024;
      for (;;) {
        if (tid == 0) slot[3] = xb_add(&wq[qi * 64], 1u);
        __syncthreads();
        const int it = (int)slot[3];
        __syncthreads();
        if (it >= qn_) break;
        if (s_ < 4) nsa_tile(p, (255 - it) * 4 + qi, smem);
        else mlstm_out(p, it, smem);
      }
    }
  }
#else
  for (int it = bid; it < 1024 + 1024; it += G) {
    if (it < 1024) {
      int k = it >> 9, i = it & 511;
      int idx = (k & 1) ? (k * 512 + 511 - i) : it;
#ifndef DBG_SKIP_NSA
      for (int r2_ = 0; r2_ < REP_NSA; ++r2_) nsa_tile(p, idx, smem);
#endif
    } else {
#ifndef DBG_SKIP_MOUT
      mlstm_out(p, it - 1024, smem);
#endif
    }
  }
#endif
  GSYNC();
  }
  DBG_AT(5, dbg_probe_bf16(p, L0_QKRAW, 16384L*1024))
  for (int rep_ = 0; rep_ < REP_P6; ++rep_) {
#ifdef USE_G256
  for (int k_ = 0; k_ * (G >> 3) < 8 * 8; ++k_) {
    int tm, tn;
    if (!gemm_tile_xcd256(bid, G, k_, 8, tm, tn)) continue;
    gemm256((const bf16_t*)(ws + L0_QKRAW), 1024, (const bf16_t*)(ws + OFF_WOUT0), 1024, 1024, tm * 256, tn * 128, sA, (bf16_t*)(smem + 32768),
            [&](f32x4 (&acc)[4][4], int mb, int nb, int ln) { epi_out_resid(p.x, p.out, acc, mb, nb, ln); });
  }
#else
  for (int k_ = 0; k_ * (G >> 3) < 16 * 8; ++k_) {
    int tm, tn;
    if (!gemm_tile_xcd(bid, G, k_, 8, tm, tn)) continue;
    gemm128<false>((const bf16_t*)(ws + L0_QKRAW), 1024, 16383, (const bf16_t*)(ws + OFF_WOUT0), 1024, 1023, 1024, tm * 128, tn * 128, sA, sB,
            [&](f32x4 (&acc)[4][4], int mb, int nb, int ln) { epi_out_resid(p.x, p.out, acc, mb, nb, ln); });
  }
#endif
  GSYNC();
  }
  DBG_AT(6, (void)0)
  for (int rep_ = 0; rep_ < REP_P7; ++rep_) {
  { const int t_ = opaque_tid(); for (int row = (bid * 4 + (t_ >> 6)) * 2; row < 16384; row += G * 8) rmsnorm_row2(p.out, p.norm_w + 1024, (bf16_t*)(ws + L1_H), row, row + 1, t_ & 63); }
  GSYNC();
  }
  DBG_AT(7, dbg_probe_bf16(p, L1_H, 16384L*1024))
  for (int rep_ = 0; rep_ < REP_P8; ++rep_) {
#ifdef USE_G256
  for (int k_ = 0; k_ * (G >> 3) < 8 * 32; ++k_) {
    int tm, tn;
    if (!gemm_tile_xcd256(bid, G, k_, 32, tm, tn)) continue;
    gemm256((const bf16_t*)(ws + L1_H), 1024, (const bf16_t*)(ws + OFF_WIN1), 1024, 1024, tm * 256, tn * 128, sA, (bf16_t*)(smem + 32768),
            [&](f32x4 (&acc)[4][4], int mb, int nb, int ln) { epi_proj1(p, acc, mb, nb, ln); });
  }
#else
  for (int k_ = 0; k_ * (G >> 3) < 16 * 32; ++k_) {
    int tm, tn;
    if (!gemm_tile_xcd(bid, G, k_, 32, tm, tn)) continue;
    gemm128<false>((const bf16_t*)(ws + L1_H), 1024, 16383, (const bf16_t*)(ws + OFF_WIN1), 1024, 4095, 1024, tm * 128, tn * 128, sA, sB,
            [&](f32x4 (&acc)[4][4], int mb, int nb, int ln) { epi_proj1(p, acc, mb, nb, ln); });
  }
#endif
  GSYNC();
  }
  DBG_AT(8, dbg_probe_bf16(p, L1_FP, 16384L*1024*4))
  for (int rep_ = 0; rep_ < REP_P9; ++rep_) {
  for (int it = bid; it < 2048; it += G) hgrn_local(p, it, smem);
  GSYNC();
  }
  DBG_AT(9, dbg_probe_bf16(p, L1_ST, 2048L*16384))
  for (int rep_ = 0; rep_ < REP_P10; ++rep_) {
#ifdef DUMMY_P10
  hgrn_scan<true>(p);
  GSYNC();
#endif
  hgrn_scan<false>(p);
  GSYNC();
  }
  DBG_AT(10, dbg_probe_bf16(p, L1_ST, 2048L*16384))
  for (int rep_ = 0; rep_ < REP_P11; ++rep_) {
  for (int it = bid; it < 2048; it += G) hgrn_out(p, it, smem);
  GSYNC();
  }
  DBG_AT(11, dbg_probe_bf16(p, L1_H, 16384L*1024))
  for (int rep_ = 0; rep_ < REP_P12; ++rep_) {
#ifdef USE_G256
  for (int k_ = 0; k_ * (G >> 3) < 8 * 8; ++k_) {
    int tm, tn;
    if (!gemm_tile_xcd256(bid, G, k_, 8, tm, tn)) continue;
    gemm256((const bf16_t*)(ws + L1_H), 1024, (const bf16_t*)(ws + OFF_WOUT1), 1024, 1024, tm * 256, tn * 128, sA, (bf16_t*)(smem + 32768),
            [&](f32x4 (&acc)[4][4], int mb, int nb, int ln) { epi_out_resid(p.out, p.out, acc, mb, nb, ln); });
  }
#else
  for (int k_ = 0; k_ * (G >> 3) < 16 * 8; ++k_) {
    int tm, tn;
    if (!gemm_tile_xcd(bid, G, k_, 8, tm, tn)) continue;
    gemm128<false>((const bf16_t*)(ws + L1_H), 1024, 16383, (const bf16_t*)(ws + OFF_WOUT1), 1024, 1023, 1024, tm * 128, tn * 128, sA, sB,
            [&](f32x4 (&acc)[4][4], int mb, int nb, int ln) { epi_out_resid(p.out, p.out, acc, mb, nb, ln); });
  }
#endif
  }
  __syncthreads();
  if (tid == 0) {
    const unsigned done_ = xb_add(&bar_ctr[8000], 1u);
    if (done_ == (unsigned)G - 1u) {
      for (int j_ = 0; j_ < 16; ++j_) {
        __hip_atomic_store(&bar_ctr[XB_XCNT(j_)], 0u, __ATOMIC_RELAXED, __HIP_MEMORY_SCOPE_AGENT);
        __hip_atomic_store(&bar_ctr[XB_XSUB(j_)], 0u, __ATOMIC_RELAXED, __HIP_MEMORY_SCOPE_AGENT);
        __hip_atomic_store(&bar_ctr[XB_XGEN(j_)], 0u, __ATOMIC_RELAXED, __HIP_MEMORY_SCOPE_AGENT);
        __hip_atomic_store(&bar_ctr[3600 + j_ * 64], 0u, __ATOMIC_RELAXED, __HIP_MEMORY_SCOPE_AGENT);
      }
      __hip_atomic_store(&bar_ctr[XB_TMO], 0u, __ATOMIC_RELAXED, __HIP_MEMORY_SCOPE_AGENT);
      __hip_atomic_store(&bar_ctr[XB_TOP], 0u, __ATOMIC_RELAXED, __HIP_MEMORY_SCOPE_AGENT);
      __hip_atomic_store(&bar_ctr[XB_TOPGEN], 0u, __ATOMIC_RELAXED, __HIP_MEMORY_SCOPE_AGENT);
      __hip_atomic_store(&bar_ctr[8000], 0u, __ATOMIC_RELAXED, __HIP_MEMORY_SCOPE_AGENT);
    }
  }
}

extern "C" void kernel_launch(void* const* d_in, const int* in_sizes, int n_in, void* d_out, int out_size, void* d_ws, size_t ws_size,
                              hipStream_t stream) {
  static int grid_blocks = 0;
  if (!grid_blocks) {
    int dev = 0, cus = 0, per_cu = 0;
    (void)hipGetDevice(&dev);
    (void)hipDeviceGetAttribute(&cus, hipDeviceAttributeMultiprocessorCount, dev);
    (void)hipOccupancyMaxActiveBlocksPerMultiprocessor(&per_cu, mega, 256, 0);
    if (per_cu > 2) per_cu = 2;
    if (per_cu < 1) per_cu = 1;
    grid_blocks = cus * per_cu;
  }
  Params p{};
  const float** pf = (const float**)&p;
  for (int i = 0; i < 22; ++i) pf[i] = (const float*)d_in[i];
  p.out = (float*)d_out;
  p.ws = (unsigned char*)d_ws;
  void* args[] = {&p};
  hipError_t e = hipLaunchCooperativeKernel((void*)mega, dim3(grid_blocks), dim3(256), args, 0, stream);
  if (e != hipSuccess) fprintf(stderr, "cooperative launch failed: %s (grid %d)\n", hipGetErrorString(e), grid_blocks);
}
```
